# Optimizing an MI355X kernel written in HIP

```python
import math
import jax, jax.numpy as jnp
from jax import lax
import numpy as np

D_MODEL = 1024
BATCH = 16
SEQ = 2048
DEPTH = 4

PLE_DIM = 256
D_FF = 2816
RMS_EPS = 1e-6
N_BRANCH = 3
MIX_W = 512

HG_HEADS = 8
HG_DK = 64
HG_DV = 64
HG_CHUNK = 64
NSA_HEADS = 8
NSA_KV_HEADS = 2
NSA_HD = 64
CMP_LEN = 32
CMP_STRIDE = 16
CMP_HIDDEN = 128
SLC_BLOCK = 64
SLC_TOPN = 8
SLC_QBLOCK = 64
WIN = 256
WIN_QBLOCK = 128
RW_HEADS = 8
RW_HD = 64
RW_DECAY_LORA = 64
RW_A_LORA = 64
RW_GATE_LORA = 128
RW_GN_EPS = 64e-5
REL_BUCKETS = 32
REL_MAX_DIST = 128

HG_W = HG_HEADS * HG_DK
NSA_W = NSA_HEADS * NSA_HD
NSA_KV_W = NSA_KV_HEADS * NSA_HD
RW_W = RW_HEADS * RW_HD
RW_SIZES = (RW_W, RW_W, RW_W, RW_DECAY_LORA, RW_A_LORA, RW_GATE_LORA)
RW_COLS = 3 * RW_W + RW_DECAY_LORA + RW_A_LORA + RW_GATE_LORA
IN_SIZES = (HG_W, HG_W, HG_W, HG_W, NSA_W, NSA_KV_W, NSA_KV_W, NSA_KV_W, NSA_KV_W, NSA_KV_W, NSA_KV_W, 3 * NSA_HEADS, RW_COLS, N_BRANCH * D_MODEL)
IN_COLS = 4 * HG_W + NSA_W + 6 * NSA_KV_W + 3 * NSA_HEADS + RW_COLS + N_BRANCH * D_MODEL

kernel_name = "hybrid_hgrn2_nsa_rwkv7_macaron"


def _split(t, sizes):
    return jnp.split(t, np.cumsum(sizes)[:-1].tolist(), axis=-1)


def rmsnorm(x, g, eps=RMS_EPS):
    xf = x.astype(jnp.float32)
    y = xf * lax.rsqrt(jnp.mean(xf * xf, axis=-1, keepdims=True) + eps)
    return (y * g.astype(jnp.float32)).astype(x.dtype)


def swiglu(x, w_gu, w_d):
    gate, up = jnp.split(x @ w_gu, 2, axis=-1)
    return (jax.nn.silu(gate) * up) @ w_d


def t5_bucket(n):
    n = jnp.maximum(n, 0)
    max_exact = REL_BUCKETS // 2
    nf = jnp.maximum(n, 1).astype(jnp.float32)
    large = max_exact + (jnp.log(nf / max_exact) / math.log(REL_MAX_DIST / max_exact) * (REL_BUCKETS - max_exact)).astype(jnp.int32)
    large = jnp.minimum(large, REL_BUCKETS - 1)
    return jnp.where(n < max_exact, n, large)


def masked_softmax(logits, mask):
    logits = jnp.where(mask, logits.astype(jnp.float32), -jnp.inf)
    m = jnp.max(logits, axis=-1, keepdims=True)
    m = jnp.where(jnp.isfinite(m), m, 0.0)
    e = jnp.exp(logits - m)
    return e / jnp.maximum(jnp.sum(e, axis=-1, keepdims=True), 1e-30)


def hgrn2(q_raw, f_raw, i_raw, g_raw, lb, norm_g):
    B, S, _ = q_raw.shape
    H, C = HG_HEADS, HG_CHUNK
    N = S // C
    f32 = jnp.float32
    z = f_raw.astype(f32)
    lb = jnp.maximum(lb, 0.0)
    log_f = jnp.logaddexp(jax.nn.log_sigmoid(z), jnp.log(lb) + jax.nn.log_sigmoid(-z))
    k = (1.0 - lb) * jax.nn.sigmoid(-z)
    q = jax.nn.silu(q_raw.astype(f32))
    v = i_raw.astype(f32)

    def chunks(t, d):
        return t.reshape(B, N, C, H, d).transpose(1, 0, 3, 2, 4)

    causal = jnp.tril(jnp.ones((C, C), dtype=bool))[:, :, None]

    def step(state, inp):
        qc, kc, vc, lfc = inp
        b = jnp.cumsum(lfc, axis=2)
        decay = jnp.exp(jnp.where(causal, b[:, :, :, None, :] - b[:, :, None, :, :], -jnp.inf))
        scores = jnp.sum(qc[:, :, :, None, :] * kc[:, :, None, :, :] * decay, axis=-1)
        o = scores @ vc + jnp.einsum("bhtd,bhde->bhte", qc * jnp.exp(b), state)
        b_end = b[:, :, -1:, :]
        state = jnp.exp(b_end[:, :, 0, :, None]) * state + jnp.einsum("bhsd,bhse->bhde", kc * jnp.exp(b_end - b), vc)
        return state, o

    state0 = jnp.zeros((B, H, HG_DK, HG_DV), f32)
    _, o = lax.scan(step, state0, (chunks(q, HG_DK), chunks(k, HG_DK), chunks(v, HG_DV), chunks(log_f, HG_DK)))
    o = o.transpose(1, 0, 3, 2, 4).reshape(B, S, H, HG_DV)
    o = o * lax.rsqrt(jnp.mean(o * o, axis=-1, keepdims=True) + RMS_EPS) * norm_g.astype(f32).reshape(H, HG_DV)
    o = o.reshape(B, S, H * HG_DV) * jax.nn.silu(g_raw.astype(f32))
    return o.astype(q_raw.dtype)


def nsa(q_raw, k_cmp, v_cmp, k_slc, v_slc, k_win, v_win, gate_raw, pe, w1, w2, rel_bias):
    B, S, _ = q_raw.shape
    G, HPG, Dh = NSA_KV_HEADS, NSA_HEADS // NSA_KV_HEADS, NSA_HD
    q = q_raw.reshape(B, S, G, HPG, Dh) * (Dh ** -0.5)
    kv = lambda t: t.reshape(B, S, G, Dh)
    pos = jnp.arange(S)

    n_cmp = (S - CMP_LEN) // CMP_STRIDE + 1
    blk_idx = np.arange(n_cmp)[:, None] * CMP_STRIDE + np.arange(CMP_LEN)[None, :]

    def compress(t, pe_, w1_, w2_):
        blocks = t[:, blk_idx] + pe_[None, None, :, None, :]
        hid = jax.nn.silu(jnp.einsum("bnlgd,ldh->bngh", blocks, w1_.reshape(CMP_LEN, Dh, CMP_HIDDEN)))
        return hid @ w2_

    kc = compress(kv(k_cmp), pe[0], w1[0], w2[0])
    vc = compress(kv(v_cmp), pe[1], w1[1], w2[1])
    dist_c = pos[:, None] - jnp.asarray(blk_idx[:, -1])[None, :]
    bias_c = rel_bias[t5_bucket(dist_c)].reshape(S, n_cmp, G, HPG).transpose(2, 3, 0, 1)
    p_cmp = masked_softmax(jnp.einsum("bsghd,bngd->bghsn", q, kc) + bias_c, dist_c >= 0)
    o_cmp = jnp.einsum("bghsn,bngd->bsghd", p_cmp, vc.astype(jnp.float32))

    n_slc = S // SLC_BLOCK
    s_lo = np.arange(n_slc) * SLC_BLOCK
    cover = ((blk_idx[:, :1] <= (s_lo + SLC_BLOCK - 1)[None, :]) & (blk_idx[:, -1:] >= s_lo[None, :])).astype(np.float32)
    imp = jnp.einsum("bghsn,nm->bgsm", p_cmp, jnp.asarray(cover))
    cur = (pos // SLC_BLOCK)[:, None]
    blk = jnp.arange(n_slc)[None, :]
    forced = (blk == 0) | (blk == cur) | (blk == cur - 1)
    score = jnp.where(forced, jnp.inf, jnp.where(blk <= cur, imp, -jnp.inf))
    n_sel = min(SLC_TOPN, n_slc)
    _, sel = lax.top_k(score, n_sel)

    ks = kv(k_slc).reshape(B, n_slc, SLC_BLOCK, G, Dh).transpose(0, 3, 1, 2, 4)
    vs = kv(v_slc).reshape(B, n_slc, SLC_BLOCK, G, Dh).transpose(0, 3, 1, 2, 4)
    n_qb = S // SLC_QBLOCK
    q_b = q.reshape(B, n_qb, SLC_QBLOCK, G, HPG, Dh).transpose(1, 0, 2, 3, 4, 5)
    sel_b = sel.reshape(B, G, n_qb, SLC_QBLOCK, n_sel).transpose(2, 0, 1, 3, 4)
    qpos_b = pos.reshape(n_qb, SLC_QBLOCK)
    bi = jnp.arange(B)[:, None, None, None]
    gi = jnp.arange(G)[None, :, None, None]
    table_g = rel_bias.reshape(REL_BUCKETS, G, HPG).transpose(1, 0, 2)
    n_keys = n_sel * SLC_BLOCK

    def slc_block(args):
        qb, sb, qp = args
        kg = ks[bi, gi, sb].reshape(B, G, SLC_QBLOCK, n_keys, Dh)
        vg = vs[bi, gi, sb].reshape(B, G, SLC_QBLOCK, n_keys, Dh)
        kpos = (sb[..., None] * SLC_BLOCK + jnp.arange(SLC_BLOCK)).reshape(B, G, SLC_QBLOCK, n_keys)
        dist = qp[None, None, :, None] - kpos
        bias = table_g[gi, t5_bucket(dist)].transpose(0, 1, 4, 2, 3)
        logits = jnp.einsum("bqghd,bgqkd->bghqk", qb, kg) + bias
        pr = masked_softmax(logits, (dist >= 0)[:, :, None])
        return jnp.einsum("bghqk,bgqkd->bqghd", pr, vg.astype(jnp.float32))

    o_slc = lax.map(slc_block, (q_b, sel_b, qpos_b)).transpose(1, 0, 2, 3, 4, 5).reshape(B, S, G, HPG, Dh)

    nwb = S // WIN_QBLOCK
    nprev = WIN // WIN_QBLOCK
    kw_len = (nprev + 1) * WIN_QBLOCK

    def band(t):
        tb = jnp.pad(t.reshape(B, nwb, WIN_QBLOCK, G, Dh), ((0, 0), (nprev, 0), (0, 0), (0, 0), (0, 0)))
        return jnp.concatenate([tb[:, j:j + nwb] for j in range(nprev + 1)], axis=2)

    kwb, vwb = band(kv(k_win)), band(kv(v_win))
    ka = np.arange(kw_len)
    rel = nprev * WIN_QBLOCK + np.arange(WIN_QBLOCK)[:, None] - ka[None, :]
    kpos_w = (np.arange(nwb)[:, None] - nprev) * WIN_QBLOCK + ka[None, :]
    mask_w = ((rel >= 0) & (rel < WIN))[None] & (kpos_w >= 0)[:, None, :]
    bias_w = rel_bias[t5_bucket(jnp.asarray(rel))].reshape(WIN_QBLOCK, kw_len, G, HPG).transpose(2, 3, 0, 1)
    qw = q.reshape(B, nwb, WIN_QBLOCK, G, HPG, Dh)
    pw = masked_softmax(jnp.einsum("bnqghd,bnkgd->bnghqk", qw, kwb) + bias_w, jnp.asarray(mask_w)[None, :, None, None])
    o_win = jnp.einsum("bnghqk,bnkgd->bnqghd", pw, vwb.astype(jnp.float32)).reshape(B, S, G, HPG, Dh)

    g = jax.nn.sigmoid(gate_raw.astype(jnp.float32)).reshape(B, S, G, HPG, 3)
    o = g[..., 0:1] * o_cmp + g[..., 1:2] * o_slc + g[..., 2:3] * o_win
    return o.reshape(B, S, NSA_W).astype(q_raw.dtype)


def rwkv7(proj, mu, w0, wB, a0, aB, gB, k_k, k_a, r_k, ln_w, ln_b):
    B, S, _ = proj.shape
    H, N = RW_HEADS, RW_HD
    f32 = jnp.float32
    prev = jnp.pad(proj, ((0, 0), (1, 0), (0, 0)))[:, :-1]
    xm = proj + (prev - proj) * mu
    r, k, v, wl, al, gl = _split(xm, RW_SIZES)
    w = -jax.nn.softplus(-(w0 + jnp.tanh(wl) @ wB)) - 0.5
    decay = jnp.exp(-jnp.exp(w.astype(f32)))
    a = jax.nn.sigmoid(a0 + al @ aB)
    g = jax.nn.sigmoid(gl) @ gB
    hd = lambda t: t.astype(f32).reshape(B, S, H, N)
    kk = hd(k * k_k)
    kk = kk / jnp.maximum(jnp.sqrt(jnp.sum(kk * kk, axis=-1, keepdims=True)), 1e-12)
    k = k * (1.0 + (a - 1.0) * k_a)
    r_h, k_h, v_h, a_h, w_h = hd(r), hd(k), hd(v), hd(a), hd(decay)
    tm = lambda t: t.transpose(1, 0, 2, 3)

    def step(st, inp):
        r_t, w_t, k_t, v_t, kk_t, a_t = inp
        sa = jnp.einsum("bhvk,bhk->bhv", st, -kk_t)
        st = st * w_t[:, :, None, :] + sa[..., None] * (kk_t * a_t)[:, :, None, :] + v_t[..., None] * k_t[:, :, None, :]
        return st, jnp.einsum("bhvk,bhk->bhv", st, r_t)

    st0 = jnp.zeros((B, H, N, N), f32)
    _, y = lax.scan(step, st0, (tm(r_h), tm(w_h), tm(k_h), tm(v_h), tm(kk), tm(a_h)))
    y = y.transpose(1, 0, 2, 3)
    mean = jnp.mean(y, axis=-1, keepdims=True)
    var = jnp.mean(jnp.square(y - mean), axis=-1, keepdims=True)
    y = (y - mean) * lax.rsqrt(var + RW_GN_EPS) * ln_w.astype(f32).reshape(H, N) + ln_b.astype(f32).reshape(H, N)
    y = y + jnp.sum(r_h * k_h * r_k.astype(f32), axis=-1, keepdims=True) * v_h
    return (y.reshape(B, S, H * N) * g.astype(f32)).astype(proj.dtype)


def setup_inputs(seed: int = 0) -> dict:
    key = jax.random.key(seed)
    keys = iter(jax.random.split(key, 40))
    f32 = jnp.float32
    L, D = DEPTH, D_MODEL

    def nrm(shape, scale):
        return jax.random.normal(next(keys), shape, f32) * scale

    def gain(shape):
        return 1.0 + 0.02 * jax.random.normal(next(keys), shape, f32)

    return {
        "x": nrm((BATCH, SEQ, D), 1.0),
        "p": nrm((L, BATCH, SEQ, PLE_DIM), 1.0),
        "ffn1_norm": gain((L, D)),
        "ffn1_wgu": nrm((L, D, 2 * D_FF), D ** -0.5),
        "ffn1_wd": nrm((L, D_FF, D), D_FF ** -0.5),
        "mix_norm": gain((L, D)),
        "w_in": nrm((L, D, IN_COLS), D ** -0.5),
        "hg_lb": nrm((L, HG_W), 0.1),
        "hg_norm": gain((L, HG_W)),
        "cmp_pe": nrm((L, 2, CMP_LEN, NSA_HD), 0.1),
        "cmp_w1": nrm((L, 2, CMP_LEN * NSA_HD, CMP_HIDDEN), (CMP_LEN * NSA_HD) ** -0.5),
        "cmp_w2": nrm((L, 2, CMP_HIDDEN, NSA_HD), CMP_HIDDEN ** -0.5),
        "rel_bias": nrm((REL_BUCKETS, NSA_HEADS), 0.5),
        "rw_mu": jax.random.uniform(next(keys), (L, RW_COLS), f32),
        "rw_w0": nrm((L, RW_W), 0.5),
        "rw_wB": nrm((L, RW_DECAY_LORA, RW_W), RW_DECAY_LORA ** -0.5),
        "rw_a0": nrm((L, RW_W), 0.5),
        "rw_aB": nrm((L, RW_A_LORA, RW_W), RW_A_LORA ** -0.5),
        "rw_gB": nrm((L, RW_GATE_LORA, RW_W), RW_GATE_LORA ** -0.5),
        "rw_kk": 0.85 + nrm((L, RW_W), 0.1),
        "rw_ka": 1.0 + nrm((L, RW_W), 0.1),
        "rw_rk": nrm((L, RW_HEADS, RW_HD), 0.1),
        "rw_ln_w": gain((L, RW_W)),
        "rw_ln_b": nrm((L, RW_W), 0.02),
        "w_branch": nrm((L, N_BRANCH, MIX_W, D), MIX_W ** -0.5),
        "w_out": nrm((L, D, D), D ** -0.5),
        "ffn2_norm": gain((L, D)),
        "ffn2_wgu": nrm((L, D, 2 * D_FF), D ** -0.5),
        "ffn2_wd": nrm((L, D_FF, D), D_FF ** -0.5),
        "ple_norm": gain((L, D)),
        "ple_gate_w": nrm((L, D, D), D ** -0.5),
        "ple_w": nrm((L, PLE_DIM, D), PLE_DIM ** -0.5),
        "final_norm": gain((D,)),
    }


def reference(x, p, ffn1_norm, ffn1_wgu, ffn1_wd, mix_norm, w_in, hg_lb, hg_norm,
              cmp_pe, cmp_w1, cmp_w2, rel_bias, rw_mu, rw_w0, rw_wB, rw_a0, rw_aB, rw_gB,
              rw_kk, rw_ka, rw_rk, rw_ln_w, rw_ln_b, w_branch, w_out,
              ffn2_norm, ffn2_wgu, ffn2_wd, ple_norm, ple_gate_w, ple_w, final_norm):
    B, S, D = x.shape
    lb_w = jax.nn.softmax(hg_lb.astype(jnp.float32), axis=0)
    lower_bounds = jnp.cumsum(lb_w, axis=0) - lb_w[0]
    h = x
    for i in range(DEPTH):
        h = h + 0.5 * swiglu(rmsnorm(h, ffn1_norm[i]), ffn1_wgu[i], ffn1_wd[i])
        u = rmsnorm(h, mix_norm[i])
        (hq, hf, hi, hg, nq, kc, vc, ksl, vsl, kw, vw, ngate, rwp, mgate) = _split(u @ w_in[i], IN_SIZES)
        o_hg = hgrn2(hq, hf, hi, hg, lower_bounds[i], hg_norm[i])
        o_ns = nsa(nq, kc, vc, ksl, vsl, kw, vw, ngate, cmp_pe[i], cmp_w1[i], cmp_w2[i], rel_bias)
        o_rw = rwkv7(rwp, rw_mu[i], rw_w0[i], rw_wB[i], rw_a0[i], rw_aB[i], rw_gB[i],
                     rw_kk[i], rw_ka[i], rw_rk[i], rw_ln_w[i], rw_ln_b[i])
        gates = jax.nn.sigmoid(mgate).reshape(B, S, N_BRANCH, D)
        merged = (gates[:, :, 0] * (o_hg @ w_branch[i, 0])
                  + gates[:, :, 1] * (o_ns @ w_branch[i, 1])
                  + gates[:, :, 2] * (o_rw @ w_branch[i, 2]))
        h = h + merged @ w_out[i]
        h = h + 0.5 * swiglu(rmsnorm(h, ffn2_norm[i]), ffn2_wgu[i], ffn2_wd[i])
        ple_gate = jax.nn.sigmoid(rmsnorm(h, ple_norm[i]) @ ple_gate_w[i])
        h = h + ple_gate * (p[i] @ ple_w[i])
    return rmsnorm(h, final_norm)
```

```cpp
#include <hip/hip_runtime.h>
#include <hip/hip_cooperative_groups.h>
#include <cstdio>
namespace cg = cooperative_groups;

#define LAS __attribute__((address_space(3)))
#define DI __device__ __forceinline__
typedef unsigned short bf16_t;
typedef short bf16x8 __attribute__((ext_vector_type(8)));
typedef float f32x4 __attribute__((ext_vector_type(4)));
typedef float f32x2 __attribute__((ext_vector_type(2)));
typedef float f32x16 __attribute__((ext_vector_type(16)));
typedef unsigned u32x4 __attribute__((ext_vector_type(4)));
typedef unsigned u32x2 __attribute__((ext_vector_type(2)));

constexpr int T_TOK = 32768, SEQ = 2048, NB = 16, DM = 1024, DFF = 2816, DEPTH = 4;
constexpr int PLD = 8448;
constexpr int C_HQ = 0, C_HF = 512, C_HI = 1024, C_HG = 1536, C_NQ = 2048, C_KC = 2560, C_VC = 2688, C_KS = 2816, C_VS = 2944,
              C_KW = 3072, C_VW = 3200, C_NG = 3328, C_RW = 3352, C_MG = 5376, IN_REAL = 5144, IN_COLS = 8216;
enum { I_X = 0, I_P, I_F1N, I_F1GU, I_F1D, I_MIXN, I_WIN, I_HGLB, I_HGN, I_PE, I_CW1, I_CW2, I_RELB, I_MU, I_W0, I_WB, I_A0, I_AB, I_GB,
       I_KK, I_KA, I_RK, I_LNW, I_LNB, I_WBR, I_WOUT, I_F2N, I_F2GU, I_F2D, I_PLEN, I_PLEG, I_PLEW, I_FINN, N_INPUTS };

constexpr size_t WS_PEB = 4096;
constexpr size_t WS_WBF = 8192;
constexpr size_t E_GU1 = 0, E_D1 = E_GU1 + 5632ull * 1024, E_IN = E_D1 + 1024ull * 2816, E_BR = E_IN + 8448ull * 1024, E_OUT = E_BR + 3ull * 1024 * 512,
                 E_GU2 = E_OUT + 1024ull * 1024, E_D2 = E_GU2 + 5632ull * 1024, E_PG = E_D2 + 1024ull * 2816, E_PW = E_PG + 1024ull * 1024,
                 E_C1 = E_PW + 1024ull * 256, E_END = E_C1 + 2ull * 256 * 1024;
constexpr size_t WS_UN = WS_WBF + E_END * 2;
constexpr size_t WS_ORW = WS_UN + (size_t)T_TOK * 1024 * 2;
constexpr size_t WS_XK = WS_ORW + (size_t)T_TOK * 512 * 2;
constexpr size_t WS_XV = WS_XK + 4096ull * 1024 * 2;
constexpr size_t WS_P01 = WS_XV + 4096ull * 1024 * 2;
constexpr size_t WS_KC = WS_P01 + 2ull * 4096 * 256 * 4;
constexpr size_t WS_PROJ = WS_KC + 2ull * 16 * 2 * 128 * 64 * 4;
constexpr size_t WS_END = WS_PROJ + (size_t)T_TOK * PLD * 2;
constexpr size_t WS_ACT = WS_PROJ;
constexpr size_t WS_PB = WS_PROJ + 200ull * 1024 * 1024;
constexpr size_t WS_TMP = WS_PROJ + 256ull * 1024 * 1024;
constexpr int LDS_BYTES = 144 * 1024;

struct Params {
    const float* in[N_INPUTS];
    float* out;
    unsigned char* ws;
    int ph_lo, ph_hi;
};
typedef const Params __attribute__((address_space(4)))* CP;

DI int tid_() { int t = threadIdx.x; asm volatile("" : "+v"(t)); return t; }
DI int bid_() { int b = blockIdx.x; asm volatile("" : "+s"(b)); return b; }
DI bf16_t f2bf(float f) { unsigned u = __float_as_uint(f); u += 0x7FFFu + ((u >> 16) & 1u); return (bf16_t)(u >> 16); }
DI float bf2f(bf16_t b) { return __uint_as_float(((unsigned)b) << 16); }
DI unsigned pack2(float lo, float hi) { return (unsigned)f2bf(lo) | ((unsigned)f2bf(hi) << 16); }
DI float sigmoidf_(float x) { return 1.0f / (1.0f + __expf(-x)); }
DI float siluf_(float x) { return x / (1.0f + __expf(-x)); }
DI float shfl_xor_(float v, int mask, int lane) { return __int_as_float(__builtin_amdgcn_ds_bpermute((lane ^ mask) << 2, __float_as_int(v))); }
DI float wave_sum(float v) {
    const int lane = tid_() & 63;
#pragma unroll
    for (int o = 32; o >= 1; o >>= 1) v += shfl_xor_(v, o, lane);
    return v;
}

namespace pg8 {
constexpr int BM = 256, BK = 64, HALF = 128, HTB = HALF * BK * 2, STAGE_BYTES = 8 * HTB, NXCD = 8, WGM = 8;
DI int lds_byte(int r, int c) { const int st = (r >> 4) * 2 + (c >> 5), rr = r & 15, cc = c & 31, ob = rr * 64 + cc * 2; return st * 1024 + (ob ^ (((ob >> 9) & 1) << 5)); }
DI void stage_rc(int b, int& R, int& C) { const int st = b / 1024, sb = b % 1024, swz = sb ^ (((sb >> 9) & 1) << 5); R = (st >> 1) * 16 + swz / 64; C = (st & 1) * 32 + (swz % 64) / 2; }
DI int perm32(int rho) { const int n = rho >> 4, i = rho & 15; return 8 * (i >> 2) + 4 * n + (i & 3); }
struct Unit { int pm, pn; };
struct Gemm { const bf16_t* A; const bf16_t* Bt; int M, N, K, lda; };
struct StaticOrder {
    int nM, nN, nwg, G, c;
    DI void init(int M, int N, int G_, int c_) { nM = M / BM; nN = N / BM; nwg = nM * nN; G = G_; c = c_; }
    DI bool next(int i, Unit& u) const {
        const long L = (long)i * G + c; if (L >= nwg) return false;
        int wgid = (int)L; { const int q = nwg / NXCD, r = nwg % NXCD, xcd = wgid % NXCD, off = wgid / NXCD; wgid = (xcd < r ? xcd * (q + 1) : r * (q + 1) + (xcd - r) * q) + off; }
        const int nig = WGM * nN, gid = wgid / nig, fm = gid * WGM, gsz = (nM - fm) < WGM ? (nM - fm) : WGM;
        u.pm = fm + ((wgid % nig) % gsz); u.pn = (wgid % nig) / gsz; return true;
    }
};

template <class Epi>
DI void gemm_phase(LAS unsigned char* lds, const Gemm g, const StaticOrder& S, const Epi& E) {
    int tid = tid_();
    const int wid = __builtin_amdgcn_readfirstlane(tid >> 6), lane = tid & 63, wr = wid >> 2, wc = wid & 3, fr = lane & 15, fq = lane >> 4;
    const int K = g.K, nt = K / BK, lda = g.lda;
    unsigned voffA[2], voffB[2];
#pragma unroll
    for (int i = 0; i < 2; ++i) { int R, C; stage_rc(tid * 16 + i * 8192, R, C); const int Rb = Epi::PERM ? ((R & ~31) + perm32(R & 31)) : R;
        voffA[i] = (unsigned)(R * lda + C) * 2u; voffB[i] = (unsigned)(Rb * K + C) * 2u; }
    const size_t kstep = (size_t)(BK * 2);
    const size_t hstepA = (size_t)HALF * lda * 2, hstepB = (size_t)HALF * K * 2;
    const size_t tstepA = 2 * hstepA, tstepB = 2 * hstepB;
    const unsigned ldsw = (unsigned)wid * 1024u;
    const int aoff = lds_byte(wr * 64 + fr, fq * 8), boff = lds_byte(wc * 32 + fr, fq * 8);
#define PG8_SA(b, h) (((b) * 2 + (h)) * HTB)
#define PG8_SB(b, h) ((4 + (b) * 2 + (h)) * HTB)
#define PG8_STAGE(bufoff, gbase, voff) do { _Pragma("unroll") for (int _i = 0; _i < 2; ++_i) \
        __builtin_amdgcn_global_load_lds((const unsigned*)((const char*)(gbase) + (voff)[_i]), (LAS unsigned*)(lds + (bufoff) + ldsw + _i * 8192), 16, 0, 0); } while (0)
#define PG8_LDA(dst, b, h) do { _Pragma("unroll") for (int m = 0; m < 4; ++m) _Pragma("unroll") for (int k = 0; k < 2; ++k) dst[m][k] = *(const LAS bf16x8*)(lds + PG8_SA(b, h) + aoff + m * 2048 + k * 1024); } while (0)
#define PG8_LDB(dst, b, h) do { _Pragma("unroll") for (int n = 0; n < 2; ++n) _Pragma("unroll") for (int k = 0; k < 2; ++k) dst[n][k] = *(const LAS bf16x8*)(lds + PG8_SB(b, h) + boff + n * 2048 + k * 1024); } while (0)
#define PG8_MMA(ai, bj, At, Bt) do { __builtin_amdgcn_s_setprio(1); _Pragma("unroll") for (int m = 0; m < 4; ++m) _Pragma("unroll") for (int n = 0; n < 2; ++n) _Pragma("unroll") for (int k = 0; k < 2; ++k) \
        acc[ai][bj][m][n] = __builtin_amdgcn_mfma_f32_16x16x32_bf16(Bt[n][k], At[m][k], acc[ai][bj][m][n], 0, 0, 0); __builtin_amdgcn_s_setprio(0); } while (0)
#define PG8_WAIT_V(n) asm volatile("s_waitcnt vmcnt(" #n ")" ::: "memory")
#define PG8_WAIT_L(n) asm volatile("s_waitcnt lgkmcnt(" #n ")" ::: "memory")
#define PG8_BAR __builtin_amdgcn_s_barrier()
#define PG8_SCHED __builtin_amdgcn_sched_barrier(0)
    Unit cur, nxt; int ui = 0;
    if (!S.next(0, cur)) return;
    f32x4 acc[2][2][4][2];
#pragma unroll
    for (int a = 0; a < 2; ++a)
#pragma unroll
        for (int b = 0; b < 2; ++b)
#pragma unroll
            for (int m = 0; m < 4; ++m)
#pragma unroll
                for (int n = 0; n < 2; ++n) acc[a][b][m][n] = (f32x4){0.f, 0.f, 0.f, 0.f};
    bf16x8 At[4][2], B0[2][2], B1[2][2];
    const char* cA = (const char*)g.A + (size_t)cur.pm * tstepA; const char* cB = (const char*)g.Bt + (size_t)cur.pn * tstepB;
    PG8_STAGE(PG8_SB(0, 0), cB, voffB); PG8_STAGE(PG8_SA(0, 0), cA, voffA); PG8_STAGE(PG8_SB(0, 1), cB + hstepB, voffB); PG8_STAGE(PG8_SA(0, 1), cA + hstepA, voffA);
    if (wr == 1) PG8_BAR;
    PG8_WAIT_V(4); PG8_BAR;
    PG8_STAGE(PG8_SB(1, 0), cB + kstep, voffB); PG8_STAGE(PG8_SA(1, 0), cA + kstep, voffA); PG8_STAGE(PG8_SB(1, 1), cB + hstepB + kstep, voffB);
    PG8_WAIT_V(6); PG8_BAR;
    for (;;) {
        const bool has_next = S.next(ui + 1, nxt);
        const char* nA = has_next ? (const char*)g.A + (size_t)nxt.pm * tstepA : cA; const char* nB = has_next ? (const char*)g.Bt + (size_t)nxt.pn * tstepB : cB;
        for (int t = 0; t < nt; t += 2) {
            const bool last = (t == nt - 2);
            const char* a1 = cA + (size_t)(t + 1) * kstep;
            const char* a2 = last ? nA : cA + (size_t)(t + 2) * kstep; const char* b2 = last ? nB : cB + (size_t)(t + 2) * kstep;
            const char* a3 = a2 + kstep; const char* b3 = b2 + kstep;
            PG8_LDB(B0, 0, 0); PG8_SCHED; PG8_LDA(At, 0, 0); PG8_STAGE(PG8_SA(1, 1), a1 + hstepA, voffA);
            PG8_WAIT_L(8); PG8_BAR; PG8_WAIT_L(0); PG8_MMA(0, 0, At, B0); PG8_BAR; PG8_SCHED;
            PG8_LDB(B1, 0, 1); PG8_STAGE(PG8_SB(0, 0), b2, voffB);
            PG8_BAR; PG8_WAIT_L(0); PG8_MMA(0, 1, At, B1); PG8_BAR;
            PG8_LDA(At, 0, 1); PG8_STAGE(PG8_SA(0, 0), a2, voffA);
            PG8_BAR; PG8_WAIT_L(0); PG8_MMA(1, 0, At, B0); PG8_BAR; PG8_SCHED;
            PG8_STAGE(PG8_SB(0, 1), b2 + hstepB, voffB);
            PG8_WAIT_V(6); PG8_BAR; PG8_MMA(1, 1, At, B1); PG8_BAR;
            PG8_LDB(B0, 1, 0); PG8_SCHED; PG8_LDA(At, 1, 0); PG8_STAGE(PG8_SA(0, 1), a2 + hstepA, voffA);
            PG8_WAIT_L(8); PG8_BAR; PG8_WAIT_L(0); PG8_MMA(0, 0, At, B0); PG8_BAR; PG8_SCHED;
            PG8_LDB(B1, 1, 1); PG8_STAGE(PG8_SB(1, 0), b3, voffB);
            PG8_BAR; PG8_WAIT_L(0); PG8_MMA(0, 1, At, B1); PG8_BAR;
            PG8_LDA(At, 1, 1); PG8_STAGE(PG8_SA(1, 0), a3, voffA);
            PG8_BAR; PG8_WAIT_L(0); PG8_MMA(1, 0, At, B0); PG8_BAR; PG8_SCHED;
            PG8_STAGE(PG8_SB(1, 1), b3 + hstepB, voffB);
            PG8_WAIT_V(6); PG8_BAR; PG8_MMA(1, 1, At, B1); PG8_BAR;
        }
        E(acc, cur, wr, wc, fr, fq);
        if (!has_next) break;
#pragma unroll
        for (int a = 0; a < 2; ++a)
#pragma unroll
            for (int b = 0; b < 2; ++b)
#pragma unroll
                for (int m = 0; m < 4; ++m)
#pragma unroll
                    for (int n = 0; n < 2; ++n) acc[a][b][m][n] = (f32x4){0.f, 0.f, 0.f, 0.f};
        cur = nxt; cA = nA; cB = nB; ++ui;
    }
    PG8_WAIT_V(0);
    if (wr == 0) PG8_BAR;
    PG8_BAR;
#undef PG8_SA
#undef PG8_SB
#undef PG8_STAGE
#undef PG8_LDA
#undef PG8_LDB
#undef PG8_MMA
#undef PG8_WAIT_V
#undef PG8_WAIT_L
#undef PG8_BAR
#undef PG8_SCHED
}
}

typedef f32x4 AccT[2][2][4][2];
#define EPI_LOOP_PERM(...) \
    const int row0 = u.pm * 256 + wr * 64 + fr, col0 = u.pn * 256 + wc * 32 + 8 * fq; \
    _Pragma("unroll") for (int ai = 0; ai < 2; ++ai) _Pragma("unroll") for (int m = 0; m < 4; ++m) { const int row = row0 + ai * 128 + m * 16; \
        _Pragma("unroll") for (int bj = 0; bj < 2; ++bj) { const int col = col0 + bj * 128; const f32x4 v0 = acc[ai][bj][m][0], v1 = acc[ai][bj][m][1]; __VA_ARGS__ } }
#define EPI_LOOP_NAT(...) \
    const int row0 = u.pm * 256 + wr * 64 + fr, col0 = u.pn * 256 + wc * 32 + 4 * fq; \
    _Pragma("unroll") for (int ai = 0; ai < 2; ++ai) _Pragma("unroll") for (int m = 0; m < 4; ++m) { const int row = row0 + ai * 128 + m * 16; \
        _Pragma("unroll") for (int bj = 0; bj < 2; ++bj) _Pragma("unroll") for (int n = 0; n < 2; ++n) { const int col = col0 + bj * 128 + n * 16; const f32x4 v = acc[ai][bj][m][n]; __VA_ARGS__ } }

struct EpiSwiglu { static constexpr bool PERM = true; bf16_t* O;
    DI void operator()(const AccT& acc, const pg8::Unit& u, int wr, int wc, int fr, int fq) const {
        EPI_LOOP_PERM({ u32x2 w; w.x = pack2(siluf_(v0[0]) * v1[0], siluf_(v0[1]) * v1[1]); w.y = pack2(siluf_(v0[2]) * v1[2], siluf_(v0[3]) * v1[3]);
            *(u32x2*)(O + (size_t)row * DFF + (col >> 1)) = w; })
    } };
struct EpiResid { static constexpr bool PERM = false; float* H; float scale;
    DI void operator()(const AccT& acc, const pg8::Unit& u, int wr, int wc, int fr, int fq) const {
        EPI_LOOP_NAT({ f32x4* p = (f32x4*)(H + (size_t)row * DM + col); *p = *p + v * scale; })
    } };
struct EpiProj { static constexpr bool PERM = true; bf16_t* O; bf16_t* XK; bf16_t* XV;
    DI void operator()(const AccT& acc, const pg8::Unit& u, int wr, int wc, int fr, int fq) const {
        const bool is_mg = u.pn * 256 >= C_MG, is_cmp = (u.pn == 10);
        EPI_LOOP_PERM({ f32x4 a = v0, b = v1;
            if (is_mg) { for (int j = 0; j < 4; ++j) { a[j] = sigmoidf_(a[j]); b[j] = sigmoidf_(b[j]); } }
            u32x4 w; w.x = pack2(a[0], a[1]); w.y = pack2(a[2], a[3]); w.z = pack2(b[0], b[1]); w.w = pack2(b[2], b[3]);
            *(u32x4*)(O + (size_t)row * PLD + col) = w;
            if (is_cmp) { const int c = col - C_KC, kv = c >> 7, gg = (c >> 6) & 1, d = c & 63, bb = row >> 11, s = row & 2047, jj = s >> 4, l = s & 15;
                bf16_t* X = kv ? XV : XK; *(u32x4*)(X + ((size_t)((bb * 128 + jj) * 2 + gg)) * 1024 + l * 64 + d) = w; } })
    } };
struct EpiMerge { static constexpr bool PERM = true; bf16_t* MRG; const bf16_t* PROJ; int J;
    DI void operator()(const AccT& acc, const pg8::Unit& u, int wr, int wc, int fr, int fq) const {
        EPI_LOOP_PERM({ const u32x4 gt = *(const u32x4*)(PROJ + (size_t)row * PLD + C_MG + J * 1024 + col);
            u32x4* mp = (u32x4*)(MRG + (size_t)row * DM + col); u32x4 old = (u32x4){0u, 0u, 0u, 0u}; if (J > 0) old = *mp;
            float r[8]; const float x[8] = {v0[0], v0[1], v0[2], v0[3], v1[0], v1[1], v1[2], v1[3]};
            _Pragma("unroll") for (int j = 0; j < 8; ++j) { const unsigned gw = gt[j >> 1], ow = old[j >> 1];
                const float gf = (j & 1) ? __uint_as_float(gw & 0xFFFF0000u) : __uint_as_float(gw << 16);
                const float of = (j & 1) ? __uint_as_float(ow & 0xFFFF0000u) : __uint_as_float(ow << 16);
                r[j] = of + gf * x[j]; }
            u32x4 w; w.x = pack2(r[0], r[1]); w.y = pack2(r[2], r[3]); w.z = pack2(r[4], r[5]); w.w = pack2(r[6], r[7]); *mp = w; })
    } };
struct EpiF32 { static constexpr bool PERM = false; float* C; int ldc;
    DI void operator()(const AccT& acc, const pg8::Unit& u, int wr, int wc, int fr, int fq) const {
        EPI_LOOP_NAT({ *(f32x4*)(C + (size_t)row * ldc + col) = v; })
    } };
struct EpiBf16 { static constexpr bool PERM = true; bf16_t* O; int ldc;
    DI void operator()(const AccT& acc, const pg8::Unit& u, int wr, int wc, int fr, int fq) const {
        EPI_LOOP_PERM({ u32x4 w; w.x = pack2(v0[0], v0[1]); w.y = pack2(v0[2], v0[3]); w.z = pack2(v1[0], v1[1]); w.w = pack2(v1[2], v1[3]);
            *(u32x4*)(O + (size_t)row * ldc + col) = w; })
    } };
struct EpiPleGate { static constexpr bool PERM = false; float* H; const bf16_t* TMP;
    DI void operator()(const AccT& acc, const pg8::Unit& u, int wr, int wc, int fr, int fq) const {
        EPI_LOOP_NAT({ const u32x2 tw = *(const u32x2*)(TMP + (size_t)row * DM + col); f32x4* p = (f32x4*)(H + (size_t)row * DM + col); f32x4 h = *p;
            h[0] += sigmoidf_(v[0]) * __uint_as_float(tw.x << 16); h[1] += sigmoidf_(v[1]) * __uint_as_float(tw.x & 0xFFFF0000u);
            h[2] += sigmoidf_(v[2]) * __uint_as_float(tw.y << 16); h[3] += sigmoidf_(v[3]) * __uint_as_float(tw.y & 0xFFFF0000u); *p = h; })
    } };

template <class Epi> DI void run_gemm(unsigned char* smem, const bf16_t* A, int lda, const bf16_t* Bt, int M, int N, int K, const Epi& E) {
    __syncthreads();
    pg8::Gemm g; g.A = A; g.Bt = Bt; g.M = M; g.N = N; g.K = K; g.lda = lda;
    pg8::StaticOrder S; S.init(M, N, (int)gridDim.x, bid_());
    pg8::gemm_phase<Epi>((LAS unsigned char*)smem, g, S, E);
    __syncthreads();
}

struct MapId { DI int operator()(int n) const { return n; } };
struct MapGU { DI int operator()(int n) const { const int q = n >> 3, e = n & 7; return e < 4 ? 4 * q + e : DFF + 4 * q + (e - 4); } };
struct MapIn { DI int operator()(int n) const { return n < IN_REAL ? n : (n < C_MG ? -1 : n - (C_MG - IN_REAL)); } };
template <class Map> __device__ __forceinline__ void transpose_cvt(unsigned char* smem, const float* src, int ldsrc, bf16_t* dst, int K, int Nd, Map map) {
    float* tile = (float*)smem;
    const int tid = tid_(), ntk = K / 64, nt = ntk * (Nd / 64);
    for (int t = bid_(); t < nt; t += gridDim.x) {
        const int n0 = (t / ntk) * 64, k0 = (t % ntk) * 64;
        const int nn = tid & 63, sc = map(n0 + nn);
#pragma unroll
        for (int p = 0; p < 8; ++p) { const int kk = (tid >> 6) + p * 8; tile[kk * 65 + nn] = sc >= 0 ? src[(size_t)(k0 + kk) * ldsrc + sc] : 0.f; }
        __syncthreads();
#pragma unroll
        for (int p = 0; p < 4; ++p) { const int nn2 = (tid >> 5) + p * 16, kk2 = (tid & 31) * 2;
            *(unsigned*)(dst + (size_t)(n0 + nn2) * K + k0 + kk2) = pack2(tile[kk2 * 65 + nn2], tile[(kk2 + 1) * 65 + nn2]); }
        __syncthreads();
    }
}
__device__ __forceinline__ void convert_layer_weights(unsigned char* smem, CP p, int L) {
    bf16_t* W = (bf16_t*)(p->ws + WS_WBF);
    transpose_cvt(smem, p->in[I_F1GU] + (size_t)L * DM * 2 * DFF, 2 * DFF, W + E_GU1, DM, 2 * DFF, MapGU());
    transpose_cvt(smem, p->in[I_F1D] + (size_t)L * DFF * DM, DM, W + E_D1, DFF, DM, MapId());
    transpose_cvt(smem, p->in[I_WIN] + (size_t)L * DM * IN_COLS, IN_COLS, W + E_IN, DM, PLD, MapIn());
    for (int j = 0; j < 3; ++j) transpose_cvt(smem, p->in[I_WBR] + ((size_t)L * 3 + j) * 512 * DM, DM, W + E_BR + (size_t)j * 1024 * 512, 512, DM, MapId());
    transpose_cvt(smem, p->in[I_WOUT] + (size_t)L * DM * DM, DM, W + E_OUT, DM, DM, MapId());
    transpose_cvt(smem, p->in[I_F2GU] + (size_t)L * DM * 2 * DFF, 2 * DFF, W + E_GU2, DM, 2 * DFF, MapGU());
    transpose_cvt(smem, p->in[I_F2D] + (size_t)L * DFF * DM, DM, W + E_D2, DFF, DM, MapId());
    transpose_cvt(smem, p->in[I_PLEG] + (size_t)L * DM * DM, DM, W + E_PG, DM, DM, MapId());
    transpose_cvt(smem, p->in[I_PLEW] + (size_t)L * 256 * DM, DM, W + E_PW, 256, DM, MapId());
    for (int kv = 0; kv < 2; ++kv) for (int hf = 0; hf < 2; ++hf)
        transpose_cvt(smem, p->in[I_CW1] + ((size_t)(L * 2 + kv) * 2048 + hf * 1024) * 128, 128, W + E_C1 + ((size_t)kv * 256 + hf * 128) * 1024, 1024, 128, MapId());
    if (bid_() == gridDim.x - 1 && tid_() < 256) {
        const int kv = tid_() >> 7, hc = tid_() & 127;
        const float* pe = p->in[I_PE] + (size_t)(L * 2 + kv) * 2048; const float* w1 = p->in[I_CW1] + (size_t)(L * 2 + kv) * 2048 * 128 + hc;
        float s = 0.f; for (int i = 0; i < 2048; ++i) s += pe[i] * w1[(size_t)i * 128];
        ((float*)(p->ws + WS_PEB))[kv * 128 + hc] = s;
    }
}

__device__ __forceinline__ void rmsnorm_rows(const float* hin, float* hcopy, const float* g, bf16_t* un, float* outf) {
    const int lane = tid_() & 63, gw = bid_() * 8 + (tid_() >> 6), nw = gridDim.x * 8;
    f32x4 gv[4];
#pragma unroll
    for (int i = 0; i < 4; ++i) gv[i] = *(const f32x4*)(g + lane * 4 + i * 256);
    for (int row = gw; row < T_TOK; row += nw) {
        f32x4 x[4]; float ss = 0.f;
#pragma unroll
        for (int i = 0; i < 4; ++i) { x[i] = *(const f32x4*)(hin + (size_t)row * DM + lane * 4 + i * 256); ss += x[i][0] * x[i][0] + x[i][1] * x[i][1] + x[i][2] * x[i][2] + x[i][3] * x[i][3]; }
        ss = wave_sum(ss);
        const float rs = rsqrtf(ss * (1.0f / DM) + 1e-6f);
#pragma unroll
        for (int i = 0; i < 4; ++i) {
            const f32x4 y = x[i] * rs * gv[i];
            if (hcopy) *(f32x4*)(hcopy + (size_t)row * DM + lane * 4 + i * 256) = x[i];
            if (un) { u32x2 w; w.x = pack2(y[0], y[1]); w.y = pack2(y[2], y[3]); *(u32x2*)(un + (size_t)row * DM + lane * 4 + i * 256) = w; }
            if (outf) *(f32x4*)(outf + (size_t)row * DM + lane * 4 + i * 256) = y;
        }
    }
}
__device__ __forceinline__ void cvt_f32_bf16(const float* src, bf16_t* dst, size_t n4) {
    for (size_t i = (size_t)bid_() * 512 + tid_(); i < n4; i += (size_t)gridDim.x * 512) {
        const f32x4 v = *(const f32x4*)(src + i * 4); u32x2 w; w.x = pack2(v[0], v[1]); w.y = pack2(v[2], v[3]); *(u32x2*)(dst + i * 4) = w; }
}

__device__ __forceinline__ void finalize_cmp(unsigned char* smem, CP p, int L) {
    float* hid = (float*)smem + (tid_() >> 6) * 128;
    const int lane = tid_() & 63, gw = bid_() * 8 + (tid_() >> 6), nw = gridDim.x * 8;
    const float* peb = (const float*)(p->ws + WS_PEB);
    const int total = 2 * 16 * 2 * 128, iters = (total + nw - 1) / nw;
    for (int it = 0; it < iters; ++it) {
        const int id = gw + it * nw; const bool ok = id < total;
        const int n = id & 127, gg = (id >> 7) & 1, bb = (id >> 8) & 15, kv = (id >> 12) & 1;
        if (ok && n < 127) {
            const float* Pm = (const float*)(p->ws + WS_P01) + (size_t)kv * 4096 * 256;
            const size_t r0 = (size_t)((bb * 128 + n) * 2 + gg) * 256, r1 = (size_t)((bb * 128 + n + 1) * 2 + gg) * 256;
#pragma unroll
            for (int q = 0; q < 2; ++q) { const int hc = lane + q * 64; hid[hc] = siluf_(Pm[r0 + hc] + Pm[r1 + 128 + hc] + peb[kv * 128 + hc]); }
        }
        __syncthreads();
        if (ok) {
            float o = 0.f;
            if (n < 127) { const float* w2 = p->in[I_CW2] + (size_t)(L * 2 + kv) * 128 * 64 + lane;
                for (int hc = 0; hc < 128; ++hc) o += hid[hc] * w2[hc * 64]; }
            ((float*)(p->ws + WS_KC))[((((size_t)kv * 16 + bb) * 2 + gg) * 128 + n) * 64 + lane] = o;
        }
        __syncthreads();
    }
}

__device__ __forceinline__ void hgrn_scan(unsigned char* smem, CP p, int L, int b, int h) {
    float* F = (float*)smem; float* Kx = F + 2048; float* Q = Kx + 2048; float* V = Q + 2048; float* PO = V + 2048;
    const int tid = tid_(), e = tid & 63, wv = tid >> 6, C = h * 64 + e;
    float lb;
    { const float* hl = p->in[I_HGLB]; const float a0 = hl[C], a1 = hl[512 + C], a2 = hl[1024 + C], a3 = hl[1536 + C];
      const float mx = fmaxf(fmaxf(a0, a1), fmaxf(a2, a3)); const float e0 = __expf(a0 - mx), e1 = __expf(a1 - mx), e2 = __expf(a2 - mx), e3 = __expf(a3 - mx);
      const float inv = 1.0f / (e0 + e1 + e2 + e3); float acc = 0.f; if (L >= 1) acc += e1; if (L >= 2) acc += e2; if (L >= 3) acc += e3; lb = fmaxf(acc * inv, 0.f); }
    const float ng = p->in[I_HGN][L * 512 + C];
    bf16_t* base = (bf16_t*)(p->ws + WS_PROJ) + (size_t)b * SEQ * PLD;
    f32x2 S0 = {0.f, 0.f}, S1 = {0.f, 0.f}, S2 = {0.f, 0.f}, S3 = {0.f, 0.f};
    for (int t0 = 0; t0 < SEQ; t0 += 32) {
#pragma unroll
        for (int i = 0; i < 4; ++i) { const int t = wv * 4 + i; const bf16_t* row = base + (size_t)(t0 + t) * PLD;
            const float z = bf2f(row[C_HF + C]), qr = bf2f(row[C_HQ + C]), vi = bf2f(row[C_HI + C]);
            const float sg = sigmoidf_(z); F[t * 64 + e] = sg + lb * (1.0f - sg); Kx[t * 64 + e] = (1.0f - lb) * (1.0f - sg); Q[t * 64 + e] = siluf_(qr); V[t * 64 + e] = vi; }
        __syncthreads();
#pragma unroll 4
        for (int t = 0; t < 32; ++t) {
            const f32x4 f0 = *(const f32x4*)(F + t * 64 + wv * 8), f1 = *(const f32x4*)(F + t * 64 + wv * 8 + 4);
            const f32x4 k0 = *(const f32x4*)(Kx + t * 64 + wv * 8), k1 = *(const f32x4*)(Kx + t * 64 + wv * 8 + 4);
            const f32x4 q0 = *(const f32x4*)(Q + t * 64 + wv * 8), q1 = *(const f32x4*)(Q + t * 64 + wv * 8 + 4);
            const float v = V[t * 64 + e]; const f32x2 vv = {v, v};
            S0 = (f32x2){f0[0], f0[1]} * S0 + (f32x2){k0[0], k0[1]} * vv; S1 = (f32x2){f0[2], f0[3]} * S1 + (f32x2){k0[2], k0[3]} * vv;
            S2 = (f32x2){f1[0], f1[1]} * S2 + (f32x2){k1[0], k1[1]} * vv; S3 = (f32x2){f1[2], f1[3]} * S3 + (f32x2){k1[2], k1[3]} * vv;
            f32x2 o2 = (f32x2){q0[0], q0[1]} * S0 + (f32x2){q0[2], q0[3]} * S1 + (f32x2){q1[0], q1[1]} * S2 + (f32x2){q1[2], q1[3]} * S3;
            PO[(t * 8 + wv) * 64 + e] = o2[0] + o2[1];
        }
        __syncthreads();
#pragma unroll
        for (int i = 0; i < 4; ++i) { const int t = wv * 4 + i; bf16_t* row = base + (size_t)(t0 + t) * PLD;
            float o = 0.f;
#pragma unroll
            for (int q = 0; q < 8; ++q) o += PO[(t * 8 + q) * 64 + e];
            const float ss = wave_sum(o * o); const float rs = rsqrtf(ss * (1.0f / 64.0f) + 1e-6f);
            const float gr = bf2f(row[C_HG + C]);
            row[C_HQ + C] = f2bf(o * rs * ng * siluf_(gr)); }
        __syncthreads();
    }
}

DI float dpp_xor1(float v) { return __int_as_float(__builtin_amdgcn_mov_dpp(__float_as_int(v), 0xB1, 0xF, 0xF, true)); }
DI float dpp_xor2(float v) { return __int_as_float(__builtin_amdgcn_mov_dpp(__float_as_int(v), 0x4E, 0xF, 0xF, true)); }
DI float dpp_hmir(float v) { return __int_as_float(__builtin_amdgcn_mov_dpp(__float_as_int(v), 0x141, 0xF, 0xF, true)); }
DI float red8(float v) { v += dpp_xor1(v); v += dpp_xor2(v); v += dpp_hmir(v); return v; }

__device__ __forceinline__ void rwkv_scan(unsigned char* smem, CP p, int L, int b, int h) {
    bf16_t* WL = (bf16_t*)smem;
    float* ACT = (float*)(smem + 32768);
    float* RS = (float*)(smem + 65536); float* KS = RS + 2048; float* VS = KS + 2048; float* DW = VS + 2048; float* AB = DW + 2048;
    float* GS = AB + 2048; float* NKK = GS + 2048; float* YS = NKK + 2048;
    const int tid = tid_(), c = tid & 63, wv = tid >> 6, C = h * 64 + c, lane = c;
    for (int i = tid; i < 256 * 64; i += 512) { const int j = i >> 6, cc = i & 63; float w;
        if (j < 64) w = p->in[I_WB][((size_t)L * 64 + j) * 512 + h * 64 + cc];
        else if (j < 128) w = p->in[I_AB][((size_t)L * 64 + (j - 64)) * 512 + h * 64 + cc];
        else w = p->in[I_GB][((size_t)L * 128 + (j - 128)) * 512 + h * 64 + cc];
        WL[i] = f2bf(w); }
    const float* mu = p->in[I_MU] + (size_t)L * 1792;
    const float mu_r = mu[C], mu_k = mu[512 + C], mu_v = mu[1024 + C];
    const int jl = tid & 255; const float mu_l = mu[1536 + jl];
    const float w0 = p->in[I_W0][L * 512 + C], a0 = p->in[I_A0][L * 512 + C], k_k = p->in[I_KK][L * 512 + C], k_a = p->in[I_KA][L * 512 + C],
                r_k = p->in[I_RK][L * 512 + C], ln_w = p->in[I_LNW][L * 512 + C], ln_b = p->in[I_LNB][L * 512 + C];
    const bf16_t* base = (const bf16_t*)(p->ws + WS_PROJ) + (size_t)b * SEQ * PLD + C_RW;
    bf16_t* obase = (bf16_t*)(p->ws + WS_ORW) + (size_t)b * SEQ * 512 + C;
    const int kp = lane & 7, vr = lane >> 3, vrow = wv * 8 + vr;
    f32x2 S0 = {0.f, 0.f}, S1 = {0.f, 0.f}, S2 = {0.f, 0.f}, S3 = {0.f, 0.f};
    __syncthreads();
    for (int t0 = 0; t0 < SEQ; t0 += 32) {
#pragma unroll
        for (int i = 0; i < 4; ++i) { const int t = wv * 4 + i, s = t0 + t; const bf16_t* row = base + (size_t)s * PLD;
            const float r1 = bf2f(row[C]), k1 = bf2f(row[512 + C]), v1 = bf2f(row[1024 + C]);
            float rp = 0.f, kq = 0.f, vp = 0.f; if (s > 0) { rp = bf2f(row[C - PLD]); kq = bf2f(row[512 + C - PLD]); vp = bf2f(row[1024 + C - PLD]); }
            RS[t * 64 + c] = r1 + (rp - r1) * mu_r; KS[t * 64 + c] = k1 + (kq - k1) * mu_k; VS[t * 64 + c] = v1 + (vp - v1) * mu_v; }
#pragma unroll 4
        for (int i = 0; i < 16; ++i) { const int t = (tid >> 8) * 16 + i, s = t0 + t; const bf16_t* row = base + (size_t)s * PLD + 1536 + jl;
            const float x1 = bf2f(row[0]); float xp = 0.f; if (s > 0) xp = bf2f(row[-PLD]);
            float xm = x1 + (xp - x1) * mu_l;
            if (jl < 64) xm = tanhf(xm); else if (jl >= 128) xm = sigmoidf_(xm);
            ACT[jl * 32 + t] = xm; }
        __syncthreads();
        f32x4 aw = {0.f, 0.f, 0.f, 0.f}, aa = aw, ag = aw;
#pragma unroll 8
        for (int j = 0; j < 64; ++j) aw += *(const f32x4*)(ACT + j * 32 + wv * 4) * bf2f(WL[j * 64 + c]);
#pragma unroll 8
        for (int j = 64; j < 128; ++j) aa += *(const f32x4*)(ACT + j * 32 + wv * 4) * bf2f(WL[j * 64 + c]);
#pragma unroll 8
        for (int j = 128; j < 256; ++j) ag += *(const f32x4*)(ACT + j * 32 + wv * 4) * bf2f(WL[j * 64 + c]);
        float bon[4];
#pragma unroll
        for (int i = 0; i < 4; ++i) { const int t = wv * 4 + i;
            const float wpre = w0 + aw[i]; const float nx = -wpre;
            const float sp = fmaxf(nx, 0.f) + log1pf(__expf(-fabsf(nx)));
            const float w = -sp - 0.5f; const float decay = __expf(-__expf(w));
            const float a = sigmoidf_(a0 + aa[i]);
            const float k = KS[t * 64 + c], r = RS[t * 64 + c];
            const float kkv = k * k_k; const float ssq = wave_sum(kkv * kkv); const float kkn = kkv / fmaxf(sqrtf(ssq), 1e-12f);
            const float kx = k * (1.0f + (a - 1.0f) * k_a);
            bon[i] = wave_sum(r * kx * r_k);
            DW[t * 64 + c] = decay; NKK[t * 64 + c] = -kkn; AB[t * 64 + c] = kkn * a; KS[t * 64 + c] = kx; GS[t * 64 + c] = ag[i]; }
        __syncthreads();
#pragma unroll 2
        for (int t = 0; t < 32; ++t) {
            const int o = t * 64 + kp * 8;
            const f32x4 w0v = *(const f32x4*)(DW + o), w1v = *(const f32x4*)(DW + o + 4), n0 = *(const f32x4*)(NKK + o), n1 = *(const f32x4*)(NKK + o + 4);
            const f32x4 b0 = *(const f32x4*)(AB + o), b1 = *(const f32x4*)(AB + o + 4), x0 = *(const f32x4*)(KS + o), x1 = *(const f32x4*)(KS + o + 4);
            const f32x4 r0 = *(const f32x4*)(RS + o), r1 = *(const f32x4*)(RS + o + 4);
            const float vv = VS[t * 64 + vrow];
            f32x2 sa2 = S0 * (f32x2){n0[0], n0[1]} + S1 * (f32x2){n0[2], n0[3]} + S2 * (f32x2){n1[0], n1[1]} + S3 * (f32x2){n1[2], n1[3]};
            const float sa = red8(sa2[0] + sa2[1]); const f32x2 sav = {sa, sa}, vv2 = {vv, vv};
            S0 = S0 * (f32x2){w0v[0], w0v[1]} + sav * (f32x2){b0[0], b0[1]} + vv2 * (f32x2){x0[0], x0[1]};
            S1 = S1 * (f32x2){w0v[2], w0v[3]} + sav * (f32x2){b0[2], b0[3]} + vv2 * (f32x2){x0[2], x0[3]};
            S2 = S2 * (f32x2){w1v[0], w1v[1]} + sav * (f32x2){b1[0], b1[1]} + vv2 * (f32x2){x1[0], x1[1]};
            S3 = S3 * (f32x2){w1v[2], w1v[3]} + sav * (f32x2){b1[2], b1[3]} + vv2 * (f32x2){x1[2], x1[3]};
            f32x2 y2 = S0 * (f32x2){r0[0], r0[1]} + S1 * (f32x2){r0[2], r0[3]} + S2 * (f32x2){r1[0], r1[1]} + S3 * (f32x2){r1[2], r1[3]};
            const float y = red8(y2[0] + y2[1]);
            if (kp == 0) YS[t * 64 + vrow] = y;
        }
        __syncthreads();
#pragma unroll
        for (int i = 0; i < 4; ++i) { const int t = wv * 4 + i;
            const float y = YS[t * 64 + c]; const float mean = wave_sum(y) * (1.0f / 64.0f); const float dlt = y - mean;
            const float var = wave_sum(dlt * dlt) * (1.0f / 64.0f);
            float yn = dlt * rsqrtf(var + 64e-5f) * ln_w + ln_b; yn += bon[i] * VS[t * 64 + c];
            obase[(size_t)(t0 + t) * 512] = f2bf(yn * GS[t * 64 + c]); }
        __syncthreads();
    }
}

#define MFMA32(a, b, c) __builtin_amdgcn_mfma_f32_32x32x16_bf16((a), (b), (c), 0, 0, 0)
constexpr int KTS = 72;
DI bf16x8 pack8(float a0, float a1, float a2, float a3, float a4, float a5, float a6, float a7) {
    u32x4 w; w.x = pack2(a0, a1); w.y = pack2(a2, a3); w.z = pack2(a4, a5); w.w = pack2(a6, a7); return __builtin_bit_cast(bf16x8, w); }
DI bf16x8 ld_vfrag(const bf16_t* vt, int off) { const u32x2 lo = *(const u32x2*)(vt + off), hi = *(const u32x2*)(vt + off + 8); u32x4 w; w.x = lo.x; w.y = lo.y; w.z = hi.x; w.w = hi.y; return __builtin_bit_cast(bf16x8, w); }

struct FlashState { f32x16 o0, o1; float m, l; };

DI void flash_update(FlashState& st, f32x16& sc0, f32x16& sc1, const bf16_t* VT, int vs, int qi, int hl) {
    float mt = -INFINITY;
#pragma unroll
    for (int i = 0; i < 16; ++i) mt = fmaxf(mt, fmaxf(sc0[i], sc1[i]));
    mt = fmaxf(mt, shfl_xor_(mt, 32, qi + 32 * hl));
    const float mnew = fmaxf(st.m, mt), muse = (mnew == -INFINITY) ? 0.f : mnew;
    const float alpha = __expf(st.m - muse);
    float ls = 0.f;
#pragma unroll
    for (int i = 0; i < 16; ++i) { sc0[i] = __expf(sc0[i] - muse); sc1[i] = __expf(sc1[i] - muse); ls += sc0[i] + sc1[i]; }
    st.l = st.l * alpha + ls; st.m = mnew;
    st.o0 *= alpha; st.o1 *= alpha;
#pragma unroll
    for (int s = 0; s < 2; ++s) {
        const bf16x8 p0 = pack8(sc0[8 * s], sc0[8 * s + 1], sc0[8 * s + 2], sc0[8 * s + 3], sc0[8 * s + 4], sc0[8 * s + 5], sc0[8 * s + 6], sc0[8 * s + 7]);
        const bf16x8 p1 = pack8(sc1[8 * s], sc1[8 * s + 1], sc1[8 * s + 2], sc1[8 * s + 3], sc1[8 * s + 4], sc1[8 * s + 5], sc1[8 * s + 6], sc1[8 * s + 7]);
        st.o0 = MFMA32(ld_vfrag(VT, qi * vs + 16 * s + 4 * hl), p0, st.o0);
        st.o1 = MFMA32(ld_vfrag(VT, (32 + qi) * vs + 16 * s + 4 * hl), p0, st.o1);
        st.o0 = MFMA32(ld_vfrag(VT, qi * vs + 32 + 16 * s + 4 * hl), p1, st.o0);
        st.o1 = MFMA32(ld_vfrag(VT, (32 + qi) * vs + 32 + 16 * s + 4 * hl), p1, st.o1);
    }
}
DI void qk_tile(const bf16_t* KT, const bf16x8 (&qf)[4], int qi, int hl, f32x16& sc0, f32x16& sc1) {
#pragma unroll
    for (int i = 0; i < 16; ++i) { sc0[i] = 0.f; sc1[i] = 0.f; }
#pragma unroll
    for (int s = 0; s < 4; ++s) {
        const bf16x8 k0 = *(const bf16x8*)(KT + qi * KTS + 16 * s + 8 * hl), k1 = *(const bf16x8*)(KT + (32 + qi) * KTS + 16 * s + 8 * hl);
        sc0 = MFMA32(k0, qf[s], sc0); sc1 = MFMA32(k1, qf[s], sc1);
    }
}
DI void load_kv_tile(bf16_t* KT, bf16_t* VT, const bf16_t* pb, int kcol, int vcol, int k0) {
    const int tid = tid_();
    { const int key = tid >> 3, ch = tid & 7, kpos = k0 + key; u32x4 w = {0u, 0u, 0u, 0u};
      if (kpos >= 0 && kpos < SEQ) w = *(const u32x4*)(pb + (size_t)kpos * PLD + kcol + ch * 8);
      *(u32x4*)(KT + key * KTS + ch * 8) = w; }
    { const int key = tid & 63, ch = tid >> 6, kpos = k0 + key; u32x4 w = {0u, 0u, 0u, 0u};
      if (kpos >= 0 && kpos < SEQ) w = *(const u32x4*)(pb + (size_t)kpos * PLD + vcol + ch * 8);
#pragma unroll
      for (int j = 0; j < 8; ++j) VT[(ch * 8 + j) * KTS + key] = (bf16_t)((j & 1) ? (w[j >> 1] >> 16) : (w[j >> 1] & 0xFFFFu)); }
}

__device__ __forceinline__ void nsa_item(unsigned char* smem, CP p, int L, int b, int g, int qb) {
    bf16_t* KT = (bf16_t*)smem;
    bf16_t* VT = (bf16_t*)(smem + 9216);
    float* LUT = (float*)(smem + 18432);
    unsigned* SELM = (unsigned*)(smem + 20736);
    unsigned* ORM = (unsigned*)(smem + 20992);
    float* PA = (float*)(smem + 21504);
    float* PBv = (float*)(smem + 54272);
    bf16_t* KT2 = (bf16_t*)(smem + 87040);
    bf16_t* VT2 = (bf16_t*)(smem + 105472);
    const int tid = tid_(), lane = tid & 63, wv = tid >> 6, hh = wv >> 1, qhalf = wv & 1, qi = lane & 31, hl = lane >> 5;
    const int ql = qhalf * 32 + qi, qpos = qb * 64 + ql, head = g * 4 + hh;
    bf16_t* pb = (bf16_t*)(p->ws + WS_PROJ) + (size_t)b * SEQ * PLD;
    bf16_t* qrow = pb + (size_t)qpos * PLD;
    __syncthreads();
    for (int i = tid; i < 4 * 129; i += 512) { const int h2 = i / 129, dd = i % 129; int bk;
        if (dd < 16) bk = dd; else if (dd >= 128) bk = 31; else { bk = 16 + (int)(logf((float)dd / 16.0f) / 2.0794415416798357f * 16.0f); bk = bk > 31 ? 31 : bk; }
        LUT[h2 * 132 + dd] = p->in[I_RELB][bk * 8 + g * 4 + h2]; }
    if (tid == 0) *ORM = 0u;
    if (tid < 256) PBv[tid * 32] = 0.f;
    { const float* kc = (const float*)(p->ws + WS_KC) + ((size_t)(0 * 16 + b) * 2 + g) * 128 * 64; const float* vc = (const float*)(p->ws + WS_KC) + ((size_t)(1 * 16 + b) * 2 + g) * 128 * 64;
      for (int i = tid; i < 128 * 64; i += 512) { const int n = i >> 6, d = i & 63; KT2[n * KTS + d] = f2bf(kc[i]); VT2[d * 136 + n] = f2bf(vc[i]); } }
    bf16x8 qf[4];
#pragma unroll
    for (int s = 0; s < 4; ++s) qf[s] = *(const bf16x8*)(qrow + C_NQ + head * 64 + 16 * s + 8 * hl);
    float g0, g1, g2;
    { const bf16_t* gp = qrow + C_NG + head * 3; g0 = sigmoidf_(bf2f(gp[0])); g1 = sigmoidf_(bf2f(gp[1])); g2 = sigmoidf_(bf2f(gp[2])); }
    __syncthreads();
    const float* lut = LUT + hh * 132;
    f32x16 fin0, fin1;
    {
        FlashState st;
#pragma unroll
        for (int i = 0; i < 16; ++i) { st.o0[i] = 0.f; st.o1[i] = 0.f; }
        st.m = -INFINITY; st.l = 0.f;
#pragma nounroll
        for (int t = 0; t < 2; ++t) {
            f32x16 sc0, sc1; qk_tile(KT2 + t * 64 * KTS, qf, qi, hl, sc0, sc1);
#pragma unroll
            for (int i = 0; i < 16; ++i) { const int kl = (i & 3) + 8 * (i >> 2) + 4 * hl;
                { const int n = 64 * t + kl, dist = qpos - (16 * n + 31); sc0[i] = (dist >= 0 && n < 127) ? sc0[i] * 0.125f + lut[dist > 128 ? 128 : dist] : -INFINITY; }
                { const int n = 64 * t + 32 + kl, dist = qpos - (16 * n + 31); sc1[i] = (dist >= 0 && n < 127) ? sc1[i] * 0.125f + lut[dist > 128 ? 128 : dist] : -INFINITY; } }
            flash_update(st, sc0, sc1, VT2 + 64 * t, 136, qi, hl);
        }
        const float lt = st.l + shfl_xor_(st.l, 32, lane); const float inv = 1.0f / fmaxf(lt, 1e-30f);
        const float muse = (st.m == -INFINITY) ? 0.f : st.m;
        fin0 = st.o0 * (g0 * inv); fin1 = st.o1 * (g0 * inv);
#pragma nounroll
        for (int t = 0; t < 2; ++t) {
            f32x16 sc0, sc1; qk_tile(KT2 + t * 64 * KTS, qf, qi, hl, sc0, sc1);
#pragma unroll
            for (int i = 0; i < 16; ++i) { const int kl = (i & 3) + 8 * (i >> 2) + 4 * hl;
                { const int n = 64 * t + kl, dist = qpos - (16 * n + 31); sc0[i] = (dist >= 0 && n < 127) ? __expf(sc0[i] * 0.125f + lut[dist > 128 ? 128 : dist] - muse) * inv : 0.f; }
                { const int n = 64 * t + 32 + kl, dist = qpos - (16 * n + 31); sc1[i] = (dist >= 0 && n < 127) ? __expf(sc1[i] * 0.125f + lut[dist > 128 ? 128 : dist] - muse) * inv : 0.f; } }
#pragma unroll
            for (int i4 = 0; i4 < 4; ++i4) {
                { const int m = 16 * t + 2 * i4 + hl; PA[(hh * 64 + ql) * 32 + m] = sc0[4 * i4] + sc0[4 * i4 + 1] + sc0[4 * i4 + 2] + sc0[4 * i4 + 3]; PBv[(hh * 64 + ql) * 32 + m + 1] = sc0[4 * i4 + 3]; }
                { const int m = 16 * t + 8 + 2 * i4 + hl; PA[(hh * 64 + ql) * 32 + m] = sc1[4 * i4] + sc1[4 * i4 + 1] + sc1[4 * i4 + 2] + sc1[4 * i4 + 3]; if (m + 1 < 32) PBv[(hh * 64 + ql) * 32 + m + 1] = sc1[4 * i4 + 3]; }
            }
        }
    }
    __syncthreads();
    if (tid < 64) {
        const int cur = qb; unsigned msk = 0u;
        for (int it = 0; it < 8; ++it) {
            float best = -INFINITY; int bi = -1;
            for (int m = 0; m < 32; ++m) {
                if ((msk >> m) & 1u) continue;
                float v;
                if (m == 0 || m == cur || m == cur - 1) v = INFINITY;
                else if (m <= cur) { v = 0.f; for (int h2 = 0; h2 < 4; ++h2) v += PA[(h2 * 64 + tid) * 32 + m] + PBv[(h2 * 64 + tid) * 32 + m]; }
                else v = -INFINITY;
                if (v > best) { best = v; bi = m; }
            }
            if (bi >= 0) msk |= 1u << bi;
        }
        SELM[tid] = msk; atomicOr(ORM, msk);
    }
    __syncthreads();
    const unsigned mysel = SELM[ql], orm = *ORM;
    {
        FlashState st;
#pragma unroll
        for (int i = 0; i < 16; ++i) { st.o0[i] = 0.f; st.o1[i] = 0.f; }
        st.m = -INFINITY; st.l = 0.f;
        for (int m = 0; m <= qb; ++m) {
            if (!((orm >> m) & 1u)) continue;
            __syncthreads();
            load_kv_tile(KT, VT, pb, C_KS + g * 64, C_VS + g * 64, m * 64);
            __syncthreads();
            f32x16 sc0, sc1; qk_tile(KT, qf, qi, hl, sc0, sc1);
            const bool sel = (mysel >> m) & 1u;
#pragma unroll
            for (int i = 0; i < 16; ++i) { const int kl = (i & 3) + 8 * (i >> 2) + 4 * hl;
                { const int dist = qpos - (m * 64 + kl); sc0[i] = (sel && dist >= 0) ? sc0[i] * 0.125f + lut[dist > 128 ? 128 : dist] : -INFINITY; }
                { const int dist = qpos - (m * 64 + 32 + kl); sc1[i] = (sel && dist >= 0) ? sc1[i] * 0.125f + lut[dist > 128 ? 128 : dist] : -INFINITY; } }
            flash_update(st, sc0, sc1, VT, KTS, qi, hl);
        }
        const float lt = st.l + shfl_xor_(st.l, 32, lane); const float sc = g1 / fmaxf(lt, 1e-30f);
        fin0 += st.o0 * sc; fin1 += st.o1 * sc;
    }
    {
        FlashState st;
#pragma unroll
        for (int i = 0; i < 16; ++i) { st.o0[i] = 0.f; st.o1[i] = 0.f; }
        st.m = -INFINITY; st.l = 0.f;
        for (int w = 0; w < 5; ++w) {
            const int k0 = qb * 64 - 256 + 64 * w;
            if (k0 + 63 < 0) continue;
            __syncthreads();
            load_kv_tile(KT, VT, pb, C_KW + g * 64, C_VW + g * 64, k0);
            __syncthreads();
            f32x16 sc0, sc1; qk_tile(KT, qf, qi, hl, sc0, sc1);
#pragma unroll
            for (int i = 0; i < 16; ++i) { const int kl = (i & 3) + 8 * (i >> 2) + 4 * hl;
                { const int kpos = k0 + kl, dist = qpos - kpos; sc0[i] = (dist >= 0 && dist < 256 && kpos >= 0) ? sc0[i] * 0.125f + lut[dist > 128 ? 128 : dist] : -INFINITY; }
                { const int kpos = k0 + 32 + kl, dist = qpos - kpos; sc1[i] = (dist >= 0 && dist < 256 && kpos >= 0) ? sc1[i] * 0.125f + lut[dist > 128 ? 128 : dist] : -INFINITY; } }
            flash_update(st, sc0, sc1, VT, KTS, qi, hl);
        }
        const float lt = st.l + shfl_xor_(st.l, 32, lane); const float sc = g2 / fmaxf(lt, 1e-30f);
        fin0 += st.o0 * sc; fin1 += st.o1 * sc;
    }
#pragma unroll
    for (int i4 = 0; i4 < 4; ++i4) {
        u32x2 w0; w0.x = pack2(fin0[4 * i4], fin0[4 * i4 + 1]); w0.y = pack2(fin0[4 * i4 + 2], fin0[4 * i4 + 3]);
        u32x2 w1; w1.x = pack2(fin1[4 * i4], fin1[4 * i4 + 1]); w1.y = pack2(fin1[4 * i4 + 2], fin1[4 * i4 + 3]);
        *(u32x2*)(qrow + C_NQ + head * 64 + 8 * i4 + 4 * hl) = w0;
        *(u32x2*)(qrow + C_NQ + head * 64 + 32 + 8 * i4 + 4 * hl) = w1;
    }
}

constexpr int PH_PER_LAYER = 16, PH_TOTAL = DEPTH * PH_PER_LAYER + 1;

__device__ __forceinline__ void run_phase(unsigned char* smem, CP p, int ph) {
#ifndef ONLY_SUB
#define ONLY_SUB -1
#endif
#ifndef PH_MASK
#define PH_MASK 0x1FFFF
#endif
#define ON(x) ((PH_MASK >> (x)) & 1)
    const bool fin = (ph == DEPTH * PH_PER_LAYER);
    const int L = fin ? 0 : ph / PH_PER_LAYER, sub = ONLY_SUB >= 0 ? ONLY_SUB : (fin ? 16 : ph % PH_PER_LAYER);
    unsigned char* ws = p->ws; float* H = p->out;
    bf16_t* W = (bf16_t*)(ws + WS_WBF); bf16_t* UN = (bf16_t*)(ws + WS_UN); bf16_t* PROJ = (bf16_t*)(ws + WS_PROJ); bf16_t* ACT = (bf16_t*)(ws + WS_ACT);
    bf16_t* TMP = (bf16_t*)(ws + WS_TMP); bf16_t* PBF = (bf16_t*)(ws + WS_PB); bf16_t* ORW = (bf16_t*)(ws + WS_ORW);
    bf16_t* XK = (bf16_t*)(ws + WS_XK); bf16_t* XV = (bf16_t*)(ws + WS_XV); float* P01 = (float*)(ws + WS_P01);
    if (ON(0) && sub == 0) convert_layer_weights(smem, p, L);
    if (ON(13) && sub == 13) cvt_f32_bf16(p->in[I_P] + (size_t)L * T_TOK * 256, PBF, (size_t)T_TOK * 256 / 4);
    if (ON(3) && (sub == 0 || sub == 3 || sub == 10 || sub == 13 || sub == 16)) {
        const float* hin = (sub == 0 && L == 0) ? p->in[I_X] : H; float* hcopy = (sub == 0 && L == 0) ? H : nullptr;
        const float* g = sub == 0 ? p->in[I_F1N] + L * DM : sub == 3 ? p->in[I_MIXN] + L * DM : sub == 10 ? p->in[I_F2N] + L * DM : sub == 13 ? p->in[I_PLEN] + L * DM : p->in[I_FINN];
        rmsnorm_rows(hin, hcopy, g, sub == 16 ? nullptr : UN, sub == 16 ? H : nullptr);
    } else if (ON(1) && (sub == 1 || sub == 11)) {
        EpiSwiglu e; e.O = ACT; run_gemm(smem, UN, DM, W + (sub == 1 ? E_GU1 : E_GU2), T_TOK, 2 * DFF, DM, e);
    } else if (ON(2) && (sub == 2 || sub == 12 || sub == 9)) {
        EpiResid e; e.H = H; e.scale = sub == 9 ? 1.0f : 0.5f;
        run_gemm(smem, sub == 9 ? UN : ACT, sub == 9 ? DM : DFF, W + (sub == 2 ? E_D1 : sub == 12 ? E_D2 : E_OUT), T_TOK, DM, sub == 9 ? DM : DFF, e);
    } else if (ON(4) && sub == 4) {
        EpiProj e; e.O = PROJ; e.XK = XK; e.XV = XV; run_gemm(smem, UN, DM, W + E_IN, T_TOK, PLD, DM, e);
    } else if (ON(5) && sub == 5) {
#pragma nounroll
        for (int kv = 0; kv < 2; ++kv) { EpiF32 e; e.C = P01 + (size_t)kv * 4096 * 256; e.ldc = 256;
            run_gemm(smem, kv ? XV : XK, 1024, W + E_C1 + (size_t)kv * 256 * 1024, 4096, 256, 1024, e); }
    } else if (ON(6) && sub == 6) {
        finalize_cmp(smem, p, L);
        for (int item = bid_(); item < 256; item += gridDim.x) {
            __syncthreads();
            if (item < 128) rwkv_scan(smem, p, L, item >> 3, item & 7); else hgrn_scan(smem, p, L, (item - 128) >> 3, (item - 128) & 7);
        }
    } else if (ON(7) && sub == 7) {
        for (int idx = bid_(), k = 0; idx < 1024; idx += gridDim.x, ++k) {
            const int bg = idx & 31, qq = idx >> 5; const int qb = (k & 1) ? ((qq & ~7) + 7 - (qq & 7)) : qq;
            nsa_item(smem, p, L, bg >> 1, bg & 1, qb);
        }
    } else if (ON(8) && sub == 8) {
#pragma nounroll
        for (int j = 0; j < 3; ++j) { EpiMerge e; e.MRG = UN; e.PROJ = PROJ; e.J = j;
            const bf16_t* A = j == 0 ? PROJ + C_HQ : (j == 1 ? PROJ + C_NQ : ORW);
            run_gemm(smem, A, j == 2 ? 512 : PLD, W + E_BR + (size_t)j * 1024 * 512, T_TOK, DM, 512, e); }
    } else if (ON(14) && sub == 14) {
        EpiBf16 e; e.O = TMP; e.ldc = DM; run_gemm(smem, PBF, 256, W + E_PW, T_TOK, DM, 256, e);
    } else if (ON(15) && sub == 15) {
        EpiPleGate e; e.H = H; e.TMP = TMP; run_gemm(smem, UN, DM, W + E_PG, T_TOK, DM, DM, e);
    }
}

__global__ void __launch_bounds__(512, 2) mega_fwd(Params p) {
    extern __shared__ __attribute__((aligned(16))) unsigned char smem[];
    cg::grid_group grid = cg::this_grid();
    for (int ph = p.ph_lo; ph < p.ph_hi; ++ph) {
        CP pp = (CP)__builtin_amdgcn_kernarg_segment_ptr(); asm volatile("" : "+s"(pp));
        run_phase(smem, pp, ph);
        if (ph + 1 < p.ph_hi) grid.sync();
    }
}

#ifndef MULTI_LAUNCH
#define MULTI_LAUNCH 0
#endif

extern "C" void kernel_launch(void* const* d_in, const int* in_sizes, int n_in, void* d_out, int out_size, void* d_ws, size_t ws_size, hipStream_t stream) {
    static int grid = 0;
    if (grid == 0) {
        if (n_in != N_INPUTS || out_size != T_TOK * DM || ws_size < WS_END) { fprintf(stderr, "kernel_launch: unexpected shapes: n_in %d out %d ws %zu (need %zu)\n", n_in, out_size, ws_size, (size_t)WS_END); grid = -1; return; }
        int dev = 0, cus = 0, per_cu = 0;
        (void)hipGetDevice(&dev); (void)hipDeviceGetAttribute(&cus, hipDeviceAttributeMultiprocessorCount, dev);
        if (hipFuncSetAttribute((const void*)mega_fwd, hipFuncAttributeMaxDynamicSharedMemorySize, LDS_BYTES) != hipSuccess) { fprintf(stderr, "kernel_launch: hipFuncSetAttribute failed\n"); grid = -1; return; }
        if (hipOccupancyMaxActiveBlocksPerMultiprocessor(&per_cu, (const void*)mega_fwd, 512, LDS_BYTES) != hipSuccess || per_cu < 1) { fprintf(stderr, "kernel_launch: occupancy query gives %d\n", per_cu); per_cu = 1; }
        (void)hipGetLastError();
        grid = cus * 1;
        if (grid > 256) grid = 256;
        fprintf(stderr, "kernel_launch: grid %d (cus %d, per_cu %d)\n", grid, cus, per_cu);
    }
    if (grid < 0) return;
    Params p{};
    for (int i = 0; i < N_INPUTS; ++i) p.in[i] = (const float*)d_in[i];
    p.out = (float*)d_out; p.ws = (unsigned char*)d_ws;
#if MULTI_LAUNCH
    for (int ph = 0; ph < PH_TOTAL; ++ph) { p.ph_lo = ph; p.ph_hi = ph + 1; hipLaunchKernelGGL(mega_fwd, dim3(grid), dim3(512), LDS_BYTES, stream, p); }
#else
    p.ph_lo = 0; p.ph_hi = PH_TOTAL;
    void* args[] = {&p};
    hipError_t e = hipLaunchCooperativeKernel((const void*)mega_fwd, dim3(grid), dim3(512), args, LDS_BYTES, stream);
    if (e != hipSuccess) fprintf(stderr, "kernel_launch: cooperative launch failed: %s\n", hipGetErrorString(e));
#endif
}
```

```cpp
#include <hip/hip_runtime.h>
#include <hip/hip_cooperative_groups.h>
#include <cstdio>
namespace cg = cooperative_groups;

#define LAS __attribute__((address_space(3)))
#define DI __device__ __forceinline__
typedef unsigned short bf16_t;
typedef short bf16x8 __attribute__((ext_vector_type(8)));
typedef float f32x4 __attribute__((ext_vector_type(4)));
typedef float f32x2 __attribute__((ext_vector_type(2)));
typedef float f32x16 __attribute__((ext_vector_type(16)));
typedef unsigned u32x4 __attribute__((ext_vector_type(4)));
typedef unsigned u32x2 __attribute__((ext_vector_type(2)));

constexpr int T_TOK = 32768, SEQ = 2048, NB = 16, DM = 1024, DFF = 2816, DEPTH = 4;
constexpr int PLD = 8448;
constexpr int C_HQ = 0, C_HF = 512, C_HI = 1024, C_HG = 1536, C_NQ = 2048, C_KC = 2560, C_VC = 2688, C_KS = 2816, C_VS = 2944,
              C_KW = 3072, C_VW = 3200, C_NG = 3328, C_RW = 3352, C_MG = 5376, IN_REAL = 5144, IN_COLS = 8216;
enum { I_X = 0, I_P, I_F1N, I_F1GU, I_F1D, I_MIXN, I_WIN, I_HGLB, I_HGN, I_PE, I_CW1, I_CW2, I_RELB, I_MU, I_W0, I_WB, I_A0, I_AB, I_GB,
       I_KK, I_KA, I_RK, I_LNW, I_LNB, I_WBR, I_WOUT, I_F2N, I_F2GU, I_F2D, I_PLEN, I_PLEG, I_PLEW, I_FINN, N_INPUTS };

constexpr size_t WS_PEB = 4096;
constexpr size_t WS_WBF = 8192;
constexpr size_t E_GU1 = 0, E_D1 = E_GU1 + 5632ull * 1024, E_IN = E_D1 + 1024ull * 2816, E_BR = E_IN + 8448ull * 1024, E_OUT = E_BR + 3ull * 1024 * 512,
                 E_GU2 = E_GU1, E_D2 = E_D1  , E_PG = E_OUT + 1024ull * 1024, E_PW = E_PG + 1024ull * 1024,
                 E_C1 = E_PW + 1024ull * 256, E_LORA = E_C1 + 2ull * 256 * 1024, E_END = E_LORA + 1536ull * 256;
constexpr size_t WS_UN = WS_WBF + E_END * 2;
constexpr size_t WS_ORW = WS_UN + (size_t)T_TOK * 1024 * 2;
constexpr size_t WS_XK = WS_ORW + (size_t)T_TOK * 512 * 2;
constexpr size_t WS_XV = WS_XK + 4096ull * 1024 * 2;
constexpr size_t WS_P01 = WS_XV + 4096ull * 1024 * 2;
constexpr size_t WS_KC = WS_P01 + 2ull * 4096 * 256 * 4;
constexpr size_t WS_LACT = WS_KC + 2ull * 16 * 2 * 128 * 64 * 4;
constexpr size_t WS_PROJ = WS_LACT + (size_t)T_TOK * 256 * 2;
constexpr size_t WS_END = WS_PROJ + (size_t)T_TOK * PLD * 2;
constexpr size_t WS_ACT = WS_PROJ;
constexpr size_t WS_PB = WS_PROJ + 200ull * 1024 * 1024;
constexpr size_t WS_TMP = WS_PROJ + 256ull * 1024 * 1024;
constexpr int LDS_BYTES = 144 * 1024;

struct Params {
    const float* in[N_INPUTS];
    float* out;
    unsigned char* ws;
    int ph_lo, ph_hi;
};
typedef const Params __attribute__((address_space(4)))* CP;

DI int tid_() { int t = threadIdx.x; asm volatile("" : "+v"(t)); return t; }
DI int bid_() { int b = blockIdx.x; asm volatile("" : "+s"(b)); return b; }
DI bf16_t f2bf(float f) { unsigned u = __float_as_uint(f); u += 0x7FFFu + ((u >> 16) & 1u); return (bf16_t)(u >> 16); }
DI float bf2f(bf16_t b) { return __uint_as_float(((unsigned)b) << 16); }
DI unsigned pack2(float lo, float hi) { return (unsigned)f2bf(lo) | ((unsigned)f2bf(hi) << 16); }
DI float sigmoidf_(float x) { return 1.0f / (1.0f + __expf(-x)); }
DI float siluf_(float x) { return x / (1.0f + __expf(-x)); }
DI float shfl_xor_(float v, int mask, int lane) { return __int_as_float(__builtin_amdgcn_ds_bpermute((lane ^ mask) << 2, __float_as_int(v))); }
DI float wave_sum(float v) {
    const int lane = tid_() & 63;
#pragma unroll
    for (int o = 32; o >= 1; o >>= 1) v += shfl_xor_(v, o, lane);
    return v;
}

namespace pg8 {
constexpr int BM = 256, BK = 64, HALF = 128, HTB = HALF * BK * 2, STAGE_BYTES = 8 * HTB, NXCD = 8, WGM = 8;
DI int lds_byte(int r, int c) { const int st = (r >> 4) * 2 + (c >> 5), rr = r & 15, cc = c & 31, ob = rr * 64 + cc * 2; return st * 1024 + (ob ^ (((ob >> 9) & 1) << 5)); }
DI void stage_rc(int b, int& R, int& C) { const int st = b / 1024, sb = b % 1024, swz = sb ^ (((sb >> 9) & 1) << 5); R = (st >> 1) * 16 + swz / 64; C = (st & 1) * 32 + (swz % 64) / 2; }
DI int perm32(int rho) { const int n = rho >> 4, i = rho & 15; return 8 * (i >> 2) + 4 * n + (i & 3); }
struct Unit { int pm, pn; };
struct Gemm { const bf16_t* A; const bf16_t* Bt; int M, N, K, lda; };
struct StaticOrder {
    int nM, nN, nwg, G, c;
    DI void init(int M, int N, int G_, int c_) { nM = M / BM; nN = N / BM; nwg = nM * nN; G = G_; c = c_; }
    DI bool next(int i, Unit& u) const {
        const long L = (long)i * G + c; if (L >= nwg) return false;
        int wgid = (int)L; { const int q = nwg / NXCD, r = nwg % NXCD, xcd = wgid % NXCD, off = wgid / NXCD; wgid = (xcd < r ? xcd * (q + 1) : r * (q + 1) + (xcd - r) * q) + off; }
        const int nig = WGM * nN, gid = wgid / nig, fm = gid * WGM, gsz = (nM - fm) < WGM ? (nM - fm) : WGM;
        u.pm = fm + ((wgid % nig) % gsz); u.pn = (wgid % nig) / gsz; return true;
    }
};

template <class Epi>
DI void gemm_phase(LAS unsigned char* lds, const Gemm g, const StaticOrder& S, const Epi& E) {
    int tid = tid_();
    const int wid = __builtin_amdgcn_readfirstlane(tid >> 6), lane = tid & 63, wr = wid >> 2, wc = wid & 3, fr = lane & 15, fq = lane >> 4;
    const int K = g.K, nt = K / BK, lda = g.lda;
    unsigned voffA[2], voffB[2];
#pragma unroll
    for (int i = 0; i < 2; ++i) { int R, C; stage_rc(tid * 16 + i * 8192, R, C); const int Rb = Epi::PERM ? ((R & ~31) + perm32(R & 31)) : R;
        voffA[i] = (unsigned)(R * lda + C) * 2u; voffB[i] = (unsigned)(Rb * K + C) * 2u; }
    const size_t kstep = (size_t)(BK * 2);
    const size_t hstepA = (size_t)HALF * lda * 2, hstepB = (size_t)HALF * K * 2;
    const size_t tstepA = 2 * hstepA, tstepB = 2 * hstepB;
    const unsigned ldsw = (unsigned)wid * 1024u;
    const int aoff = lds_byte(wr * 64 + fr, fq * 8), boff = lds_byte(wc * 32 + fr, fq * 8);
#define PG8_SA(b, h) (((b) * 2 + (h)) * HTB)
#define PG8_SB(b, h) ((4 + (b) * 2 + (h)) * HTB)
#define PG8_STAGE(bufoff, gbase, voff) do { _Pragma("unroll") for (int _i = 0; _i < 2; ++_i) \
        __builtin_amdgcn_global_load_lds((const unsigned*)((const char*)(gbase) + (voff)[_i]), (LAS unsigned*)(lds + (bufoff) + ldsw + _i * 8192), 16, 0, 0); } while (0)
#define PG8_LDA(dst, b, h) do { _Pragma("unroll") for (int m = 0; m < 4; ++m) _Pragma("unroll") for (int k = 0; k < 2; ++k) dst[m][k] = *(const LAS bf16x8*)(lds + PG8_SA(b, h) + aoff + m * 2048 + k * 1024); } while (0)
#define PG8_LDB(dst, b, h) do { _Pragma("unroll") for (int n = 0; n < 2; ++n) _Pragma("unroll") for (int k = 0; k < 2; ++k) dst[n][k] = *(const LAS bf16x8*)(lds + PG8_SB(b, h) + boff + n * 2048 + k * 1024); } while (0)
#define PG8_MMA(ai, bj, At, Bt) do { __builtin_amdgcn_s_setprio(1); _Pragma("unroll") for (int m = 0; m < 4; ++m) _Pragma("unroll") for (int n = 0; n < 2; ++n) _Pragma("unroll") for (int k = 0; k < 2; ++k) \
        acc[ai][bj][m][n] = __builtin_amdgcn_mfma_f32_16x16x32_bf16(Bt[n][k], At[m][k], acc[ai][bj][m][n], 0, 0, 0); __builtin_amdgcn_s_setprio(0); } while (0)
#define PG8_WAIT_V(n) asm volatile("s_waitcnt vmcnt(" #n ")" ::: "memory")
#define PG8_WAIT_L(n) asm volatile("s_waitcnt lgkmcnt(" #n ")" ::: "memory")
#define PG8_BAR __builtin_amdgcn_s_barrier()
#define PG8_SCHED __builtin_amdgcn_sched_barrier(0)
    Unit cur, nxt; int ui = 0;
    if (!S.next(0, cur)) return;
    f32x4 acc[2][2][4][2];
#pragma unroll
    for (int a = 0; a < 2; ++a)
#pragma unroll
        for (int b = 0; b < 2; ++b)
#pragma unroll
            for (int m = 0; m < 4; ++m)
#pragma unroll
                for (int n = 0; n < 2; ++n) acc[a][b][m][n] = (f32x4){0.f, 0.f, 0.f, 0.f};
    bf16x8 At[4][2], B0[2][2], B1[2][2];
    const char* cA = (const char*)g.A + (size_t)cur.pm * tstepA; const char* cB = (const char*)g.Bt + (size_t)cur.pn * tstepB;
    PG8_STAGE(PG8_SB(0, 0), cB, voffB); PG8_STAGE(PG8_SA(0, 0), cA, voffA); PG8_STAGE(PG8_SB(0, 1), cB + hstepB, voffB); PG8_STAGE(PG8_SA(0, 1), cA + hstepA, voffA);
    if (wr == 1) PG8_BAR;
    PG8_WAIT_V(4); PG8_BAR;
    PG8_STAGE(PG8_SB(1, 0), cB + kstep, voffB); PG8_STAGE(PG8_SA(1, 0), cA + kstep, voffA); PG8_STAGE(PG8_SB(1, 1), cB + hstepB + kstep, voffB);
    PG8_WAIT_V(6); PG8_BAR;
    for (;;) {
        const bool has_next = S.next(ui + 1, nxt);
        const char* nA = has_next ? (const char*)g.A + (size_t)nxt.pm * tstepA : cA; const char* nB = has_next ? (const char*)g.Bt + (size_t)nxt.pn * tstepB : cB;
        for (int t = 0; t < nt; t += 2) {
            const bool last = (t == nt - 2);
            const char* a1 = cA + (size_t)(t + 1) * kstep;
            const char* a2 = last ? nA : cA + (size_t)(t + 2) * kstep; const char* b2 = last ? nB : cB + (size_t)(t + 2) * kstep;
            const char* a3 = a2 + kstep; const char* b3 = b2 + kstep;
            PG8_LDB(B0, 0, 0); PG8_SCHED; PG8_LDA(At, 0, 0); PG8_STAGE(PG8_SA(1, 1), a1 + hstepA, voffA);
            PG8_WAIT_L(8); PG8_BAR; PG8_WAIT_L(0); PG8_MMA(0, 0, At, B0); PG8_BAR; PG8_SCHED;
            PG8_LDB(B1, 0, 1); PG8_STAGE(PG8_SB(0, 0), b2, voffB);
            PG8_BAR; PG8_WAIT_L(0); PG8_MMA(0, 1, At, B1); PG8_BAR;
            PG8_LDA(At, 0, 1); PG8_STAGE(PG8_SA(0, 0), a2, voffA);
            PG8_BAR; PG8_WAIT_L(0); PG8_MMA(1, 0, At, B0); PG8_BAR; PG8_SCHED;
            PG8_STAGE(PG8_SB(0, 1), b2 + hstepB, voffB);
            PG8_WAIT_V(6); PG8_BAR; PG8_MMA(1, 1, At, B1); PG8_BAR;
            PG8_LDB(B0, 1, 0); PG8_SCHED; PG8_LDA(At, 1, 0); PG8_STAGE(PG8_SA(0, 1), a2 + hstepA, voffA);
            PG8_WAIT_L(8); PG8_BAR; PG8_WAIT_L(0); PG8_MMA(0, 0, At, B0); PG8_BAR; PG8_SCHED;
            PG8_LDB(B1, 1, 1); PG8_STAGE(PG8_SB(1, 0), b3, voffB);
            PG8_BAR; PG8_WAIT_L(0); PG8_MMA(0, 1, At, B1); PG8_BAR;
            PG8_LDA(At, 1, 1); PG8_STAGE(PG8_SA(1, 0), a3, voffA);
            PG8_BAR; PG8_WAIT_L(0); PG8_MMA(1, 0, At, B0); PG8_BAR; PG8_SCHED;
            PG8_STAGE(PG8_SB(1, 1), b3 + hstepB, voffB);
            PG8_WAIT_V(6); PG8_BAR; PG8_MMA(1, 1, At, B1); PG8_BAR;
        }
        E(acc, cur, wr, wc, fr, fq);
        if (!has_next) break;
#pragma unroll
        for (int a = 0; a < 2; ++a)
#pragma unroll
            for (int b = 0; b < 2; ++b)
#pragma unroll
                for (int m = 0; m < 4; ++m)
#pragma unroll
                    for (int n = 0; n < 2; ++n) acc[a][b][m][n] = (f32x4){0.f, 0.f, 0.f, 0.f};
        cur = nxt; cA = nA; cB = nB; ++ui;
    }
    PG8_WAIT_V(0);
    if (wr == 0) PG8_BAR;
    PG8_BAR;
#undef PG8_SA
#undef PG8_SB
#undef PG8_STAGE
#undef PG8_LDA
#undef PG8_LDB
#undef PG8_MMA
#undef PG8_WAIT_V
#undef PG8_WAIT_L
#undef PG8_BAR
#undef PG8_SCHED
}
}

typedef f32x4 AccT[2][2][4][2];
#define EPI_LANE const int t_ = tid_(), wid_ = t_ >> 6, ln_ = t_ & 63, wr_ = wid_ >> 2, wc_ = wid_ & 3, fr_ = ln_ & 15, fq_ = ln_ >> 4;
#define EPI_LOOP_PERM(...) EPI_LANE \
    const int row0 = u.pm * 256 + wr_ * 64 + fr_, col0 = u.pn * 256 + wc_ * 32 + 8 * fq_; \
    _Pragma("unroll") for (int ai = 0; ai < 2; ++ai) _Pragma("unroll") for (int m = 0; m < 4; ++m) { const int row = row0 + ai * 128 + m * 16; \
        _Pragma("unroll") for (int bj = 0; bj < 2; ++bj) { const int col = col0 + bj * 128; const f32x4 v0 = acc[ai][bj][m][0], v1 = acc[ai][bj][m][1]; __VA_ARGS__ } }
#define EPI_LOOP_NAT(...) EPI_LANE \
    const int row0 = u.pm * 256 + wr_ * 64 + fr_, col0 = u.pn * 256 + wc_ * 32 + 4 * fq_; \
    _Pragma("unroll") for (int ai = 0; ai < 2; ++ai) _Pragma("unroll") for (int m = 0; m < 4; ++m) { const int row = row0 + ai * 128 + m * 16; \
        _Pragma("unroll") for (int bj = 0; bj < 2; ++bj) _Pragma("unroll") for (int n = 0; n < 2; ++n) { const int col = col0 + bj * 128 + n * 16; const f32x4 v = acc[ai][bj][m][n]; __VA_ARGS__ } }

struct EpiSwiglu { static constexpr bool PERM = true; bf16_t* O;
    DI void operator()(const AccT& acc, const pg8::Unit& u, int wr, int wc, int fr, int fq) const {
        EPI_LOOP_PERM({ u32x2 w; w.x = pack2(siluf_(v0[0]) * v1[0], siluf_(v0[1]) * v1[1]); w.y = pack2(siluf_(v0[2]) * v1[2], siluf_(v0[3]) * v1[3]);
            *(u32x2*)(O + (size_t)row * DFF + (col >> 1)) = w; })
    } };
struct EpiResid { static constexpr bool PERM = false; float* H; float scale;
    DI void operator()(const AccT& acc, const pg8::Unit& u, int wr, int wc, int fr, int fq) const {
        EPI_LOOP_NAT({ f32x4* p = (f32x4*)(H + (size_t)row * DM + col); *p = *p + v * scale; })
    } };
struct EpiProj { static constexpr bool PERM = true; bf16_t* O; bf16_t* XK; bf16_t* XV;
    DI void operator()(const AccT& acc, const pg8::Unit& u, int wr, int wc, int fr, int fq) const {
        const bool is_mg = u.pn * 256 >= C_MG, is_cmp = (u.pn == 10);
        EPI_LOOP_PERM({ f32x4 a = v0, b = v1;
            if (is_mg) { for (int j = 0; j < 4; ++j) { a[j] = sigmoidf_(a[j]); b[j] = sigmoidf_(b[j]); } }
            u32x4 w; w.x = pack2(a[0], a[1]); w.y = pack2(a[2], a[3]); w.z = pack2(b[0], b[1]); w.w = pack2(b[2], b[3]);
            *(u32x4*)(O + (size_t)row * PLD + col) = w;
            if (is_cmp) { const int c = col - C_KC, kv = c >> 7, gg = (c >> 6) & 1, d = c & 63, bb = row >> 11, s = row & 2047, jj = s >> 4, l = s & 15;
                bf16_t* X = kv ? XV : XK; *(u32x4*)(X + ((size_t)((bb * 128 + jj) * 2 + gg)) * 1024 + l * 64 + d) = w; } })
    } };
struct EpiMerge { static constexpr bool PERM = true; bf16_t* MRG; const bf16_t* PROJ; int J;
    DI void operator()(const AccT& acc, const pg8::Unit& u, int wr, int wc, int fr, int fq) const {
        EPI_LOOP_PERM({ const u32x4 gt = *(const u32x4*)(PROJ + (size_t)row * PLD + C_MG + J * 1024 + col);
            u32x4* mp = (u32x4*)(MRG + (size_t)row * DM + col); u32x4 old = (u32x4){0u, 0u, 0u, 0u}; if (J > 0) old = *mp;
            float r[8]; const float x[8] = {v0[0], v0[1], v0[2], v0[3], v1[0], v1[1], v1[2], v1[3]};
            _Pragma("unroll") for (int j = 0; j < 8; ++j) { const unsigned gw = gt[j >> 1], ow = old[j >> 1];
                const float gf = (j & 1) ? __uint_as_float(gw & 0xFFFF0000u) : __uint_as_float(gw << 16);
                const float of = (j & 1) ? __uint_as_float(ow & 0xFFFF0000u) : __uint_as_float(ow << 16);
                r[j] = of + gf * x[j]; }
            u32x4 w; w.x = pack2(r[0], r[1]); w.y = pack2(r[2], r[3]); w.z = pack2(r[4], r[5]); w.w = pack2(r[6], r[7]); *mp = w; })
    } };
struct EpiF32 { static constexpr bool PERM = false; float* C; static constexpr int ldc = 256;
    DI void operator()(const AccT& acc, const pg8::Unit& u, int wr, int wc, int fr, int fq) const {
        EPI_LOOP_NAT({ *(f32x4*)(C + (size_t)row * ldc + col) = v; })
    } };
struct EpiBf16 { static constexpr bool PERM = true; bf16_t* O; static constexpr int ldc = DM;
    DI void operator()(const AccT& acc, const pg8::Unit& u, int wr, int wc, int fr, int fq) const {
        EPI_LOOP_PERM({ u32x4 w; w.x = pack2(v0[0], v0[1]); w.y = pack2(v0[2], v0[3]); w.z = pack2(v1[0], v1[1]); w.w = pack2(v1[2], v1[3]);
            *(u32x4*)(O + (size_t)row * ldc + col) = w; })
    } };
struct EpiPleGate { static constexpr bool PERM = false; float* H; const bf16_t* TMP;
    DI void operator()(const AccT& acc, const pg8::Unit& u, int wr, int wc, int fr, int fq) const {
        EPI_LOOP_NAT({ const u32x2 tw = *(const u32x2*)(TMP + (size_t)row * DM + col); f32x4* p = (f32x4*)(H + (size_t)row * DM + col); f32x4 h = *p;
            h[0] += sigmoidf_(v[0]) * __uint_as_float(tw.x << 16); h[1] += sigmoidf_(v[1]) * __uint_as_float(tw.x & 0xFFFF0000u);
            h[2] += sigmoidf_(v[2]) * __uint_as_float(tw.y << 16); h[3] += sigmoidf_(v[3]) * __uint_as_float(tw.y & 0xFFFF0000u); *p = h; })
    } };

struct EpiLora { static constexpr bool PERM = true; bf16_t* EWA; bf16_t* G;
    DI void operator()(const AccT& acc, const pg8::Unit& u, int wr, int wc, int fr, int fq) const {
        const bool isg = u.pn >= 4; bf16_t* O = isg ? G - 1024 : EWA; const int ld = isg ? 512 : 1024;
        EPI_LOOP_PERM({ u32x4 w; w.x = pack2(v0[0], v0[1]); w.y = pack2(v0[2], v0[3]); w.z = pack2(v1[0], v1[1]); w.w = pack2(v1[2], v1[3]);
            *(u32x4*)(O + (size_t)row * ld + col) = w; })
    } };

template <class Epi> DI void run_gemm(unsigned char* smem, const bf16_t* A, int lda, const bf16_t* Bt, int M, int N, int K, const Epi& E) {
    __syncthreads();
    pg8::Gemm g; g.A = A; g.Bt = Bt; g.M = M; g.N = N; g.K = K; g.lda = lda;
    pg8::StaticOrder S; S.init(M, N, (int)gridDim.x, bid_());
    pg8::gemm_phase<Epi>((LAS unsigned char*)smem, g, S, E);
    __syncthreads();
}

struct MapId { DI int operator()(int n) const { return n; } };
struct MapGU { DI int operator()(int n) const { const int q = n >> 3, e = n & 7; return e < 4 ? 4 * q + e : DFF + 4 * q + (e - 4); } };
struct MapIn { DI int operator()(int n) const { return n < IN_REAL ? n : (n < C_MG ? -1 : n - (C_MG - IN_REAL)); } };
template <class Map> __device__ __forceinline__ void transpose_cvt(unsigned char* smem, const float* src, int ldsrc, bf16_t* dst, int K, int Nd, Map map) {
    float* tile = (float*)smem;
    const int tid = tid_(), ntk = K / 64, nt = ntk * (Nd / 64);
    for (int t = bid_(); t < nt; t += gridDim.x) {
        const int n0 = (t / ntk) * 64, k0 = (t % ntk) * 64;
        const int nn = tid & 63, sc = map(n0 + nn);
#pragma unroll
        for (int p = 0; p < 8; ++p) { const int kk = (tid >> 6) + p * 8; tile[kk * 65 + nn] = sc >= 0 ? src[(size_t)(k0 + kk) * ldsrc + sc] : 0.f; }
        __syncthreads();
#pragma unroll
        for (int p = 0; p < 4; ++p) { const int nn2 = (tid >> 5) + p * 16, kk2 = (tid & 31) * 2;
            *(unsigned*)(dst + (size_t)(n0 + nn2) * K + k0 + kk2) = pack2(tile[kk2 * 65 + nn2], tile[(kk2 + 1) * 65 + nn2]); }
        __syncthreads();
    }
}
__device__ __forceinline__ void convert_layer_weights(unsigned char* smem, CP p, int L) {
    bf16_t* W = (bf16_t*)(p->ws + WS_WBF);
    transpose_cvt(smem, p->in[I_F1GU] + (size_t)L * DM * 2 * DFF, 2 * DFF, W + E_GU1, DM, 2 * DFF, MapGU());
    transpose_cvt(smem, p->in[I_F1D] + (size_t)L * DFF * DM, DM, W + E_D1, DFF, DM, MapId());
    transpose_cvt(smem, p->in[I_WIN] + (size_t)L * DM * IN_COLS, IN_COLS, W + E_IN, DM, PLD, MapIn());
    for (int j = 0; j < 3; ++j) transpose_cvt(smem, p->in[I_WBR] + ((size_t)L * 3 + j) * 512 * DM, DM, W + E_BR + (size_t)j * 1024 * 512, 512, DM, MapId());
    transpose_cvt(smem, p->in[I_WOUT] + (size_t)L * DM * DM, DM, W + E_OUT, DM, DM, MapId());
    for (int i = bid_() * 512 + tid_(); i < 1536 * 256; i += gridDim.x * 512) { const int n = i >> 8, k = i & 255; float w = 0.f;
        if (n < 512) { if (k < 64) w = p->in[I_WB][((size_t)L * 64 + k) * 512 + n]; }
        else if (n < 1024) { if (k >= 64 && k < 128) w = p->in[I_AB][((size_t)L * 64 + (k - 64)) * 512 + (n - 512)]; }
        else { if (k >= 128) w = p->in[I_GB][((size_t)L * 128 + (k - 128)) * 512 + (n - 1024)]; }
        W[E_LORA + i] = f2bf(w); }
    transpose_cvt(smem, p->in[I_PLEG] + (size_t)L * DM * DM, DM, W + E_PG, DM, DM, MapId());
    transpose_cvt(smem, p->in[I_PLEW] + (size_t)L * 256 * DM, DM, W + E_PW, 256, DM, MapId());
    for (int kv = 0; kv < 2; ++kv) for (int hf = 0; hf < 2; ++hf)
        transpose_cvt(smem, p->in[I_CW1] + ((size_t)(L * 2 + kv) * 2048 + hf * 1024) * 128, 128, W + E_C1 + ((size_t)kv * 256 + hf * 128) * 1024, 1024, 128, MapId());
    if (bid_() == gridDim.x - 1 && tid_() < 256) {
        const int kv = tid_() >> 7, hc = tid_() & 127;
        const float* pe = p->in[I_PE] + (size_t)(L * 2 + kv) * 2048; const float* w1 = p->in[I_CW1] + (size_t)(L * 2 + kv) * 2048 * 128 + hc;
        float s = 0.f; for (int i = 0; i < 2048; ++i) s += pe[i] * w1[(size_t)i * 128];
        ((float*)(p->ws + WS_PEB))[kv * 128 + hc] = s;
    }
}

__device__ __forceinline__ void convert_ffn2_weights(unsigned char* smem, CP p, int L) {
    bf16_t* W = (bf16_t*)(p->ws + WS_WBF);
    transpose_cvt(smem, p->in[I_F2GU] + (size_t)L * DM * 2 * DFF, 2 * DFF, W + E_GU2, DM, 2 * DFF, MapGU());
    transpose_cvt(smem, p->in[I_F2D] + (size_t)L * DFF * DM, DM, W + E_D2, DFF, DM, MapId());
}
__device__ __forceinline__ void lora_act(CP p, int L) {
    const bf16_t* PROJ = (const bf16_t*)(p->ws + WS_PROJ); bf16_t* LACT = (bf16_t*)(p->ws + WS_LACT);
    const float* mu = p->in[I_MU] + (size_t)L * 1792 + 1536;
    for (int i = bid_() * 512 + tid_(); i < T_TOK * 32; i += gridDim.x * 512) {
        const int t = i >> 5, j0 = (i & 31) * 8; const bf16_t* row = PROJ + (size_t)t * PLD + C_RW + 1536 + j0;
        const u32x4 cur = *(const u32x4*)row; u32x4 prv = {0u, 0u, 0u, 0u}; if ((t & (SEQ - 1)) != 0) prv = *(const u32x4*)(row - PLD);
        float r[8];
#pragma unroll
        for (int e = 0; e < 8; ++e) { const float x1 = (e & 1) ? __uint_as_float(cur[e >> 1] & 0xFFFF0000u) : __uint_as_float(cur[e >> 1] << 16);
            const float xp = (e & 1) ? __uint_as_float(prv[e >> 1] & 0xFFFF0000u) : __uint_as_float(prv[e >> 1] << 16);
            float xm = x1 + (xp - x1) * mu[j0 + e];
            if (j0 < 64) xm = tanhf(xm); else if (j0 >= 128) xm = sigmoidf_(xm);
            r[e] = xm; }
        u32x4 w; w.x = pack2(r[0], r[1]); w.y = pack2(r[2], r[3]); w.z = pack2(r[4], r[5]); w.w = pack2(r[6], r[7]);
        *(u32x4*)(LACT + (size_t)t * 256 + j0) = w;
    }
}

__device__ __forceinline__ void rmsnorm_rows(const float* hin, float* hcopy, const float* g, bf16_t* un, float* outf) {
    const int lane = tid_() & 63, gw = bid_() * 8 + (tid_() >> 6), nw = gridDim.x * 8;
    f32x4 gv[4];
#pragma unroll
    for (int i = 0; i < 4; ++i) gv[i] = *(const f32x4*)(g + lane * 4 + i * 256);
    for (int row = gw; row < T_TOK; row += nw) {
        f32x4 x[4]; float ss = 0.f;
#pragma unroll
        for (int i = 0; i < 4; ++i) { x[i] = *(const f32x4*)(hin + (size_t)row * DM + lane * 4 + i * 256); ss += x[i][0] * x[i][0] + x[i][1] * x[i][1] + x[i][2] * x[i][2] + x[i][3] * x[i][3]; }
        ss = wave_sum(ss);
        const float rs = rsqrtf(ss * (1.0f / DM) + 1e-6f);
#pragma unroll
        for (int i = 0; i < 4; ++i) {
            const f32x4 y = x[i] * rs * gv[i];
            if (hcopy) *(f32x4*)(hcopy + (size_t)row * DM + lane * 4 + i * 256) = x[i];
            if (un) { u32x2 w; w.x = pack2(y[0], y[1]); w.y = pack2(y[2], y[3]); *(u32x2*)(un + (size_t)row * DM + lane * 4 + i * 256) = w; }
            if (outf) *(f32x4*)(outf + (size_t)row * DM + lane * 4 + i * 256) = y;
        }
    }
}
__device__ __forceinline__ void cvt_f32_bf16(const float* src, bf16_t* dst, size_t n4) {
    for (size_t i = (size_t)bid_() * 512 + tid_(); i < n4; i += (size_t)gridDim.x * 512) {
        const f32x4 v = *(const f32x4*)(src + i * 4); u32x2 w; w.x = pack2(v[0], v[1]); w.y = pack2(v[2], v[3]); *(u32x2*)(dst + i * 4) = w; }
}

__device__ __forceinline__ void finalize_cmp(unsigned char* smem, CP p, int L) {
    float* hid = (float*)smem + (tid_() >> 6) * 128;
    const int lane = tid_() & 63, gw = bid_() * 8 + (tid_() >> 6), nw = gridDim.x * 8;
    const float* peb = (const float*)(p->ws + WS_PEB);
    const int total = 2 * 16 * 2 * 128, iters = (total + nw - 1) / nw;
    for (int it = 0; it < iters; ++it) {
        const int id = gw + it * nw; const bool ok = id < total;
        const int n = id & 127, gg = (id >> 7) & 1, bb = (id >> 8) & 15, kv = (id >> 12) & 1;
        if (ok && n < 127) {
            const float* Pm = (const float*)(p->ws + WS_P01) + (size_t)kv * 4096 * 256;
            const size_t r0 = (size_t)((bb * 128 + n) * 2 + gg) * 256, r1 = (size_t)((bb * 128 + n + 1) * 2 + gg) * 256;
#pragma unroll
            for (int q = 0; q < 2; ++q) { const int hc = lane + q * 64; hid[hc] = siluf_(Pm[r0 + hc] + Pm[r1 + 128 + hc] + peb[kv * 128 + hc]); }
        }
        __syncthreads();
        if (ok) {
            float o = 0.f;
            if (n < 127) { const float* w2 = p->in[I_CW2] + (size_t)(L * 2 + kv) * 128 * 64 + lane;
                for (int hc = 0; hc < 128; ++hc) o += hid[hc] * w2[hc * 64]; }
            ((float*)(p->ws + WS_KC))[((((size_t)kv * 16 + bb) * 2 + gg) * 128 + n) * 64 + lane] = o;
        }
        __syncthreads();
    }
}

__device__ __forceinline__ void hgrn_scan(unsigned char* smem, CP p, int L, int b, int h) {
    float* F = (float*)smem; float* Kx = F + 2048; float* Q = Kx + 2048; float* V = Q + 2048; float* PO = V + 2048;
    const int tid = tid_(), e = tid & 63, wv = tid >> 6, C = h * 64 + e;
    float lb;
    { const float* hl = p->in[I_HGLB]; const float a0 = hl[C], a1 = hl[512 + C], a2 = hl[1024 + C], a3 = hl[1536 + C];
      const float mx = fmaxf(fmaxf(a0, a1), fmaxf(a2, a3)); const float e0 = __expf(a0 - mx), e1 = __expf(a1 - mx), e2 = __expf(a2 - mx), e3 = __expf(a3 - mx);
      const float inv = 1.0f / (e0 + e1 + e2 + e3); float acc = 0.f; if (L >= 1) acc += e1; if (L >= 2) acc += e2; if (L >= 3) acc += e3; lb = fmaxf(acc * inv, 0.f); }
    const float ng = p->in[I_HGN][L * 512 + C];
    bf16_t* base = (bf16_t*)(p->ws + WS_PROJ) + (size_t)b * SEQ * PLD;
    f32x2 S0 = {0.f, 0.f}, S1 = {0.f, 0.f}, S2 = {0.f, 0.f}, S3 = {0.f, 0.f};
    for (int t0 = 0; t0 < SEQ; t0 += 32) {
#pragma unroll
        for (int i = 0; i < 4; ++i) { const int t = wv * 4 + i; const bf16_t* row = base + (size_t)(t0 + t) * PLD;
            const float z = bf2f(row[C_HF + C]), qr = bf2f(row[C_HQ + C]), vi = bf2f(row[C_HI + C]);
            const float sg = sigmoidf_(z); F[t * 64 + e] = sg + lb * (1.0f - sg); Kx[t * 64 + e] = (1.0f - lb) * (1.0f - sg); Q[t * 64 + e] = siluf_(qr); V[t * 64 + e] = vi; }
        __syncthreads();
#pragma unroll 4
        for (int t = 0; t < 32; ++t) {
            const f32x4 f0 = *(const f32x4*)(F + t * 64 + wv * 8), f1 = *(const f32x4*)(F + t * 64 + wv * 8 + 4);
            const f32x4 k0 = *(const f32x4*)(Kx + t * 64 + wv * 8), k1 = *(const f32x4*)(Kx + t * 64 + wv * 8 + 4);
            const f32x4 q0 = *(const f32x4*)(Q + t * 64 + wv * 8), q1 = *(const f32x4*)(Q + t * 64 + wv * 8 + 4);
            const float v = V[t * 64 + e]; const f32x2 vv = {v, v};
            S0 = (f32x2){f0[0], f0[1]} * S0 + (f32x2){k0[0], k0[1]} * vv; S1 = (f32x2){f0[2], f0[3]} * S1 + (f32x2){k0[2], k0[3]} * vv;
            S2 = (f32x2){f1[0], f1[1]} * S2 + (f32x2){k1[0], k1[1]} * vv; S3 = (f32x2){f1[2], f1[3]} * S3 + (f32x2){k1[2], k1[3]} * vv;
            f32x2 o2 = (f32x2){q0[0], q0[1]} * S0 + (f32x2){q0[2], q0[3]} * S1 + (f32x2){q1[0], q1[1]} * S2 + (f32x2){q1[2], q1[3]} * S3;
            PO[(t * 8 + wv) * 64 + e] = o2[0] + o2[1];
        }
        __syncthreads();
#pragma unroll
        for (int i = 0; i < 4; ++i) { const int t = wv * 4 + i; bf16_t* row = base + (size_t)(t0 + t) * PLD;
            float o = 0.f;
#pragma unroll
            for (int q = 0; q < 8; ++q) o += PO[(t * 8 + q) * 64 + e];
            const float ss = wave_sum(o * o); const float rs = rsqrtf(ss * (1.0f / 64.0f) + 1e-6f);
            const float gr = bf2f(row[C_HG + C]);
            row[C_HQ + C] = f2bf(o * rs * ng * siluf_(gr)); }
        __syncthreads();
    }
}

DI float dpp_xor1(float v) { return __int_as_float(__builtin_amdgcn_mov_dpp(__float_as_int(v), 0xB1, 0xF, 0xF, true)); }
DI float dpp_xor2(float v) { return __int_as_float(__builtin_amdgcn_mov_dpp(__float_as_int(v), 0x4E, 0xF, 0xF, true)); }
DI float dpp_hmir(float v) { return __int_as_float(__builtin_amdgcn_mov_dpp(__float_as_int(v), 0x141, 0xF, 0xF, true)); }
DI float red8(float v) { v += dpp_xor1(v); v += dpp_xor2(v); v += dpp_hmir(v); return v; }

__device__ __forceinline__ void rwkv_scan(unsigned char* smem, CP p, int L, int b, int h) {
    constexpr int BUF_F = 6 * 2048 + 64 + 2048;
    const int tid = tid_(), c = tid & 63, wv = tid >> 6, C = h * 64 + c, lane = c;
    const float* mu = p->in[I_MU] + (size_t)L * 1792;
    const float mu_r = mu[C], mu_k = mu[512 + C], mu_v = mu[1024 + C];
    const float w0 = p->in[I_W0][L * 512 + C], a0 = p->in[I_A0][L * 512 + C];
    const float k_k = p->in[I_KK][L * 512 + C], k_a = p->in[I_KA][L * 512 + C], r_k = p->in[I_RK][L * 512 + C], ln_w = p->in[I_LNW][L * 512 + C], ln_b = p->in[I_LNB][L * 512 + C];
    const bf16_t* base = (const bf16_t*)(p->ws + WS_PROJ) + (size_t)b * SEQ * PLD + C_RW + C;
    const bf16_t* ewa = (const bf16_t*)(p->ws + WS_UN) + (size_t)b * SEQ * 1024 + C;
    bf16_t* obase = (bf16_t*)(p->ws + WS_ORW) + (size_t)b * SEQ * 512 + C;
    const int kp = lane & 7, vr = lane >> 3, vrow = wv * 8 + vr;
    f32x2 S0 = {0.f, 0.f}, S1 = {0.f, 0.f}, S2 = {0.f, 0.f}, S3 = {0.f, 0.f};
    bf16_t pr[4], pk[4], pv[4], pe[4], pa[4], pg[4], qr, qk, qv;
#define RW_PREFETCH(T0) do { const int s0_ = (T0) + wv * 4; \
        _Pragma("unroll") for (int i = 0; i < 4; ++i) { const bf16_t* row = base + (size_t)(s0_ + i) * PLD; pr[i] = row[0]; pk[i] = row[512]; pv[i] = row[1024]; \
            pe[i] = ewa[(size_t)(s0_ + i) * 1024]; pa[i] = ewa[(size_t)(s0_ + i) * 1024 + 512]; pg[i] = obase[(size_t)(s0_ + i) * 512]; } \
        if (s0_ > 0) { const bf16_t* row = base + (size_t)(s0_ - 1) * PLD; qr = row[0]; qk = row[512]; qv = row[1024]; } else { qr = 0; qk = 0; qv = 0; } } while (0)
    RW_PREFETCH(0);
    __syncthreads();
    for (int blk = 0; blk < SEQ / 32; ++blk) {
        float* Bf = (float*)smem + (blk & 1) * BUF_F;
        float* Wd = Bf; float* NKK = Bf + 2048; float* AB = Bf + 4096; float* KX = Bf + 6144; float* WR = Bf + 8192; float* VS = Bf + 10240; float* SC = Bf + 12288; float* YS = Bf + 12352;
        float bon[4], gv[4];
        { float rp = bf2f(qr), kq = bf2f(qk), vp = bf2f(qv);
#pragma unroll
          for (int i = 0; i < 4; ++i) { const int t = wv * 4 + i;
              const float r1 = bf2f(pr[i]), k1 = bf2f(pk[i]), v1 = bf2f(pv[i]);
              const float r = r1 + (rp - r1) * mu_r, k = k1 + (kq - k1) * mu_k, v = v1 + (vp - v1) * mu_v; rp = r1; kq = k1; vp = v1;
              const float decay = __expf(-0.6065306597f * sigmoidf_(w0 + bf2f(pe[i]))), a = sigmoidf_(a0 + bf2f(pa[i])); gv[i] = bf2f(pg[i]);
              const float kkv = k * k_k; const float ssq = wave_sum(kkv * kkv); const float kkn = kkv / fmaxf(sqrtf(ssq), 1e-12f);
              const float kx = k * (1.0f + (a - 1.0f) * k_a), ab = kkn * a;
              const float br = wave_sum(ab * r), kr = wave_sum(kx * r); bon[i] = wave_sum(r * kx * r_k);
              Wd[t * 64 + c] = decay; NKK[t * 64 + c] = -kkn; AB[t * 64 + c] = ab; KX[t * 64 + c] = kx; WR[t * 64 + c] = decay * r; VS[t * 64 + c] = v;
              if (c == 0) { SC[t * 2] = br; SC[t * 2 + 1] = kr; } } }
        __syncthreads();
        if (blk + 1 < SEQ / 32) RW_PREFETCH((blk + 1) * 32);
#pragma nounroll
        for (int t8 = 0; t8 < 4; ++t8) {
            float ykeep = 0.f;
#pragma unroll
            for (int j = 0; j < 8; ++j) {
                const int t = t8 * 8 + j, o = t * 64 + kp * 8;
                const f32x4 w0v = *(const f32x4*)(Wd + o), w1v = *(const f32x4*)(Wd + o + 4), n0 = *(const f32x4*)(NKK + o), n1 = *(const f32x4*)(NKK + o + 4);
                const f32x4 b0 = *(const f32x4*)(AB + o), b1 = *(const f32x4*)(AB + o + 4), x0 = *(const f32x4*)(KX + o), x1 = *(const f32x4*)(KX + o + 4);
                const f32x4 q0 = *(const f32x4*)(WR + o), q1 = *(const f32x4*)(WR + o + 4);
                const float vv = VS[t * 64 + vrow]; const f32x2 sc = *(const f32x2*)(SC + t * 2);
                const f32x2 sa2 = S0 * (f32x2){n0[0], n0[1]} + S1 * (f32x2){n0[2], n0[3]} + S2 * (f32x2){n1[0], n1[1]} + S3 * (f32x2){n1[2], n1[3]};
                const f32x2 y2 = S0 * (f32x2){q0[0], q0[1]} + S1 * (f32x2){q0[2], q0[3]} + S2 * (f32x2){q1[0], q1[1]} + S3 * (f32x2){q1[2], q1[3]};
                float sa = sa2[0] + sa2[1], yy = y2[0] + y2[1];
                sa += dpp_xor1(sa); yy += dpp_xor1(yy); sa += dpp_xor2(sa); yy += dpp_xor2(yy); sa += dpp_hmir(sa); yy += dpp_hmir(yy);
                const f32x2 sav = {sa, sa}, vv2 = {vv, vv};
                S0 = S0 * (f32x2){w0v[0], w0v[1]} + sav * (f32x2){b0[0], b0[1]} + vv2 * (f32x2){x0[0], x0[1]};
                S1 = S1 * (f32x2){w0v[2], w0v[3]} + sav * (f32x2){b0[2], b0[3]} + vv2 * (f32x2){x0[2], x0[3]};
                S2 = S2 * (f32x2){w1v[0], w1v[1]} + sav * (f32x2){b1[0], b1[1]} + vv2 * (f32x2){x1[0], x1[1]};
                S3 = S3 * (f32x2){w1v[2], w1v[3]} + sav * (f32x2){b1[2], b1[3]} + vv2 * (f32x2){x1[2], x1[3]};
                const float y = yy + sa * sc[0] + vv * sc[1];
                ykeep = (kp == j) ? y : ykeep;
            }
            YS[(t8 * 8 + kp) * 64 + vrow] = ykeep;
        }
        __syncthreads();
#pragma unroll
        for (int i = 0; i < 4; ++i) { const int t = wv * 4 + i;
            const float y = YS[t * 64 + c]; const float mean = wave_sum(y) * (1.0f / 64.0f); const float dlt = y - mean;
            const float var = wave_sum(dlt * dlt) * (1.0f / 64.0f);
            float yn = dlt * rsqrtf(var + 64e-5f) * ln_w + ln_b; yn += bon[i] * VS[t * 64 + c];
            obase[(size_t)(blk * 32 + t) * 512] = f2bf(yn * gv[i]); }
    }
#undef RW_PREFETCH
    __syncthreads();
}

#define MFMA32(a, b, c) __builtin_amdgcn_mfma_f32_32x32x16_bf16((a), (b), (c), 0, 0, 0)
constexpr int KTS = 72;
DI bf16x8 pack8(float a0, float a1, float a2, float a3, float a4, float a5, float a6, float a7) {
    u32x4 w; w.x = pack2(a0, a1); w.y = pack2(a2, a3); w.z = pack2(a4, a5); w.w = pack2(a6, a7); return __builtin_bit_cast(bf16x8, w); }
DI bf16x8 ld_vfrag(const bf16_t* vt, int off) { const u32x2 lo = *(const u32x2*)(vt + off), hi = *(const u32x2*)(vt + off + 8); u32x4 w; w.x = lo.x; w.y = lo.y; w.z = hi.x; w.w = hi.y; return __builtin_bit_cast(bf16x8, w); }

struct FlashState { f32x16 o0, o1; float m, l; };

DI void flash_update(FlashState& st, f32x16& sc0, f32x16& sc1, const bf16_t* VT, int vs, int qi, int hl) {
    float mt = -INFINITY;
#pragma unroll
    for (int i = 0; i < 16; ++i) mt = fmaxf(mt, fmaxf(sc0[i], sc1[i]));
    mt = fmaxf(mt, shfl_xor_(mt, 32, qi + 32 * hl));
    const float mnew = fmaxf(st.m, mt), muse = (mnew == -INFINITY) ? 0.f : mnew;
    const float alpha = __expf(st.m - muse);
    float ls = 0.f;
#pragma unroll
    for (int i = 0; i < 16; ++i) { sc0[i] = __expf(sc0[i] - muse); sc1[i] = __expf(sc1[i] - muse); ls += sc0[i] + sc1[i]; }
    st.l = st.l * alpha + ls; st.m = mnew;
    st.o0 *= alpha; st.o1 *= alpha;
#pragma unroll
    for (int s = 0; s < 2; ++s) {
        const bf16x8 p0 = pack8(sc0[8 * s], sc0[8 * s + 1], sc0[8 * s + 2], sc0[8 * s + 3], sc0[8 * s + 4], sc0[8 * s + 5], sc0[8 * s + 6], sc0[8 * s + 7]);
        const bf16x8 p1 = pack8(sc1[8 * s], sc1[8 * s + 1], sc1[8 * s + 2], sc1[8 * s + 3], sc1[8 * s + 4], sc1[8 * s + 5], sc1[8 * s + 6], sc1[8 * s + 7]);
        st.o0 = MFMA32(ld_vfrag(VT, qi * vs + 16 * s + 4 * hl), p0, st.o0);
        st.o1 = MFMA32(ld_vfrag(VT, (32 + qi) * vs + 16 * s + 4 * hl), p0, st.o1);
        st.o0 = MFMA32(ld_vfrag(VT, qi * vs + 32 + 16 * s + 4 * hl), p1, st.o0);
        st.o1 = MFMA32(ld_vfrag(VT, (32 + qi) * vs + 32 + 16 * s + 4 * hl), p1, st.o1);
    }
}
DI void qk_tile(const bf16_t* KT, const bf16x8 (&qf)[4], int qi, int hl, f32x16& sc0, f32x16& sc1) {
#pragma unroll
    for (int i = 0; i < 16; ++i) { sc0[i] = 0.f; sc1[i] = 0.f; }
#pragma unroll
    for (int s = 0; s < 4; ++s) {
        const bf16x8 k0 = *(const bf16x8*)(KT + qi * KTS + 16 * s + 8 * hl), k1 = *(const bf16x8*)(KT + (32 + qi) * KTS + 16 * s + 8 * hl);
        sc0 = MFMA32(k0, qf[s], sc0); sc1 = MFMA32(k1, qf[s], sc1);
    }
}
DI void load_kv_tile(bf16_t* KT, bf16_t* VT, const bf16_t* pb, int kcol, int vcol, int k0) {
    const int tid = tid_();
    { const int key = tid >> 3, ch = tid & 7, kpos = k0 + key; u32x4 w = {0u, 0u, 0u, 0u};
      if (kpos >= 0 && kpos < SEQ) w = *(const u32x4*)(pb + (size_t)kpos * PLD + kcol + ch * 8);
      *(u32x4*)(KT + key * KTS + ch * 8) = w; }
    { const int key = tid & 63, ch = tid >> 6, kpos = k0 + key; u32x4 w = {0u, 0u, 0u, 0u};
      if (kpos >= 0 && kpos < SEQ) w = *(const u32x4*)(pb + (size_t)kpos * PLD + vcol + ch * 8);
#pragma unroll
      for (int j = 0; j < 8; ++j) VT[(ch * 8 + j) * KTS + key] = (bf16_t)((j & 1) ? (w[j >> 1] >> 16) : (w[j >> 1] & 0xFFFFu)); }
}

__device__ __forceinline__ void nsa_item(unsigned char* smem, CP p, int L, int b, int g, int qb, int ocol) {
    bf16_t* KT = (bf16_t*)smem;
    bf16_t* VT = (bf16_t*)(smem + 9216);
    float* LUT = (float*)(smem + 18432);
    unsigned* SELM = (unsigned*)(smem + 20736);
    unsigned* ORM = (unsigned*)(smem + 20992);
    float* PA = (float*)(smem + 21504);
    float* PBv = (float*)(smem + 54272);
    bf16_t* KT2 = (bf16_t*)(smem + 87040);
    bf16_t* VT2 = (bf16_t*)(smem + 105472);
    const int tid = tid_(), lane = tid & 63, wv = tid >> 6, hh = wv >> 1, qhalf = wv & 1, qi = lane & 31, hl = lane >> 5;
    const int ql = qhalf * 32 + qi, qpos = qb * 64 + ql, head = g * 4 + hh;
    bf16_t* pb = (bf16_t*)(p->ws + WS_PROJ) + (size_t)b * SEQ * PLD;
    bf16_t* qrow = pb + (size_t)qpos * PLD;
    __syncthreads();
    for (int i = tid; i < 4 * 129; i += 512) { const int h2 = i / 129, dd = i % 129; int bk;
        if (dd < 16) bk = dd; else if (dd >= 128) bk = 31; else { bk = 16 + (int)(logf((float)dd / 16.0f) / 2.0794415416798357f * 16.0f); bk = bk > 31 ? 31 : bk; }
        LUT[h2 * 132 + dd] = p->in[I_RELB][bk * 8 + g * 4 + h2]; }
    if (tid == 0) *ORM = 0u;
    if (tid < 256) PBv[tid * 32] = 0.f;
    { const float* kc = (const float*)(p->ws + WS_KC) + ((size_t)(0 * 16 + b) * 2 + g) * 128 * 64; const float* vc = (const float*)(p->ws + WS_KC) + ((size_t)(1 * 16 + b) * 2 + g) * 128 * 64;
      for (int i = tid; i < 128 * 64; i += 512) { const int n = i >> 6, d = i & 63; KT2[n * KTS + d] = f2bf(kc[i]); VT2[d * 136 + n] = f2bf(vc[i]); } }
    bf16x8 qf[4];
#pragma unroll
    for (int s = 0; s < 4; ++s) qf[s] = *(const bf16x8*)(qrow + C_NQ + head * 64 + 16 * s + 8 * hl);
    float g0, g1, g2;
    { const bf16_t* gp = qrow + C_NG + head * 3; g0 = sigmoidf_(bf2f(gp[0])); g1 = sigmoidf_(bf2f(gp[1])); g2 = sigmoidf_(bf2f(gp[2])); }
    __syncthreads();
    const float* lut = LUT + hh * 132;
    f32x16 fin0, fin1;
    {
        FlashState st;
#pragma unroll
        for (int i = 0; i < 16; ++i) { st.o0[i] = 0.f; st.o1[i] = 0.f; }
        st.m = -INFINITY; st.l = 0.f;
#pragma nounroll
        for (int t = 0; t < 2; ++t) {
            f32x16 sc0, sc1; qk_tile(KT2 + t * 64 * KTS, qf, qi, hl, sc0, sc1);
#pragma unroll
            for (int i = 0; i < 16; ++i) { const int kl = (i & 3) + 8 * (i >> 2) + 4 * hl;
                { const int n = 64 * t + kl, dist = qpos - (16 * n + 31); sc0[i] = (dist >= 0 && n < 127) ? sc0[i] * 0.125f + lut[dist > 128 ? 128 : dist] : -INFINITY; }
                { const int n = 64 * t + 32 + kl, dist = qpos - (16 * n + 31); sc1[i] = (dist >= 0 && n < 127) ? sc1[i] * 0.125f + lut[dist > 128 ? 128 : dist] : -INFINITY; } }
            flash_update(st, sc0, sc1, VT2 + 64 * t, 136, qi, hl);
        }
        const float lt = st.l + shfl_xor_(st.l, 32, lane); const float inv = 1.0f / fmaxf(lt, 1e-30f);
        const float muse = (st.m == -INFINITY) ? 0.f : st.m;
        fin0 = st.o0 * (g0 * inv); fin1 = st.o1 * (g0 * inv);
#pragma nounroll
        for (int t = 0; t < 2; ++t) {
            f32x16 sc0, sc1; qk_tile(KT2 + t * 64 * KTS, qf, qi, hl, sc0, sc1);
#pragma unroll
            for (int i = 0; i < 16; ++i) { const int kl = (i & 3) + 8 * (i >> 2) + 4 * hl;
                { const int n = 64 * t + kl, dist = qpos - (16 * n + 31); sc0[i] = (dist >= 0 && n < 127) ? __expf(sc0[i] * 0.125f + lut[dist > 128 ? 128 : dist] - muse) * inv : 0.f; }
                { const int n = 64 * t + 32 + kl, dist = qpos - (16 * n + 31); sc1[i] = (dist >= 0 && n < 127) ? __expf(sc1[i] * 0.125f + lut[dist > 128 ? 128 : dist] - muse) * inv : 0.f; } }
#pragma unroll
            for (int i4 = 0; i4 < 4; ++i4) {
                { const int m = 16 * t + 2 * i4 + hl; PA[(hh * 64 + ql) * 32 + m] = sc0[4 * i4] + sc0[4 * i4 + 1] + sc0[4 * i4 + 2] + sc0[4 * i4 + 3]; PBv[(hh * 64 + ql) * 32 + m + 1] = sc0[4 * i4 + 3]; }
                { const int m = 16 * t + 8 + 2 * i4 + hl; PA[(hh * 64 + ql) * 32 + m] = sc1[4 * i4] + sc1[4 * i4 + 1] + sc1[4 * i4 + 2] + sc1[4 * i4 + 3]; if (m + 1 < 32) PBv[(hh * 64 + ql) * 32 + m + 1] = sc1[4 * i4 + 3]; }
            }
        }
    }
    __syncthreads();
    if (tid < 64) {
        const int cur = qb; unsigned msk = 0u;
        for (int it = 0; it < 8; ++it) {
            float best = -INFINITY; int bi = -1;
            for (int m = 0; m < 32; ++m) {
                if ((msk >> m) & 1u) continue;
                float v;
                if (m == 0 || m == cur || m == cur - 1) v = INFINITY;
                else if (m <= cur) { v = 0.f; for (int h2 = 0; h2 < 4; ++h2) v += PA[(h2 * 64 + tid) * 32 + m] + PBv[(h2 * 64 + tid) * 32 + m]; }
                else v = -INFINITY;
                if (v > best) { best = v; bi = m; }
            }
            if (bi >= 0) msk |= 1u << bi;
        }
        SELM[tid] = msk; atomicOr(ORM, msk);
    }
    __syncthreads();
    const unsigned mysel = SELM[ql], orm = *ORM;
    {
        FlashState st;
#pragma unroll
        for (int i = 0; i < 16; ++i) { st.o0[i] = 0.f; st.o1[i] = 0.f; }
        st.m = -INFINITY; st.l = 0.f;
        for (int m = 0; m <= qb; ++m) {
            if (!((orm >> m) & 1u)) continue;
            __syncthreads();
            load_kv_tile(KT, VT, pb, C_KS + g * 64, C_VS + g * 64, m * 64);
            __syncthreads();
            f32x16 sc0, sc1; qk_tile(KT, qf, qi, hl, sc0, sc1);
            const bool sel = (mysel >> m) & 1u;
#pragma unroll
            for (int i = 0; i < 16; ++i) { const int kl = (i & 3) + 8 * (i >> 2) + 4 * hl;
                { const int dist = qpos - (m * 64 + kl); sc0[i] = (sel && dist >= 0) ? sc0[i] * 0.125f + lut[dist > 128 ? 128 : dist] : -INFINITY; }
                { const int dist = qpos - (m * 64 + 32 + kl); sc1[i] = (sel && dist >= 0) ? sc1[i] * 0.125f + lut[dist > 128 ? 128 : dist] : -INFINITY; } }
            flash_update(st, sc0, sc1, VT, KTS, qi, hl);
        }
        const float lt = st.l + shfl_xor_(st.l, 32, lane); const float sc = g1 / fmaxf(lt, 1e-30f);
        fin0 += st.o0 * sc; fin1 += st.o1 * sc;
    }
    {
        FlashState st;
#pragma unroll
        for (int i = 0; i < 16; ++i) { st.o0[i] = 0.f; st.o1[i] = 0.f; }
        st.m = -INFINITY; st.l = 0.f;
        for (int w = 0; w < 5; ++w) {
            const int k0 = qb * 64 - 256 + 64 * w;
            if (k0 + 63 < 0) continue;
            __syncthreads();
            load_kv_tile(KT, VT, pb, C_KW + g * 64, C_VW + g * 64, k0);
            __syncthreads();
            f32x16 sc0, sc1; qk_tile(KT, qf, qi, hl, sc0, sc1);
#pragma unroll
            for (int i = 0; i < 16; ++i) { const int kl = (i & 3) + 8 * (i >> 2) + 4 * hl;
                { const int kpos = k0 + kl, dist = qpos - kpos; sc0[i] = (dist >= 0 && dist < 256 && kpos >= 0) ? sc0[i] * 0.125f + lut[dist > 128 ? 128 : dist] : -INFINITY; }
                { const int kpos = k0 + 32 + kl, dist = qpos - kpos; sc1[i] = (dist >= 0 && dist < 256 && kpos >= 0) ? sc1[i] * 0.125f + lut[dist > 128 ? 128 : dist] : -INFINITY; } }
            flash_update(st, sc0, sc1, VT, KTS, qi, hl);
        }
        const float lt = st.l + shfl_xor_(st.l, 32, lane); const float sc = g2 / fmaxf(lt, 1e-30f);
        fin0 += st.o0 * sc; fin1 += st.o1 * sc;
    }
#pragma unroll
    for (int i4 = 0; i4 < 4; ++i4) {
        u32x2 w0; w0.x = pack2(fin0[4 * i4], fin0[4 * i4 + 1]); w0.y = pack2(fin0[4 * i4 + 2], fin0[4 * i4 + 3]);
        u32x2 w1; w1.x = pack2(fin1[4 * i4], fin1[4 * i4 + 1]); w1.y = pack2(fin1[4 * i4 + 2], fin1[4 * i4 + 3]);
        *(u32x2*)(qrow + ocol + head * 64 + 8 * i4 + 4 * hl) = w0;
        *(u32x2*)(qrow + ocol + head * 64 + 32 + 8 * i4 + 4 * hl) = w1;
    }
}

constexpr int PH_PER_LAYER = 17, PH_TOTAL = DEPTH * PH_PER_LAYER + 1;
enum { S_PREP = 0, S_GU1, S_D1, S_NORM_MIX, S_WIN, S_CMP, S_LORA, S_SCAN, S_NSA, S_MERGE, S_OUT, S_NORM2, S_GU2, S_D2, S_NORM_PLE, S_PLE, S_PLEG, S_FINAL };

__device__ __forceinline__ void run_phase(unsigned char* smem, CP p, int ph) {
    const bool fin = (ph == DEPTH * PH_PER_LAYER);
    const int L = fin ? 0 : ph / PH_PER_LAYER; const int sub = fin ? S_FINAL : ph % PH_PER_LAYER;
    unsigned char* ws = p->ws; float* H = p->out;
    bf16_t* W = (bf16_t*)(ws + WS_WBF); bf16_t* UN = (bf16_t*)(ws + WS_UN); bf16_t* PROJ = (bf16_t*)(ws + WS_PROJ); bf16_t* ACT = (bf16_t*)(ws + WS_ACT);
    bf16_t* TMP = (bf16_t*)(ws + WS_TMP); bf16_t* PBF = (bf16_t*)(ws + WS_PB); bf16_t* ORW = (bf16_t*)(ws + WS_ORW);
    bf16_t* XK = (bf16_t*)(ws + WS_XK); bf16_t* XV = (bf16_t*)(ws + WS_XV); float* P01 = (float*)(ws + WS_P01);
    if (sub == S_PREP) convert_layer_weights(smem, p, L);
    if (sub == S_NORM_MIX) convert_ffn2_weights(smem, p, L);
    if (sub == S_NORM_PLE) cvt_f32_bf16(p->in[I_P] + (size_t)L * T_TOK * 256, PBF, (size_t)T_TOK * 256 / 4);
    if (sub == S_CMP) lora_act(p, L);
    if (sub == S_LORA) finalize_cmp(smem, p, L);
    if (sub == S_PREP || sub == S_NORM_MIX || sub == S_NORM2 || sub == S_NORM_PLE || sub == S_FINAL) {
        const float* hin = (sub == S_PREP && L == 0) ? p->in[I_X] : H; float* hcopy = (sub == S_PREP && L == 0) ? H : nullptr;
        const float* g = sub == S_PREP ? p->in[I_F1N] + L * DM : sub == S_NORM_MIX ? p->in[I_MIXN] + L * DM : sub == S_NORM2 ? p->in[I_F2N] + L * DM : sub == S_NORM_PLE ? p->in[I_PLEN] + L * DM : p->in[I_FINN];
        rmsnorm_rows(hin, hcopy, g, sub == S_FINAL ? nullptr : UN, sub == S_FINAL ? H : nullptr);
    } else if (sub == S_GU1 || sub == S_GU2) {
        EpiSwiglu e; e.O = ACT; run_gemm(smem, UN, DM, W + (sub == S_GU1 ? E_GU1 : E_GU2), T_TOK, 2 * DFF, DM, e);
    } else if (sub == S_D1 || sub == S_D2 || sub == S_OUT) {
        EpiResid e; e.H = H; e.scale = sub == S_OUT ? 1.0f : 0.5f;
        run_gemm(smem, sub == S_OUT ? UN : ACT, sub == S_OUT ? DM : DFF, W + (sub == S_D1 ? E_D1 : sub == S_D2 ? E_D2 : E_OUT), T_TOK, DM, sub == S_OUT ? DM : DFF, e);
    } else if (sub == S_WIN) {
        EpiProj e; e.O = PROJ; e.XK = XK; e.XV = XV; run_gemm(smem, UN, DM, W + E_IN, T_TOK, PLD, DM, e);
    } else if (sub == S_CMP) {
#pragma nounroll
        for (int kv = 0; kv < 2; ++kv) { EpiF32 e; e.C = P01 + (size_t)kv * 4096 * 256;
            run_gemm(smem, kv ? XV : XK, 1024, W + E_C1 + (size_t)kv * 256 * 1024, 4096, 256, 1024, e); }
    } else if (sub == S_LORA) {
        EpiLora e; e.EWA = UN; e.G = ORW;
        run_gemm(smem, (const bf16_t*)(ws + WS_LACT), 256, W + E_LORA, T_TOK, 1536, 256, e);
    } else if (sub == S_SCAN) {
        for (int item = bid_(); item < 256; item += gridDim.x) {
            __syncthreads();
            if (item < 128) rwkv_scan(smem, p, L, item >> 3, item & 7); else hgrn_scan(smem, p, L, (item - 128) >> 3, (item - 128) & 7);
        }
    } else if (sub == S_NSA) {
        for (int idx = bid_(), k = 0; idx < 1024; idx += gridDim.x, ++k) {
            const int bg = idx & 31, qq = idx >> 5; const int qb = (k & 1) ? ((qq & ~7) + 7 - (qq & 7)) : qq;
            nsa_item(smem, p, L, bg >> 1, bg & 1, qb, C_NQ);
        }
    } else if (sub == S_MERGE) {
#pragma nounroll
        for (int j = 0; j < 3; ++j) { EpiMerge e; e.MRG = UN; e.PROJ = PROJ; e.J = j;
            const bf16_t* A = j == 0 ? PROJ + C_HQ : (j == 1 ? PROJ + C_NQ : ORW);
            run_gemm(smem, A, j == 2 ? 512 : PLD, W + E_BR + (size_t)j * 1024 * 512, T_TOK, DM, 512, e); }
    } else if (sub == S_PLE) {
        EpiBf16 e; e.O = TMP; run_gemm(smem, PBF, 256, W + E_PW, T_TOK, DM, 256, e);
    } else if (sub == S_PLEG) {
        EpiPleGate e; e.H = H; e.TMP = TMP; run_gemm(smem, UN, DM, W + E_PG, T_TOK, DM, DM, e);
    }
}

__global__ void __launch_bounds__(512, 2) mega_fwd(Params p) {
    extern __shared__ __attribute__((aligned(16))) unsigned char smem[];
    cg::grid_group grid = cg::this_grid();
    for (int ph = p.ph_lo; ph < p.ph_hi; ++ph) {
        CP pp = (CP)__builtin_amdgcn_kernarg_segment_ptr(); asm volatile("" : "+s"(pp));
        run_phase(smem, pp, ph);
        if (ph + 1 < p.ph_hi) grid.sync();
    }
}

#ifndef MULTI_LAUNCH
#define MULTI_LAUNCH 0
#endif

extern "C" void kernel_launch(void* const* d_in, const int* in_sizes, int n_in, void* d_out, int out_size, void* d_ws, size_t ws_size, hipStream_t stream) {
    static int grid = 0;
    if (grid == 0) {
        if (n_in != N_INPUTS || out_size != T_TOK * DM || ws_size < WS_END) { fprintf(stderr, "kernel_launch: unexpected shapes: n_in %d out %d ws %zu (need %zu)\n", n_in, out_size, ws_size, (size_t)WS_END); grid = -1; return; }
        int dev = 0, cus = 0, per_cu = 0;
        (void)hipGetDevice(&dev); (void)hipDeviceGetAttribute(&cus, hipDeviceAttributeMultiprocessorCount, dev);
        if (hipFuncSetAttribute((const void*)mega_fwd, hipFuncAttributeMaxDynamicSharedMemorySize, LDS_BYTES) != hipSuccess) { fprintf(stderr, "kernel_launch: hipFuncSetAttribute failed\n"); grid = -1; return; }
        if (hipOccupancyMaxActiveBlocksPerMultiprocessor(&per_cu, (const void*)mega_fwd, 512, LDS_BYTES) != hipSuccess || per_cu < 1) { fprintf(stderr, "kernel_launch: occupancy query gives %d\n", per_cu); per_cu = 1; }
        (void)hipGetLastError();
        grid = cus * 1;
        if (grid > 256) grid = 256;
        fprintf(stderr, "kernel_launch: grid %d (cus %d, per_cu %d)\n", grid, cus, per_cu);
    }
    if (grid < 0) return;
    Params p{};
    for (int i = 0; i < N_INPUTS; ++i) p.in[i] = (const float*)d_in[i];
    p.out = (float*)d_out; p.ws = (unsigned char*)d_ws;
#if MULTI_LAUNCH
    for (int ph = 0; ph < PH_TOTAL; ++ph) { p.ph_lo = ph; p.ph_hi = ph + 1; hipLaunchKernelGGL(mega_fwd, dim3(grid), dim3(512), LDS_BYTES, stream, p); }
#else
    p.ph_lo = 0; p.ph_hi = PH_TOTAL;
    void* args[] = {&p};
    hipError_t e = hipLaunchCooperativeKernel((const void*)mega_fwd, dim3(grid), dim3(512), args, LDS_BYTES, stream);
    if (e != hipSuccess) fprintf(stderr, "kernel_launch: cooperative launch failed: %s\n", hipGetErrorString(e));
#endif
}
```

```cpp
#include <hip/hip_runtime.h>
#include <hip/hip_cooperative_groups.h>
#include <cstdio>
namespace cg = cooperative_groups;

#define LAS __attribute__((address_space(3)))
#define DI __device__ __forceinline__
typedef unsigned short bf16_t;
typedef short bf16x8 __attribute__((ext_vector_type(8)));
typedef float f32x4 __attribute__((ext_vector_type(4)));
typedef float f32x2 __attribute__((ext_vector_type(2)));
typedef float f32x16 __attribute__((ext_vector_type(16)));
typedef unsigned u32x4 __attribute__((ext_vector_type(4)));
typedef unsigned u32x2 __attribute__((ext_vector_type(2)));

constexpr int T_TOK = 32768, SEQ = 2048, NB = 16, DM = 1024, DFF = 2816, DEPTH = 4;
constexpr int PLD = 8448;
constexpr int C_HQ = 0, C_HF = 512, C_HI = 1024, C_HG = 1536, C_NQ = 2048, C_KC = 2560, C_VC = 2688, C_KS = 2816, C_VS = 2944,
              C_KW = 3072, C_VW = 3200, C_NG = 3328, C_RW = 3352, C_MG = 5376, IN_REAL = 5144, IN_COLS = 8216;
enum { I_X = 0, I_P, I_F1N, I_F1GU, I_F1D, I_MIXN, I_WIN, I_HGLB, I_HGN, I_PE, I_CW1, I_CW2, I_RELB, I_MU, I_W0, I_WB, I_A0, I_AB, I_GB,
       I_KK, I_KA, I_RK, I_LNW, I_LNB, I_WBR, I_WOUT, I_F2N, I_F2GU, I_F2D, I_PLEN, I_PLEG, I_PLEW, I_FINN, N_INPUTS };

constexpr size_t WS_PEB = 4096;
constexpr size_t WS_WBF = 8192;
constexpr size_t E_GU1 = 0, E_D1 = E_GU1 + 5632ull * 1024, E_IN = E_D1 + 1024ull * 2816, E_BR = E_IN + 8448ull * 1024, E_OUT = E_BR + 3ull * 1024 * 512,
                 E_GU2 = E_GU1, E_D2 = E_D1  , E_PG = E_OUT + 1024ull * 1024, E_PW = E_PG + 1024ull * 1024,
                 E_C1 = E_PW + 1024ull * 256, E_LORA = E_C1 + 2ull * 256 * 1024, E_END = E_LORA + 1536ull * 256;
constexpr size_t WS_UN = WS_WBF + E_END * 2;
constexpr size_t WS_ORW = WS_UN + (size_t)T_TOK * 1024 * 2;
constexpr size_t WS_XK = WS_ORW + (size_t)T_TOK * 512 * 2;
constexpr size_t WS_XV = WS_XK + 4096ull * 1024 * 2;
constexpr size_t WS_P01 = WS_XV + 4096ull * 1024 * 2;
constexpr size_t WS_KC = WS_P01 + 2ull * 4096 * 256 * 4;
constexpr size_t WS_LACT = WS_KC + 2ull * 16 * 2 * 128 * 64 * 4;
constexpr size_t WS_PROJ = WS_LACT + (size_t)T_TOK * 256 * 2;
constexpr size_t WS_END = WS_PROJ + (size_t)T_TOK * PLD * 2;
constexpr size_t WS_ACT = WS_PROJ;
constexpr size_t WS_PB = WS_PROJ + 200ull * 1024 * 1024;
constexpr size_t WS_TMP = WS_PROJ + 256ull * 1024 * 1024;
constexpr int LDS_BYTES = 144 * 1024;

struct Params {
    const float* in[N_INPUTS];
    float* out;
    unsigned char* ws;
    int ph_lo, ph_hi;
};
typedef const Params __attribute__((address_space(4)))* CP;

DI int tid_() { int t = threadIdx.x; asm volatile("" : "+v"(t)); return t; }
DI int bid_() { int b = blockIdx.x; asm volatile("" : "+s"(b)); return b; }
typedef __bf16 bf16v2 __attribute__((ext_vector_type(2)));
DI float bf2f(bf16_t b) { return __uint_as_float(((unsigned)b) << 16); }
DI unsigned pack2(float lo, float hi) { const f32x2 v = {lo, hi}; return __builtin_bit_cast(unsigned, __builtin_convertvector(v, bf16v2)); }
DI bf16_t f2bf(float f) { return (bf16_t)(pack2(f, 0.f) & 0xFFFFu); }
DI float sigmoidf_(float x) { return 1.0f / (1.0f + __expf(-x)); }
DI float siluf_(float x) { return x / (1.0f + __expf(-x)); }
DI float shfl_xor_(float v, int mask, int lane) { return __int_as_float(__builtin_amdgcn_ds_bpermute((lane ^ mask) << 2, __float_as_int(v))); }
DI float wave_sum(float v) {
    const int lane = tid_() & 63;
#pragma unroll
    for (int o = 32; o >= 1; o >>= 1) v += shfl_xor_(v, o, lane);
    return v;
}

namespace pg8 {
constexpr int BM = 256, BK = 64, HALF = 128, HTB = HALF * BK * 2, STAGE_BYTES = 8 * HTB, NXCD = 8, WGM = 8;
DI int lds_byte(int r, int c) { const int st = (r >> 4) * 2 + (c >> 5), rr = r & 15, cc = c & 31, ob = rr * 64 + cc * 2; return st * 1024 + (ob ^ (((ob >> 9) & 1) << 5)); }
DI void stage_rc(int b, int& R, int& C) { const int st = b / 1024, sb = b % 1024, swz = sb ^ (((sb >> 9) & 1) << 5); R = (st >> 1) * 16 + swz / 64; C = (st & 1) * 32 + (swz % 64) / 2; }
DI int perm32(int rho) { const int n = rho >> 4, i = rho & 15; return 8 * (i >> 2) + 4 * n + (i & 3); }
struct Unit { int pm, pn; };
struct Gemm { const bf16_t* A; const bf16_t* Bt; int M, N, K, lda; };
struct StaticOrder {
    int nM, nN, nwg, G, c;
    DI void init(int M, int N, int G_, int c_) { nM = M / BM; nN = N / BM; nwg = nM * nN; G = G_; c = c_; }
    DI bool next(int i, Unit& u) const {
        const long L = (long)i * G + c; if (L >= nwg) return false;
        int wgid = (int)L; { const int q = nwg / NXCD, r = nwg % NXCD, xcd = wgid % NXCD, off = wgid / NXCD; wgid = (xcd < r ? xcd * (q + 1) : r * (q + 1) + (xcd - r) * q) + off; }
        const int nig = WGM * nN, gid = wgid / nig, fm = gid * WGM, gsz = (nM - fm) < WGM ? (nM - fm) : WGM;
        u.pm = fm + ((wgid % nig) % gsz); u.pn = (wgid % nig) / gsz; return true;
    }
};

template <class Epi>
DI void gemm_phase(LAS unsigned char* lds, const Gemm g, const StaticOrder& S, const Epi& E) {
    int tid = tid_();
    const int wid = __builtin_amdgcn_readfirstlane(tid >> 6), lane = tid & 63, wr = wid >> 2, wc = wid & 3, fr = lane & 15, fq = lane >> 4;
    const int K = g.K, nt = K / BK, lda = g.lda;
    unsigned voffA[2], voffB[2];
#pragma unroll
    for (int i = 0; i < 2; ++i) { int R, C; stage_rc(tid * 16 + i * 8192, R, C); const int Rb = Epi::PERM ? ((R & ~31) + perm32(R & 31)) : R;
        voffA[i] = (unsigned)(R * lda + C) * 2u; voffB[i] = (unsigned)(Rb * K + C) * 2u; }
    const size_t kstep = (size_t)(BK * 2);
    const size_t hstepA = (size_t)HALF * lda * 2, hstepB = (size_t)HALF * K * 2;
    const size_t tstepA = 2 * hstepA, tstepB = 2 * hstepB;
    const unsigned ldsw = (unsigned)wid * 1024u;
    const int aoff = lds_byte(wr * 64 + fr, fq * 8), boff = lds_byte(wc * 32 + fr, fq * 8);
#define PG8_SA(b, h) (((b) * 2 + (h)) * HTB)
#define PG8_SB(b, h) ((4 + (b) * 2 + (h)) * HTB)
#define PG8_STAGE(bufoff, gbase, voff) do { _Pragma("unroll") for (int _i = 0; _i < 2; ++_i) \
        __builtin_amdgcn_global_load_lds((const unsigned*)((const char*)(gbase) + (voff)[_i]), (LAS unsigned*)(lds + (bufoff) + ldsw + _i * 8192), 16, 0, 0); } while (0)
#define PG8_LDA(dst, b, h) do { _Pragma("unroll") for (int m = 0; m < 4; ++m) _Pragma("unroll") for (int k = 0; k < 2; ++k) dst[m][k] = *(const LAS bf16x8*)(lds + PG8_SA(b, h) + aoff + m * 2048 + k * 1024); } while (0)
#define PG8_LDB(dst, b, h) do { _Pragma("unroll") for (int n = 0; n < 2; ++n) _Pragma("unroll") for (int k = 0; k < 2; ++k) dst[n][k] = *(const LAS bf16x8*)(lds + PG8_SB(b, h) + boff + n * 2048 + k * 1024); } while (0)
#define PG8_MMA(ai, bj, At, Bt) do { __builtin_amdgcn_s_setprio(1); _Pragma("unroll") for (int m = 0; m < 4; ++m) _Pragma("unroll") for (int n = 0; n < 2; ++n) _Pragma("unroll") for (int k = 0; k < 2; ++k) \
        acc[ai][bj][m][n] = __builtin_amdgcn_mfma_f32_16x16x32_bf16(Bt[n][k], At[m][k], acc[ai][bj][m][n], 0, 0, 0); __builtin_amdgcn_s_setprio(0); } while (0)
#define PG8_WAIT_V(n) asm volatile("s_waitcnt vmcnt(" #n ")" ::: "memory")
#define PG8_WAIT_L(n) asm volatile("s_waitcnt lgkmcnt(" #n ")" ::: "memory")
#define PG8_BAR __builtin_amdgcn_s_barrier()
#define PG8_SCHED __builtin_amdgcn_sched_barrier(0)
    Unit cur, nxt; int ui = 0;
    if (!S.next(0, cur)) return;
    f32x4 acc[2][2][4][2];
#pragma unroll
    for (int a = 0; a < 2; ++a)
#pragma unroll
        for (int b = 0; b < 2; ++b)
#pragma unroll
            for (int m = 0; m < 4; ++m)
#pragma unroll
                for (int n = 0; n < 2; ++n) acc[a][b][m][n] = (f32x4){0.f, 0.f, 0.f, 0.f};
    bf16x8 At[4][2], B0[2][2], B1[2][2];
    const char* cA = (const char*)g.A + (size_t)cur.pm * tstepA; const char* cB = (const char*)g.Bt + (size_t)cur.pn * tstepB;
    PG8_STAGE(PG8_SB(0, 0), cB, voffB); PG8_STAGE(PG8_SA(0, 0), cA, voffA); PG8_STAGE(PG8_SB(0, 1), cB + hstepB, voffB); PG8_STAGE(PG8_SA(0, 1), cA + hstepA, voffA);
    if (wr == 1) PG8_BAR;
    PG8_WAIT_V(4); PG8_BAR;
    PG8_STAGE(PG8_SB(1, 0), cB + kstep, voffB); PG8_STAGE(PG8_SA(1, 0), cA + kstep, voffA); PG8_STAGE(PG8_SB(1, 1), cB + hstepB + kstep, voffB);
    PG8_WAIT_V(6); PG8_BAR;
    for (;;) {
        const bool has_next = S.next(ui + 1, nxt);
        const char* nA = has_next ? (const char*)g.A + (size_t)nxt.pm * tstepA : cA; const char* nB = has_next ? (const char*)g.Bt + (size_t)nxt.pn * tstepB : cB;
        for (int t = 0; t < nt; t += 2) {
            const bool last = (t == nt - 2);
            const char* a1 = cA + (size_t)(t + 1) * kstep;
            const char* a2 = last ? nA : cA + (size_t)(t + 2) * kstep; const char* b2 = last ? nB : cB + (size_t)(t + 2) * kstep;
            const char* a3 = a2 + kstep; const char* b3 = b2 + kstep;
            PG8_LDB(B0, 0, 0); PG8_SCHED; PG8_LDA(At, 0, 0); PG8_STAGE(PG8_SA(1, 1), a1 + hstepA, voffA);
            PG8_WAIT_L(8); PG8_BAR; PG8_WAIT_L(0); PG8_MMA(0, 0, At, B0); PG8_BAR; PG8_SCHED;
            PG8_LDB(B1, 0, 1); PG8_STAGE(PG8_SB(0, 0), b2, voffB);
            PG8_BAR; PG8_WAIT_L(0); PG8_MMA(0, 1, At, B1); PG8_BAR;
            PG8_LDA(At, 0, 1); PG8_STAGE(PG8_SA(0, 0), a2, voffA);
            PG8_BAR; PG8_WAIT_L(0); PG8_MMA(1, 0, At, B0); PG8_BAR; PG8_SCHED;
            PG8_STAGE(PG8_SB(0, 1), b2 + hstepB, voffB);
            PG8_WAIT_V(6); PG8_BAR; PG8_MMA(1, 1, At, B1); PG8_BAR;
            PG8_LDB(B0, 1, 0); PG8_SCHED; PG8_LDA(At, 1, 0); PG8_STAGE(PG8_SA(0, 1), a2 + hstepA, voffA);
            PG8_WAIT_L(8); PG8_BAR; PG8_WAIT_L(0); PG8_MMA(0, 0, At, B0); PG8_BAR; PG8_SCHED;
            PG8_LDB(B1, 1, 1); PG8_STAGE(PG8_SB(1, 0), b3, voffB);
            PG8_BAR; PG8_WAIT_L(0); PG8_MMA(0, 1, At, B1); PG8_BAR;
            PG8_LDA(At, 1, 1); PG8_STAGE(PG8_SA(1, 0), a3, voffA);
            PG8_BAR; PG8_WAIT_L(0); PG8_MMA(1, 0, At, B0); PG8_BAR; PG8_SCHED;
            PG8_STAGE(PG8_SB(1, 1), b3 + hstepB, voffB);
            PG8_WAIT_V(6); PG8_BAR; PG8_MMA(1, 1, At, B1); PG8_BAR;
        }
        E(acc, cur, wr, wc, fr, fq);
        if (!has_next) break;
#pragma unroll
        for (int a = 0; a < 2; ++a)
#pragma unroll
            for (int b = 0; b < 2; ++b)
#pragma unroll
                for (int m = 0; m < 4; ++m)
#pragma unroll
                    for (int n = 0; n < 2; ++n) acc[a][b][m][n] = (f32x4){0.f, 0.f, 0.f, 0.f};
        cur = nxt; cA = nA; cB = nB; ++ui;
    }
    PG8_WAIT_V(0);
    if (wr == 0) PG8_BAR;
    PG8_BAR;
#undef PG8_SA
#undef PG8_SB
#undef PG8_STAGE
#undef PG8_LDA
#undef PG8_LDB
#undef PG8_MMA
#undef PG8_WAIT_V
#undef PG8_WAIT_L
#undef PG8_BAR
#undef PG8_SCHED
}
}

typedef f32x4 AccT[2][2][4][2];
#define EPI_LANE const int t_ = tid_(), wid_ = t_ >> 6, ln_ = t_ & 63, wr_ = wid_ >> 2, wc_ = wid_ & 3, fr_ = ln_ & 15, fq_ = ln_ >> 4;
#define EPI_LOOP_PERM(...) EPI_LANE \
    const int row0 = u.pm * 256 + wr_ * 64 + fr_, col0 = u.pn * 256 + wc_ * 32 + 8 * fq_; \
    _Pragma("unroll") for (int ai = 0; ai < 2; ++ai) _Pragma("unroll") for (int m = 0; m < 4; ++m) { const int row = row0 + ai * 128 + m * 16; \
        _Pragma("unroll") for (int bj = 0; bj < 2; ++bj) { const int col = col0 + bj * 128; const f32x4 v0 = acc[ai][bj][m][0], v1 = acc[ai][bj][m][1]; __VA_ARGS__ } }
#define EPI_LOOP_NAT(...) EPI_LANE \
    const int row0 = u.pm * 256 + wr_ * 64 + fr_, col0 = u.pn * 256 + wc_ * 32 + 4 * fq_; \
    _Pragma("unroll") for (int ai = 0; ai < 2; ++ai) _Pragma("unroll") for (int m = 0; m < 4; ++m) { const int row = row0 + ai * 128 + m * 16; \
        _Pragma("unroll") for (int bj = 0; bj < 2; ++bj) _Pragma("unroll") for (int n = 0; n < 2; ++n) { const int col = col0 + bj * 128 + n * 16; const f32x4 v = acc[ai][bj][m][n]; __VA_ARGS__ } }

struct EpiSwiglu { static constexpr bool PERM = true; bf16_t* O;
    DI void operator()(const AccT& acc, const pg8::Unit& u, int wr, int wc, int fr, int fq) const {
        EPI_LOOP_PERM({ u32x2 w; w.x = pack2(siluf_(v0[0]) * v1[0], siluf_(v0[1]) * v1[1]); w.y = pack2(siluf_(v0[2]) * v1[2], siluf_(v0[3]) * v1[3]);
            *(u32x2*)(O + (size_t)row * DFF + (col >> 1)) = w; })
    } };
struct EpiResid { static constexpr bool PERM = false; float* H; float scale;
    DI void operator()(const AccT& acc, const pg8::Unit& u, int wr, int wc, int fr, int fq) const {
        EPI_LOOP_NAT({ f32x4* p = (f32x4*)(H + (size_t)row * DM + col); *p = *p + v * scale; })
    } };
struct EpiProj { static constexpr bool PERM = true; bf16_t* O; bf16_t* XK; bf16_t* XV;
    DI void operator()(const AccT& acc, const pg8::Unit& u, int wr, int wc, int fr, int fq) const {
        const bool is_mg = u.pn * 256 >= C_MG, is_cmp = (u.pn == 10);
        EPI_LOOP_PERM({ f32x4 a = v0, b = v1;
            if (is_mg) { for (int j = 0; j < 4; ++j) { a[j] = sigmoidf_(a[j]); b[j] = sigmoidf_(b[j]); } }
            u32x4 w; w.x = pack2(a[0], a[1]); w.y = pack2(a[2], a[3]); w.z = pack2(b[0], b[1]); w.w = pack2(b[2], b[3]);
            *(u32x4*)(O + (size_t)row * PLD + col) = w;
            if (is_cmp) { const int c = col - C_KC, kv = c >> 7, gg = (c >> 6) & 1, d = c & 63, bb = row >> 11, s = row & 2047, jj = s >> 4, l = s & 15;
                bf16_t* X = kv ? XV : XK; *(u32x4*)(X + ((size_t)((bb * 128 + jj) * 2 + gg)) * 1024 + l * 64 + d) = w; } })
    } };
struct EpiMerge { static constexpr bool PERM = true; bf16_t* MRG; const bf16_t* PROJ; int J;
    DI void operator()(const AccT& acc, const pg8::Unit& u, int wr, int wc, int fr, int fq) const {
        EPI_LOOP_PERM({ const u32x4 gt = *(const u32x4*)(PROJ + (size_t)row * PLD + C_MG + J * 1024 + col);
            u32x4* mp = (u32x4*)(MRG + (size_t)row * DM + col); u32x4 old = (u32x4){0u, 0u, 0u, 0u}; if (J > 0) old = *mp;
            float r[8]; const float x[8] = {v0[0], v0[1], v0[2], v0[3], v1[0], v1[1], v1[2], v1[3]};
            _Pragma("unroll") for (int j = 0; j < 8; ++j) { const unsigned gw = gt[j >> 1], ow = old[j >> 1];
                const float gf = (j & 1) ? __uint_as_float(gw & 0xFFFF0000u) : __uint_as_float(gw << 16);
                const float of = (j & 1) ? __uint_as_float(ow & 0xFFFF0000u) : __uint_as_float(ow << 16);
                r[j] = of + gf * x[j]; }
            u32x4 w; w.x = pack2(r[0], r[1]); w.y = pack2(r[2], r[3]); w.z = pack2(r[4], r[5]); w.w = pack2(r[6], r[7]); *mp = w; })
    } };
struct EpiF32 { static constexpr bool PERM = false; float* C; static constexpr int ldc = 256;
    DI void operator()(const AccT& acc, const pg8::Unit& u, int wr, int wc, int fr, int fq) const {
        EPI_LOOP_NAT({ *(f32x4*)(C + (size_t)row * ldc + col) = v; })
    } };
struct EpiBf16 { static constexpr bool PERM = true; bf16_t* O; static constexpr int ldc = DM;
    DI void operator()(const AccT& acc, const pg8::Unit& u, int wr, int wc, int fr, int fq) const {
        EPI_LOOP_PERM({ u32x4 w; w.x = pack2(v0[0], v0[1]); w.y = pack2(v0[2], v0[3]); w.z = pack2(v1[0], v1[1]); w.w = pack2(v1[2], v1[3]);
            *(u32x4*)(O + (size_t)row * ldc + col) = w; })
    } };
struct EpiPleGate { static constexpr bool PERM = false; float* H; const bf16_t* TMP;
    DI void operator()(const AccT& acc, const pg8::Unit& u, int wr, int wc, int fr, int fq) const {
        EPI_LOOP_NAT({ const u32x2 tw = *(const u32x2*)(TMP + (size_t)row * DM + col); f32x4* p = (f32x4*)(H + (size_t)row * DM + col); f32x4 h = *p;
            h[0] += sigmoidf_(v[0]) * __uint_as_float(tw.x << 16); h[1] += sigmoidf_(v[1]) * __uint_as_float(tw.x & 0xFFFF0000u);
            h[2] += sigmoidf_(v[2]) * __uint_as_float(tw.y << 16); h[3] += sigmoidf_(v[3]) * __uint_as_float(tw.y & 0xFFFF0000u); *p = h; })
    } };

struct EpiLora { static constexpr bool PERM = true; bf16_t* EWA; bf16_t* G;
    DI void operator()(const AccT& acc, const pg8::Unit& u, int wr, int wc, int fr, int fq) const {
        const bool isg = u.pn >= 4; bf16_t* O = isg ? G - 1024 : EWA; const int ld = isg ? 512 : 1024;
        EPI_LOOP_PERM({ u32x4 w; w.x = pack2(v0[0], v0[1]); w.y = pack2(v0[2], v0[3]); w.z = pack2(v1[0], v1[1]); w.w = pack2(v1[2], v1[3]);
            *(u32x4*)(O + (size_t)row * ld + col) = w; })
    } };

template <class Epi> DI void run_gemm(unsigned char* smem, const bf16_t* A, int lda, const bf16_t* Bt, int M, int N, int K, const Epi& E) {
    __syncthreads();
    pg8::Gemm g; g.A = A; g.Bt = Bt; g.M = M; g.N = N; g.K = K; g.lda = lda;
    pg8::StaticOrder S; S.init(M, N, (int)gridDim.x, bid_());
    pg8::gemm_phase<Epi>((LAS unsigned char*)smem, g, S, E);
    __syncthreads();
}

struct MapId { DI int operator()(int n) const { return n; } };
struct MapGU { DI int operator()(int n) const { const int q = n >> 3, e = n & 7; return e < 4 ? 4 * q + e : DFF + 4 * q + (e - 4); } };
struct MapIn { DI int operator()(int n) const { return n < IN_REAL ? n : (n < C_MG ? -1 : n - (C_MG - IN_REAL)); } };
template <class Map> __device__ __forceinline__ void transpose_cvt(unsigned char* smem, const float* src, int ldsrc, bf16_t* dst, int K, int Nd, Map map) {
    float* tile = (float*)smem;
    const int tid = tid_(), ntk = K / 64, nt = ntk * (Nd / 64);
    for (int t = bid_(); t < nt; t += gridDim.x) {
        const int n0 = (t / ntk) * 64, k0 = (t % ntk) * 64;
        const int nn = tid & 63, sc = map(n0 + nn);
#pragma unroll
        for (int p = 0; p < 8; ++p) { const int kk = (tid >> 6) + p * 8; tile[kk * 65 + nn] = sc >= 0 ? src[(size_t)(k0 + kk) * ldsrc + sc] : 0.f; }
        __syncthreads();
#pragma unroll
        for (int p = 0; p < 4; ++p) { const int nn2 = (tid >> 5) + p * 16, kk2 = (tid & 31) * 2;
            *(unsigned*)(dst + (size_t)(n0 + nn2) * K + k0 + kk2) = pack2(tile[kk2 * 65 + nn2], tile[(kk2 + 1) * 65 + nn2]); }
        __syncthreads();
    }
}
__device__ __forceinline__ void convert_layer_weights(unsigned char* smem, CP p, int L) {
    bf16_t* W = (bf16_t*)(p->ws + WS_WBF);
    transpose_cvt(smem, p->in[I_F1GU] + (size_t)L * DM * 2 * DFF, 2 * DFF, W + E_GU1, DM, 2 * DFF, MapGU());
    transpose_cvt(smem, p->in[I_F1D] + (size_t)L * DFF * DM, DM, W + E_D1, DFF, DM, MapId());
    transpose_cvt(smem, p->in[I_WIN] + (size_t)L * DM * IN_COLS, IN_COLS, W + E_IN, DM, PLD, MapIn());
    for (int j = 0; j < 3; ++j) transpose_cvt(smem, p->in[I_WBR] + ((size_t)L * 3 + j) * 512 * DM, DM, W + E_BR + (size_t)j * 1024 * 512, 512, DM, MapId());
    transpose_cvt(smem, p->in[I_WOUT] + (size_t)L * DM * DM, DM, W + E_OUT, DM, DM, MapId());
    for (int i = bid_() * 512 + tid_(); i < 1536 * 256; i += gridDim.x * 512) { const int n = i >> 8, k = i & 255; float w = 0.f;
        if (n < 512) { if (k < 64) w = p->in[I_WB][((size_t)L * 64 + k) * 512 + n]; }
        else if (n < 1024) { if (k >= 64 && k < 128) w = p->in[I_AB][((size_t)L * 64 + (k - 64)) * 512 + (n - 512)]; }
        else { if (k >= 128) w = p->in[I_GB][((size_t)L * 128 + (k - 128)) * 512 + (n - 1024)]; }
        W[E_LORA + i] = f2bf(w); }
    transpose_cvt(smem, p->in[I_PLEG] + (size_t)L * DM * DM, DM, W + E_PG, DM, DM, MapId());
    transpose_cvt(smem, p->in[I_PLEW] + (size_t)L * 256 * DM, DM, W + E_PW, 256, DM, MapId());
    for (int kv = 0; kv < 2; ++kv) for (int hf = 0; hf < 2; ++hf)
        transpose_cvt(smem, p->in[I_CW1] + ((size_t)(L * 2 + kv) * 2048 + hf * 1024) * 128, 128, W + E_C1 + ((size_t)kv * 256 + hf * 128) * 1024, 1024, 128, MapId());
    if (bid_() == gridDim.x - 1 && tid_() < 256) {
        const int kv = tid_() >> 7, hc = tid_() & 127;
        const float* pe = p->in[I_PE] + (size_t)(L * 2 + kv) * 2048; const float* w1 = p->in[I_CW1] + (size_t)(L * 2 + kv) * 2048 * 128 + hc;
        float s = 0.f; for (int i = 0; i < 2048; ++i) s += pe[i] * w1[(size_t)i * 128];
        ((float*)(p->ws + WS_PEB))[kv * 128 + hc] = s;
    }
}

__device__ __forceinline__ void convert_ffn2_weights(unsigned char* smem, CP p, int L) {
    bf16_t* W = (bf16_t*)(p->ws + WS_WBF);
    transpose_cvt(smem, p->in[I_F2GU] + (size_t)L * DM * 2 * DFF, 2 * DFF, W + E_GU2, DM, 2 * DFF, MapGU());
    transpose_cvt(smem, p->in[I_F2D] + (size_t)L * DFF * DM, DM, W + E_D2, DFF, DM, MapId());
}
__device__ __forceinline__ void lora_act(CP p, int L) {
    const bf16_t* PROJ = (const bf16_t*)(p->ws + WS_PROJ); bf16_t* LACT = (bf16_t*)(p->ws + WS_LACT);
    const float* mu = p->in[I_MU] + (size_t)L * 1792 + 1536;
    for (int i = bid_() * 512 + tid_(); i < T_TOK * 32; i += gridDim.x * 512) {
        const int t = i >> 5, j0 = (i & 31) * 8; const bf16_t* row = PROJ + (size_t)t * PLD + C_RW + 1536 + j0;
        const u32x4 cur = *(const u32x4*)row; u32x4 prv = {0u, 0u, 0u, 0u}; if ((t & (SEQ - 1)) != 0) prv = *(const u32x4*)(row - PLD);
        float r[8];
#pragma unroll
        for (int e = 0; e < 8; ++e) { const float x1 = (e & 1) ? __uint_as_float(cur[e >> 1] & 0xFFFF0000u) : __uint_as_float(cur[e >> 1] << 16);
            const float xp = (e & 1) ? __uint_as_float(prv[e >> 1] & 0xFFFF0000u) : __uint_as_float(prv[e >> 1] << 16);
            float xm = x1 + (xp - x1) * mu[j0 + e];
            if (j0 < 64) xm = tanhf(xm); else if (j0 >= 128) xm = sigmoidf_(xm);
            r[e] = xm; }
        u32x4 w; w.x = pack2(r[0], r[1]); w.y = pack2(r[2], r[3]); w.z = pack2(r[4], r[5]); w.w = pack2(r[6], r[7]);
        *(u32x4*)(LACT + (size_t)t * 256 + j0) = w;
    }
}

__device__ __forceinline__ void rmsnorm_rows(const float* hin, float* hcopy, const float* g, bf16_t* un, float* outf) {
    const int lane = tid_() & 63, gw = bid_() * 8 + (tid_() >> 6), nw = gridDim.x * 8;
    f32x4 gv[4];
#pragma unroll
    for (int i = 0; i < 4; ++i) gv[i] = *(const f32x4*)(g + lane * 4 + i * 256);
    for (int row = gw; row < T_TOK; row += nw) {
        f32x4 x[4]; float ss = 0.f;
#pragma unroll
        for (int i = 0; i < 4; ++i) { x[i] = *(const f32x4*)(hin + (size_t)row * DM + lane * 4 + i * 256); ss += x[i][0] * x[i][0] + x[i][1] * x[i][1] + x[i][2] * x[i][2] + x[i][3] * x[i][3]; }
        ss = wave_sum(ss);
        const float rs = rsqrtf(ss * (1.0f / DM) + 1e-6f);
#pragma unroll
        for (int i = 0; i < 4; ++i) {
            const f32x4 y = x[i] * rs * gv[i];
            if (hcopy) *(f32x4*)(hcopy + (size_t)row * DM + lane * 4 + i * 256) = x[i];
            if (un) { u32x2 w; w.x = pack2(y[0], y[1]); w.y = pack2(y[2], y[3]); *(u32x2*)(un + (size_t)row * DM + lane * 4 + i * 256) = w; }
            if (outf) *(f32x4*)(outf + (size_t)row * DM + lane * 4 + i * 256) = y;
        }
    }
}
__device__ __forceinline__ void cvt_f32_bf16(const float* src, bf16_t* dst, size_t n4) {
    for (size_t i = (size_t)bid_() * 512 + tid_(); i < n4; i += (size_t)gridDim.x * 512) {
        const f32x4 v = *(const f32x4*)(src + i * 4); u32x2 w; w.x = pack2(v[0], v[1]); w.y = pack2(v[2], v[3]); *(u32x2*)(dst + i * 4) = w; }
}

__device__ __forceinline__ void finalize_cmp(unsigned char* smem, CP p, int L) {
    float* hid = (float*)smem + (tid_() >> 6) * 128;
    const int lane = tid_() & 63, gw = bid_() * 8 + (tid_() >> 6), nw = gridDim.x * 8;
    const float* peb = (const float*)(p->ws + WS_PEB);
    const int total = 2 * 16 * 2 * 128, iters = (total + nw - 1) / nw;
    for (int it = 0; it < iters; ++it) {
        const int id = gw + it * nw; const bool ok = id < total;
        const int n = id & 127, gg = (id >> 7) & 1, bb = (id >> 8) & 15, kv = (id >> 12) & 1;
        if (ok && n < 127) {
            const float* Pm = (const float*)(p->ws + WS_P01) + (size_t)kv * 4096 * 256;
            const size_t r0 = (size_t)((bb * 128 + n) * 2 + gg) * 256, r1 = (size_t)((bb * 128 + n + 1) * 2 + gg) * 256;
#pragma unroll
            for (int q = 0; q < 2; ++q) { const int hc = lane + q * 64; hid[hc] = siluf_(Pm[r0 + hc] + Pm[r1 + 128 + hc] + peb[kv * 128 + hc]); }
        }
        __syncthreads();
        if (ok) {
            float o = 0.f;
            if (n < 127) { const float* w2 = p->in[I_CW2] + (size_t)(L * 2 + kv) * 128 * 64 + lane;
                for (int hc = 0; hc < 128; ++hc) o += hid[hc] * w2[hc * 64]; }
            ((float*)(p->ws + WS_KC))[((((size_t)kv * 16 + bb) * 2 + gg) * 128 + n) * 64 + lane] = o;
        }
        __syncthreads();
    }
}

__device__ __forceinline__ void hgrn_scan(unsigned char* smem, CP p, int L, int b, int h) {
    float* F = (float*)smem; float* Kx = F + 2048; float* Q = Kx + 2048; float* V = Q + 2048; float* PO = V + 2048;
    const int tid = tid_(), e = tid & 63, wv = tid >> 6, C = h * 64 + e;
    float lb;
    { const float* hl = p->in[I_HGLB]; const float a0 = hl[C], a1 = hl[512 + C], a2 = hl[1024 + C], a3 = hl[1536 + C];
      const float mx = fmaxf(fmaxf(a0, a1), fmaxf(a2, a3)); const float e0 = __expf(a0 - mx), e1 = __expf(a1 - mx), e2 = __expf(a2 - mx), e3 = __expf(a3 - mx);
      const float inv = 1.0f / (e0 + e1 + e2 + e3); float acc = 0.f; if (L >= 1) acc += e1; if (L >= 2) acc += e2; if (L >= 3) acc += e3; lb = fmaxf(acc * inv, 0.f); }
    const float ng = p->in[I_HGN][L * 512 + C];
    bf16_t* base = (bf16_t*)(p->ws + WS_PROJ) + (size_t)b * SEQ * PLD;
    f32x2 S0 = {0.f, 0.f}, S1 = {0.f, 0.f}, S2 = {0.f, 0.f}, S3 = {0.f, 0.f};
    for (int t0 = 0; t0 < SEQ; t0 += 32) {
#pragma unroll
        for (int i = 0; i < 4; ++i) { const int t = wv * 4 + i; const bf16_t* row = base + (size_t)(t0 + t) * PLD;
            const float z = bf2f(row[C_HF + C]), qr = bf2f(row[C_HQ + C]), vi = bf2f(row[C_HI + C]);
            const float sg = sigmoidf_(z); F[t * 64 + e] = sg + lb * (1.0f - sg); Kx[t * 64 + e] = (1.0f - lb) * (1.0f - sg); Q[t * 64 + e] = siluf_(qr); V[t * 64 + e] = vi; }
        __syncthreads();
#pragma unroll 4
        for (int t = 0; t < 32; ++t) {
            const f32x4 f0 = *(const f32x4*)(F + t * 64 + wv * 8), f1 = *(const f32x4*)(F + t * 64 + wv * 8 + 4);
            const f32x4 k0 = *(const f32x4*)(Kx + t * 64 + wv * 8), k1 = *(const f32x4*)(Kx + t * 64 + wv * 8 + 4);
            const f32x4 q0 = *(const f32x4*)(Q + t * 64 + wv * 8), q1 = *(const f32x4*)(Q + t * 64 + wv * 8 + 4);
            const float v = V[t * 64 + e]; const f32x2 vv = {v, v};
            S0 = (f32x2){f0[0], f0[1]} * S0 + (f32x2){k0[0], k0[1]} * vv; S1 = (f32x2){f0[2], f0[3]} * S1 + (f32x2){k0[2], k0[3]} * vv;
            S2 = (f32x2){f1[0], f1[1]} * S2 + (f32x2){k1[0], k1[1]} * vv; S3 = (f32x2){f1[2], f1[3]} * S3 + (f32x2){k1[2], k1[3]} * vv;
            f32x2 o2 = (f32x2){q0[0], q0[1]} * S0 + (f32x2){q0[2], q0[3]} * S1 + (f32x2){q1[0], q1[1]} * S2 + (f32x2){q1[2], q1[3]} * S3;
            PO[(t * 8 + wv) * 64 + e] = o2[0] + o2[1];
        }
        __syncthreads();
#pragma unroll
        for (int i = 0; i < 4; ++i) { const int t = wv * 4 + i; bf16_t* row = base + (size_t)(t0 + t) * PLD;
            float o = 0.f;
#pragma unroll
            for (int q = 0; q < 8; ++q) o += PO[(t * 8 + q) * 64 + e];
            const float ss = wave_sum(o * o); const float rs = rsqrtf(ss * (1.0f / 64.0f) + 1e-6f);
            const float gr = bf2f(row[C_HG + C]);
            row[C_HQ + C] = f2bf(o * rs * ng * siluf_(gr)); }
        __syncthreads();
    }
}

DI float dpp_xor1(float v) { return __int_as_float(__builtin_amdgcn_mov_dpp(__float_as_int(v), 0xB1, 0xF, 0xF, true)); }
DI float dpp_xor2(float v) { return __int_as_float(__builtin_amdgcn_mov_dpp(__float_as_int(v), 0x4E, 0xF, 0xF, true)); }
DI float dpp_hmir(float v) { return __int_as_float(__builtin_amdgcn_mov_dpp(__float_as_int(v), 0x141, 0xF, 0xF, true)); }
DI float red8(float v) { v += dpp_xor1(v); v += dpp_xor2(v); v += dpp_hmir(v); return v; }

__device__ __forceinline__ void rwkv_scan(unsigned char* smem, CP p, int L, int b, int h) {
    constexpr int BUF_F = 6 * 2048 + 64 + 2048;
    const int tid = tid_(), c = tid & 63, wv = tid >> 6, C = h * 64 + c, lane = c;
    const float* mu = p->in[I_MU] + (size_t)L * 1792;
    const float mu_r = mu[C], mu_k = mu[512 + C], mu_v = mu[1024 + C];
    const float w0 = p->in[I_W0][L * 512 + C], a0 = p->in[I_A0][L * 512 + C];
    const float k_k = p->in[I_KK][L * 512 + C], k_a = p->in[I_KA][L * 512 + C], r_k = p->in[I_RK][L * 512 + C], ln_w = p->in[I_LNW][L * 512 + C], ln_b = p->in[I_LNB][L * 512 + C];
    const bf16_t* base = (const bf16_t*)(p->ws + WS_PROJ) + (size_t)b * SEQ * PLD + C_RW + C;
    const bf16_t* ewa = (const bf16_t*)(p->ws + WS_UN) + (size_t)b * SEQ * 1024 + C;
    bf16_t* obase = (bf16_t*)(p->ws + WS_ORW) + (size_t)b * SEQ * 512 + C;
    const int kp = lane & 7, vr = lane >> 3, vrow = wv * 8 + vr;
    f32x2 S0 = {0.f, 0.f}, S1 = {0.f, 0.f}, S2 = {0.f, 0.f}, S3 = {0.f, 0.f};
    bf16_t pr[4], pk[4], pv[4], pe[4], pa[4], pg[4], qr, qk, qv;
#define RW_PREFETCH(T0) do { const int s0_ = (T0) + wv * 4; \
        _Pragma("unroll") for (int i = 0; i < 4; ++i) { const bf16_t* row = base + (size_t)(s0_ + i) * PLD; pr[i] = row[0]; pk[i] = row[512]; pv[i] = row[1024]; \
            pe[i] = ewa[(size_t)(s0_ + i) * 1024]; pa[i] = ewa[(size_t)(s0_ + i) * 1024 + 512]; pg[i] = obase[(size_t)(s0_ + i) * 512]; } \
        if (s0_ > 0) { const bf16_t* row = base + (size_t)(s0_ - 1) * PLD; qr = row[0]; qk = row[512]; qv = row[1024]; } else { qr = 0; qk = 0; qv = 0; } } while (0)
    RW_PREFETCH(0);
    __syncthreads();
    for (int blk = 0; blk < SEQ / 32; ++blk) {
        float* Bf = (float*)smem + (blk & 1) * BUF_F;
        float* Wd = Bf; float* NKK = Bf + 2048; float* AB = Bf + 4096; float* KX = Bf + 6144; float* WR = Bf + 8192; float* VS = Bf + 10240; float* SC = Bf + 12288; float* YS = Bf + 12352;
        float bon[4], gv[4];
        { float rp = bf2f(qr), kq = bf2f(qk), vp = bf2f(qv);
#pragma unroll
          for (int i = 0; i < 4; ++i) { const int t = wv * 4 + i;
              const float r1 = bf2f(pr[i]), k1 = bf2f(pk[i]), v1 = bf2f(pv[i]);
              const float r = r1 + (rp - r1) * mu_r, k = k1 + (kq - k1) * mu_k, v = v1 + (vp - v1) * mu_v; rp = r1; kq = k1; vp = v1;
              const float decay = __expf(-0.6065306597f * sigmoidf_(w0 + bf2f(pe[i]))), a = sigmoidf_(a0 + bf2f(pa[i])); gv[i] = bf2f(pg[i]);
              const float kkv = k * k_k; const float ssq = wave_sum(kkv * kkv); const float kkn = kkv / fmaxf(sqrtf(ssq), 1e-12f);
              const float kx = k * (1.0f + (a - 1.0f) * k_a), ab = kkn * a;
              const float br = wave_sum(ab * r), kr = wave_sum(kx * r); bon[i] = wave_sum(r * kx * r_k);
              Wd[t * 64 + c] = decay; NKK[t * 64 + c] = -kkn; AB[t * 64 + c] = ab; KX[t * 64 + c] = kx; WR[t * 64 + c] = decay * r; VS[t * 64 + c] = v;
              if (c == 0) { SC[t * 2] = br; SC[t * 2 + 1] = kr; } } }
        __syncthreads();
        if (blk + 1 < SEQ / 32) RW_PREFETCH((blk + 1) * 32);
#pragma nounroll
        for (int t8 = 0; t8 < 4; ++t8) {
            float ykeep = 0.f;
#pragma unroll
            for (int j = 0; j < 8; ++j) {
                const int t = t8 * 8 + j, o = t * 64 + kp * 8;
                const f32x4 w0v = *(const f32x4*)(Wd + o), w1v = *(const f32x4*)(Wd + o + 4), n0 = *(const f32x4*)(NKK + o), n1 = *(const f32x4*)(NKK + o + 4);
                const f32x4 b0 = *(const f32x4*)(AB + o), b1 = *(const f32x4*)(AB + o + 4), x0 = *(const f32x4*)(KX + o), x1 = *(const f32x4*)(KX + o + 4);
                const f32x4 q0 = *(const f32x4*)(WR + o), q1 = *(const f32x4*)(WR + o + 4);
                const float vv = VS[t * 64 + vrow]; const f32x2 sc = *(const f32x2*)(SC + t * 2);
                const f32x2 sa2 = S0 * (f32x2){n0[0], n0[1]} + S1 * (f32x2){n0[2], n0[3]} + S2 * (f32x2){n1[0], n1[1]} + S3 * (f32x2){n1[2], n1[3]};
                const f32x2 y2 = S0 * (f32x2){q0[0], q0[1]} + S1 * (f32x2){q0[2], q0[3]} + S2 * (f32x2){q1[0], q1[1]} + S3 * (f32x2){q1[2], q1[3]};
                float sa = sa2[0] + sa2[1], yy = y2[0] + y2[1];
                sa += dpp_xor1(sa); yy += dpp_xor1(yy); sa += dpp_xor2(sa); yy += dpp_xor2(yy); sa += dpp_hmir(sa); yy += dpp_hmir(yy);
                const f32x2 sav = {sa, sa}, vv2 = {vv, vv};
                S0 = S0 * (f32x2){w0v[0], w0v[1]} + sav * (f32x2){b0[0], b0[1]} + vv2 * (f32x2){x0[0], x0[1]};
                S1 = S1 * (f32x2){w0v[2], w0v[3]} + sav * (f32x2){b0[2], b0[3]} + vv2 * (f32x2){x0[2], x0[3]};
                S2 = S2 * (f32x2){w1v[0], w1v[1]} + sav * (f32x2){b1[0], b1[1]} + vv2 * (f32x2){x1[0], x1[1]};
                S3 = S3 * (f32x2){w1v[2], w1v[3]} + sav * (f32x2){b1[2], b1[3]} + vv2 * (f32x2){x1[2], x1[3]};
                const float y = yy + sa * sc[0] + vv * sc[1];
                ykeep = (kp == j) ? y : ykeep;
            }
            YS[(t8 * 8 + kp) * 64 + vrow] = ykeep;
        }
        __syncthreads();
#pragma unroll
        for (int i = 0; i < 4; ++i) { const int t = wv * 4 + i;
            const float y = YS[t * 64 + c]; const float mean = wave_sum(y) * (1.0f / 64.0f); const float dlt = y - mean;
            const float var = wave_sum(dlt * dlt) * (1.0f / 64.0f);
            float yn = dlt * rsqrtf(var + 64e-5f) * ln_w + ln_b; yn += bon[i] * VS[t * 64 + c];
            obase[(size_t)(blk * 32 + t) * 512] = f2bf(yn * gv[i]); }
    }
#undef RW_PREFETCH
    __syncthreads();
}

#define MFMA32(a, b, c) __builtin_amdgcn_mfma_f32_32x32x16_bf16((a), (b), (c), 0, 0, 0)
constexpr int KTS = 72;
DI bf16x8 pack8(float a0, float a1, float a2, float a3, float a4, float a5, float a6, float a7) {
    u32x4 w; w.x = pack2(a0, a1); w.y = pack2(a2, a3); w.z = pack2(a4, a5); w.w = pack2(a6, a7); return __builtin_bit_cast(bf16x8, w); }
DI bf16x8 ld_vfrag(const bf16_t* vt, int off) { const u32x2 lo = *(const u32x2*)(vt + off), hi = *(const u32x2*)(vt + off + 8); u32x4 w; w.x = lo.x; w.y = lo.y; w.z = hi.x; w.w = hi.y; return __builtin_bit_cast(bf16x8, w); }

struct FlashState { f32x16 o0, o1; float m, l; };

DI void flash_update(FlashState& st, f32x16& sc0, f32x16& sc1, const bf16_t* VT, int vs, int qi, int hl) {
    float mt = -INFINITY;
#pragma unroll
    for (int i = 0; i < 16; ++i) mt = fmaxf(mt, fmaxf(sc0[i], sc1[i]));
    mt = fmaxf(mt, shfl_xor_(mt, 32, qi + 32 * hl));
    const float mnew = fmaxf(st.m, mt), muse = (mnew == -INFINITY) ? 0.f : mnew;
    const float alpha = __builtin_amdgcn_exp2f(st.m - muse);
    float ls = 0.f;
#pragma unroll
    for (int i = 0; i < 16; ++i) { sc0[i] = __builtin_amdgcn_exp2f(sc0[i] - muse); sc1[i] = __builtin_amdgcn_exp2f(sc1[i] - muse); ls += sc0[i] + sc1[i]; }
    st.l = st.l * alpha + ls; st.m = mnew;
    st.o0 *= alpha; st.o1 *= alpha;
#pragma unroll
    for (int s = 0; s < 2; ++s) {
        const bf16x8 p0 = pack8(sc0[8 * s], sc0[8 * s + 1], sc0[8 * s + 2], sc0[8 * s + 3], sc0[8 * s + 4], sc0[8 * s + 5], sc0[8 * s + 6], sc0[8 * s + 7]);
        const bf16x8 p1 = pack8(sc1[8 * s], sc1[8 * s + 1], sc1[8 * s + 2], sc1[8 * s + 3], sc1[8 * s + 4], sc1[8 * s + 5], sc1[8 * s + 6], sc1[8 * s + 7]);
        st.o0 = MFMA32(ld_vfrag(VT, qi * vs + 16 * s + 4 * hl), p0, st.o0);
        st.o1 = MFMA32(ld_vfrag(VT, (32 + qi) * vs + 16 * s + 4 * hl), p0, st.o1);
        st.o0 = MFMA32(ld_vfrag(VT, qi * vs + 32 + 16 * s + 4 * hl), p1, st.o0);
        st.o1 = MFMA32(ld_vfrag(VT, (32 + qi) * vs + 32 + 16 * s + 4 * hl), p1, st.o1);
    }
}
DI void qk_tile(const bf16_t* KT, const bf16x8 (&qf)[4], int qi, int hl, f32x16& sc0, f32x16& sc1) {
#pragma unroll
    for (int i = 0; i < 16; ++i) { sc0[i] = 0.f; sc1[i] = 0.f; }
#pragma unroll
    for (int s = 0; s < 4; ++s) {
        const bf16x8 k0 = *(const bf16x8*)(KT + qi * KTS + 16 * s + 8 * hl), k1 = *(const bf16x8*)(KT + (32 + qi) * KTS + 16 * s + 8 * hl);
        sc0 = MFMA32(k0, qf[s], sc0); sc1 = MFMA32(k1, qf[s], sc1);
    }
}
struct KVRegs { u32x4 k, v; };
DI void kv_fetch(KVRegs& r, const bf16_t* pb, int kcol, int vcol, int k0) {
    const int tid = tid_();
    const unsigned ok_ = (unsigned)((k0 + (tid >> 3)) * PLD + kcol + (tid & 7) * 8) * 2u, ov_ = (unsigned)((k0 + (tid & 63)) * PLD + vcol + (tid >> 6) * 8) * 2u;
    r.k = *(const u32x4*)((const char*)pb + ok_);
    r.v = *(const u32x4*)((const char*)pb + ov_);
}
DI void kv_store(const KVRegs& r, bf16_t* KT, bf16_t* VT) {
    const int tid = tid_();
    *(u32x4*)(KT + (tid >> 3) * KTS + (tid & 7) * 8) = r.k;
    const int key = tid & 63, ch = tid >> 6;
#pragma unroll
    for (int j = 0; j < 8; ++j) VT[(ch * 8 + j) * KTS + key] = (bf16_t)((j & 1) ? (r.v[j >> 1] >> 16) : (r.v[j >> 1] & 0xFFFFu));
}
template <bool LUTB, bool CAUSAL, bool WHI, bool SEL>
DI void mask_tile(f32x16& sc0, f32x16& sc1, const float* lut, int qpos, int k0, int hl, bool sel, float qs) {
    const float bfar = lut[128];
#pragma unroll
    for (int i = 0; i < 16; ++i) { const int kl = (i & 3) + 8 * (i >> 2) + 4 * hl;
        { const int dist = qpos - (k0 + kl); const float v = sc0[i] * qs + (LUTB ? lut[dist > 128 ? 128 : (dist < 0 ? 0 : dist)] : bfar);
          bool ok = true; if (CAUSAL) ok = ok && dist >= 0; if (WHI) ok = ok && dist < 256; if (SEL) ok = ok && sel; sc0[i] = ok ? v : -INFINITY; }
        { const int dist = qpos - (k0 + 32 + kl); const float v = sc1[i] * qs + (LUTB ? lut[dist > 128 ? 128 : (dist < 0 ? 0 : dist)] : bfar);
          bool ok = true; if (CAUSAL) ok = ok && dist >= 0; if (WHI) ok = ok && dist < 256; if (SEL) ok = ok && sel; sc1[i] = ok ? v : -INFINITY; } }
}

__device__ __forceinline__ void nsa_item(unsigned char* smem, CP p, int L, int b, int g, int qb, int ocol) {
    bf16_t* KT = (bf16_t*)smem;
    bf16_t* VT = (bf16_t*)(smem + 9216);
    float* LUT = (float*)(smem + 18432);
    unsigned* SELM = (unsigned*)(smem + 20736);
    unsigned* ORM = (unsigned*)(smem + 20992);
    float* PA = (float*)(smem + 21504);
    float* PBv = (float*)(smem + 54272);
    bf16_t* KT2 = (bf16_t*)(smem + 87040);
    bf16_t* VT2 = (bf16_t*)(smem + 105472);
    const int tid = tid_(), lane = tid & 63, wv = tid >> 6, hh = wv >> 1, qhalf = wv & 1, qi = lane & 31, hl = lane >> 5;
    const int ql = qhalf * 32 + qi, qpos = qb * 64 + ql, head = g * 4 + hh;
    bf16_t* pb = (bf16_t*)(p->ws + WS_PROJ) + (size_t)b * SEQ * PLD;
    bf16_t* qrow = pb + (size_t)qpos * PLD;
    __syncthreads();
    for (int i = tid; i < 4 * 129; i += 512) { const int h2 = i / 129, dd = i % 129; int bk;
        if (dd < 16) bk = dd; else if (dd >= 128) bk = 31; else { bk = 16 + (int)(logf((float)dd / 16.0f) / 2.0794415416798357f * 16.0f); bk = bk > 31 ? 31 : bk; }
        LUT[h2 * 132 + dd] = p->in[I_RELB][bk * 8 + g * 4 + h2] * 1.4426950408889634f; }
    if (tid == 0) *ORM = 0u;
    if (tid < 256) PBv[tid * 32] = 0.f;
    { const float* kc = (const float*)(p->ws + WS_KC) + ((size_t)(0 * 16 + b) * 2 + g) * 128 * 64; const float* vc = (const float*)(p->ws + WS_KC) + ((size_t)(1 * 16 + b) * 2 + g) * 128 * 64;
      for (int i = tid; i < 128 * 64; i += 512) { const int n = i >> 6, d = i & 63; KT2[n * KTS + d] = f2bf(kc[i]); VT2[d * 136 + n] = f2bf(vc[i]); } }
    bf16x8 qf[4];
#pragma unroll
    for (int s = 0; s < 4; ++s) qf[s] = *(const bf16x8*)(qrow + C_NQ + head * 64 + 16 * s + 8 * hl);
    float g0, g1, g2;
    { const bf16_t* gp = qrow + C_NG + head * 3; g0 = sigmoidf_(bf2f(gp[0])); g1 = sigmoidf_(bf2f(gp[1])); g2 = sigmoidf_(bf2f(gp[2])); }
    __syncthreads();
    const float* lut = LUT + hh * 132;
    constexpr float QS = 0.125f * 1.4426950408889634f;
    f32x16 fin0, fin1;
    {
        FlashState st;
#pragma unroll
        for (int i = 0; i < 16; ++i) { st.o0[i] = 0.f; st.o1[i] = 0.f; }
        st.m = -INFINITY; st.l = 0.f;
#pragma nounroll
        for (int t = 0; t < 2; ++t) {
            f32x16 sc0, sc1; qk_tile(KT2 + t * 64 * KTS, qf, qi, hl, sc0, sc1);
#pragma unroll
            for (int i = 0; i < 16; ++i) { const int kl = (i & 3) + 8 * (i >> 2) + 4 * hl;
                { const int n = 64 * t + kl, dist = qpos - (16 * n + 31); sc0[i] = (dist >= 0 && n < 127) ? sc0[i] * QS + lut[dist > 128 ? 128 : dist] : -INFINITY; }
                { const int n = 64 * t + 32 + kl, dist = qpos - (16 * n + 31); sc1[i] = (dist >= 0 && n < 127) ? sc1[i] * QS + lut[dist > 128 ? 128 : dist] : -INFINITY; } }
            flash_update(st, sc0, sc1, VT2 + 64 * t, 136, qi, hl);
        }
        const float lt = st.l + shfl_xor_(st.l, 32, lane); const float inv = 1.0f / fmaxf(lt, 1e-30f);
        const float muse = (st.m == -INFINITY) ? 0.f : st.m;
        fin0 = st.o0 * (g0 * inv); fin1 = st.o1 * (g0 * inv);
#pragma nounroll
        for (int t = 0; t < 2; ++t) {
            f32x16 sc0, sc1; qk_tile(KT2 + t * 64 * KTS, qf, qi, hl, sc0, sc1);
#pragma unroll
            for (int i = 0; i < 16; ++i) { const int kl = (i & 3) + 8 * (i >> 2) + 4 * hl;
                { const int n = 64 * t + kl, dist = qpos - (16 * n + 31); sc0[i] = (dist >= 0 && n < 127) ? __builtin_amdgcn_exp2f(sc0[i] * QS + lut[dist > 128 ? 128 : dist] - muse) * inv : 0.f; }
                { const int n = 64 * t + 32 + kl, dist = qpos - (16 * n + 31); sc1[i] = (dist >= 0 && n < 127) ? __builtin_amdgcn_exp2f(sc1[i] * QS + lut[dist > 128 ? 128 : dist] - muse) * inv : 0.f; } }
#pragma unroll
            for (int i4 = 0; i4 < 4; ++i4) {
                { const int m = 16 * t + 2 * i4 + hl; PA[(hh * 64 + ql) * 32 + m] = sc0[4 * i4] + sc0[4 * i4 + 1] + sc0[4 * i4 + 2] + sc0[4 * i4 + 3]; PBv[(hh * 64 + ql) * 32 + m + 1] = sc0[4 * i4 + 3]; }
                { const int m = 16 * t + 8 + 2 * i4 + hl; PA[(hh * 64 + ql) * 32 + m] = sc1[4 * i4] + sc1[4 * i4 + 1] + sc1[4 * i4 + 2] + sc1[4 * i4 + 3]; if (m + 1 < 32) PBv[(hh * 64 + ql) * 32 + m + 1] = sc1[4 * i4 + 3]; }
            }
        }
    }
    __syncthreads();
    if (tid < 64) {
        const int cur = qb; unsigned msk = 0u;
        for (int it = 0; it < 8; ++it) {
            float best = -INFINITY; int bi = -1;
            for (int m = 0; m < 32; ++m) {
                if ((msk >> m) & 1u) continue;
                float v;
                if (m == 0 || m == cur || m == cur - 1) v = INFINITY;
                else if (m <= cur) { v = 0.f; for (int h2 = 0; h2 < 4; ++h2) v += PA[(h2 * 64 + tid) * 32 + m] + PBv[(h2 * 64 + tid) * 32 + m]; }
                else v = -INFINITY;
                if (v > best) { best = v; bi = m; }
            }
            if (bi >= 0) msk |= 1u << bi;
        }
        SELM[tid] = msk; atomicOr(ORM, msk);
    }
    __syncthreads();
    const unsigned mysel = SELM[ql], orm = *ORM;
    __syncthreads();
    float* PARK = PA + (wv * 32) * 64 + lane;
#pragma unroll
    for (int i = 0; i < 16; ++i) { PARK[i * 64] = fin0[i]; PARK[(16 + i) * 64] = fin1[i]; }
    {
        FlashState st;
#pragma unroll
        for (int i = 0; i < 16; ++i) { st.o0[i] = 0.f; st.o1[i] = 0.f; }
        st.m = -INFINITY; st.l = 0.f;
        const unsigned todo = orm & (qb >= 31 ? 0xFFFFFFFFu : ((2u << qb) - 1u));
        KVRegs kr;
        int m = todo ? __builtin_ctz(todo) : -1;
        if (m >= 0) { kv_fetch(kr, pb, C_KS + g * 64, C_VS + g * 64, m * 64); __syncthreads(); kv_store(kr, KT, VT); __syncthreads(); }
        while (m >= 0) {
            const unsigned rest = todo & ~((2u << m) - 1u); const int nm = (m < 31 && rest) ? __builtin_ctz(rest) : -1;
            if (nm >= 0) kv_fetch(kr, pb, C_KS + g * 64, C_VS + g * 64, nm * 64);
            f32x16 sc0, sc1; qk_tile(KT, qf, qi, hl, sc0, sc1);
            const bool sel = (mysel >> m) & 1u;
            if (m + 3 <= qb) mask_tile<false, false, false, true>(sc0, sc1, lut, qpos, m * 64, hl, sel, QS);
            else mask_tile<true, true, false, true>(sc0, sc1, lut, qpos, m * 64, hl, sel, QS);
            flash_update(st, sc0, sc1, VT, KTS, qi, hl);
            __syncthreads();
            if (nm >= 0) kv_store(kr, KT, VT);
            __syncthreads();
            m = nm;
        }
        const float lt = st.l + shfl_xor_(st.l, 32, lane); const float sc = g1 / fmaxf(lt, 1e-30f);
#pragma unroll
        for (int i = 0; i < 16; ++i) { PARK[i * 64] += st.o0[i] * sc; PARK[(16 + i) * 64] += st.o1[i] * sc; }
    }
    {
        FlashState st;
#pragma unroll
        for (int i = 0; i < 16; ++i) { st.o0[i] = 0.f; st.o1[i] = 0.f; }
        st.m = -INFINITY; st.l = 0.f;
        KVRegs kr;
        int w = qb >= 4 ? 0 : 4 - qb;
        kv_fetch(kr, pb, C_KW + g * 64, C_VW + g * 64, qb * 64 - 256 + 64 * w); __syncthreads(); kv_store(kr, KT, VT); __syncthreads();
        for (; w < 5; ++w) {
            const int k0 = qb * 64 - 256 + 64 * w;
            if (w < 4) kv_fetch(kr, pb, C_KW + g * 64, C_VW + g * 64, k0 + 64);
            f32x16 sc0, sc1; qk_tile(KT, qf, qi, hl, sc0, sc1);
            if (w == 0) mask_tile<false, false, true, false>(sc0, sc1, lut, qpos, k0, hl, true, QS);
            else if (w == 1) mask_tile<false, false, false, false>(sc0, sc1, lut, qpos, k0, hl, true, QS);
            else if (w < 4) mask_tile<true, false, false, false>(sc0, sc1, lut, qpos, k0, hl, true, QS);
            else mask_tile<true, true, false, false>(sc0, sc1, lut, qpos, k0, hl, true, QS);
            flash_update(st, sc0, sc1, VT, KTS, qi, hl);
            __syncthreads();
            if (w < 4) kv_store(kr, KT, VT);
            __syncthreads();
        }
        const float lt = st.l + shfl_xor_(st.l, 32, lane); const float sc = g2 / fmaxf(lt, 1e-30f);
#pragma unroll
        for (int i = 0; i < 16; ++i) { fin0[i] = PARK[i * 64] + st.o0[i] * sc; fin1[i] = PARK[(16 + i) * 64] + st.o1[i] * sc; }
    }
#pragma unroll
    for (int i4 = 0; i4 < 4; ++i4) {
        u32x2 w0; w0.x = pack2(fin0[4 * i4], fin0[4 * i4 + 1]); w0.y = pack2(fin0[4 * i4 + 2], fin0[4 * i4 + 3]);
        u32x2 w1; w1.x = pack2(fin1[4 * i4], fin1[4 * i4 + 1]); w1.y = pack2(fin1[4 * i4 + 2], fin1[4 * i4 + 3]);
        *(u32x2*)(qrow + ocol + head * 64 + 8 * i4 + 4 * hl) = w0;
        *(u32x2*)(qrow + ocol + head * 64 + 32 + 8 * i4 + 4 * hl) = w1;
    }
}

constexpr int PH_PER_LAYER = 17, PH_TOTAL = DEPTH * PH_PER_LAYER + 1;
enum { S_PREP = 0, S_GU1, S_D1, S_NORM_MIX, S_WIN, S_CMP, S_LORA, S_SCAN, S_NSA, S_MERGE, S_OUT, S_NORM2, S_GU2, S_D2, S_NORM_PLE, S_PLE, S_PLEG, S_FINAL };

__device__ __forceinline__ void run_phase(unsigned char* smem, CP p, int ph) {
    const bool fin = (ph == DEPTH * PH_PER_LAYER);
    const int L = fin ? 0 : ph / PH_PER_LAYER; const int sub = fin ? S_FINAL : ph % PH_PER_LAYER;
    unsigned char* ws = p->ws; float* H = p->out;
    bf16_t* W = (bf16_t*)(ws + WS_WBF); bf16_t* UN = (bf16_t*)(ws + WS_UN); bf16_t* PROJ = (bf16_t*)(ws + WS_PROJ); bf16_t* ACT = (bf16_t*)(ws + WS_ACT);
    bf16_t* TMP = (bf16_t*)(ws + WS_TMP); bf16_t* PBF = (bf16_t*)(ws + WS_PB); bf16_t* ORW = (bf16_t*)(ws + WS_ORW);
    bf16_t* XK = (bf16_t*)(ws + WS_XK); bf16_t* XV = (bf16_t*)(ws + WS_XV); float* P01 = (float*)(ws + WS_P01);
    if (sub == S_PREP) convert_layer_weights(smem, p, L);
    if (sub == S_NORM_MIX) convert_ffn2_weights(smem, p, L);
    if (sub == S_NORM_PLE) cvt_f32_bf16(p->in[I_P] + (size_t)L * T_TOK * 256, PBF, (size_t)T_TOK * 256 / 4);
    if (sub == S_CMP) lora_act(p, L);
    if (sub == S_LORA) finalize_cmp(smem, p, L);
    if (sub == S_PREP || sub == S_NORM_MIX || sub == S_NORM2 || sub == S_NORM_PLE || sub == S_FINAL) {
        const float* hin = (sub == S_PREP && L == 0) ? p->in[I_X] : H; float* hcopy = (sub == S_PREP && L == 0) ? H : nullptr;
        const float* g = sub == S_PREP ? p->in[I_F1N] + L * DM : sub == S_NORM_MIX ? p->in[I_MIXN] + L * DM : sub == S_NORM2 ? p->in[I_F2N] + L * DM : sub == S_NORM_PLE ? p->in[I_PLEN] + L * DM : p->in[I_FINN];
        rmsnorm_rows(hin, hcopy, g, sub == S_FINAL ? nullptr : UN, sub == S_FINAL ? H : nullptr);
    } else if (sub == S_GU1 || sub == S_GU2) {
        EpiSwiglu e; e.O = ACT; run_gemm(smem, UN, DM, W + (sub == S_GU1 ? E_GU1 : E_GU2), T_TOK, 2 * DFF, DM, e);
    } else if (sub == S_D1 || sub == S_D2 || sub == S_OUT) {
        EpiResid e; e.H = H; e.scale = sub == S_OUT ? 1.0f : 0.5f;
        run_gemm(smem, sub == S_OUT ? UN : ACT, sub == S_OUT ? DM : DFF, W + (sub == S_D1 ? E_D1 : sub == S_D2 ? E_D2 : E_OUT), T_TOK, DM, sub == S_OUT ? DM : DFF, e);
    } else if (sub == S_WIN) {
        EpiProj e; e.O = PROJ; e.XK = XK; e.XV = XV; run_gemm(smem, UN, DM, W + E_IN, T_TOK, PLD, DM, e);
    } else if (sub == S_CMP) {
#pragma nounroll
        for (int kv = 0; kv < 2; ++kv) { EpiF32 e; e.C = P01 + (size_t)kv * 4096 * 256;
            run_gemm(smem, kv ? XV : XK, 1024, W + E_C1 + (size_t)kv * 256 * 1024, 4096, 256, 1024, e); }
    } else if (sub == S_LORA) {
        EpiLora e; e.EWA = UN; e.G = ORW;
        run_gemm(smem, (const bf16_t*)(ws + WS_LACT), 256, W + E_LORA, T_TOK, 1536, 256, e);
    } else if (sub == S_SCAN) {
        for (int item = bid_(); item < 256; item += gridDim.x) {
            __syncthreads();
            if (item < 128) rwkv_scan(smem, p, L, item >> 3, item & 7); else hgrn_scan(smem, p, L, (item - 128) >> 3, (item - 128) & 7);
        }
    } else if (sub == S_NSA) {
        for (int idx = bid_(), k = 0; idx < 1024; idx += gridDim.x, ++k) {
            const int bg = idx & 31, qq = idx >> 5; const int qb = (k & 1) ? ((qq & ~7) + 7 - (qq & 7)) : qq;
            nsa_item(smem, p, L, bg >> 1, bg & 1, qb, C_NQ);
        }
    } else if (sub == S_MERGE) {
#pragma nounroll
        for (int j = 0; j < 3; ++j) { EpiMerge e; e.MRG = UN; e.PROJ = PROJ; e.J = j;
            const bf16_t* A = j == 0 ? PROJ + C_HQ : (j == 1 ? PROJ + C_NQ : ORW);
            run_gemm(smem, A, j == 2 ? 512 : PLD, W + E_BR + (size_t)j * 1024 * 512, T_TOK, DM, 512, e); }
    } else if (sub == S_PLE) {
        EpiBf16 e; e.O = TMP; run_gemm(smem, PBF, 256, W + E_PW, T_TOK, DM, 256, e);
    } else if (sub == S_PLEG) {
        EpiPleGate e; e.H = H; e.TMP = TMP; run_gemm(smem, UN, DM, W + E_PG, T_TOK, DM, DM, e);
    }
}

__global__ void __launch_bounds__(512, 2) mega_fwd(Params p) {
    extern __shared__ __attribute__((aligned(16))) unsigned char smem[];
    cg::grid_group grid = cg::this_grid();
    for (int ph = p.ph_lo; ph < p.ph_hi; ++ph) {
        CP pp = (CP)__builtin_amdgcn_kernarg_segment_ptr(); asm volatile("" : "+s"(pp));
        run_phase(smem, pp, ph);
        if (ph + 1 < p.ph_hi) grid.sync();
    }
}

#ifndef MULTI_LAUNCH
#define MULTI_LAUNCH 0
#endif

extern "C" void kernel_launch(void* const* d_in, const int* in_sizes, int n_in, void* d_out, int out_size, void* d_ws, size_t ws_size, hipStream_t stream) {
    static int grid = 0;
    if (grid == 0) {
        if (n_in != N_INPUTS || out_size != T_TOK * DM || ws_size < WS_END) { fprintf(stderr, "kernel_launch: unexpected shapes: n_in %d out %d ws %zu (need %zu)\n", n_in, out_size, ws_size, (size_t)WS_END); grid = -1; return; }
        int dev = 0, cus = 0, per_cu = 0;
        (void)hipGetDevice(&dev); (void)hipDeviceGetAttribute(&cus, hipDeviceAttributeMultiprocessorCount, dev);
        if (hipFuncSetAttribute((const void*)mega_fwd, hipFuncAttributeMaxDynamicSharedMemorySize, LDS_BYTES) != hipSuccess) { fprintf(stderr, "kernel_launch: hipFuncSetAttribute failed\n"); grid = -1; return; }
        if (hipOccupancyMaxActiveBlocksPerMultiprocessor(&per_cu, (const void*)mega_fwd, 512, LDS_BYTES) != hipSuccess || per_cu < 1) { fprintf(stderr, "kernel_launch: occupancy query gives %d\n", per_cu); per_cu = 1; }
        (void)hipGetLastError();
        grid = cus * 1;
        if (grid > 256) grid = 256;
        fprintf(stderr, "kernel_launch: grid %d (cus %d, per_cu %d)\n", grid, cus, per_cu);
    }
    if (grid < 0) return;
    Params p{};
    for (int i = 0; i < N_INPUTS; ++i) p.in[i] = (const float*)d_in[i];
    p.out = (float*)d_out; p.ws = (unsigned char*)d_ws;
#if MULTI_LAUNCH
    for (int ph = 0; ph < PH_TOTAL; ++ph) { p.ph_lo = ph; p.ph_hi = ph + 1; hipLaunchKernelGGL(mega_fwd, dim3(grid), dim3(512), LDS_BYTES, stream, p); }
#else
    p.ph_lo = 0; p.ph_hi = PH_TOTAL;
    void* args[] = {&p};
    hipError_t e = hipLaunchCooperativeKernel((const void*)mega_fwd, dim3(grid), dim3(512), args, LDS_BYTES, stream);
    if (e != hipSuccess) fprintf(stderr, "kernel_launch: cooperative launch failed: %s\n", hipGetErrorString(e));
#endif
}
```

```cpp
#include <hip/hip_runtime.h>
#include <hip/hip_cooperative_groups.h>
#include <cstdio>
namespace cg = cooperative_groups;

#define LAS __attribute__((address_space(3)))
#define DI __device__ __forceinline__
typedef unsigned short bf16_t;
typedef short bf16x8 __attribute__((ext_vector_type(8)));
typedef float f32x4 __attribute__((ext_vector_type(4)));
typedef float f32x2 __attribute__((ext_vector_type(2)));
typedef float f32x16 __attribute__((ext_vector_type(16)));
typedef unsigned u32x4 __attribute__((ext_vector_type(4)));
typedef unsigned u32x2 __attribute__((ext_vector_type(2)));

constexpr int T_TOK = 32768, SEQ = 2048, NB = 16, DM = 1024, DFF = 2816, DEPTH = 4;
constexpr int PLD = 8448;
constexpr int C_HQ = 0, C_HF = 512, C_HI = 1024, C_HG = 1536, C_NQ = 2048, C_KC = 2560, C_VC = 2688, C_KS = 2816, C_VS = 2944,
              C_KW = 3072, C_VW = 3200, C_NG = 3328, C_RW = 3352, C_MG = 5376, IN_REAL = 5144, IN_COLS = 8216;
enum { I_X = 0, I_P, I_F1N, I_F1GU, I_F1D, I_MIXN, I_WIN, I_HGLB, I_HGN, I_PE, I_CW1, I_CW2, I_RELB, I_MU, I_W0, I_WB, I_A0, I_AB, I_GB,
       I_KK, I_KA, I_RK, I_LNW, I_LNB, I_WBR, I_WOUT, I_F2N, I_F2GU, I_F2D, I_PLEN, I_PLEG, I_PLEW, I_FINN, N_INPUTS };

constexpr size_t WS_BAR = 0;
constexpr size_t WS_PEB = 16384;
constexpr size_t WS_WBF = 20480;
constexpr size_t E_GU1 = 0, E_D1 = E_GU1 + 5632ull * 1024, E_IN = E_D1 + 1024ull * 2816, E_BR = E_IN + 8448ull * 1024, E_OUT = E_BR + 3ull * 1024 * 512,
                 E_GU2 = E_GU1, E_D2 = E_D1  , E_PG = E_OUT + 1024ull * 1024, E_PW = E_PG + 1024ull * 1024,
                 E_C1 = E_PW + 1024ull * 256, E_LORA = E_C1 + 2ull * 256 * 1024, E_END = E_LORA + 1536ull * 256;
constexpr size_t WS_UN = WS_WBF + E_END * 2;
constexpr size_t WS_ORW = WS_UN + (size_t)T_TOK * 1024 * 2;
constexpr size_t WS_XK = WS_ORW + (size_t)T_TOK * 512 * 2;
constexpr size_t WS_XV = WS_XK + 4096ull * 1024 * 2;
constexpr size_t WS_P01 = WS_XV + 4096ull * 1024 * 2;
constexpr size_t WS_KC = WS_P01 + 2ull * 4096 * 256 * 4;
constexpr size_t WS_LACT = WS_KC + 2ull * 16 * 2 * 128 * 64 * 4;
constexpr size_t WS_PROJ = WS_LACT + (size_t)T_TOK * 256 * 2;
constexpr size_t WS_END = WS_PROJ + (size_t)T_TOK * PLD * 2;
constexpr size_t WS_ACT = WS_PROJ;
constexpr size_t WS_PB = WS_PROJ + 200ull * 1024 * 1024;
constexpr size_t WS_TMP = WS_PROJ + 256ull * 1024 * 1024;
constexpr int LDS_BYTES = 144 * 1024;

struct Params {
    const float* in[N_INPUTS];
    float* out;
    unsigned char* ws;
    int ph_lo, ph_hi;
};
typedef const Params __attribute__((address_space(4)))* CP;

DI int tid_() { int t = threadIdx.x; asm volatile("" : "+v"(t)); return t; }
DI int bid_() { int b = blockIdx.x; asm volatile("" : "+s"(b)); return b; }
typedef __bf16 bf16v2 __attribute__((ext_vector_type(2)));
DI float bf2f(bf16_t b) { return __uint_as_float(((unsigned)b) << 16); }
DI unsigned pack2(float lo, float hi) { const f32x2 v = {lo, hi}; return __builtin_bit_cast(unsigned, __builtin_convertvector(v, bf16v2)); }
DI bf16_t f2bf(float f) { return (bf16_t)(pack2(f, 0.f) & 0xFFFFu); }
DI float sigmoidf_(float x) { return 1.0f / (1.0f + __expf(-x)); }
DI float siluf_(float x) { return x / (1.0f + __expf(-x)); }
DI float shfl_xor_(float v, int mask, int lane) { return __int_as_float(__builtin_amdgcn_ds_bpermute((lane ^ mask) << 2, __float_as_int(v))); }
DI float dppf_(float v, int) { return v; }
#define DPPF(v, ctrl) __int_as_float(__builtin_amdgcn_mov_dpp(__float_as_int(v), ctrl, 0xF, 0xF, true))
DI float wave_sum(float v) {
    v += DPPF(v, 0xB1); v += DPPF(v, 0x4E); v += DPPF(v, 0x141); v += DPPF(v, 0x140);
    const float s0 = __int_as_float(__builtin_amdgcn_readlane(__float_as_int(v), 0)), s1 = __int_as_float(__builtin_amdgcn_readlane(__float_as_int(v), 16));
    const float s2 = __int_as_float(__builtin_amdgcn_readlane(__float_as_int(v), 32)), s3 = __int_as_float(__builtin_amdgcn_readlane(__float_as_int(v), 48));
    return (s0 + s1) + (s2 + s3);
}

namespace pg8 {
constexpr int BM = 256, BK = 64, HALF = 128, HTB = HALF * BK * 2, STAGE_BYTES = 8 * HTB, NXCD = 8, WGM = 8;
DI int lds_byte(int r, int c) { const int st = (r >> 4) * 2 + (c >> 5), rr = r & 15, cc = c & 31, ob = rr * 64 + cc * 2; return st * 1024 + (ob ^ (((ob >> 9) & 1) << 5)); }
DI void stage_rc(int b, int& R, int& C) { const int st = b / 1024, sb = b % 1024, swz = sb ^ (((sb >> 9) & 1) << 5); R = (st >> 1) * 16 + swz / 64; C = (st & 1) * 32 + (swz % 64) / 2; }
DI int perm32(int rho) { const int n = rho >> 4, i = rho & 15; return 8 * (i >> 2) + 4 * n + (i & 3); }
struct Unit { int pm, pn; };
struct Gemm { const bf16_t* A; const bf16_t* Bt; int M, N, K, lda; };
struct StaticOrder {
    int nM, nN, nwg, G, c;
    DI void init(int M, int N, int G_, int c_) { nM = M / BM; nN = N / BM; nwg = nM * nN; G = G_; c = c_; }
    DI bool next(int i, Unit& u) const {
        const long L = (long)i * G + c; if (L >= nwg) return false;
        int wgid = (int)L; { const int q = nwg / NXCD, r = nwg % NXCD, xcd = wgid % NXCD, off = wgid / NXCD; wgid = (xcd < r ? xcd * (q + 1) : r * (q + 1) + (xcd - r) * q) + off; }
        const int nig = WGM * nN, gid = wgid / nig, fm = gid * WGM, gsz = (nM - fm) < WGM ? (nM - fm) : WGM;
        u.pm = fm + ((wgid % nig) % gsz); u.pn = (wgid % nig) / gsz; return true;
    }
};

template <class Epi>
DI void gemm_phase(LAS unsigned char* lds, const Gemm g, const StaticOrder& S, const Epi& E) {
    int tid = tid_();
    const int wid = __builtin_amdgcn_readfirstlane(tid >> 6), lane = tid & 63, wr = wid >> 2, wc = wid & 3, fr = lane & 15, fq = lane >> 4;
    const int K = g.K, nt = K / BK, lda = g.lda;
    unsigned voffA[2], voffB[2];
#pragma unroll
    for (int i = 0; i < 2; ++i) { int R, C; stage_rc(tid * 16 + i * 8192, R, C); const int Rb = Epi::PERM ? ((R & ~31) + perm32(R & 31)) : R;
        voffA[i] = (unsigned)(R * lda + C) * 2u; voffB[i] = (unsigned)(Rb * K + C) * 2u; }
    const size_t kstep = (size_t)(BK * 2);
    const size_t hstepA = (size_t)HALF * lda * 2, hstepB = (size_t)HALF * K * 2;
    const size_t tstepA = 2 * hstepA, tstepB = 2 * hstepB;
    const unsigned ldsw = (unsigned)wid * 1024u;
    const int aoff = lds_byte(wr * 64 + fr, fq * 8), boff = lds_byte(wc * 32 + fr, fq * 8);
#define PG8_SA(b, h) (((b) * 2 + (h)) * HTB)
#define PG8_SB(b, h) ((4 + (b) * 2 + (h)) * HTB)
#define PG8_STAGE(bufoff, gbase, voff) do { _Pragma("unroll") for (int _i = 0; _i < 2; ++_i) \
        __builtin_amdgcn_global_load_lds((const unsigned*)((const char*)(gbase) + (voff)[_i]), (LAS unsigned*)(lds + (bufoff) + ldsw + _i * 8192), 16, 0, 0); } while (0)
#define PG8_LDA(dst, b, h) do { _Pragma("unroll") for (int m = 0; m < 4; ++m) _Pragma("unroll") for (int k = 0; k < 2; ++k) dst[m][k] = *(const LAS bf16x8*)(lds + PG8_SA(b, h) + aoff + m * 2048 + k * 1024); } while (0)
#define PG8_LDB(dst, b, h) do { _Pragma("unroll") for (int n = 0; n < 2; ++n) _Pragma("unroll") for (int k = 0; k < 2; ++k) dst[n][k] = *(const LAS bf16x8*)(lds + PG8_SB(b, h) + boff + n * 2048 + k * 1024); } while (0)
#define PG8_MMA(ai, bj, At, Bt) do { __builtin_amdgcn_s_setprio(1); _Pragma("unroll") for (int m = 0; m < 4; ++m) _Pragma("unroll") for (int n = 0; n < 2; ++n) _Pragma("unroll") for (int k = 0; k < 2; ++k) \
        acc[ai][bj][m][n] = __builtin_amdgcn_mfma_f32_16x16x32_bf16(Bt[n][k], At[m][k], acc[ai][bj][m][n], 0, 0, 0); __builtin_amdgcn_s_setprio(0); } while (0)
#define PG8_WAIT_V(n) asm volatile("s_waitcnt vmcnt(" #n ")" ::: "memory")
#define PG8_WAIT_L(n) asm volatile("s_waitcnt lgkmcnt(" #n ")" ::: "memory")
#define PG8_BAR __builtin_amdgcn_s_barrier()
#define PG8_SCHED __builtin_amdgcn_sched_barrier(0)
    Unit cur, nxt; int ui = 0;
    if (!S.next(0, cur)) return;
    f32x4 acc[2][2][4][2];
#pragma unroll
    for (int a = 0; a < 2; ++a)
#pragma unroll
        for (int b = 0; b < 2; ++b)
#pragma unroll
            for (int m = 0; m < 4; ++m)
#pragma unroll
                for (int n = 0; n < 2; ++n) acc[a][b][m][n] = (f32x4){0.f, 0.f, 0.f, 0.f};
    bf16x8 At[4][2], B0[2][2], B1[2][2];
    const char* cA = (const char*)g.A + (size_t)cur.pm * tstepA; const char* cB = (const char*)g.Bt + (size_t)cur.pn * tstepB;
    PG8_STAGE(PG8_SB(0, 0), cB, voffB); PG8_STAGE(PG8_SA(0, 0), cA, voffA); PG8_STAGE(PG8_SB(0, 1), cB + hstepB, voffB); PG8_STAGE(PG8_SA(0, 1), cA + hstepA, voffA);
    if (wr == 1) PG8_BAR;
    PG8_WAIT_V(4); PG8_BAR;
    PG8_STAGE(PG8_SB(1, 0), cB + kstep, voffB); PG8_STAGE(PG8_SA(1, 0), cA + kstep, voffA); PG8_STAGE(PG8_SB(1, 1), cB + hstepB + kstep, voffB);
    PG8_WAIT_V(6); PG8_BAR;
    for (;;) {
        const bool has_next = S.next(ui + 1, nxt);
        const char* nA = has_next ? (const char*)g.A + (size_t)nxt.pm * tstepA : cA; const char* nB = has_next ? (const char*)g.Bt + (size_t)nxt.pn * tstepB : cB;
        for (int t = 0; t < nt; t += 2) {
            const bool last = (t == nt - 2);
            const char* a1 = cA + (size_t)(t + 1) * kstep;
            const char* a2 = last ? nA : cA + (size_t)(t + 2) * kstep; const char* b2 = last ? nB : cB + (size_t)(t + 2) * kstep;
            const char* a3 = a2 + kstep; const char* b3 = b2 + kstep;
            PG8_LDB(B0, 0, 0); PG8_SCHED; PG8_LDA(At, 0, 0); PG8_STAGE(PG8_SA(1, 1), a1 + hstepA, voffA);
            PG8_WAIT_L(8); PG8_BAR; PG8_WAIT_L(0); PG8_MMA(0, 0, At, B0); PG8_BAR; PG8_SCHED;
            PG8_LDB(B1, 0, 1); PG8_STAGE(PG8_SB(0, 0), b2, voffB);
            PG8_BAR; PG8_WAIT_L(0); PG8_MMA(0, 1, At, B1); PG8_BAR;
            PG8_LDA(At, 0, 1); PG8_STAGE(PG8_SA(0, 0), a2, voffA);
            PG8_BAR; PG8_WAIT_L(0); PG8_MMA(1, 0, At, B0); PG8_BAR; PG8_SCHED;
            PG8_STAGE(PG8_SB(0, 1), b2 + hstepB, voffB);
            PG8_WAIT_V(6); PG8_BAR; PG8_MMA(1, 1, At, B1); PG8_BAR;
            PG8_LDB(B0, 1, 0); PG8_SCHED; PG8_LDA(At, 1, 0); PG8_STAGE(PG8_SA(0, 1), a2 + hstepA, voffA);
            PG8_WAIT_L(8); PG8_BAR; PG8_WAIT_L(0); PG8_MMA(0, 0, At, B0); PG8_BAR; PG8_SCHED;
            PG8_LDB(B1, 1, 1); PG8_STAGE(PG8_SB(1, 0), b3, voffB);
            PG8_BAR; PG8_WAIT_L(0); PG8_MMA(0, 1, At, B1); PG8_BAR;
            PG8_LDA(At, 1, 1); PG8_STAGE(PG8_SA(1, 0), a3, voffA);
            PG8_BAR; PG8_WAIT_L(0); PG8_MMA(1, 0, At, B0); PG8_BAR; PG8_SCHED;
            PG8_STAGE(PG8_SB(1, 1), b3 + hstepB, voffB);
            PG8_WAIT_V(6); PG8_BAR; PG8_MMA(1, 1, At, B1); PG8_BAR;
        }
        E(acc, cur, wr, wc, fr, fq);
        if (!has_next) break;
#pragma unroll
        for (int a = 0; a < 2; ++a)
#pragma unroll
            for (int b = 0; b < 2; ++b)
#pragma unroll
                for (int m = 0; m < 4; ++m)
#pragma unroll
                    for (int n = 0; n < 2; ++n) acc[a][b][m][n] = (f32x4){0.f, 0.f, 0.f, 0.f};
        cur = nxt; cA = nA; cB = nB; ++ui;
    }
    PG8_WAIT_V(0);
    if (wr == 0) PG8_BAR;
    PG8_BAR;
#undef PG8_SA
#undef PG8_SB
#undef PG8_STAGE
#undef PG8_LDA
#undef PG8_LDB
#undef PG8_MMA
#undef PG8_WAIT_V
#undef PG8_WAIT_L
#undef PG8_BAR
#undef PG8_SCHED
}
}

typedef f32x4 AccT[2][2][4][2];
#define EPI_LANE const int t_ = tid_(), wid_ = t_ >> 6, ln_ = t_ & 63, wr_ = wid_ >> 2, wc_ = wid_ & 3, fr_ = ln_ & 15, fq_ = ln_ >> 4;
#define EPI_LOOP_PERM(...) EPI_LANE \
    const int row0 = u.pm * 256 + wr_ * 64 + fr_, col0 = u.pn * 256 + wc_ * 32 + 8 * fq_; \
    _Pragma("unroll") for (int ai = 0; ai < 2; ++ai) _Pragma("unroll") for (int m = 0; m < 4; ++m) { const int row = row0 + ai * 128 + m * 16; \
        _Pragma("unroll") for (int bj = 0; bj < 2; ++bj) { const int col = col0 + bj * 128; const f32x4 v0 = acc[ai][bj][m][0], v1 = acc[ai][bj][m][1]; __VA_ARGS__ } }
#define EPI_LOOP_NAT(...) EPI_LANE \
    const int row0 = u.pm * 256 + wr_ * 64 + fr_, col0 = u.pn * 256 + wc_ * 32 + 4 * fq_; \
    _Pragma("unroll") for (int ai = 0; ai < 2; ++ai) _Pragma("unroll") for (int m = 0; m < 4; ++m) { const int row = row0 + ai * 128 + m * 16; \
        _Pragma("unroll") for (int bj = 0; bj < 2; ++bj) _Pragma("unroll") for (int n = 0; n < 2; ++n) { const int col = col0 + bj * 128 + n * 16; const f32x4 v = acc[ai][bj][m][n]; __VA_ARGS__ } }

struct EpiSwiglu { static constexpr bool PERM = true; bf16_t* O;
    DI void operator()(const AccT& acc, const pg8::Unit& u, int wr, int wc, int fr, int fq) const {
        EPI_LOOP_PERM({ u32x2 w; w.x = pack2(siluf_(v0[0]) * v1[0], siluf_(v0[1]) * v1[1]); w.y = pack2(siluf_(v0[2]) * v1[2], siluf_(v0[3]) * v1[3]);
            *(u32x2*)(O + (size_t)row * DFF + (col >> 1)) = w; })
    } };
struct EpiResid { static constexpr bool PERM = false; float* H; float scale;
    DI void operator()(const AccT& acc, const pg8::Unit& u, int wr, int wc, int fr, int fq) const {
        EPI_LOOP_NAT({ f32x4* p = (f32x4*)(H + (size_t)row * DM + col); *p = *p + v * scale; })
    } };
struct EpiProj { static constexpr bool PERM = true; bf16_t* O; bf16_t* XK; bf16_t* XV;
    DI void operator()(const AccT& acc, const pg8::Unit& u, int wr, int wc, int fr, int fq) const {
        const bool is_mg = u.pn * 256 >= C_MG, is_cmp = (u.pn == 10);
        EPI_LOOP_PERM({ f32x4 a = v0, b = v1;
            if (is_mg) { for (int j = 0; j < 4; ++j) { a[j] = sigmoidf_(a[j]); b[j] = sigmoidf_(b[j]); } }
            u32x4 w; w.x = pack2(a[0], a[1]); w.y = pack2(a[2], a[3]); w.z = pack2(b[0], b[1]); w.w = pack2(b[2], b[3]);
            *(u32x4*)(O + (size_t)row * PLD + col) = w;
            if (is_cmp) { const int c = col - C_KC, kv = c >> 7, gg = (c >> 6) & 1, d = c & 63, bb = row >> 11, s = row & 2047, jj = s >> 4, l = s & 15;
                bf16_t* X = kv ? XV : XK; *(u32x4*)(X + ((size_t)((bb * 128 + jj) * 2 + gg)) * 1024 + l * 64 + d) = w; } })
    } };
struct EpiMerge { static constexpr bool PERM = true; bf16_t* MRG; const bf16_t* PROJ; int J;
    DI void operator()(const AccT& acc, const pg8::Unit& u, int wr, int wc, int fr, int fq) const {
        EPI_LOOP_PERM({ const u32x4 gt = *(const u32x4*)(PROJ + (size_t)row * PLD + C_MG + J * 1024 + col);
            u32x4* mp = (u32x4*)(MRG + (size_t)row * DM + col); u32x4 old = (u32x4){0u, 0u, 0u, 0u}; if (J > 0) old = *mp;
            float r[8]; const float x[8] = {v0[0], v0[1], v0[2], v0[3], v1[0], v1[1], v1[2], v1[3]};
            _Pragma("unroll") for (int j = 0; j < 8; ++j) { const unsigned gw = gt[j >> 1], ow = old[j >> 1];
                const float gf = (j & 1) ? __uint_as_float(gw & 0xFFFF0000u) : __uint_as_float(gw << 16);
                const float of = (j & 1) ? __uint_as_float(ow & 0xFFFF0000u) : __uint_as_float(ow << 16);
                r[j] = of + gf * x[j]; }
            u32x4 w; w.x = pack2(r[0], r[1]); w.y = pack2(r[2], r[3]); w.z = pack2(r[4], r[5]); w.w = pack2(r[6], r[7]); *mp = w; })
    } };
struct EpiF32 { static constexpr bool PERM = false; float* C; static constexpr int ldc = 256;
    DI void operator()(const AccT& acc, const pg8::Unit& u, int wr, int wc, int fr, int fq) const {
        EPI_LOOP_NAT({ *(f32x4*)(C + (size_t)row * ldc + col) = v; })
    } };
struct EpiBf16 { static constexpr bool PERM = true; bf16_t* O; static constexpr int ldc = DM;
    DI void operator()(const AccT& acc, const pg8::Unit& u, int wr, int wc, int fr, int fq) const {
        EPI_LOOP_PERM({ u32x4 w; w.x = pack2(v0[0], v0[1]); w.y = pack2(v0[2], v0[3]); w.z = pack2(v1[0], v1[1]); w.w = pack2(v1[2], v1[3]);
            *(u32x4*)(O + (size_t)row * ldc + col) = w; })
    } };
struct EpiPleGate { static constexpr bool PERM = false; float* H; const bf16_t* TMP;
    DI void operator()(const AccT& acc, const pg8::Unit& u, int wr, int wc, int fr, int fq) const {
        EPI_LOOP_NAT({ const u32x2 tw = *(const u32x2*)(TMP + (size_t)row * DM + col); f32x4* p = (f32x4*)(H + (size_t)row * DM + col); f32x4 h = *p;
            h[0] += sigmoidf_(v[0]) * __uint_as_float(tw.x << 16); h[1] += sigmoidf_(v[1]) * __uint_as_float(tw.x & 0xFFFF0000u);
            h[2] += sigmoidf_(v[2]) * __uint_as_float(tw.y << 16); h[3] += sigmoidf_(v[3]) * __uint_as_float(tw.y & 0xFFFF0000u); *p = h; })
    } };

struct EpiLora { static constexpr bool PERM = true; bf16_t* EWA; bf16_t* G;
    DI void operator()(const AccT& acc, const pg8::Unit& u, int wr, int wc, int fr, int fq) const {
        const bool isg = u.pn >= 4; bf16_t* O = isg ? G - 1024 : EWA; const int ld = isg ? 512 : 1024;
        EPI_LOOP_PERM({ u32x4 w; w.x = pack2(v0[0], v0[1]); w.y = pack2(v0[2], v0[3]); w.z = pack2(v1[0], v1[1]); w.w = pack2(v1[2], v1[3]);
            *(u32x4*)(O + (size_t)row * ld + col) = w; })
    } };

template <class Epi> DI void run_gemm(unsigned char* smem, const bf16_t* A, int lda, const bf16_t* Bt, int M, int N, int K, const Epi& E) {
    __syncthreads();
    pg8::Gemm g; g.A = A; g.Bt = Bt; g.M = M; g.N = N; g.K = K; g.lda = lda;
    pg8::StaticOrder S; S.init(M, N, (int)gridDim.x, bid_());
    pg8::gemm_phase<Epi>((LAS unsigned char*)smem, g, S, E);
    __syncthreads();
}

struct MapId { DI int operator()(int n) const { return n; } };
struct MapGU { DI int operator()(int n) const { const int q = n >> 3, e = n & 7; return e < 4 ? 4 * q + e : DFF + 4 * q + (e - 4); } };
struct MapIn { DI int operator()(int n) const { return n < IN_REAL ? n : (n < C_MG ? -1 : n - (C_MG - IN_REAL)); } };
template <class Map> __device__ __forceinline__ void transpose_cvt(unsigned char* smem, const float* src, int ldsrc, bf16_t* dst, int K, int Nd, Map map) {
    float* tile = (float*)smem;
    const int tid = tid_(), ntk = K / 64, nt = ntk * (Nd / 64);
    for (int t = bid_(); t < nt; t += gridDim.x) {
        const int n0 = (t / ntk) * 64, k0 = (t % ntk) * 64;
        const int nn = tid & 63, sc = map(n0 + nn);
#pragma unroll
        for (int p = 0; p < 8; ++p) { const int kk = (tid >> 6) + p * 8; tile[kk * 65 + nn] = sc >= 0 ? src[(size_t)(k0 + kk) * ldsrc + sc] : 0.f; }
        __syncthreads();
#pragma unroll
        for (int p = 0; p < 4; ++p) { const int nn2 = (tid >> 5) + p * 16, kk2 = (tid & 31) * 2;
            *(unsigned*)(dst + (size_t)(n0 + nn2) * K + k0 + kk2) = pack2(tile[kk2 * 65 + nn2], tile[(kk2 + 1) * 65 + nn2]); }
        __syncthreads();
    }
}
__device__ __forceinline__ void convert_layer_weights(unsigned char* smem, CP p, int L) {
    bf16_t* W = (bf16_t*)(p->ws + WS_WBF);
    transpose_cvt(smem, p->in[I_F1GU] + (size_t)L * DM * 2 * DFF, 2 * DFF, W + E_GU1, DM, 2 * DFF, MapGU());
    transpose_cvt(smem, p->in[I_F1D] + (size_t)L * DFF * DM, DM, W + E_D1, DFF, DM, MapId());
    transpose_cvt(smem, p->in[I_WIN] + (size_t)L * DM * IN_COLS, IN_COLS, W + E_IN, DM, PLD, MapIn());
    for (int j = 0; j < 3; ++j) transpose_cvt(smem, p->in[I_WBR] + ((size_t)L * 3 + j) * 512 * DM, DM, W + E_BR + (size_t)j * 1024 * 512, 512, DM, MapId());
    transpose_cvt(smem, p->in[I_WOUT] + (size_t)L * DM * DM, DM, W + E_OUT, DM, DM, MapId());
    for (int i = bid_() * 512 + tid_(); i < 1536 * 256; i += gridDim.x * 512) { const int n = i >> 8, k = i & 255; float w = 0.f;
        if (n < 512) { if (k < 64) w = p->in[I_WB][((size_t)L * 64 + k) * 512 + n]; }
        else if (n < 1024) { if (k >= 64 && k < 128) w = p->in[I_AB][((size_t)L * 64 + (k - 64)) * 512 + (n - 512)]; }
        else { if (k >= 128) w = p->in[I_GB][((size_t)L * 128 + (k - 128)) * 512 + (n - 1024)]; }
        W[E_LORA + i] = f2bf(w); }
    transpose_cvt(smem, p->in[I_PLEG] + (size_t)L * DM * DM, DM, W + E_PG, DM, DM, MapId());
    transpose_cvt(smem, p->in[I_PLEW] + (size_t)L * 256 * DM, DM, W + E_PW, 256, DM, MapId());
    for (int kv = 0; kv < 2; ++kv) for (int hf = 0; hf < 2; ++hf)
        transpose_cvt(smem, p->in[I_CW1] + ((size_t)(L * 2 + kv) * 2048 + hf * 1024) * 128, 128, W + E_C1 + ((size_t)kv * 256 + hf * 128) * 1024, 1024, 128, MapId());
    if (bid_() == gridDim.x - 1 && tid_() < 256) {
        const int kv = tid_() >> 7, hc = tid_() & 127;
        const float* pe = p->in[I_PE] + (size_t)(L * 2 + kv) * 2048; const float* w1 = p->in[I_CW1] + (size_t)(L * 2 + kv) * 2048 * 128 + hc;
        float s = 0.f; for (int i = 0; i < 2048; ++i) s += pe[i] * w1[(size_t)i * 128];
        ((float*)(p->ws + WS_PEB))[kv * 128 + hc] = s;
    }
}

__device__ __forceinline__ void convert_ffn2_weights(unsigned char* smem, CP p, int L) {
    bf16_t* W = (bf16_t*)(p->ws + WS_WBF);
    transpose_cvt(smem, p->in[I_F2GU] + (size_t)L * DM * 2 * DFF, 2 * DFF, W + E_GU2, DM, 2 * DFF, MapGU());
    transpose_cvt(smem, p->in[I_F2D] + (size_t)L * DFF * DM, DM, W + E_D2, DFF, DM, MapId());
}
__device__ __forceinline__ void lora_act(CP p, int L) {
    const bf16_t* PROJ = (const bf16_t*)(p->ws + WS_PROJ); bf16_t* LACT = (bf16_t*)(p->ws + WS_LACT);
    const float* mu = p->in[I_MU] + (size_t)L * 1792 + 1536;
    for (int i = bid_() * 512 + tid_(); i < T_TOK * 32; i += gridDim.x * 512) {
        const int t = i >> 5, j0 = (i & 31) * 8; const bf16_t* row = PROJ + (size_t)t * PLD + C_RW + 1536 + j0;
        const u32x4 cur = *(const u32x4*)row; u32x4 prv = {0u, 0u, 0u, 0u}; if ((t & (SEQ - 1)) != 0) prv = *(const u32x4*)(row - PLD);
        float r[8];
#pragma unroll
        for (int e = 0; e < 8; ++e) { const float x1 = (e & 1) ? __uint_as_float(cur[e >> 1] & 0xFFFF0000u) : __uint_as_float(cur[e >> 1] << 16);
            const float xp = (e & 1) ? __uint_as_float(prv[e >> 1] & 0xFFFF0000u) : __uint_as_float(prv[e >> 1] << 16);
            float xm = x1 + (xp - x1) * mu[j0 + e];
            if (j0 < 64) xm = tanhf(xm); else if (j0 >= 128) xm = sigmoidf_(xm);
            r[e] = xm; }
        u32x4 w; w.x = pack2(r[0], r[1]); w.y = pack2(r[2], r[3]); w.z = pack2(r[4], r[5]); w.w = pack2(r[6], r[7]);
        *(u32x4*)(LACT + (size_t)t * 256 + j0) = w;
    }
}

__device__ __forceinline__ void rmsnorm_rows(const float* hin, float* hcopy, const float* g, bf16_t* un, float* outf) {
    const int lane = tid_() & 63, gw = bid_() * 8 + (tid_() >> 6), nw = gridDim.x * 8;
    f32x4 gv[4];
#pragma unroll
    for (int i = 0; i < 4; ++i) gv[i] = *(const f32x4*)(g + lane * 4 + i * 256);
    for (int row = gw; row < T_TOK; row += nw) {
        f32x4 x[4]; float ss = 0.f;
#pragma unroll
        for (int i = 0; i < 4; ++i) { x[i] = *(const f32x4*)(hin + (size_t)row * DM + lane * 4 + i * 256); ss += x[i][0] * x[i][0] + x[i][1] * x[i][1] + x[i][2] * x[i][2] + x[i][3] * x[i][3]; }
        ss = wave_sum(ss);
        const float rs = rsqrtf(ss * (1.0f / DM) + 1e-6f);
#pragma unroll
        for (int i = 0; i < 4; ++i) {
            const f32x4 y = x[i] * rs * gv[i];
            if (hcopy) *(f32x4*)(hcopy + (size_t)row * DM + lane * 4 + i * 256) = x[i];
            if (un) { u32x2 w; w.x = pack2(y[0], y[1]); w.y = pack2(y[2], y[3]); *(u32x2*)(un + (size_t)row * DM + lane * 4 + i * 256) = w; }
            if (outf) *(f32x4*)(outf + (size_t)row * DM + lane * 4 + i * 256) = y;
        }
    }
}
__device__ __forceinline__ void cvt_f32_bf16(const float* src, bf16_t* dst, size_t n4) {
    for (size_t i = (size_t)bid_() * 512 + tid_(); i < n4; i += (size_t)gridDim.x * 512) {
        const f32x4 v = *(const f32x4*)(src + i * 4); u32x2 w; w.x = pack2(v[0], v[1]); w.y = pack2(v[2], v[3]); *(u32x2*)(dst + i * 4) = w; }
}

__device__ __forceinline__ void finalize_cmp(unsigned char* smem, CP p, int L) {
    float* hid = (float*)smem + (tid_() >> 6) * 128;
    const int lane = tid_() & 63, gw = bid_() * 8 + (tid_() >> 6), nw = gridDim.x * 8;
    const float* peb = (const float*)(p->ws + WS_PEB);
    const int total = 2 * 16 * 2 * 128, iters = (total + nw - 1) / nw;
    for (int it = 0; it < iters; ++it) {
        const int id = gw + it * nw; const bool ok = id < total;
        const int n = id & 127, gg = (id >> 7) & 1, bb = (id >> 8) & 15, kv = (id >> 12) & 1;
        if (ok && n < 127) {
            const float* Pm = (const float*)(p->ws + WS_P01) + (size_t)kv * 4096 * 256;
            const size_t r0 = (size_t)((bb * 128 + n) * 2 + gg) * 256, r1 = (size_t)((bb * 128 + n + 1) * 2 + gg) * 256;
#pragma unroll
            for (int q = 0; q < 2; ++q) { const int hc = lane + q * 64; hid[hc] = siluf_(Pm[r0 + hc] + Pm[r1 + 128 + hc] + peb[kv * 128 + hc]); }
        }
        __syncthreads();
        if (ok) {
            float o = 0.f;
            if (n < 127) { const float* w2 = p->in[I_CW2] + (size_t)(L * 2 + kv) * 128 * 64 + lane;
                for (int hc = 0; hc < 128; ++hc) o += hid[hc] * w2[hc * 64]; }
            ((float*)(p->ws + WS_KC))[((((size_t)kv * 16 + bb) * 2 + gg) * 128 + n) * 64 + lane] = o;
        }
        __syncthreads();
    }
}

__device__ __forceinline__ void hgrn_scan(unsigned char* smem, CP p, int L, int b, int h) {
    float* F = (float*)smem; float* Kx = F + 2048; float* Q = Kx + 2048; float* V = Q + 2048; float* PO = V + 2048;
    const int tid = tid_(), e = tid & 63, wv = tid >> 6, C = h * 64 + e;
    float lb;
    { const float* hl = p->in[I_HGLB]; const float a0 = hl[C], a1 = hl[512 + C], a2 = hl[1024 + C], a3 = hl[1536 + C];
      const float mx = fmaxf(fmaxf(a0, a1), fmaxf(a2, a3)); const float e0 = __expf(a0 - mx), e1 = __expf(a1 - mx), e2 = __expf(a2 - mx), e3 = __expf(a3 - mx);
      const float inv = 1.0f / (e0 + e1 + e2 + e3); float acc = 0.f; if (L >= 1) acc += e1; if (L >= 2) acc += e2; if (L >= 3) acc += e3; lb = fmaxf(acc * inv, 0.f); }
    const float ng = p->in[I_HGN][L * 512 + C];
    bf16_t* base = (bf16_t*)(p->ws + WS_PROJ) + (size_t)b * SEQ * PLD;
    f32x2 S0 = {0.f, 0.f}, S1 = {0.f, 0.f}, S2 = {0.f, 0.f}, S3 = {0.f, 0.f};
    for (int t0 = 0; t0 < SEQ; t0 += 32) {
#pragma unroll
        for (int i = 0; i < 4; ++i) { const int t = wv * 4 + i; const bf16_t* row = base + (size_t)(t0 + t) * PLD;
            const float z = bf2f(row[C_HF + C]), qr = bf2f(row[C_HQ + C]), vi = bf2f(row[C_HI + C]);
            const float sg = sigmoidf_(z); F[t * 64 + e] = sg + lb * (1.0f - sg); Kx[t * 64 + e] = (1.0f - lb) * (1.0f - sg); Q[t * 64 + e] = siluf_(qr); V[t * 64 + e] = vi; }
        __syncthreads();
#pragma unroll 4
        for (int t = 0; t < 32; ++t) {
            const f32x4 f0 = *(const f32x4*)(F + t * 64 + wv * 8), f1 = *(const f32x4*)(F + t * 64 + wv * 8 + 4);
            const f32x4 k0 = *(const f32x4*)(Kx + t * 64 + wv * 8), k1 = *(const f32x4*)(Kx + t * 64 + wv * 8 + 4);
            const f32x4 q0 = *(const f32x4*)(Q + t * 64 + wv * 8), q1 = *(const f32x4*)(Q + t * 64 + wv * 8 + 4);
            const float v = V[t * 64 + e]; const f32x2 vv = {v, v};
            S0 = (f32x2){f0[0], f0[1]} * S0 + (f32x2){k0[0], k0[1]} * vv; S1 = (f32x2){f0[2], f0[3]} * S1 + (f32x2){k0[2], k0[3]} * vv;
            S2 = (f32x2){f1[0], f1[1]} * S2 + (f32x2){k1[0], k1[1]} * vv; S3 = (f32x2){f1[2], f1[3]} * S3 + (f32x2){k1[2], k1[3]} * vv;
            f32x2 o2 = (f32x2){q0[0], q0[1]} * S0 + (f32x2){q0[2], q0[3]} * S1 + (f32x2){q1[0], q1[1]} * S2 + (f32x2){q1[2], q1[3]} * S3;
            PO[(t * 8 + wv) * 64 + e] = o2[0] + o2[1];
        }
        __syncthreads();
#pragma unroll
        for (int i = 0; i < 4; ++i) { const int t = wv * 4 + i; bf16_t* row = base + (size_t)(t0 + t) * PLD;
            float o = 0.f;
#pragma unroll
            for (int q = 0; q < 8; ++q) o += PO[(t * 8 + q) * 64 + e];
            const float ss = wave_sum(o * o); const float rs = rsqrtf(ss * (1.0f / 64.0f) + 1e-6f);
            const float gr = bf2f(row[C_HG + C]);
            row[C_HQ + C] = f2bf(o * rs * ng * siluf_(gr)); }
        __syncthreads();
    }
}

DI float dpp_xor1(float v) { return __int_as_float(__builtin_amdgcn_mov_dpp(__float_as_int(v), 0xB1, 0xF, 0xF, true)); }
DI float dpp_xor2(float v) { return __int_as_float(__builtin_amdgcn_mov_dpp(__float_as_int(v), 0x4E, 0xF, 0xF, true)); }
DI float dpp_hmir(float v) { return __int_as_float(__builtin_amdgcn_mov_dpp(__float_as_int(v), 0x141, 0xF, 0xF, true)); }
DI float red8(float v) { v += dpp_xor1(v); v += dpp_xor2(v); v += dpp_hmir(v); return v; }

__device__ __forceinline__ void rwkv_scan(unsigned char* smem, CP p, int L, int b, int h) {
    constexpr int BUF_F = 6 * 2048 + 64 + 2048;
    const int tid = tid_(), c = tid & 63, wv = tid >> 6, C = h * 64 + c, lane = c;
    const float* mu = p->in[I_MU] + (size_t)L * 1792;
    const float mu_r = mu[C], mu_k = mu[512 + C], mu_v = mu[1024 + C];
    const float w0 = p->in[I_W0][L * 512 + C], a0 = p->in[I_A0][L * 512 + C];
    const float k_k = p->in[I_KK][L * 512 + C], k_a = p->in[I_KA][L * 512 + C], r_k = p->in[I_RK][L * 512 + C], ln_w = p->in[I_LNW][L * 512 + C], ln_b = p->in[I_LNB][L * 512 + C];
    const bf16_t* base = (const bf16_t*)(p->ws + WS_PROJ) + (size_t)b * SEQ * PLD + C_RW + C;
    const bf16_t* ewa = (const bf16_t*)(p->ws + WS_UN) + (size_t)b * SEQ * 1024 + C;
    bf16_t* obase = (bf16_t*)(p->ws + WS_ORW) + (size_t)b * SEQ * 512 + C;
    const int kp = lane & 7, vr = lane >> 3, vrow = wv * 8 + vr;
    f32x2 S0 = {0.f, 0.f}, S1 = {0.f, 0.f}, S2 = {0.f, 0.f}, S3 = {0.f, 0.f};
    bf16_t pr[4], pk[4], pv[4], pe[4], pa[4], pg[4], qr, qk, qv;
#define RW_PREFETCH(T0) do { const int s0_ = (T0) + wv * 4; \
        _Pragma("unroll") for (int i = 0; i < 4; ++i) { const bf16_t* row = base + (size_t)(s0_ + i) * PLD; pr[i] = row[0]; pk[i] = row[512]; pv[i] = row[1024]; \
            pe[i] = ewa[(size_t)(s0_ + i) * 1024]; pa[i] = ewa[(size_t)(s0_ + i) * 1024 + 512]; pg[i] = obase[(size_t)(s0_ + i) * 512]; } \
        if (s0_ > 0) { const bf16_t* row = base + (size_t)(s0_ - 1) * PLD; qr = row[0]; qk = row[512]; qv = row[1024]; } else { qr = 0; qk = 0; qv = 0; } } while (0)
    RW_PREFETCH(0);
    __syncthreads();
    for (int blk = 0; blk < SEQ / 32; ++blk) {
        float* Bf = (float*)smem + (blk & 1) * BUF_F;
        float* Wd = Bf; float* NKK = Bf + 2048; float* AB = Bf + 4096; float* KX = Bf + 6144; float* WR = Bf + 8192; float* VS = Bf + 10240; float* SC = Bf + 12288; float* YS = Bf + 12352;
        float bon[4], gv[4];
        { float rp = bf2f(qr), kq = bf2f(qk), vp = bf2f(qv);
#pragma unroll
          for (int i = 0; i < 4; ++i) { const int t = wv * 4 + i;
              const float r1 = bf2f(pr[i]), k1 = bf2f(pk[i]), v1 = bf2f(pv[i]);
              const float r = r1 + (rp - r1) * mu_r, k = k1 + (kq - k1) * mu_k, v = v1 + (vp - v1) * mu_v; rp = r1; kq = k1; vp = v1;
              const float decay = __expf(-0.6065306597f * sigmoidf_(w0 + bf2f(pe[i]))), a = sigmoidf_(a0 + bf2f(pa[i])); gv[i] = bf2f(pg[i]);
              const float kkv = k * k_k; const float ssq = wave_sum(kkv * kkv); const float kkn = kkv / fmaxf(sqrtf(ssq), 1e-12f);
              const float kx = k * (1.0f + (a - 1.0f) * k_a), ab = kkn * a;
              const float br = wave_sum(ab * r), kr = wave_sum(kx * r); bon[i] = wave_sum(r * kx * r_k);
              Wd[t * 64 + c] = decay; NKK[t * 64 + c] = -kkn; AB[t * 64 + c] = ab; KX[t * 64 + c] = kx; WR[t * 64 + c] = decay * r; VS[t * 64 + c] = v;
              if (c == 0) { SC[t * 2] = br; SC[t * 2 + 1] = kr; } } }
        __syncthreads();
        if (blk + 1 < SEQ / 32) RW_PREFETCH((blk + 1) * 32);
#define RW_LOAD(T, w0v, w1v, n0, n1, b0, b1, x0, x1, q0, q1, vv, sc) do { const int o_ = (T) * 64 + kp * 8; \
            w0v = *(const f32x4*)(Wd + o_); w1v = *(const f32x4*)(Wd + o_ + 4); n0 = *(const f32x4*)(NKK + o_); n1 = *(const f32x4*)(NKK + o_ + 4); \
            b0 = *(const f32x4*)(AB + o_); b1 = *(const f32x4*)(AB + o_ + 4); x0 = *(const f32x4*)(KX + o_); x1 = *(const f32x4*)(KX + o_ + 4); \
            q0 = *(const f32x4*)(WR + o_); q1 = *(const f32x4*)(WR + o_ + 4); vv = VS[(T) * 64 + vrow]; sc = *(const f32x2*)(SC + (T) * 2); } while (0)
        f32x4 cw0, cw1, cn0, cn1, cb0, cb1, cx0, cx1, cq0, cq1; float cvv; f32x2 csc;
        RW_LOAD(0, cw0, cw1, cn0, cn1, cb0, cb1, cx0, cx1, cq0, cq1, cvv, csc);
#pragma nounroll
        for (int t8 = 0; t8 < 4; ++t8) {
            float ykeep = 0.f;
#pragma unroll
            for (int j = 0; j < 8; ++j) {
                const int t = t8 * 8 + j;
                const f32x4 w0v = cw0, w1v = cw1, n0 = cn0, n1 = cn1, b0 = cb0, b1 = cb1, x0 = cx0, x1 = cx1, q0 = cq0, q1 = cq1; const float vv = cvv; const f32x2 sc = csc;
                { const int tn = (t + 1) & 31; RW_LOAD(tn, cw0, cw1, cn0, cn1, cb0, cb1, cx0, cx1, cq0, cq1, cvv, csc); }
                const f32x2 sa2 = S0 * (f32x2){n0[0], n0[1]} + S1 * (f32x2){n0[2], n0[3]} + S2 * (f32x2){n1[0], n1[1]} + S3 * (f32x2){n1[2], n1[3]};
                const f32x2 y2 = S0 * (f32x2){q0[0], q0[1]} + S1 * (f32x2){q0[2], q0[3]} + S2 * (f32x2){q1[0], q1[1]} + S3 * (f32x2){q1[2], q1[3]};
                float sa = sa2[0] + sa2[1], yy = y2[0] + y2[1];
                sa += dpp_xor1(sa); yy += dpp_xor1(yy); sa += dpp_xor2(sa); yy += dpp_xor2(yy); sa += dpp_hmir(sa); yy += dpp_hmir(yy);
                const f32x2 sav = {sa, sa}, vv2 = {vv, vv};
                S0 = S0 * (f32x2){w0v[0], w0v[1]} + sav * (f32x2){b0[0], b0[1]} + vv2 * (f32x2){x0[0], x0[1]};
                S1 = S1 * (f32x2){w0v[2], w0v[3]} + sav * (f32x2){b0[2], b0[3]} + vv2 * (f32x2){x0[2], x0[3]};
                S2 = S2 * (f32x2){w1v[0], w1v[1]} + sav * (f32x2){b1[0], b1[1]} + vv2 * (f32x2){x1[0], x1[1]};
                S3 = S3 * (f32x2){w1v[2], w1v[3]} + sav * (f32x2){b1[2], b1[3]} + vv2 * (f32x2){x1[2], x1[3]};
                const float y = yy + sa * sc[0] + vv * sc[1];
                ykeep = (kp == j) ? y : ykeep;
            }
            YS[(t8 * 8 + kp) * 64 + vrow] = ykeep;
        }
#undef RW_LOAD
        __syncthreads();
#pragma unroll
        for (int i = 0; i < 4; ++i) { const int t = wv * 4 + i;
            const float y = YS[t * 64 + c]; const float mean = wave_sum(y) * (1.0f / 64.0f); const float dlt = y - mean;
            const float var = wave_sum(dlt * dlt) * (1.0f / 64.0f);
            float yn = dlt * rsqrtf(var + 64e-5f) * ln_w + ln_b; yn += bon[i] * VS[t * 64 + c];
            obase[(size_t)(blk * 32 + t) * 512] = f2bf(yn * gv[i]); }
    }
#undef RW_PREFETCH
    __syncthreads();
}

#define MFMA32(a, b, c) __builtin_amdgcn_mfma_f32_32x32x16_bf16((a), (b), (c), 0, 0, 0)
constexpr int KTS = 72;
DI bf16x8 pack8(float a0, float a1, float a2, float a3, float a4, float a5, float a6, float a7) {
    u32x4 w; w.x = pack2(a0, a1); w.y = pack2(a2, a3); w.z = pack2(a4, a5); w.w = pack2(a6, a7); return __builtin_bit_cast(bf16x8, w); }
DI bf16x8 ld_vfrag(const bf16_t* vt, int off) { const u32x2 lo = *(const u32x2*)(vt + off), hi = *(const u32x2*)(vt + off + 8); u32x4 w; w.x = lo.x; w.y = lo.y; w.z = hi.x; w.w = hi.y; return __builtin_bit_cast(bf16x8, w); }

struct FlashState { f32x16 o0, o1; float m, l; };

DI void flash_update(FlashState& st, f32x16& sc0, f32x16& sc1, const bf16_t* VT, int vs, int qi, int hl) {
    float mt = -INFINITY;
#pragma unroll
    for (int i = 0; i < 16; ++i) mt = fmaxf(mt, fmaxf(sc0[i], sc1[i]));
    mt = fmaxf(mt, shfl_xor_(mt, 32, qi + 32 * hl));
    const float mnew = fmaxf(st.m, mt), muse = (mnew == -INFINITY) ? 0.f : mnew;
    const float alpha = __builtin_amdgcn_exp2f(st.m - muse);
    float ls = 0.f;
#pragma unroll
    for (int i = 0; i < 16; ++i) { sc0[i] = __builtin_amdgcn_exp2f(sc0[i] - muse); sc1[i] = __builtin_amdgcn_exp2f(sc1[i] - muse); ls += sc0[i] + sc1[i]; }
    st.l = st.l * alpha + ls; st.m = mnew;
    st.o0 *= alpha; st.o1 *= alpha;
#pragma unroll
    for (int s = 0; s < 2; ++s) {
        const bf16x8 p0 = pack8(sc0[8 * s], sc0[8 * s + 1], sc0[8 * s + 2], sc0[8 * s + 3], sc0[8 * s + 4], sc0[8 * s + 5], sc0[8 * s + 6], sc0[8 * s + 7]);
        const bf16x8 p1 = pack8(sc1[8 * s], sc1[8 * s + 1], sc1[8 * s + 2], sc1[8 * s + 3], sc1[8 * s + 4], sc1[8 * s + 5], sc1[8 * s + 6], sc1[8 * s + 7]);
        st.o0 = MFMA32(ld_vfrag(VT, qi * vs + 16 * s + 4 * hl), p0, st.o0);
        st.o1 = MFMA32(ld_vfrag(VT, (32 + qi) * vs + 16 * s + 4 * hl), p0, st.o1);
        st.o0 = MFMA32(ld_vfrag(VT, qi * vs + 32 + 16 * s + 4 * hl), p1, st.o0);
        st.o1 = MFMA32(ld_vfrag(VT, (32 + qi) * vs + 32 + 16 * s + 4 * hl), p1, st.o1);
    }
}
DI void qk_tile(const bf16_t* KT, const bf16x8 (&qf)[4], int qi, int hl, f32x16& sc0, f32x16& sc1) {
#pragma unroll
    for (int i = 0; i < 16; ++i) { sc0[i] = 0.f; sc1[i] = 0.f; }
#pragma unroll
    for (int s = 0; s < 4; ++s) {
        const bf16x8 k0 = *(const bf16x8*)(KT + qi * KTS + 16 * s + 8 * hl), k1 = *(const bf16x8*)(KT + (32 + qi) * KTS + 16 * s + 8 * hl);
        sc0 = MFMA32(k0, qf[s], sc0); sc1 = MFMA32(k1, qf[s], sc1);
    }
}
struct KVRegs { u32x4 k, v; };
DI void kv_fetch(KVRegs& r, const bf16_t* pb, int kcol, int vcol, int k0) {
    const int tid = tid_();
    const unsigned ok_ = (unsigned)((k0 + (tid >> 3)) * PLD + kcol + (tid & 7) * 8) * 2u, ov_ = (unsigned)((k0 + (tid & 63)) * PLD + vcol + (tid >> 6) * 8) * 2u;
    r.k = *(const u32x4*)((const char*)pb + ok_);
    r.v = *(const u32x4*)((const char*)pb + ov_);
}
DI void kv_store(const KVRegs& r, bf16_t* KT, bf16_t* VT) {
    const int tid = tid_();
    *(u32x4*)(KT + (tid >> 3) * KTS + (tid & 7) * 8) = r.k;
    const int key = tid & 63, ch = tid >> 6;
#pragma unroll
    for (int j = 0; j < 8; ++j) VT[(ch * 8 + j) * KTS + key] = (bf16_t)((j & 1) ? (r.v[j >> 1] >> 16) : (r.v[j >> 1] & 0xFFFFu));
}
template <bool LUTB, bool CAUSAL, bool WHI, bool SEL>
DI void mask_tile(f32x16& sc0, f32x16& sc1, const float* lut, int qpos, int k0, int hl, bool sel, float qs) {
    const float bfar = lut[128];
#pragma unroll
    for (int i = 0; i < 16; ++i) { const int kl = (i & 3) + 8 * (i >> 2) + 4 * hl;
        { const int dist = qpos - (k0 + kl); const float v = sc0[i] * qs + (LUTB ? lut[dist > 128 ? 128 : (dist < 0 ? 0 : dist)] : bfar);
          bool ok = true; if (CAUSAL) ok = ok && dist >= 0; if (WHI) ok = ok && dist < 256; if (SEL) ok = ok && sel; sc0[i] = ok ? v : -INFINITY; }
        { const int dist = qpos - (k0 + 32 + kl); const float v = sc1[i] * qs + (LUTB ? lut[dist > 128 ? 128 : (dist < 0 ? 0 : dist)] : bfar);
          bool ok = true; if (CAUSAL) ok = ok && dist >= 0; if (WHI) ok = ok && dist < 256; if (SEL) ok = ok && sel; sc1[i] = ok ? v : -INFINITY; } }
}

__device__ __forceinline__ void nsa_item(unsigned char* smem, CP p, int L, int b, int g, int qb, int ocol) {
    bf16_t* KT = (bf16_t*)smem;
    bf16_t* VT = (bf16_t*)(smem + 9216);
    float* LUT = (float*)(smem + 18432);
    unsigned* SELM = (unsigned*)(smem + 20736);
    unsigned* ORM = (unsigned*)(smem + 20992);
    float* PA = (float*)(smem + 21504);
    float* PBv = (float*)(smem + 54272);
    bf16_t* KT2 = (bf16_t*)(smem + 87040);
    bf16_t* VT2 = (bf16_t*)(smem + 105472);
    const int tid = tid_(), lane = tid & 63, wv = tid >> 6, hh = wv >> 1, qhalf = wv & 1, qi = lane & 31, hl = lane >> 5;
    const int ql = qhalf * 32 + qi, qpos = qb * 64 + ql, head = g * 4 + hh;
    bf16_t* pb = (bf16_t*)(p->ws + WS_PROJ) + (size_t)b * SEQ * PLD;
    bf16_t* qrow = pb + (size_t)qpos * PLD;
    __syncthreads();
    for (int i = tid; i < 4 * 129; i += 512) { const int h2 = i / 129, dd = i % 129; int bk;
        if (dd < 16) bk = dd; else if (dd >= 128) bk = 31; else { bk = 16 + (int)(logf((float)dd / 16.0f) / 2.0794415416798357f * 16.0f); bk = bk > 31 ? 31 : bk; }
        LUT[h2 * 132 + dd] = p->in[I_RELB][bk * 8 + g * 4 + h2] * 1.4426950408889634f; }
    if (tid == 0) *ORM = 0u;
    if (tid < 256) PBv[tid * 32] = 0.f;
    { const float* kc = (const float*)(p->ws + WS_KC) + ((size_t)(0 * 16 + b) * 2 + g) * 128 * 64; const float* vc = (const float*)(p->ws + WS_KC) + ((size_t)(1 * 16 + b) * 2 + g) * 128 * 64;
      for (int i = tid; i < 128 * 64; i += 512) { const int n = i >> 6, d = i & 63; KT2[n * KTS + d] = f2bf(kc[i]); VT2[d * 136 + n] = f2bf(vc[i]); } }
    bf16x8 qf[4];
#pragma unroll
    for (int s = 0; s < 4; ++s) qf[s] = *(const bf16x8*)(qrow + C_NQ + head * 64 + 16 * s + 8 * hl);
    float g0, g1, g2;
    { const bf16_t* gp = qrow + C_NG + head * 3; g0 = sigmoidf_(bf2f(gp[0])); g1 = sigmoidf_(bf2f(gp[1])); g2 = sigmoidf_(bf2f(gp[2])); }
    __syncthreads();
    const float* lut = LUT + hh * 132;
    constexpr float QS = 0.125f * 1.4426950408889634f;
    f32x16 fin0, fin1;
    {
        FlashState st;
#pragma unroll
        for (int i = 0; i < 16; ++i) { st.o0[i] = 0.f; st.o1[i] = 0.f; }
        st.m = -INFINITY; st.l = 0.f;
#pragma nounroll
        for (int t = 0; t < 2; ++t) {
            f32x16 sc0, sc1; qk_tile(KT2 + t * 64 * KTS, qf, qi, hl, sc0, sc1);
#pragma unroll
            for (int i = 0; i < 16; ++i) { const int kl = (i & 3) + 8 * (i >> 2) + 4 * hl;
                { const int n = 64 * t + kl, dist = qpos - (16 * n + 31); sc0[i] = (dist >= 0 && n < 127) ? sc0[i] * QS + lut[dist > 128 ? 128 : dist] : -INFINITY; }
                { const int n = 64 * t + 32 + kl, dist = qpos - (16 * n + 31); sc1[i] = (dist >= 0 && n < 127) ? sc1[i] * QS + lut[dist > 128 ? 128 : dist] : -INFINITY; } }
            flash_update(st, sc0, sc1, VT2 + 64 * t, 136, qi, hl);
        }
        const float lt = st.l + shfl_xor_(st.l, 32, lane); const float inv = 1.0f / fmaxf(lt, 1e-30f);
        const float muse = (st.m == -INFINITY) ? 0.f : st.m;
        fin0 = st.o0 * (g0 * inv); fin1 = st.o1 * (g0 * inv);
#pragma nounroll
        for (int t = 0; t < 2; ++t) {
            f32x16 sc0, sc1; qk_tile(KT2 + t * 64 * KTS, qf, qi, hl, sc0, sc1);
#pragma unroll
            for (int i = 0; i < 16; ++i) { const int kl = (i & 3) + 8 * (i >> 2) + 4 * hl;
                { const int n = 64 * t + kl, dist = qpos - (16 * n + 31); sc0[i] = (dist >= 0 && n < 127) ? __builtin_amdgcn_exp2f(sc0[i] * QS + lut[dist > 128 ? 128 : dist] - muse) * inv : 0.f; }
                { const int n = 64 * t + 32 + kl, dist = qpos - (16 * n + 31); sc1[i] = (dist >= 0 && n < 127) ? __builtin_amdgcn_exp2f(sc1[i] * QS + lut[dist > 128 ? 128 : dist] - muse) * inv : 0.f; } }
#pragma unroll
            for (int i4 = 0; i4 < 4; ++i4) {
                { const int m = 16 * t + 2 * i4 + hl; PA[(hh * 64 + ql) * 32 + m] = sc0[4 * i4] + sc0[4 * i4 + 1] + sc0[4 * i4 + 2] + sc0[4 * i4 + 3]; PBv[(hh * 64 + ql) * 32 + m + 1] = sc0[4 * i4 + 3]; }
                { const int m = 16 * t + 8 + 2 * i4 + hl; PA[(hh * 64 + ql) * 32 + m] = sc1[4 * i4] + sc1[4 * i4 + 1] + sc1[4 * i4 + 2] + sc1[4 * i4 + 3]; if (m + 1 < 32) PBv[(hh * 64 + ql) * 32 + m + 1] = sc1[4 * i4 + 3]; }
            }
        }
    }
    __syncthreads();
    if (tid < 64) {
        const int cur = qb; unsigned msk = 0u;
        for (int it = 0; it < 8; ++it) {
            float best = -INFINITY; int bi = -1;
            for (int m = 0; m < 32; ++m) {
                if ((msk >> m) & 1u) continue;
                float v;
                if (m == 0 || m == cur || m == cur - 1) v = INFINITY;
                else if (m <= cur) { v = 0.f; for (int h2 = 0; h2 < 4; ++h2) v += PA[(h2 * 64 + tid) * 32 + m] + PBv[(h2 * 64 + tid) * 32 + m]; }
                else v = -INFINITY;
                if (v > best) { best = v; bi = m; }
            }
            if (bi >= 0) msk |= 1u << bi;
        }
        SELM[tid] = msk; atomicOr(ORM, msk);
    }
    __syncthreads();
    const unsigned mysel = SELM[ql], orm = *ORM;
    __syncthreads();
    float* PARK = PA + (wv * 32) * 64 + lane;
#pragma unroll
    for (int i = 0; i < 16; ++i) { PARK[i * 64] = fin0[i]; PARK[(16 + i) * 64] = fin1[i]; }
    {
        FlashState st;
#pragma unroll
        for (int i = 0; i < 16; ++i) { st.o0[i] = 0.f; st.o1[i] = 0.f; }
        st.m = -INFINITY; st.l = 0.f;
        const unsigned todo = orm & (qb >= 31 ? 0xFFFFFFFFu : ((2u << qb) - 1u));
        KVRegs kr;
        int m = todo ? __builtin_ctz(todo) : -1;
        if (m >= 0) { kv_fetch(kr, pb, C_KS + g * 64, C_VS + g * 64, m * 64); __syncthreads(); kv_store(kr, KT, VT); __syncthreads(); }
        while (m >= 0) {
            const unsigned rest = todo & ~((2u << m) - 1u); const int nm = (m < 31 && rest) ? __builtin_ctz(rest) : -1;
            if (nm >= 0) kv_fetch(kr, pb, C_KS + g * 64, C_VS + g * 64, nm * 64);
            f32x16 sc0, sc1; qk_tile(KT, qf, qi, hl, sc0, sc1);
            const bool sel = (mysel >> m) & 1u;
            if (m + 3 <= qb) mask_tile<false, false, false, true>(sc0, sc1, lut, qpos, m * 64, hl, sel, QS);
            else mask_tile<true, true, false, true>(sc0, sc1, lut, qpos, m * 64, hl, sel, QS);
            flash_update(st, sc0, sc1, VT, KTS, qi, hl);
            __syncthreads();
            if (nm >= 0) kv_store(kr, KT, VT);
            __syncthreads();
            m = nm;
        }
        const float lt = st.l + shfl_xor_(st.l, 32, lane); const float sc = g1 / fmaxf(lt, 1e-30f);
#pragma unroll
        for (int i = 0; i < 16; ++i) { PARK[i * 64] += st.o0[i] * sc; PARK[(16 + i) * 64] += st.o1[i] * sc; }
    }
    {
        FlashState st;
#pragma unroll
        for (int i = 0; i < 16; ++i) { st.o0[i] = 0.f; st.o1[i] = 0.f; }
        st.m = -INFINITY; st.l = 0.f;
        KVRegs kr;
        int w = qb >= 4 ? 0 : 4 - qb;
        kv_fetch(kr, pb, C_KW + g * 64, C_VW + g * 64, qb * 64 - 256 + 64 * w); __syncthreads(); kv_store(kr, KT, VT); __syncthreads();
        for (; w < 5; ++w) {
            const int k0 = qb * 64 - 256 + 64 * w;
            if (w < 4) kv_fetch(kr, pb, C_KW + g * 64, C_VW + g * 64, k0 + 64);
            f32x16 sc0, sc1; qk_tile(KT, qf, qi, hl, sc0, sc1);
            if (w == 0) mask_tile<false, false, true, false>(sc0, sc1, lut, qpos, k0, hl, true, QS);
            else if (w == 1) mask_tile<false, false, false, false>(sc0, sc1, lut, qpos, k0, hl, true, QS);
            else if (w < 4) mask_tile<true, false, false, false>(sc0, sc1, lut, qpos, k0, hl, true, QS);
            else mask_tile<true, true, false, false>(sc0, sc1, lut, qpos, k0, hl, true, QS);
            flash_update(st, sc0, sc1, VT, KTS, qi, hl);
            __syncthreads();
            if (w < 4) kv_store(kr, KT, VT);
            __syncthreads();
        }
        const float lt = st.l + shfl_xor_(st.l, 32, lane); const float sc = g2 / fmaxf(lt, 1e-30f);
#pragma unroll
        for (int i = 0; i < 16; ++i) { fin0[i] = PARK[i * 64] + st.o0[i] * sc; fin1[i] = PARK[(16 + i) * 64] + st.o1[i] * sc; }
    }
#pragma unroll
    for (int i4 = 0; i4 < 4; ++i4) {
        u32x2 w0; w0.x = pack2(fin0[4 * i4], fin0[4 * i4 + 1]); w0.y = pack2(fin0[4 * i4 + 2], fin0[4 * i4 + 3]);
        u32x2 w1; w1.x = pack2(fin1[4 * i4], fin1[4 * i4 + 1]); w1.y = pack2(fin1[4 * i4 + 2], fin1[4 * i4 + 3]);
        *(u32x2*)(qrow + ocol + head * 64 + 8 * i4 + 4 * hl) = w0;
        *(u32x2*)(qrow + ocol + head * 64 + 32 + 8 * i4 + 4 * hl) = w1;
    }
}

constexpr int PH_PER_LAYER = 17, PH_TOTAL = DEPTH * PH_PER_LAYER + 1;
enum { S_PREP = 0, S_GU1, S_D1, S_NORM_MIX, S_WIN, S_CMP, S_LORA, S_SCAN, S_NSA, S_MERGE, S_OUT, S_NORM2, S_GU2, S_D2, S_NORM_PLE, S_PLE, S_PLEG, S_FINAL };

__device__ __forceinline__ void run_phase(unsigned char* smem, CP p, int ph) {
    const bool fin = (ph == DEPTH * PH_PER_LAYER);
    const int L = fin ? 0 : ph / PH_PER_LAYER; const int sub = fin ? S_FINAL : ph % PH_PER_LAYER;
    unsigned char* ws = p->ws; float* H = p->out;
    bf16_t* W = (bf16_t*)(ws + WS_WBF); bf16_t* UN = (bf16_t*)(ws + WS_UN); bf16_t* PROJ = (bf16_t*)(ws + WS_PROJ); bf16_t* ACT = (bf16_t*)(ws + WS_ACT);
    bf16_t* TMP = (bf16_t*)(ws + WS_TMP); bf16_t* PBF = (bf16_t*)(ws + WS_PB); bf16_t* ORW = (bf16_t*)(ws + WS_ORW);
    bf16_t* XK = (bf16_t*)(ws + WS_XK); bf16_t* XV = (bf16_t*)(ws + WS_XV); float* P01 = (float*)(ws + WS_P01);
    if (sub == S_PREP) convert_layer_weights(smem, p, L);
    if (sub == S_NORM_MIX) convert_ffn2_weights(smem, p, L);
    if (sub == S_NORM_PLE) cvt_f32_bf16(p->in[I_P] + (size_t)L * T_TOK * 256, PBF, (size_t)T_TOK * 256 / 4);
    if (sub == S_CMP) lora_act(p, L);
    if (sub == S_LORA) finalize_cmp(smem, p, L);
    if (sub == S_PREP || sub == S_NORM_MIX || sub == S_NORM2 || sub == S_NORM_PLE || sub == S_FINAL) {
        const float* hin = (sub == S_PREP && L == 0) ? p->in[I_X] : H; float* hcopy = (sub == S_PREP && L == 0) ? H : nullptr;
        const float* g = sub == S_PREP ? p->in[I_F1N] + L * DM : sub == S_NORM_MIX ? p->in[I_MIXN] + L * DM : sub == S_NORM2 ? p->in[I_F2N] + L * DM : sub == S_NORM_PLE ? p->in[I_PLEN] + L * DM : p->in[I_FINN];
        rmsnorm_rows(hin, hcopy, g, sub == S_FINAL ? nullptr : UN, sub == S_FINAL ? H : nullptr);
    } else if (sub == S_GU1 || sub == S_GU2) {
        EpiSwiglu e; e.O = ACT; run_gemm(smem, UN, DM, W + (sub == S_GU1 ? E_GU1 : E_GU2), T_TOK, 2 * DFF, DM, e);
    } else if (sub == S_D1 || sub == S_D2 || sub == S_OUT) {
        EpiResid e; e.H = H; e.scale = sub == S_OUT ? 1.0f : 0.5f;
        run_gemm(smem, sub == S_OUT ? UN : ACT, sub == S_OUT ? DM : DFF, W + (sub == S_D1 ? E_D1 : sub == S_D2 ? E_D2 : E_OUT), T_TOK, DM, sub == S_OUT ? DM : DFF, e);
    } else if (sub == S_WIN) {
        EpiProj e; e.O = PROJ; e.XK = XK; e.XV = XV; run_gemm(smem, UN, DM, W + E_IN, T_TOK, PLD, DM, e);
    } else if (sub == S_CMP) {
#pragma nounroll
        for (int kv = 0; kv < 2; ++kv) { EpiF32 e; e.C = P01 + (size_t)kv * 4096 * 256;
            run_gemm(smem, kv ? XV : XK, 1024, W + E_C1 + (size_t)kv * 256 * 1024, 4096, 256, 1024, e); }
    } else if (sub == S_LORA) {
        EpiLora e; e.EWA = UN; e.G = ORW;
        run_gemm(smem, (const bf16_t*)(ws + WS_LACT), 256, W + E_LORA, T_TOK, 1536, 256, e);
    } else if (sub == S_SCAN) {
        for (int item = bid_(); item < 256; item += gridDim.x) {
            __syncthreads();
            if (item < 128) rwkv_scan(smem, p, L, item >> 3, item & 7); else hgrn_scan(smem, p, L, (item - 128) >> 3, (item - 128) & 7);
        }
    } else if (sub == S_NSA) {
        for (int idx = bid_(), k = 0; idx < 1024; idx += gridDim.x, ++k) {
            const int bg = idx & 31, qq = idx >> 5; const int qb = (k & 1) ? ((qq & ~7) + 7 - (qq & 7)) : qq;
            nsa_item(smem, p, L, bg >> 1, bg & 1, qb, C_NQ);
        }
    } else if (sub == S_MERGE) {
#pragma nounroll
        for (int j = 0; j < 3; ++j) { EpiMerge e; e.MRG = UN; e.PROJ = PROJ; e.J = j;
            const bf16_t* A = j == 0 ? PROJ + C_HQ : (j == 1 ? PROJ + C_NQ : ORW);
            run_gemm(smem, A, j == 2 ? 512 : PLD, W + E_BR + (size_t)j * 1024 * 512, T_TOK, DM, 512, e); }
    } else if (sub == S_PLE) {
        EpiBf16 e; e.O = TMP; run_gemm(smem, PBF, 256, W + E_PW, T_TOK, DM, 256, e);
    } else if (sub == S_PLEG) {
        EpiPleGate e; e.H = H; e.TMP = TMP; run_gemm(smem, UN, DM, W + E_PG, T_TOK, DM, DM, e);
    }
}

#define XB_TMO      128
#define XB_XCNT(j)  (256  + 64 * (j))
#define XB_XSUB(j)  (1280 + 64 * (j))
#define XB_XGEN(j)  (2304 + 64 * (j))
#define XB_TOP      3328
#define XB_TOPGEN   3392
#define XCD_BAR_WORDS 3456
#define XB_SPIN_CAP (1u << 20)
DI unsigned xb_ld(unsigned* p)              { return __hip_atomic_load(p, __ATOMIC_RELAXED, __HIP_MEMORY_SCOPE_AGENT); }
DI unsigned xb_add(unsigned* p, unsigned v) { return __hip_atomic_fetch_add(p, v, __ATOMIC_RELAXED, __HIP_MEMORY_SCOPE_AGENT); }
DI unsigned xb_xcc_id() { return (unsigned)__builtin_amdgcn_s_getreg((3 << 11) | 20) & 0xFu; }
#define XB_SPIN(cond, bar) do { unsigned _sp = 0; while (cond) { __builtin_amdgcn_s_sleep(1); \
    if ((++_sp & 255u) == 0u) { if (xb_ld(&(bar)[XB_TMO])) break; if (_sp > XB_SPIN_CAP) { atomicAdd(&(bar)[XB_TMO], 1u); break; } } } } while (0)
struct XcdBarrier { unsigned* bar; unsigned x; volatile LAS unsigned* st; };
DI XcdBarrier xcd_barrier_post(unsigned* bar, volatile LAS unsigned* st) {
    XcdBarrier b; b.bar = bar; b.x = xb_xcc_id(); b.st = st;
    if (threadIdx.x == 0) (void)xb_add(&bar[XB_XCNT(b.x)], 1u);
    return b;
}
DI void xcd_barrier_complete(unsigned* bar, unsigned x, unsigned& nloc, unsigned& nx) {
    const unsigned G = gridDim.x * gridDim.y * gridDim.z;
    unsigned sum, cnt, mine, sp = 0u;
    for (;;) {
        sum = 0u; cnt = 0u; mine = 0u;
#pragma unroll
        for (unsigned j = 0; j < 16; ++j) { const unsigned c = xb_ld(&bar[XB_XCNT(j)]); sum += c; cnt += (c > 0u) ? 1u : 0u; mine = (j == x) ? c : mine; }
        if (sum == G) break;
        __builtin_amdgcn_s_sleep(1);
        if ((++sp & 255u) == 0u) { if (xb_ld(&bar[XB_TMO])) break; if (sp > XB_SPIN_CAP) { atomicAdd(&bar[XB_TMO], 1u); break; } }
    }
    nloc = mine > 0u ? mine : 1u; nx = cnt > 0u ? cnt : 1u;
}
DI void xcd_barrier(const XcdBarrier& b) {
    asm volatile("s_waitcnt vmcnt(0)" ::: "memory");
    __syncthreads();
    if (threadIdx.x == 0) {
        unsigned* bar = b.bar;
        __builtin_amdgcn_s_waitcnt(0);
        unsigned nloc = b.st[0], nx = b.st[1];
        if (nloc == 0u) { xcd_barrier_complete(bar, b.x, nloc, nx); b.st[0] = nloc; b.st[1] = nx; }
        const unsigned old = xb_add(&bar[XB_XSUB(b.x)], 1u);
        const unsigned gen = old / nloc;
        if (old + 1u == (gen + 1u) * nloc) {
            __builtin_amdgcn_fence(__ATOMIC_RELEASE, "agent");
            asm volatile("s_waitcnt vmcnt(0)" ::: "memory");
            const unsigned og = xb_add(&bar[XB_TOP], 1u);
            const unsigned tg = og / nx;
            if (og + 1u == (tg + 1u) * nx) xb_add(&bar[XB_TOPGEN], 1u);
            else XB_SPIN(xb_ld(&bar[XB_TOPGEN]) == tg, bar);
            __builtin_amdgcn_fence(__ATOMIC_ACQUIRE, "agent");
            xb_add(&bar[XB_XGEN(b.x)], 1u);
            asm volatile("s_waitcnt vmcnt(0)" ::: "memory");
        } else {
            XB_SPIN(xb_ld(&bar[XB_XGEN(b.x)]) == gen, bar);
            __builtin_amdgcn_fence(__ATOMIC_ACQUIRE, "agent");
            asm volatile("s_waitcnt vmcnt(0)" ::: "memory");
        }
    }
    __syncthreads();
}

__global__ void __launch_bounds__(512, 2) mega_fwd(Params p) {
    extern __shared__ __attribute__((aligned(16))) unsigned char smem[];
    cg::grid_group grid = cg::this_grid();
    volatile LAS unsigned* xst = (volatile LAS unsigned*)(LAS unsigned char*)(smem + 140 * 1024);
    if (threadIdx.x == 0) { xst[0] = 0u; xst[1] = 0u; }
    __syncthreads();
    const XcdBarrier xb = xcd_barrier_post((unsigned*)(p.ws + WS_BAR), xst);
    for (int ph = p.ph_lo; ph < p.ph_hi; ++ph) {
        CP pp = (CP)__builtin_amdgcn_kernarg_segment_ptr(); asm volatile("" : "+s"(pp));
        run_phase(smem, pp, ph);
        if (ph + 1 < p.ph_hi) {
            if (ph == p.ph_lo) grid.sync();
            else xcd_barrier(xb);
        }
    }
}

#ifndef MULTI_LAUNCH
#define MULTI_LAUNCH 0
#endif

extern "C" void kernel_launch(void* const* d_in, const int* in_sizes, int n_in, void* d_out, int out_size, void* d_ws, size_t ws_size, hipStream_t stream) {
    static int grid = 0;
    if (grid == 0) {
        if (n_in != N_INPUTS || out_size != T_TOK * DM || ws_size < WS_END) { fprintf(stderr, "kernel_launch: unexpected shapes: n_in %d out %d ws %zu (need %zu)\n", n_in, out_size, ws_size, (size_t)WS_END); grid = -1; return; }
        int dev = 0, cus = 0, per_cu = 0;
        (void)hipGetDevice(&dev); (void)hipDeviceGetAttribute(&cus, hipDeviceAttributeMultiprocessorCount, dev);
        if (hipFuncSetAttribute((const void*)mega_fwd, hipFuncAttributeMaxDynamicSharedMemorySize, LDS_BYTES) != hipSuccess) { fprintf(stderr, "kernel_launch: hipFuncSetAttribute failed\n"); grid = -1; return; }
        if (hipOccupancyMaxActiveBlocksPerMultiprocessor(&per_cu, (const void*)mega_fwd, 512, LDS_BYTES) != hipSuccess || per_cu < 1) { fprintf(stderr, "kernel_launch: occupancy query gives %d\n", per_cu); per_cu = 1; }
        (void)hipGetLastError();
        grid = cus * 1;
        if (grid > 256) grid = 256;
        fprintf(stderr, "kernel_launch: grid %d (cus %d, per_cu %d)\n", grid, cus, per_cu);
    }
    if (grid < 0) return;
    (void)hipMemsetAsync(d_ws, 0, 16384, stream);
    Params p{};
    for (int i = 0; i < N_INPUTS; ++i) p.in[i] = (const float*)d_in[i];
    p.out = (float*)d_out; p.ws = (unsigned char*)d_ws;
#if MULTI_LAUNCH
    for (int ph = 0; ph < PH_TOTAL; ++ph) { p.ph_lo = ph; p.ph_hi = ph + 1; hipLaunchKernelGGL(mega_fwd, dim3(grid), dim3(512), LDS_BYTES, stream, p); }
#else
    p.ph_lo = 0; p.ph_hi = PH_TOTAL;
    void* args[] = {&p};
    hipError_t e = hipLaunchCooperativeKernel((const void*)mega_fwd, dim3(grid), dim3(512), args, LDS_BYTES, stream);
    if (e != hipSuccess) fprintf(stderr, "kernel_launch: cooperative launch failed: %s\n", hipGetErrorString(e));
#endif
}
```

```cpp
#include <hip/hip_runtime.h>
#include <hip/hip_cooperative_groups.h>
#include <cstdio>
namespace cg = cooperative_groups;

#define LAS __attribute__((address_space(3)))
#define DI __device__ __forceinline__
typedef unsigned short bf16_t;
typedef short bf16x8 __attribute__((ext_vector_type(8)));
typedef float f32x4 __attribute__((ext_vector_type(4)));
typedef float f32x2 __attribute__((ext_vector_type(2)));
typedef float f32x16 __attribute__((ext_vector_type(16)));
typedef unsigned u32x4 __attribute__((ext_vector_type(4)));
typedef unsigned u32x2 __attribute__((ext_vector_type(2)));

constexpr int T_TOK = 32768, SEQ = 2048, NB = 16, DM = 1024, DFF = 2816, DEPTH = 4;
constexpr int PLD = 8448;
constexpr int C_HQ = 0, C_HF = 512, C_HI = 1024, C_HG = 1536, C_NQ = 2048, C_KC = 2560, C_VC = 2688, C_KS = 2816, C_VS = 2944,
              C_KW = 3072, C_VW = 3200, C_NG = 3328, C_RW = 3352, C_MG = 5376, IN_REAL = 5144, IN_COLS = 8216;
enum { I_X = 0, I_P, I_F1N, I_F1GU, I_F1D, I_MIXN, I_WIN, I_HGLB, I_HGN, I_PE, I_CW1, I_CW2, I_RELB, I_MU, I_W0, I_WB, I_A0, I_AB, I_GB,
       I_KK, I_KA, I_RK, I_LNW, I_LNB, I_WBR, I_WOUT, I_F2N, I_F2GU, I_F2D, I_PLEN, I_PLEG, I_PLEW, I_FINN, N_INPUTS };

constexpr size_t WS_BAR = 0;
constexpr size_t WS_PEB = 16384;
constexpr size_t WS_WBF = 20480;
constexpr size_t E_GU1 = 0, E_D1 = E_GU1 + 5632ull * 1024, E_IN = E_D1 + 1024ull * 2816, E_BR = E_IN + 8448ull * 1024, E_OUT = E_BR + 3ull * 1024 * 512,
                 E_GU2 = E_GU1, E_D2 = E_D1  , E_PG = E_OUT + 1024ull * 1024, E_PW = E_PG + 1024ull * 1024,
                 E_C1 = E_PW + 1024ull * 256, E_LORA = E_C1 + 2ull * 256 * 1024, E_END = E_LORA + 1536ull * 256;
constexpr size_t WS_UN = WS_WBF + E_END * 2;
constexpr size_t WS_ORW = WS_UN + (size_t)T_TOK * 1024 * 2;
constexpr size_t WS_XK = WS_ORW + (size_t)T_TOK * 512 * 2;
constexpr size_t WS_XV = WS_XK + 4096ull * 1024 * 2;
constexpr size_t WS_P01 = WS_XV + 4096ull * 1024 * 2;
constexpr size_t WS_KC = WS_P01 + 2ull * 4096 * 256 * 4;
constexpr size_t WS_LACT = WS_KC + 2ull * 16 * 2 * 128 * 64 * 4;
constexpr size_t WS_PROJ = WS_LACT + (size_t)T_TOK * 256 * 2;
constexpr size_t WS_END = WS_PROJ + (size_t)T_TOK * PLD * 2;
constexpr size_t WS_ACT = WS_PROJ;
constexpr size_t WS_PB = WS_PROJ + 200ull * 1024 * 1024;
constexpr size_t WS_TMP = WS_PROJ + 256ull * 1024 * 1024;
constexpr int LDS_BYTES = 144 * 1024;

struct Params {
    const float* in[N_INPUTS];
    float* out;
    unsigned char* ws;
    int ph_lo, ph_hi;
};
typedef const Params __attribute__((address_space(4)))* CP;

DI int tid_() { int t = threadIdx.x; asm volatile("" : "+v"(t)); return t; }
DI int bid_() { int b = blockIdx.x; asm volatile("" : "+s"(b)); return b; }
typedef __bf16 bf16v2 __attribute__((ext_vector_type(2)));
DI float bf2f(bf16_t b) { return __uint_as_float(((unsigned)b) << 16); }
DI unsigned pack2(float lo, float hi) { const f32x2 v = {lo, hi}; return __builtin_bit_cast(unsigned, __builtin_convertvector(v, bf16v2)); }
DI bf16_t f2bf(float f) { return (bf16_t)(pack2(f, 0.f) & 0xFFFFu); }
DI float sigmoidf_(float x) { return 1.0f / (1.0f + __expf(-x)); }
DI float siluf_(float x) { return x / (1.0f + __expf(-x)); }
DI float shfl_xor_(float v, int mask, int lane) { return __int_as_float(__builtin_amdgcn_ds_bpermute((lane ^ mask) << 2, __float_as_int(v))); }
DI float dppf_(float v, int) { return v; }
#define DPPF(v, ctrl) __int_as_float(__builtin_amdgcn_mov_dpp(__float_as_int(v), ctrl, 0xF, 0xF, true))
DI float wave_sum(float v) {
    v += DPPF(v, 0xB1); v += DPPF(v, 0x4E); v += DPPF(v, 0x141); v += DPPF(v, 0x140);
    const float s0 = __int_as_float(__builtin_amdgcn_readlane(__float_as_int(v), 0)), s1 = __int_as_float(__builtin_amdgcn_readlane(__float_as_int(v), 16));
    const float s2 = __int_as_float(__builtin_amdgcn_readlane(__float_as_int(v), 32)), s3 = __int_as_float(__builtin_amdgcn_readlane(__float_as_int(v), 48));
    return (s0 + s1) + (s2 + s3);
}

namespace pg8 {
constexpr int BM = 256, BK = 64, HALF = 128, HTB = HALF * BK * 2, STAGE_BYTES = 8 * HTB, NXCD = 8, WGM = 8;
DI int lds_byte(int r, int c) { const int st = (r >> 4) * 2 + (c >> 5), rr = r & 15, cc = c & 31, ob = rr * 64 + cc * 2; return st * 1024 + (ob ^ (((ob >> 9) & 1) << 5)); }
DI void stage_rc(int b, int& R, int& C) { const int st = b / 1024, sb = b % 1024, swz = sb ^ (((sb >> 9) & 1) << 5); R = (st >> 1) * 16 + swz / 64; C = (st & 1) * 32 + (swz % 64) / 2; }
DI int perm32(int rho) { const int n = rho >> 4, i = rho & 15; return 8 * (i >> 2) + 4 * n + (i & 3); }
struct Unit { int pm, pn; };
struct Gemm { const bf16_t* A; const bf16_t* Bt; int M, N, K, lda; };
struct StaticOrder {
    int nM, nN, nwg, G, c;
    DI void init(int M, int N, int G_, int c_) { nM = M / BM; nN = N / BM; nwg = nM * nN; G = G_; c = c_; }
    DI bool next(int i, Unit& u) const {
        const long L = (long)i * G + c; if (L >= nwg) return false;
        int wgid = (int)L; { const int q = nwg / NXCD, r = nwg % NXCD, xcd = wgid % NXCD, off = wgid / NXCD; wgid = (xcd < r ? xcd * (q + 1) : r * (q + 1) + (xcd - r) * q) + off; }
        const int nig = WGM * nN, gid = wgid / nig, fm = gid * WGM, gsz = (nM - fm) < WGM ? (nM - fm) : WGM;
        u.pm = fm + ((wgid % nig) % gsz); u.pn = (wgid % nig) / gsz; return true;
    }
};

template <class Epi>
DI void gemm_phase(LAS unsigned char* lds, const Gemm g, const StaticOrder& S, const Epi& E) {
    int tid = tid_();
    const int wid = __builtin_amdgcn_readfirstlane(tid >> 6), lane = tid & 63, wr = wid >> 2, wc = wid & 3, fr = lane & 15, fq = lane >> 4;
    const int K = g.K, nt = K / BK, lda = g.lda;
    unsigned voffA[2], voffB[2];
#pragma unroll
    for (int i = 0; i < 2; ++i) { int R, C; stage_rc(tid * 16 + i * 8192, R, C); const int Rb = Epi::PERM ? ((R & ~31) + perm32(R & 31)) : R;
        voffA[i] = (unsigned)(R * lda + C) * 2u; voffB[i] = (unsigned)(Rb * K + C) * 2u; }
    const size_t kstep = (size_t)(BK * 2);
    const size_t hstepA = (size_t)HALF * lda * 2, hstepB = (size_t)HALF * K * 2;
    const size_t tstepA = 2 * hstepA, tstepB = 2 * hstepB;
    const unsigned ldsw = (unsigned)wid * 1024u;
    const int aoff = lds_byte(wr * 64 + fr, fq * 8), boff = lds_byte(wc * 32 + fr, fq * 8);
#define PG8_SA(b, h) (((b) * 2 + (h)) * HTB)
#define PG8_SB(b, h) ((4 + (b) * 2 + (h)) * HTB)
#define PG8_STAGE(bufoff, gbase, voff) do { _Pragma("unroll") for (int _i = 0; _i < 2; ++_i) \
        __builtin_amdgcn_global_load_lds((const unsigned*)((const char*)(gbase) + (voff)[_i]), (LAS unsigned*)(lds + (bufoff) + ldsw + _i * 8192), 16, 0, 0); } while (0)
#define PG8_LDA(dst, b, h) do { _Pragma("unroll") for (int m = 0; m < 4; ++m) _Pragma("unroll") for (int k = 0; k < 2; ++k) dst[m][k] = *(const LAS bf16x8*)(lds + PG8_SA(b, h) + aoff + m * 2048 + k * 1024); } while (0)
#define PG8_LDB(dst, b, h) do { _Pragma("unroll") for (int n = 0; n < 2; ++n) _Pragma("unroll") for (int k = 0; k < 2; ++k) dst[n][k] = *(const LAS bf16x8*)(lds + PG8_SB(b, h) + boff + n * 2048 + k * 1024); } while (0)
#define PG8_MMA(ai, bj, At, Bt) do { __builtin_amdgcn_s_setprio(1); _Pragma("unroll") for (int m = 0; m < 4; ++m) _Pragma("unroll") for (int n = 0; n < 2; ++n) _Pragma("unroll") for (int k = 0; k < 2; ++k) \
        acc[ai][bj][m][n] = __builtin_amdgcn_mfma_f32_16x16x32_bf16(Bt[n][k], At[m][k], acc[ai][bj][m][n], 0, 0, 0); __builtin_amdgcn_s_setprio(0); } while (0)
#define PG8_WAIT_V(n) asm volatile("s_waitcnt vmcnt(" #n ")" ::: "memory")
#define PG8_WAIT_L(n) asm volatile("s_waitcnt lgkmcnt(" #n ")" ::: "memory")
#define PG8_BAR __builtin_amdgcn_s_barrier()
#define PG8_SCHED __builtin_amdgcn_sched_barrier(0)
    Unit cur, nxt; int ui = 0;
    if (!S.next(0, cur)) return;
    f32x4 acc[2][2][4][2];
#pragma unroll
    for (int a = 0; a < 2; ++a)
#pragma unroll
        for (int b = 0; b < 2; ++b)
#pragma unroll
            for (int m = 0; m < 4; ++m)
#pragma unroll
                for (int n = 0; n < 2; ++n) acc[a][b][m][n] = (f32x4){0.f, 0.f, 0.f, 0.f};
    bf16x8 At[4][2], B0[2][2], B1[2][2];
    const char* cA = (const char*)g.A + (size_t)cur.pm * tstepA; const char* cB = (const char*)g.Bt + (size_t)cur.pn * tstepB;
    PG8_STAGE(PG8_SB(0, 0), cB, voffB); PG8_STAGE(PG8_SA(0, 0), cA, voffA); PG8_STAGE(PG8_SB(0, 1), cB + hstepB, voffB); PG8_STAGE(PG8_SA(0, 1), cA + hstepA, voffA);
    if (wr == 1) PG8_BAR;
    PG8_WAIT_V(4); PG8_BAR;
    PG8_STAGE(PG8_SB(1, 0), cB + kstep, voffB); PG8_STAGE(PG8_SA(1, 0), cA + kstep, voffA); PG8_STAGE(PG8_SB(1, 1), cB + hstepB + kstep, voffB);
    PG8_WAIT_V(6); PG8_BAR;
    for (;;) {
        const bool has_next = S.next(ui + 1, nxt);
        const char* nA = has_next ? (const char*)g.A + (size_t)nxt.pm * tstepA : cA; const char* nB = has_next ? (const char*)g.Bt + (size_t)nxt.pn * tstepB : cB;
        for (int t = 0; t < nt; t += 2) {
            const bool last = (t == nt - 2);
            const char* a1 = cA + (size_t)(t + 1) * kstep;
            const char* a2 = last ? nA : cA + (size_t)(t + 2) * kstep; const char* b2 = last ? nB : cB + (size_t)(t + 2) * kstep;
            const char* a3 = a2 + kstep; const char* b3 = b2 + kstep;
            PG8_LDB(B0, 0, 0); PG8_SCHED; PG8_LDA(At, 0, 0); PG8_STAGE(PG8_SA(1, 1), a1 + hstepA, voffA);
            PG8_WAIT_L(8); PG8_BAR; PG8_WAIT_L(0); PG8_MMA(0, 0, At, B0); PG8_BAR; PG8_SCHED;
            PG8_LDB(B1, 0, 1); PG8_STAGE(PG8_SB(0, 0), b2, voffB);
            PG8_BAR; PG8_WAIT_L(0); PG8_MMA(0, 1, At, B1); PG8_BAR;
            PG8_LDA(At, 0, 1); PG8_STAGE(PG8_SA(0, 0), a2, voffA);
            PG8_BAR; PG8_WAIT_L(0); PG8_MMA(1, 0, At, B0); PG8_BAR; PG8_SCHED;
            PG8_STAGE(PG8_SB(0, 1), b2 + hstepB, voffB);
            PG8_WAIT_V(6); PG8_BAR; PG8_MMA(1, 1, At, B1); PG8_BAR;
            PG8_LDB(B0, 1, 0); PG8_SCHED; PG8_LDA(At, 1, 0); PG8_STAGE(PG8_SA(0, 1), a2 + hstepA, voffA);
            PG8_WAIT_L(8); PG8_BAR; PG8_WAIT_L(0); PG8_MMA(0, 0, At, B0); PG8_BAR; PG8_SCHED;
            PG8_LDB(B1, 1, 1); PG8_STAGE(PG8_SB(1, 0), b3, voffB);
            PG8_BAR; PG8_WAIT_L(0); PG8_MMA(0, 1, At, B1); PG8_BAR;
            PG8_LDA(At, 1, 1); PG8_STAGE(PG8_SA(1, 0), a3, voffA);
            PG8_BAR; PG8_WAIT_L(0); PG8_MMA(1, 0, At, B0); PG8_BAR; PG8_SCHED;
            PG8_STAGE(PG8_SB(1, 1), b3 + hstepB, voffB);
            PG8_WAIT_V(6); PG8_BAR; PG8_MMA(1, 1, At, B1); PG8_BAR;
        }
        E(acc, cur, wr, wc, fr, fq);
        if (!has_next) break;
#pragma unroll
        for (int a = 0; a < 2; ++a)
#pragma unroll
            for (int b = 0; b < 2; ++b)
#pragma unroll
                for (int m = 0; m < 4; ++m)
#pragma unroll
                    for (int n = 0; n < 2; ++n) acc[a][b][m][n] = (f32x4){0.f, 0.f, 0.f, 0.f};
        cur = nxt; cA = nA; cB = nB; ++ui;
    }
    PG8_WAIT_V(0);
    if (wr == 0) PG8_BAR;
    PG8_BAR;
#undef PG8_SA
#undef PG8_SB
#undef PG8_STAGE
#undef PG8_LDA
#undef PG8_LDB
#undef PG8_MMA
#undef PG8_WAIT_V
#undef PG8_WAIT_L
#undef PG8_BAR
#undef PG8_SCHED
}
}

typedef f32x4 AccT[2][2][4][2];
#define EPI_LANE const int t_ = tid_(), wid_ = t_ >> 6, ln_ = t_ & 63, wr_ = wid_ >> 2, wc_ = wid_ & 3, fr_ = ln_ & 15, fq_ = ln_ >> 4;
#define EPI_LOOP_PERM(...) EPI_LANE \
    const int row0 = u.pm * 256 + wr_ * 64 + fr_, col0 = u.pn * 256 + wc_ * 32 + 8 * fq_; \
    _Pragma("unroll") for (int ai = 0; ai < 2; ++ai) _Pragma("unroll") for (int m = 0; m < 4; ++m) { const int row = row0 + ai * 128 + m * 16; \
        _Pragma("unroll") for (int bj = 0; bj < 2; ++bj) { const int col = col0 + bj * 128; const f32x4 v0 = acc[ai][bj][m][0], v1 = acc[ai][bj][m][1]; __VA_ARGS__ } }
#define EPI_LOOP_NAT(...) EPI_LANE \
    const int row0 = u.pm * 256 + wr_ * 64 + fr_, col0 = u.pn * 256 + wc_ * 32 + 4 * fq_; \
    _Pragma("unroll") for (int ai = 0; ai < 2; ++ai) _Pragma("unroll") for (int m = 0; m < 4; ++m) { const int row = row0 + ai * 128 + m * 16; \
        _Pragma("unroll") for (int bj = 0; bj < 2; ++bj) _Pragma("unroll") for (int n = 0; n < 2; ++n) { const int col = col0 + bj * 128 + n * 16; const f32x4 v = acc[ai][bj][m][n]; __VA_ARGS__ } }

struct EpiSwiglu { static constexpr bool PERM = true; bf16_t* O;
    DI void operator()(const AccT& acc, const pg8::Unit& u, int wr, int wc, int fr, int fq) const {
        EPI_LOOP_PERM({ u32x2 w; w.x = pack2(siluf_(v0[0]) * v1[0], siluf_(v0[1]) * v1[1]); w.y = pack2(siluf_(v0[2]) * v1[2], siluf_(v0[3]) * v1[3]);
            *(u32x2*)(O + (size_t)row * DFF + (col >> 1)) = w; })
    } };
struct EpiResid { static constexpr bool PERM = false; float* H; float scale;
    DI void operator()(const AccT& acc, const pg8::Unit& u, int wr, int wc, int fr, int fq) const {
        EPI_LOOP_NAT({ f32x4* p = (f32x4*)(H + (size_t)row * DM + col); *p = *p + v * scale; })
    } };
struct EpiProj { static constexpr bool PERM = true; bf16_t* O; bf16_t* XK; bf16_t* XV;
    DI void operator()(const AccT& acc, const pg8::Unit& u, int wr, int wc, int fr, int fq) const {
        const bool is_mg = u.pn * 256 >= C_MG, is_cmp = (u.pn == 10);
        EPI_LOOP_PERM({ f32x4 a = v0, b = v1;
            if (is_mg) { for (int j = 0; j < 4; ++j) { a[j] = sigmoidf_(a[j]); b[j] = sigmoidf_(b[j]); } }
            u32x4 w; w.x = pack2(a[0], a[1]); w.y = pack2(a[2], a[3]); w.z = pack2(b[0], b[1]); w.w = pack2(b[2], b[3]);
            *(u32x4*)(O + (size_t)row * PLD + col) = w;
            if (is_cmp) { const int c = col - C_KC, kv = c >> 7, gg = (c >> 6) & 1, d = c & 63, bb = row >> 11, s = row & 2047, jj = s >> 4, l = s & 15;
                bf16_t* X = kv ? XV : XK; *(u32x4*)(X + ((size_t)((bb * 128 + jj) * 2 + gg)) * 1024 + l * 64 + d) = w; } })
    } };
struct EpiMerge { static constexpr bool PERM = true; bf16_t* MRG; const bf16_t* PROJ; int J;
    DI void operator()(const AccT& acc, const pg8::Unit& u, int wr, int wc, int fr, int fq) const {
        EPI_LOOP_PERM({ const u32x4 gt = *(const u32x4*)(PROJ + (size_t)row * PLD + C_MG + J * 1024 + col);
            u32x4* mp = (u32x4*)(MRG + (size_t)row * DM + col); u32x4 old = (u32x4){0u, 0u, 0u, 0u}; if (J > 0) old = *mp;
            float r[8]; const float x[8] = {v0[0], v0[1], v0[2], v0[3], v1[0], v1[1], v1[2], v1[3]};
            _Pragma("unroll") for (int j = 0; j < 8; ++j) { const unsigned gw = gt[j >> 1], ow = old[j >> 1];
                const float gf = (j & 1) ? __uint_as_float(gw & 0xFFFF0000u) : __uint_as_float(gw << 16);
                const float of = (j & 1) ? __uint_as_float(ow & 0xFFFF0000u) : __uint_as_float(ow << 16);
                r[j] = of + gf * x[j]; }
            u32x4 w; w.x = pack2(r[0], r[1]); w.y = pack2(r[2], r[3]); w.z = pack2(r[4], r[5]); w.w = pack2(r[6], r[7]); *mp = w; })
    } };
struct EpiF32 { static constexpr bool PERM = false; float* C; static constexpr int ldc = 256;
    DI void operator()(const AccT& acc, const pg8::Unit& u, int wr, int wc, int fr, int fq) const {
        EPI_LOOP_NAT({ *(f32x4*)(C + (size_t)row * ldc + col) = v; })
    } };
struct EpiBf16 { static constexpr bool PERM = true; bf16_t* O; static constexpr int ldc = DM;
    DI void operator()(const AccT& acc, const pg8::Unit& u, int wr, int wc, int fr, int fq) const {
        EPI_LOOP_PERM({ u32x4 w; w.x = pack2(v0[0], v0[1]); w.y = pack2(v0[2], v0[3]); w.z = pack2(v1[0], v1[1]); w.w = pack2(v1[2], v1[3]);
            *(u32x4*)(O + (size_t)row * ldc + col) = w; })
    } };
struct EpiPleGate { static constexpr bool PERM = false; float* H; const bf16_t* TMP;
    DI void operator()(const AccT& acc, const pg8::Unit& u, int wr, int wc, int fr, int fq) const {
        EPI_LOOP_NAT({ const u32x2 tw = *(const u32x2*)(TMP + (size_t)row * DM + col); f32x4* p = (f32x4*)(H + (size_t)row * DM + col); f32x4 h = *p;
            h[0] += sigmoidf_(v[0]) * __uint_as_float(tw.x << 16); h[1] += sigmoidf_(v[1]) * __uint_as_float(tw.x & 0xFFFF0000u);
            h[2] += sigmoidf_(v[2]) * __uint_as_float(tw.y << 16); h[3] += sigmoidf_(v[3]) * __uint_as_float(tw.y & 0xFFFF0000u); *p = h; })
    } };

struct EpiLora { static constexpr bool PERM = true; bf16_t* EWA; bf16_t* G;
    DI void operator()(const AccT& acc, const pg8::Unit& u, int wr, int wc, int fr, int fq) const {
        const bool isg = u.pn >= 4; bf16_t* O = isg ? G - 1024 : EWA; const int ld = isg ? 512 : 1024;
        EPI_LOOP_PERM({ u32x4 w; w.x = pack2(v0[0], v0[1]); w.y = pack2(v0[2], v0[3]); w.z = pack2(v1[0], v1[1]); w.w = pack2(v1[2], v1[3]);
            *(u32x4*)(O + (size_t)row * ld + col) = w; })
    } };

template <class Epi> DI void run_gemm(unsigned char* smem, const bf16_t* A, int lda, const bf16_t* Bt, int M, int N, int K, const Epi& E) {
    __syncthreads();
    pg8::Gemm g; g.A = A; g.Bt = Bt; g.M = M; g.N = N; g.K = K; g.lda = lda;
    pg8::StaticOrder S; S.init(M, N, (int)gridDim.x, bid_());
    pg8::gemm_phase<Epi>((LAS unsigned char*)smem, g, S, E);
    __syncthreads();
}

struct MapId { DI int operator()(int n) const { return n; } };
struct MapGU { DI int operator()(int n) const { const int q = n >> 3, e = n & 7; return e < 4 ? 4 * q + e : DFF + 4 * q + (e - 4); } };
struct MapIn { DI int operator()(int n) const { return n < IN_REAL ? n : (n < C_MG ? -1 : n - (C_MG - IN_REAL)); } };
template <class Map> __device__ __forceinline__ void transpose_cvt(unsigned char* smem, const float* src, int ldsrc, bf16_t* dst, int K, int Nd, Map map) {
    float* tile = (float*)smem;
    const int tid = tid_(), ntk = K / 64, nt = ntk * (Nd / 64);
    for (int t = bid_(); t < nt; t += gridDim.x) {
        const int n0 = (t / ntk) * 64, k0 = (t % ntk) * 64;
        const int nn = tid & 63, sc = map(n0 + nn);
#pragma unroll
        for (int p = 0; p < 8; ++p) { const int kk = (tid >> 6) + p * 8; tile[kk * 65 + nn] = sc >= 0 ? src[(size_t)(k0 + kk) * ldsrc + sc] : 0.f; }
        __syncthreads();
#pragma unroll
        for (int p = 0; p < 4; ++p) { const int nn2 = (tid >> 5) + p * 16, kk2 = (tid & 31) * 2;
            *(unsigned*)(dst + (size_t)(n0 + nn2) * K + k0 + kk2) = pack2(tile[kk2 * 65 + nn2], tile[(kk2 + 1) * 65 + nn2]); }
        __syncthreads();
    }
}
__device__ __forceinline__ void convert_layer_weights(unsigned char* smem, CP p, int L) {
    bf16_t* W = (bf16_t*)(p->ws + WS_WBF);
    transpose_cvt(smem, p->in[I_F1GU] + (size_t)L * DM * 2 * DFF, 2 * DFF, W + E_GU1, DM, 2 * DFF, MapGU());
    transpose_cvt(smem, p->in[I_F1D] + (size_t)L * DFF * DM, DM, W + E_D1, DFF, DM, MapId());
    transpose_cvt(smem, p->in[I_WIN] + (size_t)L * DM * IN_COLS, IN_COLS, W + E_IN, DM, PLD, MapIn());
    for (int j = 0; j < 3; ++j) transpose_cvt(smem, p->in[I_WBR] + ((size_t)L * 3 + j) * 512 * DM, DM, W + E_BR + (size_t)j * 1024 * 512, 512, DM, MapId());
    transpose_cvt(smem, p->in[I_WOUT] + (size_t)L * DM * DM, DM, W + E_OUT, DM, DM, MapId());
    for (int i = bid_() * 512 + tid_(); i < 1536 * 256; i += gridDim.x * 512) { const int n = i >> 8, k = i & 255; float w = 0.f;
        if (n < 512) { if (k < 64) w = p->in[I_WB][((size_t)L * 64 + k) * 512 + n]; }
        else if (n < 1024) { if (k >= 64 && k < 128) w = p->in[I_AB][((size_t)L * 64 + (k - 64)) * 512 + (n - 512)]; }
        else { if (k >= 128) w = p->in[I_GB][((size_t)L * 128 + (k - 128)) * 512 + (n - 1024)]; }
        W[E_LORA + i] = f2bf(w); }
    transpose_cvt(smem, p->in[I_PLEG] + (size_t)L * DM * DM, DM, W + E_PG, DM, DM, MapId());
    transpose_cvt(smem, p->in[I_PLEW] + (size_t)L * 256 * DM, DM, W + E_PW, 256, DM, MapId());
    for (int kv = 0; kv < 2; ++kv) for (int hf = 0; hf < 2; ++hf)
        transpose_cvt(smem, p->in[I_CW1] + ((size_t)(L * 2 + kv) * 2048 + hf * 1024) * 128, 128, W + E_C1 + ((size_t)kv * 256 + hf * 128) * 1024, 1024, 128, MapId());
    if (bid_() == gridDim.x - 1 && tid_() < 256) {
        const int kv = tid_() >> 7, hc = tid_() & 127;
        const float* pe = p->in[I_PE] + (size_t)(L * 2 + kv) * 2048; const float* w1 = p->in[I_CW1] + (size_t)(L * 2 + kv) * 2048 * 128 + hc;
        float s = 0.f; for (int i = 0; i < 2048; ++i) s += pe[i] * w1[(size_t)i * 128];
        ((float*)(p->ws + WS_PEB))[kv * 128 + hc] = s;
    }
}

__device__ __forceinline__ void convert_ffn2_weights(unsigned char* smem, CP p, int L) {
    bf16_t* W = (bf16_t*)(p->ws + WS_WBF);
    transpose_cvt(smem, p->in[I_F2GU] + (size_t)L * DM * 2 * DFF, 2 * DFF, W + E_GU2, DM, 2 * DFF, MapGU());
    transpose_cvt(smem, p->in[I_F2D] + (size_t)L * DFF * DM, DM, W + E_D2, DFF, DM, MapId());
}
__device__ __forceinline__ void lora_act(CP p, int L) {
    const bf16_t* PROJ = (const bf16_t*)(p->ws + WS_PROJ); bf16_t* LACT = (bf16_t*)(p->ws + WS_LACT);
    const float* mu = p->in[I_MU] + (size_t)L * 1792 + 1536;
    for (int i = bid_() * 512 + tid_(); i < T_TOK * 32; i += gridDim.x * 512) {
        const int t = i >> 5, j0 = (i & 31) * 8; const bf16_t* row = PROJ + (size_t)t * PLD + C_RW + 1536 + j0;
        const u32x4 cur = *(const u32x4*)row; u32x4 prv = {0u, 0u, 0u, 0u}; if ((t & (SEQ - 1)) != 0) prv = *(const u32x4*)(row - PLD);
        float r[8];
#pragma unroll
        for (int e = 0; e < 8; ++e) { const float x1 = (e & 1) ? __uint_as_float(cur[e >> 1] & 0xFFFF0000u) : __uint_as_float(cur[e >> 1] << 16);
            const float xp = (e & 1) ? __uint_as_float(prv[e >> 1] & 0xFFFF0000u) : __uint_as_float(prv[e >> 1] << 16);
            float xm = x1 + (xp - x1) * mu[j0 + e];
            if (j0 < 64) xm = tanhf(xm); else if (j0 >= 128) xm = sigmoidf_(xm);
            r[e] = xm; }
        u32x4 w; w.x = pack2(r[0], r[1]); w.y = pack2(r[2], r[3]); w.z = pack2(r[4], r[5]); w.w = pack2(r[6], r[7]);
        *(u32x4*)(LACT + (size_t)t * 256 + j0) = w;
    }
}

__device__ __forceinline__ void rmsnorm_rows(const float* hin, float* hcopy, const float* g, bf16_t* un, float* outf) {
    const int lane = tid_() & 63, gw = bid_() * 8 + (tid_() >> 6), nw = gridDim.x * 8;
    f32x4 gv[4];
#pragma unroll
    for (int i = 0; i < 4; ++i) gv[i] = *(const f32x4*)(g + lane * 4 + i * 256);
    for (int row = gw; row < T_TOK; row += nw) {
        f32x4 x[4]; float ss = 0.f;
#pragma unroll
        for (int i = 0; i < 4; ++i) { x[i] = *(const f32x4*)(hin + (size_t)row * DM + lane * 4 + i * 256); ss += x[i][0] * x[i][0] + x[i][1] * x[i][1] + x[i][2] * x[i][2] + x[i][3] * x[i][3]; }
        ss = wave_sum(ss);
        const float rs = rsqrtf(ss * (1.0f / DM) + 1e-6f);
#pragma unroll
        for (int i = 0; i < 4; ++i) {
            const f32x4 y = x[i] * rs * gv[i];
            if (hcopy) *(f32x4*)(hcopy + (size_t)row * DM + lane * 4 + i * 256) = x[i];
            if (un) { u32x2 w; w.x = pack2(y[0], y[1]); w.y = pack2(y[2], y[3]); *(u32x2*)(un + (size_t)row * DM + lane * 4 + i * 256) = w; }
            if (outf) *(f32x4*)(outf + (size_t)row * DM + lane * 4 + i * 256) = y;
        }
    }
}
__device__ __forceinline__ void cvt_f32_bf16(const float* src, bf16_t* dst, size_t n4) {
    for (size_t i = (size_t)bid_() * 512 + tid_(); i < n4; i += (size_t)gridDim.x * 512) {
        const f32x4 v = *(const f32x4*)(src + i * 4); u32x2 w; w.x = pack2(v[0], v[1]); w.y = pack2(v[2], v[3]); *(u32x2*)(dst + i * 4) = w; }
}

__device__ __forceinline__ void finalize_cmp(unsigned char* smem, CP p, int L) {
    float* hid = (float*)smem + (tid_() >> 6) * 128;
    const int lane = tid_() & 63, gw = bid_() * 8 + (tid_() >> 6), nw = gridDim.x * 8;
    const float* peb = (const float*)(p->ws + WS_PEB);
    const int total = 2 * 16 * 2 * 128, iters = (total + nw - 1) / nw;
    for (int it = 0; it < iters; ++it) {
        const int id = gw + it * nw; const bool ok = id < total;
        const int n = id & 127, gg = (id >> 7) & 1, bb = (id >> 8) & 15, kv = (id >> 12) & 1;
        if (ok && n < 127) {
            const float* Pm = (const float*)(p->ws + WS_P01) + (size_t)kv * 4096 * 256;
            const size_t r0 = (size_t)((bb * 128 + n) * 2 + gg) * 256, r1 = (size_t)((bb * 128 + n + 1) * 2 + gg) * 256;
#pragma unroll
            for (int q = 0; q < 2; ++q) { const int hc = lane + q * 64; hid[hc] = siluf_(Pm[r0 + hc] + Pm[r1 + 128 + hc] + peb[kv * 128 + hc]); }
        }
        __syncthreads();
        if (ok) {
            float o = 0.f;
            if (n < 127) { const float* w2 = p->in[I_CW2] + (size_t)(L * 2 + kv) * 128 * 64 + lane;
                for (int hc = 0; hc < 128; ++hc) o += hid[hc] * w2[hc * 64]; }
            ((float*)(p->ws + WS_KC))[((((size_t)kv * 16 + bb) * 2 + gg) * 128 + n) * 64 + lane] = o;
        }
        __syncthreads();
    }
}

__device__ __forceinline__ void hgrn_scan(unsigned char* smem, CP p, int L, int b, int h) {
    float* F = (float*)smem; float* Kx = F + 2048; float* Q = Kx + 2048; float* V = Q + 2048; float* PO = V + 2048;
    const int tid = tid_(), e = tid & 63, wv = tid >> 6, C = h * 64 + e;
    float lb;
    { const float* hl = p->in[I_HGLB]; const float a0 = hl[C], a1 = hl[512 + C], a2 = hl[1024 + C], a3 = hl[1536 + C];
      const float mx = fmaxf(fmaxf(a0, a1), fmaxf(a2, a3)); const float e0 = __expf(a0 - mx), e1 = __expf(a1 - mx), e2 = __expf(a2 - mx), e3 = __expf(a3 - mx);
      const float inv = 1.0f / (e0 + e1 + e2 + e3); float acc = 0.f; if (L >= 1) acc += e1; if (L >= 2) acc += e2; if (L >= 3) acc += e3; lb = fmaxf(acc * inv, 0.f); }
    const float ng = p->in[I_HGN][L * 512 + C];
    bf16_t* base = (bf16_t*)(p->ws + WS_PROJ) + (size_t)b * SEQ * PLD;
    f32x2 S0 = {0.f, 0.f}, S1 = {0.f, 0.f}, S2 = {0.f, 0.f}, S3 = {0.f, 0.f};
    for (int t0 = 0; t0 < SEQ; t0 += 32) {
#pragma unroll
        for (int i = 0; i < 4; ++i) { const int t = wv * 4 + i; const bf16_t* row = base + (size_t)(t0 + t) * PLD;
            const float z = bf2f(row[C_HF + C]), qr = bf2f(row[C_HQ + C]), vi = bf2f(row[C_HI + C]);
            const float sg = sigmoidf_(z); F[t * 64 + e] = sg + lb * (1.0f - sg); Kx[t * 64 + e] = (1.0f - lb) * (1.0f - sg); Q[t * 64 + e] = siluf_(qr); V[t * 64 + e] = vi; }
        __syncthreads();
#pragma unroll 4
        for (int t = 0; t < 32; ++t) {
            const f32x4 f0 = *(const f32x4*)(F + t * 64 + wv * 8), f1 = *(const f32x4*)(F + t * 64 + wv * 8 + 4);
            const f32x4 k0 = *(const f32x4*)(Kx + t * 64 + wv * 8), k1 = *(const f32x4*)(Kx + t * 64 + wv * 8 + 4);
            const f32x4 q0 = *(const f32x4*)(Q + t * 64 + wv * 8), q1 = *(const f32x4*)(Q + t * 64 + wv * 8 + 4);
            const float v = V[t * 64 + e]; const f32x2 vv = {v, v};
            S0 = (f32x2){f0[0], f0[1]} * S0 + (f32x2){k0[0], k0[1]} * vv; S1 = (f32x2){f0[2], f0[3]} * S1 + (f32x2){k0[2], k0[3]} * vv;
            S2 = (f32x2){f1[0], f1[1]} * S2 + (f32x2){k1[0], k1[1]} * vv; S3 = (f32x2){f1[2], f1[3]} * S3 + (f32x2){k1[2], k1[3]} * vv;
            f32x2 o2 = (f32x2){q0[0], q0[1]} * S0 + (f32x2){q0[2], q0[3]} * S1 + (f32x2){q1[0], q1[1]} * S2 + (f32x2){q1[2], q1[3]} * S3;
            PO[(t * 8 + wv) * 64 + e] = o2[0] + o2[1];
        }
        __syncthreads();
#pragma unroll
        for (int i = 0; i < 4; ++i) { const int t = wv * 4 + i; bf16_t* row = base + (size_t)(t0 + t) * PLD;
            float o = 0.f;
#pragma unroll
            for (int q = 0; q < 8; ++q) o += PO[(t * 8 + q) * 64 + e];
            const float ss = wave_sum(o * o); const float rs = rsqrtf(ss * (1.0f / 64.0f) + 1e-6f);
            const float gr = bf2f(row[C_HG + C]);
            row[C_HQ + C] = f2bf(o * rs * ng * siluf_(gr)); }
        __syncthreads();
    }
}

DI float dpp_xor1(float v) { return __int_as_float(__builtin_amdgcn_mov_dpp(__float_as_int(v), 0xB1, 0xF, 0xF, true)); }
DI float dpp_xor2(float v) { return __int_as_float(__builtin_amdgcn_mov_dpp(__float_as_int(v), 0x4E, 0xF, 0xF, true)); }
DI float dpp_hmir(float v) { return __int_as_float(__builtin_amdgcn_mov_dpp(__float_as_int(v), 0x141, 0xF, 0xF, true)); }
DI float red8(float v) { v += dpp_xor1(v); v += dpp_xor2(v); v += dpp_hmir(v); return v; }

__device__ __forceinline__ void rwkv_scan(unsigned char* smem, CP p, int L, int b, int h) {
    constexpr int BUF_F = 6 * 2048 + 64 + 2048;
    const int tid = tid_(), c = tid & 63, wv = tid >> 6, C = h * 64 + c, lane = c;
    const float* mu = p->in[I_MU] + (size_t)L * 1792;
    const float mu_r = mu[C], mu_k = mu[512 + C], mu_v = mu[1024 + C];
    const float w0 = p->in[I_W0][L * 512 + C], a0 = p->in[I_A0][L * 512 + C];
    const float k_k = p->in[I_KK][L * 512 + C], k_a = p->in[I_KA][L * 512 + C], r_k = p->in[I_RK][L * 512 + C], ln_w = p->in[I_LNW][L * 512 + C], ln_b = p->in[I_LNB][L * 512 + C];
    const bf16_t* base = (const bf16_t*)(p->ws + WS_PROJ) + (size_t)b * SEQ * PLD + C_RW + C;
    const bf16_t* ewa = (const bf16_t*)(p->ws + WS_UN) + (size_t)b * SEQ * 1024 + C;
    bf16_t* obase = (bf16_t*)(p->ws + WS_ORW) + (size_t)b * SEQ * 512 + C;
    const int kp = lane & 7, vr = lane >> 3, vrow = wv * 8 + vr;
    f32x2 S0 = {0.f, 0.f}, S1 = {0.f, 0.f}, S2 = {0.f, 0.f}, S3 = {0.f, 0.f};
    bf16_t pr[4], pk[4], pv[4], pe[4], pa[4], pg[4], qr, qk, qv;
#define RW_PREFETCH(T0) do { const int s0_ = (T0) + wv * 4; \
        _Pragma("unroll") for (int i = 0; i < 4; ++i) { const bf16_t* row = base + (size_t)(s0_ + i) * PLD; pr[i] = row[0]; pk[i] = row[512]; pv[i] = row[1024]; \
            pe[i] = ewa[(size_t)(s0_ + i) * 1024]; pa[i] = ewa[(size_t)(s0_ + i) * 1024 + 512]; pg[i] = obase[(size_t)(s0_ + i) * 512]; } \
        if (s0_ > 0) { const bf16_t* row = base + (size_t)(s0_ - 1) * PLD; qr = row[0]; qk = row[512]; qv = row[1024]; } else { qr = 0; qk = 0; qv = 0; } } while (0)
    RW_PREFETCH(0);
    __syncthreads();
    for (int blk = 0; blk < SEQ / 32; ++blk) {
        float* Bf = (float*)smem + (blk & 1) * BUF_F;
        float* Wd = Bf; float* NKK = Bf + 2048; float* AB = Bf + 4096; float* KX = Bf + 6144; float* WR = Bf + 8192; float* VS = Bf + 10240; float* SC = Bf + 12288; float* YS = Bf + 12352;
        float bon[4], gv[4];
        { float rp = bf2f(qr), kq = bf2f(qk), vp = bf2f(qv);
#pragma unroll
          for (int i = 0; i < 4; ++i) { const int t = wv * 4 + i;
              const float r1 = bf2f(pr[i]), k1 = bf2f(pk[i]), v1 = bf2f(pv[i]);
              const float r = r1 + (rp - r1) * mu_r, k = k1 + (kq - k1) * mu_k, v = v1 + (vp - v1) * mu_v; rp = r1; kq = k1; vp = v1;
              const float decay = __expf(-0.6065306597f * sigmoidf_(w0 + bf2f(pe[i]))), a = sigmoidf_(a0 + bf2f(pa[i])); gv[i] = bf2f(pg[i]);
              const float kkv = k * k_k; const float ssq = wave_sum(kkv * kkv); const float kkn = kkv / fmaxf(sqrtf(ssq), 1e-12f);
              const float kx = k * (1.0f + (a - 1.0f) * k_a), ab = kkn * a;
              const float br = wave_sum(ab * r), kr = wave_sum(kx * r); bon[i] = wave_sum(r * kx * r_k);
              Wd[t * 64 + c] = decay; NKK[t * 64 + c] = -kkn; AB[t * 64 + c] = ab; KX[t * 64 + c] = kx; WR[t * 64 + c] = decay * r; VS[t * 64 + c] = v;
              if (c == 0) { SC[t * 2] = br; SC[t * 2 + 1] = kr; } } }
        __syncthreads();
        if (blk + 1 < SEQ / 32) RW_PREFETCH((blk + 1) * 32);
#define RW_LOAD(T, w0v, w1v, n0, n1, b0, b1, x0, x1, q0, q1, vv, sc) do { const int o_ = (T) * 64 + kp * 8; \
            w0v = *(const f32x4*)(Wd + o_); w1v = *(const f32x4*)(Wd + o_ + 4); n0 = *(const f32x4*)(NKK + o_); n1 = *(const f32x4*)(NKK + o_ + 4); \
            b0 = *(const f32x4*)(AB + o_); b1 = *(const f32x4*)(AB + o_ + 4); x0 = *(const f32x4*)(KX + o_); x1 = *(const f32x4*)(KX + o_ + 4); \
            q0 = *(const f32x4*)(WR + o_); q1 = *(const f32x4*)(WR + o_ + 4); vv = VS[(T) * 64 + vrow]; sc = *(const f32x2*)(SC + (T) * 2); } while (0)
        f32x4 cw0, cw1, cn0, cn1, cb0, cb1, cx0, cx1, cq0, cq1; float cvv; f32x2 csc;
        RW_LOAD(0, cw0, cw1, cn0, cn1, cb0, cb1, cx0, cx1, cq0, cq1, cvv, csc);
#pragma nounroll
        for (int t8 = 0; t8 < 4; ++t8) {
            float ykeep = 0.f;
#pragma unroll
            for (int j = 0; j < 8; ++j) {
                const int t = t8 * 8 + j;
                const f32x4 w0v = cw0, w1v = cw1, n0 = cn0, n1 = cn1, b0 = cb0, b1 = cb1, x0 = cx0, x1 = cx1, q0 = cq0, q1 = cq1; const float vv = cvv; const f32x2 sc = csc;
                { const int tn = (t + 1) & 31; RW_LOAD(tn, cw0, cw1, cn0, cn1, cb0, cb1, cx0, cx1, cq0, cq1, cvv, csc); }
                const f32x2 sa2 = S0 * (f32x2){n0[0], n0[1]} + S1 * (f32x2){n0[2], n0[3]} + S2 * (f32x2){n1[0], n1[1]} + S3 * (f32x2){n1[2], n1[3]};
                const f32x2 y2 = S0 * (f32x2){q0[0], q0[1]} + S1 * (f32x2){q0[2], q0[3]} + S2 * (f32x2){q1[0], q1[1]} + S3 * (f32x2){q1[2], q1[3]};
                float sa = sa2[0] + sa2[1], yy = y2[0] + y2[1];
                sa += dpp_xor1(sa); yy += dpp_xor1(yy); sa += dpp_xor2(sa); yy += dpp_xor2(yy); sa += dpp_hmir(sa); yy += dpp_hmir(yy);
                const f32x2 sav = {sa, sa}, vv2 = {vv, vv};
                S0 = S0 * (f32x2){w0v[0], w0v[1]} + sav * (f32x2){b0[0], b0[1]} + vv2 * (f32x2){x0[0], x0[1]};
                S1 = S1 * (f32x2){w0v[2], w0v[3]} + sav * (f32x2){b0[2], b0[3]} + vv2 * (f32x2){x0[2], x0[3]};
                S2 = S2 * (f32x2){w1v[0], w1v[1]} + sav * (f32x2){b1[0], b1[1]} + vv2 * (f32x2){x1[0], x1[1]};
                S3 = S3 * (f32x2){w1v[2], w1v[3]} + sav * (f32x2){b1[2], b1[3]} + vv2 * (f32x2){x1[2], x1[3]};
                const float y = yy + sa * sc[0] + vv * sc[1];
                ykeep = (kp == j) ? y : ykeep;
            }
            YS[(t8 * 8 + kp) * 64 + vrow] = ykeep;
        }
#undef RW_LOAD
        __syncthreads();
#pragma unroll
        for (int i = 0; i < 4; ++i) { const int t = wv * 4 + i;
            const float y = YS[t * 64 + c]; const float mean = wave_sum(y) * (1.0f / 64.0f); const float dlt = y - mean;
            const float var = wave_sum(dlt * dlt) * (1.0f / 64.0f);
            float yn = dlt * rsqrtf(var + 64e-5f) * ln_w + ln_b; yn += bon[i] * VS[t * 64 + c];
            obase[(size_t)(blk * 32 + t) * 512] = f2bf(yn * gv[i]); }
    }
#undef RW_PREFETCH
    __syncthreads();
}

#define MFMA32(a, b, c) __builtin_amdgcn_mfma_f32_32x32x16_bf16((a), (b), (c), 0, 0, 0)
constexpr int KTS = 72;
DI bf16x8 pack8(float a0, float a1, float a2, float a3, float a4, float a5, float a6, float a7) {
    u32x4 w; w.x = pack2(a0, a1); w.y = pack2(a2, a3); w.z = pack2(a4, a5); w.w = pack2(a6, a7); return __builtin_bit_cast(bf16x8, w); }
DI bf16x8 ld_vfrag(const bf16_t* vt, int off) { const u32x2 lo = *(const u32x2*)(vt + off), hi = *(const u32x2*)(vt + off + 8); u32x4 w; w.x = lo.x; w.y = lo.y; w.z = hi.x; w.w = hi.y; return __builtin_bit_cast(bf16x8, w); }

struct FlashState { f32x16 o0, o1; float m, l; };

DI void flash_update(FlashState& st, f32x16& sc0, f32x16& sc1, const bf16_t* VT, int vs, int qi, int hl) {
    float mt = -INFINITY;
#pragma unroll
    for (int i = 0; i < 16; ++i) mt = fmaxf(mt, fmaxf(sc0[i], sc1[i]));
    mt = fmaxf(mt, shfl_xor_(mt, 32, qi + 32 * hl));
    const float mnew = fmaxf(st.m, mt), muse = (mnew == -INFINITY) ? 0.f : mnew;
    const float alpha = __builtin_amdgcn_exp2f(st.m - muse);
    float ls = 0.f;
#pragma unroll
    for (int i = 0; i < 16; ++i) { sc0[i] = __builtin_amdgcn_exp2f(sc0[i] - muse); sc1[i] = __builtin_amdgcn_exp2f(sc1[i] - muse); ls += sc0[i] + sc1[i]; }
    st.l = st.l * alpha + ls; st.m = mnew;
    st.o0 *= alpha; st.o1 *= alpha;
#pragma unroll
    for (int s = 0; s < 2; ++s) {
        const bf16x8 p0 = pack8(sc0[8 * s], sc0[8 * s + 1], sc0[8 * s + 2], sc0[8 * s + 3], sc0[8 * s + 4], sc0[8 * s + 5], sc0[8 * s + 6], sc0[8 * s + 7]);
        const bf16x8 p1 = pack8(sc1[8 * s], sc1[8 * s + 1], sc1[8 * s + 2], sc1[8 * s + 3], sc1[8 * s + 4], sc1[8 * s + 5], sc1[8 * s + 6], sc1[8 * s + 7]);
        st.o0 = MFMA32(ld_vfrag(VT, qi * vs + 16 * s + 4 * hl), p0, st.o0);
        st.o1 = MFMA32(ld_vfrag(VT, (32 + qi) * vs + 16 * s + 4 * hl), p0, st.o1);
        st.o0 = MFMA32(ld_vfrag(VT, qi * vs + 32 + 16 * s + 4 * hl), p1, st.o0);
        st.o1 = MFMA32(ld_vfrag(VT, (32 + qi) * vs + 32 + 16 * s + 4 * hl), p1, st.o1);
    }
}
DI void qk_tile(const bf16_t* KT, const bf16x8 (&qf)[4], int qi, int hl, f32x16& sc0, f32x16& sc1) {
#pragma unroll
    for (int i = 0; i < 16; ++i) { sc0[i] = 0.f; sc1[i] = 0.f; }
#pragma unroll
    for (int s = 0; s < 4; ++s) {
        const bf16x8 k0 = *(const bf16x8*)(KT + qi * KTS + 16 * s + 8 * hl), k1 = *(const bf16x8*)(KT + (32 + qi) * KTS + 16 * s + 8 * hl);
        sc0 = MFMA32(k0, qf[s], sc0); sc1 = MFMA32(k1, qf[s], sc1);
    }
}
struct KVRegs { u32x4 k, v; };
DI void kv_fetch(KVRegs& r, const bf16_t* pb, int kcol, int vcol, int k0) {
    const int tid = tid_();
    const unsigned ok_ = (unsigned)((k0 + (tid >> 3)) * PLD + kcol + (tid & 7) * 8) * 2u, ov_ = (unsigned)((k0 + (tid & 63)) * PLD + vcol + (tid >> 6) * 8) * 2u;
    r.k = *(const u32x4*)((const char*)pb + ok_);
    r.v = *(const u32x4*)((const char*)pb + ov_);
}
DI void kv_store(const KVRegs& r, bf16_t* KT, bf16_t* VT) {
    const int tid = tid_();
    *(u32x4*)(KT + (tid >> 3) * KTS + (tid & 7) * 8) = r.k;
    const int key = tid & 63, ch = tid >> 6;
#pragma unroll
    for (int j = 0; j < 8; ++j) VT[(ch * 8 + j) * KTS + key] = (bf16_t)((j & 1) ? (r.v[j >> 1] >> 16) : (r.v[j >> 1] & 0xFFFFu));
}
template <bool LUTB, bool CAUSAL, bool WHI, bool SEL>
DI void mask_tile(f32x16& sc0, f32x16& sc1, const float* lut, int qpos, int k0, int hl, bool sel, float qs) {
    const float bfar = lut[128];
#pragma unroll
    for (int i = 0; i < 16; ++i) { const int kl = (i & 3) + 8 * (i >> 2) + 4 * hl;
        { const int dist = qpos - (k0 + kl); const float v = sc0[i] * qs + (LUTB ? lut[dist > 128 ? 128 : (dist < 0 ? 0 : dist)] : bfar);
          bool ok = true; if (CAUSAL) ok = ok && dist >= 0; if (WHI) ok = ok && dist < 256; if (SEL) ok = ok && sel; sc0[i] = ok ? v : -INFINITY; }
        { const int dist = qpos - (k0 + 32 + kl); const float v = sc1[i] * qs + (LUTB ? lut[dist > 128 ? 128 : (dist < 0 ? 0 : dist)] : bfar);
          bool ok = true; if (CAUSAL) ok = ok && dist >= 0; if (WHI) ok = ok && dist < 256; if (SEL) ok = ok && sel; sc1[i] = ok ? v : -INFINITY; } }
}

__device__ __forceinline__ void nsa_item(unsigned char* smem, CP p, int L, int b, int g, int qb, int ocol) {
    bf16_t* KT = (bf16_t*)smem;
    bf16_t* VT = (bf16_t*)(smem + 9216);
    float* LUT = (float*)(smem + 18432);
    unsigned* SELM = (unsigned*)(smem + 20736);
    unsigned* ORM = (unsigned*)(smem + 20992);
    float* PA = (float*)(smem + 21504);
    float* PBv = (float*)(smem + 54272);
    bf16_t* KT2 = (bf16_t*)(smem + 87040);
    bf16_t* VT2 = (bf16_t*)(smem + 105472);
    const int tid = tid_(), lane = tid & 63, wv = tid >> 6, hh = wv >> 1, qhalf = wv & 1, qi = lane & 31, hl = lane >> 5;
    const int ql = qhalf * 32 + qi, qpos = qb * 64 + ql, head = g * 4 + hh;
    bf16_t* pb = (bf16_t*)(p->ws + WS_PROJ) + (size_t)b * SEQ * PLD;
    bf16_t* qrow = pb + (size_t)qpos * PLD;
    __syncthreads();
    for (int i = tid; i < 4 * 129; i += 512) { const int h2 = i / 129, dd = i % 129; int bk;
        if (dd < 16) bk = dd; else if (dd >= 128) bk = 31; else { bk = 16 + (int)(logf((float)dd / 16.0f) / 2.0794415416798357f * 16.0f); bk = bk > 31 ? 31 : bk; }
        LUT[h2 * 132 + dd] = p->in[I_RELB][bk * 8 + g * 4 + h2] * 1.4426950408889634f; }
    if (tid == 0) *ORM = 0u;
    if (tid < 64) SELM[tid] = 0u;
    if (tid < 256) PBv[tid * 32] = 0.f;
    { const float* kc = (const float*)(p->ws + WS_KC) + ((size_t)(0 * 16 + b) * 2 + g) * 128 * 64; const float* vc = (const float*)(p->ws + WS_KC) + ((size_t)(1 * 16 + b) * 2 + g) * 128 * 64;
      for (int i = tid; i < 128 * 64; i += 512) { const int n = i >> 6, d = i & 63; KT2[n * KTS + d] = f2bf(kc[i]); }
      for (int i = tid; i < 128 * 64; i += 512) { const int n = i & 127, d = i >> 7; VT2[d * 136 + n] = f2bf(vc[n * 64 + d]); } }
    bf16x8 qf[4];
#pragma unroll
    for (int s = 0; s < 4; ++s) qf[s] = *(const bf16x8*)(qrow + C_NQ + head * 64 + 16 * s + 8 * hl);
    float g0, g1, g2;
    { const bf16_t* gp = qrow + C_NG + head * 3; g0 = sigmoidf_(bf2f(gp[0])); g1 = sigmoidf_(bf2f(gp[1])); g2 = sigmoidf_(bf2f(gp[2])); }
    __syncthreads();
    const float* lut = LUT + hh * 132;
    constexpr float QS = 0.125f * 1.4426950408889634f;
    f32x16 fin0, fin1;
    {
        FlashState st;
#pragma unroll
        for (int i = 0; i < 16; ++i) { st.o0[i] = 0.f; st.o1[i] = 0.f; }
        st.m = -INFINITY; st.l = 0.f;
#pragma nounroll
        for (int t = 0; t < 2; ++t) {
            f32x16 sc0, sc1; qk_tile(KT2 + t * 64 * KTS, qf, qi, hl, sc0, sc1);
#pragma unroll
            for (int i = 0; i < 16; ++i) { const int kl = (i & 3) + 8 * (i >> 2) + 4 * hl;
                { const int n = 64 * t + kl, dist = qpos - (16 * n + 31); sc0[i] = (dist >= 0 && n < 127) ? sc0[i] * QS + lut[dist > 128 ? 128 : dist] : -INFINITY; }
                { const int n = 64 * t + 32 + kl, dist = qpos - (16 * n + 31); sc1[i] = (dist >= 0 && n < 127) ? sc1[i] * QS + lut[dist > 128 ? 128 : dist] : -INFINITY; } }
            flash_update(st, sc0, sc1, VT2 + 64 * t, 136, qi, hl);
        }
        const float lt = st.l + shfl_xor_(st.l, 32, lane); const float inv = 1.0f / fmaxf(lt, 1e-30f);
        const float muse = (st.m == -INFINITY) ? 0.f : st.m;
        fin0 = st.o0 * (g0 * inv); fin1 = st.o1 * (g0 * inv);
#pragma nounroll
        for (int t = 0; t < 2; ++t) {
            f32x16 sc0, sc1; qk_tile(KT2 + t * 64 * KTS, qf, qi, hl, sc0, sc1);
#pragma unroll
            for (int i = 0; i < 16; ++i) { const int kl = (i & 3) + 8 * (i >> 2) + 4 * hl;
                { const int n = 64 * t + kl, dist = qpos - (16 * n + 31); sc0[i] = (dist >= 0 && n < 127) ? __builtin_amdgcn_exp2f(sc0[i] * QS + lut[dist > 128 ? 128 : dist] - muse) * inv : 0.f; }
                { const int n = 64 * t + 32 + kl, dist = qpos - (16 * n + 31); sc1[i] = (dist >= 0 && n < 127) ? __builtin_amdgcn_exp2f(sc1[i] * QS + lut[dist > 128 ? 128 : dist] - muse) * inv : 0.f; } }
#pragma unroll
            for (int i4 = 0; i4 < 4; ++i4) {
                { const int m = 16 * t + 2 * i4 + hl; PA[(hh * 64 + ql) * 32 + m] = sc0[4 * i4] + sc0[4 * i4 + 1] + sc0[4 * i4 + 2] + sc0[4 * i4 + 3]; PBv[(hh * 64 + ql) * 32 + m + 1] = sc0[4 * i4 + 3]; }
                { const int m = 16 * t + 8 + 2 * i4 + hl; PA[(hh * 64 + ql) * 32 + m] = sc1[4 * i4] + sc1[4 * i4 + 1] + sc1[4 * i4 + 2] + sc1[4 * i4 + 3]; if (m + 1 < 32) PBv[(hh * 64 + ql) * 32 + m + 1] = sc1[4 * i4 + 3]; }
            }
        }
    }
    __syncthreads();
    {
        float* IMP = (float*)smem;
        const int q = tid & 63, part = tid >> 6, cur = qb;
#pragma unroll
        for (int mm = 0; mm < 4; ++mm) { const int m = part * 4 + mm; float v;
            if (m == 0 || m == cur || m == cur - 1) v = INFINITY;
            else if (m <= cur) { v = 0.f; for (int h2 = 0; h2 < 4; ++h2) v += PA[(h2 * 64 + q) * 32 + m] + PBv[(h2 * 64 + q) * 32 + m]; }
            else v = -INFINITY;
            IMP[q * 33 + m] = v; }
        __syncthreads();
        unsigned bits = 0u;
#pragma unroll
        for (int mm = 0; mm < 4; ++mm) { const int m = part * 4 + mm; const float v = IMP[q * 33 + m]; int rank = 0;
            for (int m2 = 0; m2 < 32; ++m2) { const float v2 = IMP[q * 33 + m2]; rank += (v2 > v || (v2 == v && m2 < m)) ? 1 : 0; }
            if (rank < 8 && v > -INFINITY) bits |= 1u << m; }
        atomicOr(&SELM[q], bits); atomicOr(ORM, bits);
    }
    __syncthreads();
    const unsigned mysel = SELM[ql], orm = *ORM;
    __syncthreads();
    float* PARK = PA + (wv * 32) * 64 + lane;
#pragma unroll
    for (int i = 0; i < 16; ++i) { PARK[i * 64] = fin0[i]; PARK[(16 + i) * 64] = fin1[i]; }
    {
        FlashState st;
#pragma unroll
        for (int i = 0; i < 16; ++i) { st.o0[i] = 0.f; st.o1[i] = 0.f; }
        st.m = -INFINITY; st.l = 0.f;
        const unsigned todo = orm & (qb >= 31 ? 0xFFFFFFFFu : ((2u << qb) - 1u));
        KVRegs kr;
        int m = todo ? __builtin_ctz(todo) : -1;
        if (m >= 0) { kv_fetch(kr, pb, C_KS + g * 64, C_VS + g * 64, m * 64); __syncthreads(); kv_store(kr, KT, VT); __syncthreads(); }
        while (m >= 0) {
            const unsigned rest = todo & ~((2u << m) - 1u); const int nm = (m < 31 && rest) ? __builtin_ctz(rest) : -1;
            if (nm >= 0) kv_fetch(kr, pb, C_KS + g * 64, C_VS + g * 64, nm * 64);
            f32x16 sc0, sc1; qk_tile(KT, qf, qi, hl, sc0, sc1);
            const bool sel = (mysel >> m) & 1u;
            if (m + 3 <= qb) mask_tile<false, false, false, true>(sc0, sc1, lut, qpos, m * 64, hl, sel, QS);
            else mask_tile<true, true, false, true>(sc0, sc1, lut, qpos, m * 64, hl, sel, QS);
            flash_update(st, sc0, sc1, VT, KTS, qi, hl);
            __syncthreads();
            if (nm >= 0) kv_store(kr, KT, VT);
            __syncthreads();
            m = nm;
        }
        const float lt = st.l + shfl_xor_(st.l, 32, lane); const float sc = g1 / fmaxf(lt, 1e-30f);
#pragma unroll
        for (int i = 0; i < 16; ++i) { PARK[i * 64] += st.o0[i] * sc; PARK[(16 + i) * 64] += st.o1[i] * sc; }
    }
    {
        FlashState st;
#pragma unroll
        for (int i = 0; i < 16; ++i) { st.o0[i] = 0.f; st.o1[i] = 0.f; }
        st.m = -INFINITY; st.l = 0.f;
        KVRegs kr;
        int w = qb >= 4 ? 0 : 4 - qb;
        kv_fetch(kr, pb, C_KW + g * 64, C_VW + g * 64, qb * 64 - 256 + 64 * w); __syncthreads(); kv_store(kr, KT, VT); __syncthreads();
        for (; w < 5; ++w) {
            const int k0 = qb * 64 - 256 + 64 * w;
            if (w < 4) kv_fetch(kr, pb, C_KW + g * 64, C_VW + g * 64, k0 + 64);
            f32x16 sc0, sc1; qk_tile(KT, qf, qi, hl, sc0, sc1);
            if (w == 0) mask_tile<false, false, true, false>(sc0, sc1, lut, qpos, k0, hl, true, QS);
            else if (w == 1) mask_tile<false, false, false, false>(sc0, sc1, lut, qpos, k0, hl, true, QS);
            else if (w < 4) mask_tile<true, false, false, false>(sc0, sc1, lut, qpos, k0, hl, true, QS);
            else mask_tile<true, true, false, false>(sc0, sc1, lut, qpos, k0, hl, true, QS);
            flash_update(st, sc0, sc1, VT, KTS, qi, hl);
            __syncthreads();
            if (w < 4) kv_store(kr, KT, VT);
            __syncthreads();
        }
        const float lt = st.l + shfl_xor_(st.l, 32, lane); const float sc = g2 / fmaxf(lt, 1e-30f);
#pragma unroll
        for (int i = 0; i < 16; ++i) { fin0[i] = PARK[i * 64] + st.o0[i] * sc; fin1[i] = PARK[(16 + i) * 64] + st.o1[i] * sc; }
    }
#pragma unroll
    for (int i4 = 0; i4 < 4; ++i4) {
        u32x2 w0; w0.x = pack2(fin0[4 * i4], fin0[4 * i4 + 1]); w0.y = pack2(fin0[4 * i4 + 2], fin0[4 * i4 + 3]);
        u32x2 w1; w1.x = pack2(fin1[4 * i4], fin1[4 * i4 + 1]); w1.y = pack2(fin1[4 * i4 + 2], fin1[4 * i4 + 3]);
        *(u32x2*)(qrow + ocol + head * 64 + 8 * i4 + 4 * hl) = w0;
        *(u32x2*)(qrow + ocol + head * 64 + 32 + 8 * i4 + 4 * hl) = w1;
    }
}

constexpr int PH_PER_LAYER = 16, PH_TOTAL = DEPTH * PH_PER_LAYER + 1;
enum { S_PREP = 0, S_GU1, S_D1, S_NORM_MIX, S_WIN, S_CMP, S_LORA, S_SCAN, S_NSA, S_MERGE, S_OUT, S_NORM2, S_GU2, S_D2, S_NORM_PLE, S_PLEG, S_FINAL };

__device__ __forceinline__ void run_phase(unsigned char* smem, CP p, int ph) {
    const bool fin = (ph == DEPTH * PH_PER_LAYER);
    const int L = fin ? 0 : ph / PH_PER_LAYER; const int sub = fin ? S_FINAL : ph % PH_PER_LAYER;
    unsigned char* ws = p->ws; float* H = p->out;
    bf16_t* W = (bf16_t*)(ws + WS_WBF); bf16_t* UN = (bf16_t*)(ws + WS_UN); bf16_t* PROJ = (bf16_t*)(ws + WS_PROJ); bf16_t* ACT = (bf16_t*)(ws + WS_ACT);
    bf16_t* TMP = (bf16_t*)(ws + WS_TMP); bf16_t* PBF = (bf16_t*)(ws + WS_PB); bf16_t* ORW = (bf16_t*)(ws + WS_ORW);
    bf16_t* XK = (bf16_t*)(ws + WS_XK); bf16_t* XV = (bf16_t*)(ws + WS_XV); float* P01 = (float*)(ws + WS_P01);
    if (sub == S_PREP) convert_layer_weights(smem, p, L);
    if (sub == S_NORM_MIX) convert_ffn2_weights(smem, p, L);
    if (sub == S_NORM2) cvt_f32_bf16(p->in[I_P] + (size_t)L * T_TOK * 256, PBF, (size_t)T_TOK * 256 / 4);
    if (sub == S_CMP) lora_act(p, L);
    if (sub == S_LORA) finalize_cmp(smem, p, L);
    if (sub == S_NORM_PLE) { EpiBf16 e; e.O = TMP; run_gemm(smem, PBF, 256, W + E_PW, T_TOK, DM, 256, e); }
    if (sub == S_PREP || sub == S_NORM_MIX || sub == S_NORM2 || sub == S_NORM_PLE || sub == S_FINAL) {
        const float* hin = (sub == S_PREP && L == 0) ? p->in[I_X] : H; float* hcopy = (sub == S_PREP && L == 0) ? H : nullptr;
        const float* g = sub == S_PREP ? p->in[I_F1N] + L * DM : sub == S_NORM_MIX ? p->in[I_MIXN] + L * DM : sub == S_NORM2 ? p->in[I_F2N] + L * DM : sub == S_NORM_PLE ? p->in[I_PLEN] + L * DM : p->in[I_FINN];
        rmsnorm_rows(hin, hcopy, g, sub == S_FINAL ? nullptr : UN, sub == S_FINAL ? H : nullptr);
    } else if (sub == S_GU1 || sub == S_GU2) {
        EpiSwiglu e; e.O = ACT; run_gemm(smem, UN, DM, W + (sub == S_GU1 ? E_GU1 : E_GU2), T_TOK, 2 * DFF, DM, e);
    } else if (sub == S_D1 || sub == S_D2 || sub == S_OUT) {
        EpiResid e; e.H = H; e.scale = sub == S_OUT ? 1.0f : 0.5f;
        run_gemm(smem, sub == S_OUT ? UN : ACT, sub == S_OUT ? DM : DFF, W + (sub == S_D1 ? E_D1 : sub == S_D2 ? E_D2 : E_OUT), T_TOK, DM, sub == S_OUT ? DM : DFF, e);
    } else if (sub == S_WIN) {
        EpiProj e; e.O = PROJ; e.XK = XK; e.XV = XV; run_gemm(smem, UN, DM, W + E_IN, T_TOK, PLD, DM, e);
    } else if (sub == S_CMP) {
#pragma nounroll
        for (int kv = 0; kv < 2; ++kv) { EpiF32 e; e.C = P01 + (size_t)kv * 4096 * 256;
            run_gemm(smem, kv ? XV : XK, 1024, W + E_C1 + (size_t)kv * 256 * 1024, 4096, 256, 1024, e); }
    } else if (sub == S_LORA) {
        EpiLora e; e.EWA = UN; e.G = ORW;
        run_gemm(smem, (const bf16_t*)(ws + WS_LACT), 256, W + E_LORA, T_TOK, 1536, 256, e);
    } else if (sub == S_SCAN) {
        for (int item = bid_(); item < 256; item += gridDim.x) {
            __syncthreads();
            if (item < 128) rwkv_scan(smem, p, L, item >> 3, item & 7); else hgrn_scan(smem, p, L, (item - 128) >> 3, (item - 128) & 7);
        }
    } else if (sub == S_NSA) {
        for (int idx = bid_(), k = 0; idx < 1024; idx += gridDim.x, ++k) {
            const int bg = idx & 31, qq = idx >> 5; const int qb = (k & 1) ? ((qq & ~7) + 7 - (qq & 7)) : qq;
            nsa_item(smem, p, L, bg >> 1, bg & 1, qb, C_NQ);
        }
    } else if (sub == S_MERGE) {
#pragma nounroll
        for (int j = 0; j < 3; ++j) { EpiMerge e; e.MRG = UN; e.PROJ = PROJ; e.J = j;
            const bf16_t* A = j == 0 ? PROJ + C_HQ : (j == 1 ? PROJ + C_NQ : ORW);
            run_gemm(smem, A, j == 2 ? 512 : PLD, W + E_BR + (size_t)j * 1024 * 512, T_TOK, DM, 512, e); }
    } else if (sub == S_PLEG) {
        EpiPleGate e; e.H = H; e.TMP = TMP; run_gemm(smem, UN, DM, W + E_PG, T_TOK, DM, DM, e);
    }
}

#define XB_TMO      128
#define XB_XCNT(j)  (256  + 64 * (j))
#define XB_XSUB(j)  (1280 + 64 * (j))
#define XB_XGEN(j)  (2304 + 64 * (j))
#define XB_TOP      3328
#define XB_TOPGEN   3392
#define XCD_BAR_WORDS 3456
#define XB_SPIN_CAP (1u << 20)
DI unsigned xb_ld(unsigned* p)              { return __hip_atomic_load(p, __ATOMIC_RELAXED, __HIP_MEMORY_SCOPE_AGENT); }
DI unsigned xb_add(unsigned* p, unsigned v) { return __hip_atomic_fetch_add(p, v, __ATOMIC_RELAXED, __HIP_MEMORY_SCOPE_AGENT); }
DI unsigned xb_xcc_id() { return (unsigned)__builtin_amdgcn_s_getreg((3 << 11) | 20) & 0xFu; }
#define XB_SPIN(cond, bar) do { unsigned _sp = 0; while (cond) { __builtin_amdgcn_s_sleep(1); \
    if ((++_sp & 255u) == 0u) { if (xb_ld(&(bar)[XB_TMO])) break; if (_sp > XB_SPIN_CAP) { atomicAdd(&(bar)[XB_TMO], 1u); break; } } } } while (0)
struct XcdBarrier { unsigned* bar; unsigned x; volatile LAS unsigned* st; };
DI XcdBarrier xcd_barrier_post(unsigned* bar, volatile LAS unsigned* st) {
    XcdBarrier b; b.bar = bar; b.x = xb_xcc_id(); b.st = st;
    if (threadIdx.x == 0) (void)xb_add(&bar[XB_XCNT(b.x)], 1u);
    return b;
}
DI void xcd_barrier_complete(unsigned* bar, unsigned x, unsigned& nloc, unsigned& nx) {
    const unsigned G = gridDim.x * gridDim.y * gridDim.z;
    unsigned sum, cnt, mine, sp = 0u;
    for (;;) {
        sum = 0u; cnt = 0u; mine = 0u;
#pragma unroll
        for (unsigned j = 0; j < 16; ++j) { const unsigned c = xb_ld(&bar[XB_XCNT(j)]); sum += c; cnt += (c > 0u) ? 1u : 0u; mine = (j == x) ? c : mine; }
        if (sum == G) break;
        __builtin_amdgcn_s_sleep(1);
        if ((++sp & 255u) == 0u) { if (xb_ld(&bar[XB_TMO])) break; if (sp > XB_SPIN_CAP) { atomicAdd(&bar[XB_TMO], 1u); break; } }
    }
    nloc = mine > 0u ? mine : 1u; nx = cnt > 0u ? cnt : 1u;
}
DI void xcd_barrier(const XcdBarrier& b) {
    asm volatile("s_waitcnt vmcnt(0)" ::: "memory");
    __syncthreads();
    if (threadIdx.x == 0) {
        unsigned* bar = b.bar;
        __builtin_amdgcn_s_waitcnt(0);
        unsigned nloc = b.st[0], nx = b.st[1];
        if (nloc == 0u) { xcd_barrier_complete(bar, b.x, nloc, nx); b.st[0] = nloc; b.st[1] = nx; }
        const unsigned old = xb_add(&bar[XB_XSUB(b.x)], 1u);
        const unsigned gen = old / nloc;
        if (old + 1u == (gen + 1u) * nloc) {
            __builtin_amdgcn_fence(__ATOMIC_RELEASE, "agent");
            asm volatile("s_waitcnt vmcnt(0)" ::: "memory");
            const unsigned og = xb_add(&bar[XB_TOP], 1u);
            const unsigned tg = og / nx;
            if (og + 1u == (tg + 1u) * nx) xb_add(&bar[XB_TOPGEN], 1u);
            else XB_SPIN(xb_ld(&bar[XB_TOPGEN]) == tg, bar);
            __builtin_amdgcn_fence(__ATOMIC_ACQUIRE, "agent");
            xb_add(&bar[XB_XGEN(b.x)], 1u);
            asm volatile("s_waitcnt vmcnt(0)" ::: "memory");
        } else {
            XB_SPIN(xb_ld(&bar[XB_XGEN(b.x)]) == gen, bar);
            __builtin_amdgcn_fence(__ATOMIC_ACQUIRE, "agent");
            asm volatile("s_waitcnt vmcnt(0)" ::: "memory");
        }
    }
    __syncthreads();
}

__global__ void __launch_bounds__(512, 2) mega_fwd(Params p) {
    extern __shared__ __attribute__((aligned(16))) unsigned char smem[];
    cg::grid_group grid = cg::this_grid();
    volatile LAS unsigned* xst = (volatile LAS unsigned*)(LAS unsigned char*)(smem + 140 * 1024);
    if (threadIdx.x == 0) { xst[0] = 0u; xst[1] = 0u; }
    __syncthreads();
    const XcdBarrier xb = xcd_barrier_post((unsigned*)(p.ws + WS_BAR), xst);
#ifndef PROBE_DUP
#define PROBE_DUP -1
#endif
    constexpr int IT_PER_LAYER = PH_PER_LAYER + (PROBE_DUP >= 0 ? 1 : 0);
    const int it_lo = p.ph_lo, it_hi = PROBE_DUP >= 0 ? DEPTH * IT_PER_LAYER + 1 : p.ph_hi;
    for (int it = it_lo; it < it_hi; ++it) {
        int ph = it;
        if (PROBE_DUP >= 0) { const int l_ = it / IT_PER_LAYER, r_ = it % IT_PER_LAYER; ph = l_ * PH_PER_LAYER + (r_ <= PROBE_DUP ? r_ : r_ - 1); }
        CP pp = (CP)__builtin_amdgcn_kernarg_segment_ptr(); asm volatile("" : "+s"(pp));
        run_phase(smem, pp, ph);
        if (it + 1 < it_hi) {
            if (it == it_lo) grid.sync();
            else xcd_barrier(xb);
        }
    }
}

#ifndef MULTI_LAUNCH
#define MULTI_LAUNCH 0
#endif

extern "C" void kernel_launch(void* const* d_in, const int* in_sizes, int n_in, void* d_out, int out_size, void* d_ws, size_t ws_size, hipStream_t stream) {
    static int grid = 0;
    if (grid == 0) {
        if (n_in != N_INPUTS || out_size != T_TOK * DM || ws_size < WS_END) { fprintf(stderr, "kernel_launch: unexpected shapes: n_in %d out %d ws %zu (need %zu)\n", n_in, out_size, ws_size, (size_t)WS_END); grid = -1; return; }
        int dev = 0, cus = 0, per_cu = 0;
        (void)hipGetDevice(&dev); (void)hipDeviceGetAttribute(&cus, hipDeviceAttributeMultiprocessorCount, dev);
        if (hipFuncSetAttribute((const void*)mega_fwd, hipFuncAttributeMaxDynamicSharedMemorySize, LDS_BYTES) != hipSuccess) { fprintf(stderr, "kernel_launch: hipFuncSetAttribute failed\n"); grid = -1; return; }
        if (hipOccupancyMaxActiveBlocksPerMultiprocessor(&per_cu, (const void*)mega_fwd, 512, LDS_BYTES) != hipSuccess || per_cu < 1) { fprintf(stderr, "kernel_launch: occupancy query gives %d\n", per_cu); per_cu = 1; }
        (void)hipGetLastError();
        grid = cus * 1;
        if (grid > 256) grid = 256;
        fprintf(stderr, "kernel_launch: grid %d (cus %d, per_cu %d)\n", grid, cus, per_cu);
    }
    if (grid < 0) return;
    (void)hipMemsetAsync(d_ws, 0, 16384, stream);
    Params p{};
    for (int i = 0; i < N_INPUTS; ++i) p.in[i] = (const float*)d_in[i];
    p.out = (float*)d_out; p.ws = (unsigned char*)d_ws;
#if MULTI_LAUNCH
    for (int ph = 0; ph < PH_TOTAL; ++ph) { p.ph_lo = ph; p.ph_hi = ph + 1; hipLaunchKernelGGL(mega_fwd, dim3(grid), dim3(512), LDS_BYTES, stream, p); }
#else
    p.ph_lo = 0; p.ph_hi = PH_TOTAL;
    void* args[] = {&p};
    hipError_t e = hipLaunchCooperativeKernel((const void*)mega_fwd, dim3(grid), dim3(512), args, LDS_BYTES, stream);
    if (e != hipSuccess) fprintf(stderr, "kernel_launch: cooperative launch failed: %s\n", hipGetErrorString(e));
#endif
}
```

```cpp
#include <hip/hip_runtime.h>
#include <hip/hip_cooperative_groups.h>
#include <cstdio>
namespace cg = cooperative_groups;

#define LAS __attribute__((address_space(3)))
#define DI __device__ __forceinline__
typedef unsigned short bf16_t;
typedef short bf16x8 __attribute__((ext_vector_type(8)));
typedef float f32x4 __attribute__((ext_vector_type(4)));
typedef float f32x2 __attribute__((ext_vector_type(2)));
typedef float f32x16 __attribute__((ext_vector_type(16)));
typedef unsigned u32x4 __attribute__((ext_vector_type(4)));
typedef unsigned u32x2 __attribute__((ext_vector_type(2)));

constexpr int T_TOK = 32768, SEQ = 2048, NB = 16, DM = 1024, DFF = 2816, DEPTH = 4;
constexpr int PLD = 8448;
constexpr int C_HQ = 0, C_HF = 512, C_HI = 1024, C_HG = 1536, C_NQ = 2048, C_KC = 2560, C_VC = 2688, C_KS = 2816, C_VS = 2944,
              C_KW = 3072, C_VW = 3200, C_NG = 3328, C_RW = 3352, C_MG = 5376, IN_REAL = 5144, IN_COLS = 8216;
enum { I_X = 0, I_P, I_F1N, I_F1GU, I_F1D, I_MIXN, I_WIN, I_HGLB, I_HGN, I_PE, I_CW1, I_CW2, I_RELB, I_MU, I_W0, I_WB, I_A0, I_AB, I_GB,
       I_KK, I_KA, I_RK, I_LNW, I_LNB, I_WBR, I_WOUT, I_F2N, I_F2GU, I_F2D, I_PLEN, I_PLEG, I_PLEW, I_FINN, N_INPUTS };

constexpr size_t WS_BAR = 0;
constexpr size_t WS_PEB = 16384;
constexpr size_t WS_WBF = 20480;
constexpr size_t E_GU1 = 0, E_D1 = E_GU1 + 5632ull * 1024, E_IN = E_D1 + 1024ull * 2816, E_BR = E_IN + 8448ull * 1024, E_OUT = E_BR + 3ull * 1024 * 512,
                 E_GU2 = E_GU1, E_D2 = E_D1  , E_PG = E_OUT + 1024ull * 1024, E_PW = E_PG + 1024ull * 1024,
                 E_C1 = E_PW + 1024ull * 256, E_LORA = E_C1 + 2ull * 256 * 1024, E_END = E_LORA + 1536ull * 256;
constexpr size_t WS_UN = WS_WBF + E_END * 2;
constexpr size_t WS_ORW = WS_UN + (size_t)T_TOK * 1024 * 2;
constexpr size_t WS_XK = WS_ORW + (size_t)T_TOK * 512 * 2;
constexpr size_t WS_XV = WS_XK + 4096ull * 1024 * 2;
constexpr size_t WS_P01 = WS_XV + 4096ull * 1024 * 2;
constexpr size_t WS_KC = WS_P01 + 2ull * 4096 * 256 * 4;
constexpr size_t WS_LACT = WS_KC + 2ull * 16 * 2 * 128 * 64 * 4;
constexpr size_t WS_PROJ = WS_LACT + (size_t)T_TOK * 256 * 2;
constexpr size_t WS_END = WS_PROJ + (size_t)T_TOK * PLD * 2;
constexpr size_t WS_ACT = WS_PROJ;
constexpr size_t WS_PB = WS_PROJ + 200ull * 1024 * 1024;
constexpr size_t WS_TMP = WS_PROJ + 256ull * 1024 * 1024;
constexpr int LDS_BYTES = 144 * 1024;

struct Params {
    const float* in[N_INPUTS];
    float* out;
    unsigned char* ws;
    int ph_lo, ph_hi;
};
typedef const Params __attribute__((address_space(4)))* CP;

DI int tid_() { int t = threadIdx.x; asm volatile("" : "+v"(t)); return t; }
DI int bid_() { int b = blockIdx.x; asm volatile("" : "+s"(b)); return b; }
typedef __bf16 bf16v2 __attribute__((ext_vector_type(2)));
DI float bf2f(bf16_t b) { return __uint_as_float(((unsigned)b) << 16); }
DI unsigned pack2(float lo, float hi) { const f32x2 v = {lo, hi}; return __builtin_bit_cast(unsigned, __builtin_convertvector(v, bf16v2)); }
DI bf16_t f2bf(float f) { return (bf16_t)(pack2(f, 0.f) & 0xFFFFu); }
DI float sigmoidf_(float x) { return __builtin_amdgcn_rcpf(1.0f + __builtin_amdgcn_exp2f(-1.4426950408889634f * x)); }
DI float siluf_(float x) { return x * __builtin_amdgcn_rcpf(1.0f + __builtin_amdgcn_exp2f(-1.4426950408889634f * x)); }
DI float shfl_xor_(float v, int mask, int lane) { return __int_as_float(__builtin_amdgcn_ds_bpermute((lane ^ mask) << 2, __float_as_int(v))); }
DI float dppf_(float v, int) { return v; }
#define DPPF(v, ctrl) __int_as_float(__builtin_amdgcn_mov_dpp(__float_as_int(v), ctrl, 0xF, 0xF, true))
DI float wave_sum(float v) {
    v += DPPF(v, 0xB1); v += DPPF(v, 0x4E); v += DPPF(v, 0x141); v += DPPF(v, 0x140);
    const float s0 = __int_as_float(__builtin_amdgcn_readlane(__float_as_int(v), 0)), s1 = __int_as_float(__builtin_amdgcn_readlane(__float_as_int(v), 16));
    const float s2 = __int_as_float(__builtin_amdgcn_readlane(__float_as_int(v), 32)), s3 = __int_as_float(__builtin_amdgcn_readlane(__float_as_int(v), 48));
    return (s0 + s1) + (s2 + s3);
}

namespace pg8 {
constexpr int BM = 256, BK = 64, HALF = 128, HTB = HALF * BK * 2, STAGE_BYTES = 8 * HTB, NXCD = 8, WGM = 8;
DI int lds_byte(int r, int c) { const int st = (r >> 4) * 2 + (c >> 5), rr = r & 15, cc = c & 31, ob = rr * 64 + cc * 2; return st * 1024 + (ob ^ (((ob >> 9) & 1) << 5)); }
DI void stage_rc(int b, int& R, int& C) { const int st = b / 1024, sb = b % 1024, swz = sb ^ (((sb >> 9) & 1) << 5); R = (st >> 1) * 16 + swz / 64; C = (st & 1) * 32 + (swz % 64) / 2; }
DI int perm32(int rho) { const int n = rho >> 4, i = rho & 15; return 8 * (i >> 2) + 4 * n + (i & 3); }
struct Unit { int pm, pn; };
struct Gemm { const bf16_t* A; const bf16_t* Bt; int M, N, K, lda; };
struct StaticOrder {
    int nM, nN, nwg, G, c;
    DI void init(int M, int N, int G_, int c_) { nM = M / BM; nN = N / BM; nwg = nM * nN; G = G_; c = c_; }
    DI bool next(int i, Unit& u) const {
        const long L = (long)i * G + c; if (L >= nwg) return false;
        int wgid = (int)L; { const int q = nwg / NXCD, r = nwg % NXCD, xcd = wgid % NXCD, off = wgid / NXCD; wgid = (xcd < r ? xcd * (q + 1) : r * (q + 1) + (xcd - r) * q) + off; }
        const int nig = WGM * nN, gid = wgid / nig, fm = gid * WGM, gsz = (nM - fm) < WGM ? (nM - fm) : WGM;
        u.pm = fm + ((wgid % nig) % gsz); u.pn = (wgid % nig) / gsz; return true;
    }
};

template <class Epi>
DI void gemm_phase(LAS unsigned char* lds, const Gemm g, const StaticOrder& S, const Epi& E) {
    int tid = tid_();
    const int wid = __builtin_amdgcn_readfirstlane(tid >> 6), lane = tid & 63, wr = wid >> 2, wc = wid & 3, fr = lane & 15, fq = lane >> 4;
    const int K = g.K, nt = K / BK, lda = g.lda;
    unsigned voffA[2], voffB[2];
#pragma unroll
    for (int i = 0; i < 2; ++i) { int R, C; stage_rc(tid * 16 + i * 8192, R, C); const int Rb = Epi::PERM ? ((R & ~31) + perm32(R & 31)) : R;
        voffA[i] = (unsigned)(R * lda + C) * 2u; voffB[i] = (unsigned)(Rb * K + C) * 2u; }
    const size_t kstep = (size_t)(BK * 2);
    const size_t hstepA = (size_t)HALF * lda * 2, hstepB = (size_t)HALF * K * 2;
    const size_t tstepA = 2 * hstepA, tstepB = 2 * hstepB;
    const unsigned ldsw = (unsigned)wid * 1024u;
    const int aoff = lds_byte(wr * 64 + fr, fq * 8), boff = lds_byte(wc * 32 + fr, fq * 8);
#define PG8_SA(b, h) (((b) * 2 + (h)) * HTB)
#define PG8_SB(b, h) ((4 + (b) * 2 + (h)) * HTB)
#define PG8_STAGE(bufoff, gbase, voff) do { _Pragma("unroll") for (int _i = 0; _i < 2; ++_i) \
        __builtin_amdgcn_global_load_lds((const unsigned*)((const char*)(gbase) + (voff)[_i]), (LAS unsigned*)(lds + (bufoff) + ldsw + _i * 8192), 16, 0, 0); } while (0)
#define PG8_LDA(dst, b, h) do { _Pragma("unroll") for (int m = 0; m < 4; ++m) _Pragma("unroll") for (int k = 0; k < 2; ++k) dst[m][k] = *(const LAS bf16x8*)(lds + PG8_SA(b, h) + aoff + m * 2048 + k * 1024); } while (0)
#define PG8_LDB(dst, b, h) do { _Pragma("unroll") for (int n = 0; n < 2; ++n) _Pragma("unroll") for (int k = 0; k < 2; ++k) dst[n][k] = *(const LAS bf16x8*)(lds + PG8_SB(b, h) + boff + n * 2048 + k * 1024); } while (0)
#define PG8_MMA(ai, bj, At, Bt) do { __builtin_amdgcn_s_setprio(1); _Pragma("unroll") for (int m = 0; m < 4; ++m) _Pragma("unroll") for (int n = 0; n < 2; ++n) _Pragma("unroll") for (int k = 0; k < 2; ++k) \
        acc[ai][bj][m][n] = __builtin_amdgcn_mfma_f32_16x16x32_bf16(Bt[n][k], At[m][k], acc[ai][bj][m][n], 0, 0, 0); __builtin_amdgcn_s_setprio(0); } while (0)
#define PG8_WAIT_V(n) asm volatile("s_waitcnt vmcnt(" #n ")" ::: "memory")
#define PG8_WAIT_L(n) asm volatile("s_waitcnt lgkmcnt(" #n ")" ::: "memory")
#define PG8_BAR __builtin_amdgcn_s_barrier()
#define PG8_SCHED __builtin_amdgcn_sched_barrier(0)
    Unit cur, nxt; int ui = 0;
    if (!S.next(0, cur)) return;
    f32x4 acc[2][2][4][2];
#pragma unroll
    for (int a = 0; a < 2; ++a)
#pragma unroll
        for (int b = 0; b < 2; ++b)
#pragma unroll
            for (int m = 0; m < 4; ++m)
#pragma unroll
                for (int n = 0; n < 2; ++n) acc[a][b][m][n] = (f32x4){0.f, 0.f, 0.f, 0.f};
    bf16x8 At[4][2], B0[2][2], B1[2][2];
    const char* cA = (const char*)g.A + (size_t)cur.pm * tstepA; const char* cB = (const char*)g.Bt + (size_t)cur.pn * tstepB;
    PG8_STAGE(PG8_SB(0, 0), cB, voffB); PG8_STAGE(PG8_SA(0, 0), cA, voffA); PG8_STAGE(PG8_SB(0, 1), cB + hstepB, voffB); PG8_STAGE(PG8_SA(0, 1), cA + hstepA, voffA);
    if (wr == 1) PG8_BAR;
    PG8_WAIT_V(4); PG8_BAR;
    PG8_STAGE(PG8_SB(1, 0), cB + kstep, voffB); PG8_STAGE(PG8_SA(1, 0), cA + kstep, voffA); PG8_STAGE(PG8_SB(1, 1), cB + hstepB + kstep, voffB);
    PG8_WAIT_V(6); PG8_BAR;
    for (;;) {
        const bool has_next = S.next(ui + 1, nxt);
        const char* nA = has_next ? (const char*)g.A + (size_t)nxt.pm * tstepA : cA; const char* nB = has_next ? (const char*)g.Bt + (size_t)nxt.pn * tstepB : cB;
        for (int t = 0; t < nt; t += 2) {
            const bool last = (t == nt - 2);
            const char* a1 = cA + (size_t)(t + 1) * kstep;
            const char* a2 = last ? nA : cA + (size_t)(t + 2) * kstep; const char* b2 = last ? nB : cB + (size_t)(t + 2) * kstep;
            const char* a3 = a2 + kstep; const char* b3 = b2 + kstep;
            PG8_LDB(B0, 0, 0); PG8_SCHED; PG8_LDA(At, 0, 0); PG8_STAGE(PG8_SA(1, 1), a1 + hstepA, voffA);
            PG8_WAIT_L(8); PG8_BAR; PG8_WAIT_L(0); PG8_MMA(0, 0, At, B0); PG8_BAR; PG8_SCHED;
            PG8_LDB(B1, 0, 1); PG8_STAGE(PG8_SB(0, 0), b2, voffB);
            PG8_BAR; PG8_WAIT_L(0); PG8_MMA(0, 1, At, B1); PG8_BAR;
            PG8_LDA(At, 0, 1); PG8_STAGE(PG8_SA(0, 0), a2, voffA);
            PG8_BAR; PG8_WAIT_L(0); PG8_MMA(1, 0, At, B0); PG8_BAR; PG8_SCHED;
            PG8_STAGE(PG8_SB(0, 1), b2 + hstepB, voffB);
            PG8_WAIT_V(6); PG8_BAR; PG8_MMA(1, 1, At, B1); PG8_BAR;
            PG8_LDB(B0, 1, 0); PG8_SCHED; PG8_LDA(At, 1, 0); PG8_STAGE(PG8_SA(0, 1), a2 + hstepA, voffA);
            PG8_WAIT_L(8); PG8_BAR; PG8_WAIT_L(0); PG8_MMA(0, 0, At, B0); PG8_BAR; PG8_SCHED;
            PG8_LDB(B1, 1, 1); PG8_STAGE(PG8_SB(1, 0), b3, voffB);
            PG8_BAR; PG8_WAIT_L(0); PG8_MMA(0, 1, At, B1); PG8_BAR;
            PG8_LDA(At, 1, 1); PG8_STAGE(PG8_SA(1, 0), a3, voffA);
            PG8_BAR; PG8_WAIT_L(0); PG8_MMA(1, 0, At, B0); PG8_BAR; PG8_SCHED;
            PG8_STAGE(PG8_SB(1, 1), b3 + hstepB, voffB);
            PG8_WAIT_V(6); PG8_BAR; PG8_MMA(1, 1, At, B1); PG8_BAR;
        }
        E(acc, cur, wr, wc, fr, fq);
        if (!has_next) break;
#pragma unroll
        for (int a = 0; a < 2; ++a)
#pragma unroll
            for (int b = 0; b < 2; ++b)
#pragma unroll
                for (int m = 0; m < 4; ++m)
#pragma unroll
                    for (int n = 0; n < 2; ++n) acc[a][b][m][n] = (f32x4){0.f, 0.f, 0.f, 0.f};
        cur = nxt; cA = nA; cB = nB; ++ui;
    }
    PG8_WAIT_V(0);
    if (wr == 0) PG8_BAR;
    PG8_BAR;
#undef PG8_SA
#undef PG8_SB
#undef PG8_STAGE
#undef PG8_LDA
#undef PG8_LDB
#undef PG8_MMA
#undef PG8_WAIT_V
#undef PG8_WAIT_L
#undef PG8_BAR
#undef PG8_SCHED
}
}

typedef f32x4 AccT[2][2][4][2];
#define EPI_LANE const int t_ = tid_(), wid_ = t_ >> 6, ln_ = t_ & 63, wr_ = wid_ >> 2, wc_ = wid_ & 3, fr_ = ln_ & 15, fq_ = ln_ >> 4;
#define EPI_LOOP_PERM(...) EPI_LANE \
    const int row0 = u.pm * 256 + wr_ * 64 + fr_, col0 = u.pn * 256 + wc_ * 32 + 8 * fq_; \
    _Pragma("unroll") for (int ai = 0; ai < 2; ++ai) _Pragma("unroll") for (int m = 0; m < 4; ++m) { const int row = row0 + ai * 128 + m * 16; \
        _Pragma("unroll") for (int bj = 0; bj < 2; ++bj) { const int col = col0 + bj * 128; const f32x4 v0 = acc[ai][bj][m][0], v1 = acc[ai][bj][m][1]; __VA_ARGS__ } }
#define EPI_LOOP_NAT(...) EPI_LANE \
    const int row0 = u.pm * 256 + wr_ * 64 + fr_, col0 = u.pn * 256 + wc_ * 32 + 4 * fq_; \
    _Pragma("unroll") for (int ai = 0; ai < 2; ++ai) _Pragma("unroll") for (int m = 0; m < 4; ++m) { const int row = row0 + ai * 128 + m * 16; \
        _Pragma("unroll") for (int bj = 0; bj < 2; ++bj) _Pragma("unroll") for (int n = 0; n < 2; ++n) { const int col = col0 + bj * 128 + n * 16; const f32x4 v = acc[ai][bj][m][n]; __VA_ARGS__ } }

struct EpiSwiglu { static constexpr bool PERM = true; bf16_t* O;
    DI void operator()(const AccT& acc, const pg8::Unit& u, int wr, int wc, int fr, int fq) const {
        EPI_LOOP_PERM({ u32x2 w; w.x = pack2(siluf_(v0[0]) * v1[0], siluf_(v0[1]) * v1[1]); w.y = pack2(siluf_(v0[2]) * v1[2], siluf_(v0[3]) * v1[3]);
            *(u32x2*)(O + (size_t)row * DFF + (col >> 1)) = w; })
    } };
struct EpiResid { static constexpr bool PERM = false; float* H; float scale;
    DI void operator()(const AccT& acc, const pg8::Unit& u, int wr, int wc, int fr, int fq) const {
        EPI_LOOP_NAT({ f32x4* p = (f32x4*)(H + (size_t)row * DM + col); *p = *p + v * scale; })
    } };
struct EpiProj { static constexpr bool PERM = true; bf16_t* O; bf16_t* XK; bf16_t* XV;
    DI void operator()(const AccT& acc, const pg8::Unit& u, int wr, int wc, int fr, int fq) const {
        const bool is_mg = u.pn * 256 >= C_MG, is_cmp = (u.pn == 10);
        EPI_LOOP_PERM({ f32x4 a = v0, b = v1;
            if (is_mg) { for (int j = 0; j < 4; ++j) { a[j] = sigmoidf_(a[j]); b[j] = sigmoidf_(b[j]); } }
            u32x4 w; w.x = pack2(a[0], a[1]); w.y = pack2(a[2], a[3]); w.z = pack2(b[0], b[1]); w.w = pack2(b[2], b[3]);
            *(u32x4*)(O + (size_t)row * PLD + col) = w;
            if (is_cmp) { const int c = col - C_KC, kv = c >> 7, gg = (c >> 6) & 1, d = c & 63, bb = row >> 11, s = row & 2047, jj = s >> 4, l = s & 15;
                bf16_t* X = kv ? XV : XK; *(u32x4*)(X + ((size_t)((bb * 128 + jj) * 2 + gg)) * 1024 + l * 64 + d) = w; } })
    } };
struct EpiMerge { static constexpr bool PERM = true; bf16_t* MRG; const bf16_t* PROJ; int J;
    DI void operator()(const AccT& acc, const pg8::Unit& u, int wr, int wc, int fr, int fq) const {
        EPI_LOOP_PERM({ const u32x4 gt = *(const u32x4*)(PROJ + (size_t)row * PLD + C_MG + J * 1024 + col);
            u32x4* mp = (u32x4*)(MRG + (size_t)row * DM + col); u32x4 old = (u32x4){0u, 0u, 0u, 0u}; if (J > 0) old = *mp;
            float r[8]; const float x[8] = {v0[0], v0[1], v0[2], v0[3], v1[0], v1[1], v1[2], v1[3]};
            _Pragma("unroll") for (int j = 0; j < 8; ++j) { const unsigned gw = gt[j >> 1], ow = old[j >> 1];
                const float gf = (j & 1) ? __uint_as_float(gw & 0xFFFF0000u) : __uint_as_float(gw << 16);
                const float of = (j & 1) ? __uint_as_float(ow & 0xFFFF0000u) : __uint_as_float(ow << 16);
                r[j] = of + gf * x[j]; }
            u32x4 w; w.x = pack2(r[0], r[1]); w.y = pack2(r[2], r[3]); w.z = pack2(r[4], r[5]); w.w = pack2(r[6], r[7]); *mp = w; })
    } };
struct EpiF32 { static constexpr bool PERM = false; float* C; static constexpr int ldc = 256;
    DI void operator()(const AccT& acc, const pg8::Unit& u, int wr, int wc, int fr, int fq) const {
        EPI_LOOP_NAT({ *(f32x4*)(C + (size_t)row * ldc + col) = v; })
    } };
struct EpiBf16 { static constexpr bool PERM = true; bf16_t* O; static constexpr int ldc = DM;
    DI void operator()(const AccT& acc, const pg8::Unit& u, int wr, int wc, int fr, int fq) const {
        EPI_LOOP_PERM({ u32x4 w; w.x = pack2(v0[0], v0[1]); w.y = pack2(v0[2], v0[3]); w.z = pack2(v1[0], v1[1]); w.w = pack2(v1[2], v1[3]);
            *(u32x4*)(O + (size_t)row * ldc + col) = w; })
    } };
struct EpiPleGate { static constexpr bool PERM = false; float* H; const bf16_t* TMP;
    DI void operator()(const AccT& acc, const pg8::Unit& u, int wr, int wc, int fr, int fq) const {
        EPI_LOOP_NAT({ const u32x2 tw = *(const u32x2*)(TMP + (size_t)row * DM + col); f32x4* p = (f32x4*)(H + (size_t)row * DM + col); f32x4 h = *p;
            h[0] += sigmoidf_(v[0]) * __uint_as_float(tw.x << 16); h[1] += sigmoidf_(v[1]) * __uint_as_float(tw.x & 0xFFFF0000u);
            h[2] += sigmoidf_(v[2]) * __uint_as_float(tw.y << 16); h[3] += sigmoidf_(v[3]) * __uint_as_float(tw.y & 0xFFFF0000u); *p = h; })
    } };

struct EpiLora { static constexpr bool PERM = true; bf16_t* EWA; bf16_t* G;
    DI void operator()(const AccT& acc, const pg8::Unit& u, int wr, int wc, int fr, int fq) const {
        const bool isg = u.pn >= 4; bf16_t* O = isg ? G - 1024 : EWA; const int ld = isg ? 512 : 1024;
        EPI_LOOP_PERM({ u32x4 w; w.x = pack2(v0[0], v0[1]); w.y = pack2(v0[2], v0[3]); w.z = pack2(v1[0], v1[1]); w.w = pack2(v1[2], v1[3]);
            *(u32x4*)(O + (size_t)row * ld + col) = w; })
    } };

template <class Epi> DI void run_gemm(unsigned char* smem, const bf16_t* A, int lda, const bf16_t* Bt, int M, int N, int K, const Epi& E) {
    __syncthreads();
    pg8::Gemm g; g.A = A; g.Bt = Bt; g.M = M; g.N = N; g.K = K; g.lda = lda;
    pg8::StaticOrder S; S.init(M, N, (int)gridDim.x, bid_());
    pg8::gemm_phase<Epi>((LAS unsigned char*)smem, g, S, E);
    __syncthreads();
}

struct MapId { DI int operator()(int n) const { return n; } };
struct MapGU { DI int operator()(int n) const { const int q = n >> 3, e = n & 7; return e < 4 ? 4 * q + e : DFF + 4 * q + (e - 4); } };
struct MapIn { DI int operator()(int n) const { return n < IN_REAL ? n : (n < C_MG ? -1 : n - (C_MG - IN_REAL)); } };
template <class Map> __device__ __forceinline__ void transpose_cvt(unsigned char* smem, const float* src, int ldsrc, bf16_t* dst, int K, int Nd, Map map) {
    float* tile = (float*)smem;
    const int tid = tid_(), ntk = K / 64, nt = ntk * (Nd / 64);
    for (int t = bid_(); t < nt; t += gridDim.x) {
        const int n0 = (t / ntk) * 64, k0 = (t % ntk) * 64;
        const int nn = tid & 63, sc = map(n0 + nn);
#pragma unroll
        for (int p = 0; p < 8; ++p) { const int kk = (tid >> 6) + p * 8; tile[kk * 65 + nn] = sc >= 0 ? src[(size_t)(k0 + kk) * ldsrc + sc] : 0.f; }
        __syncthreads();
#pragma unroll
        for (int p = 0; p < 4; ++p) { const int nn2 = (tid >> 5) + p * 16, kk2 = (tid & 31) * 2;
            *(unsigned*)(dst + (size_t)(n0 + nn2) * K + k0 + kk2) = pack2(tile[kk2 * 65 + nn2], tile[(kk2 + 1) * 65 + nn2]); }
        __syncthreads();
    }
}
__device__ __forceinline__ void convert_layer_weights(unsigned char* smem, CP p, int L) {
    bf16_t* W = (bf16_t*)(p->ws + WS_WBF);
    transpose_cvt(smem, p->in[I_F1GU] + (size_t)L * DM * 2 * DFF, 2 * DFF, W + E_GU1, DM, 2 * DFF, MapGU());
    transpose_cvt(smem, p->in[I_F1D] + (size_t)L * DFF * DM, DM, W + E_D1, DFF, DM, MapId());
    transpose_cvt(smem, p->in[I_WIN] + (size_t)L * DM * IN_COLS, IN_COLS, W + E_IN, DM, PLD, MapIn());
    for (int j = 0; j < 3; ++j) transpose_cvt(smem, p->in[I_WBR] + ((size_t)L * 3 + j) * 512 * DM, DM, W + E_BR + (size_t)j * 1024 * 512, 512, DM, MapId());
    transpose_cvt(smem, p->in[I_WOUT] + (size_t)L * DM * DM, DM, W + E_OUT, DM, DM, MapId());
    for (int i = bid_() * 512 + tid_(); i < 1536 * 256; i += gridDim.x * 512) { const int n = i >> 8, k = i & 255; float w = 0.f;
        if (n < 512) { if (k < 64) w = p->in[I_WB][((size_t)L * 64 + k) * 512 + n]; }
        else if (n < 1024) { if (k >= 64 && k < 128) w = p->in[I_AB][((size_t)L * 64 + (k - 64)) * 512 + (n - 512)]; }
        else { if (k >= 128) w = p->in[I_GB][((size_t)L * 128 + (k - 128)) * 512 + (n - 1024)]; }
        W[E_LORA + i] = f2bf(w); }
    transpose_cvt(smem, p->in[I_PLEG] + (size_t)L * DM * DM, DM, W + E_PG, DM, DM, MapId());
    transpose_cvt(smem, p->in[I_PLEW] + (size_t)L * 256 * DM, DM, W + E_PW, 256, DM, MapId());
    for (int kv = 0; kv < 2; ++kv) for (int hf = 0; hf < 2; ++hf)
        transpose_cvt(smem, p->in[I_CW1] + ((size_t)(L * 2 + kv) * 2048 + hf * 1024) * 128, 128, W + E_C1 + ((size_t)kv * 256 + hf * 128) * 1024, 1024, 128, MapId());
    if (bid_() == gridDim.x - 1 && tid_() < 256) {
        const int kv = tid_() >> 7, hc = tid_() & 127;
        const float* pe = p->in[I_PE] + (size_t)(L * 2 + kv) * 2048; const float* w1 = p->in[I_CW1] + (size_t)(L * 2 + kv) * 2048 * 128 + hc;
        float s = 0.f; for (int i = 0; i < 2048; ++i) s += pe[i] * w1[(size_t)i * 128];
        ((float*)(p->ws + WS_PEB))[kv * 128 + hc] = s;
    }
}

__device__ __forceinline__ void convert_ffn2_weights(unsigned char* smem, CP p, int L) {
    bf16_t* W = (bf16_t*)(p->ws + WS_WBF);
    transpose_cvt(smem, p->in[I_F2GU] + (size_t)L * DM * 2 * DFF, 2 * DFF, W + E_GU2, DM, 2 * DFF, MapGU());
    transpose_cvt(smem, p->in[I_F2D] + (size_t)L * DFF * DM, DM, W + E_D2, DFF, DM, MapId());
}
__device__ __forceinline__ void lora_act(CP p, int L) {
    const bf16_t* PROJ = (const bf16_t*)(p->ws + WS_PROJ); bf16_t* LACT = (bf16_t*)(p->ws + WS_LACT);
    const float* mu = p->in[I_MU] + (size_t)L * 1792 + 1536;
    for (int i = bid_() * 512 + tid_(); i < T_TOK * 32; i += gridDim.x * 512) {
        const int t = i >> 5, j0 = (i & 31) * 8; const bf16_t* row = PROJ + (size_t)t * PLD + C_RW + 1536 + j0;
        const u32x4 cur = *(const u32x4*)row; u32x4 prv = {0u, 0u, 0u, 0u}; if ((t & (SEQ - 1)) != 0) prv = *(const u32x4*)(row - PLD);
        float r[8];
#pragma unroll
        for (int e = 0; e < 8; ++e) { const float x1 = (e & 1) ? __uint_as_float(cur[e >> 1] & 0xFFFF0000u) : __uint_as_float(cur[e >> 1] << 16);
            const float xp = (e & 1) ? __uint_as_float(prv[e >> 1] & 0xFFFF0000u) : __uint_as_float(prv[e >> 1] << 16);
            float xm = x1 + (xp - x1) * mu[j0 + e];
            if (j0 < 64) xm = tanhf(xm); else if (j0 >= 128) xm = sigmoidf_(xm);
            r[e] = xm; }
        u32x4 w; w.x = pack2(r[0], r[1]); w.y = pack2(r[2], r[3]); w.z = pack2(r[4], r[5]); w.w = pack2(r[6], r[7]);
        *(u32x4*)(LACT + (size_t)t * 256 + j0) = w;
    }
}

__device__ __forceinline__ void rmsnorm_rows(const float* hin, float* hcopy, const float* g, bf16_t* un, float* outf) {
    const int lane = tid_() & 63, gw = bid_() * 8 + (tid_() >> 6), nw = gridDim.x * 8;
    f32x4 gv[4];
#pragma unroll
    for (int i = 0; i < 4; ++i) gv[i] = *(const f32x4*)(g + lane * 4 + i * 256);
    for (int row = gw; row < T_TOK; row += nw) {
        f32x4 x[4]; float ss = 0.f;
#pragma unroll
        for (int i = 0; i < 4; ++i) { x[i] = *(const f32x4*)(hin + (size_t)row * DM + lane * 4 + i * 256); ss += x[i][0] * x[i][0] + x[i][1] * x[i][1] + x[i][2] * x[i][2] + x[i][3] * x[i][3]; }
        ss = wave_sum(ss);
        const float rs = rsqrtf(ss * (1.0f / DM) + 1e-6f);
#pragma unroll
        for (int i = 0; i < 4; ++i) {
            const f32x4 y = x[i] * rs * gv[i];
            if (hcopy) *(f32x4*)(hcopy + (size_t)row * DM + lane * 4 + i * 256) = x[i];
            if (un) { u32x2 w; w.x = pack2(y[0], y[1]); w.y = pack2(y[2], y[3]); *(u32x2*)(un + (size_t)row * DM + lane * 4 + i * 256) = w; }
            if (outf) *(f32x4*)(outf + (size_t)row * DM + lane * 4 + i * 256) = y;
        }
    }
}
__device__ __forceinline__ void cvt_f32_bf16(const float* src, bf16_t* dst, size_t n4) {
    for (size_t i = (size_t)bid_() * 512 + tid_(); i < n4; i += (size_t)gridDim.x * 512) {
        const f32x4 v = *(const f32x4*)(src + i * 4); u32x2 w; w.x = pack2(v[0], v[1]); w.y = pack2(v[2], v[3]); *(u32x2*)(dst + i * 4) = w; }
}

__device__ __forceinline__ void finalize_cmp(unsigned char* smem, CP p, int L) {
    float* hid = (float*)smem + (tid_() >> 6) * 128;
    const int lane = tid_() & 63, gw = bid_() * 8 + (tid_() >> 6), nw = gridDim.x * 8;
    const float* peb = (const float*)(p->ws + WS_PEB);
    const int total = 2 * 16 * 2 * 128, iters = (total + nw - 1) / nw;
    for (int it = 0; it < iters; ++it) {
        const int id = gw + it * nw; const bool ok = id < total;
        const int n = id & 127, gg = (id >> 7) & 1, bb = (id >> 8) & 15, kv = (id >> 12) & 1;
        if (ok && n < 127) {
            const float* Pm = (const float*)(p->ws + WS_P01) + (size_t)kv * 4096 * 256;
            const size_t r0 = (size_t)((bb * 128 + n) * 2 + gg) * 256, r1 = (size_t)((bb * 128 + n + 1) * 2 + gg) * 256;
#pragma unroll
            for (int q = 0; q < 2; ++q) { const int hc = lane + q * 64; hid[hc] = siluf_(Pm[r0 + hc] + Pm[r1 + 128 + hc] + peb[kv * 128 + hc]); }
        }
        __syncthreads();
        if (ok) {
            float o = 0.f;
            if (n < 127) { const float* w2 = p->in[I_CW2] + (size_t)(L * 2 + kv) * 128 * 64 + lane;
                for (int hc = 0; hc < 128; ++hc) o += hid[hc] * w2[hc * 64]; }
            ((float*)(p->ws + WS_KC))[((((size_t)kv * 16 + bb) * 2 + gg) * 128 + n) * 64 + lane] = o;
        }
        __syncthreads();
    }
}

__device__ __forceinline__ void hgrn_scan(unsigned char* smem, CP p, int L, int b, int h) {
    float* F = (float*)smem; float* Kx = F + 2048; float* Q = Kx + 2048; float* V = Q + 2048; float* PO = V + 2048;
    const int tid = tid_(), e = tid & 63, wv = tid >> 6, C = h * 64 + e;
    float lb;
    { const float* hl = p->in[I_HGLB]; const float a0 = hl[C], a1 = hl[512 + C], a2 = hl[1024 + C], a3 = hl[1536 + C];
      const float mx = fmaxf(fmaxf(a0, a1), fmaxf(a2, a3)); const float e0 = __expf(a0 - mx), e1 = __expf(a1 - mx), e2 = __expf(a2 - mx), e3 = __expf(a3 - mx);
      const float inv = 1.0f / (e0 + e1 + e2 + e3); float acc = 0.f; if (L >= 1) acc += e1; if (L >= 2) acc += e2; if (L >= 3) acc += e3; lb = fmaxf(acc * inv, 0.f); }
    const float ng = p->in[I_HGN][L * 512 + C];
    bf16_t* base = (bf16_t*)(p->ws + WS_PROJ) + (size_t)b * SEQ * PLD;
    f32x2 S0 = {0.f, 0.f}, S1 = {0.f, 0.f}, S2 = {0.f, 0.f}, S3 = {0.f, 0.f};
    for (int t0 = 0; t0 < SEQ; t0 += 32) {
#pragma unroll
        for (int i = 0; i < 4; ++i) { const int t = wv * 4 + i; const bf16_t* row = base + (size_t)(t0 + t) * PLD;
            const float z = bf2f(row[C_HF + C]), qr = bf2f(row[C_HQ + C]), vi = bf2f(row[C_HI + C]);
            const float sg = sigmoidf_(z); F[t * 64 + e] = sg + lb * (1.0f - sg); Kx[t * 64 + e] = (1.0f - lb) * (1.0f - sg); Q[t * 64 + e] = siluf_(qr); V[t * 64 + e] = vi; }
        __syncthreads();
#pragma unroll 4
        for (int t = 0; t < 32; ++t) {
            const f32x4 f0 = *(const f32x4*)(F + t * 64 + wv * 8), f1 = *(const f32x4*)(F + t * 64 + wv * 8 + 4);
            const f32x4 k0 = *(const f32x4*)(Kx + t * 64 + wv * 8), k1 = *(const f32x4*)(Kx + t * 64 + wv * 8 + 4);
            const f32x4 q0 = *(const f32x4*)(Q + t * 64 + wv * 8), q1 = *(const f32x4*)(Q + t * 64 + wv * 8 + 4);
            const float v = V[t * 64 + e]; const f32x2 vv = {v, v};
            S0 = (f32x2){f0[0], f0[1]} * S0 + (f32x2){k0[0], k0[1]} * vv; S1 = (f32x2){f0[2], f0[3]} * S1 + (f32x2){k0[2], k0[3]} * vv;
            S2 = (f32x2){f1[0], f1[1]} * S2 + (f32x2){k1[0], k1[1]} * vv; S3 = (f32x2){f1[2], f1[3]} * S3 + (f32x2){k1[2], k1[3]} * vv;
            f32x2 o2 = (f32x2){q0[0], q0[1]} * S0 + (f32x2){q0[2], q0[3]} * S1 + (f32x2){q1[0], q1[1]} * S2 + (f32x2){q1[2], q1[3]} * S3;
            PO[(t * 8 + wv) * 64 + e] = o2[0] + o2[1];
        }
        __syncthreads();
#pragma unroll
        for (int i = 0; i < 4; ++i) { const int t = wv * 4 + i; bf16_t* row = base + (size_t)(t0 + t) * PLD;
            float o = 0.f;
#pragma unroll
            for (int q = 0; q < 8; ++q) o += PO[(t * 8 + q) * 64 + e];
            const float ss = wave_sum(o * o); const float rs = rsqrtf(ss * (1.0f / 64.0f) + 1e-6f);
            const float gr = bf2f(row[C_HG + C]);
            row[C_HQ + C] = f2bf(o * rs * ng * siluf_(gr)); }
        __syncthreads();
    }
}

DI float dpp_xor1(float v) { return __int_as_float(__builtin_amdgcn_mov_dpp(__float_as_int(v), 0xB1, 0xF, 0xF, true)); }
DI float dpp_xor2(float v) { return __int_as_float(__builtin_amdgcn_mov_dpp(__float_as_int(v), 0x4E, 0xF, 0xF, true)); }
DI float dpp_hmir(float v) { return __int_as_float(__builtin_amdgcn_mov_dpp(__float_as_int(v), 0x141, 0xF, 0xF, true)); }
DI float red8(float v) { v += dpp_xor1(v); v += dpp_xor2(v); v += dpp_hmir(v); return v; }

__device__ __forceinline__ void rwkv_scan(unsigned char* smem, CP p, int L, int b, int h) {
    constexpr int BUF_F = 6 * 2048 + 64 + 2048;
    const int tid = tid_(), c = tid & 63, wv = tid >> 6, C = h * 64 + c, lane = c;
    const float* mu = p->in[I_MU] + (size_t)L * 1792;
    const float mu_r = mu[C], mu_k = mu[512 + C], mu_v = mu[1024 + C];
    const float w0 = p->in[I_W0][L * 512 + C], a0 = p->in[I_A0][L * 512 + C];
    const float k_k = p->in[I_KK][L * 512 + C], k_a = p->in[I_KA][L * 512 + C], r_k = p->in[I_RK][L * 512 + C], ln_w = p->in[I_LNW][L * 512 + C], ln_b = p->in[I_LNB][L * 512 + C];
    const bf16_t* base = (const bf16_t*)(p->ws + WS_PROJ) + (size_t)b * SEQ * PLD + C_RW + C;
    const bf16_t* ewa = (const bf16_t*)(p->ws + WS_UN) + (size_t)b * SEQ * 1024 + C;
    bf16_t* obase = (bf16_t*)(p->ws + WS_ORW) + (size_t)b * SEQ * 512 + C;
    const int kp = lane & 7, vr = lane >> 3, vrow = wv * 8 + vr;
    f32x2 S0 = {0.f, 0.f}, S1 = {0.f, 0.f}, S2 = {0.f, 0.f}, S3 = {0.f, 0.f};
    bf16_t pr[4], pk[4], pv[4], pe[4], pa[4], pg[4], qr, qk, qv;
#define RW_PREFETCH(T0) do { const int s0_ = (T0) + wv * 4; \
        _Pragma("unroll") for (int i = 0; i < 4; ++i) { const bf16_t* row = base + (size_t)(s0_ + i) * PLD; pr[i] = row[0]; pk[i] = row[512]; pv[i] = row[1024]; \
            pe[i] = ewa[(size_t)(s0_ + i) * 1024]; pa[i] = ewa[(size_t)(s0_ + i) * 1024 + 512]; pg[i] = obase[(size_t)(s0_ + i) * 512]; } \
        if (s0_ > 0) { const bf16_t* row = base + (size_t)(s0_ - 1) * PLD; qr = row[0]; qk = row[512]; qv = row[1024]; } else { qr = 0; qk = 0; qv = 0; } } while (0)
    RW_PREFETCH(0);
    __syncthreads();
    for (int blk = 0; blk < SEQ / 32; ++blk) {
        float* Bf = (float*)smem + (blk & 1) * BUF_F;
        float* Wd = Bf; float* NKK = Bf + 2048; float* AB = Bf + 4096; float* KX = Bf + 6144; float* WR = Bf + 8192; float* VS = Bf + 10240; float* SC = Bf + 12288; float* YS = Bf + 12352;
        float bon[4], gv[4];
        { float rp = bf2f(qr), kq = bf2f(qk), vp = bf2f(qv);
#pragma unroll
          for (int i = 0; i < 4; ++i) { const int t = wv * 4 + i;
              const float r1 = bf2f(pr[i]), k1 = bf2f(pk[i]), v1 = bf2f(pv[i]);
              const float r = r1 + (rp - r1) * mu_r, k = k1 + (kq - k1) * mu_k, v = v1 + (vp - v1) * mu_v; rp = r1; kq = k1; vp = v1;
              const float decay = __expf(-0.6065306597f * sigmoidf_(w0 + bf2f(pe[i]))), a = sigmoidf_(a0 + bf2f(pa[i])); gv[i] = bf2f(pg[i]);
              const float kkv = k * k_k; const float ssq = wave_sum(kkv * kkv); const float kkn = kkv / fmaxf(sqrtf(ssq), 1e-12f);
              const float kx = k * (1.0f + (a - 1.0f) * k_a), ab = kkn * a;
              const float br = wave_sum(ab * r), kr = wave_sum(kx * r); bon[i] = wave_sum(r * kx * r_k);
              Wd[t * 64 + c] = decay; NKK[t * 64 + c] = -kkn; AB[t * 64 + c] = ab; KX[t * 64 + c] = kx; WR[t * 64 + c] = decay * r; VS[t * 64 + c] = v;
              if (c == 0) { SC[t * 2] = br; SC[t * 2 + 1] = kr; } } }
        __syncthreads();
        if (blk + 1 < SEQ / 32) RW_PREFETCH((blk + 1) * 32);
#define RW_LOAD(T, w0v, w1v, n0, n1, b0, b1, x0, x1, q0, q1, vv, sc) do { const int o_ = (T) * 64 + kp * 8; \
            w0v = *(const f32x4*)(Wd + o_); w1v = *(const f32x4*)(Wd + o_ + 4); n0 = *(const f32x4*)(NKK + o_); n1 = *(const f32x4*)(NKK + o_ + 4); \
            b0 = *(const f32x4*)(AB + o_); b1 = *(const f32x4*)(AB + o_ + 4); x0 = *(const f32x4*)(KX + o_); x1 = *(const f32x4*)(KX + o_ + 4); \
            q0 = *(const f32x4*)(WR + o_); q1 = *(const f32x4*)(WR + o_ + 4); vv = VS[(T) * 64 + vrow]; sc = *(const f32x2*)(SC + (T) * 2); } while (0)
        f32x4 cw0, cw1, cn0, cn1, cb0, cb1, cx0, cx1, cq0, cq1; float cvv; f32x2 csc;
        RW_LOAD(0, cw0, cw1, cn0, cn1, cb0, cb1, cx0, cx1, cq0, cq1, cvv, csc);
#pragma nounroll
        for (int t8 = 0; t8 < 4; ++t8) {
            float ykeep = 0.f;
#pragma unroll
            for (int j = 0; j < 8; ++j) {
                const int t = t8 * 8 + j;
                const f32x4 w0v = cw0, w1v = cw1, n0 = cn0, n1 = cn1, b0 = cb0, b1 = cb1, x0 = cx0, x1 = cx1, q0 = cq0, q1 = cq1; const float vv = cvv; const f32x2 sc = csc;
                { const int tn = (t + 1) & 31; RW_LOAD(tn, cw0, cw1, cn0, cn1, cb0, cb1, cx0, cx1, cq0, cq1, cvv, csc); }
                const f32x2 sa2 = S0 * (f32x2){n0[0], n0[1]} + S1 * (f32x2){n0[2], n0[3]} + S2 * (f32x2){n1[0], n1[1]} + S3 * (f32x2){n1[2], n1[3]};
                const f32x2 y2 = S0 * (f32x2){q0[0], q0[1]} + S1 * (f32x2){q0[2], q0[3]} + S2 * (f32x2){q1[0], q1[1]} + S3 * (f32x2){q1[2], q1[3]};
                float sa = sa2[0] + sa2[1], yy = y2[0] + y2[1];
                sa += dpp_xor1(sa); yy += dpp_xor1(yy); sa += dpp_xor2(sa); yy += dpp_xor2(yy); sa += dpp_hmir(sa); yy += dpp_hmir(yy);
                const f32x2 sav = {sa, sa}, vv2 = {vv, vv};
                S0 = S0 * (f32x2){w0v[0], w0v[1]} + sav * (f32x2){b0[0], b0[1]} + vv2 * (f32x2){x0[0], x0[1]};
                S1 = S1 * (f32x2){w0v[2], w0v[3]} + sav * (f32x2){b0[2], b0[3]} + vv2 * (f32x2){x0[2], x0[3]};
                S2 = S2 * (f32x2){w1v[0], w1v[1]} + sav * (f32x2){b1[0], b1[1]} + vv2 * (f32x2){x1[0], x1[1]};
                S3 = S3 * (f32x2){w1v[2], w1v[3]} + sav * (f32x2){b1[2], b1[3]} + vv2 * (f32x2){x1[2], x1[3]};
                const float y = yy + sa * sc[0] + vv * sc[1];
                ykeep = (kp == j) ? y : ykeep;
            }
            YS[(t8 * 8 + kp) * 64 + vrow] = ykeep;
        }
#undef RW_LOAD
        __syncthreads();
#pragma unroll
        for (int i = 0; i < 4; ++i) { const int t = wv * 4 + i;
            const float y = YS[t * 64 + c]; const float mean = wave_sum(y) * (1.0f / 64.0f); const float dlt = y - mean;
            const float var = wave_sum(dlt * dlt) * (1.0f / 64.0f);
            float yn = dlt * rsqrtf(var + 64e-5f) * ln_w + ln_b; yn += bon[i] * VS[t * 64 + c];
            obase[(size_t)(blk * 32 + t) * 512] = f2bf(yn * gv[i]); }
    }
#undef RW_PREFETCH
    __syncthreads();
}

#define MFMA32(a, b, c) __builtin_amdgcn_mfma_f32_32x32x16_bf16((a), (b), (c), 0, 0, 0)
constexpr int KTS = 72;
DI bf16x8 pack8(float a0, float a1, float a2, float a3, float a4, float a5, float a6, float a7) {
    u32x4 w; w.x = pack2(a0, a1); w.y = pack2(a2, a3); w.z = pack2(a4, a5); w.w = pack2(a6, a7); return __builtin_bit_cast(bf16x8, w); }
DI bf16x8 ld_vfrag(const bf16_t* vt, int off) { const u32x2 lo = *(const u32x2*)(vt + off), hi = *(const u32x2*)(vt + off + 8); u32x4 w; w.x = lo.x; w.y = lo.y; w.z = hi.x; w.w = hi.y; return __builtin_bit_cast(bf16x8, w); }

struct FlashState { f32x16 o0, o1; float m, l; };

DI void flash_update(FlashState& st, f32x16& sc0, f32x16& sc1, const bf16_t* VT, int vs, int qi, int hl) {
    float mt = -INFINITY;
#pragma unroll
    for (int i = 0; i < 16; ++i) mt = fmaxf(mt, fmaxf(sc0[i], sc1[i]));
    mt = fmaxf(mt, shfl_xor_(mt, 32, qi + 32 * hl));
    const float mnew = fmaxf(st.m, mt), muse = (mnew == -INFINITY) ? 0.f : mnew;
    const float alpha = __builtin_amdgcn_exp2f(st.m - muse);
    float ls = 0.f;
#pragma unroll
    for (int i = 0; i < 16; ++i) { sc0[i] = __builtin_amdgcn_exp2f(sc0[i] - muse); sc1[i] = __builtin_amdgcn_exp2f(sc1[i] - muse); ls += sc0[i] + sc1[i]; }
    st.l = st.l * alpha + ls; st.m = mnew;
    st.o0 *= alpha; st.o1 *= alpha;
#pragma unroll
    for (int s = 0; s < 2; ++s) {
        const bf16x8 p0 = pack8(sc0[8 * s], sc0[8 * s + 1], sc0[8 * s + 2], sc0[8 * s + 3], sc0[8 * s + 4], sc0[8 * s + 5], sc0[8 * s + 6], sc0[8 * s + 7]);
        const bf16x8 p1 = pack8(sc1[8 * s], sc1[8 * s + 1], sc1[8 * s + 2], sc1[8 * s + 3], sc1[8 * s + 4], sc1[8 * s + 5], sc1[8 * s + 6], sc1[8 * s + 7]);
        st.o0 = MFMA32(ld_vfrag(VT, qi * vs + 16 * s + 4 * hl), p0, st.o0);
        st.o1 = MFMA32(ld_vfrag(VT, (32 + qi) * vs + 16 * s + 4 * hl), p0, st.o1);
        st.o0 = MFMA32(ld_vfrag(VT, qi * vs + 32 + 16 * s + 4 * hl), p1, st.o0);
        st.o1 = MFMA32(ld_vfrag(VT, (32 + qi) * vs + 32 + 16 * s + 4 * hl), p1, st.o1);
    }
}
DI void qk_tile(const bf16_t* KT, const bf16x8 (&qf)[4], int qi, int hl, f32x16& sc0, f32x16& sc1) {
#pragma unroll
    for (int i = 0; i < 16; ++i) { sc0[i] = 0.f; sc1[i] = 0.f; }
#pragma unroll
    for (int s = 0; s < 4; ++s) {
        const bf16x8 k0 = *(const bf16x8*)(KT + qi * KTS + 16 * s + 8 * hl), k1 = *(const bf16x8*)(KT + (32 + qi) * KTS + 16 * s + 8 * hl);
        sc0 = MFMA32(k0, qf[s], sc0); sc1 = MFMA32(k1, qf[s], sc1);
    }
}
struct KVRegs { u32x4 k, v; };
DI void kv_fetch(KVRegs& r, const bf16_t* pb, int kcol, int vcol, int k0) {
    const int tid = tid_();
    const unsigned ok_ = (unsigned)((k0 + (tid >> 3)) * PLD + kcol + (tid & 7) * 8) * 2u, ov_ = (unsigned)((k0 + (tid & 63)) * PLD + vcol + (tid >> 6) * 8) * 2u;
    r.k = *(const u32x4*)((const char*)pb + ok_);
    r.v = *(const u32x4*)((const char*)pb + ov_);
}
DI void kv_store(const KVRegs& r, bf16_t* KT, bf16_t* VT) {
    const int tid = tid_();
    *(u32x4*)(KT + (tid >> 3) * KTS + (tid & 7) * 8) = r.k;
    const int key = tid & 63, ch = tid >> 6;
#pragma unroll
    for (int j = 0; j < 8; ++j) VT[(ch * 8 + j) * KTS + key] = (bf16_t)((j & 1) ? (r.v[j >> 1] >> 16) : (r.v[j >> 1] & 0xFFFFu));
}
template <bool LUTB, bool CAUSAL, bool WHI, bool SEL>
DI void mask_tile(f32x16& sc0, f32x16& sc1, const float* lut, int qpos, int k0, int hl, bool sel, float qs) {
    const float bfar = lut[128];
#pragma unroll
    for (int i = 0; i < 16; ++i) { const int kl = (i & 3) + 8 * (i >> 2) + 4 * hl;
        { const int dist = qpos - (k0 + kl); const float v = sc0[i] * qs + (LUTB ? lut[dist > 128 ? 128 : (dist < 0 ? 0 : dist)] : bfar);
          bool ok = true; if (CAUSAL) ok = ok && dist >= 0; if (WHI) ok = ok && dist < 256; if (SEL) ok = ok && sel; sc0[i] = ok ? v : -INFINITY; }
        { const int dist = qpos - (k0 + 32 + kl); const float v = sc1[i] * qs + (LUTB ? lut[dist > 128 ? 128 : (dist < 0 ? 0 : dist)] : bfar);
          bool ok = true; if (CAUSAL) ok = ok && dist >= 0; if (WHI) ok = ok && dist < 256; if (SEL) ok = ok && sel; sc1[i] = ok ? v : -INFINITY; } }
}

__device__ __forceinline__ void nsa_item(unsigned char* smem, CP p, int L, int b, int g, int qb, int ocol) {
    bf16_t* KT = (bf16_t*)smem;
    bf16_t* VT = (bf16_t*)(smem + 9216);
    float* LUT = (float*)(smem + 18432);
    unsigned* SELM = (unsigned*)(smem + 20736);
    unsigned* ORM = (unsigned*)(smem + 20992);
    float* PA = (float*)(smem + 21504);
    float* PBv = (float*)(smem + 54272);
    bf16_t* KT2 = (bf16_t*)(smem + 87040);
    bf16_t* VT2 = (bf16_t*)(smem + 105472);
    const int tid = tid_(), lane = tid & 63, wv = tid >> 6, hh = wv >> 1, qhalf = wv & 1, qi = lane & 31, hl = lane >> 5;
    const int ql = qhalf * 32 + qi, qpos = qb * 64 + ql, head = g * 4 + hh;
    bf16_t* pb = (bf16_t*)(p->ws + WS_PROJ) + (size_t)b * SEQ * PLD;
    bf16_t* qrow = pb + (size_t)qpos * PLD;
    __syncthreads();
    for (int i = tid; i < 4 * 129; i += 512) { const int h2 = i / 129, dd = i % 129; int bk;
        if (dd < 16) bk = dd; else if (dd >= 128) bk = 31; else { bk = 16 + (int)(logf((float)dd / 16.0f) / 2.0794415416798357f * 16.0f); bk = bk > 31 ? 31 : bk; }
        LUT[h2 * 132 + dd] = p->in[I_RELB][bk * 8 + g * 4 + h2] * 1.4426950408889634f; }
    if (tid == 0) *ORM = 0u;
    if (tid < 64) SELM[tid] = 0u;
    if (tid < 256) PBv[tid * 32] = 0.f;
    { const float* kc = (const float*)(p->ws + WS_KC) + ((size_t)(0 * 16 + b) * 2 + g) * 128 * 64; const float* vc = (const float*)(p->ws + WS_KC) + ((size_t)(1 * 16 + b) * 2 + g) * 128 * 64;
      for (int i = tid; i < 128 * 64; i += 512) { const int n = i >> 6, d = i & 63; KT2[n * KTS + d] = f2bf(kc[i]); }
      for (int i = tid; i < 128 * 64; i += 512) { const int n = i & 127, d = i >> 7; VT2[d * 136 + n] = f2bf(vc[n * 64 + d]); } }
    bf16x8 qf[4];
#pragma unroll
    for (int s = 0; s < 4; ++s) qf[s] = *(const bf16x8*)(qrow + C_NQ + head * 64 + 16 * s + 8 * hl);
    float g0, g1, g2;
    { const bf16_t* gp = qrow + C_NG + head * 3; g0 = sigmoidf_(bf2f(gp[0])); g1 = sigmoidf_(bf2f(gp[1])); g2 = sigmoidf_(bf2f(gp[2])); }
    __syncthreads();
    const float* lut = LUT + hh * 132;
    constexpr float QS = 0.125f * 1.4426950408889634f;
    f32x16 fin0, fin1;
    {
        FlashState st;
#pragma unroll
        for (int i = 0; i < 16; ++i) { st.o0[i] = 0.f; st.o1[i] = 0.f; }
        st.m = -INFINITY; st.l = 0.f;
#pragma nounroll
        for (int t = 0; t < 2; ++t) {
            f32x16 sc0, sc1; qk_tile(KT2 + t * 64 * KTS, qf, qi, hl, sc0, sc1);
#pragma unroll
            for (int i = 0; i < 16; ++i) { const int kl = (i & 3) + 8 * (i >> 2) + 4 * hl;
                { const int n = 64 * t + kl, dist = qpos - (16 * n + 31); sc0[i] = (dist >= 0 && n < 127) ? sc0[i] * QS + lut[dist > 128 ? 128 : dist] : -INFINITY; }
                { const int n = 64 * t + 32 + kl, dist = qpos - (16 * n + 31); sc1[i] = (dist >= 0 && n < 127) ? sc1[i] * QS + lut[dist > 128 ? 128 : dist] : -INFINITY; } }
            flash_update(st, sc0, sc1, VT2 + 64 * t, 136, qi, hl);
        }
        const float lt = st.l + shfl_xor_(st.l, 32, lane); const float inv = 1.0f / fmaxf(lt, 1e-30f);
        const float muse = (st.m == -INFINITY) ? 0.f : st.m;
        fin0 = st.o0 * (g0 * inv); fin1 = st.o1 * (g0 * inv);
#pragma nounroll
        for (int t = 0; t < 2; ++t) {
            f32x16 sc0, sc1; qk_tile(KT2 + t * 64 * KTS, qf, qi, hl, sc0, sc1);
#pragma unroll
            for (int i = 0; i < 16; ++i) { const int kl = (i & 3) + 8 * (i >> 2) + 4 * hl;
                { const int n = 64 * t + kl, dist = qpos - (16 * n + 31); sc0[i] = (dist >= 0 && n < 127) ? __builtin_amdgcn_exp2f(sc0[i] * QS + lut[dist > 128 ? 128 : dist] - muse) * inv : 0.f; }
                { const int n = 64 * t + 32 + kl, dist = qpos - (16 * n + 31); sc1[i] = (dist >= 0 && n < 127) ? __builtin_amdgcn_exp2f(sc1[i] * QS + lut[dist > 128 ? 128 : dist] - muse) * inv : 0.f; } }
#pragma unroll
            for (int i4 = 0; i4 < 4; ++i4) {
                { const int m = 16 * t + 2 * i4 + hl; PA[(hh * 64 + ql) * 32 + m] = sc0[4 * i4] + sc0[4 * i4 + 1] + sc0[4 * i4 + 2] + sc0[4 * i4 + 3]; PBv[(hh * 64 + ql) * 32 + m + 1] = sc0[4 * i4 + 3]; }
                { const int m = 16 * t + 8 + 2 * i4 + hl; PA[(hh * 64 + ql) * 32 + m] = sc1[4 * i4] + sc1[4 * i4 + 1] + sc1[4 * i4 + 2] + sc1[4 * i4 + 3]; if (m + 1 < 32) PBv[(hh * 64 + ql) * 32 + m + 1] = sc1[4 * i4 + 3]; }
            }
        }
    }
    __syncthreads();
    {
        float* IMP = (float*)smem;
        const int q = tid & 63, part = tid >> 6, cur = qb;
#pragma unroll
        for (int mm = 0; mm < 4; ++mm) { const int m = part * 4 + mm; float v;
            if (m == 0 || m == cur || m == cur - 1) v = INFINITY;
            else if (m <= cur) { v = 0.f; for (int h2 = 0; h2 < 4; ++h2) v += PA[(h2 * 64 + q) * 32 + m] + PBv[(h2 * 64 + q) * 32 + m]; }
            else v = -INFINITY;
            IMP[q * 33 + m] = v; }
        __syncthreads();
        unsigned bits = 0u;
#pragma unroll
        for (int mm = 0; mm < 4; ++mm) { const int m = part * 4 + mm; const float v = IMP[q * 33 + m]; int rank = 0;
            for (int m2 = 0; m2 < 32; ++m2) { const float v2 = IMP[q * 33 + m2]; rank += (v2 > v || (v2 == v && m2 < m)) ? 1 : 0; }
            if (rank < 8 && v > -INFINITY) bits |= 1u << m; }
        atomicOr(&SELM[q], bits); atomicOr(ORM, bits);
    }
    __syncthreads();
    const unsigned mysel = SELM[ql], orm = *ORM;
    __syncthreads();
    float* PARK = PA + (wv * 32) * 64 + lane;
#pragma unroll
    for (int i = 0; i < 16; ++i) { PARK[i * 64] = fin0[i]; PARK[(16 + i) * 64] = fin1[i]; }
    {
        FlashState st;
#pragma unroll
        for (int i = 0; i < 16; ++i) { st.o0[i] = 0.f; st.o1[i] = 0.f; }
        st.m = -INFINITY; st.l = 0.f;
        const unsigned todo = orm & (qb >= 31 ? 0xFFFFFFFFu : ((2u << qb) - 1u));
        KVRegs kr;
        int m = todo ? __builtin_ctz(todo) : -1;
        if (m >= 0) { kv_fetch(kr, pb, C_KS + g * 64, C_VS + g * 64, m * 64); __syncthreads(); kv_store(kr, KT, VT); __syncthreads(); }
        while (m >= 0) {
            const unsigned rest = todo & ~((2u << m) - 1u); const int nm = (m < 31 && rest) ? __builtin_ctz(rest) : -1;
            if (nm >= 0) kv_fetch(kr, pb, C_KS + g * 64, C_VS + g * 64, nm * 64);
            f32x16 sc0, sc1; qk_tile(KT, qf, qi, hl, sc0, sc1);
            const bool sel = (mysel >> m) & 1u;
            if (m + 3 <= qb) mask_tile<false, false, false, true>(sc0, sc1, lut, qpos, m * 64, hl, sel, QS);
            else mask_tile<true, true, false, true>(sc0, sc1, lut, qpos, m * 64, hl, sel, QS);
            flash_update(st, sc0, sc1, VT, KTS, qi, hl);
            __syncthreads();
            if (nm >= 0) kv_store(kr, KT, VT);
            __syncthreads();
            m = nm;
        }
        const float lt = st.l + shfl_xor_(st.l, 32, lane); const float sc = g1 / fmaxf(lt, 1e-30f);
#pragma unroll
        for (int i = 0; i < 16; ++i) { PARK[i * 64] += st.o0[i] * sc; PARK[(16 + i) * 64] += st.o1[i] * sc; }
    }
    {
        FlashState st;
#pragma unroll
        for (int i = 0; i < 16; ++i) { st.o0[i] = 0.f; st.o1[i] = 0.f; }
        st.m = -INFINITY; st.l = 0.f;
        KVRegs kr;
        int w = qb >= 4 ? 0 : 4 - qb;
        kv_fetch(kr, pb, C_KW + g * 64, C_VW + g * 64, qb * 64 - 256 + 64 * w); __syncthreads(); kv_store(kr, KT, VT); __syncthreads();
        for (; w < 5; ++w) {
            const int k0 = qb * 64 - 256 + 64 * w;
            if (w < 4) kv_fetch(kr, pb, C_KW + g * 64, C_VW + g * 64, k0 + 64);
            f32x16 sc0, sc1; qk_tile(KT, qf, qi, hl, sc0, sc1);
            if (w == 0) mask_tile<false, false, true, false>(sc0, sc1, lut, qpos, k0, hl, true, QS);
            else if (w == 1) mask_tile<false, false, false, false>(sc0, sc1, lut, qpos, k0, hl, true, QS);
            else if (w < 4) mask_tile<true, false, false, false>(sc0, sc1, lut, qpos, k0, hl, true, QS);
            else mask_tile<true, true, false, false>(sc0, sc1, lut, qpos, k0, hl, true, QS);
            flash_update(st, sc0, sc1, VT, KTS, qi, hl);
            __syncthreads();
            if (w < 4) kv_store(kr, KT, VT);
            __syncthreads();
        }
        const float lt = st.l + shfl_xor_(st.l, 32, lane); const float sc = g2 / fmaxf(lt, 1e-30f);
#pragma unroll
        for (int i = 0; i < 16; ++i) { fin0[i] = PARK[i * 64] + st.o0[i] * sc; fin1[i] = PARK[(16 + i) * 64] + st.o1[i] * sc; }
    }
#pragma unroll
    for (int i4 = 0; i4 < 4; ++i4) {
        u32x2 w0; w0.x = pack2(fin0[4 * i4], fin0[4 * i4 + 1]); w0.y = pack2(fin0[4 * i4 + 2], fin0[4 * i4 + 3]);
        u32x2 w1; w1.x = pack2(fin1[4 * i4], fin1[4 * i4 + 1]); w1.y = pack2(fin1[4 * i4 + 2], fin1[4 * i4 + 3]);
        *(u32x2*)(qrow + ocol + head * 64 + 8 * i4 + 4 * hl) = w0;
        *(u32x2*)(qrow + ocol + head * 64 + 32 + 8 * i4 + 4 * hl) = w1;
    }
}

constexpr int PH_PER_LAYER = 15, PH_TOTAL = DEPTH * PH_PER_LAYER + 1;
enum { S_PREP = 0, S_GU1, S_D1, S_NORM_MIX, S_WIN, S_CMP, S_LORA, S_SCAN, S_MERGE, S_OUT, S_NORM2, S_GU2, S_D2, S_NORM_PLE, S_PLEG, S_FINAL };

__device__ __forceinline__ void run_phase(unsigned char* smem, CP p, int ph) {
    const bool fin = (ph == DEPTH * PH_PER_LAYER);
    const int L = fin ? 0 : ph / PH_PER_LAYER; const int sub = fin ? S_FINAL : ph % PH_PER_LAYER;
    unsigned char* ws = p->ws; float* H = p->out;
    bf16_t* W = (bf16_t*)(ws + WS_WBF); bf16_t* UN = (bf16_t*)(ws + WS_UN); bf16_t* PROJ = (bf16_t*)(ws + WS_PROJ); bf16_t* ACT = (bf16_t*)(ws + WS_ACT);
    bf16_t* TMP = (bf16_t*)(ws + WS_TMP); bf16_t* PBF = (bf16_t*)(ws + WS_PB); bf16_t* ORW = (bf16_t*)(ws + WS_ORW);
    bf16_t* XK = (bf16_t*)(ws + WS_XK); bf16_t* XV = (bf16_t*)(ws + WS_XV); float* P01 = (float*)(ws + WS_P01);
    if (sub == S_PREP) convert_layer_weights(smem, p, L);
    if (sub == S_NORM_MIX) convert_ffn2_weights(smem, p, L);
    if (sub == S_NORM2) cvt_f32_bf16(p->in[I_P] + (size_t)L * T_TOK * 256, PBF, (size_t)T_TOK * 256 / 4);
    if (sub == S_CMP) lora_act(p, L);
    if (sub == S_LORA) finalize_cmp(smem, p, L);
    if (sub == S_NORM_PLE) { EpiBf16 e; e.O = TMP; run_gemm(smem, PBF, 256, W + E_PW, T_TOK, DM, 256, e); }
    if (sub == S_PREP || sub == S_NORM_MIX || sub == S_NORM2 || sub == S_NORM_PLE || sub == S_FINAL) {
        const float* hin = (sub == S_PREP && L == 0) ? p->in[I_X] : H; float* hcopy = (sub == S_PREP && L == 0) ? H : nullptr;
        const float* g = sub == S_PREP ? p->in[I_F1N] + L * DM : sub == S_NORM_MIX ? p->in[I_MIXN] + L * DM : sub == S_NORM2 ? p->in[I_F2N] + L * DM : sub == S_NORM_PLE ? p->in[I_PLEN] + L * DM : p->in[I_FINN];
        rmsnorm_rows(hin, hcopy, g, sub == S_FINAL ? nullptr : UN, sub == S_FINAL ? H : nullptr);
    } else if (sub == S_GU1 || sub == S_GU2) {
        EpiSwiglu e; e.O = ACT; run_gemm(smem, UN, DM, W + (sub == S_GU1 ? E_GU1 : E_GU2), T_TOK, 2 * DFF, DM, e);
    } else if (sub == S_D1 || sub == S_D2 || sub == S_OUT) {
        EpiResid e; e.H = H; e.scale = sub == S_OUT ? 1.0f : 0.5f;
        run_gemm(smem, sub == S_OUT ? UN : ACT, sub == S_OUT ? DM : DFF, W + (sub == S_D1 ? E_D1 : sub == S_D2 ? E_D2 : E_OUT), T_TOK, DM, sub == S_OUT ? DM : DFF, e);
    } else if (sub == S_WIN) {
        EpiProj e; e.O = PROJ; e.XK = XK; e.XV = XV; run_gemm(smem, UN, DM, W + E_IN, T_TOK, PLD, DM, e);
    } else if (sub == S_CMP) {
#pragma nounroll
        for (int kv = 0; kv < 2; ++kv) { EpiF32 e; e.C = P01 + (size_t)kv * 4096 * 256;
            run_gemm(smem, kv ? XV : XK, 1024, W + E_C1 + (size_t)kv * 256 * 1024, 4096, 256, 1024, e); }
    } else if (sub == S_LORA) {
        EpiLora e; e.EWA = UN; e.G = ORW;
        run_gemm(smem, (const bf16_t*)(ws + WS_LACT), 256, W + E_LORA, T_TOK, 1536, 256, e);
    } else if (sub == S_SCAN) {
        for (int item = bid_(); item < 256; item += gridDim.x) {
            __syncthreads();
            if (item < 128) rwkv_scan(smem, p, L, item >> 3, item & 7); else hgrn_scan(smem, p, L, (item - 128) >> 3, (item - 128) & 7);
        }
        unsigned* ctr = (unsigned*)(ws + 14336) + L * 64;
        volatile unsigned* slot = (volatile unsigned*)(smem + 141 * 1024);
        for (;;) {
            __syncthreads();
            if (tid_() == 0) *slot = __hip_atomic_fetch_add(ctr, 1u, __ATOMIC_RELAXED, __HIP_MEMORY_SCOPE_AGENT);
            __syncthreads();
            const unsigned idx = *slot;
            if (idx >= 1024u) break;
            const int bg = idx & 31, qb = 31 - (int)(idx >> 5);
            nsa_item(smem, p, L, bg >> 1, bg & 1, qb, C_NQ);
        }
    } else if (sub == S_MERGE) {
#pragma nounroll
        for (int j = 0; j < 3; ++j) { EpiMerge e; e.MRG = UN; e.PROJ = PROJ; e.J = j;
            const bf16_t* A = j == 0 ? PROJ + C_HQ : (j == 1 ? PROJ + C_NQ : ORW);
            run_gemm(smem, A, j == 2 ? 512 : PLD, W + E_BR + (size_t)j * 1024 * 512, T_TOK, DM, 512, e); }
    } else if (sub == S_PLEG) {
        EpiPleGate e; e.H = H; e.TMP = TMP; run_gemm(smem, UN, DM, W + E_PG, T_TOK, DM, DM, e);
    }
}

#define XB_TMO      128
#define XB_XCNT(j)  (256  + 64 * (j))
#define XB_XSUB(j)  (1280 + 64 * (j))
#define XB_XGEN(j)  (2304 + 64 * (j))
#define XB_TOP      3328
#define XB_TOPGEN   3392
#define XCD_BAR_WORDS 3456
#define XB_SPIN_CAP (1u << 20)
DI unsigned xb_ld(unsigned* p)              { return __hip_atomic_load(p, __ATOMIC_RELAXED, __HIP_MEMORY_SCOPE_AGENT); }
DI unsigned xb_add(unsigned* p, unsigned v) { return __hip_atomic_fetch_add(p, v, __ATOMIC_RELAXED, __HIP_MEMORY_SCOPE_AGENT); }
DI unsigned xb_xcc_id() { return (unsigned)__builtin_amdgcn_s_getreg((3 << 11) | 20) & 0xFu; }
#define XB_SPIN(cond, bar) do { unsigned _sp = 0; while (cond) { __builtin_amdgcn_s_sleep(1); \
    if ((++_sp & 255u) == 0u) { if (xb_ld(&(bar)[XB_TMO])) break; if (_sp > XB_SPIN_CAP) { atomicAdd(&(bar)[XB_TMO], 1u); break; } } } } while (0)
struct XcdBarrier { unsigned* bar; unsigned x; volatile LAS unsigned* st; };
DI XcdBarrier xcd_barrier_post(unsigned* bar, volatile LAS unsigned* st) {
    XcdBarrier b; b.bar = bar; b.x = xb_xcc_id(); b.st = st;
    if (threadIdx.x == 0) (void)xb_add(&bar[XB_XCNT(b.x)], 1u);
    return b;
}
DI void xcd_barrier_complete(unsigned* bar, unsigned x, unsigned& nloc, unsigned& nx) {
    const unsigned G = gridDim.x * gridDim.y * gridDim.z;
    unsigned sum, cnt, mine, sp = 0u;
    for (;;) {
        sum = 0u; cnt = 0u; mine = 0u;
#pragma unroll
        for (unsigned j = 0; j < 16; ++j) { const unsigned c = xb_ld(&bar[XB_XCNT(j)]); sum += c; cnt += (c > 0u) ? 1u : 0u; mine = (j == x) ? c : mine; }
        if (sum == G) break;
        __builtin_amdgcn_s_sleep(1);
        if ((++sp & 255u) == 0u) { if (xb_ld(&bar[XB_TMO])) break; if (sp > XB_SPIN_CAP) { atomicAdd(&bar[XB_TMO], 1u); break; } }
    }
    nloc = mine > 0u ? mine : 1u; nx = cnt > 0u ? cnt : 1u;
}
DI void xcd_barrier(const XcdBarrier& b) {
    asm volatile("s_waitcnt vmcnt(0)" ::: "memory");
    __syncthreads();
    if (threadIdx.x == 0) {
        unsigned* bar = b.bar;
        __builtin_amdgcn_s_waitcnt(0);
        unsigned nloc = b.st[0], nx = b.st[1];
        if (nloc == 0u) { xcd_barrier_complete(bar, b.x, nloc, nx); b.st[0] = nloc; b.st[1] = nx; }
        const unsigned old = xb_add(&bar[XB_XSUB(b.x)], 1u);
        const unsigned gen = old / nloc;
        if (old + 1u == (gen + 1u) * nloc) {
            __builtin_amdgcn_fence(__ATOMIC_RELEASE, "agent");
            asm volatile("s_waitcnt vmcnt(0)" ::: "memory");
            const unsigned og = xb_add(&bar[XB_TOP], 1u);
            const unsigned tg = og / nx;
            if (og + 1u == (tg + 1u) * nx) xb_add(&bar[XB_TOPGEN], 1u);
            else XB_SPIN(xb_ld(&bar[XB_TOPGEN]) == tg, bar);
            __builtin_amdgcn_fence(__ATOMIC_ACQUIRE, "agent");
            xb_add(&bar[XB_XGEN(b.x)], 1u);
            asm volatile("s_waitcnt vmcnt(0)" ::: "memory");
        } else {
            XB_SPIN(xb_ld(&bar[XB_XGEN(b.x)]) == gen, bar);
            __builtin_amdgcn_fence(__ATOMIC_ACQUIRE, "agent");
            asm volatile("s_waitcnt vmcnt(0)" ::: "memory");
        }
    }
    __syncthreads();
}

__global__ void __launch_bounds__(512, 2) mega_fwd(Params p) {
    extern __shared__ __attribute__((aligned(16))) unsigned char smem[];
    cg::grid_group grid = cg::this_grid();
    volatile LAS unsigned* xst = (volatile LAS unsigned*)(LAS unsigned char*)(smem + 140 * 1024);
    if (threadIdx.x == 0) { xst[0] = 0u; xst[1] = 0u; }
    __syncthreads();
    const XcdBarrier xb = xcd_barrier_post((unsigned*)(p.ws + WS_BAR), xst);
#ifndef PROBE_DUP
#define PROBE_DUP -1
#endif
    constexpr int IT_PER_LAYER = PH_PER_LAYER + (PROBE_DUP >= 0 ? 1 : 0);
    const int it_lo = p.ph_lo, it_hi = PROBE_DUP >= 0 ? DEPTH * IT_PER_LAYER + 1 : p.ph_hi;
    for (int it = it_lo; it < it_hi; ++it) {
        int ph = it;
        if (PROBE_DUP >= 0) { const int l_ = it / IT_PER_LAYER, r_ = it % IT_PER_LAYER; ph = l_ * PH_PER_LAYER + (r_ <= PROBE_DUP ? r_ : r_ - 1); }
        CP pp = (CP)__builtin_amdgcn_kernarg_segment_ptr(); asm volatile("" : "+s"(pp));
        run_phase(smem, pp, ph);
        if (it + 1 < it_hi) {
            if (it == it_lo) grid.sync();
            else xcd_barrier(xb);
        }
    }
}

#ifndef MULTI_LAUNCH
#define MULTI_LAUNCH 0
#endif

extern "C" void kernel_launch(void* const* d_in, const int* in_sizes, int n_in, void* d_out, int out_size, void* d_ws, size_t ws_size, hipStream_t stream) {
    static int grid = 0;
    if (grid == 0) {
        if (n_in != N_INPUTS || out_size != T_TOK * DM || ws_size < WS_END) { fprintf(stderr, "kernel_launch: unexpected shapes: n_in %d out %d ws %zu (need %zu)\n", n_in, out_size, ws_size, (size_t)WS_END); grid = -1; return; }
        int dev = 0, cus = 0, per_cu = 0;
        (void)hipGetDevice(&dev); (void)hipDeviceGetAttribute(&cus, hipDeviceAttributeMultiprocessorCount, dev);
        if (hipFuncSetAttribute((const void*)mega_fwd, hipFuncAttributeMaxDynamicSharedMemorySize, LDS_BYTES) != hipSuccess) { fprintf(stderr, "kernel_launch: hipFuncSetAttribute failed\n"); grid = -1; return; }
        if (hipOccupancyMaxActiveBlocksPerMultiprocessor(&per_cu, (const void*)mega_fwd, 512, LDS_BYTES) != hipSuccess || per_cu < 1) { fprintf(stderr, "kernel_launch: occupancy query gives %d\n", per_cu); per_cu = 1; }
        (void)hipGetLastError();
        grid = cus * 1;
        if (grid > 256) grid = 256;
        fprintf(stderr, "kernel_launch: grid %d (cus %d, per_cu %d)\n", grid, cus, per_cu);
    }
    if (grid < 0) return;
    (void)hipMemsetAsync(d_ws, 0, 16384, stream);
    Params p{};
    for (int i = 0; i < N_INPUTS; ++i) p.in[i] = (const float*)d_in[i];
    p.out = (float*)d_out; p.ws = (unsigned char*)d_ws;
#if MULTI_LAUNCH
    for (int ph = 0; ph < PH_TOTAL; ++ph) { p.ph_lo = ph; p.ph_hi = ph + 1; hipLaunchKernelGGL(mega_fwd, dim3(grid), dim3(512), LDS_BYTES, stream, p); }
#else
    p.ph_lo = 0; p.ph_hi = PH_TOTAL;
    void* args[] = {&p};
    hipError_t e = hipLaunchCooperativeKernel((const void*)mega_fwd, dim3(grid), dim3(512), args, LDS_BYTES, stream);
    if (e != hipSuccess) fprintf(stderr, "kernel_launch: cooperative launch failed: %s\n", hipGetErrorString(e));
#endif
}
```

```cpp
#include <hip/hip_runtime.h>
#include <hip/hip_cooperative_groups.h>
#include <cstdio>
namespace cg = cooperative_groups;

#define LAS __attribute__((address_space(3)))
#define DI __device__ __forceinline__
typedef unsigned short bf16_t;
typedef short bf16x8 __attribute__((ext_vector_type(8)));
typedef float f32x4 __attribute__((ext_vector_type(4)));
typedef float f32x2 __attribute__((ext_vector_type(2)));
typedef float f32x16 __attribute__((ext_vector_type(16)));
typedef unsigned u32x4 __attribute__((ext_vector_type(4)));
typedef unsigned u32x2 __attribute__((ext_vector_type(2)));

constexpr int T_TOK = 32768, SEQ = 2048, NB = 16, DM = 1024, DFF = 2816, DEPTH = 4;
constexpr int PLD = 8448;
constexpr int C_HQ = 0, C_HF = 512, C_HI = 1024, C_HG = 1536, C_NQ = 2048, C_KC = 2560, C_VC = 2688, C_KS = 2816, C_VS = 2944,
              C_KW = 3072, C_VW = 3200, C_NG = 3328, C_RW = 3352, C_MG = 5376, IN_REAL = 5144, IN_COLS = 8216;
enum { I_X = 0, I_P, I_F1N, I_F1GU, I_F1D, I_MIXN, I_WIN, I_HGLB, I_HGN, I_PE, I_CW1, I_CW2, I_RELB, I_MU, I_W0, I_WB, I_A0, I_AB, I_GB,
       I_KK, I_KA, I_RK, I_LNW, I_LNB, I_WBR, I_WOUT, I_F2N, I_F2GU, I_F2D, I_PLEN, I_PLEG, I_PLEW, I_FINN, N_INPUTS };

constexpr size_t WS_BAR = 0;
constexpr size_t WS_PEB = 16384;
constexpr size_t WS_WBF = 20480;
constexpr size_t E_GU1 = 0, E_D1 = E_GU1 + 5632ull * 1024, E_IN = E_D1 + 1024ull * 2816, E_BR = E_IN + 8448ull * 1024, E_OUT = E_BR + 3ull * 1024 * 512,
                 E_GU2 = E_GU1, E_D2 = E_D1  , E_PG = E_OUT + 1024ull * 1024, E_PW = E_PG + 1024ull * 1024,
                 E_C1 = E_PW + 1024ull * 256, E_LORA = E_C1 + 2ull * 256 * 1024, E_END = E_LORA + 1536ull * 256;
constexpr size_t WS_UN = WS_WBF + E_END * 2;
constexpr size_t WS_ORW = WS_UN + (size_t)T_TOK * 1024 * 2;
constexpr size_t WS_XK = WS_ORW + (size_t)T_TOK * 512 * 2;
constexpr size_t WS_XV = WS_XK + 4096ull * 1024 * 2;
constexpr size_t WS_P01 = WS_XV + 4096ull * 1024 * 2;
constexpr size_t WS_KC = WS_P01 + 2ull * 4096 * 256 * 4;
constexpr size_t WS_LACT = WS_KC + 2ull * 16 * 2 * 128 * 64 * 4;
constexpr size_t WS_PROJ = WS_LACT + (size_t)T_TOK * 256 * 2;
constexpr size_t WS_END = WS_PROJ + (size_t)T_TOK * PLD * 2;
constexpr size_t WS_ACT = WS_PROJ;
constexpr size_t WS_PB = WS_PROJ + 200ull * 1024 * 1024;
constexpr size_t WS_TMP = WS_PROJ + 256ull * 1024 * 1024;
constexpr int LDS_BYTES = 144 * 1024;

struct Params {
    const float* in[N_INPUTS];
    float* out;
    unsigned char* ws;
    int ph_lo, ph_hi;
};
typedef const Params __attribute__((address_space(4)))* CP;

DI int tid_() { int t = threadIdx.x; asm volatile("" : "+v"(t)); return t; }
DI int bid_() { int b = blockIdx.x; asm volatile("" : "+s"(b)); return b; }
typedef __bf16 bf16v2 __attribute__((ext_vector_type(2)));
DI float bf2f(bf16_t b) { return __uint_as_float(((unsigned)b) << 16); }
DI unsigned pack2(float lo, float hi) { const f32x2 v = {lo, hi}; return __builtin_bit_cast(unsigned, __builtin_convertvector(v, bf16v2)); }
DI bf16_t f2bf(float f) { return (bf16_t)(pack2(f, 0.f) & 0xFFFFu); }
DI float sigmoidf_(float x) { return __builtin_amdgcn_rcpf(1.0f + __builtin_amdgcn_exp2f(-1.4426950408889634f * x)); }
DI float siluf_(float x) { return x * __builtin_amdgcn_rcpf(1.0f + __builtin_amdgcn_exp2f(-1.4426950408889634f * x)); }
DI float shfl_xor_(float v, int mask, int lane) { return __int_as_float(__builtin_amdgcn_ds_bpermute((lane ^ mask) << 2, __float_as_int(v))); }
DI float dppf_(float v, int) { return v; }
#define DPPF(v, ctrl) __int_as_float(__builtin_amdgcn_mov_dpp(__float_as_int(v), ctrl, 0xF, 0xF, true))
DI float wave_sum(float v) {
    v += DPPF(v, 0xB1); v += DPPF(v, 0x4E); v += DPPF(v, 0x141); v += DPPF(v, 0x140);
    const float s0 = __int_as_float(__builtin_amdgcn_readlane(__float_as_int(v), 0)), s1 = __int_as_float(__builtin_amdgcn_readlane(__float_as_int(v), 16));
    const float s2 = __int_as_float(__builtin_amdgcn_readlane(__float_as_int(v), 32)), s3 = __int_as_float(__builtin_amdgcn_readlane(__float_as_int(v), 48));
    return (s0 + s1) + (s2 + s3);
}

namespace pg8 {
constexpr int BM = 256, BK = 64, HALF = 128, HTB = HALF * BK * 2, STAGE_BYTES = 8 * HTB, NXCD = 8, WGM = 8;
DI int lds_byte(int r, int c) { const int st = (r >> 4) * 2 + (c >> 5), rr = r & 15, cc = c & 31, ob = rr * 64 + cc * 2; return st * 1024 + (ob ^ (((ob >> 9) & 1) << 5)); }
DI void stage_rc(int b, int& R, int& C) { const int st = b / 1024, sb = b % 1024, swz = sb ^ (((sb >> 9) & 1) << 5); R = (st >> 1) * 16 + swz / 64; C = (st & 1) * 32 + (swz % 64) / 2; }
DI int perm32(int rho) { const int n = rho >> 4, i = rho & 15; return 8 * (i >> 2) + 4 * n + (i & 3); }
struct Unit { int pm, pn; };
struct Gemm { const bf16_t* A; const bf16_t* Bt; int M, N, K, lda; };
struct StaticOrder {
    int nM, nN, nwg, G, c;
    DI void init(int M, int N, int G_, int c_) { nM = M / BM; nN = N / BM; nwg = nM * nN; G = G_; c = c_; }
    DI bool next(int i, Unit& u) const {
        const long L = (long)i * G + c; if (L >= nwg) return false;
        int wgid = (int)L; { const int q = nwg / NXCD, r = nwg % NXCD, xcd = wgid % NXCD, off = wgid / NXCD; wgid = (xcd < r ? xcd * (q + 1) : r * (q + 1) + (xcd - r) * q) + off; }
        const int nig = WGM * nN, gid = wgid / nig, fm = gid * WGM, gsz = (nM - fm) < WGM ? (nM - fm) : WGM;
        u.pm = fm + ((wgid % nig) % gsz); u.pn = (wgid % nig) / gsz; return true;
    }
};

template <class Epi>
DI void gemm_phase(LAS unsigned char* lds, const Gemm g, const StaticOrder& S, const Epi& E) {
    int tid = tid_();
    const int wid = __builtin_amdgcn_readfirstlane(tid >> 6), lane = tid & 63, wr = wid >> 2, wc = wid & 3, fr = lane & 15, fq = lane >> 4;
    const int K = g.K, nt = K / BK, lda = g.lda;
    unsigned voffA[2], voffB[2];
#pragma unroll
    for (int i = 0; i < 2; ++i) { int R, C; stage_rc(tid * 16 + i * 8192, R, C); const int Rb = Epi::PERM ? ((R & ~31) + perm32(R & 31)) : R;
        voffA[i] = (unsigned)(R * lda + C) * 2u; voffB[i] = (unsigned)(Rb * K + C) * 2u; }
    const size_t kstep = (size_t)(BK * 2);
    const size_t hstepA = (size_t)HALF * lda * 2, hstepB = (size_t)HALF * K * 2;
    const size_t tstepA = 2 * hstepA, tstepB = 2 * hstepB;
    const unsigned ldsw = (unsigned)wid * 1024u;
    const int aoff = lds_byte(wr * 64 + fr, fq * 8), boff = lds_byte(wc * 32 + fr, fq * 8);
#define PG8_SA(b, h) (((b) * 2 + (h)) * HTB)
#define PG8_SB(b, h) ((4 + (b) * 2 + (h)) * HTB)
#define PG8_STAGE(bufoff, gbase, voff) do { _Pragma("unroll") for (int _i = 0; _i < 2; ++_i) \
        __builtin_amdgcn_global_load_lds((const unsigned*)((const char*)(gbase) + (voff)[_i]), (LAS unsigned*)(lds + (bufoff) + ldsw + _i * 8192), 16, 0, 0); } while (0)
#define PG8_LDA(dst, b, h) do { _Pragma("unroll") for (int m = 0; m < 4; ++m) _Pragma("unroll") for (int k = 0; k < 2; ++k) dst[m][k] = *(const LAS bf16x8*)(lds + PG8_SA(b, h) + aoff + m * 2048 + k * 1024); } while (0)
#define PG8_LDB(dst, b, h) do { _Pragma("unroll") for (int n = 0; n < 2; ++n) _Pragma("unroll") for (int k = 0; k < 2; ++k) dst[n][k] = *(const LAS bf16x8*)(lds + PG8_SB(b, h) + boff + n * 2048 + k * 1024); } while (0)
#define PG8_MMA(ai, bj, At, Bt) do { __builtin_amdgcn_s_setprio(1); _Pragma("unroll") for (int m = 0; m < 4; ++m) _Pragma("unroll") for (int n = 0; n < 2; ++n) _Pragma("unroll") for (int k = 0; k < 2; ++k) \
        acc[ai][bj][m][n] = __builtin_amdgcn_mfma_f32_16x16x32_bf16(Bt[n][k], At[m][k], acc[ai][bj][m][n], 0, 0, 0); __builtin_amdgcn_s_setprio(0); } while (0)
#define PG8_WAIT_V(n) asm volatile("s_waitcnt vmcnt(" #n ")" ::: "memory")
#define PG8_WAIT_L(n) asm volatile("s_waitcnt lgkmcnt(" #n ")" ::: "memory")
#define PG8_BAR __builtin_amdgcn_s_barrier()
#define PG8_SCHED __builtin_amdgcn_sched_barrier(0)
    Unit cur, nxt; int ui = 0;
    if (!S.next(0, cur)) return;
    f32x4 acc[2][2][4][2];
#pragma unroll
    for (int a = 0; a < 2; ++a)
#pragma unroll
        for (int b = 0; b < 2; ++b)
#pragma unroll
            for (int m = 0; m < 4; ++m)
#pragma unroll
                for (int n = 0; n < 2; ++n) acc[a][b][m][n] = (f32x4){0.f, 0.f, 0.f, 0.f};
    bf16x8 At[4][2], B0[2][2], B1[2][2];
    const char* cA = (const char*)g.A + (size_t)cur.pm * tstepA; const char* cB = (const char*)g.Bt + (size_t)cur.pn * tstepB;
    PG8_STAGE(PG8_SB(0, 0), cB, voffB); PG8_STAGE(PG8_SA(0, 0), cA, voffA); PG8_STAGE(PG8_SB(0, 1), cB + hstepB, voffB); PG8_STAGE(PG8_SA(0, 1), cA + hstepA, voffA);
    if (wr == 1) PG8_BAR;
    PG8_WAIT_V(4); PG8_BAR;
    PG8_STAGE(PG8_SB(1, 0), cB + kstep, voffB); PG8_STAGE(PG8_SA(1, 0), cA + kstep, voffA); PG8_STAGE(PG8_SB(1, 1), cB + hstepB + kstep, voffB);
    PG8_WAIT_V(6); PG8_BAR;
    for (;;) {
        const bool has_next = S.next(ui + 1, nxt);
        const char* nA = has_next ? (const char*)g.A + (size_t)nxt.pm * tstepA : cA; const char* nB = has_next ? (const char*)g.Bt + (size_t)nxt.pn * tstepB : cB;
        for (int t = 0; t < nt; t += 2) {
            const bool last = (t == nt - 2);
            const char* a1 = cA + (size_t)(t + 1) * kstep;
            const char* a2 = last ? nA : cA + (size_t)(t + 2) * kstep; const char* b2 = last ? nB : cB + (size_t)(t + 2) * kstep;
            const char* a3 = a2 + kstep; const char* b3 = b2 + kstep;
            PG8_LDB(B0, 0, 0); PG8_SCHED; PG8_LDA(At, 0, 0); PG8_STAGE(PG8_SA(1, 1), a1 + hstepA, voffA);
            PG8_WAIT_L(8); PG8_BAR; PG8_WAIT_L(0); PG8_MMA(0, 0, At, B0); PG8_BAR; PG8_SCHED;
            PG8_LDB(B1, 0, 1); PG8_STAGE(PG8_SB(0, 0), b2, voffB);
            PG8_BAR; PG8_WAIT_L(0); PG8_MMA(0, 1, At, B1); PG8_BAR;
            PG8_LDA(At, 0, 1); PG8_STAGE(PG8_SA(0, 0), a2, voffA);
            PG8_BAR; PG8_WAIT_L(0); PG8_MMA(1, 0, At, B0); PG8_BAR; PG8_SCHED;
            PG8_STAGE(PG8_SB(0, 1), b2 + hstepB, voffB);
            PG8_WAIT_V(6); PG8_BAR; PG8_MMA(1, 1, At, B1); PG8_BAR;
            PG8_LDB(B0, 1, 0); PG8_SCHED; PG8_LDA(At, 1, 0); PG8_STAGE(PG8_SA(0, 1), a2 + hstepA, voffA);
            PG8_WAIT_L(8); PG8_BAR; PG8_WAIT_L(0); PG8_MMA(0, 0, At, B0); PG8_BAR; PG8_SCHED;
            PG8_LDB(B1, 1, 1); PG8_STAGE(PG8_SB(1, 0), b3, voffB);
            PG8_BAR; PG8_WAIT_L(0); PG8_MMA(0, 1, At, B1); PG8_BAR;
            PG8_LDA(At, 1, 1); PG8_STAGE(PG8_SA(1, 0), a3, voffA);
            PG8_BAR; PG8_WAIT_L(0); PG8_MMA(1, 0, At, B0); PG8_BAR; PG8_SCHED;
            PG8_STAGE(PG8_SB(1, 1), b3 + hstepB, voffB);
            PG8_WAIT_V(6); PG8_BAR; PG8_MMA(1, 1, At, B1); PG8_BAR;
        }
        E(acc, cur, wr, wc, fr, fq);
        if (!has_next) break;
#pragma unroll
        for (int a = 0; a < 2; ++a)
#pragma unroll
            for (int b = 0; b < 2; ++b)
#pragma unroll
                for (int m = 0; m < 4; ++m)
#pragma unroll
                    for (int n = 0; n < 2; ++n) acc[a][b][m][n] = (f32x4){0.f, 0.f, 0.f, 0.f};
        cur = nxt; cA = nA; cB = nB; ++ui;
    }
    PG8_WAIT_V(0);
    if (wr == 0) PG8_BAR;
    PG8_BAR;
#undef PG8_SA
#undef PG8_SB
#undef PG8_STAGE
#undef PG8_LDA
#undef PG8_LDB
#undef PG8_MMA
#undef PG8_WAIT_V
#undef PG8_WAIT_L
#undef PG8_BAR
#undef PG8_SCHED
}
}

typedef f32x4 AccT[2][2][4][2];
#define EPI_LANE const int t_ = tid_(), wid_ = t_ >> 6, ln_ = t_ & 63, wr_ = wid_ >> 2, wc_ = wid_ & 3, fr_ = ln_ & 15, fq_ = ln_ >> 4;
#define EPI_LOOP_PERM(...) EPI_LANE \
    const int row0 = u.pm * 256 + wr_ * 64 + fr_, col0 = u.pn * 256 + wc_ * 32 + 8 * fq_; \
    _Pragma("unroll") for (int ai = 0; ai < 2; ++ai) _Pragma("unroll") for (int m = 0; m < 4; ++m) { const int row = row0 + ai * 128 + m * 16; \
        _Pragma("unroll") for (int bj = 0; bj < 2; ++bj) { const int col = col0 + bj * 128; const f32x4 v0 = acc[ai][bj][m][0], v1 = acc[ai][bj][m][1]; __VA_ARGS__ } }
#define EPI_LOOP_NAT(...) EPI_LANE \
    const int row0 = u.pm * 256 + wr_ * 64 + fr_, col0 = u.pn * 256 + wc_ * 32 + 4 * fq_; \
    _Pragma("unroll") for (int ai = 0; ai < 2; ++ai) _Pragma("unroll") for (int m = 0; m < 4; ++m) { const int row = row0 + ai * 128 + m * 16; \
        _Pragma("unroll") for (int bj = 0; bj < 2; ++bj) _Pragma("unroll") for (int n = 0; n < 2; ++n) { const int col = col0 + bj * 128 + n * 16; const f32x4 v = acc[ai][bj][m][n]; __VA_ARGS__ } }

struct EpiSwiglu { static constexpr bool PERM = true; bf16_t* O;
    DI void operator()(const AccT& acc, const pg8::Unit& u, int wr, int wc, int fr, int fq) const {
        EPI_LOOP_PERM({ u32x2 w; w.x = pack2(siluf_(v0[0]) * v1[0], siluf_(v0[1]) * v1[1]); w.y = pack2(siluf_(v0[2]) * v1[2], siluf_(v0[3]) * v1[3]);
            *(u32x2*)(O + (size_t)row * DFF + (col >> 1)) = w; })
    } };
struct EpiResid { static constexpr bool PERM = false; float* H; float scale;
    DI void operator()(const AccT& acc, const pg8::Unit& u, int wr, int wc, int fr, int fq) const {
        EPI_LOOP_NAT({ f32x4* p = (f32x4*)(H + (size_t)row * DM + col); *p = *p + v * scale; })
    } };
struct EpiProj { static constexpr bool PERM = true; bf16_t* O; bf16_t* XK; bf16_t* XV;
    DI void operator()(const AccT& acc, const pg8::Unit& u, int wr, int wc, int fr, int fq) const {
        const bool is_mg = u.pn * 256 >= C_MG, is_cmp = (u.pn == 10);
        EPI_LOOP_PERM({ f32x4 a = v0, b = v1;
            if (is_mg) { for (int j = 0; j < 4; ++j) { a[j] = sigmoidf_(a[j]); b[j] = sigmoidf_(b[j]); } }
            u32x4 w; w.x = pack2(a[0], a[1]); w.y = pack2(a[2], a[3]); w.z = pack2(b[0], b[1]); w.w = pack2(b[2], b[3]);
            *(u32x4*)(O + (size_t)row * PLD + col) = w;
            if (is_cmp) { const int c = col - C_KC, kv = c >> 7, gg = (c >> 6) & 1, d = c & 63, bb = row >> 11, s = row & 2047, jj = s >> 4, l = s & 15;
                bf16_t* X = kv ? XV : XK; *(u32x4*)(X + ((size_t)((bb * 128 + jj) * 2 + gg)) * 1024 + l * 64 + d) = w; } })
    } };
struct EpiMerge { static constexpr bool PERM = true; bf16_t* MRG; const bf16_t* PROJ; int J;
    DI void operator()(const AccT& acc, const pg8::Unit& u, int wr, int wc, int fr, int fq) const {
        EPI_LOOP_PERM({ const u32x4 gt = *(const u32x4*)(PROJ + (size_t)row * PLD + C_MG + J * 1024 + col);
            u32x4* mp = (u32x4*)(MRG + (size_t)row * DM + col); u32x4 old = (u32x4){0u, 0u, 0u, 0u}; if (J > 0) old = *mp;
            float r[8]; const float x[8] = {v0[0], v0[1], v0[2], v0[3], v1[0], v1[1], v1[2], v1[3]};
            _Pragma("unroll") for (int j = 0; j < 8; ++j) { const unsigned gw = gt[j >> 1], ow = old[j >> 1];
                const float gf = (j & 1) ? __uint_as_float(gw & 0xFFFF0000u) : __uint_as_float(gw << 16);
                const float of = (j & 1) ? __uint_as_float(ow & 0xFFFF0000u) : __uint_as_float(ow << 16);
                r[j] = of + gf * x[j]; }
            u32x4 w; w.x = pack2(r[0], r[1]); w.y = pack2(r[2], r[3]); w.z = pack2(r[4], r[5]); w.w = pack2(r[6], r[7]); *mp = w; })
    } };
struct EpiF32 { static constexpr bool PERM = false; float* C; static constexpr int ldc = 256;
    DI void operator()(const AccT& acc, const pg8::Unit& u, int wr, int wc, int fr, int fq) const {
        EPI_LOOP_NAT({ *(f32x4*)(C + (size_t)row * ldc + col) = v; })
    } };
struct EpiBf16 { static constexpr bool PERM = true; bf16_t* O; static constexpr int ldc = DM;
    DI void operator()(const AccT& acc, const pg8::Unit& u, int wr, int wc, int fr, int fq) const {
        EPI_LOOP_PERM({ u32x4 w; w.x = pack2(v0[0], v0[1]); w.y = pack2(v0[2], v0[3]); w.z = pack2(v1[0], v1[1]); w.w = pack2(v1[2], v1[3]);
            *(u32x4*)(O + (size_t)row * ldc + col) = w; })
    } };
struct EpiPleGate { static constexpr bool PERM = false; float* H; const bf16_t* TMP;
    DI void operator()(const AccT& acc, const pg8::Unit& u, int wr, int wc, int fr, int fq) const {
        EPI_LOOP_NAT({ const u32x2 tw = *(const u32x2*)(TMP + (size_t)row * DM + col); f32x4* p = (f32x4*)(H + (size_t)row * DM + col); f32x4 h = *p;
            h[0] += sigmoidf_(v[0]) * __uint_as_float(tw.x << 16); h[1] += sigmoidf_(v[1]) * __uint_as_float(tw.x & 0xFFFF0000u);
            h[2] += sigmoidf_(v[2]) * __uint_as_float(tw.y << 16); h[3] += sigmoidf_(v[3]) * __uint_as_float(tw.y & 0xFFFF0000u); *p = h; })
    } };

struct EpiLora { static constexpr bool PERM = true; bf16_t* EWA; bf16_t* G;
    DI void operator()(const AccT& acc, const pg8::Unit& u, int wr, int wc, int fr, int fq) const {
        const bool isg = u.pn >= 4; bf16_t* O = isg ? G - 1024 : EWA; const int ld = isg ? 512 : 1024;
        EPI_LOOP_PERM({ u32x4 w; w.x = pack2(v0[0], v0[1]); w.y = pack2(v0[2], v0[3]); w.z = pack2(v1[0], v1[1]); w.w = pack2(v1[2], v1[3]);
            *(u32x4*)(O + (size_t)row * ld + col) = w; })
    } };

template <class Epi> DI void run_gemm(unsigned char* smem, const bf16_t* A, int lda, const bf16_t* Bt, int M, int N, int K, const Epi& E) {
    __syncthreads();
    pg8::Gemm g; g.A = A; g.Bt = Bt; g.M = M; g.N = N; g.K = K; g.lda = lda;
    pg8::StaticOrder S; S.init(M, N, (int)gridDim.x, bid_());
    pg8::gemm_phase<Epi>((LAS unsigned char*)smem, g, S, E);
    __syncthreads();
}

struct MapId { DI int operator()(int n) const { return n; } };
struct MapGU { DI int operator()(int n) const { const int q = n >> 3, e = n & 7; return e < 4 ? 4 * q + e : DFF + 4 * q + (e - 4); } };
struct MapIn { DI int operator()(int n) const { return n < IN_REAL ? n : (n < C_MG ? -1 : n - (C_MG - IN_REAL)); } };
template <class Map> __device__ __forceinline__ void transpose_cvt(unsigned char* smem, const float* src, int ldsrc, bf16_t* dst, int K, int Nd, Map map) {
    float* tile = (float*)smem;
    const int tid = tid_(), ntk = K / 64, nt = ntk * (Nd / 64);
    for (int t = bid_(); t < nt; t += gridDim.x) {
        const int n0 = (t / ntk) * 64, k0 = (t % ntk) * 64;
        const int nn = tid & 63, sc = map(n0 + nn);
#pragma unroll
        for (int p = 0; p < 8; ++p) { const int kk = (tid >> 6) + p * 8; tile[kk * 65 + nn] = sc >= 0 ? src[(size_t)(k0 + kk) * ldsrc + sc] : 0.f; }
        __syncthreads();
#pragma unroll
        for (int p = 0; p < 4; ++p) { const int nn2 = (tid >> 5) + p * 16, kk2 = (tid & 31) * 2;
            *(unsigned*)(dst + (size_t)(n0 + nn2) * K + k0 + kk2) = pack2(tile[kk2 * 65 + nn2], tile[(kk2 + 1) * 65 + nn2]); }
        __syncthreads();
    }
}
__device__ __forceinline__ void convert_layer_weights(unsigned char* smem, CP p, int L) {
    bf16_t* W = (bf16_t*)(p->ws + WS_WBF);
    transpose_cvt(smem, p->in[I_F1GU] + (size_t)L * DM * 2 * DFF, 2 * DFF, W + E_GU1, DM, 2 * DFF, MapGU());
    transpose_cvt(smem, p->in[I_F1D] + (size_t)L * DFF * DM, DM, W + E_D1, DFF, DM, MapId());
    transpose_cvt(smem, p->in[I_WIN] + (size_t)L * DM * IN_COLS, IN_COLS, W + E_IN, DM, PLD, MapIn());
    for (int j = 0; j < 3; ++j) transpose_cvt(smem, p->in[I_WBR] + ((size_t)L * 3 + j) * 512 * DM, DM, W + E_BR + (size_t)j * 1024 * 512, 512, DM, MapId());
    transpose_cvt(smem, p->in[I_WOUT] + (size_t)L * DM * DM, DM, W + E_OUT, DM, DM, MapId());
    for (int i = bid_() * 512 + tid_(); i < 1536 * 256; i += gridDim.x * 512) { const int n = i >> 8, k = i & 255; float w = 0.f;
        if (n < 512) { if (k < 64) w = p->in[I_WB][((size_t)L * 64 + k) * 512 + n]; }
        else if (n < 1024) { if (k >= 64 && k < 128) w = p->in[I_AB][((size_t)L * 64 + (k - 64)) * 512 + (n - 512)]; }
        else { if (k >= 128) w = p->in[I_GB][((size_t)L * 128 + (k - 128)) * 512 + (n - 1024)]; }
        W[E_LORA + i] = f2bf(w); }
    transpose_cvt(smem, p->in[I_PLEG] + (size_t)L * DM * DM, DM, W + E_PG, DM, DM, MapId());
    transpose_cvt(smem, p->in[I_PLEW] + (size_t)L * 256 * DM, DM, W + E_PW, 256, DM, MapId());
    for (int kv = 0; kv < 2; ++kv) for (int hf = 0; hf < 2; ++hf)
        transpose_cvt(smem, p->in[I_CW1] + ((size_t)(L * 2 + kv) * 2048 + hf * 1024) * 128, 128, W + E_C1 + ((size_t)kv * 256 + hf * 128) * 1024, 1024, 128, MapId());
    if (bid_() == gridDim.x - 1 && tid_() < 256) {
        const int kv = tid_() >> 7, hc = tid_() & 127;
        const float* pe = p->in[I_PE] + (size_t)(L * 2 + kv) * 2048; const float* w1 = p->in[I_CW1] + (size_t)(L * 2 + kv) * 2048 * 128 + hc;
        float s = 0.f; for (int i = 0; i < 2048; ++i) s += pe[i] * w1[(size_t)i * 128];
        ((float*)(p->ws + WS_PEB))[kv * 128 + hc] = s;
    }
}

__device__ __forceinline__ void convert_ffn2_weights(unsigned char* smem, CP p, int L) {
    bf16_t* W = (bf16_t*)(p->ws + WS_WBF);
    transpose_cvt(smem, p->in[I_F2GU] + (size_t)L * DM * 2 * DFF, 2 * DFF, W + E_GU2, DM, 2 * DFF, MapGU());
    transpose_cvt(smem, p->in[I_F2D] + (size_t)L * DFF * DM, DM, W + E_D2, DFF, DM, MapId());
}
__device__ __forceinline__ void lora_act(CP p, int L) {
    const bf16_t* PROJ = (const bf16_t*)(p->ws + WS_PROJ); bf16_t* LACT = (bf16_t*)(p->ws + WS_LACT);
    const float* mu = p->in[I_MU] + (size_t)L * 1792 + 1536;
    for (int i = bid_() * 512 + tid_(); i < T_TOK * 32; i += gridDim.x * 512) {
        const int t = i >> 5, j0 = (i & 31) * 8; const bf16_t* row = PROJ + (size_t)t * PLD + C_RW + 1536 + j0;
        const u32x4 cur = *(const u32x4*)row; u32x4 prv = {0u, 0u, 0u, 0u}; if ((t & (SEQ - 1)) != 0) prv = *(const u32x4*)(row - PLD);
        float r[8];
#pragma unroll
        for (int e = 0; e < 8; ++e) { const float x1 = (e & 1) ? __uint_as_float(cur[e >> 1] & 0xFFFF0000u) : __uint_as_float(cur[e >> 1] << 16);
            const float xp = (e & 1) ? __uint_as_float(prv[e >> 1] & 0xFFFF0000u) : __uint_as_float(prv[e >> 1] << 16);
            float xm = x1 + (xp - x1) * mu[j0 + e];
            if (j0 < 64) xm = tanhf(xm); else if (j0 >= 128) xm = sigmoidf_(xm);
            r[e] = xm; }
        u32x4 w; w.x = pack2(r[0], r[1]); w.y = pack2(r[2], r[3]); w.z = pack2(r[4], r[5]); w.w = pack2(r[6], r[7]);
        *(u32x4*)(LACT + (size_t)t * 256 + j0) = w;
    }
}

__device__ __forceinline__ void rmsnorm_rows(const float* hin, float* hcopy, const float* g, bf16_t* un, float* outf) {
    const int lane = tid_() & 63, gw = bid_() * 8 + (tid_() >> 6), nw = gridDim.x * 8;
    f32x4 gv[4];
#pragma unroll
    for (int i = 0; i < 4; ++i) gv[i] = *(const f32x4*)(g + lane * 4 + i * 256);
    for (int row = gw; row < T_TOK; row += nw) {
        f32x4 x[4]; float ss = 0.f;
#pragma unroll
        for (int i = 0; i < 4; ++i) { x[i] = *(const f32x4*)(hin + (size_t)row * DM + lane * 4 + i * 256); ss += x[i][0] * x[i][0] + x[i][1] * x[i][1] + x[i][2] * x[i][2] + x[i][3] * x[i][3]; }
        ss = wave_sum(ss);
        const float rs = rsqrtf(ss * (1.0f / DM) + 1e-6f);
#pragma unroll
        for (int i = 0; i < 4; ++i) {
            const f32x4 y = x[i] * rs * gv[i];
            if (hcopy) *(f32x4*)(hcopy + (size_t)row * DM + lane * 4 + i * 256) = x[i];
            if (un) { u32x2 w; w.x = pack2(y[0], y[1]); w.y = pack2(y[2], y[3]); *(u32x2*)(un + (size_t)row * DM + lane * 4 + i * 256) = w; }
            if (outf) *(f32x4*)(outf + (size_t)row * DM + lane * 4 + i * 256) = y;
        }
    }
}
__device__ __forceinline__ void cvt_f32_bf16(const float* src, bf16_t* dst, size_t n4) {
    for (size_t i = (size_t)bid_() * 512 + tid_(); i < n4; i += (size_t)gridDim.x * 512) {
        const f32x4 v = *(const f32x4*)(src + i * 4); u32x2 w; w.x = pack2(v[0], v[1]); w.y = pack2(v[2], v[3]); *(u32x2*)(dst + i * 4) = w; }
}

__device__ __forceinline__ void finalize_cmp(unsigned char* smem, CP p, int L) {
    float* hid = (float*)smem + (tid_() >> 6) * 128;
    const int lane = tid_() & 63, gw = bid_() * 8 + (tid_() >> 6), nw = gridDim.x * 8;
    const float* peb = (const float*)(p->ws + WS_PEB);
    const int total = 2 * 16 * 2 * 128, iters = (total + nw - 1) / nw;
    for (int it = 0; it < iters; ++it) {
        const int id = gw + it * nw; const bool ok = id < total;
        const int n = id & 127, gg = (id >> 7) & 1, bb = (id >> 8) & 15, kv = (id >> 12) & 1;
        if (ok && n < 127) {
            const float* Pm = (const float*)(p->ws + WS_P01) + (size_t)kv * 4096 * 256;
            const size_t r0 = (size_t)((bb * 128 + n) * 2 + gg) * 256, r1 = (size_t)((bb * 128 + n + 1) * 2 + gg) * 256;
#pragma unroll
            for (int q = 0; q < 2; ++q) { const int hc = lane + q * 64; hid[hc] = siluf_(Pm[r0 + hc] + Pm[r1 + 128 + hc] + peb[kv * 128 + hc]); }
        }
        __syncthreads();
        if (ok) {
            float o = 0.f;
            if (n < 127) { const float* w2 = p->in[I_CW2] + (size_t)(L * 2 + kv) * 128 * 64 + lane;
                for (int hc = 0; hc < 128; ++hc) o += hid[hc] * w2[hc * 64]; }
            ((float*)(p->ws + WS_KC))[((((size_t)kv * 16 + bb) * 2 + gg) * 128 + n) * 64 + lane] = o;
        }
        __syncthreads();
    }
}

__device__ __forceinline__ void hgrn_scan(unsigned char* smem, CP p, int L, int b, int h) {
    float* F = (float*)smem; float* Kx = F + 2048; float* Q = Kx + 2048; float* V = Q + 2048; float* PO = V + 2048;
    const int tid = tid_(), e = tid & 63, wv = tid >> 6, C = h * 64 + e;
    float lb;
    { const float* hl = p->in[I_HGLB]; const float a0 = hl[C], a1 = hl[512 + C], a2 = hl[1024 + C], a3 = hl[1536 + C];
      const float mx = fmaxf(fmaxf(a0, a1), fmaxf(a2, a3)); const float e0 = __expf(a0 - mx), e1 = __expf(a1 - mx), e2 = __expf(a2 - mx), e3 = __expf(a3 - mx);
      const float inv = 1.0f / (e0 + e1 + e2 + e3); float acc = 0.f; if (L >= 1) acc += e1; if (L >= 2) acc += e2; if (L >= 3) acc += e3; lb = fmaxf(acc * inv, 0.f); }
    const float ng = p->in[I_HGN][L * 512 + C];
    bf16_t* base = (bf16_t*)(p->ws + WS_PROJ) + (size_t)b * SEQ * PLD + C;
    f32x2 S0 = {0.f, 0.f}, S1 = {0.f, 0.f}, S2 = {0.f, 0.f}, S3 = {0.f, 0.f};
    bf16_t pz[4], pq[4], pi[4], pg[4];
#define HG_PREFETCH(T0) do { _Pragma("unroll") for (int i = 0; i < 4; ++i) { const bf16_t* row = base + (size_t)((T0) + wv * 4 + i) * PLD; \
        pz[i] = row[C_HF]; pq[i] = row[C_HQ]; pi[i] = row[C_HI]; pg[i] = row[C_HG]; } } while (0)
    HG_PREFETCH(0);
    for (int t0 = 0; t0 < SEQ; t0 += 32) {
        float gr[4];
#pragma unroll
        for (int i = 0; i < 4; ++i) { const int t = wv * 4 + i;
            const float z = bf2f(pz[i]), qr = bf2f(pq[i]), vi = bf2f(pi[i]); gr[i] = bf2f(pg[i]);
            const float sg = sigmoidf_(z); F[t * 64 + e] = sg + lb * (1.0f - sg); Kx[t * 64 + e] = (1.0f - lb) * (1.0f - sg); Q[t * 64 + e] = siluf_(qr); V[t * 64 + e] = vi; }
        __syncthreads();
        if (t0 + 32 < SEQ) HG_PREFETCH(t0 + 32);
#pragma unroll 4
        for (int t = 0; t < 32; ++t) {
            const f32x4 f0 = *(const f32x4*)(F + t * 64 + wv * 8), f1 = *(const f32x4*)(F + t * 64 + wv * 8 + 4);
            const f32x4 k0 = *(const f32x4*)(Kx + t * 64 + wv * 8), k1 = *(const f32x4*)(Kx + t * 64 + wv * 8 + 4);
            const f32x4 q0 = *(const f32x4*)(Q + t * 64 + wv * 8), q1 = *(const f32x4*)(Q + t * 64 + wv * 8 + 4);
            const float v = V[t * 64 + e]; const f32x2 vv = {v, v};
            S0 = (f32x2){f0[0], f0[1]} * S0 + (f32x2){k0[0], k0[1]} * vv; S1 = (f32x2){f0[2], f0[3]} * S1 + (f32x2){k0[2], k0[3]} * vv;
            S2 = (f32x2){f1[0], f1[1]} * S2 + (f32x2){k1[0], k1[1]} * vv; S3 = (f32x2){f1[2], f1[3]} * S3 + (f32x2){k1[2], k1[3]} * vv;
            f32x2 o2 = (f32x2){q0[0], q0[1]} * S0 + (f32x2){q0[2], q0[3]} * S1 + (f32x2){q1[0], q1[1]} * S2 + (f32x2){q1[2], q1[3]} * S3;
            PO[(t * 8 + wv) * 64 + e] = o2[0] + o2[1];
        }
        __syncthreads();
#pragma unroll
        for (int i = 0; i < 4; ++i) { const int t = wv * 4 + i;
            float o = 0.f;
#pragma unroll
            for (int q = 0; q < 8; ++q) o += PO[(t * 8 + q) * 64 + e];
            const float ss = wave_sum(o * o); const float rs = rsqrtf(ss * (1.0f / 64.0f) + 1e-6f);
            base[(size_t)(t0 + t) * PLD + C_HQ] = f2bf(o * rs * ng * siluf_(gr[i])); }
        __syncthreads();
    }
#undef HG_PREFETCH
}

DI float dpp_xor1(float v) { return __int_as_float(__builtin_amdgcn_mov_dpp(__float_as_int(v), 0xB1, 0xF, 0xF, true)); }
DI float dpp_xor2(float v) { return __int_as_float(__builtin_amdgcn_mov_dpp(__float_as_int(v), 0x4E, 0xF, 0xF, true)); }
DI float dpp_hmir(float v) { return __int_as_float(__builtin_amdgcn_mov_dpp(__float_as_int(v), 0x141, 0xF, 0xF, true)); }
DI float red8(float v) { v += dpp_xor1(v); v += dpp_xor2(v); v += dpp_hmir(v); return v; }

__device__ __forceinline__ void rwkv_scan(unsigned char* smem, CP p, int L, int b, int h) {
    constexpr int BUF_F = 6 * 2048 + 64 + 2048;
    const int tid = tid_(), c = tid & 63, wv = tid >> 6, C = h * 64 + c, lane = c;
    const float* mu = p->in[I_MU] + (size_t)L * 1792;
    const float mu_r = mu[C], mu_k = mu[512 + C], mu_v = mu[1024 + C];
    const float w0 = p->in[I_W0][L * 512 + C], a0 = p->in[I_A0][L * 512 + C];
    const float k_k = p->in[I_KK][L * 512 + C], k_a = p->in[I_KA][L * 512 + C], r_k = p->in[I_RK][L * 512 + C], ln_w = p->in[I_LNW][L * 512 + C], ln_b = p->in[I_LNB][L * 512 + C];
    const bf16_t* base = (const bf16_t*)(p->ws + WS_PROJ) + (size_t)b * SEQ * PLD + C_RW + C;
    const bf16_t* ewa = (const bf16_t*)(p->ws + WS_UN) + (size_t)b * SEQ * 1024 + C;
    bf16_t* obase = (bf16_t*)(p->ws + WS_ORW) + (size_t)b * SEQ * 512 + C;
    const int kp = lane & 7, vr = lane >> 3, vrow = wv * 8 + vr;
    f32x2 S0 = {0.f, 0.f}, S1 = {0.f, 0.f}, S2 = {0.f, 0.f}, S3 = {0.f, 0.f};
    bf16_t pr[4], pk[4], pv[4], pe[4], pa[4], pg[4], qr, qk, qv;
#define RW_PREFETCH(T0) do { const int s0_ = (T0) + wv * 4; \
        _Pragma("unroll") for (int i = 0; i < 4; ++i) { const bf16_t* row = base + (size_t)(s0_ + i) * PLD; pr[i] = row[0]; pk[i] = row[512]; pv[i] = row[1024]; \
            pe[i] = ewa[(size_t)(s0_ + i) * 1024]; pa[i] = ewa[(size_t)(s0_ + i) * 1024 + 512]; pg[i] = obase[(size_t)(s0_ + i) * 512]; } \
        if (s0_ > 0) { const bf16_t* row = base + (size_t)(s0_ - 1) * PLD; qr = row[0]; qk = row[512]; qv = row[1024]; } else { qr = 0; qk = 0; qv = 0; } } while (0)
    RW_PREFETCH(0);
    __syncthreads();
    for (int blk = 0; blk < SEQ / 32; ++blk) {
        float* Bf = (float*)smem + (blk & 1) * BUF_F;
        float* Wd = Bf; float* NKK = Bf + 2048; float* AB = Bf + 4096; float* KX = Bf + 6144; float* WR = Bf + 8192; float* VS = Bf + 10240; float* SC = Bf + 12288; float* YS = Bf + 12352;
        float bon[4], gv[4];
        { float rp = bf2f(qr), kq = bf2f(qk), vp = bf2f(qv);
#pragma unroll
          for (int i = 0; i < 4; ++i) { const int t = wv * 4 + i;
              const float r1 = bf2f(pr[i]), k1 = bf2f(pk[i]), v1 = bf2f(pv[i]);
              const float r = r1 + (rp - r1) * mu_r, k = k1 + (kq - k1) * mu_k, v = v1 + (vp - v1) * mu_v; rp = r1; kq = k1; vp = v1;
              const float decay = __expf(-0.6065306597f * sigmoidf_(w0 + bf2f(pe[i]))), a = sigmoidf_(a0 + bf2f(pa[i])); gv[i] = bf2f(pg[i]);
              const float kkv = k * k_k; const float ssq = wave_sum(kkv * kkv); const float kkn = kkv / fmaxf(sqrtf(ssq), 1e-12f);
              const float kx = k * (1.0f + (a - 1.0f) * k_a), ab = kkn * a;
              const float br = wave_sum(ab * r), kr = wave_sum(kx * r); bon[i] = wave_sum(r * kx * r_k);
              Wd[t * 64 + c] = decay; NKK[t * 64 + c] = -kkn; AB[t * 64 + c] = ab; KX[t * 64 + c] = kx; WR[t * 64 + c] = decay * r; VS[t * 64 + c] = v;
              if (c == 0) { SC[t * 2] = br; SC[t * 2 + 1] = kr; } } }
        __syncthreads();
        if (blk + 1 < SEQ / 32) RW_PREFETCH((blk + 1) * 32);
#define RW_LOAD(T, w0v, w1v, n0, n1, b0, b1, x0, x1, q0, q1, vv, sc) do { const int o_ = (T) * 64 + kp * 8; \
            w0v = *(const f32x4*)(Wd + o_); w1v = *(const f32x4*)(Wd + o_ + 4); n0 = *(const f32x4*)(NKK + o_); n1 = *(const f32x4*)(NKK + o_ + 4); \
            b0 = *(const f32x4*)(AB + o_); b1 = *(const f32x4*)(AB + o_ + 4); x0 = *(const f32x4*)(KX + o_); x1 = *(const f32x4*)(KX + o_ + 4); \
            q0 = *(const f32x4*)(WR + o_); q1 = *(const f32x4*)(WR + o_ + 4); vv = VS[(T) * 64 + vrow]; sc = *(const f32x2*)(SC + (T) * 2); } while (0)
        f32x4 cw0, cw1, cn0, cn1, cb0, cb1, cx0, cx1, cq0, cq1; float cvv; f32x2 csc;
        RW_LOAD(0, cw0, cw1, cn0, cn1, cb0, cb1, cx0, cx1, cq0, cq1, cvv, csc);
#pragma nounroll
        for (int t8 = 0; t8 < 4; ++t8) {
            float ykeep = 0.f;
#pragma unroll
            for (int j = 0; j < 8; ++j) {
                const int t = t8 * 8 + j;
                const f32x4 w0v = cw0, w1v = cw1, n0 = cn0, n1 = cn1, b0 = cb0, b1 = cb1, x0 = cx0, x1 = cx1, q0 = cq0, q1 = cq1; const float vv = cvv; const f32x2 sc = csc;
                { const int tn = (t + 1) & 31; RW_LOAD(tn, cw0, cw1, cn0, cn1, cb0, cb1, cx0, cx1, cq0, cq1, cvv, csc); }
                const f32x2 sa2 = S0 * (f32x2){n0[0], n0[1]} + S1 * (f32x2){n0[2], n0[3]} + S2 * (f32x2){n1[0], n1[1]} + S3 * (f32x2){n1[2], n1[3]};
                const f32x2 y2 = S0 * (f32x2){q0[0], q0[1]} + S1 * (f32x2){q0[2], q0[3]} + S2 * (f32x2){q1[0], q1[1]} + S3 * (f32x2){q1[2], q1[3]};
                float sa = sa2[0] + sa2[1], yy = y2[0] + y2[1];
                sa += dpp_xor1(sa); yy += dpp_xor1(yy); sa += dpp_xor2(sa); yy += dpp_xor2(yy); sa += dpp_hmir(sa); yy += dpp_hmir(yy);
                const f32x2 sav = {sa, sa}, vv2 = {vv, vv};
                S0 = S0 * (f32x2){w0v[0], w0v[1]} + sav * (f32x2){b0[0], b0[1]} + vv2 * (f32x2){x0[0], x0[1]};
                S1 = S1 * (f32x2){w0v[2], w0v[3]} + sav * (f32x2){b0[2], b0[3]} + vv2 * (f32x2){x0[2], x0[3]};
                S2 = S2 * (f32x2){w1v[0], w1v[1]} + sav * (f32x2){b1[0], b1[1]} + vv2 * (f32x2){x1[0], x1[1]};
                S3 = S3 * (f32x2){w1v[2], w1v[3]} + sav * (f32x2){b1[2], b1[3]} + vv2 * (f32x2){x1[2], x1[3]};
                const float y = yy + sa * sc[0] + vv * sc[1];
                ykeep = (kp == j) ? y : ykeep;
            }
            YS[(t8 * 8 + kp) * 64 + vrow] = ykeep;
        }
#undef RW_LOAD
        __syncthreads();
#pragma unroll
        for (int i = 0; i < 4; ++i) { const int t = wv * 4 + i;
            const float y = YS[t * 64 + c]; const float mean = wave_sum(y) * (1.0f / 64.0f); const float dlt = y - mean;
            const float var = wave_sum(dlt * dlt) * (1.0f / 64.0f);
            float yn = dlt * rsqrtf(var + 64e-5f) * ln_w + ln_b; yn += bon[i] * VS[t * 64 + c];
            obase[(size_t)(blk * 32 + t) * 512] = f2bf(yn * gv[i]); }
    }
#undef RW_PREFETCH
    __syncthreads();
}

#define MFMA32(a, b, c) __builtin_amdgcn_mfma_f32_32x32x16_bf16((a), (b), (c), 0, 0, 0)
constexpr int KTS = 72;
DI bf16x8 pack8(float a0, float a1, float a2, float a3, float a4, float a5, float a6, float a7) {
    u32x4 w; w.x = pack2(a0, a1); w.y = pack2(a2, a3); w.z = pack2(a4, a5); w.w = pack2(a6, a7); return __builtin_bit_cast(bf16x8, w); }
DI bf16x8 ld_vfrag(const bf16_t* vt, int off) { const u32x2 lo = *(const u32x2*)(vt + off), hi = *(const u32x2*)(vt + off + 8); u32x4 w; w.x = lo.x; w.y = lo.y; w.z = hi.x; w.w = hi.y; return __builtin_bit_cast(bf16x8, w); }

struct FlashState { f32x16 o0, o1; float m, l; };

DI void flash_update(FlashState& st, f32x16& sc0, f32x16& sc1, const bf16_t* VT, int vs, int qi, int hl) {
    float mt = -INFINITY;
#pragma unroll
    for (int i = 0; i < 16; ++i) mt = fmaxf(mt, fmaxf(sc0[i], sc1[i]));
    mt = fmaxf(mt, shfl_xor_(mt, 32, qi + 32 * hl));
    const float mnew = fmaxf(st.m, mt), muse = (mnew == -INFINITY) ? 0.f : mnew;
    const float alpha = __builtin_amdgcn_exp2f(st.m - muse);
    float ls = 0.f;
#pragma unroll
    for (int i = 0; i < 16; ++i) { sc0[i] = __builtin_amdgcn_exp2f(sc0[i] - muse); sc1[i] = __builtin_amdgcn_exp2f(sc1[i] - muse); ls += sc0[i] + sc1[i]; }
    st.l = st.l * alpha + ls; st.m = mnew;
    st.o0 *= alpha; st.o1 *= alpha;
#pragma unroll
    for (int s = 0; s < 2; ++s) {
        const bf16x8 p0 = pack8(sc0[8 * s], sc0[8 * s + 1], sc0[8 * s + 2], sc0[8 * s + 3], sc0[8 * s + 4], sc0[8 * s + 5], sc0[8 * s + 6], sc0[8 * s + 7]);
        const bf16x8 p1 = pack8(sc1[8 * s], sc1[8 * s + 1], sc1[8 * s + 2], sc1[8 * s + 3], sc1[8 * s + 4], sc1[8 * s + 5], sc1[8 * s + 6], sc1[8 * s + 7]);
        st.o0 = MFMA32(ld_vfrag(VT, qi * vs + 16 * s + 4 * hl), p0, st.o0);
        st.o1 = MFMA32(ld_vfrag(VT, (32 + qi) * vs + 16 * s + 4 * hl), p0, st.o1);
        st.o0 = MFMA32(ld_vfrag(VT, qi * vs + 32 + 16 * s + 4 * hl), p1, st.o0);
        st.o1 = MFMA32(ld_vfrag(VT, (32 + qi) * vs + 32 + 16 * s + 4 * hl), p1, st.o1);
    }
}
DI void qk_tile(const bf16_t* KT, const bf16x8 (&qf)[4], int qi, int hl, f32x16& sc0, f32x16& sc1) {
#pragma unroll
    for (int i = 0; i < 16; ++i) { sc0[i] = 0.f; sc1[i] = 0.f; }
#pragma unroll
    for (int s = 0; s < 4; ++s) {
        const bf16x8 k0 = *(const bf16x8*)(KT + qi * KTS + 16 * s + 8 * hl), k1 = *(const bf16x8*)(KT + (32 + qi) * KTS + 16 * s + 8 * hl);
        sc0 = MFMA32(k0, qf[s], sc0); sc1 = MFMA32(k1, qf[s], sc1);
    }
}
struct KVRegs { u32x4 k, v; };
DI void kv_fetch(KVRegs& r, const bf16_t* pb, int kcol, int vcol, int k0) {
    const int tid = tid_();
    const unsigned ok_ = (unsigned)((k0 + (tid >> 3)) * PLD + kcol + (tid & 7) * 8) * 2u, ov_ = (unsigned)((k0 + (tid & 63)) * PLD + vcol + (tid >> 6) * 8) * 2u;
    r.k = *(const u32x4*)((const char*)pb + ok_);
    r.v = *(const u32x4*)((const char*)pb + ov_);
}
DI void kv_store(const KVRegs& r, bf16_t* KT, bf16_t* VT) {
    const int tid = tid_();
    *(u32x4*)(KT + (tid >> 3) * KTS + (tid & 7) * 8) = r.k;
    const int key = tid & 63, ch = tid >> 6;
#pragma unroll
    for (int j = 0; j < 8; ++j) VT[(ch * 8 + j) * KTS + key] = (bf16_t)((j & 1) ? (r.v[j >> 1] >> 16) : (r.v[j >> 1] & 0xFFFFu));
}
template <bool LUTB, bool CAUSAL, bool WHI, bool SEL>
DI void mask_tile(f32x16& sc0, f32x16& sc1, const float* lut, int qpos, int k0, int hl, bool sel, float qs) {
    const float bfar = lut[128];
#pragma unroll
    for (int i = 0; i < 16; ++i) { const int kl = (i & 3) + 8 * (i >> 2) + 4 * hl;
        { const int dist = qpos - (k0 + kl); const float v = sc0[i] * qs + (LUTB ? lut[dist > 128 ? 128 : (dist < 0 ? 0 : dist)] : bfar);
          bool ok = true; if (CAUSAL) ok = ok && dist >= 0; if (WHI) ok = ok && dist < 256; if (SEL) ok = ok && sel; sc0[i] = ok ? v : -INFINITY; }
        { const int dist = qpos - (k0 + 32 + kl); const float v = sc1[i] * qs + (LUTB ? lut[dist > 128 ? 128 : (dist < 0 ? 0 : dist)] : bfar);
          bool ok = true; if (CAUSAL) ok = ok && dist >= 0; if (WHI) ok = ok && dist < 256; if (SEL) ok = ok && sel; sc1[i] = ok ? v : -INFINITY; } }
}

__device__ __forceinline__ void nsa_item(unsigned char* smem, CP p, int L, int b, int g, int qb, int ocol) {
    bf16_t* KT = (bf16_t*)smem;
    bf16_t* VT = (bf16_t*)(smem + 9216);
    float* LUT = (float*)(smem + 18432);
    unsigned* SELM = (unsigned*)(smem + 20736);
    unsigned* ORM = (unsigned*)(smem + 20992);
    float* PA = (float*)(smem + 21504);
    float* PBv = (float*)(smem + 54272);
    bf16_t* KT2 = (bf16_t*)(smem + 87040);
    bf16_t* VT2 = (bf16_t*)(smem + 105472);
    const int tid = tid_(), lane = tid & 63, wv = tid >> 6, hh = wv >> 1, qhalf = wv & 1, qi = lane & 31, hl = lane >> 5;
    const int ql = qhalf * 32 + qi, qpos = qb * 64 + ql, head = g * 4 + hh;
    bf16_t* pb = (bf16_t*)(p->ws + WS_PROJ) + (size_t)b * SEQ * PLD;
    bf16_t* qrow = pb + (size_t)qpos * PLD;
    __syncthreads();
    for (int i = tid; i < 4 * 129; i += 512) { const int h2 = i / 129, dd = i % 129; int bk;
        if (dd < 16) bk = dd; else if (dd >= 128) bk = 31; else { bk = 16 + (int)(logf((float)dd / 16.0f) / 2.0794415416798357f * 16.0f); bk = bk > 31 ? 31 : bk; }
        LUT[h2 * 132 + dd] = p->in[I_RELB][bk * 8 + g * 4 + h2] * 1.4426950408889634f; }
    if (tid == 0) *ORM = 0u;
    if (tid < 64) SELM[tid] = 0u;
    if (tid < 256) PBv[tid * 32] = 0.f;
    { const float* kc = (const float*)(p->ws + WS_KC) + ((size_t)(0 * 16 + b) * 2 + g) * 128 * 64; const float* vc = (const float*)(p->ws + WS_KC) + ((size_t)(1 * 16 + b) * 2 + g) * 128 * 64;
      for (int i = tid; i < 128 * 64; i += 512) { const int n = i >> 6, d = i & 63; KT2[n * KTS + d] = f2bf(kc[i]); }
      for (int i = tid; i < 128 * 64; i += 512) { const int n = i & 127, d = i >> 7; VT2[d * 136 + n] = f2bf(vc[n * 64 + d]); } }
    bf16x8 qf[4];
#pragma unroll
    for (int s = 0; s < 4; ++s) qf[s] = *(const bf16x8*)(qrow + C_NQ + head * 64 + 16 * s + 8 * hl);
    float g0, g1, g2;
    { const bf16_t* gp = qrow + C_NG + head * 3; g0 = sigmoidf_(bf2f(gp[0])); g1 = sigmoidf_(bf2f(gp[1])); g2 = sigmoidf_(bf2f(gp[2])); }
    __syncthreads();
    const float* lut = LUT + hh * 132;
    constexpr float QS = 0.125f * 1.4426950408889634f;
    f32x16 fin0, fin1;
    {
        FlashState st;
#pragma unroll
        for (int i = 0; i < 16; ++i) { st.o0[i] = 0.f; st.o1[i] = 0.f; }
        st.m = -INFINITY; st.l = 0.f;
#pragma nounroll
        for (int t = 0; t < 2; ++t) {
            f32x16 sc0, sc1; qk_tile(KT2 + t * 64 * KTS, qf, qi, hl, sc0, sc1);
#pragma unroll
            for (int i = 0; i < 16; ++i) { const int kl = (i & 3) + 8 * (i >> 2) + 4 * hl;
                { const int n = 64 * t + kl, dist = qpos - (16 * n + 31); sc0[i] = (dist >= 0 && n < 127) ? sc0[i] * QS + lut[dist > 128 ? 128 : dist] : -INFINITY; }
                { const int n = 64 * t + 32 + kl, dist = qpos - (16 * n + 31); sc1[i] = (dist >= 0 && n < 127) ? sc1[i] * QS + lut[dist > 128 ? 128 : dist] : -INFINITY; } }
            flash_update(st, sc0, sc1, VT2 + 64 * t, 136, qi, hl);
        }
        const float lt = st.l + shfl_xor_(st.l, 32, lane); const float inv = 1.0f / fmaxf(lt, 1e-30f);
        const float muse = (st.m == -INFINITY) ? 0.f : st.m;
        fin0 = st.o0 * (g0 * inv); fin1 = st.o1 * (g0 * inv);
#pragma nounroll
        for (int t = 0; t < 2; ++t) {
            f32x16 sc0, sc1; qk_tile(KT2 + t * 64 * KTS, qf, qi, hl, sc0, sc1);
#pragma unroll
            for (int i = 0; i < 16; ++i) { const int kl = (i & 3) + 8 * (i >> 2) + 4 * hl;
                { const int n = 64 * t + kl, dist = qpos - (16 * n + 31); sc0[i] = (dist >= 0 && n < 127) ? __builtin_amdgcn_exp2f(sc0[i] * QS + lut[dist > 128 ? 128 : dist] - muse) * inv : 0.f; }
                { const int n = 64 * t + 32 + kl, dist = qpos - (16 * n + 31); sc1[i] = (dist >= 0 && n < 127) ? __builtin_amdgcn_exp2f(sc1[i] * QS + lut[dist > 128 ? 128 : dist] - muse) * inv : 0.f; } }
#pragma unroll
            for (int i4 = 0; i4 < 4; ++i4) {
                { const int m = 16 * t + 2 * i4 + hl; PA[(hh * 64 + ql) * 32 + m] = sc0[4 * i4] + sc0[4 * i4 + 1] + sc0[4 * i4 + 2] + sc0[4 * i4 + 3]; PBv[(hh * 64 + ql) * 32 + m + 1] = sc0[4 * i4 + 3]; }
                { const int m = 16 * t + 8 + 2 * i4 + hl; PA[(hh * 64 + ql) * 32 + m] = sc1[4 * i4] + sc1[4 * i4 + 1] + sc1[4 * i4 + 2] + sc1[4 * i4 + 3]; if (m + 1 < 32) PBv[(hh * 64 + ql) * 32 + m + 1] = sc1[4 * i4 + 3]; }
            }
        }
    }
    __syncthreads();
    {
        float* IMP = (float*)smem;
        const int q = tid & 63, part = tid >> 6, cur = qb;
#pragma unroll
        for (int mm = 0; mm < 4; ++mm) { const int m = part * 4 + mm; float v;
            if (m == 0 || m == cur || m == cur - 1) v = INFINITY;
            else if (m <= cur) { v = 0.f; for (int h2 = 0; h2 < 4; ++h2) v += PA[(h2 * 64 + q) * 32 + m] + PBv[(h2 * 64 + q) * 32 + m]; }
            else v = -INFINITY;
            IMP[q * 33 + m] = v; }
        __syncthreads();
        unsigned bits = 0u;
#pragma unroll
        for (int mm = 0; mm < 4; ++mm) { const int m = part * 4 + mm; const float v = IMP[q * 33 + m]; int rank = 0;
            for (int m2 = 0; m2 < 32; ++m2) { const float v2 = IMP[q * 33 + m2]; rank += (v2 > v || (v2 == v && m2 < m)) ? 1 : 0; }
            if (rank < 8 && v > -INFINITY) bits |= 1u << m; }
        atomicOr(&SELM[q], bits); atomicOr(ORM, bits);
    }
    __syncthreads();
    const unsigned mysel = SELM[ql], orm = *ORM;
    __syncthreads();
    float* PARK = PA + (wv * 32) * 64 + lane;
#pragma unroll
    for (int i = 0; i < 16; ++i) { PARK[i * 64] = fin0[i]; PARK[(16 + i) * 64] = fin1[i]; }
    {
        FlashState st;
#pragma unroll
        for (int i = 0; i < 16; ++i) { st.o0[i] = 0.f; st.o1[i] = 0.f; }
        st.m = -INFINITY; st.l = 0.f;
        const unsigned todo = orm & (qb >= 31 ? 0xFFFFFFFFu : ((2u << qb) - 1u));
        KVRegs kr;
        int m = todo ? __builtin_ctz(todo) : -1;
        if (m >= 0) { kv_fetch(kr, pb, C_KS + g * 64, C_VS + g * 64, m * 64); __syncthreads(); kv_store(kr, KT, VT); __syncthreads(); }
        while (m >= 0) {
            const unsigned rest = todo & ~((2u << m) - 1u); const int nm = (m < 31 && rest) ? __builtin_ctz(rest) : -1;
            if (nm >= 0) kv_fetch(kr, pb, C_KS + g * 64, C_VS + g * 64, nm * 64);
            const bool sel = (mysel >> m) & 1u;
            if (__builtin_amdgcn_ballot_w64(sel) != 0ull) {
                f32x16 sc0, sc1; qk_tile(KT, qf, qi, hl, sc0, sc1);
                if (m + 3 <= qb) mask_tile<false, false, false, true>(sc0, sc1, lut, qpos, m * 64, hl, sel, QS);
                else mask_tile<true, true, false, true>(sc0, sc1, lut, qpos, m * 64, hl, sel, QS);
                flash_update(st, sc0, sc1, VT, KTS, qi, hl);
            }
            __syncthreads();
            if (nm >= 0) kv_store(kr, KT, VT);
            __syncthreads();
            m = nm;
        }
        const float lt = st.l + shfl_xor_(st.l, 32, lane); const float sc = g1 / fmaxf(lt, 1e-30f);
#pragma unroll
        for (int i = 0; i < 16; ++i) { PARK[i * 64] += st.o0[i] * sc; PARK[(16 + i) * 64] += st.o1[i] * sc; }
    }
    {
        FlashState st;
#pragma unroll
        for (int i = 0; i < 16; ++i) { st.o0[i] = 0.f; st.o1[i] = 0.f; }
        st.m = -INFINITY; st.l = 0.f;
        KVRegs kr;
        int w = qb >= 4 ? 0 : 4 - qb;
        kv_fetch(kr, pb, C_KW + g * 64, C_VW + g * 64, qb * 64 - 256 + 64 * w); __syncthreads(); kv_store(kr, KT, VT); __syncthreads();
        for (; w < 5; ++w) {
            const int k0 = qb * 64 - 256 + 64 * w;
            if (w < 4) kv_fetch(kr, pb, C_KW + g * 64, C_VW + g * 64, k0 + 64);
            f32x16 sc0, sc1; qk_tile(KT, qf, qi, hl, sc0, sc1);
            if (w == 0) mask_tile<false, false, true, false>(sc0, sc1, lut, qpos, k0, hl, true, QS);
            else if (w == 1) mask_tile<false, false, false, false>(sc0, sc1, lut, qpos, k0, hl, true, QS);
            else if (w < 4) mask_tile<true, false, false, false>(sc0, sc1, lut, qpos, k0, hl, true, QS);
            else mask_tile<true, true, false, false>(sc0, sc1, lut, qpos, k0, hl, true, QS);
            flash_update(st, sc0, sc1, VT, KTS, qi, hl);
            __syncthreads();
            if (w < 4) kv_store(kr, KT, VT);
            __syncthreads();
        }
        const float lt = st.l + shfl_xor_(st.l, 32, lane); const float sc = g2 / fmaxf(lt, 1e-30f);
#pragma unroll
        for (int i = 0; i < 16; ++i) { fin0[i] = PARK[i * 64] + st.o0[i] * sc; fin1[i] = PARK[(16 + i) * 64] + st.o1[i] * sc; }
    }
#pragma unroll
    for (int i4 = 0; i4 < 4; ++i4) {
        u32x2 w0; w0.x = pack2(fin0[4 * i4], fin0[4 * i4 + 1]); w0.y = pack2(fin0[4 * i4 + 2], fin0[4 * i4 + 3]);
        u32x2 w1; w1.x = pack2(fin1[4 * i4], fin1[4 * i4 + 1]); w1.y = pack2(fin1[4 * i4 + 2], fin1[4 * i4 + 3]);
        *(u32x2*)(qrow + ocol + head * 64 + 8 * i4 + 4 * hl) = w0;
        *(u32x2*)(qrow + ocol + head * 64 + 32 + 8 * i4 + 4 * hl) = w1;
    }
}

constexpr int PH_PER_LAYER = 15, PH_TOTAL = DEPTH * PH_PER_LAYER + 1;
enum { S_PREP = 0, S_GU1, S_D1, S_NORM_MIX, S_WIN, S_CMP, S_LORA, S_SCAN, S_MERGE, S_OUT, S_NORM2, S_GU2, S_D2, S_NORM_PLE, S_PLEG, S_FINAL };

__device__ __forceinline__ void run_phase(unsigned char* smem, CP p, int ph) {
    const bool fin = (ph == DEPTH * PH_PER_LAYER);
    const int L = fin ? 0 : ph / PH_PER_LAYER; const int sub = fin ? S_FINAL : ph % PH_PER_LAYER;
    unsigned char* ws = p->ws; float* H = p->out;
    bf16_t* W = (bf16_t*)(ws + WS_WBF); bf16_t* UN = (bf16_t*)(ws + WS_UN); bf16_t* PROJ = (bf16_t*)(ws + WS_PROJ); bf16_t* ACT = (bf16_t*)(ws + WS_ACT);
    bf16_t* TMP = (bf16_t*)(ws + WS_TMP); bf16_t* PBF = (bf16_t*)(ws + WS_PB); bf16_t* ORW = (bf16_t*)(ws + WS_ORW);
    bf16_t* XK = (bf16_t*)(ws + WS_XK); bf16_t* XV = (bf16_t*)(ws + WS_XV); float* P01 = (float*)(ws + WS_P01);
    if (sub == S_PREP) convert_layer_weights(smem, p, L);
    if (sub == S_NORM_MIX) convert_ffn2_weights(smem, p, L);
    if (sub == S_NORM2) cvt_f32_bf16(p->in[I_P] + (size_t)L * T_TOK * 256, PBF, (size_t)T_TOK * 256 / 4);
    if (sub == S_CMP) lora_act(p, L);
    if (sub == S_LORA) finalize_cmp(smem, p, L);
    if (sub == S_NORM_PLE) { EpiBf16 e; e.O = TMP; run_gemm(smem, PBF, 256, W + E_PW, T_TOK, DM, 256, e); }
    if (sub == S_PREP || sub == S_NORM_MIX || sub == S_NORM2 || sub == S_NORM_PLE || sub == S_FINAL) {
        const float* hin = (sub == S_PREP && L == 0) ? p->in[I_X] : H; float* hcopy = (sub == S_PREP && L == 0) ? H : nullptr;
        const float* g = sub == S_PREP ? p->in[I_F1N] + L * DM : sub == S_NORM_MIX ? p->in[I_MIXN] + L * DM : sub == S_NORM2 ? p->in[I_F2N] + L * DM : sub == S_NORM_PLE ? p->in[I_PLEN] + L * DM : p->in[I_FINN];
        rmsnorm_rows(hin, hcopy, g, sub == S_FINAL ? nullptr : UN, sub == S_FINAL ? H : nullptr);
    } else if (sub == S_GU1 || sub == S_GU2) {
        EpiSwiglu e; e.O = ACT; run_gemm(smem, UN, DM, W + (sub == S_GU1 ? E_GU1 : E_GU2), T_TOK, 2 * DFF, DM, e);
    } else if (sub == S_D1 || sub == S_D2 || sub == S_OUT) {
        EpiResid e; e.H = H; e.scale = sub == S_OUT ? 1.0f : 0.5f;
        run_gemm(smem, sub == S_OUT ? UN : ACT, sub == S_OUT ? DM : DFF, W + (sub == S_D1 ? E_D1 : sub == S_D2 ? E_D2 : E_OUT), T_TOK, DM, sub == S_OUT ? DM : DFF, e);
    } else if (sub == S_WIN) {
        EpiProj e; e.O = PROJ; e.XK = XK; e.XV = XV; run_gemm(smem, UN, DM, W + E_IN, T_TOK, PLD, DM, e);
    } else if (sub == S_CMP) {
#pragma nounroll
        for (int kv = 0; kv < 2; ++kv) { EpiF32 e; e.C = P01 + (size_t)kv * 4096 * 256;
            run_gemm(smem, kv ? XV : XK, 1024, W + E_C1 + (size_t)kv * 256 * 1024, 4096, 256, 1024, e); }
    } else if (sub == S_LORA) {
        EpiLora e; e.EWA = UN; e.G = ORW;
        run_gemm(smem, (const bf16_t*)(ws + WS_LACT), 256, W + E_LORA, T_TOK, 1536, 256, e);
    } else if (sub == S_SCAN) {
        for (int item = bid_(); item < 256; item += gridDim.x) {
            __syncthreads();
            if (item < 128) rwkv_scan(smem, p, L, item >> 3, item & 7); else hgrn_scan(smem, p, L, (item - 128) >> 3, (item - 128) & 7);
        }
        unsigned* ctr = (unsigned*)(ws + 14336) + L * 64;
        volatile unsigned* slot = (volatile unsigned*)(smem + 141 * 1024);
        for (;;) {
            __syncthreads();
            if (tid_() == 0) *slot = __hip_atomic_fetch_add(ctr, 1u, __ATOMIC_RELAXED, __HIP_MEMORY_SCOPE_AGENT);
            __syncthreads();
            const unsigned idx = *slot;
            if (idx >= 1024u) break;
            const int bg = idx & 31, qb = 31 - (int)(idx >> 5);
            nsa_item(smem, p, L, bg >> 1, bg & 1, qb, C_NQ);
        }
    } else if (sub == S_MERGE) {
#pragma nounroll
        for (int j = 0; j < 3; ++j) { EpiMerge e; e.MRG = UN; e.PROJ = PROJ; e.J = j;
            const bf16_t* A = j == 0 ? PROJ + C_HQ : (j == 1 ? PROJ + C_NQ : ORW);
            run_gemm(smem, A, j == 2 ? 512 : PLD, W + E_BR + (size_t)j * 1024 * 512, T_TOK, DM, 512, e); }
    } else if (sub == S_PLEG) {
        EpiPleGate e; e.H = H; e.TMP = TMP; run_gemm(smem, UN, DM, W + E_PG, T_TOK, DM, DM, e);
    }
}

#define XB_TMO      128
#define XB_XCNT(j)  (256  + 64 * (j))
#define XB_XSUB(j)  (1280 + 64 * (j))
#define XB_XGEN(j)  (2304 + 64 * (j))
#define XB_TOP      3328
#define XB_TOPGEN   3392
#define XCD_BAR_WORDS 3456
#define XB_SPIN_CAP (1u << 20)
DI unsigned xb_ld(unsigned* p)              { return __hip_atomic_load(p, __ATOMIC_RELAXED, __HIP_MEMORY_SCOPE_AGENT); }
DI unsigned xb_add(unsigned* p, unsigned v) { return __hip_atomic_fetch_add(p, v, __ATOMIC_RELAXED, __HIP_MEMORY_SCOPE_AGENT); }
DI unsigned xb_xcc_id() { return (unsigned)__builtin_amdgcn_s_getreg((3 << 11) | 20) & 0xFu; }
#define XB_SPIN(cond, bar) do { unsigned _sp = 0; while (cond) { __builtin_amdgcn_s_sleep(1); \
    if ((++_sp & 255u) == 0u) { if (xb_ld(&(bar)[XB_TMO])) break; if (_sp > XB_SPIN_CAP) { atomicAdd(&(bar)[XB_TMO], 1u); break; } } } } while (0)
struct XcdBarrier { unsigned* bar; unsigned x; volatile LAS unsigned* st; };
DI XcdBarrier xcd_barrier_post(unsigned* bar, volatile LAS unsigned* st) {
    XcdBarrier b; b.bar = bar; b.x = xb_xcc_id(); b.st = st;
    if (threadIdx.x == 0) (void)xb_add(&bar[XB_XCNT(b.x)], 1u);
    return b;
}
DI void xcd_barrier_complete(unsigned* bar, unsigned x, unsigned& nloc, unsigned& nx) {
    const unsigned G = gridDim.x * gridDim.y * gridDim.z;
    unsigned sum, cnt, mine, sp = 0u;
    for (;;) {
        sum = 0u; cnt = 0u; mine = 0u;
#pragma unroll
        for (unsigned j = 0; j < 16; ++j) { const unsigned c = xb_ld(&bar[XB_XCNT(j)]); sum += c; cnt += (c > 0u) ? 1u : 0u; mine = (j == x) ? c : mine; }
        if (sum == G) break;
        __builtin_amdgcn_s_sleep(1);
        if ((++sp & 255u) == 0u) { if (xb_ld(&bar[XB_TMO])) break; if (sp > XB_SPIN_CAP) { atomicAdd(&bar[XB_TMO], 1u); break; } }
    }
    nloc = mine > 0u ? mine : 1u; nx = cnt > 0u ? cnt : 1u;
}
DI void xcd_barrier(const XcdBarrier& b) {
    asm volatile("s_waitcnt vmcnt(0)" ::: "memory");
    __syncthreads();
    if (threadIdx.x == 0) {
        unsigned* bar = b.bar;
        __builtin_amdgcn_s_waitcnt(0);
        unsigned nloc = b.st[0], nx = b.st[1];
        if (nloc == 0u) { xcd_barrier_complete(bar, b.x, nloc, nx); b.st[0] = nloc; b.st[1] = nx; }
        const unsigned old = xb_add(&bar[XB_XSUB(b.x)], 1u);
        const unsigned gen = old / nloc;
        if (old + 1u == (gen + 1u) * nloc) {
            __builtin_amdgcn_fence(__ATOMIC_RELEASE, "agent");
            asm volatile("s_waitcnt vmcnt(0)" ::: "memory");
            const unsigned og = xb_add(&bar[XB_TOP], 1u);
            const unsigned tg = og / nx;
            if (og + 1u == (tg + 1u) * nx) xb_add(&bar[XB_TOPGEN], 1u);
            else XB_SPIN(xb_ld(&bar[XB_TOPGEN]) == tg, bar);
            __builtin_amdgcn_fence(__ATOMIC_ACQUIRE, "agent");
            xb_add(&bar[XB_XGEN(b.x)], 1u);
            asm volatile("s_waitcnt vmcnt(0)" ::: "memory");
        } else {
            XB_SPIN(xb_ld(&bar[XB_XGEN(b.x)]) == gen, bar);
            __builtin_amdgcn_fence(__ATOMIC_ACQUIRE, "agent");
            asm volatile("s_waitcnt vmcnt(0)" ::: "memory");
        }
    }
    __syncthreads();
}

__global__ void __launch_bounds__(512, 2) mega_fwd(Params p) {
    extern __shared__ __attribute__((aligned(16))) unsigned char smem[];
    cg::grid_group grid = cg::this_grid();
    volatile LAS unsigned* xst = (volatile LAS unsigned*)(LAS unsigned char*)(smem + 140 * 1024);
    if (threadIdx.x == 0) { xst[0] = 0u; xst[1] = 0u; }
    __syncthreads();
    const XcdBarrier xb = xcd_barrier_post((unsigned*)(p.ws + WS_BAR), xst);
#ifndef PROBE_DUP
#define PROBE_DUP -1
#endif
    constexpr int IT_PER_LAYER = PH_PER_LAYER + (PROBE_DUP >= 0 ? 1 : 0);
    const int it_lo = p.ph_lo, it_hi = PROBE_DUP >= 0 ? DEPTH * IT_PER_LAYER + 1 : p.ph_hi;
    for (int it = it_lo; it < it_hi; ++it) {
        int ph = it;
        if (PROBE_DUP >= 0) { const int l_ = it / IT_PER_LAYER, r_ = it % IT_PER_LAYER; ph = l_ * PH_PER_LAYER + (r_ <= PROBE_DUP ? r_ : r_ - 1); }
        CP pp = (CP)__builtin_amdgcn_kernarg_segment_ptr(); asm volatile("" : "+s"(pp));
        run_phase(smem, pp, ph);
        if (it + 1 < it_hi) {
            if (it == it_lo) grid.sync();
            else xcd_barrier(xb);
        }
    }
}

#ifndef MULTI_LAUNCH
#define MULTI_LAUNCH 0
#endif

extern "C" void kernel_launch(void* const* d_in, const int* in_sizes, int n_in, void* d_out, int out_size, void* d_ws, size_t ws_size, hipStream_t stream) {
    static int grid = 0;
    if (grid == 0) {
        if (n_in != N_INPUTS || out_size != T_TOK * DM || ws_size < WS_END) { fprintf(stderr, "kernel_launch: unexpected shapes: n_in %d out %d ws %zu (need %zu)\n", n_in, out_size, ws_size, (size_t)WS_END); grid = -1; return; }
        int dev = 0, cus = 0, per_cu = 0;
        (void)hipGetDevice(&dev); (void)hipDeviceGetAttribute(&cus, hipDeviceAttributeMultiprocessorCount, dev);
        if (hipFuncSetAttribute((const void*)mega_fwd, hipFuncAttributeMaxDynamicSharedMemorySize, LDS_BYTES) != hipSuccess) { fprintf(stderr, "kernel_launch: hipFuncSetAttribute failed\n"); grid = -1; return; }
        if (hipOccupancyMaxActiveBlocksPerMultiprocessor(&per_cu, (const void*)mega_fwd, 512, LDS_BYTES) != hipSuccess || per_cu < 1) { fprintf(stderr, "kernel_launch: occupancy query gives %d\n", per_cu); per_cu = 1; }
        (void)hipGetLastError();
        grid = cus * 1;
        if (grid > 256) grid = 256;
        fprintf(stderr, "kernel_launch: grid %d (cus %d, per_cu %d)\n", grid, cus, per_cu);
    }
    if (grid < 0) return;
    (void)hipMemsetAsync(d_ws, 0, 16384, stream);
    Params p{};
    for (int i = 0; i < N_INPUTS; ++i) p.in[i] = (const float*)d_in[i];
    p.out = (float*)d_out; p.ws = (unsigned char*)d_ws;
#if MULTI_LAUNCH
    for (int ph = 0; ph < PH_TOTAL; ++ph) { p.ph_lo = ph; p.ph_hi = ph + 1; hipLaunchKernelGGL(mega_fwd, dim3(grid), dim3(512), LDS_BYTES, stream, p); }
#else
    p.ph_lo = 0; p.ph_hi = PH_TOTAL;
    void* args[] = {&p};
    hipError_t e = hipLaunchCooperativeKernel((const void*)mega_fwd, dim3(grid), dim3(512), args, LDS_BYTES, stream);
    if (e != hipSuccess) fprintf(stderr, "kernel_launch: cooperative launch failed: %s\n", hipGetErrorString(e));
#endif
}
```

```cpp
#include <hip/hip_runtime.h>
#include <hip/hip_cooperative_groups.h>
#include <cstdio>
namespace cg = cooperative_groups;

#define LAS __attribute__((address_space(3)))
#define DI __device__ __forceinline__
typedef unsigned short bf16_t;
typedef short bf16x8 __attribute__((ext_vector_type(8)));
typedef float f32x4 __attribute__((ext_vector_type(4)));
typedef float f32x2 __attribute__((ext_vector_type(2)));
typedef float f32x16 __attribute__((ext_vector_type(16)));
typedef unsigned u32x4 __attribute__((ext_vector_type(4)));
typedef unsigned u32x2 __attribute__((ext_vector_type(2)));

constexpr int T_TOK = 32768, SEQ = 2048, NB = 16, DM = 1024, DFF = 2816, DEPTH = 4;
constexpr int PLD = 8448;
constexpr int C_HQ = 0, C_HF = 512, C_HI = 1024, C_HG = 1536, C_NQ = 2048, C_KC = 2560, C_VC = 2688, C_KS = 2816, C_VS = 2944,
              C_KW = 3072, C_VW = 3200, C_NG = 3328, C_RW = 3352, C_MG = 5376, IN_REAL = 5144, IN_COLS = 8216;
enum { I_X = 0, I_P, I_F1N, I_F1GU, I_F1D, I_MIXN, I_WIN, I_HGLB, I_HGN, I_PE, I_CW1, I_CW2, I_RELB, I_MU, I_W0, I_WB, I_A0, I_AB, I_GB,
       I_KK, I_KA, I_RK, I_LNW, I_LNB, I_WBR, I_WOUT, I_F2N, I_F2GU, I_F2D, I_PLEN, I_PLEG, I_PLEW, I_FINN, N_INPUTS };

constexpr size_t WS_BAR = 0;
constexpr size_t WS_PEB = 16384;
constexpr size_t WS_WBF = 20480;
constexpr size_t E_GU1 = 0, E_D1 = E_GU1 + 5632ull * 1024, E_IN = E_D1 + 1024ull * 2816, E_BR = E_IN + 8448ull * 1024, E_OUT = E_BR + 3ull * 1024 * 512,
                 E_GU2 = E_GU1, E_D2 = E_D1  , E_PG = E_OUT + 1024ull * 1024, E_PW = E_PG + 1024ull * 1024,
                 E_C1 = E_PW + 1024ull * 256, E_LORA = E_C1 + 2ull * 256 * 1024, E_END = E_LORA + 1536ull * 256;
constexpr size_t WS_UN = WS_WBF + E_END * 2;
constexpr size_t WS_ORW = WS_UN + (size_t)T_TOK * 1024 * 2;
constexpr size_t WS_XK = WS_ORW + (size_t)T_TOK * 512 * 2;
constexpr size_t WS_XV = WS_XK + 4096ull * 1024 * 2;
constexpr size_t WS_P01 = WS_XV + 4096ull * 1024 * 2;
constexpr size_t WS_KC = WS_P01 + 2ull * 4096 * 256 * 4;
constexpr size_t WS_LACT = WS_KC + 2ull * 16 * 2 * 128 * 64 * 4;
constexpr size_t WS_PROJ = WS_LACT + (size_t)T_TOK * 256 * 2;
constexpr size_t WS_END = WS_PROJ + (size_t)T_TOK * PLD * 2;
constexpr size_t WS_ACT = WS_PROJ;
constexpr size_t WS_PB = WS_PROJ + 200ull * 1024 * 1024;
constexpr size_t WS_TMP = WS_PROJ + 256ull * 1024 * 1024;
constexpr int LDS_BYTES = 144 * 1024;

struct Params {
    const float* in[N_INPUTS];
    float* out;
    unsigned char* ws;
    int ph_lo, ph_hi;
};
typedef const Params __attribute__((address_space(4)))* CP;

DI int tid_() { int t = threadIdx.x; asm volatile("" : "+v"(t)); return t; }
DI int bid_() { int b = blockIdx.x; asm volatile("" : "+s"(b)); return b; }
typedef __bf16 bf16v2 __attribute__((ext_vector_type(2)));
DI float bf2f(bf16_t b) { return __uint_as_float(((unsigned)b) << 16); }
DI unsigned pack2(float lo, float hi) { const f32x2 v = {lo, hi}; return __builtin_bit_cast(unsigned, __builtin_convertvector(v, bf16v2)); }
DI bf16_t f2bf(float f) { return (bf16_t)(pack2(f, 0.f) & 0xFFFFu); }
DI float sigmoidf_(float x) { return __builtin_amdgcn_rcpf(1.0f + __builtin_amdgcn_exp2f(-1.4426950408889634f * x)); }
DI float siluf_(float x) { return x * __builtin_amdgcn_rcpf(1.0f + __builtin_amdgcn_exp2f(-1.4426950408889634f * x)); }
DI float shfl_xor_(float v, int mask, int lane) { return __int_as_float(__builtin_amdgcn_ds_bpermute((lane ^ mask) << 2, __float_as_int(v))); }
DI float dppf_(float v, int) { return v; }
#define DPPF(v, ctrl) __int_as_float(__builtin_amdgcn_mov_dpp(__float_as_int(v), ctrl, 0xF, 0xF, true))
DI float wave_sum(float v) {
    v += DPPF(v, 0xB1); v += DPPF(v, 0x4E); v += DPPF(v, 0x141); v += DPPF(v, 0x140);
    const float s0 = __int_as_float(__builtin_amdgcn_readlane(__float_as_int(v), 0)), s1 = __int_as_float(__builtin_amdgcn_readlane(__float_as_int(v), 16));
    const float s2 = __int_as_float(__builtin_amdgcn_readlane(__float_as_int(v), 32)), s3 = __int_as_float(__builtin_amdgcn_readlane(__float_as_int(v), 48));
    return (s0 + s1) + (s2 + s3);
}

#define MFMA32(a, b, c) __builtin_amdgcn_mfma_f32_32x32x16_bf16((a), (b), (c), 0, 0, 0)
namespace pg8 {
constexpr int BM = 256, BK = 64, HALF = 128, HTB = HALF * BK * 2, STAGE_BYTES = 8 * HTB, NXCD = 8, WGM = 8;
DI int lds_byte(int r, int c) { const int st = (r >> 4) * 2 + (c >> 5), rr = r & 15, cc = c & 31, ob = rr * 64 + cc * 2; return st * 1024 + (ob ^ (((ob >> 9) & 1) << 5)); }
DI void stage_rc(int b, int& R, int& C) { const int st = b / 1024, sb = b % 1024, swz = sb ^ (((sb >> 9) & 1) << 5); R = (st >> 1) * 16 + swz / 64; C = (st & 1) * 32 + (swz % 64) / 2; }
DI int perm32(int rho) { const int n = rho >> 4, i = rho & 15; return 8 * (i >> 2) + 4 * n + (i & 3); }
struct Unit { int pm, pn; };
struct Gemm { const bf16_t* A; const bf16_t* Bt; int M, N, K, lda; };
struct StaticOrder {
    int nM, nN, nwg, G, c;
    DI void init(int M, int N, int G_, int c_) { nM = M / BM; nN = N / BM; nwg = nM * nN; G = G_; c = c_; }
    DI bool next(int i, Unit& u) const {
        const long L = (long)i * G + c; if (L >= nwg) return false;
        int wgid = (int)L; { const int q = nwg / NXCD, r = nwg % NXCD, xcd = wgid % NXCD, off = wgid / NXCD; wgid = (xcd < r ? xcd * (q + 1) : r * (q + 1) + (xcd - r) * q) + off; }
        const int nig = WGM * nN, gid = wgid / nig, fm = gid * WGM, gsz = (nM - fm) < WGM ? (nM - fm) : WGM;
        u.pm = fm + ((wgid % nig) % gsz); u.pn = (wgid % nig) / gsz; return true;
    }
};

template <class Epi>
DI void gemm_phase(LAS unsigned char* lds, const Gemm g, const StaticOrder& S, const Epi& E) {
    int tid = tid_();
    const int wid = __builtin_amdgcn_readfirstlane(tid >> 6), lane = tid & 63, wr = wid >> 2, wc = wid & 3, fr = lane & 15, fq = lane >> 4;
    const int K = g.K, nt = K / BK, lda = g.lda;
    unsigned voffA[2], voffB[2];
#pragma unroll
    for (int i = 0; i < 2; ++i) { int R, C; stage_rc(tid * 16 + i * 8192, R, C); const int Rb = Epi::PERM ? ((R & ~31) + perm32(R & 31)) : R;
        voffA[i] = (unsigned)(R * lda + C) * 2u; voffB[i] = (unsigned)(Rb * K + C) * 2u; }
    const size_t kstep = (size_t)(BK * 2);
    const size_t hstepA = (size_t)HALF * lda * 2, hstepB = (size_t)HALF * K * 2;
    const size_t tstepA = 2 * hstepA, tstepB = 2 * hstepB;
    const unsigned ldsw = (unsigned)wid * 1024u;
    const int aoff = lds_byte(wr * 64 + fr, fq * 8), boff = lds_byte(wc * 32 + fr, fq * 8);
#define PG8_SA(b, h) (((b) * 2 + (h)) * HTB)
#define PG8_SB(b, h) ((4 + (b) * 2 + (h)) * HTB)
#define PG8_STAGE(bufoff, gbase, voff) do { _Pragma("unroll") for (int _i = 0; _i < 2; ++_i) \
        __builtin_amdgcn_global_load_lds((const unsigned*)((const char*)(gbase) + (voff)[_i]), (LAS unsigned*)(lds + (bufoff) + ldsw + _i * 8192), 16, 0, 0); } while (0)
#define PG8_LDA(dst, b, h) do { _Pragma("unroll") for (int m = 0; m < 4; ++m) _Pragma("unroll") for (int k = 0; k < 2; ++k) dst[m][k] = *(const LAS bf16x8*)(lds + PG8_SA(b, h) + aoff + m * 2048 + k * 1024); } while (0)
#define PG8_LDB(dst, b, h) do { _Pragma("unroll") for (int n = 0; n < 2; ++n) _Pragma("unroll") for (int k = 0; k < 2; ++k) dst[n][k] = *(const LAS bf16x8*)(lds + PG8_SB(b, h) + boff + n * 2048 + k * 1024); } while (0)
#define PG8_MMA(ai, bj, At, Bt) do { __builtin_amdgcn_s_setprio(1); _Pragma("unroll") for (int m = 0; m < 4; ++m) _Pragma("unroll") for (int n = 0; n < 2; ++n) _Pragma("unroll") for (int k = 0; k < 2; ++k) \
        acc[ai][bj][m][n] = __builtin_amdgcn_mfma_f32_16x16x32_bf16(Bt[n][k], At[m][k], acc[ai][bj][m][n], 0, 0, 0); __builtin_amdgcn_s_setprio(0); } while (0)
#define PG8_WAIT_V(n) asm volatile("s_waitcnt vmcnt(" #n ")" ::: "memory")
#define PG8_WAIT_L(n) asm volatile("s_waitcnt lgkmcnt(" #n ")" ::: "memory")
#define PG8_BAR __builtin_amdgcn_s_barrier()
#define PG8_SCHED __builtin_amdgcn_sched_barrier(0)
    Unit cur, nxt; int ui = 0;
    if (!S.next(0, cur)) return;
    f32x4 acc[2][2][4][2];
#pragma unroll
    for (int a = 0; a < 2; ++a)
#pragma unroll
        for (int b = 0; b < 2; ++b)
#pragma unroll
            for (int m = 0; m < 4; ++m)
#pragma unroll
                for (int n = 0; n < 2; ++n) acc[a][b][m][n] = (f32x4){0.f, 0.f, 0.f, 0.f};
    bf16x8 At[4][2], B0[2][2], B1[2][2];
    const char* cA = (const char*)g.A + (size_t)cur.pm * tstepA; const char* cB = (const char*)g.Bt + (size_t)cur.pn * tstepB;
    PG8_STAGE(PG8_SB(0, 0), cB, voffB); PG8_STAGE(PG8_SA(0, 0), cA, voffA); PG8_STAGE(PG8_SB(0, 1), cB + hstepB, voffB); PG8_STAGE(PG8_SA(0, 1), cA + hstepA, voffA);
    if (wr == 1) PG8_BAR;
    PG8_WAIT_V(4); PG8_BAR;
    PG8_STAGE(PG8_SB(1, 0), cB + kstep, voffB); PG8_STAGE(PG8_SA(1, 0), cA + kstep, voffA); PG8_STAGE(PG8_SB(1, 1), cB + hstepB + kstep, voffB);
    PG8_WAIT_V(6); PG8_BAR;
    for (;;) {
        const bool has_next = S.next(ui + 1, nxt);
        const char* nA = has_next ? (const char*)g.A + (size_t)nxt.pm * tstepA : cA; const char* nB = has_next ? (const char*)g.Bt + (size_t)nxt.pn * tstepB : cB;
        for (int t = 0; t < nt; t += 2) {
            const bool last = (t == nt - 2);
            const char* a1 = cA + (size_t)(t + 1) * kstep;
            const char* a2 = last ? nA : cA + (size_t)(t + 2) * kstep; const char* b2 = last ? nB : cB + (size_t)(t + 2) * kstep;
            const char* a3 = a2 + kstep; const char* b3 = b2 + kstep;
            PG8_LDB(B0, 0, 0); PG8_SCHED; PG8_LDA(At, 0, 0); PG8_STAGE(PG8_SA(1, 1), a1 + hstepA, voffA);
            PG8_WAIT_L(8); PG8_BAR; PG8_WAIT_L(0); PG8_MMA(0, 0, At, B0); PG8_BAR; PG8_SCHED;
            PG8_LDB(B1, 0, 1); PG8_STAGE(PG8_SB(0, 0), b2, voffB);
            PG8_BAR; PG8_WAIT_L(0); PG8_MMA(0, 1, At, B1); PG8_BAR;
            PG8_LDA(At, 0, 1); PG8_STAGE(PG8_SA(0, 0), a2, voffA);
            PG8_BAR; PG8_WAIT_L(0); PG8_MMA(1, 0, At, B0); PG8_BAR; PG8_SCHED;
            PG8_STAGE(PG8_SB(0, 1), b2 + hstepB, voffB);
            PG8_WAIT_V(6); PG8_BAR; PG8_MMA(1, 1, At, B1); PG8_BAR;
            PG8_LDB(B0, 1, 0); PG8_SCHED; PG8_LDA(At, 1, 0); PG8_STAGE(PG8_SA(0, 1), a2 + hstepA, voffA);
            PG8_WAIT_L(8); PG8_BAR; PG8_WAIT_L(0); PG8_MMA(0, 0, At, B0); PG8_BAR; PG8_SCHED;
            PG8_LDB(B1, 1, 1); PG8_STAGE(PG8_SB(1, 0), b3, voffB);
            PG8_BAR; PG8_WAIT_L(0); PG8_MMA(0, 1, At, B1); PG8_BAR;
            PG8_LDA(At, 1, 1); PG8_STAGE(PG8_SA(1, 0), a3, voffA);
            PG8_BAR; PG8_WAIT_L(0); PG8_MMA(1, 0, At, B0); PG8_BAR; PG8_SCHED;
            PG8_STAGE(PG8_SB(1, 1), b3 + hstepB, voffB);
            PG8_WAIT_V(6); PG8_BAR; PG8_MMA(1, 1, At, B1); PG8_BAR;
        }
        E(acc, cur, wr, wc, fr, fq);
        if (!has_next) break;
#pragma unroll
        for (int a = 0; a < 2; ++a)
#pragma unroll
            for (int b = 0; b < 2; ++b)
#pragma unroll
                for (int m = 0; m < 4; ++m)
#pragma unroll
                    for (int n = 0; n < 2; ++n) acc[a][b][m][n] = (f32x4){0.f, 0.f, 0.f, 0.f};
        cur = nxt; cA = nA; cB = nB; ++ui;
    }
    PG8_WAIT_V(0);
    if (wr == 0) PG8_BAR;
    PG8_BAR;
#undef PG8_SA
#undef PG8_SB
#undef PG8_STAGE
#undef PG8_LDA
#undef PG8_LDB
#undef PG8_MMA
#undef PG8_WAIT_V
#undef PG8_WAIT_L
#undef PG8_BAR
#undef PG8_SCHED
}
}

typedef f32x4 AccT[2][2][4][2];
#define EPI_LANE const int t_ = tid_(), wid_ = t_ >> 6, ln_ = t_ & 63, wr_ = wid_ >> 2, wc_ = wid_ & 3, fr_ = ln_ & 15, fq_ = ln_ >> 4;
#define EPI_LOOP_PERM(...) EPI_LANE \
    const int row0 = u.pm * 256 + wr_ * 64 + fr_, col0 = u.pn * 256 + wc_ * 32 + 8 * fq_; \
    _Pragma("unroll") for (int ai = 0; ai < 2; ++ai) _Pragma("unroll") for (int m = 0; m < 4; ++m) { const int row = row0 + ai * 128 + m * 16; \
        _Pragma("unroll") for (int bj = 0; bj < 2; ++bj) { const int col = col0 + bj * 128; const f32x4 v0 = acc[ai][bj][m][0], v1 = acc[ai][bj][m][1]; __VA_ARGS__ } }
#define EPI_LOOP_NAT(...) EPI_LANE \
    const int row0 = u.pm * 256 + wr_ * 64 + fr_, col0 = u.pn * 256 + wc_ * 32 + 4 * fq_; \
    _Pragma("unroll") for (int ai = 0; ai < 2; ++ai) _Pragma("unroll") for (int m = 0; m < 4; ++m) { const int row = row0 + ai * 128 + m * 16; \
        _Pragma("unroll") for (int bj = 0; bj < 2; ++bj) _Pragma("unroll") for (int n = 0; n < 2; ++n) { const int col = col0 + bj * 128 + n * 16; const f32x4 v = acc[ai][bj][m][n]; __VA_ARGS__ } }

struct EpiSwiglu { static constexpr bool PERM = true; bf16_t* O;
    DI void operator()(const AccT& acc, const pg8::Unit& u, int wr, int wc, int fr, int fq) const {
        EPI_LOOP_PERM({ u32x2 w; w.x = pack2(siluf_(v0[0]) * v1[0], siluf_(v0[1]) * v1[1]); w.y = pack2(siluf_(v0[2]) * v1[2], siluf_(v0[3]) * v1[3]);
            *(u32x2*)(O + (size_t)row * DFF + (col >> 1)) = w; })
    } };
struct EpiResid { static constexpr bool PERM = false; float* H; float scale;
    DI void operator()(const AccT& acc, const pg8::Unit& u, int wr, int wc, int fr, int fq) const {
        EPI_LOOP_NAT({ f32x4* p = (f32x4*)(H + (size_t)row * DM + col); *p = *p + v * scale; })
    } };
struct EpiProj { static constexpr bool PERM = true; bf16_t* O; bf16_t* XK; bf16_t* XV;
    DI void operator()(const AccT& acc, const pg8::Unit& u, int wr, int wc, int fr, int fq) const {
        const bool is_mg = u.pn * 256 >= C_MG, is_cmp = (u.pn == 10);
        EPI_LOOP_PERM({ f32x4 a = v0, b = v1;
            if (is_mg) { for (int j = 0; j < 4; ++j) { a[j] = sigmoidf_(a[j]); b[j] = sigmoidf_(b[j]); } }
            u32x4 w; w.x = pack2(a[0], a[1]); w.y = pack2(a[2], a[3]); w.z = pack2(b[0], b[1]); w.w = pack2(b[2], b[3]);
            *(u32x4*)(O + (size_t)row * PLD + col) = w;
            if (is_cmp) { const int c = col - C_KC, kv = c >> 7, gg = (c >> 6) & 1, d = c & 63, bb = row >> 11, s = row & 2047, jj = s >> 4, l = s & 15;
                bf16_t* X = kv ? XV : XK; *(u32x4*)(X + ((size_t)((bb * 128 + jj) * 2 + gg)) * 1024 + l * 64 + d) = w; } })
    } };
struct EpiMerge { static constexpr bool PERM = true; bf16_t* MRG; const bf16_t* PROJ; int J;
    DI void operator()(const AccT& acc, const pg8::Unit& u, int wr, int wc, int fr, int fq) const {
        EPI_LOOP_PERM({ const u32x4 gt = *(const u32x4*)(PROJ + (size_t)row * PLD + C_MG + J * 1024 + col);
            u32x4* mp = (u32x4*)(MRG + (size_t)row * DM + col); u32x4 old = (u32x4){0u, 0u, 0u, 0u}; if (J > 0) old = *mp;
            float r[8]; const float x[8] = {v0[0], v0[1], v0[2], v0[3], v1[0], v1[1], v1[2], v1[3]};
            _Pragma("unroll") for (int j = 0; j < 8; ++j) { const unsigned gw = gt[j >> 1], ow = old[j >> 1];
                const float gf = (j & 1) ? __uint_as_float(gw & 0xFFFF0000u) : __uint_as_float(gw << 16);
                const float of = (j & 1) ? __uint_as_float(ow & 0xFFFF0000u) : __uint_as_float(ow << 16);
                r[j] = of + gf * x[j]; }
            u32x4 w; w.x = pack2(r[0], r[1]); w.y = pack2(r[2], r[3]); w.z = pack2(r[4], r[5]); w.w = pack2(r[6], r[7]); *mp = w; })
    } };
struct EpiF32 { static constexpr bool PERM = false; float* C; static constexpr int ldc = 256;
    DI void operator()(const AccT& acc, const pg8::Unit& u, int wr, int wc, int fr, int fq) const {
        EPI_LOOP_NAT({ *(f32x4*)(C + (size_t)row * ldc + col) = v; })
    } };
struct EpiBf16 { static constexpr bool PERM = true; bf16_t* O; static constexpr int ldc = DM;
    DI void operator()(const AccT& acc, const pg8::Unit& u, int wr, int wc, int fr, int fq) const {
        EPI_LOOP_PERM({ u32x4 w; w.x = pack2(v0[0], v0[1]); w.y = pack2(v0[2], v0[3]); w.z = pack2(v1[0], v1[1]); w.w = pack2(v1[2], v1[3]);
            *(u32x4*)(O + (size_t)row * ldc + col) = w; })
    } };
struct EpiPleGate { static constexpr bool PERM = false; float* H; const bf16_t* TMP;
    DI void operator()(const AccT& acc, const pg8::Unit& u, int wr, int wc, int fr, int fq) const {
        EPI_LOOP_NAT({ const u32x2 tw = *(const u32x2*)(TMP + (size_t)row * DM + col); f32x4* p = (f32x4*)(H + (size_t)row * DM + col); f32x4 h = *p;
            h[0] += sigmoidf_(v[0]) * __uint_as_float(tw.x << 16); h[1] += sigmoidf_(v[1]) * __uint_as_float(tw.x & 0xFFFF0000u);
            h[2] += sigmoidf_(v[2]) * __uint_as_float(tw.y << 16); h[3] += sigmoidf_(v[3]) * __uint_as_float(tw.y & 0xFFFF0000u); *p = h; })
    } };

struct EpiLora { static constexpr bool PERM = true; bf16_t* EWA; bf16_t* G;
    DI void operator()(const AccT& acc, const pg8::Unit& u, int wr, int wc, int fr, int fq) const {
        const bool isg = u.pn >= 4; bf16_t* O = isg ? G - 1024 : EWA; const int ld = isg ? 512 : 1024;
        EPI_LOOP_PERM({ u32x4 w; w.x = pack2(v0[0], v0[1]); w.y = pack2(v0[2], v0[3]); w.z = pack2(v1[0], v1[1]); w.w = pack2(v1[2], v1[3]);
            *(u32x4*)(O + (size_t)row * ld + col) = w; })
    } };

template <class Epi> DI void run_gemm(unsigned char* smem, const bf16_t* A, int lda, const bf16_t* Bt, int M, int N, int K, const Epi& E) {
    __syncthreads();
    pg8::Gemm g; g.A = A; g.Bt = Bt; g.M = M; g.N = N; g.K = K; g.lda = lda;
    pg8::StaticOrder S; S.init(M, N, (int)gridDim.x, bid_());
    pg8::gemm_phase<Epi>((LAS unsigned char*)smem, g, S, E);
    __syncthreads();
}

struct MapId { DI int operator()(int n) const { return n; } };
struct MapGU { DI int operator()(int n) const { const int q = n >> 3, e = n & 7; return e < 4 ? 4 * q + e : DFF + 4 * q + (e - 4); } };
struct MapIn { DI int operator()(int n) const { return n < IN_REAL ? n : (n < C_MG ? -1 : n - (C_MG - IN_REAL)); } };
template <class Map> __device__ __forceinline__ void transpose_cvt(unsigned char* smem, const float* src, int ldsrc, bf16_t* dst, int K, int Nd, Map map) {
    float* tile = (float*)smem;
    const int tid = tid_(), ntk = K / 64, nt = ntk * (Nd / 64);
    for (int t = bid_(); t < nt; t += gridDim.x) {
        const int n0 = (t / ntk) * 64, k0 = (t % ntk) * 64;
        const int nn = tid & 63, sc = map(n0 + nn);
#pragma unroll
        for (int p = 0; p < 8; ++p) { const int kk = (tid >> 6) + p * 8; tile[kk * 65 + nn] = sc >= 0 ? src[(size_t)(k0 + kk) * ldsrc + sc] : 0.f; }
        __syncthreads();
#pragma unroll
        for (int p = 0; p < 4; ++p) { const int nn2 = (tid >> 5) + p * 16, kk2 = (tid & 31) * 2;
            *(unsigned*)(dst + (size_t)(n0 + nn2) * K + k0 + kk2) = pack2(tile[kk2 * 65 + nn2], tile[(kk2 + 1) * 65 + nn2]); }
        __syncthreads();
    }
}
__device__ __forceinline__ void convert_layer_weights(unsigned char* smem, CP p, int L) {
    bf16_t* W = (bf16_t*)(p->ws + WS_WBF);
    transpose_cvt(smem, p->in[I_F1GU] + (size_t)L * DM * 2 * DFF, 2 * DFF, W + E_GU1, DM, 2 * DFF, MapGU());
    transpose_cvt(smem, p->in[I_F1D] + (size_t)L * DFF * DM, DM, W + E_D1, DFF, DM, MapId());
    transpose_cvt(smem, p->in[I_WIN] + (size_t)L * DM * IN_COLS, IN_COLS, W + E_IN, DM, PLD, MapIn());
    for (int j = 0; j < 3; ++j) transpose_cvt(smem, p->in[I_WBR] + ((size_t)L * 3 + j) * 512 * DM, DM, W + E_BR + (size_t)j * 1024 * 512, 512, DM, MapId());
    transpose_cvt(smem, p->in[I_WOUT] + (size_t)L * DM * DM, DM, W + E_OUT, DM, DM, MapId());
    for (int i = bid_() * 512 + tid_(); i < 1536 * 256; i += gridDim.x * 512) { const int n = i >> 8, k = i & 255; float w = 0.f;
        if (n < 512) { if (k < 64) w = p->in[I_WB][((size_t)L * 64 + k) * 512 + n]; }
        else if (n < 1024) { if (k >= 64 && k < 128) w = p->in[I_AB][((size_t)L * 64 + (k - 64)) * 512 + (n - 512)]; }
        else { if (k >= 128) w = p->in[I_GB][((size_t)L * 128 + (k - 128)) * 512 + (n - 1024)]; }
        W[E_LORA + i] = f2bf(w); }
    transpose_cvt(smem, p->in[I_PLEG] + (size_t)L * DM * DM, DM, W + E_PG, DM, DM, MapId());
    transpose_cvt(smem, p->in[I_PLEW] + (size_t)L * 256 * DM, DM, W + E_PW, 256, DM, MapId());
    for (int kv = 0; kv < 2; ++kv) for (int hf = 0; hf < 2; ++hf)
        transpose_cvt(smem, p->in[I_CW1] + ((size_t)(L * 2 + kv) * 2048 + hf * 1024) * 128, 128, W + E_C1 + ((size_t)kv * 256 + hf * 128) * 1024, 1024, 128, MapId());
    if (bid_() == gridDim.x - 1 && tid_() < 256) {
        const int kv = tid_() >> 7, hc = tid_() & 127;
        const float* pe = p->in[I_PE] + (size_t)(L * 2 + kv) * 2048; const float* w1 = p->in[I_CW1] + (size_t)(L * 2 + kv) * 2048 * 128 + hc;
        float s = 0.f; for (int i = 0; i < 2048; ++i) s += pe[i] * w1[(size_t)i * 128];
        ((float*)(p->ws + WS_PEB))[kv * 128 + hc] = s;
    }
}

__device__ __forceinline__ void convert_ffn2_weights(unsigned char* smem, CP p, int L) {
    bf16_t* W = (bf16_t*)(p->ws + WS_WBF);
    transpose_cvt(smem, p->in[I_F2GU] + (size_t)L * DM * 2 * DFF, 2 * DFF, W + E_GU2, DM, 2 * DFF, MapGU());
    transpose_cvt(smem, p->in[I_F2D] + (size_t)L * DFF * DM, DM, W + E_D2, DFF, DM, MapId());
}
__device__ __forceinline__ void lora_act(CP p, int L) {
    const bf16_t* PROJ = (const bf16_t*)(p->ws + WS_PROJ); bf16_t* LACT = (bf16_t*)(p->ws + WS_LACT);
    const float* mu = p->in[I_MU] + (size_t)L * 1792 + 1536;
    for (int i = bid_() * 512 + tid_(); i < T_TOK * 32; i += gridDim.x * 512) {
        const int t = i >> 5, j0 = (i & 31) * 8; const bf16_t* row = PROJ + (size_t)t * PLD + C_RW + 1536 + j0;
        const u32x4 cur = *(const u32x4*)row; u32x4 prv = {0u, 0u, 0u, 0u}; if ((t & (SEQ - 1)) != 0) prv = *(const u32x4*)(row - PLD);
        float r[8];
#pragma unroll
        for (int e = 0; e < 8; ++e) { const float x1 = (e & 1) ? __uint_as_float(cur[e >> 1] & 0xFFFF0000u) : __uint_as_float(cur[e >> 1] << 16);
            const float xp = (e & 1) ? __uint_as_float(prv[e >> 1] & 0xFFFF0000u) : __uint_as_float(prv[e >> 1] << 16);
            float xm = x1 + (xp - x1) * mu[j0 + e];
            if (j0 < 64) xm = tanhf(xm); else if (j0 >= 128) xm = sigmoidf_(xm);
            r[e] = xm; }
        u32x4 w; w.x = pack2(r[0], r[1]); w.y = pack2(r[2], r[3]); w.z = pack2(r[4], r[5]); w.w = pack2(r[6], r[7]);
        *(u32x4*)(LACT + (size_t)t * 256 + j0) = w;
    }
}

__device__ __forceinline__ void rmsnorm_rows(const float* hin, float* hcopy, const float* g, bf16_t* un, float* outf) {
    const int lane = tid_() & 63, gw = bid_() * 8 + (tid_() >> 6), nw = gridDim.x * 8;
    f32x4 gv[4];
#pragma unroll
    for (int i = 0; i < 4; ++i) gv[i] = *(const f32x4*)(g + lane * 4 + i * 256);
    for (int row = gw; row < T_TOK; row += nw) {
        f32x4 x[4]; float ss = 0.f;
#pragma unroll
        for (int i = 0; i < 4; ++i) { x[i] = *(const f32x4*)(hin + (size_t)row * DM + lane * 4 + i * 256); ss += x[i][0] * x[i][0] + x[i][1] * x[i][1] + x[i][2] * x[i][2] + x[i][3] * x[i][3]; }
        ss = wave_sum(ss);
        const float rs = rsqrtf(ss * (1.0f / DM) + 1e-6f);
#pragma unroll
        for (int i = 0; i < 4; ++i) {
            const f32x4 y = x[i] * rs * gv[i];
            if (hcopy) *(f32x4*)(hcopy + (size_t)row * DM + lane * 4 + i * 256) = x[i];
            if (un) { u32x2 w; w.x = pack2(y[0], y[1]); w.y = pack2(y[2], y[3]); *(u32x2*)(un + (size_t)row * DM + lane * 4 + i * 256) = w; }
            if (outf) *(f32x4*)(outf + (size_t)row * DM + lane * 4 + i * 256) = y;
        }
    }
}
__device__ __forceinline__ void cvt_f32_bf16(const float* src, bf16_t* dst, size_t n4) {
    for (size_t i = (size_t)bid_() * 512 + tid_(); i < n4; i += (size_t)gridDim.x * 512) {
        const f32x4 v = *(const f32x4*)(src + i * 4); u32x2 w; w.x = pack2(v[0], v[1]); w.y = pack2(v[2], v[3]); *(u32x2*)(dst + i * 4) = w; }
}

__device__ __forceinline__ void finalize_cmp(unsigned char* smem, CP p, int L) {
    float* hid = (float*)smem + (tid_() >> 6) * 128;
    const int lane = tid_() & 63, gw = bid_() * 8 + (tid_() >> 6), nw = gridDim.x * 8;
    const float* peb = (const float*)(p->ws + WS_PEB);
    const int total = 2 * 16 * 2 * 128, iters = (total + nw - 1) / nw;
    for (int it = 0; it < iters; ++it) {
        const int id = gw + it * nw; const bool ok = id < total;
        const int n = id & 127, gg = (id >> 7) & 1, bb = (id >> 8) & 15, kv = (id >> 12) & 1;
        if (ok && n < 127) {
            const float* Pm = (const float*)(p->ws + WS_P01) + (size_t)kv * 4096 * 256;
            const size_t r0 = (size_t)((bb * 128 + n) * 2 + gg) * 256, r1 = (size_t)((bb * 128 + n + 1) * 2 + gg) * 256;
#pragma unroll
            for (int q = 0; q < 2; ++q) { const int hc = lane + q * 64; hid[hc] = siluf_(Pm[r0 + hc] + Pm[r1 + 128 + hc] + peb[kv * 128 + hc]); }
        }
        __syncthreads();
        if (ok) {
            float o = 0.f;
            if (n < 127) { const float* w2 = p->in[I_CW2] + (size_t)(L * 2 + kv) * 128 * 64 + lane;
                for (int hc = 0; hc < 128; ++hc) o += hid[hc] * w2[hc * 64]; }
            ((float*)(p->ws + WS_KC))[((((size_t)kv * 16 + bb) * 2 + gg) * 128 + n) * 64 + lane] = o;
        }
        __syncthreads();
    }
}

__device__ __forceinline__ void hgrn_scan(unsigned char* smem, CP p, int L, int b, int h) {
    float* F = (float*)smem; float* Kx = F + 2048; float* Q = Kx + 2048; float* V = Q + 2048; float* PO = V + 2048;
    const int tid = tid_(), e = tid & 63, wv = tid >> 6, C = h * 64 + e;
    float lb;
    { const float* hl = p->in[I_HGLB]; const float a0 = hl[C], a1 = hl[512 + C], a2 = hl[1024 + C], a3 = hl[1536 + C];
      const float mx = fmaxf(fmaxf(a0, a1), fmaxf(a2, a3)); const float e0 = __expf(a0 - mx), e1 = __expf(a1 - mx), e2 = __expf(a2 - mx), e3 = __expf(a3 - mx);
      const float inv = 1.0f / (e0 + e1 + e2 + e3); float acc = 0.f; if (L >= 1) acc += e1; if (L >= 2) acc += e2; if (L >= 3) acc += e3; lb = fmaxf(acc * inv, 0.f); }
    const float ng = p->in[I_HGN][L * 512 + C];
    bf16_t* base = (bf16_t*)(p->ws + WS_PROJ) + (size_t)b * SEQ * PLD + C;
    f32x2 S0 = {0.f, 0.f}, S1 = {0.f, 0.f}, S2 = {0.f, 0.f}, S3 = {0.f, 0.f};
    bf16_t pz[4], pq[4], pi[4], pg[4];
#define HG_PREFETCH(T0) do { _Pragma("unroll") for (int i = 0; i < 4; ++i) { const bf16_t* row = base + (size_t)((T0) + wv * 4 + i) * PLD; \
        pz[i] = row[C_HF]; pq[i] = row[C_HQ]; pi[i] = row[C_HI]; pg[i] = row[C_HG]; } } while (0)
    HG_PREFETCH(0);
    for (int t0 = 0; t0 < SEQ; t0 += 32) {
        float gr[4];
#pragma unroll
        for (int i = 0; i < 4; ++i) { const int t = wv * 4 + i;
            const float z = bf2f(pz[i]), qr = bf2f(pq[i]), vi = bf2f(pi[i]); gr[i] = bf2f(pg[i]);
            const float sg = sigmoidf_(z); F[t * 64 + e] = sg + lb * (1.0f - sg); Kx[t * 64 + e] = (1.0f - lb) * (1.0f - sg); Q[t * 64 + e] = siluf_(qr); V[t * 64 + e] = vi; }
        __syncthreads();
        if (t0 + 32 < SEQ) HG_PREFETCH(t0 + 32);
#pragma unroll 4
        for (int t = 0; t < 32; ++t) {
            const f32x4 f0 = *(const f32x4*)(F + t * 64 + wv * 8), f1 = *(const f32x4*)(F + t * 64 + wv * 8 + 4);
            const f32x4 k0 = *(const f32x4*)(Kx + t * 64 + wv * 8), k1 = *(const f32x4*)(Kx + t * 64 + wv * 8 + 4);
            const f32x4 q0 = *(const f32x4*)(Q + t * 64 + wv * 8), q1 = *(const f32x4*)(Q + t * 64 + wv * 8 + 4);
            const float v = V[t * 64 + e]; const f32x2 vv = {v, v};
            S0 = (f32x2){f0[0], f0[1]} * S0 + (f32x2){k0[0], k0[1]} * vv; S1 = (f32x2){f0[2], f0[3]} * S1 + (f32x2){k0[2], k0[3]} * vv;
            S2 = (f32x2){f1[0], f1[1]} * S2 + (f32x2){k1[0], k1[1]} * vv; S3 = (f32x2){f1[2], f1[3]} * S3 + (f32x2){k1[2], k1[3]} * vv;
            f32x2 o2 = (f32x2){q0[0], q0[1]} * S0 + (f32x2){q0[2], q0[3]} * S1 + (f32x2){q1[0], q1[1]} * S2 + (f32x2){q1[2], q1[3]} * S3;
            PO[(t * 8 + wv) * 64 + e] = o2[0] + o2[1];
        }
        __syncthreads();
#pragma unroll
        for (int i = 0; i < 4; ++i) { const int t = wv * 4 + i;
            float o = 0.f;
#pragma unroll
            for (int q = 0; q < 8; ++q) o += PO[(t * 8 + q) * 64 + e];
            const float ss = wave_sum(o * o); const float rs = rsqrtf(ss * (1.0f / 64.0f) + 1e-6f);
            base[(size_t)(t0 + t) * PLD + C_HQ] = f2bf(o * rs * ng * siluf_(gr[i])); }
        __syncthreads();
    }
#undef HG_PREFETCH
}

DI float dpp_xor1(float v) { return __int_as_float(__builtin_amdgcn_mov_dpp(__float_as_int(v), 0xB1, 0xF, 0xF, true)); }
DI float dpp_xor2(float v) { return __int_as_float(__builtin_amdgcn_mov_dpp(__float_as_int(v), 0x4E, 0xF, 0xF, true)); }
DI float dpp_hmir(float v) { return __int_as_float(__builtin_amdgcn_mov_dpp(__float_as_int(v), 0x141, 0xF, 0xF, true)); }
DI float red8(float v) { v += dpp_xor1(v); v += dpp_xor2(v); v += dpp_hmir(v); return v; }

__device__ __forceinline__ void rwkv_scan(unsigned char* smem, CP p, int L, int b, int h) {
    constexpr int BUF_F = 6 * 2048 + 64 + 2048;
    const int tid = tid_(), c = tid & 63, wv = tid >> 6, C = h * 64 + c, lane = c;
    const float* mu = p->in[I_MU] + (size_t)L * 1792;
    const float mu_r = mu[C], mu_k = mu[512 + C], mu_v = mu[1024 + C];
    const float w0 = p->in[I_W0][L * 512 + C], a0 = p->in[I_A0][L * 512 + C];
    const float k_k = p->in[I_KK][L * 512 + C], k_a = p->in[I_KA][L * 512 + C], r_k = p->in[I_RK][L * 512 + C], ln_w = p->in[I_LNW][L * 512 + C], ln_b = p->in[I_LNB][L * 512 + C];
    const bf16_t* base = (const bf16_t*)(p->ws + WS_PROJ) + (size_t)b * SEQ * PLD + C_RW + C;
    const bf16_t* ewa = (const bf16_t*)(p->ws + WS_UN) + (size_t)b * SEQ * 1024 + C;
    bf16_t* obase = (bf16_t*)(p->ws + WS_ORW) + (size_t)b * SEQ * 512 + C;
    const int kp = lane & 7, vr = lane >> 3, vrow = wv * 8 + vr;
    f32x2 S0 = {0.f, 0.f}, S1 = {0.f, 0.f}, S2 = {0.f, 0.f}, S3 = {0.f, 0.f};
    bf16_t pr[4], pk[4], pv[4], pe[4], pa[4], pg[4], qr, qk, qv;
#define RW_PREFETCH(T0) do { const int s0_ = (T0) + wv * 4; \
        _Pragma("unroll") for (int i = 0; i < 4; ++i) { const bf16_t* row = base + (size_t)(s0_ + i) * PLD; pr[i] = row[0]; pk[i] = row[512]; pv[i] = row[1024]; \
            pe[i] = ewa[(size_t)(s0_ + i) * 1024]; pa[i] = ewa[(size_t)(s0_ + i) * 1024 + 512]; pg[i] = obase[(size_t)(s0_ + i) * 512]; } \
        if (s0_ > 0) { const bf16_t* row = base + (size_t)(s0_ - 1) * PLD; qr = row[0]; qk = row[512]; qv = row[1024]; } else { qr = 0; qk = 0; qv = 0; } } while (0)
    RW_PREFETCH(0);
    __syncthreads();
    for (int blk = 0; blk < SEQ / 32; ++blk) {
        float* Bf = (float*)smem + (blk & 1) * BUF_F;
        float* Wd = Bf; float* NKK = Bf + 2048; float* AB = Bf + 4096; float* KX = Bf + 6144; float* WR = Bf + 8192; float* VS = Bf + 10240; float* SC = Bf + 12288; float* YS = Bf + 12352;
        float bon[4], gv[4];
        { float rp = bf2f(qr), kq = bf2f(qk), vp = bf2f(qv);
#pragma unroll
          for (int i = 0; i < 4; ++i) { const int t = wv * 4 + i;
              const float r1 = bf2f(pr[i]), k1 = bf2f(pk[i]), v1 = bf2f(pv[i]);
              const float r = r1 + (rp - r1) * mu_r, k = k1 + (kq - k1) * mu_k, v = v1 + (vp - v1) * mu_v; rp = r1; kq = k1; vp = v1;
              const float decay = __expf(-0.6065306597f * sigmoidf_(w0 + bf2f(pe[i]))), a = sigmoidf_(a0 + bf2f(pa[i])); gv[i] = bf2f(pg[i]);
              const float kkv = k * k_k; const float ssq = wave_sum(kkv * kkv); const float kkn = kkv / fmaxf(sqrtf(ssq), 1e-12f);
              const float kx = k * (1.0f + (a - 1.0f) * k_a), ab = kkn * a;
              const float br = wave_sum(ab * r), kr = wave_sum(kx * r); bon[i] = wave_sum(r * kx * r_k);
              Wd[t * 64 + c] = decay; NKK[t * 64 + c] = -kkn; AB[t * 64 + c] = ab; KX[t * 64 + c] = kx; WR[t * 64 + c] = decay * r; VS[t * 64 + c] = v;
              if (c == 0) { SC[t * 2] = br; SC[t * 2 + 1] = kr; } } }
        __syncthreads();
        if (blk + 1 < SEQ / 32) RW_PREFETCH((blk + 1) * 32);
#define RW_LOAD(T, w0v, w1v, n0, n1, b0, b1, x0, x1, q0, q1, vv, sc) do { const int o_ = (T) * 64 + kp * 8; \
            w0v = *(const f32x4*)(Wd + o_); w1v = *(const f32x4*)(Wd + o_ + 4); n0 = *(const f32x4*)(NKK + o_); n1 = *(const f32x4*)(NKK + o_ + 4); \
            b0 = *(const f32x4*)(AB + o_); b1 = *(const f32x4*)(AB + o_ + 4); x0 = *(const f32x4*)(KX + o_); x1 = *(const f32x4*)(KX + o_ + 4); \
            q0 = *(const f32x4*)(WR + o_); q1 = *(const f32x4*)(WR + o_ + 4); vv = VS[(T) * 64 + vrow]; sc = *(const f32x2*)(SC + (T) * 2); } while (0)
        f32x4 cw0, cw1, cn0, cn1, cb0, cb1, cx0, cx1, cq0, cq1; float cvv; f32x2 csc;
        RW_LOAD(0, cw0, cw1, cn0, cn1, cb0, cb1, cx0, cx1, cq0, cq1, cvv, csc);
#pragma nounroll
        for (int t8 = 0; t8 < 4; ++t8) {
            float ykeep = 0.f;
#pragma unroll
            for (int j = 0; j < 8; ++j) {
                const int t = t8 * 8 + j;
                const f32x4 w0v = cw0, w1v = cw1, n0 = cn0, n1 = cn1, b0 = cb0, b1 = cb1, x0 = cx0, x1 = cx1, q0 = cq0, q1 = cq1; const float vv = cvv; const f32x2 sc = csc;
                { const int tn = (t + 1) & 31; RW_LOAD(tn, cw0, cw1, cn0, cn1, cb0, cb1, cx0, cx1, cq0, cq1, cvv, csc); }
                const f32x2 sa2 = S0 * (f32x2){n0[0], n0[1]} + S1 * (f32x2){n0[2], n0[3]} + S2 * (f32x2){n1[0], n1[1]} + S3 * (f32x2){n1[2], n1[3]};
                const f32x2 y2 = S0 * (f32x2){q0[0], q0[1]} + S1 * (f32x2){q0[2], q0[3]} + S2 * (f32x2){q1[0], q1[1]} + S3 * (f32x2){q1[2], q1[3]};
                float sa = sa2[0] + sa2[1], yy = y2[0] + y2[1];
                sa += dpp_xor1(sa); yy += dpp_xor1(yy); sa += dpp_xor2(sa); yy += dpp_xor2(yy); sa += dpp_hmir(sa); yy += dpp_hmir(yy);
                const f32x2 sav = {sa, sa}, vv2 = {vv, vv};
                S0 = S0 * (f32x2){w0v[0], w0v[1]} + sav * (f32x2){b0[0], b0[1]} + vv2 * (f32x2){x0[0], x0[1]};
                S1 = S1 * (f32x2){w0v[2], w0v[3]} + sav * (f32x2){b0[2], b0[3]} + vv2 * (f32x2){x0[2], x0[3]};
                S2 = S2 * (f32x2){w1v[0], w1v[1]} + sav * (f32x2){b1[0], b1[1]} + vv2 * (f32x2){x1[0], x1[1]};
                S3 = S3 * (f32x2){w1v[2], w1v[3]} + sav * (f32x2){b1[2], b1[3]} + vv2 * (f32x2){x1[2], x1[3]};
                const float y = yy + sa * sc[0] + vv * sc[1];
                ykeep = (kp == j) ? y : ykeep;
            }
            YS[(t8 * 8 + kp) * 64 + vrow] = ykeep;
        }
#undef RW_LOAD
        __syncthreads();
#pragma unroll
        for (int i = 0; i < 4; ++i) { const int t = wv * 4 + i;
            const float y = YS[t * 64 + c]; const float mean = wave_sum(y) * (1.0f / 64.0f); const float dlt = y - mean;
            const float var = wave_sum(dlt * dlt) * (1.0f / 64.0f);
            float yn = dlt * rsqrtf(var + 64e-5f) * ln_w + ln_b; yn += bon[i] * VS[t * 64 + c];
            obase[(size_t)(blk * 32 + t) * 512] = f2bf(yn * gv[i]); }
    }
#undef RW_PREFETCH
    __syncthreads();
}

DI int crow16(int i, int hl) { return (i & 3) + 8 * (i >> 2) + 4 * hl; }
__device__ __forceinline__ void rwkv_chunked(unsigned char* smem, CP p, int L, int b, int h) {
    bf16_t* ZB = (bf16_t*)smem;
    bf16_t* AR = (bf16_t*)(smem + 9216);
    bf16_t* BKt = (bf16_t*)(smem + 13824);
    bf16_t* UV = (bf16_t*)(smem + 18944);
    bf16_t* MT1 = (bf16_t*)(smem + 24064);
    bf16_t* MT2 = (bf16_t*)(smem + 25600);
    float* EW = (float*)(smem + 27136);
    bf16_t* BKr = (bf16_t*)(smem + 31232);
    float* Mf = (float*)(smem + 48640);
    float* Gs = (float*)(smem + 52864);
    float* YS = (float*)(smem + 57216);
    float* VS = (float*)(smem + 61312);
    float* PC = (float*)(smem + 65408);
    const int tid = tid_(), c = tid & 63, wv = tid >> 6, C = h * 64 + c, lane = c, qi = lane & 31, hl = lane >> 5;
    const float* mu = p->in[I_MU] + (size_t)L * 1792;
    const float mu_r = mu[C], mu_k = mu[512 + C], mu_v = mu[1024 + C];
    const float w0 = p->in[I_W0][L * 512 + C], a0 = p->in[I_A0][L * 512 + C];
    const float k_k = p->in[I_KK][L * 512 + C], k_a = p->in[I_KA][L * 512 + C], r_k = p->in[I_RK][L * 512 + C], ln_w = p->in[I_LNW][L * 512 + C], ln_b = p->in[I_LNB][L * 512 + C];
    const bf16_t* base = (const bf16_t*)(p->ws + WS_PROJ) + (size_t)b * SEQ * PLD + C_RW + C;
    const bf16_t* ewa = (const bf16_t*)(p->ws + WS_UN) + (size_t)b * SEQ * 1024 + C;
    bf16_t* obase = (bf16_t*)(p->ws + WS_ORW) + (size_t)b * SEQ * 512 + C;
    f32x16 zacc;
#pragma unroll
    for (int i = 0; i < 16; ++i) zacc[i] = 0.f;
    for (int i = tid; i < 64 * 72; i += 512) ZB[i] = 0;
    bf16_t pr[2], pk[2], pv[2], pe[2], pa[2], pg[2], qr, qk, qv;
#define RC_PREFETCH(T0) do { const int s0_ = (T0) + wv * 2; \
        _Pragma("unroll") for (int i = 0; i < 2; ++i) { const bf16_t* row = base + (size_t)(s0_ + i) * PLD; pr[i] = row[0]; pk[i] = row[512]; pv[i] = row[1024]; \
            pe[i] = ewa[(size_t)(s0_ + i) * 1024]; pa[i] = ewa[(size_t)(s0_ + i) * 1024 + 512]; pg[i] = obase[(size_t)(s0_ + i) * 512]; } \
        if (s0_ > 0) { const bf16_t* row = base + (size_t)(s0_ - 1) * PLD; qr = row[0]; qk = row[512]; qv = row[1024]; } else { qr = 0; qk = 0; qv = 0; } } while (0)
    RC_PREFETCH(0);
    __syncthreads();
    for (int ch = 0; ch < SEQ / 16; ++ch) {
        float bon[2], gv[2], r_[2], nk_[2], ab_[2], kx_[2], v_[2], ew_[2];
        { float rp = bf2f(qr), kq = bf2f(qk), vp = bf2f(qv);
#pragma unroll
          for (int i = 0; i < 2; ++i) { const int t = wv * 2 + i;
              const float r1 = bf2f(pr[i]), k1 = bf2f(pk[i]), v1 = bf2f(pv[i]);
              const float r = r1 + (rp - r1) * mu_r, k = k1 + (kq - k1) * mu_k, v = v1 + (vp - v1) * mu_v; rp = r1; kq = k1; vp = v1;
              const float ew = 0.6065306597f * sigmoidf_(w0 + bf2f(pe[i])), a = sigmoidf_(a0 + bf2f(pa[i])); gv[i] = bf2f(pg[i]);
              const float kkv = k * k_k; const float ssq = wave_sum(kkv * kkv); const float kkn = kkv / fmaxf(sqrtf(ssq), 1e-12f);
              const float kx = k * (1.0f + (a - 1.0f) * k_a);
              bon[i] = wave_sum(r * kx * r_k);
              r_[i] = r; nk_[i] = kkn; ab_[i] = kkn * a; kx_[i] = kx; v_[i] = v; ew_[i] = ew; EW[t * 64 + c] = ew; } }
        __syncthreads();
        if (ch + 1 < SEQ / 16) RC_PREFETCH((ch + 1) * 16);
        { float ev[16];
#pragma unroll
          for (int j = 0; j < 16; ++j) ev[j] = EW[j * 64 + c];
#pragma unroll
          for (int i = 0; i < 2; ++i) { const int t = wv * 2 + i; float cum = 0.f;
#pragma unroll
            for (int j = 0; j < 16; ++j) cum += (j <= t) ? ev[j] : 0.f;
            const float Pt = __expf(-cum), Pm = __expf(-(cum - ew_[i])), iP = __expf(cum);
            const float al = -nk_[i] * Pm, rh = r_[i] * Pt, be = ab_[i] * iP, ka = kx_[i] * iP;
            AR[t * 72 + c] = f2bf(al); AR[(16 + t) * 72 + c] = f2bf(rh); BKr[t * 72 + c] = f2bf(be); BKr[(16 + t) * 72 + c] = f2bf(ka);
            BKt[c * 40 + t] = f2bf(be); BKt[c * 40 + 16 + t] = f2bf(ka);
            UV[c * 40 + 16 + t] = f2bf(v_[i]); VS[t * 64 + c] = v_[i];
            if (t == 15) PC[c] = Pt; } }
        __syncthreads();
        f32x16 acc;
#pragma unroll
        for (int i = 0; i < 16; ++i) acc[i] = 0.f;
        if (wv == 0) {
#pragma unroll
            for (int s = 0; s < 4; ++s) acc = MFMA32(*(const bf16x8*)(BKr + qi * 72 + 16 * s + 8 * hl), *(const bf16x8*)(AR + qi * 72 + 16 * s + 8 * hl), acc);
#pragma unroll
            for (int i = 0; i < 16; ++i) { const int j = crow16(i, hl), n = qi; const float m = acc[i];
                if (j < 16) { if (n < 16) Mf[j * 17 + n] = m; MT2[n * 24 + j] = f2bf((n >= 16 && j <= n - 16) ? m : 0.f); }
                else { const int i2 = j - 16; const bool k1 = n < 16 ? (i2 < n) : (i2 <= n - 16); MT1[n * 24 + i2] = f2bf(k1 ? m : 0.f); } }
        } else if (wv < 3) {
            const int vb = wv - 1;
#pragma unroll
            for (int s = 0; s < 4; ++s) acc = MFMA32(*(const bf16x8*)(ZB + (32 * vb + qi) * 72 + 16 * s + 8 * hl), *(const bf16x8*)(AR + qi * 72 + 16 * s + 8 * hl), acc);
        }
        __syncthreads();
        if (wv == 1 || wv == 2) { const int vb = wv - 1;
            acc = MFMA32(*(const bf16x8*)(UV + (32 * vb + qi) * 40 + 16 + 8 * hl), *(const bf16x8*)(MT1 + qi * 24 + 8 * hl), acc);
            if (qi < 16) {
#pragma unroll
                for (int i = 0; i < 16; ++i) Gs[(32 * vb + crow16(i, hl)) * 17 + qi] = acc[i]; }
        }
        __syncthreads();
        if (wv == 0) {
            float u[16];
#pragma unroll
            for (int t = 0; t < 16; ++t) { float x0 = Gs[lane * 17 + t], x1 = 0.f;
#pragma unroll
                for (int i = 0; i < t; ++i) { if (i & 1) x1 += u[i] * Mf[i * 17 + t]; else x0 += u[i] * Mf[i * 17 + t]; }
                u[t] = x0 + x1; UV[lane * 40 + t] = f2bf(u[t]); }
        }
        __syncthreads();
        if (wv == 1 || wv == 2) { const int vb = wv - 1;
            acc = MFMA32(*(const bf16x8*)(UV + (32 * vb + qi) * 40 + 8 * hl), *(const bf16x8*)(MT2 + qi * 24 + 8 * hl), acc);
            if (qi >= 16) {
#pragma unroll
                for (int i = 0; i < 16; ++i) YS[(qi - 16) * 64 + 32 * vb + crow16(i, hl)] = acc[i]; }
        }
        if (wv >= 4) { const int vb = (wv >> 1) & 1, kb = wv & 1;
#pragma unroll
            for (int s = 0; s < 2; ++s) zacc = MFMA32(*(const bf16x8*)(UV + (32 * vb + qi) * 40 + 16 * s + 8 * hl), *(const bf16x8*)(BKt + (32 * kb + qi) * 40 + 16 * s + 8 * hl), zacc);
            const float pc = PC[32 * kb + qi];
#pragma unroll
            for (int i = 0; i < 16; ++i) { zacc[i] *= pc; ZB[(32 * vb + crow16(i, hl)) * 72 + 32 * kb + qi] = f2bf(zacc[i]); }
        }
        __syncthreads();
#pragma unroll
        for (int i = 0; i < 2; ++i) { const int t = wv * 2 + i;
            const float y = YS[t * 64 + c]; const float mean = wave_sum(y) * (1.0f / 64.0f); const float dlt = y - mean;
            const float var = wave_sum(dlt * dlt) * (1.0f / 64.0f);
            float yn = dlt * rsqrtf(var + 64e-5f) * ln_w + ln_b; yn += bon[i] * VS[t * 64 + c];
            obase[(size_t)(ch * 16 + t) * 512] = f2bf(yn * gv[i]); }
        __syncthreads();
    }
#undef RC_PREFETCH
}

constexpr int KTS = 72;
DI bf16x8 pack8(float a0, float a1, float a2, float a3, float a4, float a5, float a6, float a7) {
    u32x4 w; w.x = pack2(a0, a1); w.y = pack2(a2, a3); w.z = pack2(a4, a5); w.w = pack2(a6, a7); return __builtin_bit_cast(bf16x8, w); }
DI bf16x8 ld_vfrag(const bf16_t* vt, int off) { const u32x2 lo = *(const u32x2*)(vt + off), hi = *(const u32x2*)(vt + off + 8); u32x4 w; w.x = lo.x; w.y = lo.y; w.z = hi.x; w.w = hi.y; return __builtin_bit_cast(bf16x8, w); }

struct FlashState { f32x16 o0, o1; float m, l; };

DI void flash_update(FlashState& st, f32x16& sc0, f32x16& sc1, const bf16_t* VT, int vs, int qi, int hl) {
    float mt = -INFINITY;
#pragma unroll
    for (int i = 0; i < 16; ++i) mt = fmaxf(mt, fmaxf(sc0[i], sc1[i]));
    mt = fmaxf(mt, shfl_xor_(mt, 32, qi + 32 * hl));
    const float mnew = fmaxf(st.m, mt), muse = (mnew == -INFINITY) ? 0.f : mnew;
    const float alpha = __builtin_amdgcn_exp2f(st.m - muse);
    float ls = 0.f;
#pragma unroll
    for (int i = 0; i < 16; ++i) { sc0[i] = __builtin_amdgcn_exp2f(sc0[i] - muse); sc1[i] = __builtin_amdgcn_exp2f(sc1[i] - muse); ls += sc0[i] + sc1[i]; }
    st.l = st.l * alpha + ls; st.m = mnew;
    st.o0 *= alpha; st.o1 *= alpha;
#pragma unroll
    for (int s = 0; s < 2; ++s) {
        const bf16x8 p0 = pack8(sc0[8 * s], sc0[8 * s + 1], sc0[8 * s + 2], sc0[8 * s + 3], sc0[8 * s + 4], sc0[8 * s + 5], sc0[8 * s + 6], sc0[8 * s + 7]);
        const bf16x8 p1 = pack8(sc1[8 * s], sc1[8 * s + 1], sc1[8 * s + 2], sc1[8 * s + 3], sc1[8 * s + 4], sc1[8 * s + 5], sc1[8 * s + 6], sc1[8 * s + 7]);
        st.o0 = MFMA32(ld_vfrag(VT, qi * vs + 16 * s + 4 * hl), p0, st.o0);
        st.o1 = MFMA32(ld_vfrag(VT, (32 + qi) * vs + 16 * s + 4 * hl), p0, st.o1);
        st.o0 = MFMA32(ld_vfrag(VT, qi * vs + 32 + 16 * s + 4 * hl), p1, st.o0);
        st.o1 = MFMA32(ld_vfrag(VT, (32 + qi) * vs + 32 + 16 * s + 4 * hl), p1, st.o1);
    }
}
DI void qk_tile(const bf16_t* KT, const bf16x8 (&qf)[4], int qi, int hl, f32x16& sc0, f32x16& sc1) {
#pragma unroll
    for (int i = 0; i < 16; ++i) { sc0[i] = 0.f; sc1[i] = 0.f; }
#pragma unroll
    for (int s = 0; s < 4; ++s) {
        const bf16x8 k0 = *(const bf16x8*)(KT + qi * KTS + 16 * s + 8 * hl), k1 = *(const bf16x8*)(KT + (32 + qi) * KTS + 16 * s + 8 * hl);
        sc0 = MFMA32(k0, qf[s], sc0); sc1 = MFMA32(k1, qf[s], sc1);
    }
}
struct KVRegs { u32x4 k, v; };
DI void kv_fetch(KVRegs& r, const bf16_t* pb, int kcol, int vcol, int k0) {
    const int tid = tid_();
    const unsigned ok_ = (unsigned)((k0 + (tid >> 3)) * PLD + kcol + (tid & 7) * 8) * 2u, ov_ = (unsigned)((k0 + (tid & 63)) * PLD + vcol + (tid >> 6) * 8) * 2u;
    r.k = *(const u32x4*)((const char*)pb + ok_);
    r.v = *(const u32x4*)((const char*)pb + ov_);
}
DI void kv_store(const KVRegs& r, bf16_t* KT, bf16_t* VT) {
    const int tid = tid_();
    *(u32x4*)(KT + (tid >> 3) * KTS + (tid & 7) * 8) = r.k;
    const int key = tid & 63, ch = tid >> 6;
#pragma unroll
    for (int j = 0; j < 8; ++j) VT[(ch * 8 + j) * KTS + key] = (bf16_t)((j & 1) ? (r.v[j >> 1] >> 16) : (r.v[j >> 1] & 0xFFFFu));
}
template <bool LUTB, bool CAUSAL, bool WHI, bool SEL>
DI void mask_tile(f32x16& sc0, f32x16& sc1, const float* lut, int qpos, int k0, int hl, bool sel, float qs) {
    const float bfar = lut[128];
#pragma unroll
    for (int i = 0; i < 16; ++i) { const int kl = (i & 3) + 8 * (i >> 2) + 4 * hl;
        { const int dist = qpos - (k0 + kl); const float v = sc0[i] * qs + (LUTB ? lut[dist > 128 ? 128 : (dist < 0 ? 0 : dist)] : bfar);
          bool ok = true; if (CAUSAL) ok = ok && dist >= 0; if (WHI) ok = ok && dist < 256; if (SEL) ok = ok && sel; sc0[i] = ok ? v : -INFINITY; }
        { const int dist = qpos - (k0 + 32 + kl); const float v = sc1[i] * qs + (LUTB ? lut[dist > 128 ? 128 : (dist < 0 ? 0 : dist)] : bfar);
          bool ok = true; if (CAUSAL) ok = ok && dist >= 0; if (WHI) ok = ok && dist < 256; if (SEL) ok = ok && sel; sc1[i] = ok ? v : -INFINITY; } }
}

__device__ __forceinline__ void nsa_item(unsigned char* smem, CP p, int L, int b, int g, int qb, int ocol) {
    bf16_t* KT = (bf16_t*)smem;
    bf16_t* VT = (bf16_t*)(smem + 9216);
    float* LUT = (float*)(smem + 18432);
    unsigned* SELM = (unsigned*)(smem + 20736);
    unsigned* ORM = (unsigned*)(smem + 20992);
    float* PA = (float*)(smem + 21504);
    float* PBv = (float*)(smem + 54272);
    bf16_t* KT2 = (bf16_t*)(smem + 87040);
    bf16_t* VT2 = (bf16_t*)(smem + 105472);
    const int tid = tid_(), lane = tid & 63, wv = tid >> 6, hh = wv >> 1, qhalf = wv & 1, qi = lane & 31, hl = lane >> 5;
    const int ql = qhalf * 32 + qi, qpos = qb * 64 + ql, head = g * 4 + hh;
    bf16_t* pb = (bf16_t*)(p->ws + WS_PROJ) + (size_t)b * SEQ * PLD;
    bf16_t* qrow = pb + (size_t)qpos * PLD;
    __syncthreads();
    for (int i = tid; i < 4 * 129; i += 512) { const int h2 = i / 129, dd = i % 129; int bk;
        if (dd < 16) bk = dd; else if (dd >= 128) bk = 31; else { bk = 16 + (int)(logf((float)dd / 16.0f) / 2.0794415416798357f * 16.0f); bk = bk > 31 ? 31 : bk; }
        LUT[h2 * 132 + dd] = p->in[I_RELB][bk * 8 + g * 4 + h2] * 1.4426950408889634f; }
    if (tid == 0) *ORM = 0u;
    if (tid < 64) SELM[tid] = 0u;
    if (tid < 256) PBv[tid * 32] = 0.f;
    { const float* kc = (const float*)(p->ws + WS_KC) + ((size_t)(0 * 16 + b) * 2 + g) * 128 * 64; const float* vc = (const float*)(p->ws + WS_KC) + ((size_t)(1 * 16 + b) * 2 + g) * 128 * 64;
      for (int i = tid; i < 128 * 64; i += 512) { const int n = i >> 6, d = i & 63; KT2[n * KTS + d] = f2bf(kc[i]); }
      for (int i = tid; i < 128 * 64; i += 512) { const int n = i & 127, d = i >> 7; VT2[d * 136 + n] = f2bf(vc[n * 64 + d]); } }
    bf16x8 qf[4];
#pragma unroll
    for (int s = 0; s < 4; ++s) qf[s] = *(const bf16x8*)(qrow + C_NQ + head * 64 + 16 * s + 8 * hl);
    float g0, g1, g2;
    { const bf16_t* gp = qrow + C_NG + head * 3; g0 = sigmoidf_(bf2f(gp[0])); g1 = sigmoidf_(bf2f(gp[1])); g2 = sigmoidf_(bf2f(gp[2])); }
    __syncthreads();
    const float* lut = LUT + hh * 132;
    constexpr float QS = 0.125f * 1.4426950408889634f;
    f32x16 fin0, fin1;
    {
        FlashState st;
#pragma unroll
        for (int i = 0; i < 16; ++i) { st.o0[i] = 0.f; st.o1[i] = 0.f; }
        st.m = -INFINITY; st.l = 0.f;
#pragma nounroll
        for (int t = 0; t < 2; ++t) {
            f32x16 sc0, sc1; qk_tile(KT2 + t * 64 * KTS, qf, qi, hl, sc0, sc1);
#pragma unroll
            for (int i = 0; i < 16; ++i) { const int kl = (i & 3) + 8 * (i >> 2) + 4 * hl;
                { const int n = 64 * t + kl, dist = qpos - (16 * n + 31); sc0[i] = (dist >= 0 && n < 127) ? sc0[i] * QS + lut[dist > 128 ? 128 : dist] : -INFINITY; }
                { const int n = 64 * t + 32 + kl, dist = qpos - (16 * n + 31); sc1[i] = (dist >= 0 && n < 127) ? sc1[i] * QS + lut[dist > 128 ? 128 : dist] : -INFINITY; } }
            flash_update(st, sc0, sc1, VT2 + 64 * t, 136, qi, hl);
        }
        const float lt = st.l + shfl_xor_(st.l, 32, lane); const float inv = 1.0f / fmaxf(lt, 1e-30f);
        const float muse = (st.m == -INFINITY) ? 0.f : st.m;
        fin0 = st.o0 * (g0 * inv); fin1 = st.o1 * (g0 * inv);
#pragma nounroll
        for (int t = 0; t < 2; ++t) {
            f32x16 sc0, sc1; qk_tile(KT2 + t * 64 * KTS, qf, qi, hl, sc0, sc1);
#pragma unroll
            for (int i = 0; i < 16; ++i) { const int kl = (i & 3) + 8 * (i >> 2) + 4 * hl;
                { const int n = 64 * t + kl, dist = qpos - (16 * n + 31); sc0[i] = (dist >= 0 && n < 127) ? __builtin_amdgcn_exp2f(sc0[i] * QS + lut[dist > 128 ? 128 : dist] - muse) * inv : 0.f; }
                { const int n = 64 * t + 32 + kl, dist = qpos - (16 * n + 31); sc1[i] = (dist >= 0 && n < 127) ? __builtin_amdgcn_exp2f(sc1[i] * QS + lut[dist > 128 ? 128 : dist] - muse) * inv : 0.f; } }
#pragma unroll
            for (int i4 = 0; i4 < 4; ++i4) {
                { const int m = 16 * t + 2 * i4 + hl; PA[(hh * 64 + ql) * 32 + m] = sc0[4 * i4] + sc0[4 * i4 + 1] + sc0[4 * i4 + 2] + sc0[4 * i4 + 3]; PBv[(hh * 64 + ql) * 32 + m + 1] = sc0[4 * i4 + 3]; }
                { const int m = 16 * t + 8 + 2 * i4 + hl; PA[(hh * 64 + ql) * 32 + m] = sc1[4 * i4] + sc1[4 * i4 + 1] + sc1[4 * i4 + 2] + sc1[4 * i4 + 3]; if (m + 1 < 32) PBv[(hh * 64 + ql) * 32 + m + 1] = sc1[4 * i4 + 3]; }
            }
        }
    }
    __syncthreads();
    {
        float* IMP = (float*)smem;
        const int q = tid & 63, part = tid >> 6, cur = qb;
#pragma unroll
        for (int mm = 0; mm < 4; ++mm) { const int m = part * 4 + mm; float v;
            if (m == 0 || m == cur || m == cur - 1) v = INFINITY;
            else if (m <= cur) { v = 0.f; for (int h2 = 0; h2 < 4; ++h2) v += PA[(h2 * 64 + q) * 32 + m] + PBv[(h2 * 64 + q) * 32 + m]; }
            else v = -INFINITY;
            IMP[q * 33 + m] = v; }
        __syncthreads();
        unsigned bits = 0u;
#pragma unroll
        for (int mm = 0; mm < 4; ++mm) { const int m = part * 4 + mm; const float v = IMP[q * 33 + m]; int rank = 0;
            for (int m2 = 0; m2 < 32; ++m2) { const float v2 = IMP[q * 33 + m2]; rank += (v2 > v || (v2 == v && m2 < m)) ? 1 : 0; }
            if (rank < 8 && v > -INFINITY) bits |= 1u << m; }
        atomicOr(&SELM[q], bits); atomicOr(ORM, bits);
    }
    __syncthreads();
    const unsigned mysel = SELM[ql], orm = *ORM;
    __syncthreads();
    float* PARK = PA + (wv * 32) * 64 + lane;
#pragma unroll
    for (int i = 0; i < 16; ++i) { PARK[i * 64] = fin0[i]; PARK[(16 + i) * 64] = fin1[i]; }
    {
        FlashState st;
#pragma unroll
        for (int i = 0; i < 16; ++i) { st.o0[i] = 0.f; st.o1[i] = 0.f; }
        st.m = -INFINITY; st.l = 0.f;
        const unsigned todo = orm & (qb >= 31 ? 0xFFFFFFFFu : ((2u << qb) - 1u));
        KVRegs kr;
        int m = todo ? __builtin_ctz(todo) : -1;
        if (m >= 0) { kv_fetch(kr, pb, C_KS + g * 64, C_VS + g * 64, m * 64); __syncthreads(); kv_store(kr, KT, VT); __syncthreads(); }
        while (m >= 0) {
            const unsigned rest = todo & ~((2u << m) - 1u); const int nm = (m < 31 && rest) ? __builtin_ctz(rest) : -1;
            if (nm >= 0) kv_fetch(kr, pb, C_KS + g * 64, C_VS + g * 64, nm * 64);
            const bool sel = (mysel >> m) & 1u;
            if (__builtin_amdgcn_ballot_w64(sel) != 0ull) {
                f32x16 sc0, sc1; qk_tile(KT, qf, qi, hl, sc0, sc1);
                if (m + 3 <= qb) mask_tile<false, false, false, true>(sc0, sc1, lut, qpos, m * 64, hl, sel, QS);
                else mask_tile<true, true, false, true>(sc0, sc1, lut, qpos, m * 64, hl, sel, QS);
                flash_update(st, sc0, sc1, VT, KTS, qi, hl);
            }
            __syncthreads();
            if (nm >= 0) kv_store(kr, KT, VT);
            __syncthreads();
            m = nm;
        }
        const float lt = st.l + shfl_xor_(st.l, 32, lane); const float sc = g1 / fmaxf(lt, 1e-30f);
#pragma unroll
        for (int i = 0; i < 16; ++i) { PARK[i * 64] += st.o0[i] * sc; PARK[(16 + i) * 64] += st.o1[i] * sc; }
    }
    {
        FlashState st;
#pragma unroll
        for (int i = 0; i < 16; ++i) { st.o0[i] = 0.f; st.o1[i] = 0.f; }
        st.m = -INFINITY; st.l = 0.f;
        KVRegs kr;
        int w = qb >= 4 ? 0 : 4 - qb;
        kv_fetch(kr, pb, C_KW + g * 64, C_VW + g * 64, qb * 64 - 256 + 64 * w); __syncthreads(); kv_store(kr, KT, VT); __syncthreads();
        for (; w < 5; ++w) {
            const int k0 = qb * 64 - 256 + 64 * w;
            if (w < 4) kv_fetch(kr, pb, C_KW + g * 64, C_VW + g * 64, k0 + 64);
            f32x16 sc0, sc1; qk_tile(KT, qf, qi, hl, sc0, sc1);
            if (w == 0) mask_tile<false, false, true, false>(sc0, sc1, lut, qpos, k0, hl, true, QS);
            else if (w == 1) mask_tile<false, false, false, false>(sc0, sc1, lut, qpos, k0, hl, true, QS);
            else if (w < 4) mask_tile<true, false, false, false>(sc0, sc1, lut, qpos, k0, hl, true, QS);
            else mask_tile<true, true, false, false>(sc0, sc1, lut, qpos, k0, hl, true, QS);
            flash_update(st, sc0, sc1, VT, KTS, qi, hl);
            __syncthreads();
            if (w < 4) kv_store(kr, KT, VT);
            __syncthreads();
        }
        const float lt = st.l + shfl_xor_(st.l, 32, lane); const float sc = g2 / fmaxf(lt, 1e-30f);
#pragma unroll
        for (int i = 0; i < 16; ++i) { fin0[i] = PARK[i * 64] + st.o0[i] * sc; fin1[i] = PARK[(16 + i) * 64] + st.o1[i] * sc; }
    }
#pragma unroll
    for (int i4 = 0; i4 < 4; ++i4) {
        u32x2 w0; w0.x = pack2(fin0[4 * i4], fin0[4 * i4 + 1]); w0.y = pack2(fin0[4 * i4 + 2], fin0[4 * i4 + 3]);
        u32x2 w1; w1.x = pack2(fin1[4 * i4], fin1[4 * i4 + 1]); w1.y = pack2(fin1[4 * i4 + 2], fin1[4 * i4 + 3]);
        *(u32x2*)(qrow + ocol + head * 64 + 8 * i4 + 4 * hl) = w0;
        *(u32x2*)(qrow + ocol + head * 64 + 32 + 8 * i4 + 4 * hl) = w1;
    }
}

constexpr int PH_PER_LAYER = 15, PH_TOTAL = DEPTH * PH_PER_LAYER + 1;
enum { S_PREP = 0, S_GU1, S_D1, S_NORM_MIX, S_WIN, S_CMP, S_LORA, S_SCAN, S_MERGE, S_OUT, S_NORM2, S_GU2, S_D2, S_NORM_PLE, S_PLEG, S_FINAL };

__device__ __forceinline__ void run_phase(unsigned char* smem, CP p, int ph) {
    const bool fin = (ph == DEPTH * PH_PER_LAYER);
    const int L = fin ? 0 : ph / PH_PER_LAYER; const int sub = fin ? S_FINAL : ph % PH_PER_LAYER;
    unsigned char* ws = p->ws; float* H = p->out;
    bf16_t* W = (bf16_t*)(ws + WS_WBF); bf16_t* UN = (bf16_t*)(ws + WS_UN); bf16_t* PROJ = (bf16_t*)(ws + WS_PROJ); bf16_t* ACT = (bf16_t*)(ws + WS_ACT);
    bf16_t* TMP = (bf16_t*)(ws + WS_TMP); bf16_t* PBF = (bf16_t*)(ws + WS_PB); bf16_t* ORW = (bf16_t*)(ws + WS_ORW);
    bf16_t* XK = (bf16_t*)(ws + WS_XK); bf16_t* XV = (bf16_t*)(ws + WS_XV); float* P01 = (float*)(ws + WS_P01);
    if (sub == S_PREP) convert_layer_weights(smem, p, L);
    if (sub == S_NORM_MIX) convert_ffn2_weights(smem, p, L);
    if (sub == S_NORM2) cvt_f32_bf16(p->in[I_P] + (size_t)L * T_TOK * 256, PBF, (size_t)T_TOK * 256 / 4);
    if (sub == S_CMP) lora_act(p, L);
    if (sub == S_LORA) finalize_cmp(smem, p, L);
    if (sub == S_NORM_PLE) { EpiBf16 e; e.O = TMP; run_gemm(smem, PBF, 256, W + E_PW, T_TOK, DM, 256, e); }
    if (sub == S_PREP || sub == S_NORM_MIX || sub == S_NORM2 || sub == S_NORM_PLE || sub == S_FINAL) {
        const float* hin = (sub == S_PREP && L == 0) ? p->in[I_X] : H; float* hcopy = (sub == S_PREP && L == 0) ? H : nullptr;
        const float* g = sub == S_PREP ? p->in[I_F1N] + L * DM : sub == S_NORM_MIX ? p->in[I_MIXN] + L * DM : sub == S_NORM2 ? p->in[I_F2N] + L * DM : sub == S_NORM_PLE ? p->in[I_PLEN] + L * DM : p->in[I_FINN];
        rmsnorm_rows(hin, hcopy, g, sub == S_FINAL ? nullptr : UN, sub == S_FINAL ? H : nullptr);
    } else if (sub == S_GU1 || sub == S_GU2) {
        EpiSwiglu e; e.O = ACT; run_gemm(smem, UN, DM, W + (sub == S_GU1 ? E_GU1 : E_GU2), T_TOK, 2 * DFF, DM, e);
    } else if (sub == S_D1 || sub == S_D2 || sub == S_OUT) {
        EpiResid e; e.H = H; e.scale = sub == S_OUT ? 1.0f : 0.5f;
        run_gemm(smem, sub == S_OUT ? UN : ACT, sub == S_OUT ? DM : DFF, W + (sub == S_D1 ? E_D1 : sub == S_D2 ? E_D2 : E_OUT), T_TOK, DM, sub == S_OUT ? DM : DFF, e);
    } else if (sub == S_WIN) {
        EpiProj e; e.O = PROJ; e.XK = XK; e.XV = XV; run_gemm(smem, UN, DM, W + E_IN, T_TOK, PLD, DM, e);
    } else if (sub == S_CMP) {
#pragma nounroll
        for (int kv = 0; kv < 2; ++kv) { EpiF32 e; e.C = P01 + (size_t)kv * 4096 * 256;
            run_gemm(smem, kv ? XV : XK, 1024, W + E_C1 + (size_t)kv * 256 * 1024, 4096, 256, 1024, e); }
    } else if (sub == S_LORA) {
        EpiLora e; e.EWA = UN; e.G = ORW;
        run_gemm(smem, (const bf16_t*)(ws + WS_LACT), 256, W + E_LORA, T_TOK, 1536, 256, e);
    } else if (sub == S_SCAN) {
        for (int item = bid_(); item < 256; item += gridDim.x) {
            __syncthreads();
            if (item < 128) rwkv_chunked(smem, p, L, item >> 3, item & 7); else hgrn_scan(smem, p, L, (item - 128) >> 3, (item - 128) & 7);
        }
        unsigned* ctr = (unsigned*)(ws + 14336) + L * 64;
        volatile unsigned* slot = (volatile unsigned*)(smem + 141 * 1024);
        for (;;) {
            __syncthreads();
            if (tid_() == 0) *slot = __hip_atomic_fetch_add(ctr, 1u, __ATOMIC_RELAXED, __HIP_MEMORY_SCOPE_AGENT);
            __syncthreads();
            const unsigned idx = *slot;
            if (idx >= 1024u) break;
            const int bg = idx & 31, qb = 31 - (int)(idx >> 5);
            nsa_item(smem, p, L, bg >> 1, bg & 1, qb, C_NQ);
        }
    } else if (sub == S_MERGE) {
#pragma nounroll
        for (int j = 0; j < 3; ++j) { EpiMerge e; e.MRG = UN; e.PROJ = PROJ; e.J = j;
            const bf16_t* A = j == 0 ? PROJ + C_HQ : (j == 1 ? PROJ + C_NQ : ORW);
            run_gemm(smem, A, j == 2 ? 512 : PLD, W + E_BR + (size_t)j * 1024 * 512, T_TOK, DM, 512, e); }
    } else if (sub == S_PLEG) {
        EpiPleGate e; e.H = H; e.TMP = TMP; run_gemm(smem, UN, DM, W + E_PG, T_TOK, DM, DM, e);
    }
}

#define XB_TMO      128
#define XB_XCNT(j)  (256  + 64 * (j))
#define XB_XSUB(j)  (1280 + 64 * (j))
#define XB_XGEN(j)  (2304 + 64 * (j))
#define XB_TOP      3328
#define XB_TOPGEN   3392
#define XCD_BAR_WORDS 3456
#define XB_SPIN_CAP (1u << 20)
DI unsigned xb_ld(unsigned* p)              { return __hip_atomic_load(p, __ATOMIC_RELAXED, __HIP_MEMORY_SCOPE_AGENT); }
DI unsigned xb_add(unsigned* p, unsigned v) { return __hip_atomic_fetch_add(p, v, __ATOMIC_RELAXED, __HIP_MEMORY_SCOPE_AGENT); }
DI unsigned xb_xcc_id() { return (unsigned)__builtin_amdgcn_s_getreg((3 << 11) | 20) & 0xFu; }
#define XB_SPIN(cond, bar) do { unsigned _sp = 0; while (cond) { __builtin_amdgcn_s_sleep(1); \
    if ((++_sp & 255u) == 0u) { if (xb_ld(&(bar)[XB_TMO])) break; if (_sp > XB_SPIN_CAP) { atomicAdd(&(bar)[XB_TMO], 1u); break; } } } } while (0)
struct XcdBarrier { unsigned* bar; unsigned x; volatile LAS unsigned* st; };
DI XcdBarrier xcd_barrier_post(unsigned* bar, volatile LAS unsigned* st) {
    XcdBarrier b; b.bar = bar; b.x = xb_xcc_id(); b.st = st;
    if (threadIdx.x == 0) (void)xb_add(&bar[XB_XCNT(b.x)], 1u);
    return b;
}
DI void xcd_barrier_complete(unsigned* bar, unsigned x, unsigned& nloc, unsigned& nx) {
    const unsigned G = gridDim.x * gridDim.y * gridDim.z;
    unsigned sum, cnt, mine, sp = 0u;
    for (;;) {
        sum = 0u; cnt = 0u; mine = 0u;
#pragma unroll
        for (unsigned j = 0; j < 16; ++j) { const unsigned c = xb_ld(&bar[XB_XCNT(j)]); sum += c; cnt += (c > 0u) ? 1u : 0u; mine = (j == x) ? c : mine; }
        if (sum == G) break;
        __builtin_amdgcn_s_sleep(1);
        if ((++sp & 255u) == 0u) { if (xb_ld(&bar[XB_TMO])) break; if (sp > XB_SPIN_CAP) { atomicAdd(&bar[XB_TMO], 1u); break; } }
    }
    nloc = mine > 0u ? mine : 1u; nx = cnt > 0u ? cnt : 1u;
}
DI void xcd_barrier(const XcdBarrier& b) {
    asm volatile("s_waitcnt vmcnt(0)" ::: "memory");
    __syncthreads();
    if (threadIdx.x == 0) {
        unsigned* bar = b.bar;
        __builtin_amdgcn_s_waitcnt(0);
        unsigned nloc = b.st[0], nx = b.st[1];
        if (nloc == 0u) { xcd_barrier_complete(bar, b.x, nloc, nx); b.st[0] = nloc; b.st[1] = nx; }
        const unsigned old = xb_add(&bar[XB_XSUB(b.x)], 1u);
        const unsigned gen = old / nloc;
        if (old + 1u == (gen + 1u) * nloc) {
            __builtin_amdgcn_fence(__ATOMIC_RELEASE, "agent");
            asm volatile("s_waitcnt vmcnt(0)" ::: "memory");
            const unsigned og = xb_add(&bar[XB_TOP], 1u);
            const unsigned tg = og / nx;
            if (og + 1u == (tg + 1u) * nx) xb_add(&bar[XB_TOPGEN], 1u);
            else XB_SPIN(xb_ld(&bar[XB_TOPGEN]) == tg, bar);
            __builtin_amdgcn_fence(__ATOMIC_ACQUIRE, "agent");
            xb_add(&bar[XB_XGEN(b.x)], 1u);
            asm volatile("s_waitcnt vmcnt(0)" ::: "memory");
        } else {
            XB_SPIN(xb_ld(&bar[XB_XGEN(b.x)]) == gen, bar);
            __builtin_amdgcn_fence(__ATOMIC_ACQUIRE, "agent");
            asm volatile("s_waitcnt vmcnt(0)" ::: "memory");
        }
    }
    __syncthreads();
}

__global__ void __launch_bounds__(512, 2) mega_fwd(Params p) {
    extern __shared__ __attribute__((aligned(16))) unsigned char smem[];
    cg::grid_group grid = cg::this_grid();
    volatile LAS unsigned* xst = (volatile LAS unsigned*)(LAS unsigned char*)(smem + 140 * 1024);
    if (threadIdx.x == 0) { xst[0] = 0u; xst[1] = 0u; }
    __syncthreads();
    const XcdBarrier xb = xcd_barrier_post((unsigned*)(p.ws + WS_BAR), xst);
#ifndef PROBE_DUP
#define PROBE_DUP -1
#endif
    constexpr int IT_PER_LAYER = PH_PER_LAYER + (PROBE_DUP >= 0 ? 1 : 0);
    const int it_lo = p.ph_lo, it_hi = PROBE_DUP >= 0 ? DEPTH * IT_PER_LAYER + 1 : p.ph_hi;
    for (int it = it_lo; it < it_hi; ++it) {
        int ph = it;
        if (PROBE_DUP >= 0) { const int l_ = it / IT_PER_LAYER, r_ = it % IT_PER_LAYER; ph = l_ * PH_PER_LAYER + (r_ <= PROBE_DUP ? r_ : r_ - 1); }
        CP pp = (CP)__builtin_amdgcn_kernarg_segment_ptr(); asm volatile("" : "+s"(pp));
        run_phase(smem, pp, ph);
        if (it + 1 < it_hi) {
            if (it == it_lo) grid.sync();
            else xcd_barrier(xb);
        }
    }
}

#ifndef MULTI_LAUNCH
#define MULTI_LAUNCH 0
#endif

extern "C" void kernel_launch(void* const* d_in, const int* in_sizes, int n_in, void* d_out, int out_size, void* d_ws, size_t ws_size, hipStream_t stream) {
    static int grid = 0;
    if (grid == 0) {
        if (n_in != N_INPUTS || out_size != T_TOK * DM || ws_size < WS_END) { fprintf(stderr, "kernel_launch: unexpected shapes: n_in %d out %d ws %zu (need %zu)\n", n_in, out_size, ws_size, (size_t)WS_END); grid = -1; return; }
        int dev = 0, cus = 0, per_cu = 0;
        (void)hipGetDevice(&dev); (void)hipDeviceGetAttribute(&cus, hipDeviceAttributeMultiprocessorCount, dev);
        if (hipFuncSetAttribute((const void*)mega_fwd, hipFuncAttributeMaxDynamicSharedMemorySize, LDS_BYTES) != hipSuccess) { fprintf(stderr, "kernel_launch: hipFuncSetAttribute failed\n"); grid = -1; return; }
        if (hipOccupancyMaxActiveBlocksPerMultiprocessor(&per_cu, (const void*)mega_fwd, 512, LDS_BYTES) != hipSuccess || per_cu < 1) { fprintf(stderr, "kernel_launch: occupancy query gives %d\n", per_cu); per_cu = 1; }
        (void)hipGetLastError();
        grid = cus * 1;
        if (grid > 256) grid = 256;
        fprintf(stderr, "kernel_launch: grid %d (cus %d, per_cu %d)\n", grid, cus, per_cu);
    }
    if (grid < 0) return;
    (void)hipMemsetAsync(d_ws, 0, 16384, stream);
    Params p{};
    for (int i = 0; i < N_INPUTS; ++i) p.in[i] = (const float*)d_in[i];
    p.out = (float*)d_out; p.ws = (unsigned char*)d_ws;
#if MULTI_LAUNCH
    for (int ph = 0; ph < PH_TOTAL; ++ph) { p.ph_lo = ph; p.ph_hi = ph + 1; hipLaunchKernelGGL(mega_fwd, dim3(grid), dim3(512), LDS_BYTES, stream, p); }
#else
    p.ph_lo = 0; p.ph_hi = PH_TOTAL;
    void* args[] = {&p};
    hipError_t e = hipLaunchCooperativeKernel((const void*)mega_fwd, dim3(grid), dim3(512), args, LDS_BYTES, stream);
    if (e != hipSuccess) fprintf(stderr, "kernel_launch: cooperative launch failed: %s\n", hipGetErrorString(e));
#endif
}
```

```cpp
#include <hip/hip_runtime.h>
#include <hip/hip_cooperative_groups.h>
#include <cstdio>
namespace cg = cooperative_groups;

#define LAS __attribute__((address_space(3)))
#define DI __device__ __forceinline__
typedef unsigned short bf16_t;
typedef short bf16x8 __attribute__((ext_vector_type(8)));
typedef float f32x4 __attribute__((ext_vector_type(4)));
typedef float f32x2 __attribute__((ext_vector_type(2)));
typedef float f32x16 __attribute__((ext_vector_type(16)));
typedef unsigned u32x4 __attribute__((ext_vector_type(4)));
typedef unsigned u32x2 __attribute__((ext_vector_type(2)));

constexpr int T_TOK = 32768, SEQ = 2048, NB = 16, DM = 1024, DFF = 2816, DEPTH = 4;
constexpr int PLD = 8448;
constexpr int C_HQ = 0, C_HF = 512, C_HI = 1024, C_HG = 1536, C_NQ = 2048, C_KC = 2560, C_VC = 2688, C_KS = 2816, C_VS = 2944,
              C_KW = 3072, C_VW = 3200, C_NG = 3328, C_RW = 3352, C_MG = 5376, IN_REAL = 5144, IN_COLS = 8216;
enum { I_X = 0, I_P, I_F1N, I_F1GU, I_F1D, I_MIXN, I_WIN, I_HGLB, I_HGN, I_PE, I_CW1, I_CW2, I_RELB, I_MU, I_W0, I_WB, I_A0, I_AB, I_GB,
       I_KK, I_KA, I_RK, I_LNW, I_LNB, I_WBR, I_WOUT, I_F2N, I_F2GU, I_F2D, I_PLEN, I_PLEG, I_PLEW, I_FINN, N_INPUTS };

constexpr size_t WS_BAR = 0;
constexpr size_t WS_PEB = 16384;
constexpr size_t WS_WBF = 20480;
constexpr size_t E_GU1 = 0, E_D1 = E_GU1 + 5632ull * 1024, E_IN = E_D1 + 1024ull * 2816, E_BR = E_IN + 8448ull * 1024, E_OUT = E_BR + 3ull * 1024 * 512,
                 E_GU2 = E_GU1, E_D2 = E_D1  , E_PG = E_OUT + 1024ull * 1024, E_PW = E_PG + 1024ull * 1024,
                 E_C1 = E_PW + 1024ull * 256, E_LORA = E_C1 + 2ull * 256 * 1024, E_END = E_LORA + 1536ull * 256;
constexpr size_t WS_UN = WS_WBF + E_END * 2;
constexpr size_t WS_ORW = WS_UN + (size_t)T_TOK * 1024 * 2;
constexpr size_t WS_XK = WS_ORW + (size_t)T_TOK * 512 * 2;
constexpr size_t WS_XV = WS_XK + 4096ull * 1024 * 2;
constexpr size_t WS_P01 = WS_XV + 4096ull * 1024 * 2;
constexpr size_t WS_KC = WS_P01 + 2ull * 4096 * 256 * 4;
constexpr size_t WS_LACT = WS_KC + 2ull * 16 * 2 * 128 * 64 * 4;
constexpr size_t WS_PROJ = WS_LACT + (size_t)T_TOK * 256 * 2;
constexpr size_t WS_END = WS_PROJ + (size_t)T_TOK * PLD * 2;
constexpr size_t WS_ACT = WS_PROJ;
constexpr size_t WS_PB = WS_PROJ + 200ull * 1024 * 1024;
constexpr size_t WS_TMP = WS_PROJ + 256ull * 1024 * 1024;
constexpr int LDS_BYTES = 144 * 1024;

struct Params {
    const float* in[N_INPUTS];
    float* out;
    unsigned char* ws;
    int ph_lo, ph_hi;
};
typedef const Params __attribute__((address_space(4)))* CP;

DI int tid_() { int t = threadIdx.x; asm volatile("" : "+v"(t)); return t; }
DI int bid_() { int b = blockIdx.x; asm volatile("" : "+s"(b)); return b; }
typedef __bf16 bf16v2 __attribute__((ext_vector_type(2)));
DI float bf2f(bf16_t b) { return __uint_as_float(((unsigned)b) << 16); }
DI unsigned pack2(float lo, float hi) { const f32x2 v = {lo, hi}; return __builtin_bit_cast(unsigned, __builtin_convertvector(v, bf16v2)); }
DI bf16_t f2bf(float f) { return (bf16_t)(pack2(f, 0.f) & 0xFFFFu); }
DI float sigmoidf_(float x) { return __builtin_amdgcn_rcpf(1.0f + __builtin_amdgcn_exp2f(-1.4426950408889634f * x)); }
DI float siluf_(float x) { return x * __builtin_amdgcn_rcpf(1.0f + __builtin_amdgcn_exp2f(-1.4426950408889634f * x)); }
DI float shfl_xor_(float v, int mask, int lane) { return __int_as_float(__builtin_amdgcn_ds_bpermute((lane ^ mask) << 2, __float_as_int(v))); }
DI float dppf_(float v, int) { return v; }
#define DPPF(v, ctrl) __int_as_float(__builtin_amdgcn_mov_dpp(__float_as_int(v), ctrl, 0xF, 0xF, true))
DI float wave_sum(float v) {
    v += DPPF(v, 0xB1); v += DPPF(v, 0x4E); v += DPPF(v, 0x141); v += DPPF(v, 0x140);
    const float s0 = __int_as_float(__builtin_amdgcn_readlane(__float_as_int(v), 0)), s1 = __int_as_float(__builtin_amdgcn_readlane(__float_as_int(v), 16));
    const float s2 = __int_as_float(__builtin_amdgcn_readlane(__float_as_int(v), 32)), s3 = __int_as_float(__builtin_amdgcn_readlane(__float_as_int(v), 48));
    return (s0 + s1) + (s2 + s3);
}

#define MFMA32(a, b, c) __builtin_amdgcn_mfma_f32_32x32x16_bf16((a), (b), (c), 0, 0, 0)
namespace pg8 {
constexpr int BM = 256, BK = 64, HALF = 128, HTB = HALF * BK * 2, STAGE_BYTES = 8 * HTB, NXCD = 8, WGM = 8;
DI int lds_byte(int r, int c) { const int st = (r >> 4) * 2 + (c >> 5), rr = r & 15, cc = c & 31, ob = rr * 64 + cc * 2; return st * 1024 + (ob ^ (((ob >> 9) & 1) << 5)); }
DI void stage_rc(int b, int& R, int& C) { const int st = b / 1024, sb = b % 1024, swz = sb ^ (((sb >> 9) & 1) << 5); R = (st >> 1) * 16 + swz / 64; C = (st & 1) * 32 + (swz % 64) / 2; }
DI int perm32(int rho) { const int n = rho >> 4, i = rho & 15; return 8 * (i >> 2) + 4 * n + (i & 3); }
struct Unit { int pm, pn; };
struct Gemm { const bf16_t* A; const bf16_t* Bt; int M, N, K, lda; };
struct StaticOrder {
    int nM, nN, nwg, G, c;
    DI void init(int M, int N, int G_, int c_) { nM = M / BM; nN = N / BM; nwg = nM * nN; G = G_; c = c_; }
    DI bool next(int i, Unit& u) const {
        const long L = (long)i * G + c; if (L >= nwg) return false;
        int wgid = (int)L; { const int q = nwg / NXCD, r = nwg % NXCD, xcd = wgid % NXCD, off = wgid / NXCD; wgid = (xcd < r ? xcd * (q + 1) : r * (q + 1) + (xcd - r) * q) + off; }
        const int nig = WGM * nN, gid = wgid / nig, fm = gid * WGM, gsz = (nM - fm) < WGM ? (nM - fm) : WGM;
        u.pm = fm + ((wgid % nig) % gsz); u.pn = (wgid % nig) / gsz; return true;
    }
};

template <class Epi>
DI void gemm_phase(LAS unsigned char* lds, const Gemm g, const StaticOrder& S, const Epi& E) {
    int tid = tid_();
    const int wid = __builtin_amdgcn_readfirstlane(tid >> 6), lane = tid & 63, wr = wid >> 2, wc = wid & 3, fr = lane & 15, fq = lane >> 4;
    const int K = g.K, nt = K / BK, lda = g.lda;
    unsigned voffA[2], voffB[2];
#pragma unroll
    for (int i = 0; i < 2; ++i) { int R, C; stage_rc(tid * 16 + i * 8192, R, C); const int Rb = Epi::PERM ? ((R & ~31) + perm32(R & 31)) : R;
        voffA[i] = (unsigned)(R * lda + C) * 2u; voffB[i] = (unsigned)(Rb * K + C) * 2u; }
    const size_t kstep = (size_t)(BK * 2);
    const size_t hstepA = (size_t)HALF * lda * 2, hstepB = (size_t)HALF * K * 2;
    const size_t tstepA = 2 * hstepA, tstepB = 2 * hstepB;
    const unsigned ldsw = (unsigned)wid * 1024u;
    const int aoff = lds_byte(wr * 64 + fr, fq * 8), boff = lds_byte(wc * 32 + fr, fq * 8);
#define PG8_SA(b, h) (((b) * 2 + (h)) * HTB)
#define PG8_SB(b, h) ((4 + (b) * 2 + (h)) * HTB)
#define PG8_STAGE(bufoff, gbase, voff) do { _Pragma("unroll") for (int _i = 0; _i < 2; ++_i) \
        __builtin_amdgcn_global_load_lds((const unsigned*)((const char*)(gbase) + (voff)[_i]), (LAS unsigned*)(lds + (bufoff) + ldsw + _i * 8192), 16, 0, 0); } while (0)
#define PG8_LDA(dst, b, h) do { _Pragma("unroll") for (int m = 0; m < 4; ++m) _Pragma("unroll") for (int k = 0; k < 2; ++k) dst[m][k] = *(const LAS bf16x8*)(lds + PG8_SA(b, h) + aoff + m * 2048 + k * 1024); } while (0)
#define PG8_LDB(dst, b, h) do { _Pragma("unroll") for (int n = 0; n < 2; ++n) _Pragma("unroll") for (int k = 0; k < 2; ++k) dst[n][k] = *(const LAS bf16x8*)(lds + PG8_SB(b, h) + boff + n * 2048 + k * 1024); } while (0)
#define PG8_MMA(ai, bj, At, Bt) do { __builtin_amdgcn_s_setprio(1); _Pragma("unroll") for (int m = 0; m < 4; ++m) _Pragma("unroll") for (int n = 0; n < 2; ++n) _Pragma("unroll") for (int k = 0; k < 2; ++k) \
        acc[ai][bj][m][n] = __builtin_amdgcn_mfma_f32_16x16x32_bf16(Bt[n][k], At[m][k], acc[ai][bj][m][n], 0, 0, 0); __builtin_amdgcn_s_setprio(0); } while (0)
#define PG8_WAIT_V(n) asm volatile("s_waitcnt vmcnt(" #n ")" ::: "memory")
#define PG8_WAIT_L(n) asm volatile("s_waitcnt lgkmcnt(" #n ")" ::: "memory")
#define PG8_BAR __builtin_amdgcn_s_barrier()
#define PG8_SCHED __builtin_amdgcn_sched_barrier(0)
    Unit cur, nxt; int ui = 0;
    if (!S.next(0, cur)) return;
    f32x4 acc[2][2][4][2];
#pragma unroll
    for (int a = 0; a < 2; ++a)
#pragma unroll
        for (int b = 0; b < 2; ++b)
#pragma unroll
            for (int m = 0; m < 4; ++m)
#pragma unroll
                for (int n = 0; n < 2; ++n) acc[a][b][m][n] = (f32x4){0.f, 0.f, 0.f, 0.f};
    bf16x8 At[4][2], B0[2][2], B1[2][2];
    const char* cA = (const char*)g.A + (size_t)cur.pm * tstepA; const char* cB = (const char*)g.Bt + (size_t)cur.pn * tstepB;
    PG8_STAGE(PG8_SB(0, 0), cB, voffB); PG8_STAGE(PG8_SA(0, 0), cA, voffA); PG8_STAGE(PG8_SB(0, 1), cB + hstepB, voffB); PG8_STAGE(PG8_SA(0, 1), cA + hstepA, voffA);
    if (wr == 1) PG8_BAR;
    PG8_WAIT_V(4); PG8_BAR;
    PG8_STAGE(PG8_SB(1, 0), cB + kstep, voffB); PG8_STAGE(PG8_SA(1, 0), cA + kstep, voffA); PG8_STAGE(PG8_SB(1, 1), cB + hstepB + kstep, voffB);
    PG8_WAIT_V(6); PG8_BAR;
    for (;;) {
        const bool has_next = S.next(ui + 1, nxt);
        const char* nA = has_next ? (const char*)g.A + (size_t)nxt.pm * tstepA : cA; const char* nB = has_next ? (const char*)g.Bt + (size_t)nxt.pn * tstepB : cB;
        for (int t = 0; t < nt; t += 2) {
            const bool last = (t == nt - 2);
            const char* a1 = cA + (size_t)(t + 1) * kstep;
            const char* a2 = last ? nA : cA + (size_t)(t + 2) * kstep; const char* b2 = last ? nB : cB + (size_t)(t + 2) * kstep;
            const char* a3 = a2 + kstep; const char* b3 = b2 + kstep;
            PG8_LDB(B0, 0, 0); PG8_SCHED; PG8_LDA(At, 0, 0); PG8_STAGE(PG8_SA(1, 1), a1 + hstepA, voffA);
            PG8_WAIT_L(8); PG8_BAR; PG8_WAIT_L(0); PG8_MMA(0, 0, At, B0); PG8_BAR; PG8_SCHED;
            PG8_LDB(B1, 0, 1); PG8_STAGE(PG8_SB(0, 0), b2, voffB);
            PG8_BAR; PG8_WAIT_L(0); PG8_MMA(0, 1, At, B1); PG8_BAR;
            PG8_LDA(At, 0, 1); PG8_STAGE(PG8_SA(0, 0), a2, voffA);
            PG8_BAR; PG8_WAIT_L(0); PG8_MMA(1, 0, At, B0); PG8_BAR; PG8_SCHED;
            PG8_STAGE(PG8_SB(0, 1), b2 + hstepB, voffB);
            PG8_WAIT_V(6); PG8_BAR; PG8_MMA(1, 1, At, B1); PG8_BAR;
            PG8_LDB(B0, 1, 0); PG8_SCHED; PG8_LDA(At, 1, 0); PG8_STAGE(PG8_SA(0, 1), a2 + hstepA, voffA);
            PG8_WAIT_L(8); PG8_BAR; PG8_WAIT_L(0); PG8_MMA(0, 0, At, B0); PG8_BAR; PG8_SCHED;
            PG8_LDB(B1, 1, 1); PG8_STAGE(PG8_SB(1, 0), b3, voffB);
            PG8_BAR; PG8_WAIT_L(0); PG8_MMA(0, 1, At, B1); PG8_BAR;
            PG8_LDA(At, 1, 1); PG8_STAGE(PG8_SA(1, 0), a3, voffA);
            PG8_BAR; PG8_WAIT_L(0); PG8_MMA(1, 0, At, B0); PG8_BAR; PG8_SCHED;
            PG8_STAGE(PG8_SB(1, 1), b3 + hstepB, voffB);
            PG8_WAIT_V(6); PG8_BAR; PG8_MMA(1, 1, At, B1); PG8_BAR;
        }
        E(acc, cur, wr, wc, fr, fq);
        if (!has_next) break;
#pragma unroll
        for (int a = 0; a < 2; ++a)
#pragma unroll
            for (int b = 0; b < 2; ++b)
#pragma unroll
                for (int m = 0; m < 4; ++m)
#pragma unroll
                    for (int n = 0; n < 2; ++n) acc[a][b][m][n] = (f32x4){0.f, 0.f, 0.f, 0.f};
        cur = nxt; cA = nA; cB = nB; ++ui;
    }
    PG8_WAIT_V(0);
    if (wr == 0) PG8_BAR;
    PG8_BAR;
#undef PG8_SA
#undef PG8_SB
#undef PG8_STAGE
#undef PG8_LDA
#undef PG8_LDB
#undef PG8_MMA
#undef PG8_WAIT_V
#undef PG8_WAIT_L
#undef PG8_BAR
#undef PG8_SCHED
}
}

typedef f32x4 AccT[2][2][4][2];
#define EPI_LANE const int t_ = tid_(), wid_ = t_ >> 6, ln_ = t_ & 63, wr_ = wid_ >> 2, wc_ = wid_ & 3, fr_ = ln_ & 15, fq_ = ln_ >> 4;
#define EPI_LOOP_PERM(...) EPI_LANE \
    const int row0 = u.pm * 256 + wr_ * 64 + fr_, col0 = u.pn * 256 + wc_ * 32 + 8 * fq_; \
    _Pragma("unroll") for (int ai = 0; ai < 2; ++ai) _Pragma("unroll") for (int m = 0; m < 4; ++m) { const int row = row0 + ai * 128 + m * 16; \
        _Pragma("unroll") for (int bj = 0; bj < 2; ++bj) { const int col = col0 + bj * 128; const f32x4 v0 = acc[ai][bj][m][0], v1 = acc[ai][bj][m][1]; __VA_ARGS__ } }
#define EPI_LOOP_NAT(...) EPI_LANE \
    const int row0 = u.pm * 256 + wr_ * 64 + fr_, col0 = u.pn * 256 + wc_ * 32 + 4 * fq_; \
    _Pragma("unroll") for (int ai = 0; ai < 2; ++ai) _Pragma("unroll") for (int m = 0; m < 4; ++m) { const int row = row0 + ai * 128 + m * 16; \
        _Pragma("unroll") for (int bj = 0; bj < 2; ++bj) _Pragma("unroll") for (int n = 0; n < 2; ++n) { const int col = col0 + bj * 128 + n * 16; const f32x4 v = acc[ai][bj][m][n]; __VA_ARGS__ } }

struct EpiSwiglu { static constexpr bool PERM = true; bf16_t* O;
    DI void operator()(const AccT& acc, const pg8::Unit& u, int wr, int wc, int fr, int fq) const {
        EPI_LOOP_PERM({ u32x2 w; w.x = pack2(siluf_(v0[0]) * v1[0], siluf_(v0[1]) * v1[1]); w.y = pack2(siluf_(v0[2]) * v1[2], siluf_(v0[3]) * v1[3]);
            *(u32x2*)(O + (size_t)row * DFF + (col >> 1)) = w; })
    } };
struct EpiResid { static constexpr bool PERM = false; float* H; float scale;
    DI void operator()(const AccT& acc, const pg8::Unit& u, int wr, int wc, int fr, int fq) const {
        EPI_LOOP_NAT({ f32x4* p = (f32x4*)(H + (size_t)row * DM + col); *p = *p + v * scale; })
    } };
struct EpiProj { static constexpr bool PERM = true; bf16_t* O; bf16_t* XK; bf16_t* XV;
    DI void operator()(const AccT& acc, const pg8::Unit& u, int wr, int wc, int fr, int fq) const {
        const bool is_mg = u.pn * 256 >= C_MG, is_cmp = (u.pn == 10);
        EPI_LOOP_PERM({ f32x4 a = v0, b = v1;
            if (is_mg) { for (int j = 0; j < 4; ++j) { a[j] = sigmoidf_(a[j]); b[j] = sigmoidf_(b[j]); } }
            u32x4 w; w.x = pack2(a[0], a[1]); w.y = pack2(a[2], a[3]); w.z = pack2(b[0], b[1]); w.w = pack2(b[2], b[3]);
            *(u32x4*)(O + (size_t)row * PLD + col) = w;
            if (is_cmp) { const int c = col - C_KC, kv = c >> 7, gg = (c >> 6) & 1, d = c & 63, bb = row >> 11, s = row & 2047, jj = s >> 4, l = s & 15;
                bf16_t* X = kv ? XV : XK; *(u32x4*)(X + ((size_t)((bb * 128 + jj) * 2 + gg)) * 1024 + l * 64 + d) = w; } })
    } };
struct EpiMerge { static constexpr bool PERM = true; bf16_t* MRG; const bf16_t* PROJ; int J;
    DI void operator()(const AccT& acc, const pg8::Unit& u, int wr, int wc, int fr, int fq) const {
        EPI_LOOP_PERM({ const u32x4 gt = *(const u32x4*)(PROJ + (size_t)row * PLD + C_MG + J * 1024 + col);
            u32x4* mp = (u32x4*)(MRG + (size_t)row * DM + col); u32x4 old = (u32x4){0u, 0u, 0u, 0u}; if (J > 0) old = *mp;
            float r[8]; const float x[8] = {v0[0], v0[1], v0[2], v0[3], v1[0], v1[1], v1[2], v1[3]};
            _Pragma("unroll") for (int j = 0; j < 8; ++j) { const unsigned gw = gt[j >> 1], ow = old[j >> 1];
                const float gf = (j & 1) ? __uint_as_float(gw & 0xFFFF0000u) : __uint_as_float(gw << 16);
                const float of = (j & 1) ? __uint_as_float(ow & 0xFFFF0000u) : __uint_as_float(ow << 16);
                r[j] = of + gf * x[j]; }
            u32x4 w; w.x = pack2(r[0], r[1]); w.y = pack2(r[2], r[3]); w.z = pack2(r[4], r[5]); w.w = pack2(r[6], r[7]); *mp = w; })
    } };
struct EpiF32 { static constexpr bool PERM = false; float* C; static constexpr int ldc = 256;
    DI void operator()(const AccT& acc, const pg8::Unit& u, int wr, int wc, int fr, int fq) const {
        EPI_LOOP_NAT({ *(f32x4*)(C + (size_t)row * ldc + col) = v; })
    } };
struct EpiBf16 { static constexpr bool PERM = true; bf16_t* O; static constexpr int ldc = DM;
    DI void operator()(const AccT& acc, const pg8::Unit& u, int wr, int wc, int fr, int fq) const {
        EPI_LOOP_PERM({ u32x4 w; w.x = pack2(v0[0], v0[1]); w.y = pack2(v0[2], v0[3]); w.z = pack2(v1[0], v1[1]); w.w = pack2(v1[2], v1[3]);
            *(u32x4*)(O + (size_t)row * ldc + col) = w; })
    } };
struct EpiPleGate { static constexpr bool PERM = false; float* H; const bf16_t* TMP;
    DI void operator()(const AccT& acc, const pg8::Unit& u, int wr, int wc, int fr, int fq) const {
        EPI_LOOP_NAT({ const u32x2 tw = *(const u32x2*)(TMP + (size_t)row * DM + col); f32x4* p = (f32x4*)(H + (size_t)row * DM + col); f32x4 h = *p;
            h[0] += sigmoidf_(v[0]) * __uint_as_float(tw.x << 16); h[1] += sigmoidf_(v[1]) * __uint_as_float(tw.x & 0xFFFF0000u);
            h[2] += sigmoidf_(v[2]) * __uint_as_float(tw.y << 16); h[3] += sigmoidf_(v[3]) * __uint_as_float(tw.y & 0xFFFF0000u); *p = h; })
    } };

struct EpiLora { static constexpr bool PERM = true; bf16_t* EWA; bf16_t* G;
    DI void operator()(const AccT& acc, const pg8::Unit& u, int wr, int wc, int fr, int fq) const {
        const bool isg = u.pn >= 4; bf16_t* O = isg ? G - 1024 : EWA; const int ld = isg ? 512 : 1024;
        EPI_LOOP_PERM({ u32x4 w; w.x = pack2(v0[0], v0[1]); w.y = pack2(v0[2], v0[3]); w.z = pack2(v1[0], v1[1]); w.w = pack2(v1[2], v1[3]);
            *(u32x4*)(O + (size_t)row * ld + col) = w; })
    } };

template <class Epi> DI void run_gemm(unsigned char* smem, const bf16_t* A, int lda, const bf16_t* Bt, int M, int N, int K, const Epi& E) {
    __syncthreads();
    pg8::Gemm g; g.A = A; g.Bt = Bt; g.M = M; g.N = N; g.K = K; g.lda = lda;
    pg8::StaticOrder S; S.init(M, N, (int)gridDim.x, bid_());
    pg8::gemm_phase<Epi>((LAS unsigned char*)smem, g, S, E);
    __syncthreads();
}

struct MapId { DI int operator()(int n) const { return n; } };
struct MapGU { DI int operator()(int n) const { const int q = n >> 3, e = n & 7; return e < 4 ? 4 * q + e : DFF + 4 * q + (e - 4); } };
struct MapIn { DI int operator()(int n) const { return n < IN_REAL ? n : (n < C_MG ? -1 : n - (C_MG - IN_REAL)); } };
template <int TN, class Map> __device__ __forceinline__ void transpose_cvt_t(unsigned char* smem, const float* src, int ldsrc, bf16_t* dst, int K, int Nd, Map map) {
    float* tile = (float*)smem;
    constexpr int RPP = 512 / TN;
    const int tid = tid_(), ntk = K / 64, nt = ntk * (Nd / TN);
    for (int t = bid_(); t < nt; t += gridDim.x) {
        const int n0 = (t / ntk) * TN, k0 = (t % ntk) * 64;
        const int nn = tid % TN, sc = map(n0 + nn);
#pragma unroll
        for (int p = 0; p < 64 / RPP; ++p) { const int kk = (tid / TN) + p * RPP; tile[kk * (TN + 1) + nn] = sc >= 0 ? src[(size_t)(k0 + kk) * ldsrc + sc] : 0.f; }
        __syncthreads();
#pragma unroll
        for (int p = 0; p < TN / 16; ++p) { const int nn2 = (tid >> 5) + p * 16, kk2 = (tid & 31) * 2;
            *(unsigned*)(dst + (size_t)(n0 + nn2) * K + k0 + kk2) = pack2(tile[kk2 * (TN + 1) + nn2], tile[(kk2 + 1) * (TN + 1) + nn2]); }
        __syncthreads();
    }
}
template <class Map> __device__ __forceinline__ void transpose_cvt(unsigned char* smem, const float* src, int ldsrc, bf16_t* dst, int K, int Nd, Map map) {
    if ((Nd & 255) == 0) transpose_cvt_t<256>(smem, src, ldsrc, dst, K, Nd, map); else transpose_cvt_t<64>(smem, src, ldsrc, dst, K, Nd, map);
}
__device__ __forceinline__ void convert_layer_weights(unsigned char* smem, CP p, int L) {
    bf16_t* W = (bf16_t*)(p->ws + WS_WBF);
    transpose_cvt(smem, p->in[I_F1GU] + (size_t)L * DM * 2 * DFF, 2 * DFF, W + E_GU1, DM, 2 * DFF, MapGU());
    transpose_cvt(smem, p->in[I_F1D] + (size_t)L * DFF * DM, DM, W + E_D1, DFF, DM, MapId());
    transpose_cvt(smem, p->in[I_WIN] + (size_t)L * DM * IN_COLS, IN_COLS, W + E_IN, DM, PLD, MapIn());
    for (int j = 0; j < 3; ++j) transpose_cvt(smem, p->in[I_WBR] + ((size_t)L * 3 + j) * 512 * DM, DM, W + E_BR + (size_t)j * 1024 * 512, 512, DM, MapId());
    transpose_cvt(smem, p->in[I_WOUT] + (size_t)L * DM * DM, DM, W + E_OUT, DM, DM, MapId());
    for (int i = bid_() * 512 + tid_(); i < 1536 * 256; i += gridDim.x * 512) { const int n = i >> 8, k = i & 255; float w = 0.f;
        if (n < 512) { if (k < 64) w = p->in[I_WB][((size_t)L * 64 + k) * 512 + n]; }
        else if (n < 1024) { if (k >= 64 && k < 128) w = p->in[I_AB][((size_t)L * 64 + (k - 64)) * 512 + (n - 512)]; }
        else { if (k >= 128) w = p->in[I_GB][((size_t)L * 128 + (k - 128)) * 512 + (n - 1024)]; }
        W[E_LORA + i] = f2bf(w); }
    transpose_cvt(smem, p->in[I_PLEG] + (size_t)L * DM * DM, DM, W + E_PG, DM, DM, MapId());
    transpose_cvt(smem, p->in[I_PLEW] + (size_t)L * 256 * DM, DM, W + E_PW, 256, DM, MapId());
    for (int kv = 0; kv < 2; ++kv) for (int hf = 0; hf < 2; ++hf)
        transpose_cvt(smem, p->in[I_CW1] + ((size_t)(L * 2 + kv) * 2048 + hf * 1024) * 128, 128, W + E_C1 + ((size_t)kv * 256 + hf * 128) * 1024, 1024, 128, MapId());
    if (bid_() == gridDim.x - 1 && tid_() < 256) {
        const int kv = tid_() >> 7, hc = tid_() & 127;
        const float* pe = p->in[I_PE] + (size_t)(L * 2 + kv) * 2048; const float* w1 = p->in[I_CW1] + (size_t)(L * 2 + kv) * 2048 * 128 + hc;
        float s = 0.f; for (int i = 0; i < 2048; ++i) s += pe[i] * w1[(size_t)i * 128];
        ((float*)(p->ws + WS_PEB))[kv * 128 + hc] = s;
    }
}

__device__ __forceinline__ void convert_ffn2_weights(unsigned char* smem, CP p, int L) {
    bf16_t* W = (bf16_t*)(p->ws + WS_WBF);
    transpose_cvt(smem, p->in[I_F2GU] + (size_t)L * DM * 2 * DFF, 2 * DFF, W + E_GU2, DM, 2 * DFF, MapGU());
    transpose_cvt(smem, p->in[I_F2D] + (size_t)L * DFF * DM, DM, W + E_D2, DFF, DM, MapId());
}
__device__ __forceinline__ void lora_act(CP p, int L) {
    const bf16_t* PROJ = (const bf16_t*)(p->ws + WS_PROJ); bf16_t* LACT = (bf16_t*)(p->ws + WS_LACT);
    const float* mu = p->in[I_MU] + (size_t)L * 1792 + 1536;
    for (int i = bid_() * 512 + tid_(); i < T_TOK * 32; i += gridDim.x * 512) {
        const int t = i >> 5, j0 = (i & 31) * 8; const bf16_t* row = PROJ + (size_t)t * PLD + C_RW + 1536 + j0;
        const u32x4 cur = *(const u32x4*)row; u32x4 prv = {0u, 0u, 0u, 0u}; if ((t & (SEQ - 1)) != 0) prv = *(const u32x4*)(row - PLD);
        float r[8];
#pragma unroll
        for (int e = 0; e < 8; ++e) { const float x1 = (e & 1) ? __uint_as_float(cur[e >> 1] & 0xFFFF0000u) : __uint_as_float(cur[e >> 1] << 16);
            const float xp = (e & 1) ? __uint_as_float(prv[e >> 1] & 0xFFFF0000u) : __uint_as_float(prv[e >> 1] << 16);
            float xm = x1 + (xp - x1) * mu[j0 + e];
            if (j0 < 64) xm = tanhf(xm); else if (j0 >= 128) xm = sigmoidf_(xm);
            r[e] = xm; }
        u32x4 w; w.x = pack2(r[0], r[1]); w.y = pack2(r[2], r[3]); w.z = pack2(r[4], r[5]); w.w = pack2(r[6], r[7]);
        *(u32x4*)(LACT + (size_t)t * 256 + j0) = w;
    }
}

__device__ __forceinline__ void rmsnorm_rows(const float* hin, float* hcopy, const float* g, bf16_t* un, float* outf) {
    const int lane = tid_() & 63, gw = bid_() * 8 + (tid_() >> 6), nw = gridDim.x * 8;
    f32x4 gv[4];
#pragma unroll
    for (int i = 0; i < 4; ++i) gv[i] = *(const f32x4*)(g + lane * 4 + i * 256);
    for (int row = gw; row < T_TOK; row += nw) {
        f32x4 x[4]; float ss = 0.f;
#pragma unroll
        for (int i = 0; i < 4; ++i) { x[i] = *(const f32x4*)(hin + (size_t)row * DM + lane * 4 + i * 256); ss += x[i][0] * x[i][0] + x[i][1] * x[i][1] + x[i][2] * x[i][2] + x[i][3] * x[i][3]; }
        ss = wave_sum(ss);
        const float rs = rsqrtf(ss * (1.0f / DM) + 1e-6f);
#pragma unroll
        for (int i = 0; i < 4; ++i) {
            const f32x4 y = x[i] * rs * gv[i];
            if (hcopy) *(f32x4*)(hcopy + (size_t)row * DM + lane * 4 + i * 256) = x[i];
            if (un) { u32x2 w; w.x = pack2(y[0], y[1]); w.y = pack2(y[2], y[3]); *(u32x2*)(un + (size_t)row * DM + lane * 4 + i * 256) = w; }
            if (outf) *(f32x4*)(outf + (size_t)row * DM + lane * 4 + i * 256) = y;
        }
    }
}
__device__ __forceinline__ void cvt_f32_bf16(const float* src, bf16_t* dst, size_t n4) {
    for (size_t i = (size_t)bid_() * 512 + tid_(); i < n4; i += (size_t)gridDim.x * 512) {
        const f32x4 v = *(const f32x4*)(src + i * 4); u32x2 w; w.x = pack2(v[0], v[1]); w.y = pack2(v[2], v[3]); *(u32x2*)(dst + i * 4) = w; }
}

__device__ __forceinline__ void finalize_cmp(unsigned char* smem, CP p, int L) {
    float* hid = (float*)smem + (tid_() >> 6) * 128;
    const int lane = tid_() & 63, gw = bid_() * 8 + (tid_() >> 6), nw = gridDim.x * 8;
    const float* peb = (const float*)(p->ws + WS_PEB);
    const int total = 2 * 16 * 2 * 128, iters = (total + nw - 1) / nw;
    for (int it = 0; it < iters; ++it) {
        const int id = gw + it * nw; const bool ok = id < total;
        const int n = id & 127, gg = (id >> 7) & 1, bb = (id >> 8) & 15, kv = (id >> 12) & 1;
        if (ok && n < 127) {
            const float* Pm = (const float*)(p->ws + WS_P01) + (size_t)kv * 4096 * 256;
            const size_t r0 = (size_t)((bb * 128 + n) * 2 + gg) * 256, r1 = (size_t)((bb * 128 + n + 1) * 2 + gg) * 256;
#pragma unroll
            for (int q = 0; q < 2; ++q) { const int hc = lane + q * 64; hid[hc] = siluf_(Pm[r0 + hc] + Pm[r1 + 128 + hc] + peb[kv * 128 + hc]); }
        }
        __syncthreads();
        if (ok) {
            float o = 0.f;
            if (n < 127) { const float* w2 = p->in[I_CW2] + (size_t)(L * 2 + kv) * 128 * 64 + lane;
                for (int hc = 0; hc < 128; ++hc) o += hid[hc] * w2[hc * 64]; }
            ((float*)(p->ws + WS_KC))[((((size_t)kv * 16 + bb) * 2 + gg) * 128 + n) * 64 + lane] = o;
        }
        __syncthreads();
    }
}

__device__ __forceinline__ void hgrn_scan(unsigned char* smem, CP p, int L, int b, int h) {
    float* F = (float*)smem; float* Kx = F + 2048; float* Q = Kx + 2048; float* V = Q + 2048; float* PO = V + 2048;
    const int tid = tid_(), e = tid & 63, wv = tid >> 6, C = h * 64 + e;
    float lb;
    { const float* hl = p->in[I_HGLB]; const float a0 = hl[C], a1 = hl[512 + C], a2 = hl[1024 + C], a3 = hl[1536 + C];
      const float mx = fmaxf(fmaxf(a0, a1), fmaxf(a2, a3)); const float e0 = __expf(a0 - mx), e1 = __expf(a1 - mx), e2 = __expf(a2 - mx), e3 = __expf(a3 - mx);
      const float inv = 1.0f / (e0 + e1 + e2 + e3); float acc = 0.f; if (L >= 1) acc += e1; if (L >= 2) acc += e2; if (L >= 3) acc += e3; lb = fmaxf(acc * inv, 0.f); }
    const float ng = p->in[I_HGN][L * 512 + C];
    bf16_t* base = (bf16_t*)(p->ws + WS_PROJ) + (size_t)b * SEQ * PLD + C;
    f32x2 S0 = {0.f, 0.f}, S1 = {0.f, 0.f}, S2 = {0.f, 0.f}, S3 = {0.f, 0.f};
    bf16_t pz[4], pq[4], pi[4], pg[4];
#define HG_PREFETCH(T0) do { _Pragma("unroll") for (int i = 0; i < 4; ++i) { const bf16_t* row = base + (size_t)((T0) + wv * 4 + i) * PLD; \
        pz[i] = row[C_HF]; pq[i] = row[C_HQ]; pi[i] = row[C_HI]; pg[i] = row[C_HG]; } } while (0)
    HG_PREFETCH(0);
    for (int t0 = 0; t0 < SEQ; t0 += 32) {
        float gr[4];
#pragma unroll
        for (int i = 0; i < 4; ++i) { const int t = wv * 4 + i;
            const float z = bf2f(pz[i]), qr = bf2f(pq[i]), vi = bf2f(pi[i]); gr[i] = bf2f(pg[i]);
            const float sg = sigmoidf_(z); F[t * 64 + e] = sg + lb * (1.0f - sg); Kx[t * 64 + e] = (1.0f - lb) * (1.0f - sg); Q[t * 64 + e] = siluf_(qr); V[t * 64 + e] = vi; }
        __syncthreads();
        if (t0 + 32 < SEQ) HG_PREFETCH(t0 + 32);
#pragma unroll 4
        for (int t = 0; t < 32; ++t) {
            const f32x4 f0 = *(const f32x4*)(F + t * 64 + wv * 8), f1 = *(const f32x4*)(F + t * 64 + wv * 8 + 4);
            const f32x4 k0 = *(const f32x4*)(Kx + t * 64 + wv * 8), k1 = *(const f32x4*)(Kx + t * 64 + wv * 8 + 4);
            const f32x4 q0 = *(const f32x4*)(Q + t * 64 + wv * 8), q1 = *(const f32x4*)(Q + t * 64 + wv * 8 + 4);
            const float v = V[t * 64 + e]; const f32x2 vv = {v, v};
            S0 = (f32x2){f0[0], f0[1]} * S0 + (f32x2){k0[0], k0[1]} * vv; S1 = (f32x2){f0[2], f0[3]} * S1 + (f32x2){k0[2], k0[3]} * vv;
            S2 = (f32x2){f1[0], f1[1]} * S2 + (f32x2){k1[0], k1[1]} * vv; S3 = (f32x2){f1[2], f1[3]} * S3 + (f32x2){k1[2], k1[3]} * vv;
            f32x2 o2 = (f32x2){q0[0], q0[1]} * S0 + (f32x2){q0[2], q0[3]} * S1 + (f32x2){q1[0], q1[1]} * S2 + (f32x2){q1[2], q1[3]} * S3;
            PO[(t * 8 + wv) * 64 + e] = o2[0] + o2[1];
        }
        __syncthreads();
#pragma unroll
        for (int i = 0; i < 4; ++i) { const int t = wv * 4 + i;
            float o = 0.f;
#pragma unroll
            for (int q = 0; q < 8; ++q) o += PO[(t * 8 + q) * 64 + e];
            const float ss = wave_sum(o * o); const float rs = rsqrtf(ss * (1.0f / 64.0f) + 1e-6f);
            base[(size_t)(t0 + t) * PLD + C_HQ] = f2bf(o * rs * ng * siluf_(gr[i])); }
        __syncthreads();
    }
#undef HG_PREFETCH
}

DI float dpp_xor1(float v) { return __int_as_float(__builtin_amdgcn_mov_dpp(__float_as_int(v), 0xB1, 0xF, 0xF, true)); }
DI float dpp_xor2(float v) { return __int_as_float(__builtin_amdgcn_mov_dpp(__float_as_int(v), 0x4E, 0xF, 0xF, true)); }
DI float dpp_hmir(float v) { return __int_as_float(__builtin_amdgcn_mov_dpp(__float_as_int(v), 0x141, 0xF, 0xF, true)); }
DI float red8(float v) { v += dpp_xor1(v); v += dpp_xor2(v); v += dpp_hmir(v); return v; }

__device__ __forceinline__ void rwkv_scan(unsigned char* smem, CP p, int L, int b, int h) {
    constexpr int BUF_F = 6 * 2048 + 64 + 2048;
    const int tid = tid_(), c = tid & 63, wv = tid >> 6, C = h * 64 + c, lane = c;
    const float* mu = p->in[I_MU] + (size_t)L * 1792;
    const float mu_r = mu[C], mu_k = mu[512 + C], mu_v = mu[1024 + C];
    const float w0 = p->in[I_W0][L * 512 + C], a0 = p->in[I_A0][L * 512 + C];
    const float k_k = p->in[I_KK][L * 512 + C], k_a = p->in[I_KA][L * 512 + C], r_k = p->in[I_RK][L * 512 + C], ln_w = p->in[I_LNW][L * 512 + C], ln_b = p->in[I_LNB][L * 512 + C];
    const bf16_t* base = (const bf16_t*)(p->ws + WS_PROJ) + (size_t)b * SEQ * PLD + C_RW + C;
    const bf16_t* ewa = (const bf16_t*)(p->ws + WS_UN) + (size_t)b * SEQ * 1024 + C;
    bf16_t* obase = (bf16_t*)(p->ws + WS_ORW) + (size_t)b * SEQ * 512 + C;
    const int kp = lane & 7, vr = lane >> 3, vrow = wv * 8 + vr;
    f32x2 S0 = {0.f, 0.f}, S1 = {0.f, 0.f}, S2 = {0.f, 0.f}, S3 = {0.f, 0.f};
    bf16_t pr[4], pk[4], pv[4], pe[4], pa[4], pg[4], qr, qk, qv;
#define RW_PREFETCH(T0) do { const int s0_ = (T0) + wv * 4; \
        _Pragma("unroll") for (int i = 0; i < 4; ++i) { const bf16_t* row = base + (size_t)(s0_ + i) * PLD; pr[i] = row[0]; pk[i] = row[512]; pv[i] = row[1024]; \
            pe[i] = ewa[(size_t)(s0_ + i) * 1024]; pa[i] = ewa[(size_t)(s0_ + i) * 1024 + 512]; pg[i] = obase[(size_t)(s0_ + i) * 512]; } \
        if (s0_ > 0) { const bf16_t* row = base + (size_t)(s0_ - 1) * PLD; qr = row[0]; qk = row[512]; qv = row[1024]; } else { qr = 0; qk = 0; qv = 0; } } while (0)
    RW_PREFETCH(0);
    __syncthreads();
    for (int blk = 0; blk < SEQ / 32; ++blk) {
        float* Bf = (float*)smem + (blk & 1) * BUF_F;
        float* Wd = Bf; float* NKK = Bf + 2048; float* AB = Bf + 4096; float* KX = Bf + 6144; float* WR = Bf + 8192; float* VS = Bf + 10240; float* SC = Bf + 12288; float* YS = Bf + 12352;
        float bon[4], gv[4];
        { float rp = bf2f(qr), kq = bf2f(qk), vp = bf2f(qv);
#pragma unroll
          for (int i = 0; i < 4; ++i) { const int t = wv * 4 + i;
              const float r1 = bf2f(pr[i]), k1 = bf2f(pk[i]), v1 = bf2f(pv[i]);
              const float r = r1 + (rp - r1) * mu_r, k = k1 + (kq - k1) * mu_k, v = v1 + (vp - v1) * mu_v; rp = r1; kq = k1; vp = v1;
              const float decay = __expf(-0.6065306597f * sigmoidf_(w0 + bf2f(pe[i]))), a = sigmoidf_(a0 + bf2f(pa[i])); gv[i] = bf2f(pg[i]);
              const float kkv = k * k_k; const float ssq = wave_sum(kkv * kkv); const float kkn = kkv / fmaxf(sqrtf(ssq), 1e-12f);
              const float kx = k * (1.0f + (a - 1.0f) * k_a), ab = kkn * a;
              const float br = wave_sum(ab * r), kr = wave_sum(kx * r); bon[i] = wave_sum(r * kx * r_k);
              Wd[t * 64 + c] = decay; NKK[t * 64 + c] = -kkn; AB[t * 64 + c] = ab; KX[t * 64 + c] = kx; WR[t * 64 + c] = decay * r; VS[t * 64 + c] = v;
              if (c == 0) { SC[t * 2] = br; SC[t * 2 + 1] = kr; } } }
        __syncthreads();
        if (blk + 1 < SEQ / 32) RW_PREFETCH((blk + 1) * 32);
#define RW_LOAD(T, w0v, w1v, n0, n1, b0, b1, x0, x1, q0, q1, vv, sc) do { const int o_ = (T) * 64 + kp * 8; \
            w0v = *(const f32x4*)(Wd + o_); w1v = *(const f32x4*)(Wd + o_ + 4); n0 = *(const f32x4*)(NKK + o_); n1 = *(const f32x4*)(NKK + o_ + 4); \
            b0 = *(const f32x4*)(AB + o_); b1 = *(const f32x4*)(AB + o_ + 4); x0 = *(const f32x4*)(KX + o_); x1 = *(const f32x4*)(KX + o_ + 4); \
            q0 = *(const f32x4*)(WR + o_); q1 = *(const f32x4*)(WR + o_ + 4); vv = VS[(T) * 64 + vrow]; sc = *(const f32x2*)(SC + (T) * 2); } while (0)
        f32x4 cw0, cw1, cn0, cn1, cb0, cb1, cx0, cx1, cq0, cq1; float cvv; f32x2 csc;
        RW_LOAD(0, cw0, cw1, cn0, cn1, cb0, cb1, cx0, cx1, cq0, cq1, cvv, csc);
#pragma nounroll
        for (int t8 = 0; t8 < 4; ++t8) {
            float ykeep = 0.f;
#pragma unroll
            for (int j = 0; j < 8; ++j) {
                const int t = t8 * 8 + j;
                const f32x4 w0v = cw0, w1v = cw1, n0 = cn0, n1 = cn1, b0 = cb0, b1 = cb1, x0 = cx0, x1 = cx1, q0 = cq0, q1 = cq1; const float vv = cvv; const f32x2 sc = csc;
                { const int tn = (t + 1) & 31; RW_LOAD(tn, cw0, cw1, cn0, cn1, cb0, cb1, cx0, cx1, cq0, cq1, cvv, csc); }
                const f32x2 sa2 = S0 * (f32x2){n0[0], n0[1]} + S1 * (f32x2){n0[2], n0[3]} + S2 * (f32x2){n1[0], n1[1]} + S3 * (f32x2){n1[2], n1[3]};
                const f32x2 y2 = S0 * (f32x2){q0[0], q0[1]} + S1 * (f32x2){q0[2], q0[3]} + S2 * (f32x2){q1[0], q1[1]} + S3 * (f32x2){q1[2], q1[3]};
                float sa = sa2[0] + sa2[1], yy = y2[0] + y2[1];
                sa += dpp_xor1(sa); yy += dpp_xor1(yy); sa += dpp_xor2(sa); yy += dpp_xor2(yy); sa += dpp_hmir(sa); yy += dpp_hmir(yy);
                const f32x2 sav = {sa, sa}, vv2 = {vv, vv};
                S0 = S0 * (f32x2){w0v[0], w0v[1]} + sav * (f32x2){b0[0], b0[1]} + vv2 * (f32x2){x0[0], x0[1]};
                S1 = S1 * (f32x2){w0v[2], w0v[3]} + sav * (f32x2){b0[2], b0[3]} + vv2 * (f32x2){x0[2], x0[3]};
                S2 = S2 * (f32x2){w1v[0], w1v[1]} + sav * (f32x2){b1[0], b1[1]} + vv2 * (f32x2){x1[0], x1[1]};
                S3 = S3 * (f32x2){w1v[2], w1v[3]} + sav * (f32x2){b1[2], b1[3]} + vv2 * (f32x2){x1[2], x1[3]};
                const float y = yy + sa * sc[0] + vv * sc[1];
                ykeep = (kp == j) ? y : ykeep;
            }
            YS[(t8 * 8 + kp) * 64 + vrow] = ykeep;
        }
#undef RW_LOAD
        __syncthreads();
#pragma unroll
        for (int i = 0; i < 4; ++i) { const int t = wv * 4 + i;
            const float y = YS[t * 64 + c]; const float mean = wave_sum(y) * (1.0f / 64.0f); const float dlt = y - mean;
            const float var = wave_sum(dlt * dlt) * (1.0f / 64.0f);
            float yn = dlt * rsqrtf(var + 64e-5f) * ln_w + ln_b; yn += bon[i] * VS[t * 64 + c];
            obase[(size_t)(blk * 32 + t) * 512] = f2bf(yn * gv[i]); }
    }
#undef RW_PREFETCH
    __syncthreads();
}

DI int crow16(int i, int hl) { return (i & 3) + 8 * (i >> 2) + 4 * hl; }
__device__ __forceinline__ void rwkv_chunked(unsigned char* smem, CP p, int L, int b, int h) {
    bf16_t* ZB = (bf16_t*)smem;
    bf16_t* AR = (bf16_t*)(smem + 9216);
    bf16_t* BKt = (bf16_t*)(smem + 13824);
    bf16_t* UV = (bf16_t*)(smem + 18944);
    bf16_t* MT1 = (bf16_t*)(smem + 24064);
    bf16_t* MT2 = (bf16_t*)(smem + 25600);
    float* EW = (float*)(smem + 27136);
    bf16_t* BKr = (bf16_t*)(smem + 31232);
    float* Mf = (float*)(smem + 48640);
    float* Gs = (float*)(smem + 52864);
    float* YS = (float*)(smem + 57216);
    float* VS = (float*)(smem + 61312);
    float* PC = (float*)(smem + 65408);
    const int tid = tid_(), c = tid & 63, wv = tid >> 6, C = h * 64 + c, lane = c, qi = lane & 31, hl = lane >> 5;
    const float* mu = p->in[I_MU] + (size_t)L * 1792;
    const float mu_r = mu[C], mu_k = mu[512 + C], mu_v = mu[1024 + C];
    const float w0 = p->in[I_W0][L * 512 + C], a0 = p->in[I_A0][L * 512 + C];
    const float k_k = p->in[I_KK][L * 512 + C], k_a = p->in[I_KA][L * 512 + C], r_k = p->in[I_RK][L * 512 + C], ln_w = p->in[I_LNW][L * 512 + C], ln_b = p->in[I_LNB][L * 512 + C];
    const bf16_t* base = (const bf16_t*)(p->ws + WS_PROJ) + (size_t)b * SEQ * PLD + C_RW + C;
    const bf16_t* ewa = (const bf16_t*)(p->ws + WS_UN) + (size_t)b * SEQ * 1024 + C;
    bf16_t* obase = (bf16_t*)(p->ws + WS_ORW) + (size_t)b * SEQ * 512 + C;
    f32x16 zacc;
#pragma unroll
    for (int i = 0; i < 16; ++i) zacc[i] = 0.f;
    for (int i = tid; i < 64 * 72; i += 512) ZB[i] = 0;
    bf16_t pr[2], pk[2], pv[2], pe[2], pa[2], pg[2], qr, qk, qv;
#define RC_PREFETCH(T0) do { const int s0_ = (T0) + wv * 2; \
        _Pragma("unroll") for (int i = 0; i < 2; ++i) { const bf16_t* row = base + (size_t)(s0_ + i) * PLD; pr[i] = row[0]; pk[i] = row[512]; pv[i] = row[1024]; \
            pe[i] = ewa[(size_t)(s0_ + i) * 1024]; pa[i] = ewa[(size_t)(s0_ + i) * 1024 + 512]; pg[i] = obase[(size_t)(s0_ + i) * 512]; } \
        if (s0_ > 0) { const bf16_t* row = base + (size_t)(s0_ - 1) * PLD; qr = row[0]; qk = row[512]; qv = row[1024]; } else { qr = 0; qk = 0; qv = 0; } } while (0)
    RC_PREFETCH(0);
    __syncthreads();
    for (int ch = 0; ch < SEQ / 16; ++ch) {
        float bon[2], gv[2], r_[2], nk_[2], ab_[2], kx_[2], v_[2], ew_[2];
        { float rp = bf2f(qr), kq = bf2f(qk), vp = bf2f(qv);
#pragma unroll
          for (int i = 0; i < 2; ++i) { const int t = wv * 2 + i;
              const float r1 = bf2f(pr[i]), k1 = bf2f(pk[i]), v1 = bf2f(pv[i]);
              const float r = r1 + (rp - r1) * mu_r, k = k1 + (kq - k1) * mu_k, v = v1 + (vp - v1) * mu_v; rp = r1; kq = k1; vp = v1;
              const float ew = 0.6065306597f * sigmoidf_(w0 + bf2f(pe[i])), a = sigmoidf_(a0 + bf2f(pa[i])); gv[i] = bf2f(pg[i]);
              const float kkv = k * k_k; const float ssq = wave_sum(kkv * kkv); const float kkn = kkv / fmaxf(sqrtf(ssq), 1e-12f);
              const float kx = k * (1.0f + (a - 1.0f) * k_a);
              bon[i] = wave_sum(r * kx * r_k);
              r_[i] = r; nk_[i] = kkn; ab_[i] = kkn * a; kx_[i] = kx; v_[i] = v; ew_[i] = ew; EW[t * 64 + c] = ew; } }
        __syncthreads();
        if (ch + 1 < SEQ / 16) RC_PREFETCH((ch + 1) * 16);
        { float ev[16];
#pragma unroll
          for (int j = 0; j < 16; ++j) ev[j] = EW[j * 64 + c];
#pragma unroll
          for (int i = 0; i < 2; ++i) { const int t = wv * 2 + i; float cum = 0.f;
#pragma unroll
            for (int j = 0; j < 16; ++j) cum += (j <= t) ? ev[j] : 0.f;
            const float Pt = __expf(-cum), Pm = __expf(-(cum - ew_[i])), iP = __expf(cum);
            const float al = -nk_[i] * Pm, rh = r_[i] * Pt, be = ab_[i] * iP, ka = kx_[i] * iP;
            AR[t * 72 + c] = f2bf(al); AR[(16 + t) * 72 + c] = f2bf(rh); BKr[t * 72 + c] = f2bf(be); BKr[(16 + t) * 72 + c] = f2bf(ka);
            BKt[c * 40 + t] = f2bf(be); BKt[c * 40 + 16 + t] = f2bf(ka);
            UV[c * 40 + 16 + t] = f2bf(v_[i]); VS[t * 64 + c] = v_[i];
            if (t == 15) PC[c] = Pt; } }
        __syncthreads();
        f32x16 acc;
#pragma unroll
        for (int i = 0; i < 16; ++i) acc[i] = 0.f;
        if (wv == 0) {
#pragma unroll
            for (int s = 0; s < 4; ++s) acc = MFMA32(*(const bf16x8*)(BKr + qi * 72 + 16 * s + 8 * hl), *(const bf16x8*)(AR + qi * 72 + 16 * s + 8 * hl), acc);
#pragma unroll
            for (int i = 0; i < 16; ++i) { const int j = crow16(i, hl), n = qi; const float m = acc[i];
                if (j < 16) { if (n < 16) Mf[j * 17 + n] = m; MT2[n * 24 + j] = f2bf((n >= 16 && j <= n - 16) ? m : 0.f); }
                else { const int i2 = j - 16; const bool k1 = n < 16 ? (i2 < n) : (i2 <= n - 16); MT1[n * 24 + i2] = f2bf(k1 ? m : 0.f); } }
        } else if (wv < 3) {
            const int vb = wv - 1;
#pragma unroll
            for (int s = 0; s < 4; ++s) acc = MFMA32(*(const bf16x8*)(ZB + (32 * vb + qi) * 72 + 16 * s + 8 * hl), *(const bf16x8*)(AR + qi * 72 + 16 * s + 8 * hl), acc);
        }
        __syncthreads();
        if (wv == 1 || wv == 2) { const int vb = wv - 1;
            acc = MFMA32(*(const bf16x8*)(UV + (32 * vb + qi) * 40 + 16 + 8 * hl), *(const bf16x8*)(MT1 + qi * 24 + 8 * hl), acc);
            if (qi < 16) {
#pragma unroll
                for (int i = 0; i < 16; ++i) Gs[(32 * vb + crow16(i, hl)) * 17 + qi] = acc[i]; }
        }
        __syncthreads();
        if (wv == 0) {
            float u[16];
#pragma unroll
            for (int t = 0; t < 16; ++t) { float x0 = Gs[lane * 17 + t], x1 = 0.f;
#pragma unroll
                for (int i = 0; i < t; ++i) { if (i & 1) x1 += u[i] * Mf[i * 17 + t]; else x0 += u[i] * Mf[i * 17 + t]; }
                u[t] = x0 + x1; UV[lane * 40 + t] = f2bf(u[t]); }
        }
        __syncthreads();
        if (wv == 1 || wv == 2) { const int vb = wv - 1;
            acc = MFMA32(*(const bf16x8*)(UV + (32 * vb + qi) * 40 + 8 * hl), *(const bf16x8*)(MT2 + qi * 24 + 8 * hl), acc);
            if (qi >= 16) {
#pragma unroll
                for (int i = 0; i < 16; ++i) YS[(qi - 16) * 64 + 32 * vb + crow16(i, hl)] = acc[i]; }
        }
        if (wv >= 4) { const int vb = (wv >> 1) & 1, kb = wv & 1;
#pragma unroll
            for (int s = 0; s < 2; ++s) zacc = MFMA32(*(const bf16x8*)(UV + (32 * vb + qi) * 40 + 16 * s + 8 * hl), *(const bf16x8*)(BKt + (32 * kb + qi) * 40 + 16 * s + 8 * hl), zacc);
            const float pc = PC[32 * kb + qi];
#pragma unroll
            for (int i = 0; i < 16; ++i) { zacc[i] *= pc; ZB[(32 * vb + crow16(i, hl)) * 72 + 32 * kb + qi] = f2bf(zacc[i]); }
        }
        __syncthreads();
#pragma unroll
        for (int i = 0; i < 2; ++i) { const int t = wv * 2 + i;
            const float y = YS[t * 64 + c]; const float mean = wave_sum(y) * (1.0f / 64.0f); const float dlt = y - mean;
            const float var = wave_sum(dlt * dlt) * (1.0f / 64.0f);
            float yn = dlt * rsqrtf(var + 64e-5f) * ln_w + ln_b; yn += bon[i] * VS[t * 64 + c];
            obase[(size_t)(ch * 16 + t) * 512] = f2bf(yn * gv[i]); }
        __syncthreads();
    }
#undef RC_PREFETCH
}

constexpr int KTS = 72;
DI bf16x8 pack8(float a0, float a1, float a2, float a3, float a4, float a5, float a6, float a7) {
    u32x4 w; w.x = pack2(a0, a1); w.y = pack2(a2, a3); w.z = pack2(a4, a5); w.w = pack2(a6, a7); return __builtin_bit_cast(bf16x8, w); }
DI bf16x8 ld_vfrag(const bf16_t* vt, int off) { const u32x2 lo = *(const u32x2*)(vt + off), hi = *(const u32x2*)(vt + off + 8); u32x4 w; w.x = lo.x; w.y = lo.y; w.z = hi.x; w.w = hi.y; return __builtin_bit_cast(bf16x8, w); }

struct FlashState { f32x16 o0, o1; float m, l; };

DI void flash_update(FlashState& st, f32x16& sc0, f32x16& sc1, const bf16_t* VT, int vs, int qi, int hl) {
    float mt = -INFINITY;
#pragma unroll
    for (int i = 0; i < 16; ++i) mt = fmaxf(mt, fmaxf(sc0[i], sc1[i]));
    mt = fmaxf(mt, shfl_xor_(mt, 32, qi + 32 * hl));
    const float mnew = fmaxf(st.m, mt), muse = (mnew == -INFINITY) ? 0.f : mnew;
    const float alpha = __builtin_amdgcn_exp2f(st.m - muse);
    float ls = 0.f;
#pragma unroll
    for (int i = 0; i < 16; ++i) { sc0[i] = __builtin_amdgcn_exp2f(sc0[i] - muse); sc1[i] = __builtin_amdgcn_exp2f(sc1[i] - muse); ls += sc0[i] + sc1[i]; }
    st.l = st.l * alpha + ls; st.m = mnew;
    st.o0 *= alpha; st.o1 *= alpha;
#pragma unroll
    for (int s = 0; s < 2; ++s) {
        const bf16x8 p0 = pack8(sc0[8 * s], sc0[8 * s + 1], sc0[8 * s + 2], sc0[8 * s + 3], sc0[8 * s + 4], sc0[8 * s + 5], sc0[8 * s + 6], sc0[8 * s + 7]);
        const bf16x8 p1 = pack8(sc1[8 * s], sc1[8 * s + 1], sc1[8 * s + 2], sc1[8 * s + 3], sc1[8 * s + 4], sc1[8 * s + 5], sc1[8 * s + 6], sc1[8 * s + 7]);
        st.o0 = MFMA32(ld_vfrag(VT, qi * vs + 16 * s + 4 * hl), p0, st.o0);
        st.o1 = MFMA32(ld_vfrag(VT, (32 + qi) * vs + 16 * s + 4 * hl), p0, st.o1);
        st.o0 = MFMA32(ld_vfrag(VT, qi * vs + 32 + 16 * s + 4 * hl), p1, st.o0);
        st.o1 = MFMA32(ld_vfrag(VT, (32 + qi) * vs + 32 + 16 * s + 4 * hl), p1, st.o1);
    }
}
DI void qk_tile(const bf16_t* KT, const bf16x8 (&qf)[4], int qi, int hl, f32x16& sc0, f32x16& sc1) {
#pragma unroll
    for (int i = 0; i < 16; ++i) { sc0[i] = 0.f; sc1[i] = 0.f; }
#pragma unroll
    for (int s = 0; s < 4; ++s) {
        const bf16x8 k0 = *(const bf16x8*)(KT + qi * KTS + 16 * s + 8 * hl), k1 = *(const bf16x8*)(KT + (32 + qi) * KTS + 16 * s + 8 * hl);
        sc0 = MFMA32(k0, qf[s], sc0); sc1 = MFMA32(k1, qf[s], sc1);
    }
}
struct KVRegs { u32x4 k, v; };
DI void kv_fetch(KVRegs& r, const bf16_t* pb, int kcol, int vcol, int k0) {
    const int tid = tid_();
    const unsigned ok_ = (unsigned)((k0 + (tid >> 3)) * PLD + kcol + (tid & 7) * 8) * 2u, ov_ = (unsigned)((k0 + (tid & 63)) * PLD + vcol + (tid >> 6) * 8) * 2u;
    r.k = *(const u32x4*)((const char*)pb + ok_);
    r.v = *(const u32x4*)((const char*)pb + ov_);
}
DI void kv_store(const KVRegs& r, bf16_t* KT, bf16_t* VT) {
    const int tid = tid_();
    *(u32x4*)(KT + (tid >> 3) * KTS + (tid & 7) * 8) = r.k;
    const int key = tid & 63, ch = tid >> 6;
#pragma unroll
    for (int j = 0; j < 8; ++j) VT[(ch * 8 + j) * KTS + key] = (bf16_t)((j & 1) ? (r.v[j >> 1] >> 16) : (r.v[j >> 1] & 0xFFFFu));
}
template <bool LUTB, bool CAUSAL, bool WHI, bool SEL>
DI void mask_tile(f32x16& sc0, f32x16& sc1, const float* lut, int qpos, int k0, int hl, bool sel, float qs) {
    const float bfar = lut[128];
#pragma unroll
    for (int i = 0; i < 16; ++i) { const int kl = (i & 3) + 8 * (i >> 2) + 4 * hl;
        { const int dist = qpos - (k0 + kl); const float v = sc0[i] * qs + (LUTB ? lut[dist > 128 ? 128 : (dist < 0 ? 0 : dist)] : bfar);
          bool ok = true; if (CAUSAL) ok = ok && dist >= 0; if (WHI) ok = ok && dist < 256; if (SEL) ok = ok && sel; sc0[i] = ok ? v : -INFINITY; }
        { const int dist = qpos - (k0 + 32 + kl); const float v = sc1[i] * qs + (LUTB ? lut[dist > 128 ? 128 : (dist < 0 ? 0 : dist)] : bfar);
          bool ok = true; if (CAUSAL) ok = ok && dist >= 0; if (WHI) ok = ok && dist < 256; if (SEL) ok = ok && sel; sc1[i] = ok ? v : -INFINITY; } }
}

__device__ __forceinline__ void nsa_item(unsigned char* smem, CP p, int L, int b, int g, int qb, int ocol) {
    bf16_t* KT = (bf16_t*)smem;
    bf16_t* VT = (bf16_t*)(smem + 9216);
    float* LUT = (float*)(smem + 18432);
    unsigned* SELM = (unsigned*)(smem + 20736);
    unsigned* ORM = (unsigned*)(smem + 20992);
    float* PA = (float*)(smem + 21504);
    float* PBv = (float*)(smem + 54272);
    bf16_t* KT2 = (bf16_t*)(smem + 87040);
    bf16_t* VT2 = (bf16_t*)(smem + 105472);
    const int tid = tid_(), lane = tid & 63, wv = tid >> 6, hh = wv >> 1, qhalf = wv & 1, qi = lane & 31, hl = lane >> 5;
    const int ql = qhalf * 32 + qi, qpos = qb * 64 + ql, head = g * 4 + hh;
    bf16_t* pb = (bf16_t*)(p->ws + WS_PROJ) + (size_t)b * SEQ * PLD;
    bf16_t* qrow = pb + (size_t)qpos * PLD;
    __syncthreads();
    for (int i = tid; i < 4 * 129; i += 512) { const int h2 = i / 129, dd = i % 129; int bk;
        if (dd < 16) bk = dd; else if (dd >= 128) bk = 31; else { bk = 16 + (int)(logf((float)dd / 16.0f) / 2.0794415416798357f * 16.0f); bk = bk > 31 ? 31 : bk; }
        LUT[h2 * 132 + dd] = p->in[I_RELB][bk * 8 + g * 4 + h2] * 1.4426950408889634f; }
    if (tid == 0) *ORM = 0u;
    if (tid < 64) SELM[tid] = 0u;
    if (tid < 256) PBv[tid * 32] = 0.f;
    { const float* kc = (const float*)(p->ws + WS_KC) + ((size_t)(0 * 16 + b) * 2 + g) * 128 * 64; const float* vc = (const float*)(p->ws + WS_KC) + ((size_t)(1 * 16 + b) * 2 + g) * 128 * 64;
      for (int i = tid; i < 128 * 64; i += 512) { const int n = i >> 6, d = i & 63; KT2[n * KTS + d] = f2bf(kc[i]); }
      for (int i = tid; i < 128 * 64; i += 512) { const int n = i & 127, d = i >> 7; VT2[d * 136 + n] = f2bf(vc[n * 64 + d]); } }
    bf16x8 qf[4];
#pragma unroll
    for (int s = 0; s < 4; ++s) qf[s] = *(const bf16x8*)(qrow + C_NQ + head * 64 + 16 * s + 8 * hl);
    float g0, g1, g2;
    { const bf16_t* gp = qrow + C_NG + head * 3; g0 = sigmoidf_(bf2f(gp[0])); g1 = sigmoidf_(bf2f(gp[1])); g2 = sigmoidf_(bf2f(gp[2])); }
    __syncthreads();
    const float* lut = LUT + hh * 132;
    constexpr float QS = 0.125f * 1.4426950408889634f;
    f32x16 fin0, fin1;
    {
        FlashState st;
#pragma unroll
        for (int i = 0; i < 16; ++i) { st.o0[i] = 0.f; st.o1[i] = 0.f; }
        st.m = -INFINITY; st.l = 0.f;
#pragma nounroll
        for (int t = 0; t < 2; ++t) {
            f32x16 sc0, sc1; qk_tile(KT2 + t * 64 * KTS, qf, qi, hl, sc0, sc1);
#pragma unroll
            for (int i = 0; i < 16; ++i) { const int kl = (i & 3) + 8 * (i >> 2) + 4 * hl;
                { const int n = 64 * t + kl, dist = qpos - (16 * n + 31); sc0[i] = (dist >= 0 && n < 127) ? sc0[i] * QS + lut[dist > 128 ? 128 : dist] : -INFINITY; }
                { const int n = 64 * t + 32 + kl, dist = qpos - (16 * n + 31); sc1[i] = (dist >= 0 && n < 127) ? sc1[i] * QS + lut[dist > 128 ? 128 : dist] : -INFINITY; } }
            flash_update(st, sc0, sc1, VT2 + 64 * t, 136, qi, hl);
        }
        const float lt = st.l + shfl_xor_(st.l, 32, lane); const float inv = 1.0f / fmaxf(lt, 1e-30f);
        const float muse = (st.m == -INFINITY) ? 0.f : st.m;
        fin0 = st.o0 * (g0 * inv); fin1 = st.o1 * (g0 * inv);
#pragma nounroll
        for (int t = 0; t < 2; ++t) {
            f32x16 sc0, sc1; qk_tile(KT2 + t * 64 * KTS, qf, qi, hl, sc0, sc1);
#pragma unroll
            for (int i = 0; i < 16; ++i) { const int kl = (i & 3) + 8 * (i >> 2) + 4 * hl;
                { const int n = 64 * t + kl, dist = qpos - (16 * n + 31); sc0[i] = (dist >= 0 && n < 127) ? __builtin_amdgcn_exp2f(sc0[i] * QS + lut[dist > 128 ? 128 : dist] - muse) * inv : 0.f; }
                { const int n = 64 * t + 32 + kl, dist = qpos - (16 * n + 31); sc1[i] = (dist >= 0 && n < 127) ? __builtin_amdgcn_exp2f(sc1[i] * QS + lut[dist > 128 ? 128 : dist] - muse) * inv : 0.f; } }
#pragma unroll
            for (int i4 = 0; i4 < 4; ++i4) {
                { const int m = 16 * t + 2 * i4 + hl; PA[(hh * 64 + ql) * 32 + m] = sc0[4 * i4] + sc0[4 * i4 + 1] + sc0[4 * i4 + 2] + sc0[4 * i4 + 3]; PBv[(hh * 64 + ql) * 32 + m + 1] = sc0[4 * i4 + 3]; }
                { const int m = 16 * t + 8 + 2 * i4 + hl; PA[(hh * 64 + ql) * 32 + m] = sc1[4 * i4] + sc1[4 * i4 + 1] + sc1[4 * i4 + 2] + sc1[4 * i4 + 3]; if (m + 1 < 32) PBv[(hh * 64 + ql) * 32 + m + 1] = sc1[4 * i4 + 3]; }
            }
        }
    }
    __syncthreads();
    {
        float* IMP = (float*)smem;
        const int q = tid & 63, part = tid >> 6, cur = qb;
#pragma unroll
        for (int mm = 0; mm < 4; ++mm) { const int m = part * 4 + mm; float v;
            if (m == 0 || m == cur || m == cur - 1) v = INFINITY;
            else if (m <= cur) { v = 0.f; for (int h2 = 0; h2 < 4; ++h2) v += PA[(h2 * 64 + q) * 32 + m] + PBv[(h2 * 64 + q) * 32 + m]; }
            else v = -INFINITY;
            IMP[q * 33 + m] = v; }
        __syncthreads();
        unsigned bits = 0u;
#pragma unroll
        for (int mm = 0; mm < 4; ++mm) { const int m = part * 4 + mm; const float v = IMP[q * 33 + m]; int rank = 0;
            for (int m2 = 0; m2 < 32; ++m2) { const float v2 = IMP[q * 33 + m2]; rank += (v2 > v || (v2 == v && m2 < m)) ? 1 : 0; }
            if (rank < 8 && v > -INFINITY) bits |= 1u << m; }
        atomicOr(&SELM[q], bits); atomicOr(ORM, bits);
    }
    __syncthreads();
    const unsigned mysel = SELM[ql], orm = *ORM;
    __syncthreads();
    float* PARK = PA + (wv * 32) * 64 + lane;
#pragma unroll
    for (int i = 0; i < 16; ++i) { PARK[i * 64] = fin0[i]; PARK[(16 + i) * 64] = fin1[i]; }
    {
        FlashState st;
#pragma unroll
        for (int i = 0; i < 16; ++i) { st.o0[i] = 0.f; st.o1[i] = 0.f; }
        st.m = -INFINITY; st.l = 0.f;
        const unsigned todo = orm & (qb >= 31 ? 0xFFFFFFFFu : ((2u << qb) - 1u));
        KVRegs kr;
        int m = todo ? __builtin_ctz(todo) : -1;
        if (m >= 0) { kv_fetch(kr, pb, C_KS + g * 64, C_VS + g * 64, m * 64); __syncthreads(); kv_store(kr, KT, VT); __syncthreads(); }
        while (m >= 0) {
            const unsigned rest = todo & ~((2u << m) - 1u); const int nm = (m < 31 && rest) ? __builtin_ctz(rest) : -1;
            if (nm >= 0) kv_fetch(kr, pb, C_KS + g * 64, C_VS + g * 64, nm * 64);
            const bool sel = (mysel >> m) & 1u;
            if (__builtin_amdgcn_ballot_w64(sel) != 0ull) {
                f32x16 sc0, sc1; qk_tile(KT, qf, qi, hl, sc0, sc1);
                if (m + 3 <= qb) mask_tile<false, false, false, true>(sc0, sc1, lut, qpos, m * 64, hl, sel, QS);
                else mask_tile<true, true, false, true>(sc0, sc1, lut, qpos, m * 64, hl, sel, QS);
                flash_update(st, sc0, sc1, VT, KTS, qi, hl);
            }
            __syncthreads();
            if (nm >= 0) kv_store(kr, KT, VT);
            __syncthreads();
            m = nm;
        }
        const float lt = st.l + shfl_xor_(st.l, 32, lane); const float sc = g1 / fmaxf(lt, 1e-30f);
#pragma unroll
        for (int i = 0; i < 16; ++i) { PARK[i * 64] += st.o0[i] * sc; PARK[(16 + i) * 64] += st.o1[i] * sc; }
    }
    {
        FlashState st;
#pragma unroll
        for (int i = 0; i < 16; ++i) { st.o0[i] = 0.f; st.o1[i] = 0.f; }
        st.m = -INFINITY; st.l = 0.f;
        KVRegs kr;
        int w = qb >= 4 ? 0 : 4 - qb;
        kv_fetch(kr, pb, C_KW + g * 64, C_VW + g * 64, qb * 64 - 256 + 64 * w); __syncthreads(); kv_store(kr, KT, VT); __syncthreads();
        for (; w < 5; ++w) {
            const int k0 = qb * 64 - 256 + 64 * w;
            if (w < 4) kv_fetch(kr, pb, C_KW + g * 64, C_VW + g * 64, k0 + 64);
            f32x16 sc0, sc1; qk_tile(KT, qf, qi, hl, sc0, sc1);
            if (w == 0) mask_tile<false, false, true, false>(sc0, sc1, lut, qpos, k0, hl, true, QS);
            else if (w == 1) mask_tile<false, false, false, false>(sc0, sc1, lut, qpos, k0, hl, true, QS);
            else if (w < 4) mask_tile<true, false, false, false>(sc0, sc1, lut, qpos, k0, hl, true, QS);
            else mask_tile<true, true, false, false>(sc0, sc1, lut, qpos, k0, hl, true, QS);
            flash_update(st, sc0, sc1, VT, KTS, qi, hl);
            __syncthreads();
            if (w < 4) kv_store(kr, KT, VT);
            __syncthreads();
        }
        const float lt = st.l + shfl_xor_(st.l, 32, lane); const float sc = g2 / fmaxf(lt, 1e-30f);
#pragma unroll
        for (int i = 0; i < 16; ++i) { fin0[i] = PARK[i * 64] + st.o0[i] * sc; fin1[i] = PARK[(16 + i) * 64] + st.o1[i] * sc; }
    }
#pragma unroll
    for (int i4 = 0; i4 < 4; ++i4) {
        u32x2 w0; w0.x = pack2(fin0[4 * i4], fin0[4 * i4 + 1]); w0.y = pack2(fin0[4 * i4 + 2], fin0[4 * i4 + 3]);
        u32x2 w1; w1.x = pack2(fin1[4 * i4], fin1[4 * i4 + 1]); w1.y = pack2(fin1[4 * i4 + 2], fin1[4 * i4 + 3]);
        *(u32x2*)(qrow + ocol + head * 64 + 8 * i4 + 4 * hl) = w0;
        *(u32x2*)(qrow + ocol + head * 64 + 32 + 8 * i4 + 4 * hl) = w1;
    }
}

constexpr int PH_PER_LAYER = 15, PH_TOTAL = DEPTH * PH_PER_LAYER + 1;
enum { S_PREP = 0, S_GU1, S_D1, S_NORM_MIX, S_WIN, S_CMP, S_LORA, S_SCAN, S_MERGE, S_OUT, S_NORM2, S_GU2, S_D2, S_NORM_PLE, S_PLEG, S_FINAL };

__device__ __forceinline__ void run_phase(unsigned char* smem, CP p, int ph) {
    const bool fin = (ph == DEPTH * PH_PER_LAYER);
    const int L = fin ? 0 : ph / PH_PER_LAYER; const int sub = fin ? S_FINAL : ph % PH_PER_LAYER;
    unsigned char* ws = p->ws; float* H = p->out;
    bf16_t* W = (bf16_t*)(ws + WS_WBF); bf16_t* UN = (bf16_t*)(ws + WS_UN); bf16_t* PROJ = (bf16_t*)(ws + WS_PROJ); bf16_t* ACT = (bf16_t*)(ws + WS_ACT);
    bf16_t* TMP = (bf16_t*)(ws + WS_TMP); bf16_t* PBF = (bf16_t*)(ws + WS_PB); bf16_t* ORW = (bf16_t*)(ws + WS_ORW);
    bf16_t* XK = (bf16_t*)(ws + WS_XK); bf16_t* XV = (bf16_t*)(ws + WS_XV); float* P01 = (float*)(ws + WS_P01);
    if (sub == S_PREP) convert_layer_weights(smem, p, L);
    if (sub == S_NORM_MIX) convert_ffn2_weights(smem, p, L);
    if (sub == S_NORM2) cvt_f32_bf16(p->in[I_P] + (size_t)L * T_TOK * 256, PBF, (size_t)T_TOK * 256 / 4);
    if (sub == S_CMP) lora_act(p, L);
    if (sub == S_LORA) finalize_cmp(smem, p, L);
    if (sub == S_NORM_PLE) { EpiBf16 e; e.O = TMP; run_gemm(smem, PBF, 256, W + E_PW, T_TOK, DM, 256, e); }
    if (sub == S_PREP || sub == S_NORM_MIX || sub == S_NORM2 || sub == S_NORM_PLE || sub == S_FINAL) {
        const float* hin = (sub == S_PREP && L == 0) ? p->in[I_X] : H; float* hcopy = (sub == S_PREP && L == 0) ? H : nullptr;
        const float* g = sub == S_PREP ? p->in[I_F1N] + L * DM : sub == S_NORM_MIX ? p->in[I_MIXN] + L * DM : sub == S_NORM2 ? p->in[I_F2N] + L * DM : sub == S_NORM_PLE ? p->in[I_PLEN] + L * DM : p->in[I_FINN];
        rmsnorm_rows(hin, hcopy, g, sub == S_FINAL ? nullptr : UN, sub == S_FINAL ? H : nullptr);
    } else if (sub == S_GU1 || sub == S_GU2) {
        EpiSwiglu e; e.O = ACT; run_gemm(smem, UN, DM, W + (sub == S_GU1 ? E_GU1 : E_GU2), T_TOK, 2 * DFF, DM, e);
    } else if (sub == S_D1 || sub == S_D2 || sub == S_OUT) {
        EpiResid e; e.H = H; e.scale = sub == S_OUT ? 1.0f : 0.5f;
        run_gemm(smem, sub == S_OUT ? UN : ACT, sub == S_OUT ? DM : DFF, W + (sub == S_D1 ? E_D1 : sub == S_D2 ? E_D2 : E_OUT), T_TOK, DM, sub == S_OUT ? DM : DFF, e);
    } else if (sub == S_WIN) {
        EpiProj e; e.O = PROJ; e.XK = XK; e.XV = XV; run_gemm(smem, UN, DM, W + E_IN, T_TOK, PLD, DM, e);
    } else if (sub == S_CMP) {
#pragma nounroll
        for (int kv = 0; kv < 2; ++kv) { EpiF32 e; e.C = P01 + (size_t)kv * 4096 * 256;
            run_gemm(smem, kv ? XV : XK, 1024, W + E_C1 + (size_t)kv * 256 * 1024, 4096, 256, 1024, e); }
    } else if (sub == S_LORA) {
        EpiLora e; e.EWA = UN; e.G = ORW;
        run_gemm(smem, (const bf16_t*)(ws + WS_LACT), 256, W + E_LORA, T_TOK, 1536, 256, e);
    } else if (sub == S_SCAN) {
        for (int item = bid_(); item < 256; item += gridDim.x) {
            __syncthreads();
            if (item < 128) rwkv_chunked(smem, p, L, item >> 3, item & 7); else hgrn_scan(smem, p, L, (item - 128) >> 3, (item - 128) & 7);
        }
        unsigned* ctr = (unsigned*)(ws + 14336) + L * 64;
        volatile unsigned* slot = (volatile unsigned*)(smem + 141 * 1024);
        for (;;) {
            __syncthreads();
            if (tid_() == 0) *slot = __hip_atomic_fetch_add(ctr, 1u, __ATOMIC_RELAXED, __HIP_MEMORY_SCOPE_AGENT);
            __syncthreads();
            const unsigned idx = *slot;
            if (idx >= 1024u) break;
            const int bg = idx & 31, qb = 31 - (int)(idx >> 5);
            nsa_item(smem, p, L, bg >> 1, bg & 1, qb, C_NQ);
        }
    } else if (sub == S_MERGE) {
#pragma nounroll
        for (int j = 0; j < 3; ++j) { EpiMerge e; e.MRG = UN; e.PROJ = PROJ; e.J = j;
            const bf16_t* A = j == 0 ? PROJ + C_HQ : (j == 1 ? PROJ + C_NQ : ORW);
            run_gemm(smem, A, j == 2 ? 512 : PLD, W + E_BR + (size_t)j * 1024 * 512, T_TOK, DM, 512, e); }
    } else if (sub == S_PLEG) {
        EpiPleGate e; e.H = H; e.TMP = TMP; run_gemm(smem, UN, DM, W + E_PG, T_TOK, DM, DM, e);
    }
}

#define XB_TMO      128
#define XB_XCNT(j)  (256  + 64 * (j))
#define XB_XSUB(j)  (1280 + 64 * (j))
#define XB_XGEN(j)  (2304 + 64 * (j))
#define XB_TOP      3328
#define XB_TOPGEN   3392
#define XCD_BAR_WORDS 3456
#define XB_SPIN_CAP (1u << 20)
DI unsigned xb_ld(unsigned* p)              { return __hip_atomic_load(p, __ATOMIC_RELAXED, __HIP_MEMORY_SCOPE_AGENT); }
DI unsigned xb_add(unsigned* p, unsigned v) { return __hip_atomic_fetch_add(p, v, __ATOMIC_RELAXED, __HIP_MEMORY_SCOPE_AGENT); }
DI unsigned xb_xcc_id() { return (unsigned)__builtin_amdgcn_s_getreg((3 << 11) | 20) & 0xFu; }
#define XB_SPIN(cond, bar) do { unsigned _sp = 0; while (cond) { __builtin_amdgcn_s_sleep(1); \
    if ((++_sp & 255u) == 0u) { if (xb_ld(&(bar)[XB_TMO])) break; if (_sp > XB_SPIN_CAP) { atomicAdd(&(bar)[XB_TMO], 1u); break; } } } } while (0)
struct XcdBarrier { unsigned* bar; unsigned x; volatile LAS unsigned* st; };
DI XcdBarrier xcd_barrier_post(unsigned* bar, volatile LAS unsigned* st) {
    XcdBarrier b; b.bar = bar; b.x = xb_xcc_id(); b.st = st;
    if (threadIdx.x == 0) (void)xb_add(&bar[XB_XCNT(b.x)], 1u);
    return b;
}
DI void xcd_barrier_complete(unsigned* bar, unsigned x, unsigned& nloc, unsigned& nx) {
    const unsigned G = gridDim.x * gridDim.y * gridDim.z;
    unsigned sum, cnt, mine, sp = 0u;
    for (;;) {
        sum = 0u; cnt = 0u; mine = 0u;
#pragma unroll
        for (unsigned j = 0; j < 16; ++j) { const unsigned c = xb_ld(&bar[XB_XCNT(j)]); sum += c; cnt += (c > 0u) ? 1u : 0u; mine = (j == x) ? c : mine; }
        if (sum == G) break;
        __builtin_amdgcn_s_sleep(1);
        if ((++sp & 255u) == 0u) { if (xb_ld(&bar[XB_TMO])) break; if (sp > XB_SPIN_CAP) { atomicAdd(&bar[XB_TMO], 1u); break; } }
    }
    nloc = mine > 0u ? mine : 1u; nx = cnt > 0u ? cnt : 1u;
}
DI void xcd_barrier(const XcdBarrier& b) {
    asm volatile("s_waitcnt vmcnt(0)" ::: "memory");
    __syncthreads();
    if (threadIdx.x == 0) {
        unsigned* bar = b.bar;
        __builtin_amdgcn_s_waitcnt(0);
        unsigned nloc = b.st[0], nx = b.st[1];
        if (nloc == 0u) { xcd_barrier_complete(bar, b.x, nloc, nx); b.st[0] = nloc; b.st[1] = nx; }
        const unsigned old = xb_add(&bar[XB_XSUB(b.x)], 1u);
        const unsigned gen = old / nloc;
        if (old + 1u == (gen + 1u) * nloc) {
            __builtin_amdgcn_fence(__ATOMIC_RELEASE, "agent");
            asm volatile("s_waitcnt vmcnt(0)" ::: "memory");
            const unsigned og = xb_add(&bar[XB_TOP], 1u);
            const unsigned tg = og / nx;
            if (og + 1u == (tg + 1u) * nx) xb_add(&bar[XB_TOPGEN], 1u);
            else XB_SPIN(xb_ld(&bar[XB_TOPGEN]) == tg, bar);
            __builtin_amdgcn_fence(__ATOMIC_ACQUIRE, "agent");
            xb_add(&bar[XB_XGEN(b.x)], 1u);
            asm volatile("s_waitcnt vmcnt(0)" ::: "memory");
        } else {
            XB_SPIN(xb_ld(&bar[XB_XGEN(b.x)]) == gen, bar);
            __builtin_amdgcn_fence(__ATOMIC_ACQUIRE, "agent");
            asm volatile("s_waitcnt vmcnt(0)" ::: "memory");
        }
    }
    __syncthreads();
}

__global__ void __launch_bounds__(512, 2) mega_fwd(Params p) {
    extern __shared__ __attribute__((aligned(16))) unsigned char smem[];
    cg::grid_group grid = cg::this_grid();
    volatile LAS unsigned* xst = (volatile LAS unsigned*)(LAS unsigned char*)(smem + 140 * 1024);
    if (threadIdx.x == 0) { xst[0] = 0u; xst[1] = 0u; }
    __syncthreads();
    const XcdBarrier xb = xcd_barrier_post((unsigned*)(p.ws + WS_BAR), xst);
#ifndef PROBE_DUP
#define PROBE_DUP -1
#endif
    constexpr int IT_PER_LAYER = PH_PER_LAYER + (PROBE_DUP >= 0 ? 1 : 0);
    const int it_lo = p.ph_lo, it_hi = PROBE_DUP >= 0 ? DEPTH * IT_PER_LAYER + 1 : p.ph_hi;
    for (int it = it_lo; it < it_hi; ++it) {
        int ph = it;
        if (PROBE_DUP >= 0) { const int l_ = it / IT_PER_LAYER, r_ = it % IT_PER_LAYER; ph = l_ * PH_PER_LAYER + (r_ <= PROBE_DUP ? r_ : r_ - 1); }
        CP pp = (CP)__builtin_amdgcn_kernarg_segment_ptr(); asm volatile("" : "+s"(pp));
        run_phase(smem, pp, ph);
        if (it + 1 < it_hi) {
            if (it == it_lo) grid.sync();
            else xcd_barrier(xb);
        }
    }
}

#ifndef MULTI_LAUNCH
#define MULTI_LAUNCH 0
#endif

extern "C" void kernel_launch(void* const* d_in, const int* in_sizes, int n_in, void* d_out, int out_size, void* d_ws, size_t ws_size, hipStream_t stream) {
    static int grid = 0;
    if (grid == 0) {
        if (n_in != N_INPUTS || out_size != T_TOK * DM || ws_size < WS_END) { fprintf(stderr, "kernel_launch: unexpected shapes: n_in %d out %d ws %zu (need %zu)\n", n_in, out_size, ws_size, (size_t)WS_END); grid = -1; return; }
        int dev = 0, cus = 0, per_cu = 0;
        (void)hipGetDevice(&dev); (void)hipDeviceGetAttribute(&cus, hipDeviceAttributeMultiprocessorCount, dev);
        if (hipFuncSetAttribute((const void*)mega_fwd, hipFuncAttributeMaxDynamicSharedMemorySize, LDS_BYTES) != hipSuccess) { fprintf(stderr, "kernel_launch: hipFuncSetAttribute failed\n"); grid = -1; return; }
        if (hipOccupancyMaxActiveBlocksPerMultiprocessor(&per_cu, (const void*)mega_fwd, 512, LDS_BYTES) != hipSuccess || per_cu < 1) { fprintf(stderr, "kernel_launch: occupancy query gives %d\n", per_cu); per_cu = 1; }
        (void)hipGetLastError();
        grid = cus * 1;
        if (grid > 256) grid = 256;
        fprintf(stderr, "kernel_launch: grid %d (cus %d, per_cu %d)\n", grid, cus, per_cu);
    }
    if (grid < 0) return;
    (void)hipMemsetAsync(d_ws, 0, 16384, stream);
    Params p{};
    for (int i = 0; i < N_INPUTS; ++i) p.in[i] = (const float*)d_in[i];
    p.out = (float*)d_out; p.ws = (unsigned char*)d_ws;
#if MULTI_LAUNCH
    for (int ph = 0; ph < PH_TOTAL; ++ph) { p.ph_lo = ph; p.ph_hi = ph + 1; hipLaunchKernelGGL(mega_fwd, dim3(grid), dim3(512), LDS_BYTES, stream, p); }
#else
    p.ph_lo = 0; p.ph_hi = PH_TOTAL;
    void* args[] = {&p};
    hipError_t e = hipLaunchCooperativeKernel((const void*)mega_fwd, dim3(grid), dim3(512), args, LDS_BYTES, stream);
    if (e != hipSuccess) fprintf(stderr, "kernel_launch: cooperative launch failed: %s\n", hipGetErrorString(e));
#endif
}
```

```cpp
#include <hip/hip_runtime.h>
#include <hip/hip_cooperative_groups.h>
#include <cstdio>
namespace cg = cooperative_groups;

#define LAS __attribute__((address_space(3)))
#define DI __device__ __forceinline__
typedef unsigned short bf16_t;
typedef short bf16x8 __attribute__((ext_vector_type(8)));
typedef float f32x4 __attribute__((ext_vector_type(4)));
typedef float f32x2 __attribute__((ext_vector_type(2)));
typedef float f32x16 __attribute__((ext_vector_type(16)));
typedef unsigned u32x4 __attribute__((ext_vector_type(4)));
typedef unsigned u32x2 __attribute__((ext_vector_type(2)));

constexpr int T_TOK = 32768, SEQ = 2048, NB = 16, DM = 1024, DFF = 2816, DEPTH = 4;
constexpr int PLD = 8448;
constexpr int C_HQ = 0, C_HF = 512, C_HI = 1024, C_HG = 1536, C_NQ = 2048, C_KC = 2560, C_VC = 2688, C_KS = 2816, C_VS = 2944,
              C_KW = 3072, C_VW = 3200, C_RW = 3328, C_MG = 5120, C_NG = 8192, N_WIN = 8192, IN_COLS = 8216;
enum { I_X = 0, I_P, I_F1N, I_F1GU, I_F1D, I_MIXN, I_WIN, I_HGLB, I_HGN, I_PE, I_CW1, I_CW2, I_RELB, I_MU, I_W0, I_WB, I_A0, I_AB, I_GB,
       I_KK, I_KA, I_RK, I_LNW, I_LNB, I_WBR, I_WOUT, I_F2N, I_F2GU, I_F2D, I_PLEN, I_PLEG, I_PLEW, I_FINN, N_INPUTS };

constexpr size_t WS_BAR = 0;
constexpr size_t WS_PEB = 16384;
constexpr size_t WS_WBF = 20480;
constexpr size_t E_GU1 = 0, E_D1 = E_GU1 + 5632ull * 1024, E_IN = E_D1 + 1024ull * 2816, E_BR = E_IN + 8448ull * 1024, E_OUT = E_BR + 3ull * 1024 * 512,
                 E_GU2 = E_GU1, E_D2 = E_D1  , E_PG = E_OUT + 1024ull * 1024, E_PW = E_PG + 1024ull * 1024,
                 E_C1 = E_PW + 1024ull * 256, E_LORA = E_C1 + 2ull * 256 * 1024, E_NG = E_LORA + 1536ull * 256, E_END = E_NG + 256ull * 1024;
constexpr size_t WS_UN = WS_WBF + E_END * 2;
constexpr size_t WS_ORW = WS_UN + (size_t)T_TOK * 1024 * 2;
constexpr size_t WS_XK = WS_ORW + (size_t)T_TOK * 512 * 2;
constexpr size_t WS_XV = WS_XK + 4096ull * 1024 * 2;
constexpr size_t WS_P01 = WS_XV + 4096ull * 1024 * 2;
constexpr size_t WS_KC = WS_P01 + 2ull * 4096 * 256 * 4;
constexpr size_t WS_LACT = WS_KC + 2ull * 16 * 2 * 128 * 64 * 4;
constexpr size_t WS_PROJ = WS_LACT + (size_t)T_TOK * 256 * 2;
constexpr size_t WS_END = WS_PROJ + (size_t)T_TOK * PLD * 2;
constexpr size_t WS_ACT = WS_PROJ;
constexpr size_t WS_PB = WS_PROJ + 200ull * 1024 * 1024;
constexpr size_t WS_TMP = WS_PROJ + 256ull * 1024 * 1024;
constexpr int LDS_BYTES = 144 * 1024;

struct Params {
    const float* in[N_INPUTS];
    float* out;
    unsigned char* ws;
    int ph_lo, ph_hi;
};
typedef const Params __attribute__((address_space(4)))* CP;

DI int tid_() { int t = threadIdx.x; asm volatile("" : "+v"(t)); return t; }
DI int bid_() { int b = blockIdx.x; asm volatile("" : "+s"(b)); return b; }
typedef __bf16 bf16v2 __attribute__((ext_vector_type(2)));
DI float bf2f(bf16_t b) { return __uint_as_float(((unsigned)b) << 16); }
DI unsigned pack2(float lo, float hi) { const f32x2 v = {lo, hi}; return __builtin_bit_cast(unsigned, __builtin_convertvector(v, bf16v2)); }
DI bf16_t f2bf(float f) { return (bf16_t)(pack2(f, 0.f) & 0xFFFFu); }
DI float sigmoidf_(float x) { return __builtin_amdgcn_rcpf(1.0f + __builtin_amdgcn_exp2f(-1.4426950408889634f * x)); }
DI float siluf_(float x) { return x * __builtin_amdgcn_rcpf(1.0f + __builtin_amdgcn_exp2f(-1.4426950408889634f * x)); }
DI float shfl_xor_(float v, int mask, int lane) { return __int_as_float(__builtin_amdgcn_ds_bpermute((lane ^ mask) << 2, __float_as_int(v))); }
DI float dppf_(float v, int) { return v; }
#define DPPF(v, ctrl) __int_as_float(__builtin_amdgcn_mov_dpp(__float_as_int(v), ctrl, 0xF, 0xF, true))
DI float wave_sum(float v) {
    v += DPPF(v, 0xB1); v += DPPF(v, 0x4E); v += DPPF(v, 0x141); v += DPPF(v, 0x140);
    const float s0 = __int_as_float(__builtin_amdgcn_readlane(__float_as_int(v), 0)), s1 = __int_as_float(__builtin_amdgcn_readlane(__float_as_int(v), 16));
    const float s2 = __int_as_float(__builtin_amdgcn_readlane(__float_as_int(v), 32)), s3 = __int_as_float(__builtin_amdgcn_readlane(__float_as_int(v), 48));
    return (s0 + s1) + (s2 + s3);
}

#define MFMA32(a, b, c) __builtin_amdgcn_mfma_f32_32x32x16_bf16((a), (b), (c), 0, 0, 0)
namespace pg8 {
constexpr int BM = 256, BK = 64, HALF = 128, HTB = HALF * BK * 2, STAGE_BYTES = 8 * HTB, NXCD = 8, WGM = 8;
DI int lds_byte(int r, int c) { const int st = (r >> 4) * 2 + (c >> 5), rr = r & 15, cc = c & 31, ob = rr * 64 + cc * 2; return st * 1024 + (ob ^ (((ob >> 9) & 1) << 5)); }
DI void stage_rc(int b, int& R, int& C) { const int st = b / 1024, sb = b % 1024, swz = sb ^ (((sb >> 9) & 1) << 5); R = (st >> 1) * 16 + swz / 64; C = (st & 1) * 32 + (swz % 64) / 2; }
DI int perm32(int rho) { const int n = rho >> 4, i = rho & 15; return 8 * (i >> 2) + 4 * n + (i & 3); }
struct Unit { int pm, pn; };
struct Gemm { const bf16_t* A; const bf16_t* Bt; int M, N, K, lda; };
struct StaticOrder {
    int nM, nN, nwg, G, c;
    DI void init(int M, int N, int G_, int c_) { nM = M / BM; nN = N / BM; nwg = nM * nN; G = G_; c = c_; }
    DI bool next(int i, Unit& u) const {
        const long L = (long)i * G + c; if (L >= nwg) return false;
        int wgid = (int)L; { const int q = nwg / NXCD, r = nwg % NXCD, xcd = wgid % NXCD, off = wgid / NXCD; wgid = (xcd < r ? xcd * (q + 1) : r * (q + 1) + (xcd - r) * q) + off; }
        const int nig = WGM * nN, gid = wgid / nig, fm = gid * WGM, gsz = (nM - fm) < WGM ? (nM - fm) : WGM;
        u.pm = fm + ((wgid % nig) % gsz); u.pn = (wgid % nig) / gsz; return true;
    }
};

template <class Epi>
DI void gemm_phase(LAS unsigned char* lds, const Gemm g, const StaticOrder& S, const Epi& E) {
    int tid = tid_();
    const int wid = __builtin_amdgcn_readfirstlane(tid >> 6), lane = tid & 63, wr = wid >> 2, wc = wid & 3, fr = lane & 15, fq = lane >> 4;
    const int K = g.K, nt = K / BK, lda = g.lda;
    unsigned voffA[2], voffB[2];
#pragma unroll
    for (int i = 0; i < 2; ++i) { int R, C; stage_rc(tid * 16 + i * 8192, R, C); const int Rb = Epi::PERM ? ((R & ~31) + perm32(R & 31)) : R;
        voffA[i] = (unsigned)(R * lda + C) * 2u; voffB[i] = (unsigned)(Rb * K + C) * 2u; }
    const size_t kstep = (size_t)(BK * 2);
    const size_t hstepA = (size_t)HALF * lda * 2, hstepB = (size_t)HALF * K * 2;
    const size_t tstepA = 2 * hstepA, tstepB = 2 * hstepB;
    const unsigned ldsw = (unsigned)wid * 1024u;
    const int aoff = lds_byte(wr * 64 + fr, fq * 8), boff = lds_byte(wc * 32 + fr, fq * 8);
#define PG8_SA(b, h) (((b) * 2 + (h)) * HTB)
#define PG8_SB(b, h) ((4 + (b) * 2 + (h)) * HTB)
#define PG8_STAGE(bufoff, gbase, voff) do { _Pragma("unroll") for (int _i = 0; _i < 2; ++_i) \
        __builtin_amdgcn_global_load_lds((const unsigned*)((const char*)(gbase) + (voff)[_i]), (LAS unsigned*)(lds + (bufoff) + ldsw + _i * 8192), 16, 0, 0); } while (0)
#define PG8_LDA(dst, b, h) do { _Pragma("unroll") for (int m = 0; m < 4; ++m) _Pragma("unroll") for (int k = 0; k < 2; ++k) dst[m][k] = *(const LAS bf16x8*)(lds + PG8_SA(b, h) + aoff + m * 2048 + k * 1024); } while (0)
#define PG8_LDB(dst, b, h) do { _Pragma("unroll") for (int n = 0; n < 2; ++n) _Pragma("unroll") for (int k = 0; k < 2; ++k) dst[n][k] = *(const LAS bf16x8*)(lds + PG8_SB(b, h) + boff + n * 2048 + k * 1024); } while (0)
#define PG8_MMA(ai, bj, At, Bt) do { __builtin_amdgcn_s_setprio(1); _Pragma("unroll") for (int m = 0; m < 4; ++m) _Pragma("unroll") for (int n = 0; n < 2; ++n) _Pragma("unroll") for (int k = 0; k < 2; ++k) \
        acc[ai][bj][m][n] = __builtin_amdgcn_mfma_f32_16x16x32_bf16(Bt[n][k], At[m][k], acc[ai][bj][m][n], 0, 0, 0); __builtin_amdgcn_s_setprio(0); } while (0)
#define PG8_WAIT_V(n) asm volatile("s_waitcnt vmcnt(" #n ")" ::: "memory")
#define PG8_WAIT_L(n) asm volatile("s_waitcnt lgkmcnt(" #n ")" ::: "memory")
#define PG8_BAR __builtin_amdgcn_s_barrier()
#define PG8_SCHED __builtin_amdgcn_sched_barrier(0)
    Unit cur, nxt; int ui = 0;
    if (!S.next(0, cur)) return;
    f32x4 acc[2][2][4][2];
#pragma unroll
    for (int a = 0; a < 2; ++a)
#pragma unroll
        for (int b = 0; b < 2; ++b)
#pragma unroll
            for (int m = 0; m < 4; ++m)
#pragma unroll
                for (int n = 0; n < 2; ++n) acc[a][b][m][n] = (f32x4){0.f, 0.f, 0.f, 0.f};
    bf16x8 At[4][2], B0[2][2], B1[2][2];
    const char* cA = (const char*)g.A + (size_t)cur.pm * tstepA; const char* cB = (const char*)g.Bt + (size_t)cur.pn * tstepB;
    PG8_STAGE(PG8_SB(0, 0), cB, voffB); PG8_STAGE(PG8_SA(0, 0), cA, voffA); PG8_STAGE(PG8_SB(0, 1), cB + hstepB, voffB); PG8_STAGE(PG8_SA(0, 1), cA + hstepA, voffA);
    if (wr == 1) PG8_BAR;
    PG8_WAIT_V(4); PG8_BAR;
    PG8_STAGE(PG8_SB(1, 0), cB + kstep, voffB); PG8_STAGE(PG8_SA(1, 0), cA + kstep, voffA); PG8_STAGE(PG8_SB(1, 1), cB + hstepB + kstep, voffB);
    PG8_WAIT_V(6); PG8_BAR;
    for (;;) {
        const bool has_next = S.next(ui + 1, nxt);
        const char* nA = has_next ? (const char*)g.A + (size_t)nxt.pm * tstepA : cA; const char* nB = has_next ? (const char*)g.Bt + (size_t)nxt.pn * tstepB : cB;
        for (int t = 0; t < nt; t += 2) {
            const bool last = (t == nt - 2);
            const char* a1 = cA + (size_t)(t + 1) * kstep;
            const char* a2 = last ? nA : cA + (size_t)(t + 2) * kstep; const char* b2 = last ? nB : cB + (size_t)(t + 2) * kstep;
            const char* a3 = a2 + kstep; const char* b3 = b2 + kstep;
            PG8_LDB(B0, 0, 0); PG8_SCHED; PG8_LDA(At, 0, 0); PG8_STAGE(PG8_SA(1, 1), a1 + hstepA, voffA);
            PG8_WAIT_L(8); PG8_BAR; PG8_WAIT_L(0); PG8_MMA(0, 0, At, B0); PG8_BAR; PG8_SCHED;
            PG8_LDB(B1, 0, 1); PG8_STAGE(PG8_SB(0, 0), b2, voffB);
            PG8_BAR; PG8_WAIT_L(0); PG8_MMA(0, 1, At, B1); PG8_BAR;
            PG8_LDA(At, 0, 1); PG8_STAGE(PG8_SA(0, 0), a2, voffA);
            PG8_BAR; PG8_WAIT_L(0); PG8_MMA(1, 0, At, B0); PG8_BAR; PG8_SCHED;
            PG8_STAGE(PG8_SB(0, 1), b2 + hstepB, voffB);
            PG8_WAIT_V(6); PG8_BAR; PG8_MMA(1, 1, At, B1); PG8_BAR;
            PG8_LDB(B0, 1, 0); PG8_SCHED; PG8_LDA(At, 1, 0); PG8_STAGE(PG8_SA(0, 1), a2 + hstepA, voffA);
            PG8_WAIT_L(8); PG8_BAR; PG8_WAIT_L(0); PG8_MMA(0, 0, At, B0); PG8_BAR; PG8_SCHED;
            PG8_LDB(B1, 1, 1); PG8_STAGE(PG8_SB(1, 0), b3, voffB);
            PG8_BAR; PG8_WAIT_L(0); PG8_MMA(0, 1, At, B1); PG8_BAR;
            PG8_LDA(At, 1, 1); PG8_STAGE(PG8_SA(1, 0), a3, voffA);
            PG8_BAR; PG8_WAIT_L(0); PG8_MMA(1, 0, At, B0); PG8_BAR; PG8_SCHED;
            PG8_STAGE(PG8_SB(1, 1), b3 + hstepB, voffB);
            PG8_WAIT_V(6); PG8_BAR; PG8_MMA(1, 1, At, B1); PG8_BAR;
        }
        E(acc, cur, wr, wc, fr, fq);
        if (!has_next) break;
#pragma unroll
        for (int a = 0; a < 2; ++a)
#pragma unroll
            for (int b = 0; b < 2; ++b)
#pragma unroll
                for (int m = 0; m < 4; ++m)
#pragma unroll
                    for (int n = 0; n < 2; ++n) acc[a][b][m][n] = (f32x4){0.f, 0.f, 0.f, 0.f};
        cur = nxt; cA = nA; cB = nB; ++ui;
    }
    PG8_WAIT_V(0);
    if (wr == 0) PG8_BAR;
    PG8_BAR;
#undef PG8_SA
#undef PG8_SB
#undef PG8_STAGE
#undef PG8_LDA
#undef PG8_LDB
#undef PG8_MMA
#undef PG8_WAIT_V
#undef PG8_WAIT_L
#undef PG8_BAR
#undef PG8_SCHED
}
}

typedef f32x4 AccT[2][2][4][2];
#define EPI_LANE const int t_ = tid_(), wid_ = t_ >> 6, ln_ = t_ & 63, wr_ = wid_ >> 2, wc_ = wid_ & 3, fr_ = ln_ & 15, fq_ = ln_ >> 4;
#define EPI_LOOP_PERM(...) EPI_LANE \
    const int row0 = u.pm * 256 + wr_ * 64 + fr_, col0 = u.pn * 256 + wc_ * 32 + 8 * fq_; \
    _Pragma("unroll") for (int ai = 0; ai < 2; ++ai) _Pragma("unroll") for (int m = 0; m < 4; ++m) { const int row = row0 + ai * 128 + m * 16; \
        _Pragma("unroll") for (int bj = 0; bj < 2; ++bj) { const int col = col0 + bj * 128; const f32x4 v0 = acc[ai][bj][m][0], v1 = acc[ai][bj][m][1]; __VA_ARGS__ } }
#define EPI_LOOP_NAT(...) EPI_LANE \
    const int row0 = u.pm * 256 + wr_ * 64 + fr_, col0 = u.pn * 256 + wc_ * 32 + 4 * fq_; \
    _Pragma("unroll") for (int ai = 0; ai < 2; ++ai) _Pragma("unroll") for (int m = 0; m < 4; ++m) { const int row = row0 + ai * 128 + m * 16; \
        _Pragma("unroll") for (int bj = 0; bj < 2; ++bj) _Pragma("unroll") for (int n = 0; n < 2; ++n) { const int col = col0 + bj * 128 + n * 16; const f32x4 v = acc[ai][bj][m][n]; __VA_ARGS__ } }

struct EpiSwiglu { static constexpr bool PERM = true; bf16_t* O;
    DI void operator()(const AccT& acc, const pg8::Unit& u, int wr, int wc, int fr, int fq) const {
        EPI_LOOP_PERM({ u32x2 w; w.x = pack2(siluf_(v0[0]) * v1[0], siluf_(v0[1]) * v1[1]); w.y = pack2(siluf_(v0[2]) * v1[2], siluf_(v0[3]) * v1[3]);
            *(u32x2*)(O + (size_t)row * DFF + (col >> 1)) = w; })
    } };
struct EpiResid { static constexpr bool PERM = false; float* H; float scale;
    DI void operator()(const AccT& acc, const pg8::Unit& u, int wr, int wc, int fr, int fq) const {
        EPI_LOOP_NAT({ f32x4* p = (f32x4*)(H + (size_t)row * DM + col); *p = *p + v * scale; })
    } };
struct EpiProj { static constexpr bool PERM = true; bf16_t* O; bf16_t* XK; bf16_t* XV;
    DI void operator()(const AccT& acc, const pg8::Unit& u, int wr, int wc, int fr, int fq) const {
        const bool is_mg = u.pn * 256 >= C_MG, is_cmp = (u.pn == 10);
        EPI_LOOP_PERM({ f32x4 a = v0, b = v1;
            if (is_mg) { for (int j = 0; j < 4; ++j) { a[j] = sigmoidf_(a[j]); b[j] = sigmoidf_(b[j]); } }
            u32x4 w; w.x = pack2(a[0], a[1]); w.y = pack2(a[2], a[3]); w.z = pack2(b[0], b[1]); w.w = pack2(b[2], b[3]);
            *(u32x4*)(O + (size_t)row * PLD + col) = w;
            if (is_cmp) { const int c = col - C_KC, kv = c >> 7, gg = (c >> 6) & 1, d = c & 63, bb = row >> 11, s = row & 2047, jj = s >> 4, l = s & 15;
                bf16_t* X = kv ? XV : XK; *(u32x4*)(X + ((size_t)((bb * 128 + jj) * 2 + gg)) * 1024 + l * 64 + d) = w; } })
    } };
struct EpiMerge { static constexpr bool PERM = true; bf16_t* MRG; const bf16_t* PROJ; int J;
    DI void operator()(const AccT& acc, const pg8::Unit& u, int wr, int wc, int fr, int fq) const {
        EPI_LOOP_PERM({ const u32x4 gt = *(const u32x4*)(PROJ + (size_t)row * PLD + C_MG + J * 1024 + col);
            u32x4* mp = (u32x4*)(MRG + (size_t)row * DM + col); u32x4 old = (u32x4){0u, 0u, 0u, 0u}; if (J > 0) old = *mp;
            float r[8]; const float x[8] = {v0[0], v0[1], v0[2], v0[3], v1[0], v1[1], v1[2], v1[3]};
            _Pragma("unroll") for (int j = 0; j < 8; ++j) { const unsigned gw = gt[j >> 1], ow = old[j >> 1];
                const float gf = (j & 1) ? __uint_as_float(gw & 0xFFFF0000u) : __uint_as_float(gw << 16);
                const float of = (j & 1) ? __uint_as_float(ow & 0xFFFF0000u) : __uint_as_float(ow << 16);
                r[j] = of + gf * x[j]; }
            u32x4 w; w.x = pack2(r[0], r[1]); w.y = pack2(r[2], r[3]); w.z = pack2(r[4], r[5]); w.w = pack2(r[6], r[7]); *mp = w; })
    } };
struct EpiF32 { static constexpr bool PERM = false; float* C; static constexpr int ldc = 256;
    DI void operator()(const AccT& acc, const pg8::Unit& u, int wr, int wc, int fr, int fq) const {
        EPI_LOOP_NAT({ *(f32x4*)(C + (size_t)row * ldc + col) = v; })
    } };
template <int LDC> struct EpiBf16 { static constexpr bool PERM = true; bf16_t* O; static constexpr int ldc = LDC;
    DI void operator()(const AccT& acc, const pg8::Unit& u, int wr, int wc, int fr, int fq) const {
        EPI_LOOP_PERM({ u32x4 w; w.x = pack2(v0[0], v0[1]); w.y = pack2(v0[2], v0[3]); w.z = pack2(v1[0], v1[1]); w.w = pack2(v1[2], v1[3]);
            *(u32x4*)(O + (size_t)row * ldc + col) = w; })
    } };
struct EpiPleGate { static constexpr bool PERM = false; float* H; const bf16_t* TMP;
    DI void operator()(const AccT& acc, const pg8::Unit& u, int wr, int wc, int fr, int fq) const {
        EPI_LOOP_NAT({ const u32x2 tw = *(const u32x2*)(TMP + (size_t)row * DM + col); f32x4* p = (f32x4*)(H + (size_t)row * DM + col); f32x4 h = *p;
            h[0] += sigmoidf_(v[0]) * __uint_as_float(tw.x << 16); h[1] += sigmoidf_(v[1]) * __uint_as_float(tw.x & 0xFFFF0000u);
            h[2] += sigmoidf_(v[2]) * __uint_as_float(tw.y << 16); h[3] += sigmoidf_(v[3]) * __uint_as_float(tw.y & 0xFFFF0000u); *p = h; })
    } };

struct EpiLora { static constexpr bool PERM = true; bf16_t* EWA; bf16_t* G;
    DI void operator()(const AccT& acc, const pg8::Unit& u, int wr, int wc, int fr, int fq) const {
        const bool isg = u.pn >= 4; bf16_t* O = isg ? G - 1024 : EWA; const int ld = isg ? 512 : 1024;
        EPI_LOOP_PERM({ u32x4 w; w.x = pack2(v0[0], v0[1]); w.y = pack2(v0[2], v0[3]); w.z = pack2(v1[0], v1[1]); w.w = pack2(v1[2], v1[3]);
            *(u32x4*)(O + (size_t)row * ld + col) = w; })
    } };

template <class Epi> DI void run_gemm(unsigned char* smem, const bf16_t* A, int lda, const bf16_t* Bt, int M, int N, int K, const Epi& E, int coff = 0) {
    __syncthreads();
    pg8::Gemm g; g.A = A; g.Bt = Bt; g.M = M; g.N = N; g.K = K; g.lda = lda;
    pg8::StaticOrder S; S.init(M, N, (int)gridDim.x, (bid_() + coff) % (int)gridDim.x);
    pg8::gemm_phase<Epi>((LAS unsigned char*)smem, g, S, E);
    __syncthreads();
}

struct MapId { DI int operator()(int n) const { return n; } };
struct MapGU { DI int operator()(int n) const { const int q = n >> 3, e = n & 7; return e < 4 ? 4 * q + e : DFF + 4 * q + (e - 4); } };
struct MapIn { DI int operator()(int n) const { return n < 3328 ? n : n + 24; } };
struct MapNg { DI int operator()(int n) const { return n < 24 ? 3328 + n : -1; } };
template <int TN, class Map> __device__ __forceinline__ void transpose_cvt_t(unsigned char* smem, const float* src, int ldsrc, bf16_t* dst, int K, int Nd, Map map) {
    float* tile = (float*)smem;
    constexpr int RPP = 512 / TN;
    const int tid = tid_(), ntk = K / 64, nt = ntk * (Nd / TN);
    for (int t = bid_(); t < nt; t += gridDim.x) {
        const int n0 = (t / ntk) * TN, k0 = (t % ntk) * 64;
        const int nn = tid % TN, sc = map(n0 + nn);
#pragma unroll
        for (int p = 0; p < 64 / RPP; ++p) { const int kk = (tid / TN) + p * RPP; tile[kk * (TN + 1) + nn] = sc >= 0 ? src[(size_t)(k0 + kk) * ldsrc + sc] : 0.f; }
        __syncthreads();
#pragma unroll
        for (int p = 0; p < TN / 16; ++p) { const int nn2 = (tid >> 5) + p * 16, kk2 = (tid & 31) * 2;
            *(unsigned*)(dst + (size_t)(n0 + nn2) * K + k0 + kk2) = pack2(tile[kk2 * (TN + 1) + nn2], tile[(kk2 + 1) * (TN + 1) + nn2]); }
        __syncthreads();
    }
}
template <class Map> __device__ __forceinline__ void transpose_cvt(unsigned char* smem, const float* src, int ldsrc, bf16_t* dst, int K, int Nd, Map map) {
    if ((Nd & 255) == 0) transpose_cvt_t<256>(smem, src, ldsrc, dst, K, Nd, map); else transpose_cvt_t<64>(smem, src, ldsrc, dst, K, Nd, map);
}
__device__ __forceinline__ void convert_layer_weights(unsigned char* smem, CP p, int L) {
    bf16_t* W = (bf16_t*)(p->ws + WS_WBF);
    transpose_cvt(smem, p->in[I_F1GU] + (size_t)L * DM * 2 * DFF, 2 * DFF, W + E_GU1, DM, 2 * DFF, MapGU());
    transpose_cvt(smem, p->in[I_F1D] + (size_t)L * DFF * DM, DM, W + E_D1, DFF, DM, MapId());
    transpose_cvt(smem, p->in[I_WIN] + (size_t)L * DM * IN_COLS, IN_COLS, W + E_IN, DM, N_WIN, MapIn());
    transpose_cvt(smem, p->in[I_WIN] + (size_t)L * DM * IN_COLS, IN_COLS, W + E_NG, DM, 256, MapNg());
    for (int j = 0; j < 3; ++j) transpose_cvt(smem, p->in[I_WBR] + ((size_t)L * 3 + j) * 512 * DM, DM, W + E_BR + (size_t)j * 1024 * 512, 512, DM, MapId());
    transpose_cvt(smem, p->in[I_WOUT] + (size_t)L * DM * DM, DM, W + E_OUT, DM, DM, MapId());
    for (int i = bid_() * 512 + tid_(); i < 1536 * 256; i += gridDim.x * 512) { const int n = i >> 8, k = i & 255; float w = 0.f;
        if (n < 512) { if (k < 64) w = p->in[I_WB][((size_t)L * 64 + k) * 512 + n]; }
        else if (n < 1024) { if (k >= 64 && k < 128) w = p->in[I_AB][((size_t)L * 64 + (k - 64)) * 512 + (n - 512)]; }
        else { if (k >= 128) w = p->in[I_GB][((size_t)L * 128 + (k - 128)) * 512 + (n - 1024)]; }
        W[E_LORA + i] = f2bf(w); }
    transpose_cvt(smem, p->in[I_PLEG] + (size_t)L * DM * DM, DM, W + E_PG, DM, DM, MapId());
    transpose_cvt(smem, p->in[I_PLEW] + (size_t)L * 256 * DM, DM, W + E_PW, 256, DM, MapId());
    for (int kv = 0; kv < 2; ++kv) for (int hf = 0; hf < 2; ++hf)
        transpose_cvt(smem, p->in[I_CW1] + ((size_t)(L * 2 + kv) * 2048 + hf * 1024) * 128, 128, W + E_C1 + ((size_t)kv * 256 + hf * 128) * 1024, 1024, 128, MapId());
    if (bid_() == gridDim.x - 1 && tid_() < 256) {
        const int kv = tid_() >> 7, hc = tid_() & 127;
        const float* pe = p->in[I_PE] + (size_t)(L * 2 + kv) * 2048; const float* w1 = p->in[I_CW1] + (size_t)(L * 2 + kv) * 2048 * 128 + hc;
        float s = 0.f; for (int i = 0; i < 2048; ++i) s += pe[i] * w1[(size_t)i * 128];
        ((float*)(p->ws + WS_PEB))[kv * 128 + hc] = s;
    }
}

__device__ __forceinline__ void convert_ffn2_weights(unsigned char* smem, CP p, int L) {
    bf16_t* W = (bf16_t*)(p->ws + WS_WBF);
    transpose_cvt(smem, p->in[I_F2GU] + (size_t)L * DM * 2 * DFF, 2 * DFF, W + E_GU2, DM, 2 * DFF, MapGU());
    transpose_cvt(smem, p->in[I_F2D] + (size_t)L * DFF * DM, DM, W + E_D2, DFF, DM, MapId());
}
__device__ __forceinline__ void lora_act(CP p, int L) {
    const bf16_t* PROJ = (const bf16_t*)(p->ws + WS_PROJ); bf16_t* LACT = (bf16_t*)(p->ws + WS_LACT);
    const float* mu = p->in[I_MU] + (size_t)L * 1792 + 1536;
    for (int i = bid_() * 512 + tid_(); i < T_TOK * 32; i += gridDim.x * 512) {
        const int t = i >> 5, j0 = (i & 31) * 8; const bf16_t* row = PROJ + (size_t)t * PLD + C_RW + 1536 + j0;
        const u32x4 cur = *(const u32x4*)row; u32x4 prv = {0u, 0u, 0u, 0u}; if ((t & (SEQ - 1)) != 0) prv = *(const u32x4*)(row - PLD);
        float r[8];
#pragma unroll
        for (int e = 0; e < 8; ++e) { const float x1 = (e & 1) ? __uint_as_float(cur[e >> 1] & 0xFFFF0000u) : __uint_as_float(cur[e >> 1] << 16);
            const float xp = (e & 1) ? __uint_as_float(prv[e >> 1] & 0xFFFF0000u) : __uint_as_float(prv[e >> 1] << 16);
            float xm = x1 + (xp - x1) * mu[j0 + e];
            if (j0 < 64) xm = tanhf(xm); else if (j0 >= 128) xm = sigmoidf_(xm);
            r[e] = xm; }
        u32x4 w; w.x = pack2(r[0], r[1]); w.y = pack2(r[2], r[3]); w.z = pack2(r[4], r[5]); w.w = pack2(r[6], r[7]);
        *(u32x4*)(LACT + (size_t)t * 256 + j0) = w;
    }
}

__device__ __forceinline__ void rmsnorm_rows(const float* hin, float* hcopy, const float* g, bf16_t* un, float* outf) {
    const int lane = tid_() & 63, gw = bid_() * 8 + (tid_() >> 6), nw = gridDim.x * 8;
    f32x4 gv[4];
#pragma unroll
    for (int i = 0; i < 4; ++i) gv[i] = *(const f32x4*)(g + lane * 4 + i * 256);
    for (int row = gw; row < T_TOK; row += nw) {
        f32x4 x[4]; float ss = 0.f;
#pragma unroll
        for (int i = 0; i < 4; ++i) { x[i] = *(const f32x4*)(hin + (size_t)row * DM + lane * 4 + i * 256); ss += x[i][0] * x[i][0] + x[i][1] * x[i][1] + x[i][2] * x[i][2] + x[i][3] * x[i][3]; }
        ss = wave_sum(ss);
        const float rs = rsqrtf(ss * (1.0f / DM) + 1e-6f);
#pragma unroll
        for (int i = 0; i < 4; ++i) {
            const f32x4 y = x[i] * rs * gv[i];
            if (hcopy) *(f32x4*)(hcopy + (size_t)row * DM + lane * 4 + i * 256) = x[i];
            if (un) { u32x2 w; w.x = pack2(y[0], y[1]); w.y = pack2(y[2], y[3]); *(u32x2*)(un + (size_t)row * DM + lane * 4 + i * 256) = w; }
            if (outf) *(f32x4*)(outf + (size_t)row * DM + lane * 4 + i * 256) = y;
        }
    }
}
__device__ __forceinline__ void cvt_f32_bf16(const float* src, bf16_t* dst, size_t n4) {
    for (size_t i = (size_t)bid_() * 512 + tid_(); i < n4; i += (size_t)gridDim.x * 512) {
        const f32x4 v = *(const f32x4*)(src + i * 4); u32x2 w; w.x = pack2(v[0], v[1]); w.y = pack2(v[2], v[3]); *(u32x2*)(dst + i * 4) = w; }
}

__device__ __forceinline__ void finalize_cmp(unsigned char* smem, CP p, int L) {
    float* hid = (float*)smem + (tid_() >> 6) * 128;
    const int lane = tid_() & 63, gw = bid_() * 8 + (tid_() >> 6), nw = gridDim.x * 8;
    const float* peb = (const float*)(p->ws + WS_PEB);
    const int total = 2 * 16 * 2 * 128, iters = (total + nw - 1) / nw;
    for (int it = 0; it < iters; ++it) {
        const int id = gw + it * nw; const bool ok = id < total;
        const int n = id & 127, gg = (id >> 7) & 1, bb = (id >> 8) & 15, kv = (id >> 12) & 1;
        if (ok && n < 127) {
            const float* Pm = (const float*)(p->ws + WS_P01) + (size_t)kv * 4096 * 256;
            const size_t r0 = (size_t)((bb * 128 + n) * 2 + gg) * 256, r1 = (size_t)((bb * 128 + n + 1) * 2 + gg) * 256;
#pragma unroll
            for (int q = 0; q < 2; ++q) { const int hc = lane + q * 64; hid[hc] = siluf_(Pm[r0 + hc] + Pm[r1 + 128 + hc] + peb[kv * 128 + hc]); }
        }
        __syncthreads();
        if (ok) {
            float o = 0.f;
            if (n < 127) { const float* w2 = p->in[I_CW2] + (size_t)(L * 2 + kv) * 128 * 64 + lane;
                for (int hc = 0; hc < 128; ++hc) o += hid[hc] * w2[hc * 64]; }
            ((float*)(p->ws + WS_KC))[((((size_t)kv * 16 + bb) * 2 + gg) * 128 + n) * 64 + lane] = o;
        }
        __syncthreads();
    }
}

__device__ __forceinline__ void hgrn_scan(unsigned char* smem, CP p, int L, int b, int h) {
    float* F = (float*)smem; float* Kx = F + 2048; float* Q = Kx + 2048; float* V = Q + 2048; float* PO = V + 2048;
    const int tid = tid_(), e = tid & 63, wv = tid >> 6, C = h * 64 + e;
    float lb;
    { const float* hl = p->in[I_HGLB]; const float a0 = hl[C], a1 = hl[512 + C], a2 = hl[1024 + C], a3 = hl[1536 + C];
      const float mx = fmaxf(fmaxf(a0, a1), fmaxf(a2, a3)); const float e0 = __expf(a0 - mx), e1 = __expf(a1 - mx), e2 = __expf(a2 - mx), e3 = __expf(a3 - mx);
      const float inv = 1.0f / (e0 + e1 + e2 + e3); float acc = 0.f; if (L >= 1) acc += e1; if (L >= 2) acc += e2; if (L >= 3) acc += e3; lb = fmaxf(acc * inv, 0.f); }
    const float ng = p->in[I_HGN][L * 512 + C];
    bf16_t* base = (bf16_t*)(p->ws + WS_PROJ) + (size_t)b * SEQ * PLD + C;
    f32x2 S0 = {0.f, 0.f}, S1 = {0.f, 0.f}, S2 = {0.f, 0.f}, S3 = {0.f, 0.f};
    bf16_t pz[4], pq[4], pi[4], pg[4];
#define HG_PREFETCH(T0) do { _Pragma("unroll") for (int i = 0; i < 4; ++i) { const bf16_t* row = base + (size_t)((T0) + wv * 4 + i) * PLD; \
        pz[i] = row[C_HF]; pq[i] = row[C_HQ]; pi[i] = row[C_HI]; pg[i] = row[C_HG]; } } while (0)
    HG_PREFETCH(0);
    for (int t0 = 0; t0 < SEQ; t0 += 32) {
        float gr[4];
#pragma unroll
        for (int i = 0; i < 4; ++i) { const int t = wv * 4 + i;
            const float z = bf2f(pz[i]), qr = bf2f(pq[i]), vi = bf2f(pi[i]); gr[i] = bf2f(pg[i]);
            const float sg = sigmoidf_(z); F[t * 64 + e] = sg + lb * (1.0f - sg); Kx[t * 64 + e] = (1.0f - lb) * (1.0f - sg); Q[t * 64 + e] = siluf_(qr); V[t * 64 + e] = vi; }
        __syncthreads();
        if (t0 + 32 < SEQ) HG_PREFETCH(t0 + 32);
#pragma unroll 4
        for (int t = 0; t < 32; ++t) {
            const f32x4 f0 = *(const f32x4*)(F + t * 64 + wv * 8), f1 = *(const f32x4*)(F + t * 64 + wv * 8 + 4);
            const f32x4 k0 = *(const f32x4*)(Kx + t * 64 + wv * 8), k1 = *(const f32x4*)(Kx + t * 64 + wv * 8 + 4);
            const f32x4 q0 = *(const f32x4*)(Q + t * 64 + wv * 8), q1 = *(const f32x4*)(Q + t * 64 + wv * 8 + 4);
            const float v = V[t * 64 + e]; const f32x2 vv = {v, v};
            S0 = (f32x2){f0[0], f0[1]} * S0 + (f32x2){k0[0], k0[1]} * vv; S1 = (f32x2){f0[2], f0[3]} * S1 + (f32x2){k0[2], k0[3]} * vv;
            S2 = (f32x2){f1[0], f1[1]} * S2 + (f32x2){k1[0], k1[1]} * vv; S3 = (f32x2){f1[2], f1[3]} * S3 + (f32x2){k1[2], k1[3]} * vv;
            f32x2 o2 = (f32x2){q0[0], q0[1]} * S0 + (f32x2){q0[2], q0[3]} * S1 + (f32x2){q1[0], q1[1]} * S2 + (f32x2){q1[2], q1[3]} * S3;
            PO[(t * 8 + wv) * 64 + e] = o2[0] + o2[1];
        }
        __syncthreads();
#pragma unroll
        for (int i = 0; i < 4; ++i) { const int t = wv * 4 + i;
            float o = 0.f;
#pragma unroll
            for (int q = 0; q < 8; ++q) o += PO[(t * 8 + q) * 64 + e];
            const float ss = wave_sum(o * o); const float rs = rsqrtf(ss * (1.0f / 64.0f) + 1e-6f);
            base[(size_t)(t0 + t) * PLD + C_HQ] = f2bf(o * rs * ng * siluf_(gr[i])); }
        __syncthreads();
    }
#undef HG_PREFETCH
}

DI float dpp_xor1(float v) { return __int_as_float(__builtin_amdgcn_mov_dpp(__float_as_int(v), 0xB1, 0xF, 0xF, true)); }
DI float dpp_xor2(float v) { return __int_as_float(__builtin_amdgcn_mov_dpp(__float_as_int(v), 0x4E, 0xF, 0xF, true)); }
DI float dpp_hmir(float v) { return __int_as_float(__builtin_amdgcn_mov_dpp(__float_as_int(v), 0x141, 0xF, 0xF, true)); }
DI float red8(float v) { v += dpp_xor1(v); v += dpp_xor2(v); v += dpp_hmir(v); return v; }

__device__ __forceinline__ void rwkv_scan(unsigned char* smem, CP p, int L, int b, int h) {
    constexpr int BUF_F = 6 * 2048 + 64 + 2048;
    const int tid = tid_(), c = tid & 63, wv = tid >> 6, C = h * 64 + c, lane = c;
    const float* mu = p->in[I_MU] + (size_t)L * 1792;
    const float mu_r = mu[C], mu_k = mu[512 + C], mu_v = mu[1024 + C];
    const float w0 = p->in[I_W0][L * 512 + C], a0 = p->in[I_A0][L * 512 + C];
    const float k_k = p->in[I_KK][L * 512 + C], k_a = p->in[I_KA][L * 512 + C], r_k = p->in[I_RK][L * 512 + C], ln_w = p->in[I_LNW][L * 512 + C], ln_b = p->in[I_LNB][L * 512 + C];
    const bf16_t* base = (const bf16_t*)(p->ws + WS_PROJ) + (size_t)b * SEQ * PLD + C_RW + C;
    const bf16_t* ewa = (const bf16_t*)(p->ws + WS_UN) + (size_t)b * SEQ * 1024 + C;
    bf16_t* obase = (bf16_t*)(p->ws + WS_ORW) + (size_t)b * SEQ * 512 + C;
    const int kp = lane & 7, vr = lane >> 3, vrow = wv * 8 + vr;
    f32x2 S0 = {0.f, 0.f}, S1 = {0.f, 0.f}, S2 = {0.f, 0.f}, S3 = {0.f, 0.f};
    bf16_t pr[4], pk[4], pv[4], pe[4], pa[4], pg[4], qr, qk, qv;
#define RW_PREFETCH(T0) do { const int s0_ = (T0) + wv * 4; \
        _Pragma("unroll") for (int i = 0; i < 4; ++i) { const bf16_t* row = base + (size_t)(s0_ + i) * PLD; pr[i] = row[0]; pk[i] = row[512]; pv[i] = row[1024]; \
            pe[i] = ewa[(size_t)(s0_ + i) * 1024]; pa[i] = ewa[(size_t)(s0_ + i) * 1024 + 512]; pg[i] = obase[(size_t)(s0_ + i) * 512]; } \
        if (s0_ > 0) { const bf16_t* row = base + (size_t)(s0_ - 1) * PLD; qr = row[0]; qk = row[512]; qv = row[1024]; } else { qr = 0; qk = 0; qv = 0; } } while (0)
    RW_PREFETCH(0);
    __syncthreads();
    for (int blk = 0; blk < SEQ / 32; ++blk) {
        float* Bf = (float*)smem + (blk & 1) * BUF_F;
        float* Wd = Bf; float* NKK = Bf + 2048; float* AB = Bf + 4096; float* KX = Bf + 6144; float* WR = Bf + 8192; float* VS = Bf + 10240; float* SC = Bf + 12288; float* YS = Bf + 12352;
        float bon[4], gv[4];
        { float rp = bf2f(qr), kq = bf2f(qk), vp = bf2f(qv);
#pragma unroll
          for (int i = 0; i < 4; ++i) { const int t = wv * 4 + i;
              const float r1 = bf2f(pr[i]), k1 = bf2f(pk[i]), v1 = bf2f(pv[i]);
              const float r = r1 + (rp - r1) * mu_r, k = k1 + (kq - k1) * mu_k, v = v1 + (vp - v1) * mu_v; rp = r1; kq = k1; vp = v1;
              const float decay = __expf(-0.6065306597f * sigmoidf_(w0 + bf2f(pe[i]))), a = sigmoidf_(a0 + bf2f(pa[i])); gv[i] = bf2f(pg[i]);
              const float kkv = k * k_k; const float ssq = wave_sum(kkv * kkv); const float kkn = kkv / fmaxf(sqrtf(ssq), 1e-12f);
              const float kx = k * (1.0f + (a - 1.0f) * k_a), ab = kkn * a;
              const float br = wave_sum(ab * r), kr = wave_sum(kx * r); bon[i] = wave_sum(r * kx * r_k);
              Wd[t * 64 + c] = decay; NKK[t * 64 + c] = -kkn; AB[t * 64 + c] = ab; KX[t * 64 + c] = kx; WR[t * 64 + c] = decay * r; VS[t * 64 + c] = v;
              if (c == 0) { SC[t * 2] = br; SC[t * 2 + 1] = kr; } } }
        __syncthreads();
        if (blk + 1 < SEQ / 32) RW_PREFETCH((blk + 1) * 32);
#define RW_LOAD(T, w0v, w1v, n0, n1, b0, b1, x0, x1, q0, q1, vv, sc) do { const int o_ = (T) * 64 + kp * 8; \
            w0v = *(const f32x4*)(Wd + o_); w1v = *(const f32x4*)(Wd + o_ + 4); n0 = *(const f32x4*)(NKK + o_); n1 = *(const f32x4*)(NKK + o_ + 4); \
            b0 = *(const f32x4*)(AB + o_); b1 = *(const f32x4*)(AB + o_ + 4); x0 = *(const f32x4*)(KX + o_); x1 = *(const f32x4*)(KX + o_ + 4); \
            q0 = *(const f32x4*)(WR + o_); q1 = *(const f32x4*)(WR + o_ + 4); vv = VS[(T) * 64 + vrow]; sc = *(const f32x2*)(SC + (T) * 2); } while (0)
        f32x4 cw0, cw1, cn0, cn1, cb0, cb1, cx0, cx1, cq0, cq1; float cvv; f32x2 csc;
        RW_LOAD(0, cw0, cw1, cn0, cn1, cb0, cb1, cx0, cx1, cq0, cq1, cvv, csc);
#pragma nounroll
        for (int t8 = 0; t8 < 4; ++t8) {
            float ykeep = 0.f;
#pragma unroll
            for (int j = 0; j < 8; ++j) {
                const int t = t8 * 8 + j;
                const f32x4 w0v = cw0, w1v = cw1, n0 = cn0, n1 = cn1, b0 = cb0, b1 = cb1, x0 = cx0, x1 = cx1, q0 = cq0, q1 = cq1; const float vv = cvv; const f32x2 sc = csc;
                { const int tn = (t + 1) & 31; RW_LOAD(tn, cw0, cw1, cn0, cn1, cb0, cb1, cx0, cx1, cq0, cq1, cvv, csc); }
                const f32x2 sa2 = S0 * (f32x2){n0[0], n0[1]} + S1 * (f32x2){n0[2], n0[3]} + S2 * (f32x2){n1[0], n1[1]} + S3 * (f32x2){n1[2], n1[3]};
                const f32x2 y2 = S0 * (f32x2){q0[0], q0[1]} + S1 * (f32x2){q0[2], q0[3]} + S2 * (f32x2){q1[0], q1[1]} + S3 * (f32x2){q1[2], q1[3]};
                float sa = sa2[0] + sa2[1], yy = y2[0] + y2[1];
                sa += dpp_xor1(sa); yy += dpp_xor1(yy); sa += dpp_xor2(sa); yy += dpp_xor2(yy); sa += dpp_hmir(sa); yy += dpp_hmir(yy);
                const f32x2 sav = {sa, sa}, vv2 = {vv, vv};
                S0 = S0 * (f32x2){w0v[0], w0v[1]} + sav * (f32x2){b0[0], b0[1]} + vv2 * (f32x2){x0[0], x0[1]};
                S1 = S1 * (f32x2){w0v[2], w0v[3]} + sav * (f32x2){b0[2], b0[3]} + vv2 * (f32x2){x0[2], x0[3]};
                S2 = S2 * (f32x2){w1v[0], w1v[1]} + sav * (f32x2){b1[0], b1[1]} + vv2 * (f32x2){x1[0], x1[1]};
                S3 = S3 * (f32x2){w1v[2], w1v[3]} + sav * (f32x2){b1[2], b1[3]} + vv2 * (f32x2){x1[2], x1[3]};
                const float y = yy + sa * sc[0] + vv * sc[1];
                ykeep = (kp == j) ? y : ykeep;
            }
            YS[(t8 * 8 + kp) * 64 + vrow] = ykeep;
        }
#undef RW_LOAD
        __syncthreads();
#pragma unroll
        for (int i = 0; i < 4; ++i) { const int t = wv * 4 + i;
            const float y = YS[t * 64 + c]; const float mean = wave_sum(y) * (1.0f / 64.0f); const float dlt = y - mean;
            const float var = wave_sum(dlt * dlt) * (1.0f / 64.0f);
            float yn = dlt * rsqrtf(var + 64e-5f) * ln_w + ln_b; yn += bon[i] * VS[t * 64 + c];
            obase[(size_t)(blk * 32 + t) * 512] = f2bf(yn * gv[i]); }
    }
#undef RW_PREFETCH
    __syncthreads();
}

DI int crow16(int i, int hl) { return (i & 3) + 8 * (i >> 2) + 4 * hl; }
__device__ __forceinline__ void rwkv_chunked(unsigned char* smem, CP p, int L, int b, int h) {
    bf16_t* ZB = (bf16_t*)smem;
    bf16_t* AR = (bf16_t*)(smem + 9216);
    bf16_t* BKt = (bf16_t*)(smem + 13824);
    bf16_t* UV = (bf16_t*)(smem + 18944);
    bf16_t* MT1 = (bf16_t*)(smem + 24064);
    bf16_t* MT2 = (bf16_t*)(smem + 25600);
    float* EW = (float*)(smem + 27136);
    bf16_t* BKr = (bf16_t*)(smem + 31232);
    float* Mf = (float*)(smem + 48640);
    float* Gs = (float*)(smem + 52864);
    float* YS = (float*)(smem + 57216);
    float* VS = (float*)(smem + 61312);
    float* PC = (float*)(smem + 65408);
    const int tid = tid_(), c = tid & 63, wv = tid >> 6, C = h * 64 + c, lane = c, qi = lane & 31, hl = lane >> 5;
    const float* mu = p->in[I_MU] + (size_t)L * 1792;
    const float mu_r = mu[C], mu_k = mu[512 + C], mu_v = mu[1024 + C];
    const float w0 = p->in[I_W0][L * 512 + C], a0 = p->in[I_A0][L * 512 + C];
    const float k_k = p->in[I_KK][L * 512 + C], k_a = p->in[I_KA][L * 512 + C], r_k = p->in[I_RK][L * 512 + C], ln_w = p->in[I_LNW][L * 512 + C], ln_b = p->in[I_LNB][L * 512 + C];
    const bf16_t* base = (const bf16_t*)(p->ws + WS_PROJ) + (size_t)b * SEQ * PLD + C_RW + C;
    const bf16_t* ewa = (const bf16_t*)(p->ws + WS_UN) + (size_t)b * SEQ * 1024 + C;
    bf16_t* obase = (bf16_t*)(p->ws + WS_ORW) + (size_t)b * SEQ * 512 + C;
    f32x16 zacc;
#pragma unroll
    for (int i = 0; i < 16; ++i) zacc[i] = 0.f;
    for (int i = tid; i < 64 * 72; i += 512) ZB[i] = 0;
    bf16_t pr[2], pk[2], pv[2], pe[2], pa[2], pg[2], qr, qk, qv;
#define RC_PREFETCH(T0) do { const int s0_ = (T0) + wv * 2; \
        _Pragma("unroll") for (int i = 0; i < 2; ++i) { const bf16_t* row = base + (size_t)(s0_ + i) * PLD; pr[i] = row[0]; pk[i] = row[512]; pv[i] = row[1024]; \
            pe[i] = ewa[(size_t)(s0_ + i) * 1024]; pa[i] = ewa[(size_t)(s0_ + i) * 1024 + 512]; pg[i] = obase[(size_t)(s0_ + i) * 512]; } \
        if (s0_ > 0) { const bf16_t* row = base + (size_t)(s0_ - 1) * PLD; qr = row[0]; qk = row[512]; qv = row[1024]; } else { qr = 0; qk = 0; qv = 0; } } while (0)
    RC_PREFETCH(0);
    __syncthreads();
    for (int ch = 0; ch < SEQ / 16; ++ch) {
        float bon[2], gv[2], r_[2], nk_[2], ab_[2], kx_[2], v_[2], ew_[2];
        { float rp = bf2f(qr), kq = bf2f(qk), vp = bf2f(qv);
#pragma unroll
          for (int i = 0; i < 2; ++i) { const int t = wv * 2 + i;
              const float r1 = bf2f(pr[i]), k1 = bf2f(pk[i]), v1 = bf2f(pv[i]);
              const float r = r1 + (rp - r1) * mu_r, k = k1 + (kq - k1) * mu_k, v = v1 + (vp - v1) * mu_v; rp = r1; kq = k1; vp = v1;
              const float ew = 0.6065306597f * sigmoidf_(w0 + bf2f(pe[i])), a = sigmoidf_(a0 + bf2f(pa[i])); gv[i] = bf2f(pg[i]);
              const float kkv = k * k_k; const float ssq = wave_sum(kkv * kkv); const float kkn = kkv * rsqrtf(fmaxf(ssq, 1e-24f));
              const float kx = k * (1.0f + (a - 1.0f) * k_a);
              bon[i] = wave_sum(r * kx * r_k);
              r_[i] = r; nk_[i] = kkn; ab_[i] = kkn * a; kx_[i] = kx; v_[i] = v; ew_[i] = ew; EW[t * 64 + c] = ew; } }
        __syncthreads();
        if (ch + 1 < SEQ / 16) RC_PREFETCH((ch + 1) * 16);
        { float ev[16];
#pragma unroll
          for (int j = 0; j < 16; ++j) ev[j] = EW[j * 64 + c];
#pragma unroll
          for (int i = 0; i < 2; ++i) { const int t = wv * 2 + i; float cum = 0.f;
#pragma unroll
            for (int j = 0; j < 16; ++j) cum += (j <= t) ? ev[j] : 0.f;
            const float Pt = __expf(-cum), Pm = __expf(-(cum - ew_[i])), iP = __expf(cum);
            const float al = -nk_[i] * Pm, rh = r_[i] * Pt, be = ab_[i] * iP, ka = kx_[i] * iP;
            AR[t * 72 + c] = f2bf(al); AR[(16 + t) * 72 + c] = f2bf(rh); BKr[t * 72 + c] = f2bf(be); BKr[(16 + t) * 72 + c] = f2bf(ka);
            BKt[c * 40 + t] = f2bf(be); BKt[c * 40 + 16 + t] = f2bf(ka);
            UV[c * 40 + 16 + t] = f2bf(v_[i]); VS[t * 64 + c] = v_[i];
            if (t == 15) PC[c] = Pt; } }
        __syncthreads();
        f32x16 acc;
#pragma unroll
        for (int i = 0; i < 16; ++i) acc[i] = 0.f;
        if (wv == 0) {
#pragma unroll
            for (int s = 0; s < 4; ++s) acc = MFMA32(*(const bf16x8*)(BKr + qi * 72 + 16 * s + 8 * hl), *(const bf16x8*)(AR + qi * 72 + 16 * s + 8 * hl), acc);
#pragma unroll
            for (int i = 0; i < 16; ++i) { const int j = crow16(i, hl), n = qi; const float m = acc[i];
                if (j < 16) { if (n < 16) Mf[j * 17 + n] = m; MT2[n * 24 + j] = f2bf((n >= 16 && j <= n - 16) ? m : 0.f); }
                else { const int i2 = j - 16; const bool k1 = n < 16 ? (i2 < n) : (i2 <= n - 16); MT1[n * 24 + i2] = f2bf(k1 ? m : 0.f); } }
        } else if (wv < 3) {
            const int vb = wv - 1;
#pragma unroll
            for (int s = 0; s < 4; ++s) acc = MFMA32(*(const bf16x8*)(ZB + (32 * vb + qi) * 72 + 16 * s + 8 * hl), *(const bf16x8*)(AR + qi * 72 + 16 * s + 8 * hl), acc);
        }
        __syncthreads();
        if (wv == 1 || wv == 2) { const int vb = wv - 1;
            acc = MFMA32(*(const bf16x8*)(UV + (32 * vb + qi) * 40 + 16 + 8 * hl), *(const bf16x8*)(MT1 + qi * 24 + 8 * hl), acc);
            if (qi < 16) {
#pragma unroll
                for (int i = 0; i < 16; ++i) Gs[(32 * vb + crow16(i, hl)) * 17 + qi] = acc[i]; }
        }
        __syncthreads();
        if (wv == 0) {
            float u[16];
#pragma unroll
            for (int t = 0; t < 16; ++t) { float x0 = Gs[lane * 17 + t], x1 = 0.f;
#pragma unroll
                for (int i = 0; i < t; ++i) { if (i & 1) x1 += u[i] * Mf[i * 17 + t]; else x0 += u[i] * Mf[i * 17 + t]; }
                u[t] = x0 + x1; UV[lane * 40 + t] = f2bf(u[t]); }
        }
        __syncthreads();
        if (wv == 1 || wv == 2) { const int vb = wv - 1;
            acc = MFMA32(*(const bf16x8*)(UV + (32 * vb + qi) * 40 + 8 * hl), *(const bf16x8*)(MT2 + qi * 24 + 8 * hl), acc);
            if (qi >= 16) {
#pragma unroll
                for (int i = 0; i < 16; ++i) YS[(qi - 16) * 64 + 32 * vb + crow16(i, hl)] = acc[i]; }
        }
        if (wv >= 4) { const int vb = (wv >> 1) & 1, kb = wv & 1;
#pragma unroll
            for (int s = 0; s < 2; ++s) zacc = MFMA32(*(const bf16x8*)(UV + (32 * vb + qi) * 40 + 16 * s + 8 * hl), *(const bf16x8*)(BKt + (32 * kb + qi) * 40 + 16 * s + 8 * hl), zacc);
            const float pc = PC[32 * kb + qi];
#pragma unroll
            for (int i = 0; i < 16; ++i) { zacc[i] *= pc; ZB[(32 * vb + crow16(i, hl)) * 72 + 32 * kb + qi] = f2bf(zacc[i]); }
        }
        __syncthreads();
#pragma unroll
        for (int i = 0; i < 2; ++i) { const int t = wv * 2 + i;
            const float y = YS[t * 64 + c]; const float mean = wave_sum(y) * (1.0f / 64.0f); const float dlt = y - mean;
            const float var = wave_sum(dlt * dlt) * (1.0f / 64.0f);
            float yn = dlt * rsqrtf(var + 64e-5f) * ln_w + ln_b; yn += bon[i] * VS[t * 64 + c];
            obase[(size_t)(ch * 16 + t) * 512] = f2bf(yn * gv[i]); }
    }
#undef RC_PREFETCH
    __syncthreads();
}

constexpr int KTS = 72;
DI bf16x8 pack8(float a0, float a1, float a2, float a3, float a4, float a5, float a6, float a7) {
    u32x4 w; w.x = pack2(a0, a1); w.y = pack2(a2, a3); w.z = pack2(a4, a5); w.w = pack2(a6, a7); return __builtin_bit_cast(bf16x8, w); }
DI bf16x8 ld_vfrag(const bf16_t* vt, int off) { const u32x2 lo = *(const u32x2*)(vt + off), hi = *(const u32x2*)(vt + off + 8); u32x4 w; w.x = lo.x; w.y = lo.y; w.z = hi.x; w.w = hi.y; return __builtin_bit_cast(bf16x8, w); }

struct FlashState { f32x16 o0, o1; float m, l; };

DI void flash_update(FlashState& st, f32x16& sc0, f32x16& sc1, const bf16_t* VT, int vs, int qi, int hl) {
    float mt = -INFINITY;
#pragma unroll
    for (int i = 0; i < 16; ++i) mt = fmaxf(mt, fmaxf(sc0[i], sc1[i]));
    mt = fmaxf(mt, shfl_xor_(mt, 32, qi + 32 * hl));
    const float mnew = fmaxf(st.m, mt), muse = (mnew == -INFINITY) ? 0.f : mnew;
    const float alpha = __builtin_amdgcn_exp2f(st.m - muse);
    float ls = 0.f;
#pragma unroll
    for (int i = 0; i < 16; ++i) { sc0[i] = __builtin_amdgcn_exp2f(sc0[i] - muse); sc1[i] = __builtin_amdgcn_exp2f(sc1[i] - muse); ls += sc0[i] + sc1[i]; }
    st.l = st.l * alpha + ls; st.m = mnew;
    st.o0 *= alpha; st.o1 *= alpha;
#pragma unroll
    for (int s = 0; s < 2; ++s) {
        const bf16x8 p0 = pack8(sc0[8 * s], sc0[8 * s + 1], sc0[8 * s + 2], sc0[8 * s + 3], sc0[8 * s + 4], sc0[8 * s + 5], sc0[8 * s + 6], sc0[8 * s + 7]);
        const bf16x8 p1 = pack8(sc1[8 * s], sc1[8 * s + 1], sc1[8 * s + 2], sc1[8 * s + 3], sc1[8 * s + 4], sc1[8 * s + 5], sc1[8 * s + 6], sc1[8 * s + 7]);
        st.o0 = MFMA32(ld_vfrag(VT, qi * vs + 16 * s + 4 * hl), p0, st.o0);
        st.o1 = MFMA32(ld_vfrag(VT, (32 + qi) * vs + 16 * s + 4 * hl), p0, st.o1);
        st.o0 = MFMA32(ld_vfrag(VT, qi * vs + 32 + 16 * s + 4 * hl), p1, st.o0);
        st.o1 = MFMA32(ld_vfrag(VT, (32 + qi) * vs + 32 + 16 * s + 4 * hl), p1, st.o1);
    }
}
DI void qk_tile(const bf16_t* KT, const bf16x8 (&qf)[4], int qi, int hl, f32x16& sc0, f32x16& sc1) {
#pragma unroll
    for (int i = 0; i < 16; ++i) { sc0[i] = 0.f; sc1[i] = 0.f; }
#pragma unroll
    for (int s = 0; s < 4; ++s) {
        const bf16x8 k0 = *(const bf16x8*)(KT + qi * KTS + 16 * s + 8 * hl), k1 = *(const bf16x8*)(KT + (32 + qi) * KTS + 16 * s + 8 * hl);
        sc0 = MFMA32(k0, qf[s], sc0); sc1 = MFMA32(k1, qf[s], sc1);
    }
}
struct KVRegs { u32x4 k, v; };
DI void kv_fetch(KVRegs& r, const bf16_t* pb, int kcol, int vcol, int k0) {
    const int tid = tid_();
    const unsigned ok_ = (unsigned)((k0 + (tid >> 3)) * PLD + kcol + (tid & 7) * 8) * 2u, ov_ = (unsigned)((k0 + (tid & 63)) * PLD + vcol + (tid >> 6) * 8) * 2u;
    r.k = *(const u32x4*)((const char*)pb + ok_);
    r.v = *(const u32x4*)((const char*)pb + ov_);
}
DI void kv_store(const KVRegs& r, bf16_t* KT, bf16_t* VT) {
    const int tid = tid_();
    *(u32x4*)(KT + (tid >> 3) * KTS + (tid & 7) * 8) = r.k;
    const int key = tid & 63, ch = tid >> 6;
#pragma unroll
    for (int j = 0; j < 8; ++j) VT[(ch * 8 + j) * KTS + key] = (bf16_t)((j & 1) ? (r.v[j >> 1] >> 16) : (r.v[j >> 1] & 0xFFFFu));
}
template <bool LUTB, bool CAUSAL, bool WHI, bool SEL>
DI void mask_tile(f32x16& sc0, f32x16& sc1, const float* lut, int qpos, int k0, int hl, bool sel, float qs) {
    const float bfar = lut[128];
#pragma unroll
    for (int i = 0; i < 16; ++i) { const int kl = (i & 3) + 8 * (i >> 2) + 4 * hl;
        { const int dist = qpos - (k0 + kl); const float v = sc0[i] * qs + (LUTB ? lut[dist > 128 ? 128 : (dist < 0 ? 0 : dist)] : bfar);
          bool ok = true; if (CAUSAL) ok = ok && dist >= 0; if (WHI) ok = ok && dist < 256; if (SEL) ok = ok && sel; sc0[i] = ok ? v : -INFINITY; }
        { const int dist = qpos - (k0 + 32 + kl); const float v = sc1[i] * qs + (LUTB ? lut[dist > 128 ? 128 : (dist < 0 ? 0 : dist)] : bfar);
          bool ok = true; if (CAUSAL) ok = ok && dist >= 0; if (WHI) ok = ok && dist < 256; if (SEL) ok = ok && sel; sc1[i] = ok ? v : -INFINITY; } }
}

__device__ __forceinline__ void nsa_item(unsigned char* smem, CP p, int L, int b, int g, int qb, int ocol) {
    bf16_t* KT = (bf16_t*)smem;
    bf16_t* VT = (bf16_t*)(smem + 9216);
    float* LUT = (float*)(smem + 18432);
    unsigned* SELM = (unsigned*)(smem + 20736);
    unsigned* ORM = (unsigned*)(smem + 20992);
    float* PA = (float*)(smem + 21504);
    float* PBv = (float*)(smem + 54272);
    bf16_t* KT2 = (bf16_t*)(smem + 87040);
    bf16_t* VT2 = (bf16_t*)(smem + 105472);
    const int tid = tid_(), lane = tid & 63, wv = tid >> 6, hh = wv >> 1, qhalf = wv & 1, qi = lane & 31, hl = lane >> 5;
    const int ql = qhalf * 32 + qi, qpos = qb * 64 + ql, head = g * 4 + hh;
    bf16_t* pb = (bf16_t*)(p->ws + WS_PROJ) + (size_t)b * SEQ * PLD;
    bf16_t* qrow = pb + (size_t)qpos * PLD;
    __syncthreads();
    for (int i = tid; i < 4 * 129; i += 512) { const int h2 = i / 129, dd = i % 129; int bk;
        if (dd < 16) bk = dd; else if (dd >= 128) bk = 31; else { bk = 16 + (int)(logf((float)dd / 16.0f) / 2.0794415416798357f * 16.0f); bk = bk > 31 ? 31 : bk; }
        LUT[h2 * 132 + dd] = p->in[I_RELB][bk * 8 + g * 4 + h2] * 1.4426950408889634f; }
    if (tid == 0) *ORM = 0u;
    if (tid < 64) SELM[tid] = 0u;
    if (tid < 256) PBv[tid * 32] = 0.f;
    { const float* kc = (const float*)(p->ws + WS_KC) + ((size_t)(0 * 16 + b) * 2 + g) * 128 * 64; const float* vc = (const float*)(p->ws + WS_KC) + ((size_t)(1 * 16 + b) * 2 + g) * 128 * 64;
      for (int i = tid; i < 128 * 64; i += 512) { const int n = i >> 6, d = i & 63; KT2[n * KTS + d] = f2bf(kc[i]); }
      for (int i = tid; i < 128 * 64; i += 512) { const int n = i & 127, d = i >> 7; VT2[d * 136 + n] = f2bf(vc[n * 64 + d]); } }
    bf16x8 qf[4];
#pragma unroll
    for (int s = 0; s < 4; ++s) qf[s] = *(const bf16x8*)(qrow + C_NQ + head * 64 + 16 * s + 8 * hl);
    float g0, g1, g2;
    { const bf16_t* gp = qrow + C_NG + head * 3; g0 = sigmoidf_(bf2f(gp[0])); g1 = sigmoidf_(bf2f(gp[1])); g2 = sigmoidf_(bf2f(gp[2])); }
    __syncthreads();
    const float* lut = LUT + hh * 132;
    constexpr float QS = 0.125f * 1.4426950408889634f;
    f32x16 fin0, fin1;
    {
        FlashState st;
#pragma unroll
        for (int i = 0; i < 16; ++i) { st.o0[i] = 0.f; st.o1[i] = 0.f; }
        st.m = -INFINITY; st.l = 0.f;
#pragma nounroll
        for (int t = 0; t < 2; ++t) {
            f32x16 sc0, sc1; qk_tile(KT2 + t * 64 * KTS, qf, qi, hl, sc0, sc1);
#pragma unroll
            for (int i = 0; i < 16; ++i) { const int kl = (i & 3) + 8 * (i >> 2) + 4 * hl;
                { const int n = 64 * t + kl, dist = qpos - (16 * n + 31); sc0[i] = (dist >= 0 && n < 127) ? sc0[i] * QS + lut[dist > 128 ? 128 : dist] : -INFINITY; }
                { const int n = 64 * t + 32 + kl, dist = qpos - (16 * n + 31); sc1[i] = (dist >= 0 && n < 127) ? sc1[i] * QS + lut[dist > 128 ? 128 : dist] : -INFINITY; } }
            flash_update(st, sc0, sc1, VT2 + 64 * t, 136, qi, hl);
        }
        const float lt = st.l + shfl_xor_(st.l, 32, lane); const float inv = 1.0f / fmaxf(lt, 1e-30f);
        const float muse = (st.m == -INFINITY) ? 0.f : st.m;
        fin0 = st.o0 * (g0 * inv); fin1 = st.o1 * (g0 * inv);
#pragma nounroll
        for (int t = 0; t < 2; ++t) {
            f32x16 sc0, sc1; qk_tile(KT2 + t * 64 * KTS, qf, qi, hl, sc0, sc1);
#pragma unroll
            for (int i = 0; i < 16; ++i) { const int kl = (i & 3) + 8 * (i >> 2) + 4 * hl;
                { const int n = 64 * t + kl, dist = qpos - (16 * n + 31); sc0[i] = (dist >= 0 && n < 127) ? __builtin_amdgcn_exp2f(sc0[i] * QS + lut[dist > 128 ? 128 : dist] - muse) * inv : 0.f; }
                { const int n = 64 * t + 32 + kl, dist = qpos - (16 * n + 31); sc1[i] = (dist >= 0 && n < 127) ? __builtin_amdgcn_exp2f(sc1[i] * QS + lut[dist > 128 ? 128 : dist] - muse) * inv : 0.f; } }
#pragma unroll
            for (int i4 = 0; i4 < 4; ++i4) {
                { const int m = 16 * t + 2 * i4 + hl; PA[(hh * 64 + ql) * 32 + m] = sc0[4 * i4] + sc0[4 * i4 + 1] + sc0[4 * i4 + 2] + sc0[4 * i4 + 3]; PBv[(hh * 64 + ql) * 32 + m + 1] = sc0[4 * i4 + 3]; }
                { const int m = 16 * t + 8 + 2 * i4 + hl; PA[(hh * 64 + ql) * 32 + m] = sc1[4 * i4] + sc1[4 * i4 + 1] + sc1[4 * i4 + 2] + sc1[4 * i4 + 3]; if (m + 1 < 32) PBv[(hh * 64 + ql) * 32 + m + 1] = sc1[4 * i4 + 3]; }
            }
        }
    }
    __syncthreads();
    {
        float* IMP = (float*)smem;
        const int q = tid & 63, part = tid >> 6, cur = qb;
#pragma unroll
        for (int mm = 0; mm < 4; ++mm) { const int m = part * 4 + mm; float v;
            if (m == 0 || m == cur || m == cur - 1) v = INFINITY;
            else if (m <= cur) { v = 0.f; for (int h2 = 0; h2 < 4; ++h2) v += PA[(h2 * 64 + q) * 32 + m] + PBv[(h2 * 64 + q) * 32 + m]; }
            else v = -INFINITY;
            IMP[q * 33 + m] = v; }
        __syncthreads();
        unsigned bits = 0u;
#pragma unroll
        for (int mm = 0; mm < 4; ++mm) { const int m = part * 4 + mm; const float v = IMP[q * 33 + m]; int rank = 0;
            for (int m2 = 0; m2 < 32; ++m2) { const float v2 = IMP[q * 33 + m2]; rank += (v2 > v || (v2 == v && m2 < m)) ? 1 : 0; }
            if (rank < 8 && v > -INFINITY) bits |= 1u << m; }
        atomicOr(&SELM[q], bits); atomicOr(ORM, bits);
    }
    __syncthreads();
    const unsigned mysel = SELM[ql], orm = *ORM;
    __syncthreads();
    float* PARK = PA + (wv * 32) * 64 + lane;
#pragma unroll
    for (int i = 0; i < 16; ++i) { PARK[i * 64] = fin0[i]; PARK[(16 + i) * 64] = fin1[i]; }
    {
        FlashState st;
#pragma unroll
        for (int i = 0; i < 16; ++i) { st.o0[i] = 0.f; st.o1[i] = 0.f; }
        st.m = -INFINITY; st.l = 0.f;
        const unsigned todo = orm & (qb >= 31 ? 0xFFFFFFFFu : ((2u << qb) - 1u));
        KVRegs kr;
        int m = todo ? __builtin_ctz(todo) : -1;
        if (m >= 0) { kv_fetch(kr, pb, C_KS + g * 64, C_VS + g * 64, m * 64); __syncthreads(); kv_store(kr, KT, VT); __syncthreads(); }
        while (m >= 0) {
            const unsigned rest = todo & ~((2u << m) - 1u); const int nm = (m < 31 && rest) ? __builtin_ctz(rest) : -1;
            if (nm >= 0) kv_fetch(kr, pb, C_KS + g * 64, C_VS + g * 64, nm * 64);
            const bool sel = (mysel >> m) & 1u;
            if (__builtin_amdgcn_ballot_w64(sel) != 0ull) {
                f32x16 sc0, sc1; qk_tile(KT, qf, qi, hl, sc0, sc1);
                if (m + 3 <= qb) mask_tile<false, false, false, true>(sc0, sc1, lut, qpos, m * 64, hl, sel, QS);
                else mask_tile<true, true, false, true>(sc0, sc1, lut, qpos, m * 64, hl, sel, QS);
                flash_update(st, sc0, sc1, VT, KTS, qi, hl);
            }
            __syncthreads();
            if (nm >= 0) kv_store(kr, KT, VT);
            __syncthreads();
            m = nm;
        }
        const float lt = st.l + shfl_xor_(st.l, 32, lane); const float sc = g1 / fmaxf(lt, 1e-30f);
#pragma unroll
        for (int i = 0; i < 16; ++i) { PARK[i * 64] += st.o0[i] * sc; PARK[(16 + i) * 64] += st.o1[i] * sc; }
    }
    {
        FlashState st;
#pragma unroll
        for (int i = 0; i < 16; ++i) { st.o0[i] = 0.f; st.o1[i] = 0.f; }
        st.m = -INFINITY; st.l = 0.f;
        KVRegs kr;
        int w = qb >= 4 ? 0 : 4 - qb;
        kv_fetch(kr, pb, C_KW + g * 64, C_VW + g * 64, qb * 64 - 256 + 64 * w); __syncthreads(); kv_store(kr, KT, VT); __syncthreads();
        for (; w < 5; ++w) {
            const int k0 = qb * 64 - 256 + 64 * w;
            if (w < 4) kv_fetch(kr, pb, C_KW + g * 64, C_VW + g * 64, k0 + 64);
            f32x16 sc0, sc1; qk_tile(KT, qf, qi, hl, sc0, sc1);
            if (w == 0) mask_tile<false, false, true, false>(sc0, sc1, lut, qpos, k0, hl, true, QS);
            else if (w == 1) mask_tile<false, false, false, false>(sc0, sc1, lut, qpos, k0, hl, true, QS);
            else if (w < 4) mask_tile<true, false, false, false>(sc0, sc1, lut, qpos, k0, hl, true, QS);
            else mask_tile<true, true, false, false>(sc0, sc1, lut, qpos, k0, hl, true, QS);
            flash_update(st, sc0, sc1, VT, KTS, qi, hl);
            __syncthreads();
            if (w < 4) kv_store(kr, KT, VT);
            __syncthreads();
        }
        const float lt = st.l + shfl_xor_(st.l, 32, lane); const float sc = g2 / fmaxf(lt, 1e-30f);
#pragma unroll
        for (int i = 0; i < 16; ++i) { fin0[i] = PARK[i * 64] + st.o0[i] * sc; fin1[i] = PARK[(16 + i) * 64] + st.o1[i] * sc; }
    }
#pragma unroll
    for (int i4 = 0; i4 < 4; ++i4) {
        u32x2 w0; w0.x = pack2(fin0[4 * i4], fin0[4 * i4 + 1]); w0.y = pack2(fin0[4 * i4 + 2], fin0[4 * i4 + 3]);
        u32x2 w1; w1.x = pack2(fin1[4 * i4], fin1[4 * i4 + 1]); w1.y = pack2(fin1[4 * i4 + 2], fin1[4 * i4 + 3]);
        *(u32x2*)(qrow + ocol + head * 64 + 8 * i4 + 4 * hl) = w0;
        *(u32x2*)(qrow + ocol + head * 64 + 32 + 8 * i4 + 4 * hl) = w1;
    }
}

constexpr int PH_PER_LAYER = 15, PH_TOTAL = DEPTH * PH_PER_LAYER + 1;
enum { S_PREP = 0, S_GU1, S_D1, S_NORM_MIX, S_WIN, S_CMP, S_LORA, S_SCAN, S_MERGE, S_OUT, S_NORM2, S_GU2, S_D2, S_NORM_PLE, S_PLEG, S_FINAL };

__device__ __forceinline__ void run_phase(unsigned char* smem, CP p, int ph) {
    const bool fin = (ph == DEPTH * PH_PER_LAYER);
    const int L = fin ? 0 : ph / PH_PER_LAYER; const int sub = fin ? S_FINAL : ph % PH_PER_LAYER;
    unsigned char* ws = p->ws; float* H = p->out;
    bf16_t* W = (bf16_t*)(ws + WS_WBF); bf16_t* UN = (bf16_t*)(ws + WS_UN); bf16_t* PROJ = (bf16_t*)(ws + WS_PROJ); bf16_t* ACT = (bf16_t*)(ws + WS_ACT);
    bf16_t* TMP = (bf16_t*)(ws + WS_TMP); bf16_t* PBF = (bf16_t*)(ws + WS_PB); bf16_t* ORW = (bf16_t*)(ws + WS_ORW);
    bf16_t* XK = (bf16_t*)(ws + WS_XK); bf16_t* XV = (bf16_t*)(ws + WS_XV); float* P01 = (float*)(ws + WS_P01);
    if (sub == S_PREP) convert_layer_weights(smem, p, L);
    if (sub == S_NORM_MIX) convert_ffn2_weights(smem, p, L);
    if (sub == S_NORM2) cvt_f32_bf16(p->in[I_P] + (size_t)L * T_TOK * 256, PBF, (size_t)T_TOK * 256 / 4);
    if (sub == S_CMP) lora_act(p, L);
    if (sub == S_LORA) finalize_cmp(smem, p, L);
    if (sub == S_NORM_PLE) { EpiBf16<DM> e; e.O = TMP; run_gemm(smem, PBF, 256, W + E_PW, T_TOK, DM, 256, e); }
    if (sub == S_PREP || sub == S_NORM_MIX || sub == S_NORM2 || sub == S_NORM_PLE || sub == S_FINAL) {
        const float* hin = (sub == S_PREP && L == 0) ? p->in[I_X] : H; float* hcopy = (sub == S_PREP && L == 0) ? H : nullptr;
        const float* g = sub == S_PREP ? p->in[I_F1N] + L * DM : sub == S_NORM_MIX ? p->in[I_MIXN] + L * DM : sub == S_NORM2 ? p->in[I_F2N] + L * DM : sub == S_NORM_PLE ? p->in[I_PLEN] + L * DM : p->in[I_FINN];
        rmsnorm_rows(hin, hcopy, g, sub == S_FINAL ? nullptr : UN, sub == S_FINAL ? H : nullptr);
    } else if (sub == S_GU1 || sub == S_GU2) {
        EpiSwiglu e; e.O = ACT; run_gemm(smem, UN, DM, W + (sub == S_GU1 ? E_GU1 : E_GU2), T_TOK, 2 * DFF, DM, e);
    } else if (sub == S_D1 || sub == S_D2 || sub == S_OUT) {
        EpiResid e; e.H = H; e.scale = sub == S_OUT ? 1.0f : 0.5f;
        run_gemm(smem, sub == S_OUT ? UN : ACT, sub == S_OUT ? DM : DFF, W + (sub == S_D1 ? E_D1 : sub == S_D2 ? E_D2 : E_OUT), T_TOK, DM, sub == S_OUT ? DM : DFF, e);
    } else if (sub == S_WIN) {
        EpiProj e; e.O = PROJ; e.XK = XK; e.XV = XV; run_gemm(smem, UN, DM, W + E_IN, T_TOK, N_WIN, DM, e);
    } else if (sub == S_CMP) {
#pragma nounroll
        for (int kv = 0; kv < 2; ++kv) { EpiF32 e; e.C = P01 + (size_t)kv * 4096 * 256;
            run_gemm(smem, kv ? XV : XK, 1024, W + E_C1 + (size_t)kv * 256 * 1024, 4096, 256, 1024, e); }
        { EpiBf16<PLD> e; e.O = PROJ + C_NG; run_gemm(smem, UN, DM, W + E_NG, T_TOK, 256, DM, e, 128); }
    } else if (sub == S_LORA) {
        EpiLora e; e.EWA = UN; e.G = ORW;
        run_gemm(smem, (const bf16_t*)(ws + WS_LACT), 256, W + E_LORA, T_TOK, 1536, 256, e);
    } else if (sub == S_SCAN) {
        for (int item = bid_(); item < 256; item += gridDim.x) {
            __syncthreads();
            if (item < 128) rwkv_chunked(smem, p, L, item >> 3, item & 7); else hgrn_scan(smem, p, L, (item - 128) >> 3, (item - 128) & 7);
        }
        unsigned* ctr = (unsigned*)(ws + 14336) + L * 64;
        volatile unsigned* slot = (volatile unsigned*)(smem + 141 * 1024);
        for (;;) {
            __syncthreads();
            if (tid_() == 0) *slot = __hip_atomic_fetch_add(ctr, 1u, __ATOMIC_RELAXED, __HIP_MEMORY_SCOPE_AGENT);
            __syncthreads();
            const unsigned idx = *slot;
            if (idx >= 1024u) break;
            const int bg = idx & 31, qb = 31 - (int)(idx >> 5);
            nsa_item(smem, p, L, bg >> 1, bg & 1, qb, C_NQ);
        }
    } else if (sub == S_MERGE) {
#pragma nounroll
        for (int j = 0; j < 3; ++j) { EpiMerge e; e.MRG = UN; e.PROJ = PROJ; e.J = j;
            const bf16_t* A = j == 0 ? PROJ + C_HQ : (j == 1 ? PROJ + C_NQ : ORW);
            run_gemm(smem, A, j == 2 ? 512 : PLD, W + E_BR + (size_t)j * 1024 * 512, T_TOK, DM, 512, e); }
    } else if (sub == S_PLEG) {
        EpiPleGate e; e.H = H; e.TMP = TMP; run_gemm(smem, UN, DM, W + E_PG, T_TOK, DM, DM, e);
    }
}

#define XB_TMO      128
#define XB_XCNT(j)  (256  + 64 * (j))
#define XB_XSUB(j)  (1280 + 64 * (j))
#define XB_XGEN(j)  (2304 + 64 * (j))
#define XB_TOP      3328
#define XB_TOPGEN   3392
#define XCD_BAR_WORDS 3456
#define XB_SPIN_CAP (1u << 20)
DI unsigned xb_ld(unsigned* p)              { return __hip_atomic_load(p, __ATOMIC_RELAXED, __HIP_MEMORY_SCOPE_AGENT); }
DI unsigned xb_add(unsigned* p, unsigned v) { return __hip_atomic_fetch_add(p, v, __ATOMIC_RELAXED, __HIP_MEMORY_SCOPE_AGENT); }
DI unsigned xb_xcc_id() { return (unsigned)__builtin_amdgcn_s_getreg((3 << 11) | 20) & 0xFu; }
#define XB_SPIN(cond, bar) do { unsigned _sp = 0; while (cond) { __builtin_amdgcn_s_sleep(1); \
    if ((++_sp & 255u) == 0u) { if (xb_ld(&(bar)[XB_TMO])) break; if (_sp > XB_SPIN_CAP) { atomicAdd(&(bar)[XB_TMO], 1u); break; } } } } while (0)
struct XcdBarrier { unsigned* bar; unsigned x; volatile LAS unsigned* st; };
DI XcdBarrier xcd_barrier_post(unsigned* bar, volatile LAS unsigned* st) {
    XcdBarrier b; b.bar = bar; b.x = xb_xcc_id(); b.st = st;
    if (threadIdx.x == 0) (void)xb_add(&bar[XB_XCNT(b.x)], 1u);
    return b;
}
DI void xcd_barrier_complete(unsigned* bar, unsigned x, unsigned& nloc, unsigned& nx) {
    const unsigned G = gridDim.x * gridDim.y * gridDim.z;
    unsigned sum, cnt, mine, sp = 0u;
    for (;;) {
        sum = 0u; cnt = 0u; mine = 0u;
#pragma unroll
        for (unsigned j = 0; j < 16; ++j) { const unsigned c = xb_ld(&bar[XB_XCNT(j)]); sum += c; cnt += (c > 0u) ? 1u : 0u; mine = (j == x) ? c : mine; }
        if (sum == G) break;
        __builtin_amdgcn_s_sleep(1);
        if ((++sp & 255u) == 0u) { if (xb_ld(&bar[XB_TMO])) break; if (sp > XB_SPIN_CAP) { atomicAdd(&bar[XB_TMO], 1u); break; } }
    }
    nloc = mine > 0u ? mine : 1u; nx = cnt > 0u ? cnt : 1u;
}
DI void xcd_barrier(const XcdBarrier& b) {
    asm volatile("s_waitcnt vmcnt(0)" ::: "memory");
    __syncthreads();
    if (threadIdx.x == 0) {
        unsigned* bar = b.bar;
        __builtin_amdgcn_s_waitcnt(0);
        unsigned nloc = b.st[0], nx = b.st[1];
        if (nloc == 0u) { xcd_barrier_complete(bar, b.x, nloc, nx); b.st[0] = nloc; b.st[1] = nx; }
        const unsigned old = xb_add(&bar[XB_XSUB(b.x)], 1u);
        const unsigned gen = old / nloc;
        if (old + 1u == (gen + 1u) * nloc) {
            __builtin_amdgcn_fence(__ATOMIC_RELEASE, "agent");
            asm volatile("s_waitcnt vmcnt(0)" ::: "memory");
            const unsigned og = xb_add(&bar[XB_TOP], 1u);
            const unsigned tg = og / nx;
            if (og + 1u == (tg + 1u) * nx) xb_add(&bar[XB_TOPGEN], 1u);
            else XB_SPIN(xb_ld(&bar[XB_TOPGEN]) == tg, bar);
            __builtin_amdgcn_fence(__ATOMIC_ACQUIRE, "agent");
            xb_add(&bar[XB_XGEN(b.x)], 1u);
            asm volatile("s_waitcnt vmcnt(0)" ::: "memory");
        } else {
            XB_SPIN(xb_ld(&bar[XB_XGEN(b.x)]) == gen, bar);
            __builtin_amdgcn_fence(__ATOMIC_ACQUIRE, "agent");
            asm volatile("s_waitcnt vmcnt(0)" ::: "memory");
        }
    }
    __syncthreads();
}

__global__ void __launch_bounds__(512, 2) mega_fwd(Params p) {
    extern __shared__ __attribute__((aligned(16))) unsigned char smem[];
    cg::grid_group grid = cg::this_grid();
    volatile LAS unsigned* xst = (volatile LAS unsigned*)(LAS unsigned char*)(smem + 140 * 1024);
    if (threadIdx.x == 0) { xst[0] = 0u; xst[1] = 0u; }
    __syncthreads();
    const XcdBarrier xb = xcd_barrier_post((unsigned*)(p.ws + WS_BAR), xst);
#ifndef PROBE_DUP
#define PROBE_DUP -1
#endif
    constexpr int IT_PER_LAYER = PH_PER_LAYER + (PROBE_DUP >= 0 ? 1 : 0);
    const int it_lo = p.ph_lo, it_hi = PROBE_DUP >= 0 ? DEPTH * IT_PER_LAYER + 1 : p.ph_hi;
    for (int it = it_lo; it < it_hi; ++it) {
        int ph = it;
        if (PROBE_DUP >= 0) { const int l_ = it / IT_PER_LAYER, r_ = it % IT_PER_LAYER; ph = l_ * PH_PER_LAYER + (r_ <= PROBE_DUP ? r_ : r_ - 1); }
        CP pp = (CP)__builtin_amdgcn_kernarg_segment_ptr(); asm volatile("" : "+s"(pp));
        run_phase(smem, pp, ph);
        if (it + 1 < it_hi) {
            if (it == it_lo) grid.sync();
            else xcd_barrier(xb);
        }
    }
}

#ifndef MULTI_LAUNCH
#define MULTI_LAUNCH 0
#endif

extern "C" void kernel_launch(void* const* d_in, const int* in_sizes, int n_in, void* d_out, int out_size, void* d_ws, size_t ws_size, hipStream_t stream) {
    static int grid = 0;
    if (grid == 0) {
        if (n_in != N_INPUTS || out_size != T_TOK * DM || ws_size < WS_END) { fprintf(stderr, "kernel_launch: unexpected shapes: n_in %d out %d ws %zu (need %zu)\n", n_in, out_size, ws_size, (size_t)WS_END); grid = -1; return; }
        int dev = 0, cus = 0, per_cu = 0;
        (void)hipGetDevice(&dev); (void)hipDeviceGetAttribute(&cus, hipDeviceAttributeMultiprocessorCount, dev);
        if (hipFuncSetAttribute((const void*)mega_fwd, hipFuncAttributeMaxDynamicSharedMemorySize, LDS_BYTES) != hipSuccess) { fprintf(stderr, "kernel_launch: hipFuncSetAttribute failed\n"); grid = -1; return; }
        if (hipOccupancyMaxActiveBlocksPerMultiprocessor(&per_cu, (const void*)mega_fwd, 512, LDS_BYTES) != hipSuccess || per_cu < 1) { fprintf(stderr, "kernel_launch: occupancy query gives %d\n", per_cu); per_cu = 1; }
        (void)hipGetLastError();
        grid = cus * 1;
        if (grid > 256) grid = 256;
        fprintf(stderr, "kernel_launch: grid %d (cus %d, per_cu %d)\n", grid, cus, per_cu);
    }
    if (grid < 0) return;
    (void)hipMemsetAsync(d_ws, 0, 16384, stream);
    Params p{};
    for (int i = 0; i < N_INPUTS; ++i) p.in[i] = (const float*)d_in[i];
    p.out = (float*)d_out; p.ws = (unsigned char*)d_ws;
#if MULTI_LAUNCH
    for (int ph = 0; ph < PH_TOTAL; ++ph) { p.ph_lo = ph; p.ph_hi = ph + 1; hipLaunchKernelGGL(mega_fwd, dim3(grid), dim3(512), LDS_BYTES, stream, p); }
#else
    p.ph_lo = 0; p.ph_hi = PH_TOTAL;
    void* args[] = {&p};
    hipError_t e = hipLaunchCooperativeKernel((const void*)mega_fwd, dim3(grid), dim3(512), args, LDS_BYTES, stream);
    if (e != hipSuccess) fprintf(stderr, "kernel_launch: cooperative launch failed: %s\n", hipGetErrorString(e));
#endif
}
```

```cpp
#include <hip/hip_runtime.h>
#include <hip/hip_cooperative_groups.h>
#include <cstdio>
namespace cg = cooperative_groups;

#define LAS __attribute__((address_space(3)))
#define DI __device__ __forceinline__
typedef unsigned short bf16_t;
typedef short bf16x8 __attribute__((ext_vector_type(8)));
typedef float f32x4 __attribute__((ext_vector_type(4)));
typedef float f32x2 __attribute__((ext_vector_type(2)));
typedef float f32x16 __attribute__((ext_vector_type(16)));
typedef unsigned u32x4 __attribute__((ext_vector_type(4)));
typedef unsigned u32x2 __attribute__((ext_vector_type(2)));

constexpr int T_TOK = 32768, SEQ = 2048, NB = 16, DM = 1024, DFF = 2816, DEPTH = 4;
constexpr int PLD = 8448;
constexpr int C_HQ = 0, C_HF = 512, C_HI = 1024, C_HG = 1536, C_NQ = 2048, C_KC = 2560, C_VC = 2688, C_KS = 2816, C_VS = 2944,
              C_KW = 3072, C_VW = 3200, C_RW = 3328, C_MG = 5120, C_NG = 8192, N_WIN = 8192, IN_COLS = 8216;
enum { I_X = 0, I_P, I_F1N, I_F1GU, I_F1D, I_MIXN, I_WIN, I_HGLB, I_HGN, I_PE, I_CW1, I_CW2, I_RELB, I_MU, I_W0, I_WB, I_A0, I_AB, I_GB,
       I_KK, I_KA, I_RK, I_LNW, I_LNB, I_WBR, I_WOUT, I_F2N, I_F2GU, I_F2D, I_PLEN, I_PLEG, I_PLEW, I_FINN, N_INPUTS };

constexpr size_t WS_BAR = 0;
constexpr size_t WS_PEB = 16384;
constexpr size_t WS_WBF = 32768;
constexpr size_t E_GU1 = 0, E_D1 = E_GU1 + 5632ull * 1024, E_IN = E_D1 + 1024ull * 2816, E_BR = E_IN + 8448ull * 1024, E_OUT = E_BR + 3ull * 1024 * 512,
                 E_GU2 = E_GU1, E_D2 = E_D1  , E_PG = E_OUT + 1024ull * 1024, E_PW = E_PG + 1024ull * 1024,
                 E_C1 = E_PW + 1024ull * 256, E_LORA = E_C1 + 2ull * 256 * 1024, E_NG = E_LORA + 1536ull * 256, E_END = E_NG + 256ull * 1024;
constexpr size_t WS_UN = WS_WBF + E_END * 2;
constexpr size_t WS_ORW = WS_UN + (size_t)T_TOK * 1024 * 2;
constexpr size_t WS_XK = WS_ORW + (size_t)T_TOK * 512 * 2;
constexpr size_t WS_XV = WS_XK + 4096ull * 1024 * 2;
constexpr size_t WS_P01 = WS_XV + 4096ull * 1024 * 2;
constexpr size_t WS_KC = WS_P01 + 2ull * 4096 * 256 * 4;
constexpr size_t WS_LACT = WS_KC + 2ull * 16 * 2 * 128 * 64 * 4;
constexpr size_t WS_PROJ = WS_LACT + (size_t)T_TOK * 256 * 2;
constexpr size_t WS_END = WS_PROJ + (size_t)T_TOK * PLD * 2;
constexpr size_t WS_ACT = WS_PROJ;
constexpr size_t WS_PB = WS_PROJ + 200ull * 1024 * 1024;
constexpr size_t WS_TMP = WS_PROJ + 256ull * 1024 * 1024;
constexpr int LDS_BYTES = 144 * 1024;

struct Params {
    const float* in[N_INPUTS];
    float* out;
    unsigned char* ws;
    int ph_lo, ph_hi;
};
typedef const Params __attribute__((address_space(4)))* CP;

DI int tid_() { int t = threadIdx.x; asm volatile("" : "+v"(t)); return t; }
DI int bid_() { int b = blockIdx.x; asm volatile("" : "+s"(b)); return b; }
typedef __bf16 bf16v2 __attribute__((ext_vector_type(2)));
DI float bf2f(bf16_t b) { return __uint_as_float(((unsigned)b) << 16); }
DI unsigned pack2(float lo, float hi) { const f32x2 v = {lo, hi}; return __builtin_bit_cast(unsigned, __builtin_convertvector(v, bf16v2)); }
DI bf16_t f2bf(float f) { return (bf16_t)(pack2(f, 0.f) & 0xFFFFu); }
DI float sigmoidf_(float x) { return __builtin_amdgcn_rcpf(1.0f + __builtin_amdgcn_exp2f(-1.4426950408889634f * x)); }
DI float siluf_(float x) { return x * __builtin_amdgcn_rcpf(1.0f + __builtin_amdgcn_exp2f(-1.4426950408889634f * x)); }
DI float shfl_xor_(float v, int mask, int lane) { return __int_as_float(__builtin_amdgcn_ds_bpermute((lane ^ mask) << 2, __float_as_int(v))); }
DI float dppf_(float v, int) { return v; }
#define DPPF(v, ctrl) __int_as_float(__builtin_amdgcn_mov_dpp(__float_as_int(v), ctrl, 0xF, 0xF, true))
DI float wave_sum(float v) {
    v += DPPF(v, 0xB1); v += DPPF(v, 0x4E); v += DPPF(v, 0x141); v += DPPF(v, 0x140);
    const float s0 = __int_as_float(__builtin_amdgcn_readlane(__float_as_int(v), 0)), s1 = __int_as_float(__builtin_amdgcn_readlane(__float_as_int(v), 16));
    const float s2 = __int_as_float(__builtin_amdgcn_readlane(__float_as_int(v), 32)), s3 = __int_as_float(__builtin_amdgcn_readlane(__float_as_int(v), 48));
    return (s0 + s1) + (s2 + s3);
}

#define MFMA32(a, b, c) __builtin_amdgcn_mfma_f32_32x32x16_bf16((a), (b), (c), 0, 0, 0)
namespace pg8 {
constexpr int BM = 256, BK = 64, HALF = 128, HTB = HALF * BK * 2, STAGE_BYTES = 8 * HTB, NXCD = 8, WGM = 8;
DI int lds_byte(int r, int c) { const int st = (r >> 4) * 2 + (c >> 5), rr = r & 15, cc = c & 31, ob = rr * 64 + cc * 2; return st * 1024 + (ob ^ (((ob >> 9) & 1) << 5)); }
DI void stage_rc(int b, int& R, int& C) { const int st = b / 1024, sb = b % 1024, swz = sb ^ (((sb >> 9) & 1) << 5); R = (st >> 1) * 16 + swz / 64; C = (st & 1) * 32 + (swz % 64) / 2; }
DI int perm32(int rho) { const int n = rho >> 4, i = rho & 15; return 8 * (i >> 2) + 4 * n + (i & 3); }
struct Unit { int pm, pn; };
struct Gemm { const bf16_t* A; const bf16_t* Bt; int M, N, K, lda; };
struct StaticOrder {
    int nM, nN, nwg, G, c;
    DI void init(int M, int N, int G_, int c_) { nM = M / BM; nN = N / BM; nwg = nM * nN; G = G_; c = c_; }
    DI bool next(int i, Unit& u) const {
        const long L = (long)i * G + c; if (L >= nwg) return false;
        int wgid = (int)L; { const int q = nwg / NXCD, r = nwg % NXCD, xcd = wgid % NXCD, off = wgid / NXCD; wgid = (xcd < r ? xcd * (q + 1) : r * (q + 1) + (xcd - r) * q) + off; }
        const int nig = WGM * nN, gid = wgid / nig, fm = gid * WGM, gsz = (nM - fm) < WGM ? (nM - fm) : WGM;
        u.pm = fm + ((wgid % nig) % gsz); u.pn = (wgid % nig) / gsz; return true;
    }
};

template <class Epi>
DI void gemm_phase(LAS unsigned char* lds, const Gemm g, const StaticOrder& S, const Epi& E) {
    int tid = tid_();
    const int wid = __builtin_amdgcn_readfirstlane(tid >> 6), lane = tid & 63, wr = wid >> 2, wc = wid & 3, fr = lane & 15, fq = lane >> 4;
    const int K = g.K, nt = K / BK, lda = g.lda;
    unsigned voffA[2], voffB[2];
#pragma unroll
    for (int i = 0; i < 2; ++i) { int R, C; stage_rc(tid * 16 + i * 8192, R, C); const int Rb = Epi::PERM ? ((R & ~31) + perm32(R & 31)) : R;
        voffA[i] = (unsigned)(R * lda + C) * 2u; voffB[i] = (unsigned)(Rb * K + C) * 2u; }
    const size_t kstep = (size_t)(BK * 2);
    const size_t hstepA = (size_t)HALF * lda * 2, hstepB = (size_t)HALF * K * 2;
    const size_t tstepA = 2 * hstepA, tstepB = 2 * hstepB;
    const unsigned ldsw = (unsigned)wid * 1024u;
    const int aoff = lds_byte(wr * 64 + fr, fq * 8), boff = lds_byte(wc * 32 + fr, fq * 8);
#define PG8_SA(b, h) (((b) * 2 + (h)) * HTB)
#define PG8_SB(b, h) ((4 + (b) * 2 + (h)) * HTB)
#define PG8_STAGE(bufoff, gbase, voff) do { _Pragma("unroll") for (int _i = 0; _i < 2; ++_i) \
        __builtin_amdgcn_global_load_lds((const unsigned*)((const char*)(gbase) + (voff)[_i]), (LAS unsigned*)(lds + (bufoff) + ldsw + _i * 8192), 16, 0, 0); } while (0)
#define PG8_LDA(dst, b, h) do { _Pragma("unroll") for (int m = 0; m < 4; ++m) _Pragma("unroll") for (int k = 0; k < 2; ++k) dst[m][k] = *(const LAS bf16x8*)(lds + PG8_SA(b, h) + aoff + m * 2048 + k * 1024); } while (0)
#define PG8_LDB(dst, b, h) do { _Pragma("unroll") for (int n = 0; n < 2; ++n) _Pragma("unroll") for (int k = 0; k < 2; ++k) dst[n][k] = *(const LAS bf16x8*)(lds + PG8_SB(b, h) + boff + n * 2048 + k * 1024); } while (0)
#define PG8_MMA(ai, bj, At, Bt) do { __builtin_amdgcn_s_setprio(1); _Pragma("unroll") for (int m = 0; m < 4; ++m) _Pragma("unroll") for (int n = 0; n < 2; ++n) _Pragma("unroll") for (int k = 0; k < 2; ++k) \
        acc[ai][bj][m][n] = __builtin_amdgcn_mfma_f32_16x16x32_bf16(Bt[n][k], At[m][k], acc[ai][bj][m][n], 0, 0, 0); __builtin_amdgcn_s_setprio(0); } while (0)
#define PG8_WAIT_V(n) asm volatile("s_waitcnt vmcnt(" #n ")" ::: "memory")
#define PG8_WAIT_L(n) asm volatile("s_waitcnt lgkmcnt(" #n ")" ::: "memory")
#define PG8_BAR __builtin_amdgcn_s_barrier()
#define PG8_SCHED __builtin_amdgcn_sched_barrier(0)
    Unit cur, nxt; int ui = 0;
    if (!S.next(0, cur)) return;
    f32x4 acc[2][2][4][2];
#pragma unroll
    for (int a = 0; a < 2; ++a)
#pragma unroll
        for (int b = 0; b < 2; ++b)
#pragma unroll
            for (int m = 0; m < 4; ++m)
#pragma unroll
                for (int n = 0; n < 2; ++n) acc[a][b][m][n] = (f32x4){0.f, 0.f, 0.f, 0.f};
    bf16x8 At[4][2], B0[2][2], B1[2][2];
    const char* cA = (const char*)g.A + (size_t)cur.pm * tstepA; const char* cB = (const char*)g.Bt + (size_t)cur.pn * tstepB;
    PG8_STAGE(PG8_SB(0, 0), cB, voffB); PG8_STAGE(PG8_SA(0, 0), cA, voffA); PG8_STAGE(PG8_SB(0, 1), cB + hstepB, voffB); PG8_STAGE(PG8_SA(0, 1), cA + hstepA, voffA);
    if (wr == 1) PG8_BAR;
    PG8_WAIT_V(4); PG8_BAR;
    PG8_STAGE(PG8_SB(1, 0), cB + kstep, voffB); PG8_STAGE(PG8_SA(1, 0), cA + kstep, voffA); PG8_STAGE(PG8_SB(1, 1), cB + hstepB + kstep, voffB);
    PG8_WAIT_V(6); PG8_BAR;
    for (;;) {
        const bool has_next = S.next(ui + 1, nxt);
        const char* nA = has_next ? (const char*)g.A + (size_t)nxt.pm * tstepA : cA; const char* nB = has_next ? (const char*)g.Bt + (size_t)nxt.pn * tstepB : cB;
        for (int t = 0; t < nt; t += 2) {
            const bool last = (t == nt - 2);
            const char* a1 = cA + (size_t)(t + 1) * kstep;
            const char* a2 = last ? nA : cA + (size_t)(t + 2) * kstep; const char* b2 = last ? nB : cB + (size_t)(t + 2) * kstep;
            const char* a3 = a2 + kstep; const char* b3 = b2 + kstep;
            PG8_LDB(B0, 0, 0); PG8_SCHED; PG8_LDA(At, 0, 0); PG8_STAGE(PG8_SA(1, 1), a1 + hstepA, voffA);
            PG8_WAIT_L(8); PG8_BAR; PG8_WAIT_L(0); PG8_MMA(0, 0, At, B0); PG8_BAR; PG8_SCHED;
            PG8_LDB(B1, 0, 1); PG8_STAGE(PG8_SB(0, 0), b2, voffB);
            PG8_BAR; PG8_WAIT_L(0); PG8_MMA(0, 1, At, B1); PG8_BAR;
            PG8_LDA(At, 0, 1); PG8_STAGE(PG8_SA(0, 0), a2, voffA);
            PG8_BAR; PG8_WAIT_L(0); PG8_MMA(1, 0, At, B0); PG8_BAR; PG8_SCHED;
            PG8_STAGE(PG8_SB(0, 1), b2 + hstepB, voffB);
            PG8_WAIT_V(6); PG8_BAR; PG8_MMA(1, 1, At, B1); PG8_BAR;
            PG8_LDB(B0, 1, 0); PG8_SCHED; PG8_LDA(At, 1, 0); PG8_STAGE(PG8_SA(0, 1), a2 + hstepA, voffA);
            PG8_WAIT_L(8); PG8_BAR; PG8_WAIT_L(0); PG8_MMA(0, 0, At, B0); PG8_BAR; PG8_SCHED;
            PG8_LDB(B1, 1, 1); PG8_STAGE(PG8_SB(1, 0), b3, voffB);
            PG8_BAR; PG8_WAIT_L(0); PG8_MMA(0, 1, At, B1); PG8_BAR;
            PG8_LDA(At, 1, 1); PG8_STAGE(PG8_SA(1, 0), a3, voffA);
            PG8_BAR; PG8_WAIT_L(0); PG8_MMA(1, 0, At, B0); PG8_BAR; PG8_SCHED;
            PG8_STAGE(PG8_SB(1, 1), b3 + hstepB, voffB);
            PG8_WAIT_V(6); PG8_BAR; PG8_MMA(1, 1, At, B1); PG8_BAR;
        }
        E(acc, cur, wr, wc, fr, fq);
        if (!has_next) break;
#pragma unroll
        for (int a = 0; a < 2; ++a)
#pragma unroll
            for (int b = 0; b < 2; ++b)
#pragma unroll
                for (int m = 0; m < 4; ++m)
#pragma unroll
                    for (int n = 0; n < 2; ++n) acc[a][b][m][n] = (f32x4){0.f, 0.f, 0.f, 0.f};
        cur = nxt; cA = nA; cB = nB; ++ui;
    }
    PG8_WAIT_V(0);
    if (wr == 0) PG8_BAR;
    PG8_BAR;
#undef PG8_SA
#undef PG8_SB
#undef PG8_STAGE
#undef PG8_LDA
#undef PG8_LDB
#undef PG8_MMA
#undef PG8_WAIT_V
#undef PG8_WAIT_L
#undef PG8_BAR
#undef PG8_SCHED
}
}

typedef f32x4 AccT[2][2][4][2];
#define EPI_LANE const int t_ = tid_(), wid_ = t_ >> 6, ln_ = t_ & 63, wr_ = wid_ >> 2, wc_ = wid_ & 3, fr_ = ln_ & 15, fq_ = ln_ >> 4;
#define EPI_LOOP_PERM(...) EPI_LANE \
    const int row0 = u.pm * 256 + wr_ * 64 + fr_, col0 = u.pn * 256 + wc_ * 32 + 8 * fq_; \
    _Pragma("unroll") for (int ai = 0; ai < 2; ++ai) _Pragma("unroll") for (int m = 0; m < 4; ++m) { const int row = row0 + ai * 128 + m * 16; \
        _Pragma("unroll") for (int bj = 0; bj < 2; ++bj) { const int col = col0 + bj * 128; const f32x4 v0 = acc[ai][bj][m][0], v1 = acc[ai][bj][m][1]; __VA_ARGS__ } }
#define EPI_LOOP_NAT(...) EPI_LANE \
    const int row0 = u.pm * 256 + wr_ * 64 + fr_, col0 = u.pn * 256 + wc_ * 32 + 4 * fq_; \
    _Pragma("unroll") for (int ai = 0; ai < 2; ++ai) _Pragma("unroll") for (int m = 0; m < 4; ++m) { const int row = row0 + ai * 128 + m * 16; \
        _Pragma("unroll") for (int bj = 0; bj < 2; ++bj) _Pragma("unroll") for (int n = 0; n < 2; ++n) { const int col = col0 + bj * 128 + n * 16; const f32x4 v = acc[ai][bj][m][n]; __VA_ARGS__ } }

struct EpiSwiglu { static constexpr bool PERM = true; bf16_t* O;
    DI void operator()(const AccT& acc, const pg8::Unit& u, int wr, int wc, int fr, int fq) const {
        EPI_LOOP_PERM({ u32x2 w; w.x = pack2(siluf_(v0[0]) * v1[0], siluf_(v0[1]) * v1[1]); w.y = pack2(siluf_(v0[2]) * v1[2], siluf_(v0[3]) * v1[3]);
            *(u32x2*)(O + (size_t)row * DFF + (col >> 1)) = w; })
    } };
struct EpiResid { static constexpr bool PERM = false; float* H; float scale;
    DI void operator()(const AccT& acc, const pg8::Unit& u, int wr, int wc, int fr, int fq) const {
        EPI_LOOP_NAT({ f32x4* p = (f32x4*)(H + (size_t)row * DM + col); *p = *p + v * scale; })
    } };
struct EpiProj { static constexpr bool PERM = true; bf16_t* O; bf16_t* XK; bf16_t* XV;
    DI void operator()(const AccT& acc, const pg8::Unit& u, int wr, int wc, int fr, int fq) const {
        const bool is_mg = u.pn * 256 >= C_MG, is_cmp = (u.pn == 10);
        EPI_LOOP_PERM({ f32x4 a = v0, b = v1;
            if (is_mg) { for (int j = 0; j < 4; ++j) { a[j] = sigmoidf_(a[j]); b[j] = sigmoidf_(b[j]); } }
            u32x4 w; w.x = pack2(a[0], a[1]); w.y = pack2(a[2], a[3]); w.z = pack2(b[0], b[1]); w.w = pack2(b[2], b[3]);
            *(u32x4*)(O + (size_t)row * PLD + col) = w;
            if (is_cmp) { const int c = col - C_KC, kv = c >> 7, gg = (c >> 6) & 1, d = c & 63, bb = row >> 11, s = row & 2047, jj = s >> 4, l = s & 15;
                bf16_t* X = kv ? XV : XK; *(u32x4*)(X + ((size_t)((bb * 128 + jj) * 2 + gg)) * 1024 + l * 64 + d) = w; } })
    } };
struct EpiMerge { static constexpr bool PERM = true; bf16_t* MRG; const bf16_t* PROJ; int J;
    DI void operator()(const AccT& acc, const pg8::Unit& u, int wr, int wc, int fr, int fq) const {
        EPI_LOOP_PERM({ const u32x4 gt = *(const u32x4*)(PROJ + (size_t)row * PLD + C_MG + J * 1024 + col);
            u32x4* mp = (u32x4*)(MRG + (size_t)row * DM + col); u32x4 old = (u32x4){0u, 0u, 0u, 0u}; if (J > 0) old = *mp;
            float r[8]; const float x[8] = {v0[0], v0[1], v0[2], v0[3], v1[0], v1[1], v1[2], v1[3]};
            _Pragma("unroll") for (int j = 0; j < 8; ++j) { const unsigned gw = gt[j >> 1], ow = old[j >> 1];
                const float gf = (j & 1) ? __uint_as_float(gw & 0xFFFF0000u) : __uint_as_float(gw << 16);
                const float of = (j & 1) ? __uint_as_float(ow & 0xFFFF0000u) : __uint_as_float(ow << 16);
                r[j] = of + gf * x[j]; }
            u32x4 w; w.x = pack2(r[0], r[1]); w.y = pack2(r[2], r[3]); w.z = pack2(r[4], r[5]); w.w = pack2(r[6], r[7]); *mp = w; })
    } };
struct EpiF32 { static constexpr bool PERM = false; float* C; static constexpr int ldc = 256;
    DI void operator()(const AccT& acc, const pg8::Unit& u, int wr, int wc, int fr, int fq) const {
        EPI_LOOP_NAT({ *(f32x4*)(C + (size_t)row * ldc + col) = v; })
    } };
template <int LDC> struct EpiBf16 { static constexpr bool PERM = true; bf16_t* O; static constexpr int ldc = LDC;
    DI void operator()(const AccT& acc, const pg8::Unit& u, int wr, int wc, int fr, int fq) const {
        EPI_LOOP_PERM({ u32x4 w; w.x = pack2(v0[0], v0[1]); w.y = pack2(v0[2], v0[3]); w.z = pack2(v1[0], v1[1]); w.w = pack2(v1[2], v1[3]);
            *(u32x4*)(O + (size_t)row * ldc + col) = w; })
    } };
struct EpiPleGate { static constexpr bool PERM = false; float* H; const bf16_t* TMP;
    DI void operator()(const AccT& acc, const pg8::Unit& u, int wr, int wc, int fr, int fq) const {
        EPI_LOOP_NAT({ const u32x2 tw = *(const u32x2*)(TMP + (size_t)row * DM + col); f32x4* p = (f32x4*)(H + (size_t)row * DM + col); f32x4 h = *p;
            h[0] += sigmoidf_(v[0]) * __uint_as_float(tw.x << 16); h[1] += sigmoidf_(v[1]) * __uint_as_float(tw.x & 0xFFFF0000u);
            h[2] += sigmoidf_(v[2]) * __uint_as_float(tw.y << 16); h[3] += sigmoidf_(v[3]) * __uint_as_float(tw.y & 0xFFFF0000u); *p = h; })
    } };

struct EpiLora { static constexpr bool PERM = true; bf16_t* EWA; bf16_t* G;
    DI void operator()(const AccT& acc, const pg8::Unit& u, int wr, int wc, int fr, int fq) const {
        const bool isg = u.pn >= 4; bf16_t* O = isg ? G - 1024 : EWA; const int ld = isg ? 512 : 1024;
        EPI_LOOP_PERM({ u32x4 w; w.x = pack2(v0[0], v0[1]); w.y = pack2(v0[2], v0[3]); w.z = pack2(v1[0], v1[1]); w.w = pack2(v1[2], v1[3]);
            *(u32x4*)(O + (size_t)row * ld + col) = w; })
    } };

template <class Epi> DI void run_gemm(unsigned char* smem, const bf16_t* A, int lda, const bf16_t* Bt, int M, int N, int K, const Epi& E, int coff = 0) {
    __syncthreads();
    pg8::Gemm g; g.A = A; g.Bt = Bt; g.M = M; g.N = N; g.K = K; g.lda = lda;
    pg8::StaticOrder S; S.init(M, N, (int)gridDim.x, (bid_() + coff) % (int)gridDim.x);
    pg8::gemm_phase<Epi>((LAS unsigned char*)smem, g, S, E);
    __syncthreads();
}

struct MapId { DI int operator()(int n) const { return n; } };
struct MapGU { DI int operator()(int n) const { const int q = n >> 3, e = n & 7; return e < 4 ? 4 * q + e : DFF + 4 * q + (e - 4); } };
struct MapIn { DI int operator()(int n) const { return n < 3328 ? n : n + 24; } };
struct MapNg { DI int operator()(int n) const { return n < 24 ? 3328 + n : -1; } };
template <int TN, class Map> __device__ __forceinline__ void transpose_cvt_t(unsigned char* smem, const float* src, int ldsrc, bf16_t* dst, int K, int Nd, Map map, int& toff) {
    float* tile = (float*)smem;
    constexpr int RPP = 512 / TN;
    const int tid = tid_(), ntk = K / 64, nt = ntk * (Nd / TN);
    const int G = (int)gridDim.x, first = (bid_() + G - (toff % G)) % G;
    toff += nt;
    for (int t = first; t < nt; t += G) {
        const int n0 = (t / ntk) * TN, k0 = (t % ntk) * 64;
        const int nn = tid % TN, sc = map(n0 + nn);
#pragma unroll
        for (int p = 0; p < 64 / RPP; ++p) { const int kk = (tid / TN) + p * RPP; tile[kk * (TN + 1) + nn] = sc >= 0 ? src[(size_t)(k0 + kk) * ldsrc + sc] : 0.f; }
        __syncthreads();
#pragma unroll
        for (int p = 0; p < TN / 16; ++p) { const int nn2 = (tid >> 5) + p * 16, kk2 = (tid & 31) * 2;
            *(unsigned*)(dst + (size_t)(n0 + nn2) * K + k0 + kk2) = pack2(tile[kk2 * (TN + 1) + nn2], tile[(kk2 + 1) * (TN + 1) + nn2]); }
        __syncthreads();
    }
}
template <class Map> __device__ __forceinline__ void transpose_cvt(unsigned char* smem, const float* src, int ldsrc, bf16_t* dst, int K, int Nd, Map map, int& toff) {
    if ((Nd & 255) == 0) transpose_cvt_t<256>(smem, src, ldsrc, dst, K, Nd, map, toff); else transpose_cvt_t<64>(smem, src, ldsrc, dst, K, Nd, map, toff);
}
__device__ __forceinline__ void convert_layer_weights(unsigned char* smem, CP p, int L) {
    bf16_t* W = (bf16_t*)(p->ws + WS_WBF); int toff = 0;
    transpose_cvt(smem, p->in[I_F1GU] + (size_t)L * DM * 2 * DFF, 2 * DFF, W + E_GU1, DM, 2 * DFF, MapGU(), toff);
    transpose_cvt(smem, p->in[I_F1D] + (size_t)L * DFF * DM, DM, W + E_D1, DFF, DM, MapId(), toff);
    transpose_cvt(smem, p->in[I_WIN] + (size_t)L * DM * IN_COLS, IN_COLS, W + E_IN, DM, N_WIN, MapIn(), toff);
    transpose_cvt(smem, p->in[I_WIN] + (size_t)L * DM * IN_COLS, IN_COLS, W + E_NG, DM, 256, MapNg(), toff);
    for (int j = 0; j < 3; ++j) transpose_cvt(smem, p->in[I_WBR] + ((size_t)L * 3 + j) * 512 * DM, DM, W + E_BR + (size_t)j * 1024 * 512, 512, DM, MapId(), toff);
    transpose_cvt(smem, p->in[I_WOUT] + (size_t)L * DM * DM, DM, W + E_OUT, DM, DM, MapId(), toff);
    for (int i = bid_() * 512 + tid_(); i < 1536 * 256; i += gridDim.x * 512) { const int n = i >> 8, k = i & 255; float w = 0.f;
        if (n < 512) { if (k < 64) w = p->in[I_WB][((size_t)L * 64 + k) * 512 + n]; }
        else if (n < 1024) { if (k >= 64 && k < 128) w = p->in[I_AB][((size_t)L * 64 + (k - 64)) * 512 + (n - 512)]; }
        else { if (k >= 128) w = p->in[I_GB][((size_t)L * 128 + (k - 128)) * 512 + (n - 1024)]; }
        W[E_LORA + i] = f2bf(w); }
    transpose_cvt(smem, p->in[I_PLEG] + (size_t)L * DM * DM, DM, W + E_PG, DM, DM, MapId(), toff);
    transpose_cvt(smem, p->in[I_PLEW] + (size_t)L * 256 * DM, DM, W + E_PW, 256, DM, MapId(), toff);
    for (int kv = 0; kv < 2; ++kv) for (int hf = 0; hf < 2; ++hf)
        transpose_cvt(smem, p->in[I_CW1] + ((size_t)(L * 2 + kv) * 2048 + hf * 1024) * 128, 128, W + E_C1 + ((size_t)kv * 256 + hf * 128) * 1024, 1024, 128, MapId(), toff);
    { const int q = (int)gridDim.x - 1 - bid_(); const int tid = tid_();
      if (q >= 0 && q < 16 && tid < 256) {
        const int kv = tid >> 7, hc = tid & 127;
        const float* pe = p->in[I_PE] + (size_t)(L * 2 + kv) * 2048 + q * 128; const float* w1 = p->in[I_CW1] + ((size_t)(L * 2 + kv) * 2048 + q * 128) * 128 + hc;
        float s0 = 0.f, s1 = 0.f, s2 = 0.f, s3 = 0.f;
#pragma unroll 4
        for (int i = 0; i < 128; i += 4) { s0 += pe[i] * w1[(size_t)i * 128]; s1 += pe[i + 1] * w1[(size_t)(i + 1) * 128]; s2 += pe[i + 2] * w1[(size_t)(i + 2) * 128]; s3 += pe[i + 3] * w1[(size_t)(i + 3) * 128]; }
        ((float*)(p->ws + WS_PEB))[(q * 2 + kv) * 128 + hc] = (s0 + s1) + (s2 + s3);
      } }
}

__device__ __forceinline__ void convert_ffn2_weights(unsigned char* smem, CP p, int L) {
    bf16_t* W = (bf16_t*)(p->ws + WS_WBF); int toff = 0;
    transpose_cvt(smem, p->in[I_F2GU] + (size_t)L * DM * 2 * DFF, 2 * DFF, W + E_GU2, DM, 2 * DFF, MapGU(), toff);
    transpose_cvt(smem, p->in[I_F2D] + (size_t)L * DFF * DM, DM, W + E_D2, DFF, DM, MapId(), toff);
}
__device__ __forceinline__ void lora_act(CP p, int L) {
    const bf16_t* PROJ = (const bf16_t*)(p->ws + WS_PROJ); bf16_t* LACT = (bf16_t*)(p->ws + WS_LACT);
    const float* mu = p->in[I_MU] + (size_t)L * 1792 + 1536;
    for (int i = bid_() * 512 + tid_(); i < T_TOK * 32; i += gridDim.x * 512) {
        const int t = i >> 5, j0 = (i & 31) * 8; const bf16_t* row = PROJ + (size_t)t * PLD + C_RW + 1536 + j0;
        const u32x4 cur = *(const u32x4*)row; u32x4 prv = {0u, 0u, 0u, 0u}; if ((t & (SEQ - 1)) != 0) prv = *(const u32x4*)(row - PLD);
        float r[8];
#pragma unroll
        for (int e = 0; e < 8; ++e) { const float x1 = (e & 1) ? __uint_as_float(cur[e >> 1] & 0xFFFF0000u) : __uint_as_float(cur[e >> 1] << 16);
            const float xp = (e & 1) ? __uint_as_float(prv[e >> 1] & 0xFFFF0000u) : __uint_as_float(prv[e >> 1] << 16);
            float xm = x1 + (xp - x1) * mu[j0 + e];
            if (j0 < 64) xm = tanhf(xm); else if (j0 >= 128) xm = sigmoidf_(xm);
            r[e] = xm; }
        u32x4 w; w.x = pack2(r[0], r[1]); w.y = pack2(r[2], r[3]); w.z = pack2(r[4], r[5]); w.w = pack2(r[6], r[7]);
        *(u32x4*)(LACT + (size_t)t * 256 + j0) = w;
    }
}

__device__ __forceinline__ void rmsnorm_rows(const float* hin, float* hcopy, const float* g, bf16_t* un, float* outf) {
    const int lane = tid_() & 63, gw = bid_() * 8 + (tid_() >> 6), nw = gridDim.x * 8;
    f32x4 gv[4];
#pragma unroll
    for (int i = 0; i < 4; ++i) gv[i] = *(const f32x4*)(g + lane * 4 + i * 256);
    for (int row0 = gw * 2; row0 < T_TOK; row0 += nw * 2) {
        f32x4 x[2][4]; float ss[2] = {0.f, 0.f};
#pragma unroll
        for (int r = 0; r < 2; ++r)
#pragma unroll
            for (int i = 0; i < 4; ++i) x[r][i] = *(const f32x4*)(hin + (size_t)(row0 + r) * DM + lane * 4 + i * 256);
#pragma unroll
        for (int r = 0; r < 2; ++r) {
#pragma unroll
            for (int i = 0; i < 4; ++i) ss[r] += x[r][i][0] * x[r][i][0] + x[r][i][1] * x[r][i][1] + x[r][i][2] * x[r][i][2] + x[r][i][3] * x[r][i][3];
            ss[r] = wave_sum(ss[r]); }
#pragma unroll
        for (int r = 0; r < 2; ++r) { const int row = row0 + r; const float rs = rsqrtf(ss[r] * (1.0f / DM) + 1e-6f);
#pragma unroll
            for (int i = 0; i < 4; ++i) {
                const f32x4 y = x[r][i] * rs * gv[i];
                if (hcopy) *(f32x4*)(hcopy + (size_t)row * DM + lane * 4 + i * 256) = x[r][i];
                if (un) { u32x2 w; w.x = pack2(y[0], y[1]); w.y = pack2(y[2], y[3]); *(u32x2*)(un + (size_t)row * DM + lane * 4 + i * 256) = w; }
                if (outf) *(f32x4*)(outf + (size_t)row * DM + lane * 4 + i * 256) = y;
            } }
    }
}
__device__ __forceinline__ void cvt_f32_bf16(const float* src, bf16_t* dst, size_t n4) {
    for (size_t i = (size_t)bid_() * 512 + tid_(); i < n4; i += (size_t)gridDim.x * 512) {
        const f32x4 v = *(const f32x4*)(src + i * 4); u32x2 w; w.x = pack2(v[0], v[1]); w.y = pack2(v[2], v[3]); *(u32x2*)(dst + i * 4) = w; }
}

__device__ __forceinline__ void finalize_cmp(unsigned char* smem, CP p, int L) {
    float* hid = (float*)smem + (tid_() >> 6) * 128;
    float* W2L = (float*)(smem + 4096);
    const int lane = tid_() & 63, gw = bid_() * 8 + (tid_() >> 6), nw = gridDim.x * 8;
    const float* peb = (const float*)(p->ws + WS_PEB);
    { const float* w2g = p->in[I_CW2] + (size_t)L * 2 * 128 * 64;
      for (int i = tid_(); i < 2 * 128 * 64 / 4; i += 512) *(f32x4*)(W2L + i * 4) = *(const f32x4*)(w2g + i * 4); }
    __syncthreads();
    const int total = 2 * 16 * 2 * 128, iters = (total + nw - 1) / nw;
    for (int it = 0; it < iters; ++it) {
        const int id = gw + it * nw; const bool ok = id < total;
        const int n = id & 127, gg = (id >> 7) & 1, bb = (id >> 8) & 15, kv = (id >> 12) & 1;
        if (ok && n < 127) {
            const float* Pm = (const float*)(p->ws + WS_P01) + (size_t)kv * 4096 * 256;
            const size_t r0 = (size_t)((bb * 128 + n) * 2 + gg) * 256, r1 = (size_t)((bb * 128 + n + 1) * 2 + gg) * 256;
#pragma unroll
            for (int q = 0; q < 2; ++q) { const int hc = lane + q * 64; float pb_ = 0.f; for (int s16 = 0; s16 < 16; ++s16) pb_ += peb[(s16 * 2 + kv) * 128 + hc];
                hid[hc] = siluf_(Pm[r0 + hc] + Pm[r1 + 128 + hc] + pb_); }
        }
        __syncthreads();
        if (ok) {
            float o0 = 0.f, o1 = 0.f;
            if (n < 127) { const float* w2 = W2L + kv * 8192 + lane;
#pragma unroll 8
                for (int hc = 0; hc < 128; hc += 2) { o0 += hid[hc] * w2[hc * 64]; o1 += hid[hc + 1] * w2[(hc + 1) * 64]; } }
            ((float*)(p->ws + WS_KC))[((((size_t)kv * 16 + bb) * 2 + gg) * 128 + n) * 64 + lane] = o0 + o1;
        }
        __syncthreads();
    }
}

__device__ __forceinline__ void hgrn_scan(unsigned char* smem, CP p, int L, int b, int h) {
    float* F = (float*)smem; float* Kx = F + 2048; float* Q = Kx + 2048; float* V = Q + 2048; float* PO = V + 2048;
    const int tid = tid_(), e = tid & 63, wv = tid >> 6, C = h * 64 + e;
    float lb;
    { const float* hl = p->in[I_HGLB]; const float a0 = hl[C], a1 = hl[512 + C], a2 = hl[1024 + C], a3 = hl[1536 + C];
      const float mx = fmaxf(fmaxf(a0, a1), fmaxf(a2, a3)); const float e0 = __expf(a0 - mx), e1 = __expf(a1 - mx), e2 = __expf(a2 - mx), e3 = __expf(a3 - mx);
      const float inv = 1.0f / (e0 + e1 + e2 + e3); float acc = 0.f; if (L >= 1) acc += e1; if (L >= 2) acc += e2; if (L >= 3) acc += e3; lb = fmaxf(acc * inv, 0.f); }
    const float ng = p->in[I_HGN][L * 512 + C];
    bf16_t* base = (bf16_t*)(p->ws + WS_PROJ) + (size_t)b * SEQ * PLD + C;
    f32x2 S0 = {0.f, 0.f}, S1 = {0.f, 0.f}, S2 = {0.f, 0.f}, S3 = {0.f, 0.f};
    bf16_t pz[4], pq[4], pi[4], pg[4];
#define HG_PREFETCH(T0) do { _Pragma("unroll") for (int i = 0; i < 4; ++i) { const bf16_t* row = base + (size_t)((T0) + wv * 4 + i) * PLD; \
        pz[i] = row[C_HF]; pq[i] = row[C_HQ]; pi[i] = row[C_HI]; pg[i] = row[C_HG]; } } while (0)
    HG_PREFETCH(0);
    for (int t0 = 0; t0 < SEQ; t0 += 32) {
        float gr[4];
#pragma unroll
        for (int i = 0; i < 4; ++i) { const int t = wv * 4 + i;
            const float z = bf2f(pz[i]), qr = bf2f(pq[i]), vi = bf2f(pi[i]); gr[i] = bf2f(pg[i]);
            const float sg = sigmoidf_(z); F[t * 64 + e] = sg + lb * (1.0f - sg); Kx[t * 64 + e] = (1.0f - lb) * (1.0f - sg); Q[t * 64 + e] = siluf_(qr); V[t * 64 + e] = vi; }
        __syncthreads();
        if (t0 + 32 < SEQ) HG_PREFETCH(t0 + 32);
#pragma unroll 4
        for (int t = 0; t < 32; ++t) {
            const f32x4 f0 = *(const f32x4*)(F + t * 64 + wv * 8), f1 = *(const f32x4*)(F + t * 64 + wv * 8 + 4);
            const f32x4 k0 = *(const f32x4*)(Kx + t * 64 + wv * 8), k1 = *(const f32x4*)(Kx + t * 64 + wv * 8 + 4);
            const f32x4 q0 = *(const f32x4*)(Q + t * 64 + wv * 8), q1 = *(const f32x4*)(Q + t * 64 + wv * 8 + 4);
            const float v = V[t * 64 + e]; const f32x2 vv = {v, v};
            S0 = (f32x2){f0[0], f0[1]} * S0 + (f32x2){k0[0], k0[1]} * vv; S1 = (f32x2){f0[2], f0[3]} * S1 + (f32x2){k0[2], k0[3]} * vv;
            S2 = (f32x2){f1[0], f1[1]} * S2 + (f32x2){k1[0], k1[1]} * vv; S3 = (f32x2){f1[2], f1[3]} * S3 + (f32x2){k1[2], k1[3]} * vv;
            f32x2 o2 = (f32x2){q0[0], q0[1]} * S0 + (f32x2){q0[2], q0[3]} * S1 + (f32x2){q1[0], q1[1]} * S2 + (f32x2){q1[2], q1[3]} * S3;
            PO[(t * 8 + wv) * 64 + e] = o2[0] + o2[1];
        }
        __syncthreads();
#pragma unroll
        for (int i = 0; i < 4; ++i) { const int t = wv * 4 + i;
            float o = 0.f;
#pragma unroll
            for (int q = 0; q < 8; ++q) o += PO[(t * 8 + q) * 64 + e];
            const float ss = wave_sum(o * o); const float rs = rsqrtf(ss * (1.0f / 64.0f) + 1e-6f);
            base[(size_t)(t0 + t) * PLD + C_HQ] = f2bf(o * rs * ng * siluf_(gr[i])); }
        __syncthreads();
    }
#undef HG_PREFETCH
}

DI float dpp_xor1(float v) { return __int_as_float(__builtin_amdgcn_mov_dpp(__float_as_int(v), 0xB1, 0xF, 0xF, true)); }
DI float dpp_xor2(float v) { return __int_as_float(__builtin_amdgcn_mov_dpp(__float_as_int(v), 0x4E, 0xF, 0xF, true)); }
DI float dpp_hmir(float v) { return __int_as_float(__builtin_amdgcn_mov_dpp(__float_as_int(v), 0x141, 0xF, 0xF, true)); }
DI float red8(float v) { v += dpp_xor1(v); v += dpp_xor2(v); v += dpp_hmir(v); return v; }

__device__ __forceinline__ void rwkv_scan(unsigned char* smem, CP p, int L, int b, int h) {
    constexpr int BUF_F = 6 * 2048 + 64 + 2048;
    const int tid = tid_(), c = tid & 63, wv = tid >> 6, C = h * 64 + c, lane = c;
    const float* mu = p->in[I_MU] + (size_t)L * 1792;
    const float mu_r = mu[C], mu_k = mu[512 + C], mu_v = mu[1024 + C];
    const float w0 = p->in[I_W0][L * 512 + C], a0 = p->in[I_A0][L * 512 + C];
    const float k_k = p->in[I_KK][L * 512 + C], k_a = p->in[I_KA][L * 512 + C], r_k = p->in[I_RK][L * 512 + C], ln_w = p->in[I_LNW][L * 512 + C], ln_b = p->in[I_LNB][L * 512 + C];
    const bf16_t* base = (const bf16_t*)(p->ws + WS_PROJ) + (size_t)b * SEQ * PLD + C_RW + C;
    const bf16_t* ewa = (const bf16_t*)(p->ws + WS_UN) + (size_t)b * SEQ * 1024 + C;
    bf16_t* obase = (bf16_t*)(p->ws + WS_ORW) + (size_t)b * SEQ * 512 + C;
    const int kp = lane & 7, vr = lane >> 3, vrow = wv * 8 + vr;
    f32x2 S0 = {0.f, 0.f}, S1 = {0.f, 0.f}, S2 = {0.f, 0.f}, S3 = {0.f, 0.f};
    bf16_t pr[4], pk[4], pv[4], pe[4], pa[4], pg[4], qr, qk, qv;
#define RW_PREFETCH(T0) do { const int s0_ = (T0) + wv * 4; \
        _Pragma("unroll") for (int i = 0; i < 4; ++i) { const bf16_t* row = base + (size_t)(s0_ + i) * PLD; pr[i] = row[0]; pk[i] = row[512]; pv[i] = row[1024]; \
            pe[i] = ewa[(size_t)(s0_ + i) * 1024]; pa[i] = ewa[(size_t)(s0_ + i) * 1024 + 512]; pg[i] = obase[(size_t)(s0_ + i) * 512]; } \
        if (s0_ > 0) { const bf16_t* row = base + (size_t)(s0_ - 1) * PLD; qr = row[0]; qk = row[512]; qv = row[1024]; } else { qr = 0; qk = 0; qv = 0; } } while (0)
    RW_PREFETCH(0);
    __syncthreads();
    for (int blk = 0; blk < SEQ / 32; ++blk) {
        float* Bf = (float*)smem + (blk & 1) * BUF_F;
        float* Wd = Bf; float* NKK = Bf + 2048; float* AB = Bf + 4096; float* KX = Bf + 6144; float* WR = Bf + 8192; float* VS = Bf + 10240; float* SC = Bf + 12288; float* YS = Bf + 12352;
        float bon[4], gv[4];
        { float rp = bf2f(qr), kq = bf2f(qk), vp = bf2f(qv);
#pragma unroll
          for (int i = 0; i < 4; ++i) { const int t = wv * 4 + i;
              const float r1 = bf2f(pr[i]), k1 = bf2f(pk[i]), v1 = bf2f(pv[i]);
              const float r = r1 + (rp - r1) * mu_r, k = k1 + (kq - k1) * mu_k, v = v1 + (vp - v1) * mu_v; rp = r1; kq = k1; vp = v1;
              const float decay = __expf(-0.6065306597f * sigmoidf_(w0 + bf2f(pe[i]))), a = sigmoidf_(a0 + bf2f(pa[i])); gv[i] = bf2f(pg[i]);
              const float kkv = k * k_k; const float ssq = wave_sum(kkv * kkv); const float kkn = kkv / fmaxf(sqrtf(ssq), 1e-12f);
              const float kx = k * (1.0f + (a - 1.0f) * k_a), ab = kkn * a;
              const float br = wave_sum(ab * r), kr = wave_sum(kx * r); bon[i] = wave_sum(r * kx * r_k);
              Wd[t * 64 + c] = decay; NKK[t * 64 + c] = -kkn; AB[t * 64 + c] = ab; KX[t * 64 + c] = kx; WR[t * 64 + c] = decay * r; VS[t * 64 + c] = v;
              if (c == 0) { SC[t * 2] = br; SC[t * 2 + 1] = kr; } } }
        __syncthreads();
        if (blk + 1 < SEQ / 32) RW_PREFETCH((blk + 1) * 32);
#define RW_LOAD(T, w0v, w1v, n0, n1, b0, b1, x0, x1, q0, q1, vv, sc) do { const int o_ = (T) * 64 + kp * 8; \
            w0v = *(const f32x4*)(Wd + o_); w1v = *(const f32x4*)(Wd + o_ + 4); n0 = *(const f32x4*)(NKK + o_); n1 = *(const f32x4*)(NKK + o_ + 4); \
            b0 = *(const f32x4*)(AB + o_); b1 = *(const f32x4*)(AB + o_ + 4); x0 = *(const f32x4*)(KX + o_); x1 = *(const f32x4*)(KX + o_ + 4); \
            q0 = *(const f32x4*)(WR + o_); q1 = *(const f32x4*)(WR + o_ + 4); vv = VS[(T) * 64 + vrow]; sc = *(const f32x2*)(SC + (T) * 2); } while (0)
        f32x4 cw0, cw1, cn0, cn1, cb0, cb1, cx0, cx1, cq0, cq1; float cvv; f32x2 csc;
        RW_LOAD(0, cw0, cw1, cn0, cn1, cb0, cb1, cx0, cx1, cq0, cq1, cvv, csc);
#pragma nounroll
        for (int t8 = 0; t8 < 4; ++t8) {
            float ykeep = 0.f;
#pragma unroll
            for (int j = 0; j < 8; ++j) {
                const int t = t8 * 8 + j;
                const f32x4 w0v = cw0, w1v = cw1, n0 = cn0, n1 = cn1, b0 = cb0, b1 = cb1, x0 = cx0, x1 = cx1, q0 = cq0, q1 = cq1; const float vv = cvv; const f32x2 sc = csc;
                { const int tn = (t + 1) & 31; RW_LOAD(tn, cw0, cw1, cn0, cn1, cb0, cb1, cx0, cx1, cq0, cq1, cvv, csc); }
                const f32x2 sa2 = S0 * (f32x2){n0[0], n0[1]} + S1 * (f32x2){n0[2], n0[3]} + S2 * (f32x2){n1[0], n1[1]} + S3 * (f32x2){n1[2], n1[3]};
                const f32x2 y2 = S0 * (f32x2){q0[0], q0[1]} + S1 * (f32x2){q0[2], q0[3]} + S2 * (f32x2){q1[0], q1[1]} + S3 * (f32x2){q1[2], q1[3]};
                float sa = sa2[0] + sa2[1], yy = y2[0] + y2[1];
                sa += dpp_xor1(sa); yy += dpp_xor1(yy); sa += dpp_xor2(sa); yy += dpp_xor2(yy); sa += dpp_hmir(sa); yy += dpp_hmir(yy);
                const f32x2 sav = {sa, sa}, vv2 = {vv, vv};
                S0 = S0 * (f32x2){w0v[0], w0v[1]} + sav * (f32x2){b0[0], b0[1]} + vv2 * (f32x2){x0[0], x0[1]};
                S1 = S1 * (f32x2){w0v[2], w0v[3]} + sav * (f32x2){b0[2], b0[3]} + vv2 * (f32x2){x0[2], x0[3]};
                S2 = S2 * (f32x2){w1v[0], w1v[1]} + sav * (f32x2){b1[0], b1[1]} + vv2 * (f32x2){x1[0], x1[1]};
                S3 = S3 * (f32x2){w1v[2], w1v[3]} + sav * (f32x2){b1[2], b1[3]} + vv2 * (f32x2){x1[2], x1[3]};
                const float y = yy + sa * sc[0] + vv * sc[1];
                ykeep = (kp == j) ? y : ykeep;
            }
            YS[(t8 * 8 + kp) * 64 + vrow] = ykeep;
        }
#undef RW_LOAD
        __syncthreads();
#pragma unroll
        for (int i = 0; i < 4; ++i) { const int t = wv * 4 + i;
            const float y = YS[t * 64 + c]; const float mean = wave_sum(y) * (1.0f / 64.0f); const float dlt = y - mean;
            const float var = wave_sum(dlt * dlt) * (1.0f / 64.0f);
            float yn = dlt * rsqrtf(var + 64e-5f) * ln_w + ln_b; yn += bon[i] * VS[t * 64 + c];
            obase[(size_t)(blk * 32 + t) * 512] = f2bf(yn * gv[i]); }
    }
#undef RW_PREFETCH
    __syncthreads();
}

DI int crow16(int i, int hl) { return (i & 3) + 8 * (i >> 2) + 4 * hl; }
__device__ __forceinline__ void rwkv_chunked(unsigned char* smem, CP p, int L, int b, int h) {
    bf16_t* ZB = (bf16_t*)smem;
    bf16_t* AR = (bf16_t*)(smem + 9216);
    bf16_t* BKt = (bf16_t*)(smem + 13824);
    bf16_t* UV = (bf16_t*)(smem + 18944);
    bf16_t* MT1 = (bf16_t*)(smem + 24064);
    bf16_t* MT2 = (bf16_t*)(smem + 25600);
    float* EW = (float*)(smem + 27136);
    bf16_t* BKr = (bf16_t*)(smem + 31232);
    float* Mf = (float*)(smem + 48640);
    float* Gs = (float*)(smem + 52864);
    float* YS = (float*)(smem + 57216);
    float* VS = (float*)(smem + 61312);
    float* PC = (float*)(smem + 65408);
    const int tid = tid_(), c = tid & 63, wv = tid >> 6, C = h * 64 + c, lane = c, qi = lane & 31, hl = lane >> 5;
    const float* mu = p->in[I_MU] + (size_t)L * 1792;
    const float mu_r = mu[C], mu_k = mu[512 + C], mu_v = mu[1024 + C];
    const float w0 = p->in[I_W0][L * 512 + C], a0 = p->in[I_A0][L * 512 + C];
    const float k_k = p->in[I_KK][L * 512 + C], k_a = p->in[I_KA][L * 512 + C], r_k = p->in[I_RK][L * 512 + C], ln_w = p->in[I_LNW][L * 512 + C], ln_b = p->in[I_LNB][L * 512 + C];
    const bf16_t* base = (const bf16_t*)(p->ws + WS_PROJ) + (size_t)b * SEQ * PLD + C_RW + C;
    const bf16_t* ewa = (const bf16_t*)(p->ws + WS_UN) + (size_t)b * SEQ * 1024 + C;
    bf16_t* obase = (bf16_t*)(p->ws + WS_ORW) + (size_t)b * SEQ * 512 + C;
    f32x16 zacc;
#pragma unroll
    for (int i = 0; i < 16; ++i) zacc[i] = 0.f;
    for (int i = tid; i < 64 * 72; i += 512) ZB[i] = 0;
    bf16_t pr[2], pk[2], pv[2], pe[2], pa[2], pg[2], qr, qk, qv;
#define RC_PREFETCH(T0) do { const int s0_ = (T0) + wv * 2; \
        _Pragma("unroll") for (int i = 0; i < 2; ++i) { const bf16_t* row = base + (size_t)(s0_ + i) * PLD; pr[i] = row[0]; pk[i] = row[512]; pv[i] = row[1024]; \
            pe[i] = ewa[(size_t)(s0_ + i) * 1024]; pa[i] = ewa[(size_t)(s0_ + i) * 1024 + 512]; pg[i] = obase[(size_t)(s0_ + i) * 512]; } \
        if (s0_ > 0) { const bf16_t* row = base + (size_t)(s0_ - 1) * PLD; qr = row[0]; qk = row[512]; qv = row[1024]; } else { qr = 0; qk = 0; qv = 0; } } while (0)
    RC_PREFETCH(0);
    __syncthreads();
    for (int ch = 0; ch < SEQ / 16; ++ch) {
        float bon[2], gv[2], r_[2], nk_[2], ab_[2], kx_[2], v_[2], ew_[2];
        { float rp = bf2f(qr), kq = bf2f(qk), vp = bf2f(qv);
#pragma unroll
          for (int i = 0; i < 2; ++i) { const int t = wv * 2 + i;
              const float r1 = bf2f(pr[i]), k1 = bf2f(pk[i]), v1 = bf2f(pv[i]);
              const float r = r1 + (rp - r1) * mu_r, k = k1 + (kq - k1) * mu_k, v = v1 + (vp - v1) * mu_v; rp = r1; kq = k1; vp = v1;
              const float ew = 0.6065306597f * sigmoidf_(w0 + bf2f(pe[i])), a = sigmoidf_(a0 + bf2f(pa[i])); gv[i] = bf2f(pg[i]);
              const float kkv = k * k_k; const float ssq = wave_sum(kkv * kkv); const float kkn = kkv * rsqrtf(fmaxf(ssq, 1e-24f));
              const float kx = k * (1.0f + (a - 1.0f) * k_a);
              bon[i] = wave_sum(r * kx * r_k);
              r_[i] = r; nk_[i] = kkn; ab_[i] = kkn * a; kx_[i] = kx; v_[i] = v; ew_[i] = ew; EW[t * 64 + c] = ew; } }
        __syncthreads();
        if (ch + 1 < SEQ / 16) RC_PREFETCH((ch + 1) * 16);
        { float ev[16];
#pragma unroll
          for (int j = 0; j < 16; ++j) ev[j] = EW[j * 64 + c];
#pragma unroll
          for (int i = 0; i < 2; ++i) { const int t = wv * 2 + i; float cum = 0.f;
#pragma unroll
            for (int j = 0; j < 16; ++j) cum += (j <= t) ? ev[j] : 0.f;
            const float Pt = __expf(-cum), Pm = __expf(-(cum - ew_[i])), iP = __expf(cum);
            const float al = -nk_[i] * Pm, rh = r_[i] * Pt, be = ab_[i] * iP, ka = kx_[i] * iP;
            AR[t * 72 + c] = f2bf(al); AR[(16 + t) * 72 + c] = f2bf(rh); BKr[t * 72 + c] = f2bf(be); BKr[(16 + t) * 72 + c] = f2bf(ka);
            BKt[c * 40 + t] = f2bf(be); BKt[c * 40 + 16 + t] = f2bf(ka);
            UV[c * 40 + 16 + t] = f2bf(v_[i]); VS[t * 64 + c] = v_[i];
            if (t == 15) PC[c] = Pt; } }
        __syncthreads();
        f32x16 acc;
#pragma unroll
        for (int i = 0; i < 16; ++i) acc[i] = 0.f;
        if (wv == 0) {
#pragma unroll
            for (int s = 0; s < 4; ++s) acc = MFMA32(*(const bf16x8*)(BKr + qi * 72 + 16 * s + 8 * hl), *(const bf16x8*)(AR + qi * 72 + 16 * s + 8 * hl), acc);
#pragma unroll
            for (int i = 0; i < 16; ++i) { const int j = crow16(i, hl), n = qi; const float m = acc[i];
                if (j < 16) { if (n < 16) Mf[j * 17 + n] = m; MT2[n * 24 + j] = f2bf((n >= 16 && j <= n - 16) ? m : 0.f); }
                else { const int i2 = j - 16; const bool k1 = n < 16 ? (i2 < n) : (i2 <= n - 16); MT1[n * 24 + i2] = f2bf(k1 ? m : 0.f); } }
        } else if (wv < 3) {
            const int vb = wv - 1;
#pragma unroll
            for (int s = 0; s < 4; ++s) acc = MFMA32(*(const bf16x8*)(ZB + (32 * vb + qi) * 72 + 16 * s + 8 * hl), *(const bf16x8*)(AR + qi * 72 + 16 * s + 8 * hl), acc);
        }
        __syncthreads();
        if (wv == 1 || wv == 2) { const int vb = wv - 1;
            acc = MFMA32(*(const bf16x8*)(UV + (32 * vb + qi) * 40 + 16 + 8 * hl), *(const bf16x8*)(MT1 + qi * 24 + 8 * hl), acc);
            if (qi < 16) {
#pragma unroll
                for (int i = 0; i < 16; ++i) Gs[(32 * vb + crow16(i, hl)) * 17 + qi] = acc[i]; }
        }
        __syncthreads();
        if (wv == 0) {
            float u[16];
#pragma unroll
            for (int t = 0; t < 16; ++t) { float x0 = Gs[lane * 17 + t], x1 = 0.f;
#pragma unroll
                for (int i = 0; i < t; ++i) { if (i & 1) x1 += u[i] * Mf[i * 17 + t]; else x0 += u[i] * Mf[i * 17 + t]; }
                u[t] = x0 + x1; UV[lane * 40 + t] = f2bf(u[t]); }
        }
        __syncthreads();
        if (wv == 1 || wv == 2) { const int vb = wv - 1;
            acc = MFMA32(*(const bf16x8*)(UV + (32 * vb + qi) * 40 + 8 * hl), *(const bf16x8*)(MT2 + qi * 24 + 8 * hl), acc);
            if (qi >= 16) {
#pragma unroll
                for (int i = 0; i < 16; ++i) YS[(qi - 16) * 64 + 32 * vb + crow16(i, hl)] = acc[i]; }
        }
        if (wv >= 4) { const int vb = (wv >> 1) & 1, kb = wv & 1;
#pragma unroll
            for (int s = 0; s < 2; ++s) zacc = MFMA32(*(const bf16x8*)(UV + (32 * vb + qi) * 40 + 16 * s + 8 * hl), *(const bf16x8*)(BKt + (32 * kb + qi) * 40 + 16 * s + 8 * hl), zacc);
            const float pc = PC[32 * kb + qi];
#pragma unroll
            for (int i = 0; i < 16; ++i) { zacc[i] *= pc; ZB[(32 * vb + crow16(i, hl)) * 72 + 32 * kb + qi] = f2bf(zacc[i]); }
        }
        __syncthreads();
#pragma unroll
        for (int i = 0; i < 2; ++i) { const int t = wv * 2 + i;
            const float y = YS[t * 64 + c]; const float mean = wave_sum(y) * (1.0f / 64.0f); const float dlt = y - mean;
            const float var = wave_sum(dlt * dlt) * (1.0f / 64.0f);
            float yn = dlt * rsqrtf(var + 64e-5f) * ln_w + ln_b; yn += bon[i] * VS[t * 64 + c];
            obase[(size_t)(ch * 16 + t) * 512] = f2bf(yn * gv[i]); }
    }
#undef RC_PREFETCH
    __syncthreads();
}

constexpr int KTS = 72;
DI bf16x8 pack8(float a0, float a1, float a2, float a3, float a4, float a5, float a6, float a7) {
    u32x4 w; w.x = pack2(a0, a1); w.y = pack2(a2, a3); w.z = pack2(a4, a5); w.w = pack2(a6, a7); return __builtin_bit_cast(bf16x8, w); }
DI bf16x8 ld_vfrag(const bf16_t* vt, int off) { const u32x2 lo = *(const u32x2*)(vt + off), hi = *(const u32x2*)(vt + off + 8); u32x4 w; w.x = lo.x; w.y = lo.y; w.z = hi.x; w.w = hi.y; return __builtin_bit_cast(bf16x8, w); }

struct FlashState { f32x16 o0, o1; float m, l; };

DI void flash_update(FlashState& st, f32x16& sc0, f32x16& sc1, const bf16_t* VT, int vs, int qi, int hl) {
    float mt = -INFINITY;
#pragma unroll
    for (int i = 0; i < 16; ++i) mt = fmaxf(mt, fmaxf(sc0[i], sc1[i]));
    mt = fmaxf(mt, shfl_xor_(mt, 32, qi + 32 * hl));
    const float mnew = fmaxf(st.m, mt), muse = (mnew == -INFINITY) ? 0.f : mnew;
    const float alpha = __builtin_amdgcn_exp2f(st.m - muse);
    float ls = 0.f;
#pragma unroll
    for (int i = 0; i < 16; ++i) { sc0[i] = __builtin_amdgcn_exp2f(sc0[i] - muse); sc1[i] = __builtin_amdgcn_exp2f(sc1[i] - muse); ls += sc0[i] + sc1[i]; }
    st.l = st.l * alpha + ls; st.m = mnew;
    st.o0 *= alpha; st.o1 *= alpha;
#pragma unroll
    for (int s = 0; s < 2; ++s) {
        const bf16x8 p0 = pack8(sc0[8 * s], sc0[8 * s + 1], sc0[8 * s + 2], sc0[8 * s + 3], sc0[8 * s + 4], sc0[8 * s + 5], sc0[8 * s + 6], sc0[8 * s + 7]);
        const bf16x8 p1 = pack8(sc1[8 * s], sc1[8 * s + 1], sc1[8 * s + 2], sc1[8 * s + 3], sc1[8 * s + 4], sc1[8 * s + 5], sc1[8 * s + 6], sc1[8 * s + 7]);
        st.o0 = MFMA32(ld_vfrag(VT, qi * vs + 16 * s + 4 * hl), p0, st.o0);
        st.o1 = MFMA32(ld_vfrag(VT, (32 + qi) * vs + 16 * s + 4 * hl), p0, st.o1);
        st.o0 = MFMA32(ld_vfrag(VT, qi * vs + 32 + 16 * s + 4 * hl), p1, st.o0);
        st.o1 = MFMA32(ld_vfrag(VT, (32 + qi) * vs + 32 + 16 * s + 4 * hl), p1, st.o1);
    }
}
DI void qk_tile(const bf16_t* KT, const bf16x8 (&qf)[4], int qi, int hl, f32x16& sc0, f32x16& sc1) {
#pragma unroll
    for (int i = 0; i < 16; ++i) { sc0[i] = 0.f; sc1[i] = 0.f; }
#pragma unroll
    for (int s = 0; s < 4; ++s) {
        const bf16x8 k0 = *(const bf16x8*)(KT + qi * KTS + 16 * s + 8 * hl), k1 = *(const bf16x8*)(KT + (32 + qi) * KTS + 16 * s + 8 * hl);
        sc0 = MFMA32(k0, qf[s], sc0); sc1 = MFMA32(k1, qf[s], sc1);
    }
}
struct KVRegs { u32x4 k, v; };
DI void kv_fetch(KVRegs& r, const bf16_t* pb, int kcol, int vcol, int k0) {
    const int tid = tid_();
    const unsigned ok_ = (unsigned)((k0 + (tid >> 3)) * PLD + kcol + (tid & 7) * 8) * 2u, ov_ = (unsigned)((k0 + (tid & 63)) * PLD + vcol + (tid >> 6) * 8) * 2u;
    r.k = *(const u32x4*)((const char*)pb + ok_);
    r.v = *(const u32x4*)((const char*)pb + ov_);
}
DI void kv_store(const KVRegs& r, bf16_t* KT, bf16_t* VT) {
    const int tid = tid_();
    *(u32x4*)(KT + (tid >> 3) * KTS + (tid & 7) * 8) = r.k;
    const int key = tid & 63, ch = tid >> 6;
#pragma unroll
    for (int j = 0; j < 8; ++j) VT[(ch * 8 + j) * KTS + key] = (bf16_t)((j & 1) ? (r.v[j >> 1] >> 16) : (r.v[j >> 1] & 0xFFFFu));
}
template <bool LUTB, bool CAUSAL, bool WHI, bool SEL>
DI void mask_tile(f32x16& sc0, f32x16& sc1, const float* lut, int qpos, int k0, int hl, bool sel, float qs) {
    const float bfar = lut[128];
#pragma unroll
    for (int i = 0; i < 16; ++i) { const int kl = (i & 3) + 8 * (i >> 2) + 4 * hl;
        { const int dist = qpos - (k0 + kl); const float v = sc0[i] * qs + (LUTB ? lut[dist > 128 ? 128 : (dist < 0 ? 0 : dist)] : bfar);
          bool ok = true; if (CAUSAL) ok = ok && dist >= 0; if (WHI) ok = ok && dist < 256; if (SEL) ok = ok && sel; sc0[i] = ok ? v : -INFINITY; }
        { const int dist = qpos - (k0 + 32 + kl); const float v = sc1[i] * qs + (LUTB ? lut[dist > 128 ? 128 : (dist < 0 ? 0 : dist)] : bfar);
          bool ok = true; if (CAUSAL) ok = ok && dist >= 0; if (WHI) ok = ok && dist < 256; if (SEL) ok = ok && sel; sc1[i] = ok ? v : -INFINITY; } }
}

__device__ __forceinline__ void nsa_item(unsigned char* smem, CP p, int L, int b, int g, int qb, int ocol) {
    bf16_t* KT = (bf16_t*)smem;
    bf16_t* VT = (bf16_t*)(smem + 9216);
    float* LUT = (float*)(smem + 18432);
    unsigned* SELM = (unsigned*)(smem + 20736);
    unsigned* ORM = (unsigned*)(smem + 20992);
    float* PA = (float*)(smem + 21504);
    float* PBv = (float*)(smem + 54272);
    bf16_t* KT2 = (bf16_t*)(smem + 87040);
    bf16_t* VT2 = (bf16_t*)(smem + 105472);
    const int tid = tid_(), lane = tid & 63, wv = tid >> 6, hh = wv >> 1, qhalf = wv & 1, qi = lane & 31, hl = lane >> 5;
    const int ql = qhalf * 32 + qi, qpos = qb * 64 + ql, head = g * 4 + hh;
    bf16_t* pb = (bf16_t*)(p->ws + WS_PROJ) + (size_t)b * SEQ * PLD;
    bf16_t* qrow = pb + (size_t)qpos * PLD;
    __syncthreads();
    for (int i = tid; i < 4 * 129; i += 512) { const int h2 = i / 129, dd = i % 129; int bk;
        if (dd < 16) bk = dd; else if (dd >= 128) bk = 31; else { bk = 16 + (int)(logf((float)dd / 16.0f) / 2.0794415416798357f * 16.0f); bk = bk > 31 ? 31 : bk; }
        LUT[h2 * 132 + dd] = p->in[I_RELB][bk * 8 + g * 4 + h2] * 1.4426950408889634f; }
    if (tid == 0) *ORM = 0u;
    if (tid < 64) SELM[tid] = 0u;
    if (tid < 256) PBv[tid * 32] = 0.f;
    { const float* kc = (const float*)(p->ws + WS_KC) + ((size_t)(0 * 16 + b) * 2 + g) * 128 * 64; const float* vc = (const float*)(p->ws + WS_KC) + ((size_t)(1 * 16 + b) * 2 + g) * 128 * 64;
      for (int i = tid; i < 128 * 64; i += 512) { const int n = i >> 6, d = i & 63; KT2[n * KTS + d] = f2bf(kc[i]); }
      for (int i = tid; i < 128 * 64; i += 512) { const int n = i & 127, d = i >> 7; VT2[d * 136 + n] = f2bf(vc[n * 64 + d]); } }
    bf16x8 qf[4];
#pragma unroll
    for (int s = 0; s < 4; ++s) qf[s] = *(const bf16x8*)(qrow + C_NQ + head * 64 + 16 * s + 8 * hl);
    float g0, g1, g2;
    { const bf16_t* gp = qrow + C_NG + head * 3; g0 = sigmoidf_(bf2f(gp[0])); g1 = sigmoidf_(bf2f(gp[1])); g2 = sigmoidf_(bf2f(gp[2])); }
    __syncthreads();
    const float* lut = LUT + hh * 132;
    constexpr float QS = 0.125f * 1.4426950408889634f;
    f32x16 fin0, fin1;
    {
        FlashState st;
#pragma unroll
        for (int i = 0; i < 16; ++i) { st.o0[i] = 0.f; st.o1[i] = 0.f; }
        st.m = -INFINITY; st.l = 0.f;
#pragma nounroll
        for (int t = 0; t < 2; ++t) {
            f32x16 sc0, sc1; qk_tile(KT2 + t * 64 * KTS, qf, qi, hl, sc0, sc1);
#pragma unroll
            for (int i = 0; i < 16; ++i) { const int kl = (i & 3) + 8 * (i >> 2) + 4 * hl;
                { const int n = 64 * t + kl, dist = qpos - (16 * n + 31); sc0[i] = (dist >= 0 && n < 127) ? sc0[i] * QS + lut[dist > 128 ? 128 : dist] : -INFINITY; }
                { const int n = 64 * t + 32 + kl, dist = qpos - (16 * n + 31); sc1[i] = (dist >= 0 && n < 127) ? sc1[i] * QS + lut[dist > 128 ? 128 : dist] : -INFINITY; } }
            flash_update(st, sc0, sc1, VT2 + 64 * t, 136, qi, hl);
        }
        const float lt = st.l + shfl_xor_(st.l, 32, lane); const float inv = 1.0f / fmaxf(lt, 1e-30f);
        const float muse = (st.m == -INFINITY) ? 0.f : st.m;
        fin0 = st.o0 * (g0 * inv); fin1 = st.o1 * (g0 * inv);
#pragma nounroll
        for (int t = 0; t < 2; ++t) {
            f32x16 sc0, sc1; qk_tile(KT2 + t * 64 * KTS, qf, qi, hl, sc0, sc1);
#pragma unroll
            for (int i = 0; i < 16; ++i) { const int kl = (i & 3) + 8 * (i >> 2) + 4 * hl;
                { const int n = 64 * t + kl, dist = qpos - (16 * n + 31); sc0[i] = (dist >= 0 && n < 127) ? __builtin_amdgcn_exp2f(sc0[i] * QS + lut[dist > 128 ? 128 : dist] - muse) * inv : 0.f; }
                { const int n = 64 * t + 32 + kl, dist = qpos - (16 * n + 31); sc1[i] = (dist >= 0 && n < 127) ? __builtin_amdgcn_exp2f(sc1[i] * QS + lut[dist > 128 ? 128 : dist] - muse) * inv : 0.f; } }
#pragma unroll
            for (int i4 = 0; i4 < 4; ++i4) {
                { const int m = 16 * t + 2 * i4 + hl; PA[(hh * 64 + ql) * 32 + m] = sc0[4 * i4] + sc0[4 * i4 + 1] + sc0[4 * i4 + 2] + sc0[4 * i4 + 3]; PBv[(hh * 64 + ql) * 32 + m + 1] = sc0[4 * i4 + 3]; }
                { const int m = 16 * t + 8 + 2 * i4 + hl; PA[(hh * 64 + ql) * 32 + m] = sc1[4 * i4] + sc1[4 * i4 + 1] + sc1[4 * i4 + 2] + sc1[4 * i4 + 3]; if (m + 1 < 32) PBv[(hh * 64 + ql) * 32 + m + 1] = sc1[4 * i4 + 3]; }
            }
        }
    }
    __syncthreads();
    {
        float* IMP = (float*)smem;
        const int q = tid & 63, part = tid >> 6, cur = qb;
#pragma unroll
        for (int mm = 0; mm < 4; ++mm) { const int m = part * 4 + mm; float v;
            if (m == 0 || m == cur || m == cur - 1) v = INFINITY;
            else if (m <= cur) { v = 0.f; for (int h2 = 0; h2 < 4; ++h2) v += PA[(h2 * 64 + q) * 32 + m] + PBv[(h2 * 64 + q) * 32 + m]; }
            else v = -INFINITY;
            IMP[q * 33 + m] = v; }
        __syncthreads();
        unsigned bits = 0u;
#pragma unroll
        for (int mm = 0; mm < 4; ++mm) { const int m = part * 4 + mm; const float v = IMP[q * 33 + m]; int rank = 0;
            for (int m2 = 0; m2 < 32; ++m2) { const float v2 = IMP[q * 33 + m2]; rank += (v2 > v || (v2 == v && m2 < m)) ? 1 : 0; }
            if (rank < 8 && v > -INFINITY) bits |= 1u << m; }
        atomicOr(&SELM[q], bits); atomicOr(ORM, bits);
    }
    __syncthreads();
    const unsigned mysel = SELM[ql], orm = *ORM;
    __syncthreads();
    float* PARK = PA + (wv * 32) * 64 + lane;
#pragma unroll
    for (int i = 0; i < 16; ++i) { PARK[i * 64] = fin0[i]; PARK[(16 + i) * 64] = fin1[i]; }
    {
        FlashState st;
#pragma unroll
        for (int i = 0; i < 16; ++i) { st.o0[i] = 0.f; st.o1[i] = 0.f; }
        st.m = -INFINITY; st.l = 0.f;
        const unsigned todo = orm & (qb >= 31 ? 0xFFFFFFFFu : ((2u << qb) - 1u));
        KVRegs kr;
        int m = todo ? __builtin_ctz(todo) : -1;
        if (m >= 0) { kv_fetch(kr, pb, C_KS + g * 64, C_VS + g * 64, m * 64); __syncthreads(); kv_store(kr, KT, VT); __syncthreads(); }
        while (m >= 0) {
            const unsigned rest = todo & ~((2u << m) - 1u); const int nm = (m < 31 && rest) ? __builtin_ctz(rest) : -1;
            if (nm >= 0) kv_fetch(kr, pb, C_KS + g * 64, C_VS + g * 64, nm * 64);
            const bool sel = (mysel >> m) & 1u;
            if (__builtin_amdgcn_ballot_w64(sel) != 0ull) {
                f32x16 sc0, sc1; qk_tile(KT, qf, qi, hl, sc0, sc1);
                if (m + 3 <= qb) mask_tile<false, false, false, true>(sc0, sc1, lut, qpos, m * 64, hl, sel, QS);
                else mask_tile<true, true, false, true>(sc0, sc1, lut, qpos, m * 64, hl, sel, QS);
                flash_update(st, sc0, sc1, VT, KTS, qi, hl);
            }
            __syncthreads();
            if (nm >= 0) kv_store(kr, KT, VT);
            __syncthreads();
            m = nm;
        }
        const float lt = st.l + shfl_xor_(st.l, 32, lane); const float sc = g1 / fmaxf(lt, 1e-30f);
#pragma unroll
        for (int i = 0; i < 16; ++i) { PARK[i * 64] += st.o0[i] * sc; PARK[(16 + i) * 64] += st.o1[i] * sc; }
    }
    {
        FlashState st;
#pragma unroll
        for (int i = 0; i < 16; ++i) { st.o0[i] = 0.f; st.o1[i] = 0.f; }
        st.m = -INFINITY; st.l = 0.f;
        KVRegs kr;
        int w = qb >= 4 ? 0 : 4 - qb;
        kv_fetch(kr, pb, C_KW + g * 64, C_VW + g * 64, qb * 64 - 256 + 64 * w); __syncthreads(); kv_store(kr, KT, VT); __syncthreads();
        for (; w < 5; ++w) {
            const int k0 = qb * 64 - 256 + 64 * w;
            if (w < 4) kv_fetch(kr, pb, C_KW + g * 64, C_VW + g * 64, k0 + 64);
            f32x16 sc0, sc1; qk_tile(KT, qf, qi, hl, sc0, sc1);
            if (w == 0) mask_tile<false, false, true, false>(sc0, sc1, lut, qpos, k0, hl, true, QS);
            else if (w == 1) mask_tile<false, false, false, false>(sc0, sc1, lut, qpos, k0, hl, true, QS);
            else if (w < 4) mask_tile<true, false, false, false>(sc0, sc1, lut, qpos, k0, hl, true, QS);
            else mask_tile<true, true, false, false>(sc0, sc1, lut, qpos, k0, hl, true, QS);
            flash_update(st, sc0, sc1, VT, KTS, qi, hl);
            __syncthreads();
            if (w < 4) kv_store(kr, KT, VT);
            __syncthreads();
        }
        const float lt = st.l + shfl_xor_(st.l, 32, lane); const float sc = g2 / fmaxf(lt, 1e-30f);
#pragma unroll
        for (int i = 0; i < 16; ++i) { fin0[i] = PARK[i * 64] + st.o0[i] * sc; fin1[i] = PARK[(16 + i) * 64] + st.o1[i] * sc; }
    }
#pragma unroll
    for (int i4 = 0; i4 < 4; ++i4) {
        u32x2 w0; w0.x = pack2(fin0[4 * i4], fin0[4 * i4 + 1]); w0.y = pack2(fin0[4 * i4 + 2], fin0[4 * i4 + 3]);
        u32x2 w1; w1.x = pack2(fin1[4 * i4], fin1[4 * i4 + 1]); w1.y = pack2(fin1[4 * i4 + 2], fin1[4 * i4 + 3]);
        *(u32x2*)(qrow + ocol + head * 64 + 8 * i4 + 4 * hl) = w0;
        *(u32x2*)(qrow + ocol + head * 64 + 32 + 8 * i4 + 4 * hl) = w1;
    }
}

constexpr int PH_PER_LAYER = 15, PH_TOTAL = DEPTH * PH_PER_LAYER + 1;
enum { S_PREP = 0, S_GU1, S_D1, S_NORM_MIX, S_WIN, S_CMP, S_LORA, S_SCAN, S_MERGE, S_OUT, S_NORM2, S_GU2, S_D2, S_NORM_PLE, S_PLEG, S_FINAL };

__device__ __forceinline__ void run_phase(unsigned char* smem, CP p, int ph) {
    const bool fin = (ph == DEPTH * PH_PER_LAYER);
    const int L = fin ? 0 : ph / PH_PER_LAYER; const int sub = fin ? S_FINAL : ph % PH_PER_LAYER;
    unsigned char* ws = p->ws; float* H = p->out;
    bf16_t* W = (bf16_t*)(ws + WS_WBF); bf16_t* UN = (bf16_t*)(ws + WS_UN); bf16_t* PROJ = (bf16_t*)(ws + WS_PROJ); bf16_t* ACT = (bf16_t*)(ws + WS_ACT);
    bf16_t* TMP = (bf16_t*)(ws + WS_TMP); bf16_t* PBF = (bf16_t*)(ws + WS_PB); bf16_t* ORW = (bf16_t*)(ws + WS_ORW);
    bf16_t* XK = (bf16_t*)(ws + WS_XK); bf16_t* XV = (bf16_t*)(ws + WS_XV); float* P01 = (float*)(ws + WS_P01);
    if (sub == S_PREP) convert_layer_weights(smem, p, L);
    if (sub == S_NORM_MIX) convert_ffn2_weights(smem, p, L);
    if (sub == S_NORM2) cvt_f32_bf16(p->in[I_P] + (size_t)L * T_TOK * 256, PBF, (size_t)T_TOK * 256 / 4);
    if (sub == S_CMP) lora_act(p, L);
    if (sub == S_LORA) finalize_cmp(smem, p, L);
    if (sub == S_NORM_PLE) { EpiBf16<DM> e; e.O = TMP; run_gemm(smem, PBF, 256, W + E_PW, T_TOK, DM, 256, e); }
    if (sub == S_PREP || sub == S_NORM_MIX || sub == S_NORM2 || sub == S_NORM_PLE || sub == S_FINAL) {
        const float* hin = (sub == S_PREP && L == 0) ? p->in[I_X] : H; float* hcopy = (sub == S_PREP && L == 0) ? H : nullptr;
        const float* g = sub == S_PREP ? p->in[I_F1N] + L * DM : sub == S_NORM_MIX ? p->in[I_MIXN] + L * DM : sub == S_NORM2 ? p->in[I_F2N] + L * DM : sub == S_NORM_PLE ? p->in[I_PLEN] + L * DM : p->in[I_FINN];
        rmsnorm_rows(hin, hcopy, g, sub == S_FINAL ? nullptr : UN, sub == S_FINAL ? H : nullptr);
    } else if (sub == S_GU1 || sub == S_GU2) {
        EpiSwiglu e; e.O = ACT; run_gemm(smem, UN, DM, W + (sub == S_GU1 ? E_GU1 : E_GU2), T_TOK, 2 * DFF, DM, e);
    } else if (sub == S_D1 || sub == S_D2 || sub == S_OUT) {
        EpiResid e; e.H = H; e.scale = sub == S_OUT ? 1.0f : 0.5f;
        run_gemm(smem, sub == S_OUT ? UN : ACT, sub == S_OUT ? DM : DFF, W + (sub == S_D1 ? E_D1 : sub == S_D2 ? E_D2 : E_OUT), T_TOK, DM, sub == S_OUT ? DM : DFF, e);
    } else if (sub == S_WIN) {
        EpiProj e; e.O = PROJ; e.XK = XK; e.XV = XV; run_gemm(smem, UN, DM, W + E_IN, T_TOK, N_WIN, DM, e);
    } else if (sub == S_CMP) {
#pragma nounroll
        for (int kv = 0; kv < 2; ++kv) { EpiF32 e; e.C = P01 + (size_t)kv * 4096 * 256;
            run_gemm(smem, kv ? XV : XK, 1024, W + E_C1 + (size_t)kv * 256 * 1024, 4096, 256, 1024, e, kv ? 240 : 0); }
        { EpiBf16<PLD> e; e.O = PROJ + C_NG; run_gemm(smem, UN, DM, W + E_NG, T_TOK, 256, DM, e, 128); }
    } else if (sub == S_LORA) {
        EpiLora e; e.EWA = UN; e.G = ORW;
        run_gemm(smem, (const bf16_t*)(ws + WS_LACT), 256, W + E_LORA, T_TOK, 1536, 256, e);
    } else if (sub == S_SCAN) {
        for (int item = bid_(); item < 256; item += gridDim.x) {
            __syncthreads();
            if (item < 128) rwkv_chunked(smem, p, L, item >> 3, item & 7); else hgrn_scan(smem, p, L, (item - 128) >> 3, (item - 128) & 7);
        }
        unsigned* ctr = (unsigned*)(ws + 14336) + L * 64;
        volatile unsigned* slot = (volatile unsigned*)(smem + 141 * 1024);
        for (;;) {
            __syncthreads();
            if (tid_() == 0) *slot = __hip_atomic_fetch_add(ctr, 1u, __ATOMIC_RELAXED, __HIP_MEMORY_SCOPE_AGENT);
            __syncthreads();
            const unsigned idx = *slot;
            if (idx >= 1024u) break;
            const int bg = idx & 31, qb = 31 - (int)(idx >> 5);
            nsa_item(smem, p, L, bg >> 1, bg & 1, qb, C_NQ);
        }
    } else if (sub == S_MERGE) {
#pragma nounroll
        for (int j = 0; j < 3; ++j) { EpiMerge e; e.MRG = UN; e.PROJ = PROJ; e.J = j;
            const bf16_t* A = j == 0 ? PROJ + C_HQ : (j == 1 ? PROJ + C_NQ : ORW);
            run_gemm(smem, A, j == 2 ? 512 : PLD, W + E_BR + (size_t)j * 1024 * 512, T_TOK, DM, 512, e); }
    } else if (sub == S_PLEG) {
        EpiPleGate e; e.H = H; e.TMP = TMP; run_gemm(smem, UN, DM, W + E_PG, T_TOK, DM, DM, e);
    }
}

#define XB_TMO      128
#define XB_XCNT(j)  (256  + 64 * (j))
#define XB_XSUB(j)  (1280 + 64 * (j))
#define XB_XGEN(j)  (2304 + 64 * (j))
#define XB_TOP      3328
#define XB_TOPGEN   3392
#define XCD_BAR_WORDS 3456
#define XB_SPIN_CAP (1u << 20)
DI unsigned xb_ld(unsigned* p)              { return __hip_atomic_load(p, __ATOMIC_RELAXED, __HIP_MEMORY_SCOPE_AGENT); }
DI unsigned xb_add(unsigned* p, unsigned v) { return __hip_atomic_fetch_add(p, v, __ATOMIC_RELAXED, __HIP_MEMORY_SCOPE_AGENT); }
DI unsigned xb_xcc_id() { return (unsigned)__builtin_amdgcn_s_getreg((3 << 11) | 20) & 0xFu; }
#define XB_SPIN(cond, bar) do { unsigned _sp = 0; while (cond) { __builtin_amdgcn_s_sleep(1); \
    if ((++_sp & 255u) == 0u) { if (xb_ld(&(bar)[XB_TMO])) break; if (_sp > XB_SPIN_CAP) { atomicAdd(&(bar)[XB_TMO], 1u); break; } } } } while (0)
struct XcdBarrier { unsigned* bar; unsigned x; volatile LAS unsigned* st; };
DI XcdBarrier xcd_barrier_post(unsigned* bar, volatile LAS unsigned* st) {
    XcdBarrier b; b.bar = bar; b.x = xb_xcc_id(); b.st = st;
    if (threadIdx.x == 0) (void)xb_add(&bar[XB_XCNT(b.x)], 1u);
    return b;
}
DI void xcd_barrier_complete(unsigned* bar, unsigned x, unsigned& nloc, unsigned& nx) {
    const unsigned G = gridDim.x * gridDim.y * gridDim.z;
    unsigned sum, cnt, mine, sp = 0u;
    for (;;) {
        sum = 0u; cnt = 0u; mine = 0u;
#pragma unroll
        for (unsigned j = 0; j < 16; ++j) { const unsigned c = xb_ld(&bar[XB_XCNT(j)]); sum += c; cnt += (c > 0u) ? 1u : 0u; mine = (j == x) ? c : mine; }
        if (sum == G) break;
        __builtin_amdgcn_s_sleep(1);
        if ((++sp & 255u) == 0u) { if (xb_ld(&bar[XB_TMO])) break; if (sp > XB_SPIN_CAP) { atomicAdd(&bar[XB_TMO], 1u); break; } }
    }
    nloc = mine > 0u ? mine : 1u; nx = cnt > 0u ? cnt : 1u;
}
DI void xcd_barrier(const XcdBarrier& b) {
    asm volatile("s_waitcnt vmcnt(0)" ::: "memory");
    __syncthreads();
    if (threadIdx.x == 0) {
        unsigned* bar = b.bar;
        __builtin_amdgcn_s_waitcnt(0);
        unsigned nloc = b.st[0], nx = b.st[1];
        if (nloc == 0u) { xcd_barrier_complete(bar, b.x, nloc, nx); b.st[0] = nloc; b.st[1] = nx; }
        const unsigned old = xb_add(&bar[XB_XSUB(b.x)], 1u);
        const unsigned gen = old / nloc;
        if (old + 1u == (gen + 1u) * nloc) {
            __builtin_amdgcn_fence(__ATOMIC_RELEASE, "agent");
            asm volatile("s_waitcnt vmcnt(0)" ::: "memory");
            const unsigned og = xb_add(&bar[XB_TOP], 1u);
            const unsigned tg = og / nx;
            if (og + 1u == (tg + 1u) * nx) xb_add(&bar[XB_TOPGEN], 1u);
            else XB_SPIN(xb_ld(&bar[XB_TOPGEN]) == tg, bar);
            __builtin_amdgcn_fence(__ATOMIC_ACQUIRE, "agent");
            xb_add(&bar[XB_XGEN(b.x)], 1u);
            asm volatile("s_waitcnt vmcnt(0)" ::: "memory");
        } else {
            XB_SPIN(xb_ld(&bar[XB_XGEN(b.x)]) == gen, bar);
            __builtin_amdgcn_fence(__ATOMIC_ACQUIRE, "agent");
            asm volatile("s_waitcnt vmcnt(0)" ::: "memory");
        }
    }
    __syncthreads();
}

__global__ void __launch_bounds__(512, 2) mega_fwd(Params p) {
    extern __shared__ __attribute__((aligned(16))) unsigned char smem[];
    cg::grid_group grid = cg::this_grid();
    volatile LAS unsigned* xst = (volatile LAS unsigned*)(LAS unsigned char*)(smem + 140 * 1024);
    if (threadIdx.x == 0) { xst[0] = 0u; xst[1] = 0u; }
    __syncthreads();
    const XcdBarrier xb = xcd_barrier_post((unsigned*)(p.ws + WS_BAR), xst);
#ifndef PROBE_DUP
#define PROBE_DUP -1
#endif
    constexpr int IT_PER_LAYER = PH_PER_LAYER + (PROBE_DUP >= 0 ? 1 : 0);
    const int it_lo = p.ph_lo, it_hi = PROBE_DUP >= 0 ? DEPTH * IT_PER_LAYER + 1 : p.ph_hi;
    for (int it = it_lo; it < it_hi; ++it) {
        int ph = it;
        if (PROBE_DUP >= 0) { const int l_ = it / IT_PER_LAYER, r_ = it % IT_PER_LAYER; ph = l_ * PH_PER_LAYER + (r_ <= PROBE_DUP ? r_ : r_ - 1); }
        CP pp = (CP)__builtin_amdgcn_kernarg_segment_ptr(); asm volatile("" : "+s"(pp));
        run_phase(smem, pp, ph);
        if (it + 1 < it_hi) {
            if (it == it_lo) grid.sync();
            else xcd_barrier(xb);
        }
    }
}

#ifndef MULTI_LAUNCH
#define MULTI_LAUNCH 0
#endif

extern "C" void kernel_launch(void* const* d_in, const int* in_sizes, int n_in, void* d_out, int out_size, void* d_ws, size_t ws_size, hipStream_t stream) {
    static int grid = 0;
    if (grid == 0) {
        if (n_in != N_INPUTS || out_size != T_TOK * DM || ws_size < WS_END) { fprintf(stderr, "kernel_launch: unexpected shapes: n_in %d out %d ws %zu (need %zu)\n", n_in, out_size, ws_size, (size_t)WS_END); grid = -1; return; }
        int dev = 0, cus = 0, per_cu = 0;
        (void)hipGetDevice(&dev); (void)hipDeviceGetAttribute(&cus, hipDeviceAttributeMultiprocessorCount, dev);
        if (hipFuncSetAttribute((const void*)mega_fwd, hipFuncAttributeMaxDynamicSharedMemorySize, LDS_BYTES) != hipSuccess) { fprintf(stderr, "kernel_launch: hipFuncSetAttribute failed\n"); grid = -1; return; }
        if (hipOccupancyMaxActiveBlocksPerMultiprocessor(&per_cu, (const void*)mega_fwd, 512, LDS_BYTES) != hipSuccess || per_cu < 1) { fprintf(stderr, "kernel_launch: occupancy query gives %d\n", per_cu); per_cu = 1; }
        (void)hipGetLastError();
        grid = cus * 1;
        if (grid > 256) grid = 256;
        fprintf(stderr, "kernel_launch: grid %d (cus %d, per_cu %d)\n", grid, cus, per_cu);
    }
    if (grid < 0) return;
    (void)hipMemsetAsync(d_ws, 0, 16384, stream);
    Params p{};
    for (int i = 0; i < N_INPUTS; ++i) p.in[i] = (const float*)d_in[i];
    p.out = (float*)d_out; p.ws = (unsigned char*)d_ws;
#if MULTI_LAUNCH
    for (int ph = 0; ph < PH_TOTAL; ++ph) { p.ph_lo = ph; p.ph_hi = ph + 1; hipLaunchKernelGGL(mega_fwd, dim3(grid), dim3(512), LDS_BYTES, stream, p); }
#else
    p.ph_lo = 0; p.ph_hi = PH_TOTAL;
    void* args[] = {&p};
    hipError_t e = hipLaunchCooperativeKernel((const void*)mega_fwd, dim3(grid), dim3(512), args, LDS_BYTES, stream);
    if (e != hipSuccess) fprintf(stderr, "kernel_launch: cooperative launch failed: %s\n", hipGetErrorString(e));
#endif
}
```

```cpp
#include <hip/hip_runtime.h>
#include <hip/hip_cooperative_groups.h>
#include <cstdio>
namespace cg = cooperative_groups;

#define LAS __attribute__((address_space(3)))
#define DI __device__ __forceinline__
typedef unsigned short bf16_t;
typedef short bf16x8 __attribute__((ext_vector_type(8)));
typedef float f32x4 __attribute__((ext_vector_type(4)));
typedef float f32x2 __attribute__((ext_vector_type(2)));
typedef float f32x16 __attribute__((ext_vector_type(16)));
typedef unsigned u32x4 __attribute__((ext_vector_type(4)));
typedef unsigned u32x2 __attribute__((ext_vector_type(2)));

constexpr int T_TOK = 32768, SEQ = 2048, NB = 16, DM = 1024, DFF = 2816, DEPTH = 4;
constexpr int PLD = 8448;
constexpr int C_HQ = 0, C_HF = 512, C_HI = 1024, C_HG = 1536, C_NQ = 2048, C_KC = 2560, C_VC = 2688, C_KS = 2816, C_VS = 2944,
              C_KW = 3072, C_VW = 3200, C_RW = 3328, C_MG = 5120, C_NG = 8192, N_WIN = 8192, IN_COLS = 8216;
enum { I_X = 0, I_P, I_F1N, I_F1GU, I_F1D, I_MIXN, I_WIN, I_HGLB, I_HGN, I_PE, I_CW1, I_CW2, I_RELB, I_MU, I_W0, I_WB, I_A0, I_AB, I_GB,
       I_KK, I_KA, I_RK, I_LNW, I_LNB, I_WBR, I_WOUT, I_F2N, I_F2GU, I_F2D, I_PLEN, I_PLEG, I_PLEW, I_FINN, N_INPUTS };

constexpr size_t WS_BAR = 0;
constexpr size_t WS_PEB = 16384;
constexpr size_t WS_WBF = 32768;
constexpr size_t E_GU1 = 0, E_D1 = E_GU1 + 5632ull * 1024, E_IN = E_D1 + 1024ull * 2816, E_BR = E_IN + 8448ull * 1024, E_OUT = E_BR + 3ull * 1024 * 512,
                 E_GU2 = E_GU1, E_D2 = E_D1  , E_PG = E_OUT + 1024ull * 1024, E_PW = E_PG + 1024ull * 1024,
                 E_C1 = E_PW + 1024ull * 256, E_LORA = E_C1 + 2ull * 256 * 1024, E_NG = E_LORA + 1536ull * 256, E_END = E_NG + 256ull * 1024;
constexpr size_t WS_UN = WS_WBF + E_END * 2;
constexpr size_t WS_ORW = WS_UN + (size_t)T_TOK * 1024 * 2;
constexpr size_t WS_XK = WS_ORW + (size_t)T_TOK * 512 * 2;
constexpr size_t WS_XV = WS_XK + 4096ull * 1024 * 2;
constexpr size_t WS_P01 = WS_XV + 4096ull * 1024 * 2;
constexpr size_t WS_KC = WS_P01 + 2ull * 4096 * 256 * 4;
constexpr size_t WS_LACT = WS_KC + 2ull * 16 * 2 * 128 * 64 * 4;
constexpr size_t WS_PROJ = WS_LACT + (size_t)T_TOK * 256 * 2;
constexpr size_t WS_END = WS_PROJ + (size_t)T_TOK * PLD * 2;
constexpr size_t WS_ACT = WS_PROJ;
constexpr size_t WS_PB = WS_PROJ + 200ull * 1024 * 1024;
constexpr size_t WS_TMP = WS_PROJ + 256ull * 1024 * 1024;
constexpr int LDS_BYTES = 144 * 1024;

struct Params {
    const float* in[N_INPUTS];
    float* out;
    unsigned char* ws;
    int ph_lo, ph_hi;
};
typedef const Params __attribute__((address_space(4)))* CP;

DI int tid_() { int t = threadIdx.x; asm volatile("" : "+v"(t)); return t; }
DI int bid_() { int b = blockIdx.x; asm volatile("" : "+s"(b)); return b; }
typedef __bf16 bf16v2 __attribute__((ext_vector_type(2)));
DI float bf2f(bf16_t b) { return __uint_as_float(((unsigned)b) << 16); }
DI unsigned pack2(float lo, float hi) { const f32x2 v = {lo, hi}; return __builtin_bit_cast(unsigned, __builtin_convertvector(v, bf16v2)); }
DI bf16_t f2bf(float f) { return (bf16_t)(pack2(f, 0.f) & 0xFFFFu); }
DI float sigmoidf_(float x) { return __builtin_amdgcn_rcpf(1.0f + __builtin_amdgcn_exp2f(-1.4426950408889634f * x)); }
DI float siluf_(float x) { return x * __builtin_amdgcn_rcpf(1.0f + __builtin_amdgcn_exp2f(-1.4426950408889634f * x)); }
DI float shfl_xor_(float v, int mask, int lane) { return __int_as_float(__builtin_amdgcn_ds_bpermute((lane ^ mask) << 2, __float_as_int(v))); }
DI float dppf_(float v, int) { return v; }
#define DPPF(v, ctrl) __int_as_float(__builtin_amdgcn_mov_dpp(__float_as_int(v), ctrl, 0xF, 0xF, true))
DI float wave_sum(float v) {
    v += DPPF(v, 0xB1); v += DPPF(v, 0x4E); v += DPPF(v, 0x141); v += DPPF(v, 0x140);
    const float s0 = __int_as_float(__builtin_amdgcn_readlane(__float_as_int(v), 0)), s1 = __int_as_float(__builtin_amdgcn_readlane(__float_as_int(v), 16));
    const float s2 = __int_as_float(__builtin_amdgcn_readlane(__float_as_int(v), 32)), s3 = __int_as_float(__builtin_amdgcn_readlane(__float_as_int(v), 48));
    return (s0 + s1) + (s2 + s3);
}

#define MFMA32(a, b, c) __builtin_amdgcn_mfma_f32_32x32x16_bf16((a), (b), (c), 0, 0, 0)
namespace pg8 {
constexpr int BM = 256, BK = 64, HALF = 128, HTB = HALF * BK * 2, STAGE_BYTES = 8 * HTB, NXCD = 8, WGM = 8;
DI int lds_byte(int r, int c) { const int st = (r >> 4) * 2 + (c >> 5), rr = r & 15, cc = c & 31, ob = rr * 64 + cc * 2; return st * 1024 + (ob ^ (((ob >> 9) & 1) << 5)); }
DI void stage_rc(int b, int& R, int& C) { const int st = b / 1024, sb = b % 1024, swz = sb ^ (((sb >> 9) & 1) << 5); R = (st >> 1) * 16 + swz / 64; C = (st & 1) * 32 + (swz % 64) / 2; }
DI int perm32(int rho) { const int n = rho >> 4, i = rho & 15; return 8 * (i >> 2) + 4 * n + (i & 3); }
struct Unit { int pm, pn; };
struct Gemm { const bf16_t* A; const bf16_t* Bt; int M, N, K, lda; };
struct StaticOrder {
    int nM, nN, nwg, G, c;
    DI void init(int M, int N, int G_, int c_) { nM = M / BM; nN = N / BM; nwg = nM * nN; G = G_; c = c_; }
    DI bool next(int i, Unit& u) const {
        const long L = (long)i * G + c; if (L >= nwg) return false;
        int wgid = (int)L; { const int q = nwg / NXCD, r = nwg % NXCD, xcd = wgid % NXCD, off = wgid / NXCD; wgid = (xcd < r ? xcd * (q + 1) : r * (q + 1) + (xcd - r) * q) + off; }
        const int nig = WGM * nN, gid = wgid / nig, fm = gid * WGM, gsz = (nM - fm) < WGM ? (nM - fm) : WGM;
        u.pm = fm + ((wgid % nig) % gsz); u.pn = (wgid % nig) / gsz; return true;
    }
};

template <class Epi>
DI void gemm_phase(LAS unsigned char* lds, const Gemm g, const StaticOrder& S, const Epi& E) {
    int tid = tid_();
    const int wid = __builtin_amdgcn_readfirstlane(tid >> 6), lane = tid & 63, wr = wid >> 2, wc = wid & 3, fr = lane & 15, fq = lane >> 4;
    const int K = g.K, nt = K / BK, lda = g.lda;
    unsigned voffA[2], voffB[2];
#pragma unroll
    for (int i = 0; i < 2; ++i) { int R, C; stage_rc(tid * 16 + i * 8192, R, C); const int Rb = Epi::PERM ? ((R & ~31) + perm32(R & 31)) : R;
        voffA[i] = (unsigned)(R * lda + C) * 2u; voffB[i] = (unsigned)(Rb * K + C) * 2u; }
    const size_t kstep = (size_t)(BK * 2);
    const size_t hstepA = (size_t)HALF * lda * 2, hstepB = (size_t)HALF * K * 2;
    const size_t tstepA = 2 * hstepA, tstepB = 2 * hstepB;
    const unsigned ldsw = (unsigned)wid * 1024u;
    const int aoff = lds_byte(wr * 64 + fr, fq * 8), boff = lds_byte(wc * 32 + fr, fq * 8);
#define PG8_SA(b, h) (((b) * 2 + (h)) * HTB)
#define PG8_SB(b, h) ((4 + (b) * 2 + (h)) * HTB)
#define PG8_STAGE(bufoff, gbase, voff) do { _Pragma("unroll") for (int _i = 0; _i < 2; ++_i) \
        __builtin_amdgcn_global_load_lds((const unsigned*)((const char*)(gbase) + (voff)[_i]), (LAS unsigned*)(lds + (bufoff) + ldsw + _i * 8192), 16, 0, 0); } while (0)
#define PG8_LDA(dst, b, h) do { _Pragma("unroll") for (int m = 0; m < 4; ++m) _Pragma("unroll") for (int k = 0; k < 2; ++k) dst[m][k] = *(const LAS bf16x8*)(lds + PG8_SA(b, h) + aoff + m * 2048 + k * 1024); } while (0)
#define PG8_LDB(dst, b, h) do { _Pragma("unroll") for (int n = 0; n < 2; ++n) _Pragma("unroll") for (int k = 0; k < 2; ++k) dst[n][k] = *(const LAS bf16x8*)(lds + PG8_SB(b, h) + boff + n * 2048 + k * 1024); } while (0)
#define PG8_MMA(ai, bj, At, Bt) do { __builtin_amdgcn_s_setprio(1); _Pragma("unroll") for (int m = 0; m < 4; ++m) _Pragma("unroll") for (int n = 0; n < 2; ++n) _Pragma("unroll") for (int k = 0; k < 2; ++k) \
        acc[ai][bj][m][n] = __builtin_amdgcn_mfma_f32_16x16x32_bf16(Bt[n][k], At[m][k], acc[ai][bj][m][n], 0, 0, 0); __builtin_amdgcn_s_setprio(0); } while (0)
#define PG8_WAIT_V(n) asm volatile("s_waitcnt vmcnt(" #n ")" ::: "memory")
#define PG8_WAIT_L(n) asm volatile("s_waitcnt lgkmcnt(" #n ")" ::: "memory")
#define PG8_BAR __builtin_amdgcn_s_barrier()
#define PG8_SCHED __builtin_amdgcn_sched_barrier(0)
    Unit cur, nxt; int ui = 0;
    if (!S.next(0, cur)) return;
    f32x4 acc[2][2][4][2];
#pragma unroll
    for (int a = 0; a < 2; ++a)
#pragma unroll
        for (int b = 0; b < 2; ++b)
#pragma unroll
            for (int m = 0; m < 4; ++m)
#pragma unroll
                for (int n = 0; n < 2; ++n) acc[a][b][m][n] = (f32x4){0.f, 0.f, 0.f, 0.f};
    bf16x8 At[4][2], B0[2][2], B1[2][2];
    const char* cA = (const char*)g.A + (size_t)cur.pm * tstepA; const char* cB = (const char*)g.Bt + (size_t)cur.pn * tstepB;
    PG8_STAGE(PG8_SB(0, 0), cB, voffB); PG8_STAGE(PG8_SA(0, 0), cA, voffA); PG8_STAGE(PG8_SB(0, 1), cB + hstepB, voffB); PG8_STAGE(PG8_SA(0, 1), cA + hstepA, voffA);
    if (wr == 1) PG8_BAR;
    PG8_WAIT_V(4); PG8_BAR;
    PG8_STAGE(PG8_SB(1, 0), cB + kstep, voffB); PG8_STAGE(PG8_SA(1, 0), cA + kstep, voffA); PG8_STAGE(PG8_SB(1, 1), cB + hstepB + kstep, voffB);
    PG8_WAIT_V(6); PG8_BAR;
    for (;;) {
        const bool has_next = S.next(ui + 1, nxt);
        const char* nA = has_next ? (const char*)g.A + (size_t)nxt.pm * tstepA : cA; const char* nB = has_next ? (const char*)g.Bt + (size_t)nxt.pn * tstepB : cB;
        for (int t = 0; t < nt; t += 2) {
            const bool last = (t == nt - 2);
            const char* a1 = cA + (size_t)(t + 1) * kstep;
            const char* a2 = last ? nA : cA + (size_t)(t + 2) * kstep; const char* b2 = last ? nB : cB + (size_t)(t + 2) * kstep;
            const char* a3 = a2 + kstep; const char* b3 = b2 + kstep;
            PG8_LDB(B0, 0, 0); PG8_SCHED; PG8_LDA(At, 0, 0); PG8_STAGE(PG8_SA(1, 1), a1 + hstepA, voffA);
            PG8_WAIT_L(8); PG8_BAR; PG8_WAIT_L(0); PG8_MMA(0, 0, At, B0); PG8_BAR; PG8_SCHED;
            PG8_LDB(B1, 0, 1); PG8_STAGE(PG8_SB(0, 0), b2, voffB);
            PG8_BAR; PG8_WAIT_L(0); PG8_MMA(0, 1, At, B1); PG8_BAR;
            PG8_LDA(At, 0, 1); PG8_STAGE(PG8_SA(0, 0), a2, voffA);
            PG8_BAR; PG8_WAIT_L(0); PG8_MMA(1, 0, At, B0); PG8_BAR; PG8_SCHED;
            PG8_STAGE(PG8_SB(0, 1), b2 + hstepB, voffB);
            PG8_WAIT_V(6); PG8_BAR; PG8_MMA(1, 1, At, B1); PG8_BAR;
            PG8_LDB(B0, 1, 0); PG8_SCHED; PG8_LDA(At, 1, 0); PG8_STAGE(PG8_SA(0, 1), a2 + hstepA, voffA);
            PG8_WAIT_L(8); PG8_BAR; PG8_WAIT_L(0); PG8_MMA(0, 0, At, B0); PG8_BAR; PG8_SCHED;
            PG8_LDB(B1, 1, 1); PG8_STAGE(PG8_SB(1, 0), b3, voffB);
            PG8_BAR; PG8_WAIT_L(0); PG8_MMA(0, 1, At, B1); PG8_BAR;
            PG8_LDA(At, 1, 1); PG8_STAGE(PG8_SA(1, 0), a3, voffA);
            PG8_BAR; PG8_WAIT_L(0); PG8_MMA(1, 0, At, B0); PG8_BAR; PG8_SCHED;
            PG8_STAGE(PG8_SB(1, 1), b3 + hstepB, voffB);
            PG8_WAIT_V(6); PG8_BAR; PG8_MMA(1, 1, At, B1); PG8_BAR;
        }
        E(acc, cur, wr, wc, fr, fq);
        if (!has_next) break;
#pragma unroll
        for (int a = 0; a < 2; ++a)
#pragma unroll
            for (int b = 0; b < 2; ++b)
#pragma unroll
                for (int m = 0; m < 4; ++m)
#pragma unroll
                    for (int n = 0; n < 2; ++n) acc[a][b][m][n] = (f32x4){0.f, 0.f, 0.f, 0.f};
        cur = nxt; cA = nA; cB = nB; ++ui;
    }
    PG8_WAIT_V(0);
    if (wr == 0) PG8_BAR;
    PG8_BAR;
#undef PG8_SA
#undef PG8_SB
#undef PG8_STAGE
#undef PG8_LDA
#undef PG8_LDB
#undef PG8_MMA
#undef PG8_WAIT_V
#undef PG8_WAIT_L
#undef PG8_BAR
#undef PG8_SCHED
}
}

typedef f32x4 AccT[2][2][4][2];
#define EPI_LANE const int t_ = tid_(), wid_ = t_ >> 6, ln_ = t_ & 63, wr_ = wid_ >> 2, wc_ = wid_ & 3, fr_ = ln_ & 15, fq_ = ln_ >> 4;
#define EPI_LOOP_PERM(...) EPI_LANE \
    const int row0 = u.pm * 256 + wr_ * 64 + fr_, col0 = u.pn * 256 + wc_ * 32 + 8 * fq_; \
    _Pragma("unroll") for (int ai = 0; ai < 2; ++ai) _Pragma("unroll") for (int m = 0; m < 4; ++m) { const int row = row0 + ai * 128 + m * 16; \
        _Pragma("unroll") for (int bj = 0; bj < 2; ++bj) { const int col = col0 + bj * 128; const f32x4 v0 = acc[ai][bj][m][0], v1 = acc[ai][bj][m][1]; __VA_ARGS__ } }
#define EPI_LOOP_NAT(...) EPI_LANE \
    const int row0 = u.pm * 256 + wr_ * 64 + fr_, col0 = u.pn * 256 + wc_ * 32 + 4 * fq_; \
    _Pragma("unroll") for (int ai = 0; ai < 2; ++ai) _Pragma("unroll") for (int m = 0; m < 4; ++m) { const int row = row0 + ai * 128 + m * 16; \
        _Pragma("unroll") for (int bj = 0; bj < 2; ++bj) _Pragma("unroll") for (int n = 0; n < 2; ++n) { const int col = col0 + bj * 128 + n * 16; const f32x4 v = acc[ai][bj][m][n]; __VA_ARGS__ } }

struct EpiSwiglu { static constexpr bool PERM = true; bf16_t* O;
    DI void operator()(const AccT& acc, const pg8::Unit& u, int wr, int wc, int fr, int fq) const {
        EPI_LOOP_PERM({ u32x2 w; w.x = pack2(siluf_(v0[0]) * v1[0], siluf_(v0[1]) * v1[1]); w.y = pack2(siluf_(v0[2]) * v1[2], siluf_(v0[3]) * v1[3]);
            *(u32x2*)(O + (size_t)row * DFF + (col >> 1)) = w; })
    } };
struct EpiResid { static constexpr bool PERM = false; float* H; float scale;
    DI void operator()(const AccT& acc, const pg8::Unit& u, int wr, int wc, int fr, int fq) const {
        EPI_LOOP_NAT({ f32x4* p = (f32x4*)(H + (size_t)row * DM + col); *p = *p + v * scale; })
    } };
struct EpiProj { static constexpr bool PERM = true; bf16_t* O; bf16_t* XK; bf16_t* XV;
    DI void operator()(const AccT& acc, const pg8::Unit& u, int wr, int wc, int fr, int fq) const {
        const bool is_mg = u.pn * 256 >= C_MG, is_cmp = (u.pn == 10);
        EPI_LOOP_PERM({ f32x4 a = v0, b = v1;
            if (is_mg) { for (int j = 0; j < 4; ++j) { a[j] = sigmoidf_(a[j]); b[j] = sigmoidf_(b[j]); } }
            u32x4 w; w.x = pack2(a[0], a[1]); w.y = pack2(a[2], a[3]); w.z = pack2(b[0], b[1]); w.w = pack2(b[2], b[3]);
            *(u32x4*)(O + (size_t)row * PLD + col) = w;
            if (is_cmp) { const int c = col - C_KC, kv = c >> 7, gg = (c >> 6) & 1, d = c & 63, bb = row >> 11, s = row & 2047, jj = s >> 4, l = s & 15;
                bf16_t* X = kv ? XV : XK; *(u32x4*)(X + ((size_t)((bb * 128 + jj) * 2 + gg)) * 1024 + l * 64 + d) = w; } })
    } };
struct EpiMerge { static constexpr bool PERM = true; bf16_t* MRG; const bf16_t* PROJ; int J;
    DI void operator()(const AccT& acc, const pg8::Unit& u, int wr, int wc, int fr, int fq) const {
        EPI_LOOP_PERM({ const u32x4 gt = *(const u32x4*)(PROJ + (size_t)row * PLD + C_MG + J * 1024 + col);
            u32x4* mp = (u32x4*)(MRG + (size_t)row * DM + col); u32x4 old = (u32x4){0u, 0u, 0u, 0u}; if (J > 0) old = *mp;
            float r[8]; const float x[8] = {v0[0], v0[1], v0[2], v0[3], v1[0], v1[1], v1[2], v1[3]};
            _Pragma("unroll") for (int j = 0; j < 8; ++j) { const unsigned gw = gt[j >> 1], ow = old[j >> 1];
                const float gf = (j & 1) ? __uint_as_float(gw & 0xFFFF0000u) : __uint_as_float(gw << 16);
                const float of = (j & 1) ? __uint_as_float(ow & 0xFFFF0000u) : __uint_as_float(ow << 16);
                r[j] = of + gf * x[j]; }
            u32x4 w; w.x = pack2(r[0], r[1]); w.y = pack2(r[2], r[3]); w.z = pack2(r[4], r[5]); w.w = pack2(r[6], r[7]); *mp = w; })
    } };
struct EpiF32 { static constexpr bool PERM = false; float* C; static constexpr int ldc = 256;
    DI void operator()(const AccT& acc, const pg8::Unit& u, int wr, int wc, int fr, int fq) const {
        EPI_LOOP_NAT({ *(f32x4*)(C + (size_t)row * ldc + col) = v; })
    } };
template <int LDC> struct EpiBf16 { static constexpr bool PERM = true; bf16_t* O; static constexpr int ldc = LDC;
    DI void operator()(const AccT& acc, const pg8::Unit& u, int wr, int wc, int fr, int fq) const {
        EPI_LOOP_PERM({ u32x4 w; w.x = pack2(v0[0], v0[1]); w.y = pack2(v0[2], v0[3]); w.z = pack2(v1[0], v1[1]); w.w = pack2(v1[2], v1[3]);
            *(u32x4*)(O + (size_t)row * ldc + col) = w; })
    } };
struct EpiPleGate { static constexpr bool PERM = false; float* H; const bf16_t* TMP;
    DI void operator()(const AccT& acc, const pg8::Unit& u, int wr, int wc, int fr, int fq) const {
        EPI_LOOP_NAT({ const u32x2 tw = *(const u32x2*)(TMP + (size_t)row * DM + col); f32x4* p = (f32x4*)(H + (size_t)row * DM + col); f32x4 h = *p;
            h[0] += sigmoidf_(v[0]) * __uint_as_float(tw.x << 16); h[1] += sigmoidf_(v[1]) * __uint_as_float(tw.x & 0xFFFF0000u);
            h[2] += sigmoidf_(v[2]) * __uint_as_float(tw.y << 16); h[3] += sigmoidf_(v[3]) * __uint_as_float(tw.y & 0xFFFF0000u); *p = h; })
    } };

struct EpiLora { static constexpr bool PERM = true; bf16_t* EWA; bf16_t* G;
    DI void operator()(const AccT& acc, const pg8::Unit& u, int wr, int wc, int fr, int fq) const {
        const bool isg = u.pn >= 4; bf16_t* O = isg ? G - 1024 : EWA; const int ld = isg ? 512 : 1024;
        EPI_LOOP_PERM({ u32x4 w; w.x = pack2(v0[0], v0[1]); w.y = pack2(v0[2], v0[3]); w.z = pack2(v1[0], v1[1]); w.w = pack2(v1[2], v1[3]);
            *(u32x4*)(O + (size_t)row * ld + col) = w; })
    } };

template <class Epi> DI void run_gemm(unsigned char* smem, const bf16_t* A, int lda, const bf16_t* Bt, int M, int N, int K, const Epi& E, int coff = 0) {
    __syncthreads();
    pg8::Gemm g; g.A = A; g.Bt = Bt; g.M = M; g.N = N; g.K = K; g.lda = lda;
    pg8::StaticOrder S; S.init(M, N, (int)gridDim.x, (bid_() + coff) % (int)gridDim.x);
    pg8::gemm_phase<Epi>((LAS unsigned char*)smem, g, S, E);
    __syncthreads();
}

struct MapId { DI int operator()(int n) const { return n; } };
struct MapGU { DI int operator()(int n) const { const int q = n >> 3, e = n & 7; return e < 4 ? 4 * q + e : DFF + 4 * q + (e - 4); } };
struct MapIn { DI int operator()(int n) const { return n < 3328 ? n : n + 24; } };
struct MapNg { DI int operator()(int n) const { return n < 24 ? 3328 + n : -1; } };
template <int TN, class Map> __device__ __forceinline__ void transpose_cvt_t(unsigned char* smem, const float* src, int ldsrc, bf16_t* dst, int K, int Nd, Map map, int& toff) {
    float* tile = (float*)smem;
    constexpr int RPP = 512 / TN;
    const int tid = tid_(), ntk = K / 64, nt = ntk * (Nd / TN);
    const int G = (int)gridDim.x, first = (bid_() + G - (toff % G)) % G;
    toff += nt;
    for (int t = first; t < nt; t += G) {
        const int n0 = (t / ntk) * TN, k0 = (t % ntk) * 64;
        const int nn = tid % TN, sc = map(n0 + nn);
#pragma unroll
        for (int p = 0; p < 64 / RPP; ++p) { const int kk = (tid / TN) + p * RPP; tile[kk * (TN + 1) + nn] = sc >= 0 ? src[(size_t)(k0 + kk) * ldsrc + sc] : 0.f; }
        __syncthreads();
#pragma unroll
        for (int p = 0; p < TN / 16; ++p) { const int nn2 = (tid >> 5) + p * 16, kk2 = (tid & 31) * 2;
            *(unsigned*)(dst + (size_t)(n0 + nn2) * K + k0 + kk2) = pack2(tile[kk2 * (TN + 1) + nn2], tile[(kk2 + 1) * (TN + 1) + nn2]); }
        __syncthreads();
    }
}
template <class Map> __device__ __forceinline__ void transpose_cvt(unsigned char* smem, const float* src, int ldsrc, bf16_t* dst, int K, int Nd, Map map, int& toff) {
    if ((Nd & 255) == 0) transpose_cvt_t<256>(smem, src, ldsrc, dst, K, Nd, map, toff); else transpose_cvt_t<64>(smem, src, ldsrc, dst, K, Nd, map, toff);
}
__device__ __forceinline__ void convert_layer_weights(unsigned char* smem, CP p, int L) {
    bf16_t* W = (bf16_t*)(p->ws + WS_WBF); int toff = 0;
    transpose_cvt(smem, p->in[I_F1GU] + (size_t)L * DM * 2 * DFF, 2 * DFF, W + E_GU1, DM, 2 * DFF, MapGU(), toff);
    transpose_cvt(smem, p->in[I_F1D] + (size_t)L * DFF * DM, DM, W + E_D1, DFF, DM, MapId(), toff);
    transpose_cvt(smem, p->in[I_WIN] + (size_t)L * DM * IN_COLS, IN_COLS, W + E_IN, DM, N_WIN, MapIn(), toff);
    transpose_cvt(smem, p->in[I_WIN] + (size_t)L * DM * IN_COLS, IN_COLS, W + E_NG, DM, 256, MapNg(), toff);
    for (int j = 0; j < 3; ++j) transpose_cvt(smem, p->in[I_WBR] + ((size_t)L * 3 + j) * 512 * DM, DM, W + E_BR + (size_t)j * 1024 * 512, 512, DM, MapId(), toff);
    transpose_cvt(smem, p->in[I_WOUT] + (size_t)L * DM * DM, DM, W + E_OUT, DM, DM, MapId(), toff);
    for (int i = bid_() * 512 + tid_(); i < 1536 * 256; i += gridDim.x * 512) { const int n = i >> 8, k = i & 255; float w = 0.f;
        if (n < 512) { if (k < 64) w = p->in[I_WB][((size_t)L * 64 + k) * 512 + n]; }
        else if (n < 1024) { if (k >= 64 && k < 128) w = p->in[I_AB][((size_t)L * 64 + (k - 64)) * 512 + (n - 512)]; }
        else { if (k >= 128) w = p->in[I_GB][((size_t)L * 128 + (k - 128)) * 512 + (n - 1024)]; }
        W[E_LORA + i] = f2bf(w); }
    transpose_cvt(smem, p->in[I_PLEG] + (size_t)L * DM * DM, DM, W + E_PG, DM, DM, MapId(), toff);
    transpose_cvt(smem, p->in[I_PLEW] + (size_t)L * 256 * DM, DM, W + E_PW, 256, DM, MapId(), toff);
    for (int kv = 0; kv < 2; ++kv) for (int hf = 0; hf < 2; ++hf)
        transpose_cvt(smem, p->in[I_CW1] + ((size_t)(L * 2 + kv) * 2048 + hf * 1024) * 128, 128, W + E_C1 + ((size_t)kv * 256 + hf * 128) * 1024, 1024, 128, MapId(), toff);
    { const int q = (int)gridDim.x - 1 - bid_(); const int tid = tid_();
      if (q >= 0 && q < 16 && tid < 256) {
        const int kv = tid >> 7, hc = tid & 127;
        const float* pe = p->in[I_PE] + (size_t)(L * 2 + kv) * 2048 + q * 128; const float* w1 = p->in[I_CW1] + ((size_t)(L * 2 + kv) * 2048 + q * 128) * 128 + hc;
        float s0 = 0.f, s1 = 0.f, s2 = 0.f, s3 = 0.f;
#pragma unroll 4
        for (int i = 0; i < 128; i += 4) { s0 += pe[i] * w1[(size_t)i * 128]; s1 += pe[i + 1] * w1[(size_t)(i + 1) * 128]; s2 += pe[i + 2] * w1[(size_t)(i + 2) * 128]; s3 += pe[i + 3] * w1[(size_t)(i + 3) * 128]; }
        ((float*)(p->ws + WS_PEB))[(q * 2 + kv) * 128 + hc] = (s0 + s1) + (s2 + s3);
      } }
}

__device__ __forceinline__ void convert_ffn2_weights(unsigned char* smem, CP p, int L) {
    bf16_t* W = (bf16_t*)(p->ws + WS_WBF); int toff = 0;
    transpose_cvt(smem, p->in[I_F2GU] + (size_t)L * DM * 2 * DFF, 2 * DFF, W + E_GU2, DM, 2 * DFF, MapGU(), toff);
    transpose_cvt(smem, p->in[I_F2D] + (size_t)L * DFF * DM, DM, W + E_D2, DFF, DM, MapId(), toff);
}
__device__ __forceinline__ void lora_act(CP p, int L) {
    const bf16_t* PROJ = (const bf16_t*)(p->ws + WS_PROJ); bf16_t* LACT = (bf16_t*)(p->ws + WS_LACT);
    const float* mu = p->in[I_MU] + (size_t)L * 1792 + 1536;
    for (int i = bid_() * 512 + tid_(); i < T_TOK * 32; i += gridDim.x * 512) {
        const int t = i >> 5, j0 = (i & 31) * 8; const bf16_t* row = PROJ + (size_t)t * PLD + C_RW + 1536 + j0;
        const u32x4 cur = *(const u32x4*)row; u32x4 prv = {0u, 0u, 0u, 0u}; if ((t & (SEQ - 1)) != 0) prv = *(const u32x4*)(row - PLD);
        float r[8];
#pragma unroll
        for (int e = 0; e < 8; ++e) { const float x1 = (e & 1) ? __uint_as_float(cur[e >> 1] & 0xFFFF0000u) : __uint_as_float(cur[e >> 1] << 16);
            const float xp = (e & 1) ? __uint_as_float(prv[e >> 1] & 0xFFFF0000u) : __uint_as_float(prv[e >> 1] << 16);
            float xm = x1 + (xp - x1) * mu[j0 + e];
            if (j0 < 64) xm = tanhf(xm); else if (j0 >= 128) xm = sigmoidf_(xm);
            r[e] = xm; }
        u32x4 w; w.x = pack2(r[0], r[1]); w.y = pack2(r[2], r[3]); w.z = pack2(r[4], r[5]); w.w = pack2(r[6], r[7]);
        *(u32x4*)(LACT + (size_t)t * 256 + j0) = w;
    }
}

__device__ __forceinline__ void rmsnorm_rows(const float* hin, float* hcopy, const float* g, bf16_t* un, float* outf) {
    const int lane = tid_() & 63, gw = bid_() * 8 + (tid_() >> 6), nw = gridDim.x * 8;
    f32x4 gv[4];
#pragma unroll
    for (int i = 0; i < 4; ++i) gv[i] = *(const f32x4*)(g + lane * 4 + i * 256);
    for (int row0 = gw * 2; row0 < T_TOK; row0 += nw * 2) {
        f32x4 x[2][4]; float ss[2] = {0.f, 0.f};
#pragma unroll
        for (int r = 0; r < 2; ++r)
#pragma unroll
            for (int i = 0; i < 4; ++i) x[r][i] = *(const f32x4*)(hin + (size_t)(row0 + r) * DM + lane * 4 + i * 256);
#pragma unroll
        for (int r = 0; r < 2; ++r) {
#pragma unroll
            for (int i = 0; i < 4; ++i) ss[r] += x[r][i][0] * x[r][i][0] + x[r][i][1] * x[r][i][1] + x[r][i][2] * x[r][i][2] + x[r][i][3] * x[r][i][3];
            ss[r] = wave_sum(ss[r]); }
#pragma unroll
        for (int r = 0; r < 2; ++r) { const int row = row0 + r; const float rs = rsqrtf(ss[r] * (1.0f / DM) + 1e-6f);
#pragma unroll
            for (int i = 0; i < 4; ++i) {
                const f32x4 y = x[r][i] * rs * gv[i];
                if (hcopy) *(f32x4*)(hcopy + (size_t)row * DM + lane * 4 + i * 256) = x[r][i];
                if (un) { u32x2 w; w.x = pack2(y[0], y[1]); w.y = pack2(y[2], y[3]); *(u32x2*)(un + (size_t)row * DM + lane * 4 + i * 256) = w; }
                if (outf) *(f32x4*)(outf + (size_t)row * DM + lane * 4 + i * 256) = y;
            } }
    }
}
__device__ __forceinline__ void cvt_f32_bf16(const float* src, bf16_t* dst, size_t n4) {
    for (size_t i = (size_t)bid_() * 512 + tid_(); i < n4; i += (size_t)gridDim.x * 512) {
        const f32x4 v = *(const f32x4*)(src + i * 4); u32x2 w; w.x = pack2(v[0], v[1]); w.y = pack2(v[2], v[3]); *(u32x2*)(dst + i * 4) = w; }
}

__device__ __forceinline__ void finalize_cmp(unsigned char* smem, CP p, int L) {
    float* hid = (float*)smem + (tid_() >> 6) * 128;
    float* W2L = (float*)(smem + 4096);
    const int lane = tid_() & 63, gw = bid_() * 8 + (tid_() >> 6), nw = gridDim.x * 8;
    const float* peb = (const float*)(p->ws + WS_PEB);
    { const float* w2g = p->in[I_CW2] + (size_t)L * 2 * 128 * 64;
      for (int i = tid_(); i < 2 * 128 * 64 / 4; i += 512) *(f32x4*)(W2L + i * 4) = *(const f32x4*)(w2g + i * 4); }
    __syncthreads();
    const int total = 2 * 16 * 2 * 128, iters = (total + nw - 1) / nw;
    for (int it = 0; it < iters; ++it) {
        const int id = gw + it * nw; const bool ok = id < total;
        const int n = id & 127, gg = (id >> 7) & 1, bb = (id >> 8) & 15, kv = (id >> 12) & 1;
        if (ok && n < 127) {
            const float* Pm = (const float*)(p->ws + WS_P01) + (size_t)kv * 4096 * 256;
            const size_t r0 = (size_t)((bb * 128 + n) * 2 + gg) * 256, r1 = (size_t)((bb * 128 + n + 1) * 2 + gg) * 256;
#pragma unroll
            for (int q = 0; q < 2; ++q) { const int hc = lane + q * 64; float pb_ = 0.f; for (int s16 = 0; s16 < 16; ++s16) pb_ += peb[(s16 * 2 + kv) * 128 + hc];
                hid[hc] = siluf_(Pm[r0 + hc] + Pm[r1 + 128 + hc] + pb_); }
        }
        __syncthreads();
        if (ok) {
            float o0 = 0.f, o1 = 0.f;
            if (n < 127) { const float* w2 = W2L + kv * 8192 + lane;
#pragma unroll 8
                for (int hc = 0; hc < 128; hc += 2) { o0 += hid[hc] * w2[hc * 64]; o1 += hid[hc + 1] * w2[(hc + 1) * 64]; } }
            ((float*)(p->ws + WS_KC))[((((size_t)kv * 16 + bb) * 2 + gg) * 128 + n) * 64 + lane] = o0 + o1;
        }
        __syncthreads();
    }
}

__device__ __forceinline__ void hgrn_scan(unsigned char* smem, CP p, int L, int b, int h) {
    float* F = (float*)smem; float* Kx = F + 2048; float* Q = Kx + 2048; float* V = Q + 2048; float* PO = V + 2048;
    const int tid = tid_(), e = tid & 63, wv = tid >> 6, C = h * 64 + e;
    float lb;
    { const float* hl = p->in[I_HGLB]; const float a0 = hl[C], a1 = hl[512 + C], a2 = hl[1024 + C], a3 = hl[1536 + C];
      const float mx = fmaxf(fmaxf(a0, a1), fmaxf(a2, a3)); const float e0 = __expf(a0 - mx), e1 = __expf(a1 - mx), e2 = __expf(a2 - mx), e3 = __expf(a3 - mx);
      const float inv = 1.0f / (e0 + e1 + e2 + e3); float acc = 0.f; if (L >= 1) acc += e1; if (L >= 2) acc += e2; if (L >= 3) acc += e3; lb = fmaxf(acc * inv, 0.f); }
    const float ng = p->in[I_HGN][L * 512 + C];
    bf16_t* base = (bf16_t*)(p->ws + WS_PROJ) + (size_t)b * SEQ * PLD + C;
    f32x2 S0 = {0.f, 0.f}, S1 = {0.f, 0.f}, S2 = {0.f, 0.f}, S3 = {0.f, 0.f};
    bf16_t pz[4], pq[4], pi[4], pg[4];
#define HG_PREFETCH(T0) do { _Pragma("unroll") for (int i = 0; i < 4; ++i) { const bf16_t* row = base + (size_t)((T0) + wv * 4 + i) * PLD; \
        pz[i] = row[C_HF]; pq[i] = row[C_HQ]; pi[i] = row[C_HI]; pg[i] = row[C_HG]; } } while (0)
    HG_PREFETCH(0);
    for (int t0 = 0; t0 < SEQ; t0 += 32) {
        float gr[4];
#pragma unroll
        for (int i = 0; i < 4; ++i) { const int t = wv * 4 + i;
            const float z = bf2f(pz[i]), qr = bf2f(pq[i]), vi = bf2f(pi[i]); gr[i] = bf2f(pg[i]);
            const float sg = sigmoidf_(z); F[t * 64 + e] = sg + lb * (1.0f - sg); Kx[t * 64 + e] = (1.0f - lb) * (1.0f - sg); Q[t * 64 + e] = siluf_(qr); V[t * 64 + e] = vi; }
        __syncthreads();
        if (t0 + 32 < SEQ) HG_PREFETCH(t0 + 32);
#pragma unroll 4
        for (int t = 0; t < 32; ++t) {
            const f32x4 f0 = *(const f32x4*)(F + t * 64 + wv * 8), f1 = *(const f32x4*)(F + t * 64 + wv * 8 + 4);
            const f32x4 k0 = *(const f32x4*)(Kx + t * 64 + wv * 8), k1 = *(const f32x4*)(Kx + t * 64 + wv * 8 + 4);
            const f32x4 q0 = *(const f32x4*)(Q + t * 64 + wv * 8), q1 = *(const f32x4*)(Q + t * 64 + wv * 8 + 4);
            const float v = V[t * 64 + e]; const f32x2 vv = {v, v};
            S0 = (f32x2){f0[0], f0[1]} * S0 + (f32x2){k0[0], k0[1]} * vv; S1 = (f32x2){f0[2], f0[3]} * S1 + (f32x2){k0[2], k0[3]} * vv;
            S2 = (f32x2){f1[0], f1[1]} * S2 + (f32x2){k1[0], k1[1]} * vv; S3 = (f32x2){f1[2], f1[3]} * S3 + (f32x2){k1[2], k1[3]} * vv;
            f32x2 o2 = (f32x2){q0[0], q0[1]} * S0 + (f32x2){q0[2], q0[3]} * S1 + (f32x2){q1[0], q1[1]} * S2 + (f32x2){q1[2], q1[3]} * S3;
            PO[(t * 8 + wv) * 64 + e] = o2[0] + o2[1];
        }
        __syncthreads();
#pragma unroll
        for (int i = 0; i < 4; ++i) { const int t = wv * 4 + i;
            float o = 0.f;
#pragma unroll
            for (int q = 0; q < 8; ++q) o += PO[(t * 8 + q) * 64 + e];
            const float ss = wave_sum(o * o); const float rs = rsqrtf(ss * (1.0f / 64.0f) + 1e-6f);
            base[(size_t)(t0 + t) * PLD + C_HQ] = f2bf(o * rs * ng * siluf_(gr[i])); }
        __syncthreads();
    }
#undef HG_PREFETCH
}

DI float dpp_xor1(float v) { return __int_as_float(__builtin_amdgcn_mov_dpp(__float_as_int(v), 0xB1, 0xF, 0xF, true)); }
DI float dpp_xor2(float v) { return __int_as_float(__builtin_amdgcn_mov_dpp(__float_as_int(v), 0x4E, 0xF, 0xF, true)); }
DI float dpp_hmir(float v) { return __int_as_float(__builtin_amdgcn_mov_dpp(__float_as_int(v), 0x141, 0xF, 0xF, true)); }
DI float red8(float v) { v += dpp_xor1(v); v += dpp_xor2(v); v += dpp_hmir(v); return v; }

__device__ __forceinline__ void rwkv_scan(unsigned char* smem, CP p, int L, int b, int h) {
    constexpr int BUF_F = 6 * 2048 + 64 + 2048;
    const int tid = tid_(), c = tid & 63, wv = tid >> 6, C = h * 64 + c, lane = c;
    const float* mu = p->in[I_MU] + (size_t)L * 1792;
    const float mu_r = mu[C], mu_k = mu[512 + C], mu_v = mu[1024 + C];
    const float w0 = p->in[I_W0][L * 512 + C], a0 = p->in[I_A0][L * 512 + C];
    const float k_k = p->in[I_KK][L * 512 + C], k_a = p->in[I_KA][L * 512 + C], r_k = p->in[I_RK][L * 512 + C], ln_w = p->in[I_LNW][L * 512 + C], ln_b = p->in[I_LNB][L * 512 + C];
    const bf16_t* base = (const bf16_t*)(p->ws + WS_PROJ) + (size_t)b * SEQ * PLD + C_RW + C;
    const bf16_t* ewa = (const bf16_t*)(p->ws + WS_UN) + (size_t)b * SEQ * 1024 + C;
    bf16_t* obase = (bf16_t*)(p->ws + WS_ORW) + (size_t)b * SEQ * 512 + C;
    const int kp = lane & 7, vr = lane >> 3, vrow = wv * 8 + vr;
    f32x2 S0 = {0.f, 0.f}, S1 = {0.f, 0.f}, S2 = {0.f, 0.f}, S3 = {0.f, 0.f};
    bf16_t pr[4], pk[4], pv[4], pe[4], pa[4], pg[4], qr, qk, qv;
#define RW_PREFETCH(T0) do { const int s0_ = (T0) + wv * 4; \
        _Pragma("unroll") for (int i = 0; i < 4; ++i) { const bf16_t* row = base + (size_t)(s0_ + i) * PLD; pr[i] = row[0]; pk[i] = row[512]; pv[i] = row[1024]; \
            pe[i] = ewa[(size_t)(s0_ + i) * 1024]; pa[i] = ewa[(size_t)(s0_ + i) * 1024 + 512]; pg[i] = obase[(size_t)(s0_ + i) * 512]; } \
        if (s0_ > 0) { const bf16_t* row = base + (size_t)(s0_ - 1) * PLD; qr = row[0]; qk = row[512]; qv = row[1024]; } else { qr = 0; qk = 0; qv = 0; } } while (0)
    RW_PREFETCH(0);
    __syncthreads();
    for (int blk = 0; blk < SEQ / 32; ++blk) {
        float* Bf = (float*)smem + (blk & 1) * BUF_F;
        float* Wd = Bf; float* NKK = Bf + 2048; float* AB = Bf + 4096; float* KX = Bf + 6144; float* WR = Bf + 8192; float* VS = Bf + 10240; float* SC = Bf + 12288; float* YS = Bf + 12352;
        float bon[4], gv[4];
        { float rp = bf2f(qr), kq = bf2f(qk), vp = bf2f(qv);
#pragma unroll
          for (int i = 0; i < 4; ++i) { const int t = wv * 4 + i;
              const float r1 = bf2f(pr[i]), k1 = bf2f(pk[i]), v1 = bf2f(pv[i]);
              const float r = r1 + (rp - r1) * mu_r, k = k1 + (kq - k1) * mu_k, v = v1 + (vp - v1) * mu_v; rp = r1; kq = k1; vp = v1;
              const float decay = __expf(-0.6065306597f * sigmoidf_(w0 + bf2f(pe[i]))), a = sigmoidf_(a0 + bf2f(pa[i])); gv[i] = bf2f(pg[i]);
              const float kkv = k * k_k; const float ssq = wave_sum(kkv * kkv); const float kkn = kkv / fmaxf(sqrtf(ssq), 1e-12f);
              const float kx = k * (1.0f + (a - 1.0f) * k_a), ab = kkn * a;
              const float br = wave_sum(ab * r), kr = wave_sum(kx * r); bon[i] = wave_sum(r * kx * r_k);
              Wd[t * 64 + c] = decay; NKK[t * 64 + c] = -kkn; AB[t * 64 + c] = ab; KX[t * 64 + c] = kx; WR[t * 64 + c] = decay * r; VS[t * 64 + c] = v;
              if (c == 0) { SC[t * 2] = br; SC[t * 2 + 1] = kr; } } }
        __syncthreads();
        if (blk + 1 < SEQ / 32) RW_PREFETCH((blk + 1) * 32);
#define RW_LOAD(T, w0v, w1v, n0, n1, b0, b1, x0, x1, q0, q1, vv, sc) do { const int o_ = (T) * 64 + kp * 8; \
            w0v = *(const f32x4*)(Wd + o_); w1v = *(const f32x4*)(Wd + o_ + 4); n0 = *(const f32x4*)(NKK + o_); n1 = *(const f32x4*)(NKK + o_ + 4); \
            b0 = *(const f32x4*)(AB + o_); b1 = *(const f32x4*)(AB + o_ + 4); x0 = *(const f32x4*)(KX + o_); x1 = *(const f32x4*)(KX + o_ + 4); \
            q0 = *(const f32x4*)(WR + o_); q1 = *(const f32x4*)(WR + o_ + 4); vv = VS[(T) * 64 + vrow]; sc = *(const f32x2*)(SC + (T) * 2); } while (0)
        f32x4 cw0, cw1, cn0, cn1, cb0, cb1, cx0, cx1, cq0, cq1; float cvv; f32x2 csc;
        RW_LOAD(0, cw0, cw1, cn0, cn1, cb0, cb1, cx0, cx1, cq0, cq1, cvv, csc);
#pragma nounroll
        for (int t8 = 0; t8 < 4; ++t8) {
            float ykeep = 0.f;
#pragma unroll
            for (int j = 0; j < 8; ++j) {
                const int t = t8 * 8 + j;
                const f32x4 w0v = cw0, w1v = cw1, n0 = cn0, n1 = cn1, b0 = cb0, b1 = cb1, x0 = cx0, x1 = cx1, q0 = cq0, q1 = cq1; const float vv = cvv; const f32x2 sc = csc;
                { const int tn = (t + 1) & 31; RW_LOAD(tn, cw0, cw1, cn0, cn1, cb0, cb1, cx0, cx1, cq0, cq1, cvv, csc); }
                const f32x2 sa2 = S0 * (f32x2){n0[0], n0[1]} + S1 * (f32x2){n0[2], n0[3]} + S2 * (f32x2){n1[0], n1[1]} + S3 * (f32x2){n1[2], n1[3]};
                const f32x2 y2 = S0 * (f32x2){q0[0], q0[1]} + S1 * (f32x2){q0[2], q0[3]} + S2 * (f32x2){q1[0], q1[1]} + S3 * (f32x2){q1[2], q1[3]};
                float sa = sa2[0] + sa2[1], yy = y2[0] + y2[1];
                sa += dpp_xor1(sa); yy += dpp_xor1(yy); sa += dpp_xor2(sa); yy += dpp_xor2(yy); sa += dpp_hmir(sa); yy += dpp_hmir(yy);
                const f32x2 sav = {sa, sa}, vv2 = {vv, vv};
                S0 = S0 * (f32x2){w0v[0], w0v[1]} + sav * (f32x2){b0[0], b0[1]} + vv2 * (f32x2){x0[0], x0[1]};
                S1 = S1 * (f32x2){w0v[2], w0v[3]} + sav * (f32x2){b0[2], b0[3]} + vv2 * (f32x2){x0[2], x0[3]};
                S2 = S2 * (f32x2){w1v[0], w1v[1]} + sav * (f32x2){b1[0], b1[1]} + vv2 * (f32x2){x1[0], x1[1]};
                S3 = S3 * (f32x2){w1v[2], w1v[3]} + sav * (f32x2){b1[2], b1[3]} + vv2 * (f32x2){x1[2], x1[3]};
                const float y = yy + sa * sc[0] + vv * sc[1];
                ykeep = (kp == j) ? y : ykeep;
            }
            YS[(t8 * 8 + kp) * 64 + vrow] = ykeep;
        }
#undef RW_LOAD
        __syncthreads();
#pragma unroll
        for (int i = 0; i < 4; ++i) { const int t = wv * 4 + i;
            const float y = YS[t * 64 + c]; const float mean = wave_sum(y) * (1.0f / 64.0f); const float dlt = y - mean;
            const float var = wave_sum(dlt * dlt) * (1.0f / 64.0f);
            float yn = dlt * rsqrtf(var + 64e-5f) * ln_w + ln_b; yn += bon[i] * VS[t * 64 + c];
            obase[(size_t)(blk * 32 + t) * 512] = f2bf(yn * gv[i]); }
    }
#undef RW_PREFETCH
    __syncthreads();
}

DI int crow16(int i, int hl) { return (i & 3) + 8 * (i >> 2) + 4 * hl; }
__device__ __forceinline__ void rwkv_chunked(unsigned char* smem, CP p, int L, int b, int h) {
    bf16_t* ZB = (bf16_t*)smem;
    bf16_t* AR = (bf16_t*)(smem + 9216);
    bf16_t* BKt = (bf16_t*)(smem + 13824);
    bf16_t* UV = (bf16_t*)(smem + 18944);
    bf16_t* MT1 = (bf16_t*)(smem + 24064);
    bf16_t* MT2 = (bf16_t*)(smem + 25600);
    float* EW = (float*)(smem + 27136);
    bf16_t* BKr = (bf16_t*)(smem + 31232);
    float* Mf = (float*)(smem + 48640);
    float* Gs = (float*)(smem + 52864);
    float* YS = (float*)(smem + 57216);
    float* VS = (float*)(smem + 61312);
    float* PC = (float*)(smem + 65408);
    const int tid = tid_(), c = tid & 63, wv = tid >> 6, C = h * 64 + c, lane = c, qi = lane & 31, hl = lane >> 5;
    const float* mu = p->in[I_MU] + (size_t)L * 1792;
    const float mu_r = mu[C], mu_k = mu[512 + C], mu_v = mu[1024 + C];
    const float w0 = p->in[I_W0][L * 512 + C], a0 = p->in[I_A0][L * 512 + C];
    const float k_k = p->in[I_KK][L * 512 + C], k_a = p->in[I_KA][L * 512 + C], r_k = p->in[I_RK][L * 512 + C], ln_w = p->in[I_LNW][L * 512 + C], ln_b = p->in[I_LNB][L * 512 + C];
    const bf16_t* base = (const bf16_t*)(p->ws + WS_PROJ) + (size_t)b * SEQ * PLD + C_RW + C;
    const bf16_t* ewa = (const bf16_t*)(p->ws + WS_UN) + (size_t)b * SEQ * 1024 + C;
    bf16_t* obase = (bf16_t*)(p->ws + WS_ORW) + (size_t)b * SEQ * 512 + C;
    f32x16 zacc;
#pragma unroll
    for (int i = 0; i < 16; ++i) zacc[i] = 0.f;
    for (int i = tid; i < 64 * 72; i += 512) ZB[i] = 0;
    bf16_t pr[2], pk[2], pv[2], pe[2], pa[2], pg[2], qr, qk, qv;
#define RC_PREFETCH(T0) do { const int s0_ = (T0) + wv * 2; \
        _Pragma("unroll") for (int i = 0; i < 2; ++i) { const bf16_t* row = base + (size_t)(s0_ + i) * PLD; pr[i] = row[0]; pk[i] = row[512]; pv[i] = row[1024]; \
            pe[i] = ewa[(size_t)(s0_ + i) * 1024]; pa[i] = ewa[(size_t)(s0_ + i) * 1024 + 512]; pg[i] = obase[(size_t)(s0_ + i) * 512]; } \
        if (s0_ > 0) { const bf16_t* row = base + (size_t)(s0_ - 1) * PLD; qr = row[0]; qk = row[512]; qv = row[1024]; } else { qr = 0; qk = 0; qv = 0; } } while (0)
    RC_PREFETCH(0);
    __syncthreads();
    for (int ch = 0; ch < SEQ / 16; ++ch) {
        float bon[2], gv[2], r_[2], nk_[2], ab_[2], kx_[2], v_[2], ew_[2];
        { float rp = bf2f(qr), kq = bf2f(qk), vp = bf2f(qv);
#pragma unroll
          for (int i = 0; i < 2; ++i) { const int t = wv * 2 + i;
              const float r1 = bf2f(pr[i]), k1 = bf2f(pk[i]), v1 = bf2f(pv[i]);
              const float r = r1 + (rp - r1) * mu_r, k = k1 + (kq - k1) * mu_k, v = v1 + (vp - v1) * mu_v; rp = r1; kq = k1; vp = v1;
              const float ew = 0.6065306597f * sigmoidf_(w0 + bf2f(pe[i])), a = sigmoidf_(a0 + bf2f(pa[i])); gv[i] = bf2f(pg[i]);
              const float kkv = k * k_k; const float ssq = wave_sum(kkv * kkv); const float kkn = kkv * rsqrtf(fmaxf(ssq, 1e-24f));
              const float kx = k * (1.0f + (a - 1.0f) * k_a);
              bon[i] = wave_sum(r * kx * r_k);
              r_[i] = r; nk_[i] = kkn; ab_[i] = kkn * a; kx_[i] = kx; v_[i] = v; ew_[i] = ew; EW[t * 64 + c] = ew; } }
        __syncthreads();
        if (ch + 1 < SEQ / 16) RC_PREFETCH((ch + 1) * 16);
        { float ev[16];
#pragma unroll
          for (int j = 0; j < 16; ++j) ev[j] = EW[j * 64 + c];
#pragma unroll
          for (int i = 0; i < 2; ++i) { const int t = wv * 2 + i; float cum = 0.f;
#pragma unroll
            for (int j = 0; j < 16; ++j) cum += (j <= t) ? ev[j] : 0.f;
            const float Pt = __expf(-cum), Pm = __expf(-(cum - ew_[i])), iP = __expf(cum);
            const float al = -nk_[i] * Pm, rh = r_[i] * Pt, be = ab_[i] * iP, ka = kx_[i] * iP;
            AR[t * 72 + c] = f2bf(al); AR[(16 + t) * 72 + c] = f2bf(rh); BKr[t * 72 + c] = f2bf(be); BKr[(16 + t) * 72 + c] = f2bf(ka);
            BKt[c * 40 + t] = f2bf(be); BKt[c * 40 + 16 + t] = f2bf(ka);
            UV[c * 40 + 16 + t] = f2bf(v_[i]); VS[t * 64 + c] = v_[i];
            if (t == 15) PC[c] = Pt; } }
        __syncthreads();
        f32x16 acc;
#pragma unroll
        for (int i = 0; i < 16; ++i) acc[i] = 0.f;
        if (wv == 0) {
#pragma unroll
            for (int s = 0; s < 4; ++s) acc = MFMA32(*(const bf16x8*)(BKr + qi * 72 + 16 * s + 8 * hl), *(const bf16x8*)(AR + qi * 72 + 16 * s + 8 * hl), acc);
#pragma unroll
            for (int i = 0; i < 16; ++i) { const int j = crow16(i, hl), n = qi; const float m = acc[i];
                if (j < 16) { if (n < 16) Mf[j * 17 + n] = m; MT2[n * 24 + j] = f2bf((n >= 16 && j <= n - 16) ? m : 0.f); }
                else { const int i2 = j - 16; const bool k1 = n < 16 ? (i2 < n) : (i2 <= n - 16); MT1[n * 24 + i2] = f2bf(k1 ? m : 0.f); } }
        } else if (wv < 3) {
            const int vb = wv - 1;
#pragma unroll
            for (int s = 0; s < 4; ++s) acc = MFMA32(*(const bf16x8*)(ZB + (32 * vb + qi) * 72 + 16 * s + 8 * hl), *(const bf16x8*)(AR + qi * 72 + 16 * s + 8 * hl), acc);
        }
        __syncthreads();
        if (wv == 1 || wv == 2) { const int vb = wv - 1;
            acc = MFMA32(*(const bf16x8*)(UV + (32 * vb + qi) * 40 + 16 + 8 * hl), *(const bf16x8*)(MT1 + qi * 24 + 8 * hl), acc);
            if (qi < 16) {
#pragma unroll
                for (int i = 0; i < 16; ++i) Gs[(32 * vb + crow16(i, hl)) * 17 + qi] = acc[i]; }
        }
        __syncthreads();
        if (wv == 0) {
            float u[16];
#pragma unroll
            for (int t = 0; t < 16; ++t) { float x0 = Gs[lane * 17 + t], x1 = 0.f;
#pragma unroll
                for (int i = 0; i < t; ++i) { if (i & 1) x1 += u[i] * Mf[i * 17 + t]; else x0 += u[i] * Mf[i * 17 + t]; }
                u[t] = x0 + x1; UV[lane * 40 + t] = f2bf(u[t]); }
        }
        __syncthreads();
        if (wv == 1 || wv == 2) { const int vb = wv - 1;
            acc = MFMA32(*(const bf16x8*)(UV + (32 * vb + qi) * 40 + 8 * hl), *(const bf16x8*)(MT2 + qi * 24 + 8 * hl), acc);
            if (qi >= 16) {
#pragma unroll
                for (int i = 0; i < 16; ++i) YS[(qi - 16) * 64 + 32 * vb + crow16(i, hl)] = acc[i]; }
        }
        if (wv >= 4) { const int vb = (wv >> 1) & 1, kb = wv & 1;
#pragma unroll
            for (int s = 0; s < 2; ++s) zacc = MFMA32(*(const bf16x8*)(UV + (32 * vb + qi) * 40 + 16 * s + 8 * hl), *(const bf16x8*)(BKt + (32 * kb + qi) * 40 + 16 * s + 8 * hl), zacc);
            const float pc = PC[32 * kb + qi];
#pragma unroll
            for (int i = 0; i < 16; ++i) { zacc[i] *= pc; ZB[(32 * vb + crow16(i, hl)) * 72 + 32 * kb + qi] = f2bf(zacc[i]); }
        }
        __syncthreads();
#pragma unroll
        for (int i = 0; i < 2; ++i) { const int t = wv * 2 + i;
            const float y = YS[t * 64 + c]; const float mean = wave_sum(y) * (1.0f / 64.0f); const float dlt = y - mean;
            const float var = wave_sum(dlt * dlt) * (1.0f / 64.0f);
            float yn = dlt * rsqrtf(var + 64e-5f) * ln_w + ln_b; yn += bon[i] * VS[t * 64 + c];
            obase[(size_t)(ch * 16 + t) * 512] = f2bf(yn * gv[i]); }
    }
#undef RC_PREFETCH
    __syncthreads();
}

constexpr int KTS = 72;
DI bf16x8 pack8(float a0, float a1, float a2, float a3, float a4, float a5, float a6, float a7) {
    u32x4 w; w.x = pack2(a0, a1); w.y = pack2(a2, a3); w.z = pack2(a4, a5); w.w = pack2(a6, a7); return __builtin_bit_cast(bf16x8, w); }
DI bf16x8 ld_vfrag(const bf16_t* vt, int off) { const u32x2 lo = *(const u32x2*)(vt + off), hi = *(const u32x2*)(vt + off + 8); u32x4 w; w.x = lo.x; w.y = lo.y; w.z = hi.x; w.w = hi.y; return __builtin_bit_cast(bf16x8, w); }

struct FlashState { f32x16 o0, o1; float m, l; };

DI void flash_update(FlashState& st, f32x16& sc0, f32x16& sc1, const bf16_t* VT, int vs, int qi, int hl) {
    float mt = -INFINITY;
#pragma unroll
    for (int i = 0; i < 16; ++i) mt = fmaxf(mt, fmaxf(sc0[i], sc1[i]));
    mt = fmaxf(mt, shfl_xor_(mt, 32, qi + 32 * hl));
    const float mnew = fmaxf(st.m, mt), muse = (mnew == -INFINITY) ? 0.f : mnew;
    const float alpha = __builtin_amdgcn_exp2f(st.m - muse);
    float ls = 0.f;
#pragma unroll
    for (int i = 0; i < 16; ++i) { sc0[i] = __builtin_amdgcn_exp2f(sc0[i] - muse); sc1[i] = __builtin_amdgcn_exp2f(sc1[i] - muse); ls += sc0[i] + sc1[i]; }
    st.l = st.l * alpha + ls; st.m = mnew;
    st.o0 *= alpha; st.o1 *= alpha;
#pragma unroll
    for (int s = 0; s < 2; ++s) {
        const bf16x8 p0 = pack8(sc0[8 * s], sc0[8 * s + 1], sc0[8 * s + 2], sc0[8 * s + 3], sc0[8 * s + 4], sc0[8 * s + 5], sc0[8 * s + 6], sc0[8 * s + 7]);
        const bf16x8 p1 = pack8(sc1[8 * s], sc1[8 * s + 1], sc1[8 * s + 2], sc1[8 * s + 3], sc1[8 * s + 4], sc1[8 * s + 5], sc1[8 * s + 6], sc1[8 * s + 7]);
        st.o0 = MFMA32(ld_vfrag(VT, qi * vs + 16 * s + 4 * hl), p0, st.o0);
        st.o1 = MFMA32(ld_vfrag(VT, (32 + qi) * vs + 16 * s + 4 * hl), p0, st.o1);
        st.o0 = MFMA32(ld_vfrag(VT, qi * vs + 32 + 16 * s + 4 * hl), p1, st.o0);
        st.o1 = MFMA32(ld_vfrag(VT, (32 + qi) * vs + 32 + 16 * s + 4 * hl), p1, st.o1);
    }
}
DI void qk_tile(const bf16_t* KT, const bf16x8 (&qf)[4], int qi, int hl, f32x16& sc0, f32x16& sc1) {
#pragma unroll
    for (int i = 0; i < 16; ++i) { sc0[i] = 0.f; sc1[i] = 0.f; }
#pragma unroll
    for (int s = 0; s < 4; ++s) {
        const bf16x8 k0 = *(const bf16x8*)(KT + qi * KTS + 16 * s + 8 * hl), k1 = *(const bf16x8*)(KT + (32 + qi) * KTS + 16 * s + 8 * hl);
        sc0 = MFMA32(k0, qf[s], sc0); sc1 = MFMA32(k1, qf[s], sc1);
    }
}
struct KVRegs { u32x4 k, v; };
DI void kv_fetch(KVRegs& r, const bf16_t* pb, int kcol, int vcol, int k0) {
    const int tid = tid_();
    const unsigned ok_ = (unsigned)((k0 + (tid >> 3)) * PLD + kcol + (tid & 7) * 8) * 2u, ov_ = (unsigned)((k0 + (tid & 63)) * PLD + vcol + (tid >> 6) * 8) * 2u;
    r.k = *(const u32x4*)((const char*)pb + ok_);
    r.v = *(const u32x4*)((const char*)pb + ov_);
}
DI void kv_store(const KVRegs& r, bf16_t* KT, bf16_t* VT) {
    const int tid = tid_();
    *(u32x4*)(KT + (tid >> 3) * KTS + (tid & 7) * 8) = r.k;
    const int key = tid & 63, ch = tid >> 6;
#pragma unroll
    for (int j = 0; j < 8; ++j) VT[(ch * 8 + j) * KTS + key] = (bf16_t)((j & 1) ? (r.v[j >> 1] >> 16) : (r.v[j >> 1] & 0xFFFFu));
}
template <bool LUTB, bool CAUSAL, bool WHI, bool SEL>
DI void mask_tile(f32x16& sc0, f32x16& sc1, const float* lut, int qpos, int k0, int hl, bool sel, float qs) {
    const float bfar = lut[128];
#pragma unroll
    for (int i = 0; i < 16; ++i) { const int kl = (i & 3) + 8 * (i >> 2) + 4 * hl;
        { const int dist = qpos - (k0 + kl); const float v = sc0[i] * qs + (LUTB ? lut[dist > 128 ? 128 : (dist < 0 ? 0 : dist)] : bfar);
          bool ok = true; if (CAUSAL) ok = ok && dist >= 0; if (WHI) ok = ok && dist < 256; if (SEL) ok = ok && sel; sc0[i] = ok ? v : -INFINITY; }
        { const int dist = qpos - (k0 + 32 + kl); const float v = sc1[i] * qs + (LUTB ? lut[dist > 128 ? 128 : (dist < 0 ? 0 : dist)] : bfar);
          bool ok = true; if (CAUSAL) ok = ok && dist >= 0; if (WHI) ok = ok && dist < 256; if (SEL) ok = ok && sel; sc1[i] = ok ? v : -INFINITY; } }
}

__device__ __forceinline__ void nsa_item(unsigned char* smem, CP p, int L, int b, int g, int qb, int ocol) {
    bf16_t* KT = (bf16_t*)smem;
    bf16_t* VT = (bf16_t*)(smem + 9216);
    float* LUT = (float*)(smem + 18432);
    unsigned* SELM = (unsigned*)(smem + 20736);
    unsigned* ORM = (unsigned*)(smem + 20992);
    float* PA = (float*)(smem + 21504);
    float* PBv = (float*)(smem + 54272);
    bf16_t* KT2 = (bf16_t*)(smem + 87040);
    bf16_t* VT2 = (bf16_t*)(smem + 105472);
    const int tid = tid_(), lane = tid & 63, wv = tid >> 6, hh = wv >> 1, qhalf = wv & 1, qi = lane & 31, hl = lane >> 5;
    const int ql = qhalf * 32 + qi, qpos = qb * 64 + ql, head = g * 4 + hh;
    bf16_t* pb = (bf16_t*)(p->ws + WS_PROJ) + (size_t)b * SEQ * PLD;
    bf16_t* qrow = pb + (size_t)qpos * PLD;
    __syncthreads();
    for (int i = tid; i < 4 * 129; i += 512) { const int h2 = i / 129, dd = i % 129; int bk;
        if (dd < 16) bk = dd; else if (dd >= 128) bk = 31; else { bk = 16 + (int)(logf((float)dd / 16.0f) / 2.0794415416798357f * 16.0f); bk = bk > 31 ? 31 : bk; }
        LUT[h2 * 132 + dd] = p->in[I_RELB][bk * 8 + g * 4 + h2] * 1.4426950408889634f; }
    if (tid == 0) *ORM = 0u;
    if (tid < 64) SELM[tid] = 0u;
    if (tid < 256) PBv[tid * 32] = 0.f;
    { const float* kc = (const float*)(p->ws + WS_KC) + ((size_t)(0 * 16 + b) * 2 + g) * 128 * 64; const float* vc = (const float*)(p->ws + WS_KC) + ((size_t)(1 * 16 + b) * 2 + g) * 128 * 64;
      for (int i = tid; i < 128 * 64; i += 512) { const int n = i >> 6, d = i & 63; KT2[n * KTS + d] = f2bf(kc[i]); }
      for (int i = tid; i < 128 * 64; i += 512) { const int n = i & 127, d = i >> 7; VT2[d * 136 + n] = f2bf(vc[n * 64 + d]); } }
    bf16x8 qf[4];
#pragma unroll
    for (int s = 0; s < 4; ++s) qf[s] = *(const bf16x8*)(qrow + C_NQ + head * 64 + 16 * s + 8 * hl);
    float g0, g1, g2;
    { const bf16_t* gp = qrow + C_NG + head * 3; g0 = sigmoidf_(bf2f(gp[0])); g1 = sigmoidf_(bf2f(gp[1])); g2 = sigmoidf_(bf2f(gp[2])); }
    __syncthreads();
    const float* lut = LUT + hh * 132;
    constexpr float QS = 0.125f * 1.4426950408889634f;
    f32x16 fin0, fin1;
    {
        FlashState st;
#pragma unroll
        for (int i = 0; i < 16; ++i) { st.o0[i] = 0.f; st.o1[i] = 0.f; }
        st.m = -INFINITY; st.l = 0.f;
#pragma nounroll
        for (int t = 0; t < 2; ++t) {
            f32x16 sc0, sc1; qk_tile(KT2 + t * 64 * KTS, qf, qi, hl, sc0, sc1);
#pragma unroll
            for (int i = 0; i < 16; ++i) { const int kl = (i & 3) + 8 * (i >> 2) + 4 * hl;
                { const int n = 64 * t + kl, dist = qpos - (16 * n + 31); const float v_ = sc0[i] * QS + lut[dist > 128 ? 128 : (dist < 0 ? 0 : dist)]; sc0[i] = (dist >= 0 && n < 127) ? v_ : -INFINITY; }
                { const int n = 64 * t + 32 + kl, dist = qpos - (16 * n + 31); const float v_ = sc1[i] * QS + lut[dist > 128 ? 128 : (dist < 0 ? 0 : dist)]; sc1[i] = (dist >= 0 && n < 127) ? v_ : -INFINITY; } }
            flash_update(st, sc0, sc1, VT2 + 64 * t, 136, qi, hl);
        }
        const float lt = st.l + shfl_xor_(st.l, 32, lane); const float inv = 1.0f / fmaxf(lt, 1e-30f);
        const float muse = (st.m == -INFINITY) ? 0.f : st.m;
        fin0 = st.o0 * (g0 * inv); fin1 = st.o1 * (g0 * inv);
#pragma nounroll
        for (int t = 0; t < 2; ++t) {
            f32x16 sc0, sc1; qk_tile(KT2 + t * 64 * KTS, qf, qi, hl, sc0, sc1);
#pragma unroll
            for (int i = 0; i < 16; ++i) { const int kl = (i & 3) + 8 * (i >> 2) + 4 * hl;
                { const int n = 64 * t + kl, dist = qpos - (16 * n + 31); const float v_ = __builtin_amdgcn_exp2f(sc0[i] * QS + lut[dist > 128 ? 128 : (dist < 0 ? 0 : dist)] - muse) * inv; sc0[i] = (dist >= 0 && n < 127) ? v_ : 0.f; }
                { const int n = 64 * t + 32 + kl, dist = qpos - (16 * n + 31); const float v_ = __builtin_amdgcn_exp2f(sc1[i] * QS + lut[dist > 128 ? 128 : (dist < 0 ? 0 : dist)] - muse) * inv; sc1[i] = (dist >= 0 && n < 127) ? v_ : 0.f; } }
#pragma unroll
            for (int i4 = 0; i4 < 4; ++i4) {
                { const int m = 16 * t + 2 * i4 + hl; PA[(hh * 64 + ql) * 32 + m] = sc0[4 * i4] + sc0[4 * i4 + 1] + sc0[4 * i4 + 2] + sc0[4 * i4 + 3]; PBv[(hh * 64 + ql) * 32 + m + 1] = sc0[4 * i4 + 3]; }
                { const int m = 16 * t + 8 + 2 * i4 + hl; PA[(hh * 64 + ql) * 32 + m] = sc1[4 * i4] + sc1[4 * i4 + 1] + sc1[4 * i4 + 2] + sc1[4 * i4 + 3]; if (m + 1 < 32) PBv[(hh * 64 + ql) * 32 + m + 1] = sc1[4 * i4 + 3]; }
            }
        }
    }
    __syncthreads();
    {
        float* IMP = (float*)smem;
        const int q = tid & 63, part = tid >> 6, cur = qb;
#pragma unroll
        for (int mm = 0; mm < 4; ++mm) { const int m = part * 4 + mm; float v;
            if (m == 0 || m == cur || m == cur - 1) v = INFINITY;
            else if (m <= cur) { v = 0.f; for (int h2 = 0; h2 < 4; ++h2) v += PA[(h2 * 64 + q) * 32 + m] + PBv[(h2 * 64 + q) * 32 + m]; }
            else v = -INFINITY;
            IMP[q * 33 + m] = v; }
        __syncthreads();
        unsigned bits = 0u;
#pragma unroll
        for (int mm = 0; mm < 4; ++mm) { const int m = part * 4 + mm; const float v = IMP[q * 33 + m]; int rank = 0;
            for (int m2 = 0; m2 < 32; ++m2) { const float v2 = IMP[q * 33 + m2]; rank += (v2 > v || (v2 == v && m2 < m)) ? 1 : 0; }
            if (rank < 8 && v > -INFINITY) bits |= 1u << m; }
        atomicOr(&SELM[q], bits); atomicOr(ORM, bits);
    }
    __syncthreads();
    const unsigned mysel = SELM[ql], orm = *ORM;
    __syncthreads();
    float* PARK = PA + (wv * 32) * 64 + lane;
#pragma unroll
    for (int i = 0; i < 16; ++i) { PARK[i * 64] = fin0[i]; PARK[(16 + i) * 64] = fin1[i]; }
    {
        FlashState st;
#pragma unroll
        for (int i = 0; i < 16; ++i) { st.o0[i] = 0.f; st.o1[i] = 0.f; }
        st.m = -INFINITY; st.l = 0.f;
        const unsigned todo = orm & (qb >= 31 ? 0xFFFFFFFFu : ((2u << qb) - 1u));
        KVRegs kr;
        int m = todo ? __builtin_ctz(todo) : -1;
        if (m >= 0) { kv_fetch(kr, pb, C_KS + g * 64, C_VS + g * 64, m * 64); __syncthreads(); kv_store(kr, KT, VT); __syncthreads(); }
        while (m >= 0) {
            const unsigned rest = todo & ~((2u << m) - 1u); const int nm = (m < 31 && rest) ? __builtin_ctz(rest) : -1;
            if (nm >= 0) kv_fetch(kr, pb, C_KS + g * 64, C_VS + g * 64, nm * 64);
            const bool sel = (mysel >> m) & 1u;
            if (__builtin_amdgcn_ballot_w64(sel) != 0ull) {
                f32x16 sc0, sc1; qk_tile(KT, qf, qi, hl, sc0, sc1);
                if (m + 3 <= qb) mask_tile<false, false, false, true>(sc0, sc1, lut, qpos, m * 64, hl, sel, QS);
                else mask_tile<true, true, false, true>(sc0, sc1, lut, qpos, m * 64, hl, sel, QS);
                flash_update(st, sc0, sc1, VT, KTS, qi, hl);
            }
            __syncthreads();
            if (nm >= 0) kv_store(kr, KT, VT);
            __syncthreads();
            m = nm;
        }
        const float lt = st.l + shfl_xor_(st.l, 32, lane); const float sc = g1 / fmaxf(lt, 1e-30f);
#pragma unroll
        for (int i = 0; i < 16; ++i) { PARK[i * 64] += st.o0[i] * sc; PARK[(16 + i) * 64] += st.o1[i] * sc; }
    }
    {
        FlashState st;
#pragma unroll
        for (int i = 0; i < 16; ++i) { st.o0[i] = 0.f; st.o1[i] = 0.f; }
        st.m = -INFINITY; st.l = 0.f;
        KVRegs kr;
        int w = qb >= 4 ? 0 : 4 - qb;
        kv_fetch(kr, pb, C_KW + g * 64, C_VW + g * 64, qb * 64 - 256 + 64 * w); __syncthreads(); kv_store(kr, KT, VT); __syncthreads();
        for (; w < 5; ++w) {
            const int k0 = qb * 64 - 256 + 64 * w;
            if (w < 4) kv_fetch(kr, pb, C_KW + g * 64, C_VW + g * 64, k0 + 64);
            f32x16 sc0, sc1; qk_tile(KT, qf, qi, hl, sc0, sc1);
            if (w == 0) mask_tile<false, false, true, false>(sc0, sc1, lut, qpos, k0, hl, true, QS);
            else if (w == 1) mask_tile<false, false, false, false>(sc0, sc1, lut, qpos, k0, hl, true, QS);
            else if (w < 4) mask_tile<true, false, false, false>(sc0, sc1, lut, qpos, k0, hl, true, QS);
            else mask_tile<true, true, false, false>(sc0, sc1, lut, qpos, k0, hl, true, QS);
            flash_update(st, sc0, sc1, VT, KTS, qi, hl);
            __syncthreads();
            if (w < 4) kv_store(kr, KT, VT);
            __syncthreads();
        }
        const float lt = st.l + shfl_xor_(st.l, 32, lane); const float sc = g2 / fmaxf(lt, 1e-30f);
#pragma unroll
        for (int i = 0; i < 16; ++i) { fin0[i] = PARK[i * 64] + st.o0[i] * sc; fin1[i] = PARK[(16 + i) * 64] + st.o1[i] * sc; }
    }
#pragma unroll
    for (int i4 = 0; i4 < 4; ++i4) {
        u32x2 w0; w0.x = pack2(fin0[4 * i4], fin0[4 * i4 + 1]); w0.y = pack2(fin0[4 * i4 + 2], fin0[4 * i4 + 3]);
        u32x2 w1; w1.x = pack2(fin1[4 * i4], fin1[4 * i4 + 1]); w1.y = pack2(fin1[4 * i4 + 2], fin1[4 * i4 + 3]);
        *(u32x2*)(qrow + ocol + head * 64 + 8 * i4 + 4 * hl) = w0;
        *(u32x2*)(qrow + ocol + head * 64 + 32 + 8 * i4 + 4 * hl) = w1;
    }
}

constexpr int PH_PER_LAYER = 15, PH_TOTAL = DEPTH * PH_PER_LAYER + 1;
enum { S_PREP = 0, S_GU1, S_D1, S_NORM_MIX, S_WIN, S_CMP, S_LORA, S_SCAN, S_MERGE, S_OUT, S_NORM2, S_GU2, S_D2, S_NORM_PLE, S_PLEG, S_FINAL };

__device__ __forceinline__ void run_phase(unsigned char* smem, CP p, int ph) {
    const bool fin = (ph == DEPTH * PH_PER_LAYER);
    const int L = fin ? 0 : ph / PH_PER_LAYER; const int sub = fin ? S_FINAL : ph % PH_PER_LAYER;
    unsigned char* ws = p->ws; float* H = p->out;
    bf16_t* W = (bf16_t*)(ws + WS_WBF); bf16_t* UN = (bf16_t*)(ws + WS_UN); bf16_t* PROJ = (bf16_t*)(ws + WS_PROJ); bf16_t* ACT = (bf16_t*)(ws + WS_ACT);
    bf16_t* TMP = (bf16_t*)(ws + WS_TMP); bf16_t* PBF = (bf16_t*)(ws + WS_PB); bf16_t* ORW = (bf16_t*)(ws + WS_ORW);
    bf16_t* XK = (bf16_t*)(ws + WS_XK); bf16_t* XV = (bf16_t*)(ws + WS_XV); float* P01 = (float*)(ws + WS_P01);
    if (sub == S_PREP) convert_layer_weights(smem, p, L);
    if (sub == S_NORM_MIX) convert_ffn2_weights(smem, p, L);
    if (sub == S_NORM2) cvt_f32_bf16(p->in[I_P] + (size_t)L * T_TOK * 256, PBF, (size_t)T_TOK * 256 / 4);
    if (sub == S_CMP) lora_act(p, L);
    if (sub == S_LORA) finalize_cmp(smem, p, L);
    if (sub == S_NORM_PLE) { EpiBf16<DM> e; e.O = TMP; run_gemm(smem, PBF, 256, W + E_PW, T_TOK, DM, 256, e); }
    if (sub == S_PREP || sub == S_NORM_MIX || sub == S_NORM2 || sub == S_NORM_PLE || sub == S_FINAL) {
        const float* hin = (sub == S_PREP && L == 0) ? p->in[I_X] : H; float* hcopy = (sub == S_PREP && L == 0) ? H : nullptr;
        const float* g = sub == S_PREP ? p->in[I_F1N] + L * DM : sub == S_NORM_MIX ? p->in[I_MIXN] + L * DM : sub == S_NORM2 ? p->in[I_F2N] + L * DM : sub == S_NORM_PLE ? p->in[I_PLEN] + L * DM : p->in[I_FINN];
        rmsnorm_rows(hin, hcopy, g, sub == S_FINAL ? nullptr : UN, sub == S_FINAL ? H : nullptr);
    } else if (sub == S_GU1 || sub == S_GU2) {
        EpiSwiglu e; e.O = ACT; run_gemm(smem, UN, DM, W + (sub == S_GU1 ? E_GU1 : E_GU2), T_TOK, 2 * DFF, DM, e);
    } else if (sub == S_D1 || sub == S_D2 || sub == S_OUT) {
        EpiResid e; e.H = H; e.scale = sub == S_OUT ? 1.0f : 0.5f;
        run_gemm(smem, sub == S_OUT ? UN : ACT, sub == S_OUT ? DM : DFF, W + (sub == S_D1 ? E_D1 : sub == S_D2 ? E_D2 : E_OUT), T_TOK, DM, sub == S_OUT ? DM : DFF, e);
    } else if (sub == S_WIN) {
        EpiProj e; e.O = PROJ; e.XK = XK; e.XV = XV; run_gemm(smem, UN, DM, W + E_IN, T_TOK, N_WIN, DM, e);
    } else if (sub == S_CMP) {
#pragma nounroll
        for (int kv = 0; kv < 2; ++kv) { EpiF32 e; e.C = P01 + (size_t)kv * 4096 * 256;
            run_gemm(smem, kv ? XV : XK, 1024, W + E_C1 + (size_t)kv * 256 * 1024, 4096, 256, 1024, e, kv ? 240 : 0); }
        { EpiBf16<PLD> e; e.O = PROJ + C_NG; run_gemm(smem, UN, DM, W + E_NG, T_TOK, 256, DM, e, 128); }
    } else if (sub == S_LORA) {
        EpiLora e; e.EWA = UN; e.G = ORW;
        run_gemm(smem, (const bf16_t*)(ws + WS_LACT), 256, W + E_LORA, T_TOK, 1536, 256, e);
    } else if (sub == S_SCAN) {
        for (int item = bid_(); item < 256; item += gridDim.x) {
            __syncthreads();
            if (item < 128) rwkv_chunked(smem, p, L, item >> 3, item & 7); else hgrn_scan(smem, p, L, (item - 128) >> 3, (item - 128) & 7);
        }
        unsigned* ctr = (unsigned*)(ws + 14336) + L * 64;
        volatile unsigned* slot = (volatile unsigned*)(smem + 141 * 1024);
        for (;;) {
            __syncthreads();
            if (tid_() == 0) *slot = __hip_atomic_fetch_add(ctr, 1u, __ATOMIC_RELAXED, __HIP_MEMORY_SCOPE_AGENT);
            __syncthreads();
            const unsigned idx = *slot;
            if (idx >= 1024u) break;
            const int bg = idx & 31, qb = 31 - (int)(idx >> 5);
            nsa_item(smem, p, L, bg >> 1, bg & 1, qb, C_NQ);
        }
    } else if (sub == S_MERGE) {
#pragma nounroll
        for (int j = 0; j < 3; ++j) { EpiMerge e; e.MRG = UN; e.PROJ = PROJ; e.J = j;
            const bf16_t* A = j == 0 ? PROJ + C_HQ : (j == 1 ? PROJ + C_NQ : ORW);
            run_gemm(smem, A, j == 2 ? 512 : PLD, W + E_BR + (size_t)j * 1024 * 512, T_TOK, DM, 512, e); }
    } else if (sub == S_PLEG) {
        EpiPleGate e; e.H = H; e.TMP = TMP; run_gemm(smem, UN, DM, W + E_PG, T_TOK, DM, DM, e);
    }
}

#define XB_TMO      128
#define XB_XCNT(j)  (256  + 64 * (j))
#define XB_XSUB(j)  (1280 + 64 * (j))
#define XB_XGEN(j)  (2304 + 64 * (j))
#define XB_TOP      3328
#define XB_TOPGEN   3392
#define XCD_BAR_WORDS 3456
#define XB_SPIN_CAP (1u << 20)
DI unsigned xb_ld(unsigned* p)              { return __hip_atomic_load(p, __ATOMIC_RELAXED, __HIP_MEMORY_SCOPE_AGENT); }
DI unsigned xb_add(unsigned* p, unsigned v) { return __hip_atomic_fetch_add(p, v, __ATOMIC_RELAXED, __HIP_MEMORY_SCOPE_AGENT); }
DI unsigned xb_xcc_id() { return (unsigned)__builtin_amdgcn_s_getreg((3 << 11) | 20) & 0xFu; }
#define XB_SPIN(cond, bar) do { unsigned _sp = 0; while (cond) { __builtin_amdgcn_s_sleep(1); \
    if ((++_sp & 255u) == 0u) { if (xb_ld(&(bar)[XB_TMO])) break; if (_sp > XB_SPIN_CAP) { atomicAdd(&(bar)[XB_TMO], 1u); break; } } } } while (0)
struct XcdBarrier { unsigned* bar; unsigned x; volatile LAS unsigned* st; };
DI XcdBarrier xcd_barrier_post(unsigned* bar, volatile LAS unsigned* st) {
    XcdBarrier b; b.bar = bar; b.x = xb_xcc_id(); b.st = st;
    if (threadIdx.x == 0) (void)xb_add(&bar[XB_XCNT(b.x)], 1u);
    return b;
}
DI void xcd_barrier_complete(unsigned* bar, unsigned x, unsigned& nloc, unsigned& nx) {
    const unsigned G = gridDim.x * gridDim.y * gridDim.z;
    unsigned sum, cnt, mine, sp = 0u;
    for (;;) {
        sum = 0u; cnt = 0u; mine = 0u;
#pragma unroll
        for (unsigned j = 0; j < 16; ++j) { const unsigned c = xb_ld(&bar[XB_XCNT(j)]); sum += c; cnt += (c > 0u) ? 1u : 0u; mine = (j == x) ? c : mine; }
        if (sum == G) break;
        __builtin_amdgcn_s_sleep(1);
        if ((++sp & 255u) == 0u) { if (xb_ld(&bar[XB_TMO])) break; if (sp > XB_SPIN_CAP) { atomicAdd(&bar[XB_TMO], 1u); break; } }
    }
    nloc = mine > 0u ? mine : 1u; nx = cnt > 0u ? cnt : 1u;
}
DI void xcd_barrier(const XcdBarrier& b) {
    asm volatile("s_waitcnt vmcnt(0)" ::: "memory");
    __syncthreads();
    if (threadIdx.x == 0) {
        unsigned* bar = b.bar;
        __builtin_amdgcn_s_waitcnt(0);
        unsigned nloc = b.st[0], nx = b.st[1];
        if (nloc == 0u) { xcd_barrier_complete(bar, b.x, nloc, nx); b.st[0] = nloc; b.st[1] = nx; }
        const unsigned old = xb_add(&bar[XB_XSUB(b.x)], 1u);
        const unsigned gen = old / nloc;
        if (old + 1u == (gen + 1u) * nloc) {
            __builtin_amdgcn_fence(__ATOMIC_RELEASE, "agent");
            asm volatile("s_waitcnt vmcnt(0)" ::: "memory");
            const unsigned og = xb_add(&bar[XB_TOP], 1u);
            const unsigned tg = og / nx;
            if (og + 1u == (tg + 1u) * nx) xb_add(&bar[XB_TOPGEN], 1u);
            else XB_SPIN(xb_ld(&bar[XB_TOPGEN]) == tg, bar);
            __builtin_amdgcn_fence(__ATOMIC_ACQUIRE, "agent");
            xb_add(&bar[XB_XGEN(b.x)], 1u);
            asm volatile("s_waitcnt vmcnt(0)" ::: "memory");
        } else {
            XB_SPIN(xb_ld(&bar[XB_XGEN(b.x)]) == gen, bar);
            __builtin_amdgcn_fence(__ATOMIC_ACQUIRE, "agent");
            asm volatile("s_waitcnt vmcnt(0)" ::: "memory");
        }
    }
    __syncthreads();
}

__global__ void __launch_bounds__(512, 2) mega_fwd(Params p) {
    extern __shared__ __attribute__((aligned(16))) unsigned char smem[];
    cg::grid_group grid = cg::this_grid();
    volatile LAS unsigned* xst = (volatile LAS unsigned*)(LAS unsigned char*)(smem + 140 * 1024);
    if (threadIdx.x == 0) { xst[0] = 0u; xst[1] = 0u; }
    __syncthreads();
    const XcdBarrier xb = xcd_barrier_post((unsigned*)(p.ws + WS_BAR), xst);
#ifndef PROBE_DUP
#define PROBE_DUP -1
#endif
    constexpr int IT_PER_LAYER = PH_PER_LAYER + (PROBE_DUP >= 0 ? 1 : 0);
    const int it_lo = p.ph_lo, it_hi = PROBE_DUP >= 0 ? DEPTH * IT_PER_LAYER + 1 : p.ph_hi;
    for (int it = it_lo; it < it_hi; ++it) {
        int ph = it;
        if (PROBE_DUP >= 0) { const int l_ = it / IT_PER_LAYER, r_ = it % IT_PER_LAYER; ph = l_ * PH_PER_LAYER + (r_ <= PROBE_DUP ? r_ : r_ - 1); }
        CP pp = (CP)__builtin_amdgcn_kernarg_segment_ptr(); asm volatile("" : "+s"(pp));
        run_phase(smem, pp, ph);
        if (it + 1 < it_hi) {
            if (it == it_lo) grid.sync();
            else xcd_barrier(xb);
        }
    }
}

#ifndef MULTI_LAUNCH
#define MULTI_LAUNCH 0
#endif

extern "C" void kernel_launch(void* const* d_in, const int* in_sizes, int n_in, void* d_out, int out_size, void* d_ws, size_t ws_size, hipStream_t stream) {
    static int grid = 0;
    if (grid == 0) {
        if (n_in != N_INPUTS || out_size != T_TOK * DM || ws_size < WS_END) { fprintf(stderr, "kernel_launch: unexpected shapes: n_in %d out %d ws %zu (need %zu)\n", n_in, out_size, ws_size, (size_t)WS_END); grid = -1; return; }
        int dev = 0, cus = 0, per_cu = 0;
        (void)hipGetDevice(&dev); (void)hipDeviceGetAttribute(&cus, hipDeviceAttributeMultiprocessorCount, dev);
        if (hipFuncSetAttribute((const void*)mega_fwd, hipFuncAttributeMaxDynamicSharedMemorySize, LDS_BYTES) != hipSuccess) { fprintf(stderr, "kernel_launch: hipFuncSetAttribute failed\n"); grid = -1; return; }
        if (hipOccupancyMaxActiveBlocksPerMultiprocessor(&per_cu, (const void*)mega_fwd, 512, LDS_BYTES) != hipSuccess || per_cu < 1) { fprintf(stderr, "kernel_launch: occupancy query gives %d\n", per_cu); per_cu = 1; }
        (void)hipGetLastError();
        grid = cus * 1;
        if (grid > 256) grid = 256;
        fprintf(stderr, "kernel_launch: grid %d (cus %d, per_cu %d)\n", grid, cus, per_cu);
    }
    if (grid < 0) return;
    (void)hipMemsetAsync(d_ws, 0, 16384, stream);
    Params p{};
    for (int i = 0; i < N_INPUTS; ++i) p.in[i] = (const float*)d_in[i];
    p.out = (float*)d_out; p.ws = (unsigned char*)d_ws;
#if MULTI_LAUNCH
    for (int ph = 0; ph < PH_TOTAL; ++ph) { p.ph_lo = ph; p.ph_hi = ph + 1; hipLaunchKernelGGL(mega_fwd, dim3(grid), dim3(512), LDS_BYTES, stream, p); }
#else
    p.ph_lo = 0; p.ph_hi = PH_TOTAL;
    void* args[] = {&p};
    hipError_t e = hipLaunchCooperativeKernel((const void*)mega_fwd, dim3(grid), dim3(512), args, LDS_BYTES, stream);
    if (e != hipSuccess) fprintf(stderr, "kernel_launch: cooperative launch failed: %s\n", hipGetErrorString(e));
#endif
}
```

```cpp
#include <hip/hip_runtime.h>
#include <hip/hip_cooperative_groups.h>
#include <cstdio>
namespace cg = cooperative_groups;

#define LAS __attribute__((address_space(3)))
#define DI __device__ __forceinline__
typedef unsigned short bf16_t;
typedef short bf16x8 __attribute__((ext_vector_type(8)));
typedef float f32x4 __attribute__((ext_vector_type(4)));
typedef float f32x2 __attribute__((ext_vector_type(2)));
typedef float f32x16 __attribute__((ext_vector_type(16)));
typedef unsigned u32x4 __attribute__((ext_vector_type(4)));
typedef unsigned u32x2 __attribute__((ext_vector_type(2)));

constexpr int T_TOK = 32768, SEQ = 2048, NB = 16, DM = 1024, DFF = 2816, DEPTH = 4;
constexpr int PLD = 8448;
constexpr int C_HQ = 0, C_HF = 512, C_HI = 1024, C_HG = 1536, C_NQ = 2048, C_KC = 2560, C_VC = 2688, C_KS = 2816, C_VS = 2944,
              C_KW = 3072, C_VW = 3200, C_RW = 3328, C_MG = 5120, C_NG = 8192, N_WIN = 8192, IN_COLS = 8216;
enum { I_X = 0, I_P, I_F1N, I_F1GU, I_F1D, I_MIXN, I_WIN, I_HGLB, I_HGN, I_PE, I_CW1, I_CW2, I_RELB, I_MU, I_W0, I_WB, I_A0, I_AB, I_GB,
       I_KK, I_KA, I_RK, I_LNW, I_LNB, I_WBR, I_WOUT, I_F2N, I_F2GU, I_F2D, I_PLEN, I_PLEG, I_PLEW, I_FINN, N_INPUTS };

constexpr size_t WS_BAR = 0;
constexpr size_t WS_PEB = 16384;
constexpr size_t WS_WBF = 32768;
constexpr size_t E_GU1 = 0, E_D1 = E_GU1 + 5632ull * 1024, E_IN = E_D1 + 1024ull * 2816, E_BR = E_IN + 8448ull * 1024, E_OUT = E_BR + 3ull * 1024 * 512,
                 E_GU2 = E_GU1, E_D2 = E_D1  , E_PG = E_OUT + 1024ull * 1024, E_PW = E_PG + 1024ull * 1024,
                 E_C1 = E_PW + 1024ull * 256, E_LORA = E_C1 + 2ull * 256 * 1024, E_NG = E_LORA + 1536ull * 256, E_END = E_NG + 256ull * 1024;
constexpr size_t WS_UN = WS_WBF + E_END * 2;
constexpr size_t WS_ORW = WS_UN + (size_t)T_TOK * 1024 * 2;
constexpr size_t WS_XK = WS_ORW + (size_t)T_TOK * 512 * 2;
constexpr size_t WS_XV = WS_XK + 4096ull * 1024 * 2;
constexpr size_t WS_P01 = WS_XV + 4096ull * 1024 * 2;
constexpr size_t WS_KC = WS_P01 + 2ull * 4096 * 256 * 4;
constexpr size_t WS_LACT = WS_KC + 2ull * 16 * 2 * 128 * 64 * 4;
constexpr size_t WS_PROJ = WS_LACT + (size_t)T_TOK * 256 * 2;
constexpr size_t WS_END = WS_PROJ + (size_t)T_TOK * PLD * 2;
constexpr size_t WS_ACT = WS_PROJ;
constexpr size_t WS_PB = WS_PROJ + 200ull * 1024 * 1024;
constexpr size_t WS_TMP = WS_PROJ + 256ull * 1024 * 1024;
constexpr int LDS_BYTES = 144 * 1024;

struct Params {
    const float* in[N_INPUTS];
    float* out;
    unsigned char* ws;
    int ph_lo, ph_hi;
};
typedef const Params __attribute__((address_space(4)))* CP;

DI int tid_() { int t = threadIdx.x; asm volatile("" : "+v"(t)); return t; }
DI int bid_() { int b = blockIdx.x; asm volatile("" : "+s"(b)); return b; }
typedef __bf16 bf16v2 __attribute__((ext_vector_type(2)));
DI float bf2f(bf16_t b) { return __uint_as_float(((unsigned)b) << 16); }
DI unsigned pack2(float lo, float hi) { const f32x2 v = {lo, hi}; return __builtin_bit_cast(unsigned, __builtin_convertvector(v, bf16v2)); }
DI bf16_t f2bf(float f) { return (bf16_t)(pack2(f, 0.f) & 0xFFFFu); }
DI float sigmoidf_(float x) { return __builtin_amdgcn_rcpf(1.0f + __builtin_amdgcn_exp2f(-1.4426950408889634f * x)); }
DI float siluf_(float x) { return x * __builtin_amdgcn_rcpf(1.0f + __builtin_amdgcn_exp2f(-1.4426950408889634f * x)); }
DI float shfl_xor_(float v, int mask, int lane) { return __int_as_float(__builtin_amdgcn_ds_bpermute((lane ^ mask) << 2, __float_as_int(v))); }
DI float dppf_(float v, int) { return v; }
#define DPPF(v, ctrl) __int_as_float(__builtin_amdgcn_mov_dpp(__float_as_int(v), ctrl, 0xF, 0xF, true))
DI float wave_sum(float v) {
    v += DPPF(v, 0xB1); v += DPPF(v, 0x4E); v += DPPF(v, 0x141); v += DPPF(v, 0x140);
    const float s0 = __int_as_float(__builtin_amdgcn_readlane(__float_as_int(v), 0)), s1 = __int_as_float(__builtin_amdgcn_readlane(__float_as_int(v), 16));
    const float s2 = __int_as_float(__builtin_amdgcn_readlane(__float_as_int(v), 32)), s3 = __int_as_float(__builtin_amdgcn_readlane(__float_as_int(v), 48));
    return (s0 + s1) + (s2 + s3);
}

#define MFMA32(a, b, c) __builtin_amdgcn_mfma_f32_32x32x16_bf16((a), (b), (c), 0, 0, 0)
namespace pg8 {
constexpr int BM = 256, BK = 64, HALF = 128, HTB = HALF * BK * 2, STAGE_BYTES = 8 * HTB, NXCD = 8, WGM = 8;
DI int lds_byte(int r, int c) { const int st = (r >> 4) * 2 + (c >> 5), rr = r & 15, cc = c & 31, ob = rr * 64 + cc * 2; return st * 1024 + (ob ^ (((ob >> 9) & 1) << 5)); }
DI void stage_rc(int b, int& R, int& C) { const int st = b / 1024, sb = b % 1024, swz = sb ^ (((sb >> 9) & 1) << 5); R = (st >> 1) * 16 + swz / 64; C = (st & 1) * 32 + (swz % 64) / 2; }
DI int perm32(int rho) { const int n = rho >> 4, i = rho & 15; return 8 * (i >> 2) + 4 * n + (i & 3); }
struct Unit { int pm, pn; };
struct Gemm { const bf16_t* A; const bf16_t* Bt; int M, N, K, lda; };
struct StaticOrder {
    int nM, nN, nwg, G, c;
    DI void init(int M, int N, int G_, int c_) { nM = M / BM; nN = N / BM; nwg = nM * nN; G = G_; c = c_; }
    DI bool next(int i, Unit& u) const {
        const long L = (long)i * G + c; if (L >= nwg) return false;
        int wgid = (int)L; { const int q = nwg / NXCD, r = nwg % NXCD, xcd = wgid % NXCD, off = wgid / NXCD; wgid = (xcd < r ? xcd * (q + 1) : r * (q + 1) + (xcd - r) * q) + off; }
        const int nig = WGM * nN, gid = wgid / nig, fm = gid * WGM, gsz = (nM - fm) < WGM ? (nM - fm) : WGM;
        u.pm = fm + ((wgid % nig) % gsz); u.pn = (wgid % nig) / gsz; return true;
    }
};

template <class Epi>
DI void gemm_phase(LAS unsigned char* lds, const Gemm g, const StaticOrder& S, const Epi& E) {
    int tid = tid_();
    const int wid = __builtin_amdgcn_readfirstlane(tid >> 6), lane = tid & 63, wr = wid >> 2, wc = wid & 3, fr = lane & 15, fq = lane >> 4;
    const int K = g.K, nt = K / BK, lda = g.lda;
    unsigned voffA[2], voffB[2];
#pragma unroll
    for (int i = 0; i < 2; ++i) { int R, C; stage_rc(tid * 16 + i * 8192, R, C); const int Rb = Epi::PERM ? ((R & ~31) + perm32(R & 31)) : R;
        voffA[i] = (unsigned)(R * lda + C) * 2u; voffB[i] = (unsigned)(Rb * K + C) * 2u; }
    const size_t kstep = (size_t)(BK * 2);
    const size_t hstepA = (size_t)HALF * lda * 2, hstepB = (size_t)HALF * K * 2;
    const size_t tstepA = 2 * hstepA, tstepB = 2 * hstepB;
    const unsigned ldsw = (unsigned)wid * 1024u;
    const int aoff = lds_byte(wr * 64 + fr, fq * 8), boff = lds_byte(wc * 32 + fr, fq * 8);
#define PG8_SA(b, h) (((b) * 2 + (h)) * HTB)
#define PG8_SB(b, h) ((4 + (b) * 2 + (h)) * HTB)
#define PG8_STAGE(bufoff, gbase, voff) do { _Pragma("unroll") for (int _i = 0; _i < 2; ++_i) \
        __builtin_amdgcn_global_load_lds((const unsigned*)((const char*)(gbase) + (voff)[_i]), (LAS unsigned*)(lds + (bufoff) + ldsw + _i * 8192), 16, 0, 0); } while (0)
#define PG8_LDA(dst, b, h) do { _Pragma("unroll") for (int m = 0; m < 4; ++m) _Pragma("unroll") for (int k = 0; k < 2; ++k) dst[m][k] = *(const LAS bf16x8*)(lds + PG8_SA(b, h) + aoff + m * 2048 + k * 1024); } while (0)
#define PG8_LDB(dst, b, h) do { _Pragma("unroll") for (int n = 0; n < 2; ++n) _Pragma("unroll") for (int k = 0; k < 2; ++k) dst[n][k] = *(const LAS bf16x8*)(lds + PG8_SB(b, h) + boff + n * 2048 + k * 1024); } while (0)
#define PG8_MMA(ai, bj, At, Bt) do { __builtin_amdgcn_s_setprio(1); _Pragma("unroll") for (int m = 0; m < 4; ++m) _Pragma("unroll") for (int n = 0; n < 2; ++n) _Pragma("unroll") for (int k = 0; k < 2; ++k) \
        acc[ai][bj][m][n] = __builtin_amdgcn_mfma_f32_16x16x32_bf16(Bt[n][k], At[m][k], acc[ai][bj][m][n], 0, 0, 0); __builtin_amdgcn_s_setprio(0); } while (0)
#define PG8_WAIT_V(n) asm volatile("s_waitcnt vmcnt(" #n ")" ::: "memory")
#define PG8_WAIT_L(n) asm volatile("s_waitcnt lgkmcnt(" #n ")" ::: "memory")
#define PG8_BAR __builtin_amdgcn_s_barrier()
#define PG8_SCHED __builtin_amdgcn_sched_barrier(0)
    Unit cur, nxt; int ui = 0;
    if (!S.next(0, cur)) return;
    f32x4 acc[2][2][4][2];
#pragma unroll
    for (int a = 0; a < 2; ++a)
#pragma unroll
        for (int b = 0; b < 2; ++b)
#pragma unroll
            for (int m = 0; m < 4; ++m)
#pragma unroll
                for (int n = 0; n < 2; ++n) acc[a][b][m][n] = (f32x4){0.f, 0.f, 0.f, 0.f};
    bf16x8 At[4][2], B0[2][2], B1[2][2];
    const char* cA = (const char*)g.A + (size_t)cur.pm * tstepA; const char* cB = (const char*)g.Bt + (size_t)cur.pn * tstepB;
    PG8_STAGE(PG8_SB(0, 0), cB, voffB); PG8_STAGE(PG8_SA(0, 0), cA, voffA); PG8_STAGE(PG8_SB(0, 1), cB + hstepB, voffB); PG8_STAGE(PG8_SA(0, 1), cA + hstepA, voffA);
    if (wr == 1) PG8_BAR;
    PG8_WAIT_V(4); PG8_BAR;
    PG8_STAGE(PG8_SB(1, 0), cB + kstep, voffB); PG8_STAGE(PG8_SA(1, 0), cA + kstep, voffA); PG8_STAGE(PG8_SB(1, 1), cB + hstepB + kstep, voffB);
    PG8_WAIT_V(6); PG8_BAR;
    for (;;) {
        const bool has_next = S.next(ui + 1, nxt);
        const char* nA = has_next ? (const char*)g.A + (size_t)nxt.pm * tstepA : cA; const char* nB = has_next ? (const char*)g.Bt + (size_t)nxt.pn * tstepB : cB;
        for (int t = 0; t < nt; t += 2) {
            const bool last = (t == nt - 2);
            const char* a1 = cA + (size_t)(t + 1) * kstep;
            const char* a2 = last ? nA : cA + (size_t)(t + 2) * kstep; const char* b2 = last ? nB : cB + (size_t)(t + 2) * kstep;
            const char* a3 = a2 + kstep; const char* b3 = b2 + kstep;
            PG8_LDB(B0, 0, 0); PG8_SCHED; PG8_LDA(At, 0, 0); PG8_STAGE(PG8_SA(1, 1), a1 + hstepA, voffA);
            PG8_WAIT_L(8); PG8_BAR; PG8_WAIT_L(0); PG8_MMA(0, 0, At, B0); PG8_BAR; PG8_SCHED;
            PG8_LDB(B1, 0, 1); PG8_STAGE(PG8_SB(0, 0), b2, voffB);
            PG8_BAR; PG8_WAIT_L(0); PG8_MMA(0, 1, At, B1); PG8_BAR;
            PG8_LDA(At, 0, 1); PG8_STAGE(PG8_SA(0, 0), a2, voffA);
            PG8_BAR; PG8_WAIT_L(0); PG8_MMA(1, 0, At, B0); PG8_BAR; PG8_SCHED;
            PG8_STAGE(PG8_SB(0, 1), b2 + hstepB, voffB);
            PG8_WAIT_V(6); PG8_BAR; PG8_MMA(1, 1, At, B1); PG8_BAR;
            PG8_LDB(B0, 1, 0); PG8_SCHED; PG8_LDA(At, 1, 0); PG8_STAGE(PG8_SA(0, 1), a2 + hstepA, voffA);
            PG8_WAIT_L(8); PG8_BAR; PG8_WAIT_L(0); PG8_MMA(0, 0, At, B0); PG8_BAR; PG8_SCHED;
            PG8_LDB(B1, 1, 1); PG8_STAGE(PG8_SB(1, 0), b3, voffB);
            PG8_BAR; PG8_WAIT_L(0); PG8_MMA(0, 1, At, B1); PG8_BAR;
            PG8_LDA(At, 1, 1); PG8_STAGE(PG8_SA(1, 0), a3, voffA);
            PG8_BAR; PG8_WAIT_L(0); PG8_MMA(1, 0, At, B0); PG8_BAR; PG8_SCHED;
            PG8_STAGE(PG8_SB(1, 1), b3 + hstepB, voffB);
            PG8_WAIT_V(6); PG8_BAR; PG8_MMA(1, 1, At, B1); PG8_BAR;
        }
        E(acc, cur, wr, wc, fr, fq);
        if (!has_next) break;
#pragma unroll
        for (int a = 0; a < 2; ++a)
#pragma unroll
            for (int b = 0; b < 2; ++b)
#pragma unroll
                for (int m = 0; m < 4; ++m)
#pragma unroll
                    for (int n = 0; n < 2; ++n) acc[a][b][m][n] = (f32x4){0.f, 0.f, 0.f, 0.f};
        cur = nxt; cA = nA; cB = nB; ++ui;
    }
    PG8_WAIT_V(0);
    if (wr == 0) PG8_BAR;
    PG8_BAR;
#undef PG8_SA
#undef PG8_SB
#undef PG8_STAGE
#undef PG8_LDA
#undef PG8_LDB
#undef PG8_MMA
#undef PG8_WAIT_V
#undef PG8_WAIT_L
#undef PG8_BAR
#undef PG8_SCHED
}
}

typedef f32x4 AccT[2][2][4][2];
#define EPI_LANE const int t_ = tid_(), wid_ = t_ >> 6, ln_ = t_ & 63, wr_ = wid_ >> 2, wc_ = wid_ & 3, fr_ = ln_ & 15, fq_ = ln_ >> 4;
#define EPI_LOOP_PERM(...) EPI_LANE \
    const int row0 = u.pm * 256 + wr_ * 64 + fr_, col0 = u.pn * 256 + wc_ * 32 + 8 * fq_; \
    _Pragma("unroll") for (int ai = 0; ai < 2; ++ai) _Pragma("unroll") for (int m = 0; m < 4; ++m) { const int row = row0 + ai * 128 + m * 16; \
        _Pragma("unroll") for (int bj = 0; bj < 2; ++bj) { const int col = col0 + bj * 128; const f32x4 v0 = acc[ai][bj][m][0], v1 = acc[ai][bj][m][1]; __VA_ARGS__ } }
#define EPI_LOOP_NAT(...) EPI_LANE \
    const int row0 = u.pm * 256 + wr_ * 64 + fr_, col0 = u.pn * 256 + wc_ * 32 + 4 * fq_; \
    _Pragma("unroll") for (int ai = 0; ai < 2; ++ai) _Pragma("unroll") for (int m = 0; m < 4; ++m) { const int row = row0 + ai * 128 + m * 16; \
        _Pragma("unroll") for (int bj = 0; bj < 2; ++bj) _Pragma("unroll") for (int n = 0; n < 2; ++n) { const int col = col0 + bj * 128 + n * 16; const f32x4 v = acc[ai][bj][m][n]; __VA_ARGS__ } }

struct EpiSwiglu { static constexpr bool PERM = true; bf16_t* O;
    DI void operator()(const AccT& acc, const pg8::Unit& u, int wr, int wc, int fr, int fq) const {
        EPI_LOOP_PERM({ u32x2 w; w.x = pack2(siluf_(v0[0]) * v1[0], siluf_(v0[1]) * v1[1]); w.y = pack2(siluf_(v0[2]) * v1[2], siluf_(v0[3]) * v1[3]);
            *(u32x2*)(O + (size_t)row * DFF + (col >> 1)) = w; })
    } };
struct EpiResid { static constexpr bool PERM = false; float* H; float scale;
    DI void operator()(const AccT& acc, const pg8::Unit& u, int wr, int wc, int fr, int fq) const {
        EPI_LOOP_NAT({ f32x4* p = (f32x4*)(H + (size_t)row * DM + col); *p = *p + v * scale; })
    } };
struct EpiProj { static constexpr bool PERM = true; bf16_t* O; bf16_t* XK; bf16_t* XV;
    DI void operator()(const AccT& acc, const pg8::Unit& u, int wr, int wc, int fr, int fq) const {
        const bool is_mg = u.pn * 256 >= C_MG, is_cmp = (u.pn == 10);
        EPI_LOOP_PERM({ f32x4 a = v0, b = v1;
            if (is_mg) { for (int j = 0; j < 4; ++j) { a[j] = sigmoidf_(a[j]); b[j] = sigmoidf_(b[j]); } }
            u32x4 w; w.x = pack2(a[0], a[1]); w.y = pack2(a[2], a[3]); w.z = pack2(b[0], b[1]); w.w = pack2(b[2], b[3]);
            *(u32x4*)(O + (size_t)row * PLD + col) = w;
            if (is_cmp) { const int c = col - C_KC, kv = c >> 7, gg = (c >> 6) & 1, d = c & 63, bb = row >> 11, s = row & 2047, jj = s >> 4, l = s & 15;
                bf16_t* X = kv ? XV : XK; *(u32x4*)(X + ((size_t)((bb * 128 + jj) * 2 + gg)) * 1024 + l * 64 + d) = w; } })
    } };
struct EpiMerge { static constexpr bool PERM = true; bf16_t* MRG; const bf16_t* PROJ; int J;
    DI void operator()(const AccT& acc, const pg8::Unit& u, int wr, int wc, int fr, int fq) const {
        EPI_LOOP_PERM({ const u32x4 gt = *(const u32x4*)(PROJ + (size_t)row * PLD + C_MG + J * 1024 + col);
            u32x4* mp = (u32x4*)(MRG + (size_t)row * DM + col); u32x4 old = (u32x4){0u, 0u, 0u, 0u}; if (J > 0) old = *mp;
            float r[8]; const float x[8] = {v0[0], v0[1], v0[2], v0[3], v1[0], v1[1], v1[2], v1[3]};
            _Pragma("unroll") for (int j = 0; j < 8; ++j) { const unsigned gw = gt[j >> 1], ow = old[j >> 1];
                const float gf = (j & 1) ? __uint_as_float(gw & 0xFFFF0000u) : __uint_as_float(gw << 16);
                const float of = (j & 1) ? __uint_as_float(ow & 0xFFFF0000u) : __uint_as_float(ow << 16);
                r[j] = of + gf * x[j]; }
            u32x4 w; w.x = pack2(r[0], r[1]); w.y = pack2(r[2], r[3]); w.z = pack2(r[4], r[5]); w.w = pack2(r[6], r[7]); *mp = w; })
    } };
struct EpiF32 { static constexpr bool PERM = false; float* C; static constexpr int ldc = 256;
    DI void operator()(const AccT& acc, const pg8::Unit& u, int wr, int wc, int fr, int fq) const {
        EPI_LOOP_NAT({ *(f32x4*)(C + (size_t)row * ldc + col) = v; })
    } };
template <int LDC> struct EpiBf16 { static constexpr bool PERM = true; bf16_t* O; static constexpr int ldc = LDC;
    DI void operator()(const AccT& acc, const pg8::Unit& u, int wr, int wc, int fr, int fq) const {
        EPI_LOOP_PERM({ u32x4 w; w.x = pack2(v0[0], v0[1]); w.y = pack2(v0[2], v0[3]); w.z = pack2(v1[0], v1[1]); w.w = pack2(v1[2], v1[3]);
            *(u32x4*)(O + (size_t)row * ldc + col) = w; })
    } };
struct EpiPleGate { static constexpr bool PERM = false; float* H; const bf16_t* TMP;
    DI void operator()(const AccT& acc, const pg8::Unit& u, int wr, int wc, int fr, int fq) const {
        EPI_LOOP_NAT({ const u32x2 tw = *(const u32x2*)(TMP + (size_t)row * DM + col); f32x4* p = (f32x4*)(H + (size_t)row * DM + col); f32x4 h = *p;
            h[0] += sigmoidf_(v[0]) * __uint_as_float(tw.x << 16); h[1] += sigmoidf_(v[1]) * __uint_as_float(tw.x & 0xFFFF0000u);
            h[2] += sigmoidf_(v[2]) * __uint_as_float(tw.y << 16); h[3] += sigmoidf_(v[3]) * __uint_as_float(tw.y & 0xFFFF0000u); *p = h; })
    } };

struct EpiLora { static constexpr bool PERM = true; bf16_t* EWA; bf16_t* G;
    DI void operator()(const AccT& acc, const pg8::Unit& u, int wr, int wc, int fr, int fq) const {
        const bool isg = u.pn >= 4; bf16_t* O = isg ? G - 1024 : EWA; const int ld = isg ? 512 : 1024;
        EPI_LOOP_PERM({ u32x4 w; w.x = pack2(v0[0], v0[1]); w.y = pack2(v0[2], v0[3]); w.z = pack2(v1[0], v1[1]); w.w = pack2(v1[2], v1[3]);
            *(u32x4*)(O + (size_t)row * ld + col) = w; })
    } };

template <class Epi> DI void run_gemm(unsigned char* smem, const bf16_t* A, int lda, const bf16_t* Bt, int M, int N, int K, const Epi& E, int coff = 0) {
    __syncthreads();
    pg8::Gemm g; g.A = A; g.Bt = Bt; g.M = M; g.N = N; g.K = K; g.lda = lda;
    pg8::StaticOrder S; S.init(M, N, (int)gridDim.x, (bid_() + coff) % (int)gridDim.x);
    pg8::gemm_phase<Epi>((LAS unsigned char*)smem, g, S, E);
    __syncthreads();
}

struct MapId { DI int operator()(int n) const { return n; } };
struct MapGU { DI int operator()(int n) const { const int q = n >> 3, e = n & 7; return e < 4 ? 4 * q + e : DFF + 4 * q + (e - 4); } };
struct MapIn { DI int operator()(int n) const { return n < 3328 ? n : n + 24; } };
struct MapNg { DI int operator()(int n) const { return n < 24 ? 3328 + n : -1; } };
template <int TN, class Map> __device__ __forceinline__ void transpose_cvt_t(unsigned char* smem, const float* src, int ldsrc, bf16_t* dst, int K, int Nd, Map map, int& toff) {
    float* tile = (float*)smem;
    constexpr int RPP = 512 / TN;
    const int tid = tid_(), ntk = K / 64, nt = ntk * (Nd / TN);
    const int G = (int)gridDim.x, first = (bid_() + G - (toff % G)) % G;
    toff += nt;
    for (int t = first; t < nt; t += G) {
        const int n0 = (t / ntk) * TN, k0 = (t % ntk) * 64;
        const int nn = tid % TN, sc = map(n0 + nn);
#pragma unroll
        for (int p = 0; p < 64 / RPP; ++p) { const int kk = (tid / TN) + p * RPP; tile[kk * (TN + 1) + nn] = sc >= 0 ? src[(size_t)(k0 + kk) * ldsrc + sc] : 0.f; }
        __syncthreads();
#pragma unroll
        for (int p = 0; p < TN / 16; ++p) { const int nn2 = (tid >> 5) + p * 16, kk2 = (tid & 31) * 2;
            *(unsigned*)(dst + (size_t)(n0 + nn2) * K + k0 + kk2) = pack2(tile[kk2 * (TN + 1) + nn2], tile[(kk2 + 1) * (TN + 1) + nn2]); }
        __syncthreads();
    }
}
template <class Map> __device__ __forceinline__ void transpose_cvt(unsigned char* smem, const float* src, int ldsrc, bf16_t* dst, int K, int Nd, Map map, int& toff) {
    if ((Nd & 255) == 0) transpose_cvt_t<256>(smem, src, ldsrc, dst, K, Nd, map, toff); else transpose_cvt_t<64>(smem, src, ldsrc, dst, K, Nd, map, toff);
}
__device__ __forceinline__ void convert_layer_weights(unsigned char* smem, CP p, int L) {
    bf16_t* W = (bf16_t*)(p->ws + WS_WBF); int toff = 0;
    transpose_cvt(smem, p->in[I_F1GU] + (size_t)L * DM * 2 * DFF, 2 * DFF, W + E_GU1, DM, 2 * DFF, MapGU(), toff);
    transpose_cvt(smem, p->in[I_F1D] + (size_t)L * DFF * DM, DM, W + E_D1, DFF, DM, MapId(), toff);
    transpose_cvt(smem, p->in[I_WIN] + (size_t)L * DM * IN_COLS, IN_COLS, W + E_IN, DM, N_WIN, MapIn(), toff);
    transpose_cvt(smem, p->in[I_WIN] + (size_t)L * DM * IN_COLS, IN_COLS, W + E_NG, DM, 256, MapNg(), toff);
    for (int j = 0; j < 3; ++j) transpose_cvt(smem, p->in[I_WBR] + ((size_t)L * 3 + j) * 512 * DM, DM, W + E_BR + (size_t)j * 1024 * 512, 512, DM, MapId(), toff);
    transpose_cvt(smem, p->in[I_WOUT] + (size_t)L * DM * DM, DM, W + E_OUT, DM, DM, MapId(), toff);
    for (int i = bid_() * 512 + tid_(); i < 1536 * 256; i += gridDim.x * 512) { const int n = i >> 8, k = i & 255; float w = 0.f;
        if (n < 512) { if (k < 64) w = p->in[I_WB][((size_t)L * 64 + k) * 512 + n]; }
        else if (n < 1024) { if (k >= 64 && k < 128) w = p->in[I_AB][((size_t)L * 64 + (k - 64)) * 512 + (n - 512)]; }
        else { if (k >= 128) w = p->in[I_GB][((size_t)L * 128 + (k - 128)) * 512 + (n - 1024)]; }
        W[E_LORA + i] = f2bf(w); }
    transpose_cvt(smem, p->in[I_PLEG] + (size_t)L * DM * DM, DM, W + E_PG, DM, DM, MapId(), toff);
    transpose_cvt(smem, p->in[I_PLEW] + (size_t)L * 256 * DM, DM, W + E_PW, 256, DM, MapId(), toff);
    for (int kv = 0; kv < 2; ++kv) for (int hf = 0; hf < 2; ++hf)
        transpose_cvt(smem, p->in[I_CW1] + ((size_t)(L * 2 + kv) * 2048 + hf * 1024) * 128, 128, W + E_C1 + ((size_t)kv * 256 + hf * 128) * 1024, 1024, 128, MapId(), toff);
    { const int q = (int)gridDim.x - 1 - bid_(); const int tid = tid_();
      if (q >= 0 && q < 16 && tid < 256) {
        const int kv = tid >> 7, hc = tid & 127;
        const float* pe = p->in[I_PE] + (size_t)(L * 2 + kv) * 2048 + q * 128; const float* w1 = p->in[I_CW1] + ((size_t)(L * 2 + kv) * 2048 + q * 128) * 128 + hc;
        float s0 = 0.f, s1 = 0.f, s2 = 0.f, s3 = 0.f;
#pragma unroll 4
        for (int i = 0; i < 128; i += 4) { s0 += pe[i] * w1[(size_t)i * 128]; s1 += pe[i + 1] * w1[(size_t)(i + 1) * 128]; s2 += pe[i + 2] * w1[(size_t)(i + 2) * 128]; s3 += pe[i + 3] * w1[(size_t)(i + 3) * 128]; }
        ((float*)(p->ws + WS_PEB))[(q * 2 + kv) * 128 + hc] = (s0 + s1) + (s2 + s3);
      } }
}

__device__ __forceinline__ void convert_ffn2_weights(unsigned char* smem, CP p, int L) {
    bf16_t* W = (bf16_t*)(p->ws + WS_WBF); int toff = 0;
    transpose_cvt(smem, p->in[I_F2GU] + (size_t)L * DM * 2 * DFF, 2 * DFF, W + E_GU2, DM, 2 * DFF, MapGU(), toff);
    transpose_cvt(smem, p->in[I_F2D] + (size_t)L * DFF * DM, DM, W + E_D2, DFF, DM, MapId(), toff);
}
__device__ __forceinline__ void lora_act(CP p, int L) {
    const bf16_t* PROJ = (const bf16_t*)(p->ws + WS_PROJ); bf16_t* LACT = (bf16_t*)(p->ws + WS_LACT);
    const float* mu = p->in[I_MU] + (size_t)L * 1792 + 1536;
    for (int i = bid_() * 512 + tid_(); i < T_TOK * 32; i += gridDim.x * 512) {
        const int t = i >> 5, j0 = (i & 31) * 8; const bf16_t* row = PROJ + (size_t)t * PLD + C_RW + 1536 + j0;
        const u32x4 cur = *(const u32x4*)row; u32x4 prv = {0u, 0u, 0u, 0u}; if ((t & (SEQ - 1)) != 0) prv = *(const u32x4*)(row - PLD);
        float r[8];
#pragma unroll
        for (int e = 0; e < 8; ++e) { const float x1 = (e & 1) ? __uint_as_float(cur[e >> 1] & 0xFFFF0000u) : __uint_as_float(cur[e >> 1] << 16);
            const float xp = (e & 1) ? __uint_as_float(prv[e >> 1] & 0xFFFF0000u) : __uint_as_float(prv[e >> 1] << 16);
            float xm = x1 + (xp - x1) * mu[j0 + e];
            if (j0 < 64) xm = tanhf(xm); else if (j0 >= 128) xm = sigmoidf_(xm);
            r[e] = xm; }
        u32x4 w; w.x = pack2(r[0], r[1]); w.y = pack2(r[2], r[3]); w.z = pack2(r[4], r[5]); w.w = pack2(r[6], r[7]);
        *(u32x4*)(LACT + (size_t)t * 256 + j0) = w;
    }
}

__device__ __forceinline__ void rmsnorm_rows(const float* hin, float* hcopy, const float* g, bf16_t* un, float* outf) {
    const int lane = tid_() & 63, gw = bid_() * 8 + (tid_() >> 6), nw = gridDim.x * 8;
    f32x4 gv[4];
#pragma unroll
    for (int i = 0; i < 4; ++i) gv[i] = *(const f32x4*)(g + lane * 4 + i * 256);
    for (int row0 = gw * 2; row0 < T_TOK; row0 += nw * 2) {
        f32x4 x[2][4]; float ss[2] = {0.f, 0.f};
#pragma unroll
        for (int r = 0; r < 2; ++r)
#pragma unroll
            for (int i = 0; i < 4; ++i) x[r][i] = *(const f32x4*)(hin + (size_t)(row0 + r) * DM + lane * 4 + i * 256);
#pragma unroll
        for (int r = 0; r < 2; ++r) {
#pragma unroll
            for (int i = 0; i < 4; ++i) ss[r] += x[r][i][0] * x[r][i][0] + x[r][i][1] * x[r][i][1] + x[r][i][2] * x[r][i][2] + x[r][i][3] * x[r][i][3];
            ss[r] = wave_sum(ss[r]); }
#pragma unroll
        for (int r = 0; r < 2; ++r) { const int row = row0 + r; const float rs = rsqrtf(ss[r] * (1.0f / DM) + 1e-6f);
#pragma unroll
            for (int i = 0; i < 4; ++i) {
                const f32x4 y = x[r][i] * rs * gv[i];
                if (hcopy) *(f32x4*)(hcopy + (size_t)row * DM + lane * 4 + i * 256) = x[r][i];
                if (un) { u32x2 w; w.x = pack2(y[0], y[1]); w.y = pack2(y[2], y[3]); *(u32x2*)(un + (size_t)row * DM + lane * 4 + i * 256) = w; }
                if (outf) *(f32x4*)(outf + (size_t)row * DM + lane * 4 + i * 256) = y;
            } }
    }
}
__device__ __forceinline__ void cvt_f32_bf16(const float* src, bf16_t* dst, size_t n4) {
    for (size_t i = (size_t)bid_() * 512 + tid_(); i < n4; i += (size_t)gridDim.x * 512) {
        const f32x4 v = *(const f32x4*)(src + i * 4); u32x2 w; w.x = pack2(v[0], v[1]); w.y = pack2(v[2], v[3]); *(u32x2*)(dst + i * 4) = w; }
}

__device__ __forceinline__ void finalize_cmp(unsigned char* smem, CP p, int L) {
    float* hid = (float*)smem + (tid_() >> 6) * 128;
    float* W2L = (float*)(smem + 4096);
    const int lane = tid_() & 63, gw = bid_() * 8 + (tid_() >> 6), nw = gridDim.x * 8;
    const float* peb = (const float*)(p->ws + WS_PEB);
    { const float* w2g = p->in[I_CW2] + (size_t)L * 2 * 128 * 64;
      for (int i = tid_(); i < 2 * 128 * 64 / 4; i += 512) *(f32x4*)(W2L + i * 4) = *(const f32x4*)(w2g + i * 4); }
    __syncthreads();
    const int total = 2 * 16 * 2 * 128, iters = (total + nw - 1) / nw;
    for (int it = 0; it < iters; ++it) {
        const int id = gw + it * nw; const bool ok = id < total;
        const int n = id & 127, gg = (id >> 7) & 1, bb = (id >> 8) & 15, kv = (id >> 12) & 1;
        if (ok && n < 127) {
            const float* Pm = (const float*)(p->ws + WS_P01) + (size_t)kv * 4096 * 256;
            const size_t r0 = (size_t)((bb * 128 + n) * 2 + gg) * 256, r1 = (size_t)((bb * 128 + n + 1) * 2 + gg) * 256;
#pragma unroll
            for (int q = 0; q < 2; ++q) { const int hc = lane + q * 64; float pb_ = 0.f; for (int s16 = 0; s16 < 16; ++s16) pb_ += peb[(s16 * 2 + kv) * 128 + hc];
                hid[hc] = siluf_(Pm[r0 + hc] + Pm[r1 + 128 + hc] + pb_); }
        }
        __syncthreads();
        if (ok) {
            float o0 = 0.f, o1 = 0.f;
            if (n < 127) { const float* w2 = W2L + kv * 8192 + lane;
#pragma unroll 8
                for (int hc = 0; hc < 128; hc += 2) { o0 += hid[hc] * w2[hc * 64]; o1 += hid[hc + 1] * w2[(hc + 1) * 64]; } }
            ((float*)(p->ws + WS_KC))[((((size_t)kv * 16 + bb) * 2 + gg) * 128 + n) * 64 + lane] = o0 + o1;
        }
        __syncthreads();
    }
}

__device__ __forceinline__ void hgrn_scan(unsigned char* smem, CP p, int L, int b, int h) {
    float* F = (float*)smem; float* Kx = F + 2048; float* Q = Kx + 2048; float* V = Q + 2048; float* PO = V + 2048;
    const int tid = tid_(), e = tid & 63, wv = tid >> 6, C = h * 64 + e;
    float lb;
    { const float* hl = p->in[I_HGLB]; const float a0 = hl[C], a1 = hl[512 + C], a2 = hl[1024 + C], a3 = hl[1536 + C];
      const float mx = fmaxf(fmaxf(a0, a1), fmaxf(a2, a3)); const float e0 = __expf(a0 - mx), e1 = __expf(a1 - mx), e2 = __expf(a2 - mx), e3 = __expf(a3 - mx);
      const float inv = 1.0f / (e0 + e1 + e2 + e3); float acc = 0.f; if (L >= 1) acc += e1; if (L >= 2) acc += e2; if (L >= 3) acc += e3; lb = fmaxf(acc * inv, 0.f); }
    const float ng = p->in[I_HGN][L * 512 + C];
    bf16_t* base = (bf16_t*)(p->ws + WS_PROJ) + (size_t)b * SEQ * PLD + C;
    f32x2 S0 = {0.f, 0.f}, S1 = {0.f, 0.f}, S2 = {0.f, 0.f}, S3 = {0.f, 0.f};
    bf16_t pz[4], pq[4], pi[4], pg[4];
#define HG_PREFETCH(T0) do { _Pragma("unroll") for (int i = 0; i < 4; ++i) { const bf16_t* row = base + (size_t)((T0) + wv * 4 + i) * PLD; \
        pz[i] = row[C_HF]; pq[i] = row[C_HQ]; pi[i] = row[C_HI]; pg[i] = row[C_HG]; } } while (0)
    HG_PREFETCH(0);
    for (int t0 = 0; t0 < SEQ; t0 += 32) {
        float gr[4];
#pragma unroll
        for (int i = 0; i < 4; ++i) { const int t = wv * 4 + i;
            const float z = bf2f(pz[i]), qr = bf2f(pq[i]), vi = bf2f(pi[i]); gr[i] = bf2f(pg[i]);
            const float sg = sigmoidf_(z); F[t * 64 + e] = sg + lb * (1.0f - sg); Kx[t * 64 + e] = (1.0f - lb) * (1.0f - sg); Q[t * 64 + e] = siluf_(qr); V[t * 64 + e] = vi; }
        __syncthreads();
        if (t0 + 32 < SEQ) HG_PREFETCH(t0 + 32);
#pragma unroll 4
        for (int t = 0; t < 32; ++t) {
            const f32x4 f0 = *(const f32x4*)(F + t * 64 + wv * 8), f1 = *(const f32x4*)(F + t * 64 + wv * 8 + 4);
            const f32x4 k0 = *(const f32x4*)(Kx + t * 64 + wv * 8), k1 = *(const f32x4*)(Kx + t * 64 + wv * 8 + 4);
            const f32x4 q0 = *(const f32x4*)(Q + t * 64 + wv * 8), q1 = *(const f32x4*)(Q + t * 64 + wv * 8 + 4);
            const float v = V[t * 64 + e]; const f32x2 vv = {v, v};
            S0 = (f32x2){f0[0], f0[1]} * S0 + (f32x2){k0[0], k0[1]} * vv; S1 = (f32x2){f0[2], f0[3]} * S1 + (f32x2){k0[2], k0[3]} * vv;
            S2 = (f32x2){f1[0], f1[1]} * S2 + (f32x2){k1[0], k1[1]} * vv; S3 = (f32x2){f1[2], f1[3]} * S3 + (f32x2){k1[2], k1[3]} * vv;
            f32x2 o2 = (f32x2){q0[0], q0[1]} * S0 + (f32x2){q0[2], q0[3]} * S1 + (f32x2){q1[0], q1[1]} * S2 + (f32x2){q1[2], q1[3]} * S3;
            PO[(t * 8 + wv) * 64 + e] = o2[0] + o2[1];
        }
        __syncthreads();
#pragma unroll
        for (int i = 0; i < 4; ++i) { const int t = wv * 4 + i;
            float o = 0.f;
#pragma unroll
            for (int q = 0; q < 8; ++q) o += PO[(t * 8 + q) * 64 + e];
            const float ss = wave_sum(o * o); const float rs = rsqrtf(ss * (1.0f / 64.0f) + 1e-6f);
            base[(size_t)(t0 + t) * PLD + C_HQ] = f2bf(o * rs * ng * siluf_(gr[i])); }
        __syncthreads();
    }
#undef HG_PREFETCH
}

DI float dpp_xor1(float v) { return __int_as_float(__builtin_amdgcn_mov_dpp(__float_as_int(v), 0xB1, 0xF, 0xF, true)); }
DI float dpp_xor2(float v) { return __int_as_float(__builtin_amdgcn_mov_dpp(__float_as_int(v), 0x4E, 0xF, 0xF, true)); }
DI float dpp_hmir(float v) { return __int_as_float(__builtin_amdgcn_mov_dpp(__float_as_int(v), 0x141, 0xF, 0xF, true)); }
DI float red8(float v) { v += dpp_xor1(v); v += dpp_xor2(v); v += dpp_hmir(v); return v; }

__device__ __forceinline__ void rwkv_scan(unsigned char* smem, CP p, int L, int b, int h) {
    constexpr int BUF_F = 6 * 2048 + 64 + 2048;
    const int tid = tid_(), c = tid & 63, wv = tid >> 6, C = h * 64 + c, lane = c;
    const float* mu = p->in[I_MU] + (size_t)L * 1792;
    const float mu_r = mu[C], mu_k = mu[512 + C], mu_v = mu[1024 + C];
    const float w0 = p->in[I_W0][L * 512 + C], a0 = p->in[I_A0][L * 512 + C];
    const float k_k = p->in[I_KK][L * 512 + C], k_a = p->in[I_KA][L * 512 + C], r_k = p->in[I_RK][L * 512 + C], ln_w = p->in[I_LNW][L * 512 + C], ln_b = p->in[I_LNB][L * 512 + C];
    const bf16_t* base = (const bf16_t*)(p->ws + WS_PROJ) + (size_t)b * SEQ * PLD + C_RW + C;
    const bf16_t* ewa = (const bf16_t*)(p->ws + WS_UN) + (size_t)b * SEQ * 1024 + C;
    bf16_t* obase = (bf16_t*)(p->ws + WS_ORW) + (size_t)b * SEQ * 512 + C;
    const int kp = lane & 7, vr = lane >> 3, vrow = wv * 8 + vr;
    f32x2 S0 = {0.f, 0.f}, S1 = {0.f, 0.f}, S2 = {0.f, 0.f}, S3 = {0.f, 0.f};
    bf16_t pr[4], pk[4], pv[4], pe[4], pa[4], pg[4], qr, qk, qv;
#define RW_PREFETCH(T0) do { const int s0_ = (T0) + wv * 4; \
        _Pragma("unroll") for (int i = 0; i < 4; ++i) { const bf16_t* row = base + (size_t)(s0_ + i) * PLD; pr[i] = row[0]; pk[i] = row[512]; pv[i] = row[1024]; \
            pe[i] = ewa[(size_t)(s0_ + i) * 1024]; pa[i] = ewa[(size_t)(s0_ + i) * 1024 + 512]; pg[i] = obase[(size_t)(s0_ + i) * 512]; } \
        if (s0_ > 0) { const bf16_t* row = base + (size_t)(s0_ - 1) * PLD; qr = row[0]; qk = row[512]; qv = row[1024]; } else { qr = 0; qk = 0; qv = 0; } } while (0)
    RW_PREFETCH(0);
    __syncthreads();
    for (int blk = 0; blk < SEQ / 32; ++blk) {
        float* Bf = (float*)smem + (blk & 1) * BUF_F;
        float* Wd = Bf; float* NKK = Bf + 2048; float* AB = Bf + 4096; float* KX = Bf + 6144; float* WR = Bf + 8192; float* VS = Bf + 10240; float* SC = Bf + 12288; float* YS = Bf + 12352;
        float bon[4], gv[4];
        { float rp = bf2f(qr), kq = bf2f(qk), vp = bf2f(qv);
#pragma unroll
          for (int i = 0; i < 4; ++i) { const int t = wv * 4 + i;
              const float r1 = bf2f(pr[i]), k1 = bf2f(pk[i]), v1 = bf2f(pv[i]);
              const float r = r1 + (rp - r1) * mu_r, k = k1 + (kq - k1) * mu_k, v = v1 + (vp - v1) * mu_v; rp = r1; kq = k1; vp = v1;
              const float decay = __expf(-0.6065306597f * sigmoidf_(w0 + bf2f(pe[i]))), a = sigmoidf_(a0 + bf2f(pa[i])); gv[i] = bf2f(pg[i]);
              const float kkv = k * k_k; const float ssq = wave_sum(kkv * kkv); const float kkn = kkv / fmaxf(sqrtf(ssq), 1e-12f);
              const float kx = k * (1.0f + (a - 1.0f) * k_a), ab = kkn * a;
              const float br = wave_sum(ab * r), kr = wave_sum(kx * r); bon[i] = wave_sum(r * kx * r_k);
              Wd[t * 64 + c] = decay; NKK[t * 64 + c] = -kkn; AB[t * 64 + c] = ab; KX[t * 64 + c] = kx; WR[t * 64 + c] = decay * r; VS[t * 64 + c] = v;
              if (c == 0) { SC[t * 2] = br; SC[t * 2 + 1] = kr; } } }
        __syncthreads();
        if (blk + 1 < SEQ / 32) RW_PREFETCH((blk + 1) * 32);
#define RW_LOAD(T, w0v, w1v, n0, n1, b0, b1, x0, x1, q0, q1, vv, sc) do { const int o_ = (T) * 64 + kp * 8; \
            w0v = *(const f32x4*)(Wd + o_); w1v = *(const f32x4*)(Wd + o_ + 4); n0 = *(const f32x4*)(NKK + o_); n1 = *(const f32x4*)(NKK + o_ + 4); \
            b0 = *(const f32x4*)(AB + o_); b1 = *(const f32x4*)(AB + o_ + 4); x0 = *(const f32x4*)(KX + o_); x1 = *(const f32x4*)(KX + o_ + 4); \
            q0 = *(const f32x4*)(WR + o_); q1 = *(const f32x4*)(WR + o_ + 4); vv = VS[(T) * 64 + vrow]; sc = *(const f32x2*)(SC + (T) * 2); } while (0)
        f32x4 cw0, cw1, cn0, cn1, cb0, cb1, cx0, cx1, cq0, cq1; float cvv; f32x2 csc;
        RW_LOAD(0, cw0, cw1, cn0, cn1, cb0, cb1, cx0, cx1, cq0, cq1, cvv, csc);
#pragma nounroll
        for (int t8 = 0; t8 < 4; ++t8) {
            float ykeep = 0.f;
#pragma unroll
            for (int j = 0; j < 8; ++j) {
                const int t = t8 * 8 + j;
                const f32x4 w0v = cw0, w1v = cw1, n0 = cn0, n1 = cn1, b0 = cb0, b1 = cb1, x0 = cx0, x1 = cx1, q0 = cq0, q1 = cq1; const float vv = cvv; const f32x2 sc = csc;
                { const int tn = (t + 1) & 31; RW_LOAD(tn, cw0, cw1, cn0, cn1, cb0, cb1, cx0, cx1, cq0, cq1, cvv, csc); }
                const f32x2 sa2 = S0 * (f32x2){n0[0], n0[1]} + S1 * (f32x2){n0[2], n0[3]} + S2 * (f32x2){n1[0], n1[1]} + S3 * (f32x2){n1[2], n1[3]};
                const f32x2 y2 = S0 * (f32x2){q0[0], q0[1]} + S1 * (f32x2){q0[2], q0[3]} + S2 * (f32x2){q1[0], q1[1]} + S3 * (f32x2){q1[2], q1[3]};
                float sa = sa2[0] + sa2[1], yy = y2[0] + y2[1];
                sa += dpp_xor1(sa); yy += dpp_xor1(yy); sa += dpp_xor2(sa); yy += dpp_xor2(yy); sa += dpp_hmir(sa); yy += dpp_hmir(yy);
                const f32x2 sav = {sa, sa}, vv2 = {vv, vv};
                S0 = S0 * (f32x2){w0v[0], w0v[1]} + sav * (f32x2){b0[0], b0[1]} + vv2 * (f32x2){x0[0], x0[1]};
                S1 = S1 * (f32x2){w0v[2], w0v[3]} + sav * (f32x2){b0[2], b0[3]} + vv2 * (f32x2){x0[2], x0[3]};
                S2 = S2 * (f32x2){w1v[0], w1v[1]} + sav * (f32x2){b1[0], b1[1]} + vv2 * (f32x2){x1[0], x1[1]};
                S3 = S3 * (f32x2){w1v[2], w1v[3]} + sav * (f32x2){b1[2], b1[3]} + vv2 * (f32x2){x1[2], x1[3]};
                const float y = yy + sa * sc[0] + vv * sc[1];
                ykeep = (kp == j) ? y : ykeep;
            }
            YS[(t8 * 8 + kp) * 64 + vrow] = ykeep;
        }
#undef RW_LOAD
        __syncthreads();
#pragma unroll
        for (int i = 0; i < 4; ++i) { const int t = wv * 4 + i;
            const float y = YS[t * 64 + c]; const float mean = wave_sum(y) * (1.0f / 64.0f); const float dlt = y - mean;
            const float var = wave_sum(dlt * dlt) * (1.0f / 64.0f);
            float yn = dlt * rsqrtf(var + 64e-5f) * ln_w + ln_b; yn += bon[i] * VS[t * 64 + c];
            obase[(size_t)(blk * 32 + t) * 512] = f2bf(yn * gv[i]); }
    }
#undef RW_PREFETCH
    __syncthreads();
}

DI int crow16(int i, int hl) { return (i & 3) + 8 * (i >> 2) + 4 * hl; }
__device__ __forceinline__ void rwkv_chunked(unsigned char* smem, CP p, int L, int b, int h) {
    bf16_t* ZB = (bf16_t*)smem;
    bf16_t* AR = (bf16_t*)(smem + 9216);
    bf16_t* BKt = (bf16_t*)(smem + 13824);
    bf16_t* UV = (bf16_t*)(smem + 18944);
    bf16_t* MT1 = (bf16_t*)(smem + 24064);
    bf16_t* MT2 = (bf16_t*)(smem + 25600);
    float* EW = (float*)(smem + 27136);
    bf16_t* BKr = (bf16_t*)(smem + 31232);
    float* Mf = (float*)(smem + 48640);
    float* Gs = (float*)(smem + 52864);
    float* YS = (float*)(smem + 57216);
    float* VS = (float*)(smem + 61312);
    float* PC = (float*)(smem + 65408);
    const int tid = tid_(), c = tid & 63, wv = tid >> 6, C = h * 64 + c, lane = c, qi = lane & 31, hl = lane >> 5;
    const float* mu = p->in[I_MU] + (size_t)L * 1792;
    const float mu_r = mu[C], mu_k = mu[512 + C], mu_v = mu[1024 + C];
    const float w0 = p->in[I_W0][L * 512 + C], a0 = p->in[I_A0][L * 512 + C];
    const float k_k = p->in[I_KK][L * 512 + C], k_a = p->in[I_KA][L * 512 + C], r_k = p->in[I_RK][L * 512 + C], ln_w = p->in[I_LNW][L * 512 + C], ln_b = p->in[I_LNB][L * 512 + C];
    const bf16_t* base = (const bf16_t*)(p->ws + WS_PROJ) + (size_t)b * SEQ * PLD + C_RW + C;
    const bf16_t* ewa = (const bf16_t*)(p->ws + WS_UN) + (size_t)b * SEQ * 1024 + C;
    bf16_t* obase = (bf16_t*)(p->ws + WS_ORW) + (size_t)b * SEQ * 512 + C;
    f32x16 zacc;
#pragma unroll
    for (int i = 0; i < 16; ++i) zacc[i] = 0.f;
    for (int i = tid; i < 64 * 72; i += 512) ZB[i] = 0;
    bf16_t pr[2], pk[2], pv[2], pe[2], pa[2], pg[2], qr, qk, qv;
#define RC_PREFETCH(T0) do { const int s0_ = (T0) + wv * 2; \
        _Pragma("unroll") for (int i = 0; i < 2; ++i) { const bf16_t* row = base + (size_t)(s0_ + i) * PLD; pr[i] = row[0]; pk[i] = row[512]; pv[i] = row[1024]; \
            pe[i] = ewa[(size_t)(s0_ + i) * 1024]; pa[i] = ewa[(size_t)(s0_ + i) * 1024 + 512]; pg[i] = obase[(size_t)(s0_ + i) * 512]; } \
        if (s0_ > 0) { const bf16_t* row = base + (size_t)(s0_ - 1) * PLD; qr = row[0]; qk = row[512]; qv = row[1024]; } else { qr = 0; qk = 0; qv = 0; } } while (0)
    RC_PREFETCH(0);
    __syncthreads();
    for (int ch = 0; ch < SEQ / 16; ++ch) {
        float bon[2], gv[2], r_[2], nk_[2], ab_[2], kx_[2], v_[2], ew_[2];
        { float rp = bf2f(qr), kq = bf2f(qk), vp = bf2f(qv);
#pragma unroll
          for (int i = 0; i < 2; ++i) { const int t = wv * 2 + i;
              const float r1 = bf2f(pr[i]), k1 = bf2f(pk[i]), v1 = bf2f(pv[i]);
              const float r = r1 + (rp - r1) * mu_r, k = k1 + (kq - k1) * mu_k, v = v1 + (vp - v1) * mu_v; rp = r1; kq = k1; vp = v1;
              const float ew = 0.6065306597f * sigmoidf_(w0 + bf2f(pe[i])), a = sigmoidf_(a0 + bf2f(pa[i])); gv[i] = bf2f(pg[i]);
              const float kkv = k * k_k; const float ssq = wave_sum(kkv * kkv); const float kkn = kkv * rsqrtf(fmaxf(ssq, 1e-24f));
              const float kx = k * (1.0f + (a - 1.0f) * k_a);
              bon[i] = wave_sum(r * kx * r_k);
              r_[i] = r; nk_[i] = kkn; ab_[i] = kkn * a; kx_[i] = kx; v_[i] = v; ew_[i] = ew; EW[t * 64 + c] = ew; } }
        __syncthreads();
        if (ch + 1 < SEQ / 16) RC_PREFETCH((ch + 1) * 16);
        { float ev[16];
#pragma unroll
          for (int j = 0; j < 16; ++j) ev[j] = EW[j * 64 + c];
#pragma unroll
          for (int i = 0; i < 2; ++i) { const int t = wv * 2 + i; float cum = 0.f;
#pragma unroll
            for (int j = 0; j < 16; ++j) cum += (j <= t) ? ev[j] : 0.f;
            const float Pt = __expf(-cum), Pm = __expf(-(cum - ew_[i])), iP = __expf(cum);
            const float al = -nk_[i] * Pm, rh = r_[i] * Pt, be = ab_[i] * iP, ka = kx_[i] * iP;
            AR[t * 72 + c] = f2bf(al); AR[(16 + t) * 72 + c] = f2bf(rh); BKr[t * 72 + c] = f2bf(be); BKr[(16 + t) * 72 + c] = f2bf(ka);
            BKt[c * 40 + t] = f2bf(be); BKt[c * 40 + 16 + t] = f2bf(ka);
            UV[c * 40 + 16 + t] = f2bf(v_[i]); VS[t * 64 + c] = v_[i];
            if (t == 15) PC[c] = Pt; } }
        __syncthreads();
        f32x16 acc;
#pragma unroll
        for (int i = 0; i < 16; ++i) acc[i] = 0.f;
        if (wv == 0) {
#pragma unroll
            for (int s = 0; s < 4; ++s) acc = MFMA32(*(const bf16x8*)(BKr + qi * 72 + 16 * s + 8 * hl), *(const bf16x8*)(AR + qi * 72 + 16 * s + 8 * hl), acc);
#pragma unroll
            for (int i = 0; i < 16; ++i) { const int j = crow16(i, hl), n = qi; const float m = acc[i];
                if (j < 16) { if (n < 16) Mf[j * 17 + n] = m; MT2[n * 24 + j] = f2bf((n >= 16 && j <= n - 16) ? m : 0.f); }
                else { const int i2 = j - 16; const bool k1 = n < 16 ? (i2 < n) : (i2 <= n - 16); MT1[n * 24 + i2] = f2bf(k1 ? m : 0.f); } }
        } else if (wv < 3) {
            const int vb = wv - 1;
#pragma unroll
            for (int s = 0; s < 4; ++s) acc = MFMA32(*(const bf16x8*)(ZB + (32 * vb + qi) * 72 + 16 * s + 8 * hl), *(const bf16x8*)(AR + qi * 72 + 16 * s + 8 * hl), acc);
        }
        __syncthreads();
        if (wv == 1 || wv == 2) { const int vb = wv - 1;
            acc = MFMA32(*(const bf16x8*)(UV + (32 * vb + qi) * 40 + 16 + 8 * hl), *(const bf16x8*)(MT1 + qi * 24 + 8 * hl), acc);
            if (qi < 16) {
#pragma unroll
                for (int i = 0; i < 16; ++i) Gs[(32 * vb + crow16(i, hl)) * 17 + qi] = acc[i]; }
        }
        __syncthreads();
        if (wv == 0) {
            float u[16];
#pragma unroll
            for (int t = 0; t < 16; ++t) { float x0 = Gs[lane * 17 + t], x1 = 0.f;
#pragma unroll
                for (int i = 0; i < t; ++i) { if (i & 1) x1 += u[i] * Mf[i * 17 + t]; else x0 += u[i] * Mf[i * 17 + t]; }
                u[t] = x0 + x1; UV[lane * 40 + t] = f2bf(u[t]); }
        }
        __syncthreads();
        if (wv == 1 || wv == 2) { const int vb = wv - 1;
            acc = MFMA32(*(const bf16x8*)(UV + (32 * vb + qi) * 40 + 8 * hl), *(const bf16x8*)(MT2 + qi * 24 + 8 * hl), acc);
            if (qi >= 16) {
#pragma unroll
                for (int i = 0; i < 16; ++i) YS[(qi - 16) * 64 + 32 * vb + crow16(i, hl)] = acc[i]; }
        }
        if (wv >= 4) { const int vb = (wv >> 1) & 1, kb = wv & 1;
#pragma unroll
            for (int s = 0; s < 2; ++s) zacc = MFMA32(*(const bf16x8*)(UV + (32 * vb + qi) * 40 + 16 * s + 8 * hl), *(const bf16x8*)(BKt + (32 * kb + qi) * 40 + 16 * s + 8 * hl), zacc);
            const float pc = PC[32 * kb + qi];
#pragma unroll
            for (int i = 0; i < 16; ++i) { zacc[i] *= pc; ZB[(32 * vb + crow16(i, hl)) * 72 + 32 * kb + qi] = f2bf(zacc[i]); }
        }
        __syncthreads();
#pragma unroll
        for (int i = 0; i < 2; ++i) { const int t = wv * 2 + i;
            const float y = YS[t * 64 + c]; const float mean = wave_sum(y) * (1.0f / 64.0f); const float dlt = y - mean;
            const float var = wave_sum(dlt * dlt) * (1.0f / 64.0f);
            float yn = dlt * rsqrtf(var + 64e-5f) * ln_w + ln_b; yn += bon[i] * VS[t * 64 + c];
            obase[(size_t)(ch * 16 + t) * 512] = f2bf(yn * gv[i]); }
    }
#undef RC_PREFETCH
    __syncthreads();
}

constexpr int KTS = 72;
DI bf16x8 pack8(float a0, float a1, float a2, float a3, float a4, float a5, float a6, float a7) {
    u32x4 w; w.x = pack2(a0, a1); w.y = pack2(a2, a3); w.z = pack2(a4, a5); w.w = pack2(a6, a7); return __builtin_bit_cast(bf16x8, w); }
DI bf16x8 ld_vfrag(const bf16_t* vt, int off) { const u32x2 lo = *(const u32x2*)(vt + off), hi = *(const u32x2*)(vt + off + 8); u32x4 w; w.x = lo.x; w.y = lo.y; w.z = hi.x; w.w = hi.y; return __builtin_bit_cast(bf16x8, w); }

struct FlashState { f32x16 o0, o1; float m, l; };

DI void flash_update(FlashState& st, f32x16& sc0, f32x16& sc1, const bf16_t* VT, int vs, int qi, int hl) {
    const bf16x8 va0 = ld_vfrag(VT, qi * vs + 4 * hl), vb0 = ld_vfrag(VT, (32 + qi) * vs + 4 * hl);
    const bf16x8 va1 = ld_vfrag(VT, qi * vs + 32 + 4 * hl), vb1 = ld_vfrag(VT, (32 + qi) * vs + 32 + 4 * hl);
    asm volatile("" ::: "memory");
    float mt = -INFINITY;
#pragma unroll
    for (int i = 0; i < 16; ++i) mt = fmaxf(mt, fmaxf(sc0[i], sc1[i]));
    mt = fmaxf(mt, shfl_xor_(mt, 32, qi + 32 * hl));
    const float mnew = fmaxf(st.m, mt), muse = (mnew == -INFINITY) ? 0.f : mnew;
    const float alpha = __builtin_amdgcn_exp2f(st.m - muse);
    float ls = 0.f;
#pragma unroll
    for (int i = 0; i < 16; ++i) { sc0[i] = __builtin_amdgcn_exp2f(sc0[i] - muse); sc1[i] = __builtin_amdgcn_exp2f(sc1[i] - muse); ls += sc0[i] + sc1[i]; }
    st.l = st.l * alpha + ls; st.m = mnew;
    st.o0 *= alpha; st.o1 *= alpha;
    {
        const bf16x8 p0 = pack8(sc0[0], sc0[1], sc0[2], sc0[3], sc0[4], sc0[5], sc0[6], sc0[7]);
        const bf16x8 p1 = pack8(sc1[0], sc1[1], sc1[2], sc1[3], sc1[4], sc1[5], sc1[6], sc1[7]);
        const bf16x8 wa0 = ld_vfrag(VT, qi * vs + 16 + 4 * hl), wb0 = ld_vfrag(VT, (32 + qi) * vs + 16 + 4 * hl);
        const bf16x8 wa1 = ld_vfrag(VT, qi * vs + 48 + 4 * hl), wb1 = ld_vfrag(VT, (32 + qi) * vs + 48 + 4 * hl);
        st.o0 = MFMA32(va0, p0, st.o0); st.o1 = MFMA32(vb0, p0, st.o1); st.o0 = MFMA32(va1, p1, st.o0); st.o1 = MFMA32(vb1, p1, st.o1);
        const bf16x8 r0 = pack8(sc0[8], sc0[9], sc0[10], sc0[11], sc0[12], sc0[13], sc0[14], sc0[15]);
        const bf16x8 r1 = pack8(sc1[8], sc1[9], sc1[10], sc1[11], sc1[12], sc1[13], sc1[14], sc1[15]);
        st.o0 = MFMA32(wa0, r0, st.o0); st.o1 = MFMA32(wb0, r0, st.o1); st.o0 = MFMA32(wa1, r1, st.o0); st.o1 = MFMA32(wb1, r1, st.o1);
    }
}
DI void qk_tile(const bf16_t* KT, const bf16x8 (&qf)[4], int qi, int hl, f32x16& sc0, f32x16& sc1) {
#pragma unroll
    for (int i = 0; i < 16; ++i) { sc0[i] = 0.f; sc1[i] = 0.f; }
#pragma unroll
    for (int s = 0; s < 4; ++s) {
        const bf16x8 k0 = *(const bf16x8*)(KT + qi * KTS + 16 * s + 8 * hl), k1 = *(const bf16x8*)(KT + (32 + qi) * KTS + 16 * s + 8 * hl);
        sc0 = MFMA32(k0, qf[s], sc0); sc1 = MFMA32(k1, qf[s], sc1);
    }
}
struct KVRegs { u32x4 k, v; };
DI void kv_fetch(KVRegs& r, const bf16_t* pb, int kcol, int vcol, int k0) {
    const int tid = tid_();
    const unsigned ok_ = (unsigned)((k0 + (tid >> 3)) * PLD + kcol + (tid & 7) * 8) * 2u, ov_ = (unsigned)((k0 + (tid & 63)) * PLD + vcol + (tid >> 6) * 8) * 2u;
    r.k = *(const u32x4*)((const char*)pb + ok_);
    r.v = *(const u32x4*)((const char*)pb + ov_);
}
DI void kv_store(const KVRegs& r, bf16_t* KT, bf16_t* VT) {
    const int tid = tid_();
    *(u32x4*)(KT + (tid >> 3) * KTS + (tid & 7) * 8) = r.k;
    const int key = tid & 63, ch = tid >> 6;
#pragma unroll
    for (int j = 0; j < 8; ++j) VT[(ch * 8 + j) * KTS + key] = (bf16_t)((j & 1) ? (r.v[j >> 1] >> 16) : (r.v[j >> 1] & 0xFFFFu));
}
template <bool LUTB, bool CAUSAL, bool WHI, bool SEL>
DI void mask_tile(f32x16& sc0, f32x16& sc1, const float* lut, int qpos, int k0, int hl, bool sel, float qs) {
    const float bfar = lut[128];
#pragma unroll
    for (int g8 = 0; g8 < 2; ++g8) {
        float ba[8], bb[8];
#pragma unroll
        for (int j = 0; j < 8; ++j) { const int i = g8 * 8 + j, kl = (i & 3) + 8 * (i >> 2) + 4 * hl; const int da = qpos - (k0 + kl), db = da - 32;
            ba[j] = LUTB ? lut[da > 128 ? 128 : (da < 0 ? 0 : da)] : bfar; bb[j] = LUTB ? lut[db > 128 ? 128 : (db < 0 ? 0 : db)] : bfar; }
        if (LUTB) asm volatile("" ::: "memory");
#pragma unroll
        for (int j = 0; j < 8; ++j) { const int i = g8 * 8 + j, kl = (i & 3) + 8 * (i >> 2) + 4 * hl; const int da = qpos - (k0 + kl), db = da - 32;
            { const float v = sc0[i] * qs + ba[j]; bool ok = true; if (CAUSAL) ok = ok && da >= 0; if (WHI) ok = ok && da < 256; if (SEL) ok = ok && sel; sc0[i] = ok ? v : -INFINITY; }
            { const float v = sc1[i] * qs + bb[j]; bool ok = true; if (CAUSAL) ok = ok && db >= 0; if (WHI) ok = ok && db < 256; if (SEL) ok = ok && sel; sc1[i] = ok ? v : -INFINITY; } }
    }
}

__device__ __forceinline__ void nsa_item(unsigned char* smem, CP p, int L, int b, int g, int qb, int ocol) {
    bf16_t* KT = (bf16_t*)smem;
    bf16_t* VT = (bf16_t*)(smem + 9216);
    float* LUT = (float*)(smem + 18432);
    unsigned* SELM = (unsigned*)(smem + 20736);
    unsigned* ORM = (unsigned*)(smem + 20992);
    float* PA = (float*)(smem + 21504);
    float* PBv = (float*)(smem + 54272);
    bf16_t* KT2 = (bf16_t*)(smem + 87040);
    bf16_t* VT2 = (bf16_t*)(smem + 105472);
    const int tid = tid_(), lane = tid & 63, wv = tid >> 6, hh = wv >> 1, qhalf = wv & 1, qi = lane & 31, hl = lane >> 5;
    const int ql = qhalf * 32 + qi, qpos = qb * 64 + ql, head = g * 4 + hh;
    bf16_t* pb = (bf16_t*)(p->ws + WS_PROJ) + (size_t)b * SEQ * PLD;
    bf16_t* qrow = pb + (size_t)qpos * PLD;
    __syncthreads();
    for (int i = tid; i < 4 * 129; i += 512) { const int h2 = i / 129, dd = i % 129; int bk;
        if (dd < 16) bk = dd; else if (dd >= 128) bk = 31; else { bk = 16 + (int)(logf((float)dd / 16.0f) / 2.0794415416798357f * 16.0f); bk = bk > 31 ? 31 : bk; }
        LUT[h2 * 132 + dd] = p->in[I_RELB][bk * 8 + g * 4 + h2] * 1.4426950408889634f; }
    if (tid == 0) *ORM = 0u;
    if (tid < 64) SELM[tid] = 0u;
    if (tid < 256) PBv[tid * 32] = 0.f;
    { const float* kc = (const float*)(p->ws + WS_KC) + ((size_t)(0 * 16 + b) * 2 + g) * 128 * 64; const float* vc = (const float*)(p->ws + WS_KC) + ((size_t)(1 * 16 + b) * 2 + g) * 128 * 64;
      for (int i = tid; i < 128 * 64; i += 512) { const int n = i >> 6, d = i & 63; KT2[n * KTS + d] = f2bf(kc[i]); }
      for (int i = tid; i < 128 * 64; i += 512) { const int n = i & 127, d = i >> 7; VT2[d * 136 + n] = f2bf(vc[n * 64 + d]); } }
    bf16x8 qf[4];
#pragma unroll
    for (int s = 0; s < 4; ++s) qf[s] = *(const bf16x8*)(qrow + C_NQ + head * 64 + 16 * s + 8 * hl);
    float g0, g1, g2;
    { const bf16_t* gp = qrow + C_NG + head * 3; g0 = sigmoidf_(bf2f(gp[0])); g1 = sigmoidf_(bf2f(gp[1])); g2 = sigmoidf_(bf2f(gp[2])); }
    __syncthreads();
    const float* lut = LUT + hh * 132;
    constexpr float QS = 0.125f * 1.4426950408889634f;
    f32x16 fin0, fin1;
    {
        FlashState st;
#pragma unroll
        for (int i = 0; i < 16; ++i) { st.o0[i] = 0.f; st.o1[i] = 0.f; }
        st.m = -INFINITY; st.l = 0.f;
#pragma nounroll
        for (int t = 0; t < 2; ++t) {
            f32x16 sc0, sc1; qk_tile(KT2 + t * 64 * KTS, qf, qi, hl, sc0, sc1);
#pragma unroll
            for (int g8 = 0; g8 < 2; ++g8) { float ba[8], bb[8];
#pragma unroll
                for (int j = 0; j < 8; ++j) { const int i = g8 * 8 + j, kl = (i & 3) + 8 * (i >> 2) + 4 * hl; const int da = qpos - (16 * (64 * t + kl) + 31), db = da - 512;
                    ba[j] = lut[da > 128 ? 128 : (da < 0 ? 0 : da)]; bb[j] = lut[db > 128 ? 128 : (db < 0 ? 0 : db)]; }
                asm volatile("" ::: "memory");
#pragma unroll
                for (int j = 0; j < 8; ++j) { const int i = g8 * 8 + j, kl = (i & 3) + 8 * (i >> 2) + 4 * hl; const int na = 64 * t + kl, nb = na + 32; const int da = qpos - (16 * na + 31), db = da - 512;
                    sc0[i] = (da >= 0 && na < 127) ? sc0[i] * QS + ba[j] : -INFINITY; sc1[i] = (db >= 0 && nb < 127) ? sc1[i] * QS + bb[j] : -INFINITY; } }
            flash_update(st, sc0, sc1, VT2 + 64 * t, 136, qi, hl);
        }
        const float lt = st.l + shfl_xor_(st.l, 32, lane); const float inv = 1.0f / fmaxf(lt, 1e-30f);
        const float muse = (st.m == -INFINITY) ? 0.f : st.m;
        fin0 = st.o0 * (g0 * inv); fin1 = st.o1 * (g0 * inv);
#pragma nounroll
        for (int t = 0; t < 2; ++t) {
            f32x16 sc0, sc1; qk_tile(KT2 + t * 64 * KTS, qf, qi, hl, sc0, sc1);
#pragma unroll
            for (int g8 = 0; g8 < 2; ++g8) { float ba[8], bb[8];
#pragma unroll
                for (int j = 0; j < 8; ++j) { const int i = g8 * 8 + j, kl = (i & 3) + 8 * (i >> 2) + 4 * hl; const int da = qpos - (16 * (64 * t + kl) + 31), db = da - 512;
                    ba[j] = lut[da > 128 ? 128 : (da < 0 ? 0 : da)]; bb[j] = lut[db > 128 ? 128 : (db < 0 ? 0 : db)]; }
                asm volatile("" ::: "memory");
#pragma unroll
                for (int j = 0; j < 8; ++j) { const int i = g8 * 8 + j, kl = (i & 3) + 8 * (i >> 2) + 4 * hl; const int na = 64 * t + kl, nb = na + 32; const int da = qpos - (16 * na + 31), db = da - 512;
                    const float va = __builtin_amdgcn_exp2f(sc0[i] * QS + ba[j] - muse) * inv, vb = __builtin_amdgcn_exp2f(sc1[i] * QS + bb[j] - muse) * inv;
                    sc0[i] = (da >= 0 && na < 127) ? va : 0.f; sc1[i] = (db >= 0 && nb < 127) ? vb : 0.f; } }
#pragma unroll
            for (int i4 = 0; i4 < 4; ++i4) {
                { const int m = 16 * t + 2 * i4 + hl; PA[(hh * 64 + ql) * 32 + m] = sc0[4 * i4] + sc0[4 * i4 + 1] + sc0[4 * i4 + 2] + sc0[4 * i4 + 3]; PBv[(hh * 64 + ql) * 32 + m + 1] = sc0[4 * i4 + 3]; }
                { const int m = 16 * t + 8 + 2 * i4 + hl; PA[(hh * 64 + ql) * 32 + m] = sc1[4 * i4] + sc1[4 * i4 + 1] + sc1[4 * i4 + 2] + sc1[4 * i4 + 3]; if (m + 1 < 32) PBv[(hh * 64 + ql) * 32 + m + 1] = sc1[4 * i4 + 3]; }
            }
        }
    }
    __syncthreads();
    {
        float* IMP = (float*)smem;
        const int q = tid & 63, part = tid >> 6, cur = qb;
#pragma unroll
        for (int mm = 0; mm < 4; ++mm) { const int m = part * 4 + mm; float v;
            if (m == 0 || m == cur || m == cur - 1) v = INFINITY;
            else if (m <= cur) { v = 0.f; for (int h2 = 0; h2 < 4; ++h2) v += PA[(h2 * 64 + q) * 32 + m] + PBv[(h2 * 64 + q) * 32 + m]; }
            else v = -INFINITY;
            IMP[q * 33 + m] = v; }
        __syncthreads();
        unsigned bits = 0u;
#pragma unroll
        for (int mm = 0; mm < 4; ++mm) { const int m = part * 4 + mm; const float v = IMP[q * 33 + m]; int rank = 0;
            for (int m2 = 0; m2 < 32; ++m2) { const float v2 = IMP[q * 33 + m2]; rank += (v2 > v || (v2 == v && m2 < m)) ? 1 : 0; }
            if (rank < 8 && v > -INFINITY) bits |= 1u << m; }
        atomicOr(&SELM[q], bits); atomicOr(ORM, bits);
    }
    __syncthreads();
    const unsigned mysel = SELM[ql], orm = *ORM;
    __syncthreads();
    float* PARK = PA + (wv * 32) * 64 + lane;
#pragma unroll
    for (int i = 0; i < 16; ++i) { PARK[i * 64] = fin0[i]; PARK[(16 + i) * 64] = fin1[i]; }
    {
        FlashState st;
#pragma unroll
        for (int i = 0; i < 16; ++i) { st.o0[i] = 0.f; st.o1[i] = 0.f; }
        st.m = -INFINITY; st.l = 0.f;
        const unsigned todo = orm & (qb >= 31 ? 0xFFFFFFFFu : ((2u << qb) - 1u));
        KVRegs kr;
        int m = todo ? __builtin_ctz(todo) : -1;
        if (m >= 0) { kv_fetch(kr, pb, C_KS + g * 64, C_VS + g * 64, m * 64); __syncthreads(); kv_store(kr, KT, VT); __syncthreads(); }
        while (m >= 0) {
            const unsigned rest = todo & ~((2u << m) - 1u); const int nm = (m < 31 && rest) ? __builtin_ctz(rest) : -1;
            if (nm >= 0) kv_fetch(kr, pb, C_KS + g * 64, C_VS + g * 64, nm * 64);
            const bool sel = (mysel >> m) & 1u;
            if (__builtin_amdgcn_ballot_w64(sel) != 0ull) {
                f32x16 sc0, sc1; qk_tile(KT, qf, qi, hl, sc0, sc1);
                if (m + 3 <= qb) mask_tile<false, false, false, true>(sc0, sc1, lut, qpos, m * 64, hl, sel, QS);
                else mask_tile<true, true, false, true>(sc0, sc1, lut, qpos, m * 64, hl, sel, QS);
                flash_update(st, sc0, sc1, VT, KTS, qi, hl);
            }
            __syncthreads();
            if (nm >= 0) kv_store(kr, KT, VT);
            __syncthreads();
            m = nm;
        }
        const float lt = st.l + shfl_xor_(st.l, 32, lane); const float sc = g1 / fmaxf(lt, 1e-30f);
#pragma unroll
        for (int i = 0; i < 16; ++i) { PARK[i * 64] += st.o0[i] * sc; PARK[(16 + i) * 64] += st.o1[i] * sc; }
    }
    {
        FlashState st;
#pragma unroll
        for (int i = 0; i < 16; ++i) { st.o0[i] = 0.f; st.o1[i] = 0.f; }
        st.m = -INFINITY; st.l = 0.f;
        KVRegs kr;
        int w = qb >= 4 ? 0 : 4 - qb;
        kv_fetch(kr, pb, C_KW + g * 64, C_VW + g * 64, qb * 64 - 256 + 64 * w); __syncthreads(); kv_store(kr, KT, VT); __syncthreads();
        for (; w < 5; ++w) {
            const int k0 = qb * 64 - 256 + 64 * w;
            if (w < 4) kv_fetch(kr, pb, C_KW + g * 64, C_VW + g * 64, k0 + 64);
            f32x16 sc0, sc1; qk_tile(KT, qf, qi, hl, sc0, sc1);
            if (w == 0) mask_tile<false, false, true, false>(sc0, sc1, lut, qpos, k0, hl, true, QS);
            else if (w == 1) mask_tile<false, false, false, false>(sc0, sc1, lut, qpos, k0, hl, true, QS);
            else if (w < 4) mask_tile<true, false, false, false>(sc0, sc1, lut, qpos, k0, hl, true, QS);
            else mask_tile<true, true, false, false>(sc0, sc1, lut, qpos, k0, hl, true, QS);
            flash_update(st, sc0, sc1, VT, KTS, qi, hl);
            __syncthreads();
            if (w < 4) kv_store(kr, KT, VT);
            __syncthreads();
        }
        const float lt = st.l + shfl_xor_(st.l, 32, lane); const float sc = g2 / fmaxf(lt, 1e-30f);
#pragma unroll
        for (int i = 0; i < 16; ++i) { fin0[i] = PARK[i * 64] + st.o0[i] * sc; fin1[i] = PARK[(16 + i) * 64] + st.o1[i] * sc; }
    }
#pragma unroll
    for (int i4 = 0; i4 < 4; ++i4) {
        u32x2 w0; w0.x = pack2(fin0[4 * i4], fin0[4 * i4 + 1]); w0.y = pack2(fin0[4 * i4 + 2], fin0[4 * i4 + 3]);
        u32x2 w1; w1.x = pack2(fin1[4 * i4], fin1[4 * i4 + 1]); w1.y = pack2(fin1[4 * i4 + 2], fin1[4 * i4 + 3]);
        *(u32x2*)(qrow + ocol + head * 64 + 8 * i4 + 4 * hl) = w0;
        *(u32x2*)(qrow + ocol + head * 64 + 32 + 8 * i4 + 4 * hl) = w1;
    }
}

constexpr int PH_PER_LAYER = 15, PH_TOTAL = DEPTH * PH_PER_LAYER + 1;
enum { S_PREP = 0, S_GU1, S_D1, S_NORM_MIX, S_WIN, S_CMP, S_LORA, S_SCAN, S_MERGE, S_OUT, S_NORM2, S_GU2, S_D2, S_NORM_PLE, S_PLEG, S_FINAL };

__device__ __forceinline__ void run_phase(unsigned char* smem, CP p, int ph) {
    const bool fin = (ph == DEPTH * PH_PER_LAYER);
    const int L = fin ? 0 : ph / PH_PER_LAYER; const int sub = fin ? S_FINAL : ph % PH_PER_LAYER;
    unsigned char* ws = p->ws; float* H = p->out;
    bf16_t* W = (bf16_t*)(ws + WS_WBF); bf16_t* UN = (bf16_t*)(ws + WS_UN); bf16_t* PROJ = (bf16_t*)(ws + WS_PROJ); bf16_t* ACT = (bf16_t*)(ws + WS_ACT);
    bf16_t* TMP = (bf16_t*)(ws + WS_TMP); bf16_t* PBF = (bf16_t*)(ws + WS_PB); bf16_t* ORW = (bf16_t*)(ws + WS_ORW);
    bf16_t* XK = (bf16_t*)(ws + WS_XK); bf16_t* XV = (bf16_t*)(ws + WS_XV); float* P01 = (float*)(ws + WS_P01);
    if (sub == S_PREP) convert_layer_weights(smem, p, L);
    if (sub == S_NORM_MIX) convert_ffn2_weights(smem, p, L);
    if (sub == S_NORM2) cvt_f32_bf16(p->in[I_P] + (size_t)L * T_TOK * 256, PBF, (size_t)T_TOK * 256 / 4);
    if (sub == S_CMP) lora_act(p, L);
    if (sub == S_LORA) finalize_cmp(smem, p, L);
    if (sub == S_NORM_PLE) { EpiBf16<DM> e; e.O = TMP; run_gemm(smem, PBF, 256, W + E_PW, T_TOK, DM, 256, e); }
    if (sub == S_PREP || sub == S_NORM_MIX || sub == S_NORM2 || sub == S_NORM_PLE || sub == S_FINAL) {
        const float* hin = (sub == S_PREP && L == 0) ? p->in[I_X] : H; float* hcopy = (sub == S_PREP && L == 0) ? H : nullptr;
        const float* g = sub == S_PREP ? p->in[I_F1N] + L * DM : sub == S_NORM_MIX ? p->in[I_MIXN] + L * DM : sub == S_NORM2 ? p->in[I_F2N] + L * DM : sub == S_NORM_PLE ? p->in[I_PLEN] + L * DM : p->in[I_FINN];
        rmsnorm_rows(hin, hcopy, g, sub == S_FINAL ? nullptr : UN, sub == S_FINAL ? H : nullptr);
    } else if (sub == S_GU1 || sub == S_GU2) {
        EpiSwiglu e; e.O = ACT; run_gemm(smem, UN, DM, W + (sub == S_GU1 ? E_GU1 : E_GU2), T_TOK, 2 * DFF, DM, e);
    } else if (sub == S_D1 || sub == S_D2 || sub == S_OUT) {
        EpiResid e; e.H = H; e.scale = sub == S_OUT ? 1.0f : 0.5f;
        run_gemm(smem, sub == S_OUT ? UN : ACT, sub == S_OUT ? DM : DFF, W + (sub == S_D1 ? E_D1 : sub == S_D2 ? E_D2 : E_OUT), T_TOK, DM, sub == S_OUT ? DM : DFF, e);
    } else if (sub == S_WIN) {
        EpiProj e; e.O = PROJ; e.XK = XK; e.XV = XV; run_gemm(smem, UN, DM, W + E_IN, T_TOK, N_WIN, DM, e);
    } else if (sub == S_CMP) {
#pragma nounroll
        for (int kv = 0; kv < 2; ++kv) { EpiF32 e; e.C = P01 + (size_t)kv * 4096 * 256;
            run_gemm(smem, kv ? XV : XK, 1024, W + E_C1 + (size_t)kv * 256 * 1024, 4096, 256, 1024, e, kv ? 240 : 0); }
        { EpiBf16<PLD> e; e.O = PROJ + C_NG; run_gemm(smem, UN, DM, W + E_NG, T_TOK, 256, DM, e, 128); }
    } else if (sub == S_LORA) {
        EpiLora e; e.EWA = UN; e.G = ORW;
        run_gemm(smem, (const bf16_t*)(ws + WS_LACT), 256, W + E_LORA, T_TOK, 1536, 256, e);
    } else if (sub == S_SCAN) {
        for (int item = bid_(); item < 256; item += gridDim.x) {
            __syncthreads();
            if (item < 128) rwkv_chunked(smem, p, L, item >> 3, item & 7); else hgrn_scan(smem, p, L, (item - 128) >> 3, (item - 128) & 7);
        }
        unsigned* ctr = (unsigned*)(ws + 14336) + L * 64;
        volatile unsigned* slot = (volatile unsigned*)(smem + 141 * 1024);
        for (;;) {
            __syncthreads();
            if (tid_() == 0) *slot = __hip_atomic_fetch_add(ctr, 1u, __ATOMIC_RELAXED, __HIP_MEMORY_SCOPE_AGENT);
            __syncthreads();
            const unsigned idx = *slot;
            if (idx >= 1024u) break;
            const int bg = idx & 31, qb = 31 - (int)(idx >> 5);
            nsa_item(smem, p, L, bg >> 1, bg & 1, qb, C_NQ);
        }
    } else if (sub == S_MERGE) {
#pragma nounroll
        for (int j = 0; j < 3; ++j) { EpiMerge e; e.MRG = UN; e.PROJ = PROJ; e.J = j;
            const bf16_t* A = j == 0 ? PROJ + C_HQ : (j == 1 ? PROJ + C_NQ : ORW);
            run_gemm(smem, A, j == 2 ? 512 : PLD, W + E_BR + (size_t)j * 1024 * 512, T_TOK, DM, 512, e); }
    } else if (sub == S_PLEG) {
        EpiPleGate e; e.H = H; e.TMP = TMP; run_gemm(smem, UN, DM, W + E_PG, T_TOK, DM, DM, e);
    }
}

#define XB_TMO      128
#define XB_XCNT(j)  (256  + 64 * (j))
#define XB_XSUB(j)  (1280 + 64 * (j))
#define XB_XGEN(j)  (2304 + 64 * (j))
#define XB_TOP      3328
#define XB_TOPGEN   3392
#define XCD_BAR_WORDS 3456
#define XB_SPIN_CAP (1u << 20)
DI unsigned xb_ld(unsigned* p)              { return __hip_atomic_load(p, __ATOMIC_RELAXED, __HIP_MEMORY_SCOPE_AGENT); }
DI unsigned xb_add(unsigned* p, unsigned v) { return __hip_atomic_fetch_add(p, v, __ATOMIC_RELAXED, __HIP_MEMORY_SCOPE_AGENT); }
DI unsigned xb_xcc_id() { return (unsigned)__builtin_amdgcn_s_getreg((3 << 11) | 20) & 0xFu; }
#define XB_SPIN(cond, bar) do { unsigned _sp = 0; while (cond) { __builtin_amdgcn_s_sleep(1); \
    if ((++_sp & 255u) == 0u) { if (xb_ld(&(bar)[XB_TMO])) break; if (_sp > XB_SPIN_CAP) { atomicAdd(&(bar)[XB_TMO], 1u); break; } } } } while (0)
struct XcdBarrier { unsigned* bar; unsigned x; volatile LAS unsigned* st; };
DI XcdBarrier xcd_barrier_post(unsigned* bar, volatile LAS unsigned* st) {
    XcdBarrier b; b.bar = bar; b.x = xb_xcc_id(); b.st = st;
    if (threadIdx.x == 0) (void)xb_add(&bar[XB_XCNT(b.x)], 1u);
    return b;
}
DI void xcd_barrier_complete(unsigned* bar, unsigned x, unsigned& nloc, unsigned& nx) {
    const unsigned G = gridDim.x * gridDim.y * gridDim.z;
    unsigned sum, cnt, mine, sp = 0u;
    for (;;) {
        sum = 0u; cnt = 0u; mine = 0u;
#pragma unroll
        for (unsigned j = 0; j < 16; ++j) { const unsigned c = xb_ld(&bar[XB_XCNT(j)]); sum += c; cnt += (c > 0u) ? 1u : 0u; mine = (j == x) ? c : mine; }
        if (sum == G) break;
        __builtin_amdgcn_s_sleep(1);
        if ((++sp & 255u) == 0u) { if (xb_ld(&bar[XB_TMO])) break; if (sp > XB_SPIN_CAP) { atomicAdd(&bar[XB_TMO], 1u); break; } }
    }
    nloc = mine > 0u ? mine : 1u; nx = cnt > 0u ? cnt : 1u;
}
DI void xcd_barrier(const XcdBarrier& b) {
    asm volatile("s_waitcnt vmcnt(0)" ::: "memory");
    __syncthreads();
    if (threadIdx.x == 0) {
        unsigned* bar = b.bar;
        __builtin_amdgcn_s_waitcnt(0);
        unsigned nloc = b.st[0], nx = b.st[1];
        if (nloc == 0u) { xcd_barrier_complete(bar, b.x, nloc, nx); b.st[0] = nloc; b.st[1] = nx; }
        const unsigned old = xb_add(&bar[XB_XSUB(b.x)], 1u);
        const unsigned gen = old / nloc;
        if (old + 1u == (gen + 1u) * nloc) {
            __builtin_amdgcn_fence(__ATOMIC_RELEASE, "agent");
            asm volatile("s_waitcnt vmcnt(0)" ::: "memory");
            const unsigned og = xb_add(&bar[XB_TOP], 1u);
            const unsigned tg = og / nx;
            if (og + 1u == (tg + 1u) * nx) xb_add(&bar[XB_TOPGEN], 1u);
            else XB_SPIN(xb_ld(&bar[XB_TOPGEN]) == tg, bar);
            __builtin_amdgcn_fence(__ATOMIC_ACQUIRE, "agent");
            xb_add(&bar[XB_XGEN(b.x)], 1u);
            asm volatile("s_waitcnt vmcnt(0)" ::: "memory");
        } else {
            XB_SPIN(xb_ld(&bar[XB_XGEN(b.x)]) == gen, bar);
            __builtin_amdgcn_fence(__ATOMIC_ACQUIRE, "agent");
            asm volatile("s_waitcnt vmcnt(0)" ::: "memory");
        }
    }
    __syncthreads();
}

__global__ void __launch_bounds__(512, 2) mega_fwd(Params p) {
    extern __shared__ __attribute__((aligned(16))) unsigned char smem[];
    cg::grid_group grid = cg::this_grid();
    volatile LAS unsigned* xst = (volatile LAS unsigned*)(LAS unsigned char*)(smem + 140 * 1024);
    if (threadIdx.x == 0) { xst[0] = 0u; xst[1] = 0u; }
    __syncthreads();
    const XcdBarrier xb = xcd_barrier_post((unsigned*)(p.ws + WS_BAR), xst);
#ifndef PROBE_DUP
#define PROBE_DUP -1
#endif
    constexpr int IT_PER_LAYER = PH_PER_LAYER + (PROBE_DUP >= 0 ? 1 : 0);
    const int it_lo = p.ph_lo, it_hi = PROBE_DUP >= 0 ? DEPTH * IT_PER_LAYER + 1 : p.ph_hi;
    for (int it = it_lo; it < it_hi; ++it) {
        int ph = it;
        if (PROBE_DUP >= 0) { const int l_ = it / IT_PER_LAYER, r_ = it % IT_PER_LAYER; ph = l_ * PH_PER_LAYER + (r_ <= PROBE_DUP ? r_ : r_ - 1); }
        CP pp = (CP)__builtin_amdgcn_kernarg_segment_ptr(); asm volatile("" : "+s"(pp));
        run_phase(smem, pp, ph);
        if (it + 1 < it_hi) {
            if (it == it_lo) grid.sync();
            else xcd_barrier(xb);
        }
    }
}

#ifndef MULTI_LAUNCH
#define MULTI_LAUNCH 0
#endif

extern "C" void kernel_launch(void* const* d_in, const int* in_sizes, int n_in, void* d_out, int out_size, void* d_ws, size_t ws_size, hipStream_t stream) {
    static int grid = 0;
    if (grid == 0) {
        if (n_in != N_INPUTS || out_size != T_TOK * DM || ws_size < WS_END) { fprintf(stderr, "kernel_launch: unexpected shapes: n_in %d out %d ws %zu (need %zu)\n", n_in, out_size, ws_size, (size_t)WS_END); grid = -1; return; }
        int dev = 0, cus = 0, per_cu = 0;
        (void)hipGetDevice(&dev); (void)hipDeviceGetAttribute(&cus, hipDeviceAttributeMultiprocessorCount, dev);
        if (hipFuncSetAttribute((const void*)mega_fwd, hipFuncAttributeMaxDynamicSharedMemorySize, LDS_BYTES) != hipSuccess) { fprintf(stderr, "kernel_launch: hipFuncSetAttribute failed\n"); grid = -1; return; }
        if (hipOccupancyMaxActiveBlocksPerMultiprocessor(&per_cu, (const void*)mega_fwd, 512, LDS_BYTES) != hipSuccess || per_cu < 1) { fprintf(stderr, "kernel_launch: occupancy query gives %d\n", per_cu); per_cu = 1; }
        (void)hipGetLastError();
        grid = cus * 1;
        if (grid > 256) grid = 256;
        fprintf(stderr, "kernel_launch: grid %d (cus %d, per_cu %d)\n", grid, cus, per_cu);
    }
    if (grid < 0) return;
    (void)hipMemsetAsync(d_ws, 0, 16384, stream);
    Params p{};
    for (int i = 0; i < N_INPUTS; ++i) p.in[i] = (const float*)d_in[i];
    p.out = (float*)d_out; p.ws = (unsigned char*)d_ws;
#if MULTI_LAUNCH
    for (int ph = 0; ph < PH_TOTAL; ++ph) { p.ph_lo = ph; p.ph_hi = ph + 1; hipLaunchKernelGGL(mega_fwd, dim3(grid), dim3(512), LDS_BYTES, stream, p); }
#else
    p.ph_lo = 0; p.ph_hi = PH_TOTAL;
    void* args[] = {&p};
    hipError_t e = hipLaunchCooperativeKernel((const void*)mega_fwd, dim3(grid), dim3(512), args, LDS_BYTES, stream);
    if (e != hipSuccess) fprintf(stderr, "kernel_launch: cooperative launch failed: %s\n", hipGetErrorString(e));
#endif
}
```

```cpp
#include <hip/hip_runtime.h>
#include <hip/hip_cooperative_groups.h>
#include <cstdio>
namespace cg = cooperative_groups;

#define LAS __attribute__((address_space(3)))
#define DI __device__ __forceinline__
typedef unsigned short bf16_t;
typedef short bf16x8 __attribute__((ext_vector_type(8)));
typedef float f32x4 __attribute__((ext_vector_type(4)));
typedef float f32x2 __attribute__((ext_vector_type(2)));
typedef float f32x16 __attribute__((ext_vector_type(16)));
typedef unsigned u32x4 __attribute__((ext_vector_type(4)));
typedef unsigned u32x2 __attribute__((ext_vector_type(2)));

constexpr int T_TOK = 32768, SEQ = 2048, NB = 16, DM = 1024, DFF = 2816, DEPTH = 4;
constexpr int PLD = 8448;
constexpr int C_HQ = 0, C_HF = 512, C_HI = 1024, C_HG = 1536, C_NQ = 2048, C_KC = 2560, C_VC = 2688, C_KS = 2816, C_VS = 2944,
              C_KW = 3072, C_VW = 3200, C_RW = 3328, C_MG = 5120, C_NG = 8192, N_WIN = 8192, IN_COLS = 8216;
enum { I_X = 0, I_P, I_F1N, I_F1GU, I_F1D, I_MIXN, I_WIN, I_HGLB, I_HGN, I_PE, I_CW1, I_CW2, I_RELB, I_MU, I_W0, I_WB, I_A0, I_AB, I_GB,
       I_KK, I_KA, I_RK, I_LNW, I_LNB, I_WBR, I_WOUT, I_F2N, I_F2GU, I_F2D, I_PLEN, I_PLEG, I_PLEW, I_FINN, N_INPUTS };

constexpr size_t WS_BAR = 0;
constexpr size_t WS_PEB = 16384;
constexpr size_t WS_WBF = 32768;
constexpr size_t E_GU1 = 0, E_D1 = E_GU1 + 5632ull * 1024, E_IN = E_D1 + 1024ull * 2816, E_BR = E_IN + 8448ull * 1024, E_OUT = E_BR + 3ull * 1024 * 512,
                 E_GU2 = E_GU1, E_D2 = E_D1  , E_PG = E_OUT + 1024ull * 1024, E_PW = E_PG + 1024ull * 1024,
                 E_C1 = E_PW + 1024ull * 256, E_LORA = E_C1 + 2ull * 256 * 1024, E_NG = E_LORA + 1536ull * 256, E_END = E_NG + 256ull * 1024;
constexpr size_t WS_UN = WS_WBF + E_END * 2;
constexpr size_t WS_ORW = WS_UN + (size_t)T_TOK * 1024 * 2;
constexpr size_t WS_XK = WS_ORW + (size_t)T_TOK * 512 * 2;
constexpr size_t WS_XV = WS_XK + 4096ull * 1024 * 2;
constexpr size_t WS_P01 = WS_XV + 4096ull * 1024 * 2;
constexpr size_t WS_KC = WS_P01 + 2ull * 4096 * 256 * 4;
constexpr size_t WS_LACT = WS_KC + 2ull * 16 * 2 * 128 * 64 * 4;
constexpr size_t WS_PROJ = WS_LACT + (size_t)T_TOK * 256 * 2;
constexpr size_t WS_END = WS_PROJ + (size_t)T_TOK * PLD * 2;
constexpr size_t WS_ACT = WS_PROJ;
constexpr size_t WS_PB = WS_PROJ + 200ull * 1024 * 1024;
constexpr size_t WS_TMP = WS_PROJ + 256ull * 1024 * 1024;
constexpr int LDS_BYTES = 144 * 1024;

struct Params {
    const float* in[N_INPUTS];
    float* out;
    unsigned char* ws;
    int ph_lo, ph_hi;
};
typedef const Params __attribute__((address_space(4)))* CP;

DI int tid_() { int t = threadIdx.x; asm volatile("" : "+v"(t)); return t; }
DI int bid_() { int b = blockIdx.x; asm volatile("" : "+s"(b)); return b; }
typedef __bf16 bf16v2 __attribute__((ext_vector_type(2)));
DI float bf2f(bf16_t b) { return __uint_as_float(((unsigned)b) << 16); }
DI unsigned pack2(float lo, float hi) { const f32x2 v = {lo, hi}; return __builtin_bit_cast(unsigned, __builtin_convertvector(v, bf16v2)); }
DI bf16_t f2bf(float f) { return (bf16_t)(pack2(f, 0.f) & 0xFFFFu); }
DI float sigmoidf_(float x) { return __builtin_amdgcn_rcpf(1.0f + __builtin_amdgcn_exp2f(-1.4426950408889634f * x)); }
DI float siluf_(float x) { return x * __builtin_amdgcn_rcpf(1.0f + __builtin_amdgcn_exp2f(-1.4426950408889634f * x)); }
DI float shfl_xor_(float v, int mask, int lane) { return __int_as_float(__builtin_amdgcn_ds_bpermute((lane ^ mask) << 2, __float_as_int(v))); }
DI float dppf_(float v, int) { return v; }
#define DPPF(v, ctrl) __int_as_float(__builtin_amdgcn_mov_dpp(__float_as_int(v), ctrl, 0xF, 0xF, true))
DI float wave_sum(float v) {
    v += DPPF(v, 0xB1); v += DPPF(v, 0x4E); v += DPPF(v, 0x141); v += DPPF(v, 0x140);
    const float s0 = __int_as_float(__builtin_amdgcn_readlane(__float_as_int(v), 0)), s1 = __int_as_float(__builtin_amdgcn_readlane(__float_as_int(v), 16));
    const float s2 = __int_as_float(__builtin_amdgcn_readlane(__float_as_int(v), 32)), s3 = __int_as_float(__builtin_amdgcn_readlane(__float_as_int(v), 48));
    return (s0 + s1) + (s2 + s3);
}

#define MFMA32(a, b, c) __builtin_amdgcn_mfma_f32_32x32x16_bf16((a), (b), (c), 0, 0, 0)
namespace pg8 {
constexpr int BM = 256, BK = 64, HALF = 128, HTB = HALF * BK * 2, STAGE_BYTES = 8 * HTB, NXCD = 8, WGM = 8;
DI int lds_byte(int r, int c) { const int st = (r >> 4) * 2 + (c >> 5), rr = r & 15, cc = c & 31, ob = rr * 64 + cc * 2; return st * 1024 + (ob ^ (((ob >> 9) & 1) << 5)); }
DI void stage_rc(int b, int& R, int& C) { const int st = b / 1024, sb = b % 1024, swz = sb ^ (((sb >> 9) & 1) << 5); R = (st >> 1) * 16 + swz / 64; C = (st & 1) * 32 + (swz % 64) / 2; }
DI int perm32(int rho) { const int n = rho >> 4, i = rho & 15; return 8 * (i >> 2) + 4 * n + (i & 3); }
struct Unit { int pm, pn; };
struct Gemm { const bf16_t* A; const bf16_t* Bt; int M, N, K, lda; };
struct StaticOrder {
    int nM, nN, nwg, G, c;
    DI void init(int M, int N, int G_, int c_) { nM = M / BM; nN = N / BM; nwg = nM * nN; G = G_; c = c_; }
    DI bool next(int i, Unit& u) const {
        const long L = (long)i * G + c; if (L >= nwg) return false;
        int wgid = (int)L; { const int q = nwg / NXCD, r = nwg % NXCD, xcd = wgid % NXCD, off = wgid / NXCD; wgid = (xcd < r ? xcd * (q + 1) : r * (q + 1) + (xcd - r) * q) + off; }
        const int nig = WGM * nN, gid = wgid / nig, fm = gid * WGM, gsz = (nM - fm) < WGM ? (nM - fm) : WGM;
        u.pm = fm + ((wgid % nig) % gsz); u.pn = (wgid % nig) / gsz; return true;
    }
};

template <class Epi>
DI void gemm_phase(LAS unsigned char* lds, const Gemm g, const StaticOrder& S, const Epi& E) {
    int tid = tid_();
    const int wid = __builtin_amdgcn_readfirstlane(tid >> 6), lane = tid & 63, wr = wid >> 2, wc = wid & 3, fr = lane & 15, fq = lane >> 4;
    const int K = g.K, nt = K / BK, lda = g.lda;
    unsigned voffA[2], voffB[2];
#pragma unroll
    for (int i = 0; i < 2; ++i) { int R, C; stage_rc(tid * 16 + i * 8192, R, C); const int Rb = Epi::PERM ? ((R & ~31) + perm32(R & 31)) : R;
        voffA[i] = (unsigned)(R * lda + C) * 2u; voffB[i] = (unsigned)(Rb * K + C) * 2u; }
    const size_t kstep = (size_t)(BK * 2);
    const size_t hstepA = (size_t)HALF * lda * 2, hstepB = (size_t)HALF * K * 2;
    const size_t tstepA = 2 * hstepA, tstepB = 2 * hstepB;
    const unsigned ldsw = (unsigned)wid * 1024u;
    const int aoff = lds_byte(wr * 64 + fr, fq * 8), boff = lds_byte(wc * 32 + fr, fq * 8);
#define PG8_SA(b, h) (((b) * 2 + (h)) * HTB)
#define PG8_SB(b, h) ((4 + (b) * 2 + (h)) * HTB)
#define PG8_STAGE(bufoff, gbase, voff) do { _Pragma("unroll") for (int _i = 0; _i < 2; ++_i) \
        __builtin_amdgcn_global_load_lds((const unsigned*)((const char*)(gbase) + (voff)[_i]), (LAS unsigned*)(lds + (bufoff) + ldsw + _i * 8192), 16, 0, 0); } while (0)
#define PG8_LDA(dst, b, h) do { _Pragma("unroll") for (int m = 0; m < 4; ++m) _Pragma("unroll") for (int k = 0; k < 2; ++k) dst[m][k] = *(const LAS bf16x8*)(lds + PG8_SA(b, h) + aoff + m * 2048 + k * 1024); } while (0)
#define PG8_LDB(dst, b, h) do { _Pragma("unroll") for (int n = 0; n < 2; ++n) _Pragma("unroll") for (int k = 0; k < 2; ++k) dst[n][k] = *(const LAS bf16x8*)(lds + PG8_SB(b, h) + boff + n * 2048 + k * 1024); } while (0)
#define PG8_MMA(ai, bj, At, Bt) do { __builtin_amdgcn_s_setprio(1); _Pragma("unroll") for (int m = 0; m < 4; ++m) _Pragma("unroll") for (int n = 0; n < 2; ++n) _Pragma("unroll") for (int k = 0; k < 2; ++k) \
        acc[ai][bj][m][n] = __builtin_amdgcn_mfma_f32_16x16x32_bf16(Bt[n][k], At[m][k], acc[ai][bj][m][n], 0, 0, 0); __builtin_amdgcn_s_setprio(0); } while (0)
#define PG8_WAIT_V(n) asm volatile("s_waitcnt vmcnt(" #n ")" ::: "memory")
#define PG8_WAIT_L(n) asm volatile("s_waitcnt lgkmcnt(" #n ")" ::: "memory")
#define PG8_BAR __builtin_amdgcn_s_barrier()
#define PG8_SCHED __builtin_amdgcn_sched_barrier(0)
    Unit cur, nxt; int ui = 0;
    if (!S.next(0, cur)) return;
    f32x4 acc[2][2][4][2];
#pragma unroll
    for (int a = 0; a < 2; ++a)
#pragma unroll
        for (int b = 0; b < 2; ++b)
#pragma unroll
            for (int m = 0; m < 4; ++m)
#pragma unroll
                for (int n = 0; n < 2; ++n) acc[a][b][m][n] = (f32x4){0.f, 0.f, 0.f, 0.f};
    bf16x8 At[4][2], B0[2][2], B1[2][2];
    const char* cA = (const char*)g.A + (size_t)cur.pm * tstepA; const char* cB = (const char*)g.Bt + (size_t)cur.pn * tstepB;
    PG8_STAGE(PG8_SB(0, 0), cB, voffB); PG8_STAGE(PG8_SA(0, 0), cA, voffA); PG8_STAGE(PG8_SB(0, 1), cB + hstepB, voffB); PG8_STAGE(PG8_SA(0, 1), cA + hstepA, voffA);
    if (wr == 1) PG8_BAR;
    PG8_WAIT_V(4); PG8_BAR;
    PG8_STAGE(PG8_SB(1, 0), cB + kstep, voffB); PG8_STAGE(PG8_SA(1, 0), cA + kstep, voffA); PG8_STAGE(PG8_SB(1, 1), cB + hstepB + kstep, voffB);
    PG8_WAIT_V(6); PG8_BAR;
    for (;;) {
        const bool has_next = S.next(ui + 1, nxt);
        const char* nA = has_next ? (const char*)g.A + (size_t)nxt.pm * tstepA : cA; const char* nB = has_next ? (const char*)g.Bt + (size_t)nxt.pn * tstepB : cB;
        for (int t = 0; t < nt; t += 2) {
            const bool last = (t == nt - 2);
            const char* a1 = cA + (size_t)(t + 1) * kstep;
            const char* a2 = last ? nA : cA + (size_t)(t + 2) * kstep; const char* b2 = last ? nB : cB + (size_t)(t + 2) * kstep;
            const char* a3 = a2 + kstep; const char* b3 = b2 + kstep;
            PG8_LDB(B0, 0, 0); PG8_SCHED; PG8_LDA(At, 0, 0); PG8_STAGE(PG8_SA(1, 1), a1 + hstepA, voffA);
            PG8_WAIT_L(8); PG8_BAR; PG8_WAIT_L(0); PG8_MMA(0, 0, At, B0); PG8_BAR; PG8_SCHED;
            PG8_LDB(B1, 0, 1); PG8_STAGE(PG8_SB(0, 0), b2, voffB);
            PG8_BAR; PG8_WAIT_L(0); PG8_MMA(0, 1, At, B1); PG8_BAR;
            PG8_LDA(At, 0, 1); PG8_STAGE(PG8_SA(0, 0), a2, voffA);
            PG8_BAR; PG8_WAIT_L(0); PG8_MMA(1, 0, At, B0); PG8_BAR; PG8_SCHED;
            PG8_STAGE(PG8_SB(0, 1), b2 + hstepB, voffB);
            PG8_WAIT_V(6); PG8_BAR; PG8_MMA(1, 1, At, B1); PG8_BAR;
            PG8_LDB(B0, 1, 0); PG8_SCHED; PG8_LDA(At, 1, 0); PG8_STAGE(PG8_SA(0, 1), a2 + hstepA, voffA);
            PG8_WAIT_L(8); PG8_BAR; PG8_WAIT_L(0); PG8_MMA(0, 0, At, B0); PG8_BAR; PG8_SCHED;
            PG8_LDB(B1, 1, 1); PG8_STAGE(PG8_SB(1, 0), b3, voffB);
            PG8_BAR; PG8_WAIT_L(0); PG8_MMA(0, 1, At, B1); PG8_BAR;
            PG8_LDA(At, 1, 1); PG8_STAGE(PG8_SA(1, 0), a3, voffA);
            PG8_BAR; PG8_WAIT_L(0); PG8_MMA(1, 0, At, B0); PG8_BAR; PG8_SCHED;
            PG8_STAGE(PG8_SB(1, 1), b3 + hstepB, voffB);
            PG8_WAIT_V(6); PG8_BAR; PG8_MMA(1, 1, At, B1); PG8_BAR;
        }
        E(acc, cur, wr, wc, fr, fq);
        if (!has_next) break;
#pragma unroll
        for (int a = 0; a < 2; ++a)
#pragma unroll
            for (int b = 0; b < 2; ++b)
#pragma unroll
                for (int m = 0; m < 4; ++m)
#pragma unroll
                    for (int n = 0; n < 2; ++n) acc[a][b][m][n] = (f32x4){0.f, 0.f, 0.f, 0.f};
        cur = nxt; cA = nA; cB = nB; ++ui;
    }
    PG8_WAIT_V(0);
    if (wr == 0) PG8_BAR;
    PG8_BAR;
#undef PG8_SA
#undef PG8_SB
#undef PG8_STAGE
#undef PG8_LDA
#undef PG8_LDB
#undef PG8_MMA
#undef PG8_WAIT_V
#undef PG8_WAIT_L
#undef PG8_BAR
#undef PG8_SCHED
}
}

typedef f32x4 AccT[2][2][4][2];
#define EPI_LANE const int t_ = tid_(), wid_ = t_ >> 6, ln_ = t_ & 63, wr_ = wid_ >> 2, wc_ = wid_ & 3, fr_ = ln_ & 15, fq_ = ln_ >> 4;
#define EPI_LOOP_PERM(...) EPI_LANE \
    const int row0 = u.pm * 256 + wr_ * 64 + fr_, col0 = u.pn * 256 + wc_ * 32 + 8 * fq_; \
    _Pragma("unroll") for (int ai = 0; ai < 2; ++ai) _Pragma("unroll") for (int m = 0; m < 4; ++m) { const int row = row0 + ai * 128 + m * 16; \
        _Pragma("unroll") for (int bj = 0; bj < 2; ++bj) { const int col = col0 + bj * 128; const f32x4 v0 = acc[ai][bj][m][0], v1 = acc[ai][bj][m][1]; __VA_ARGS__ } }
#define EPI_LOOP_NAT(...) EPI_LANE \
    const int row0 = u.pm * 256 + wr_ * 64 + fr_, col0 = u.pn * 256 + wc_ * 32 + 4 * fq_; \
    _Pragma("unroll") for (int ai = 0; ai < 2; ++ai) _Pragma("unroll") for (int m = 0; m < 4; ++m) { const int row = row0 + ai * 128 + m * 16; \
        _Pragma("unroll") for (int bj = 0; bj < 2; ++bj) _Pragma("unroll") for (int n = 0; n < 2; ++n) { const int col = col0 + bj * 128 + n * 16; const f32x4 v = acc[ai][bj][m][n]; __VA_ARGS__ } }

struct EpiSwiglu { static constexpr bool PERM = true; bf16_t* O;
    DI void operator()(const AccT& acc, const pg8::Unit& u, int wr, int wc, int fr, int fq) const {
        EPI_LOOP_PERM({ u32x2 w; w.x = pack2(siluf_(v0[0]) * v1[0], siluf_(v0[1]) * v1[1]); w.y = pack2(siluf_(v0[2]) * v1[2], siluf_(v0[3]) * v1[3]);
            *(u32x2*)(O + (size_t)row * DFF + (col >> 1)) = w; })
    } };
struct EpiResid { static constexpr bool PERM = false; float* H; float scale;
    DI void operator()(const AccT& acc, const pg8::Unit& u, int wr, int wc, int fr, int fq) const {
        EPI_LANE
        const int row0 = u.pm * 256 + wr_ * 64 + fr_, col0 = u.pn * 256 + wc_ * 32 + 4 * fq_;
#pragma unroll
        for (int ai = 0; ai < 2; ++ai)
#pragma unroll
            for (int mp = 0; mp < 2; ++mp) {
                f32x4 h[2][2][2];
#pragma unroll
                for (int mm = 0; mm < 2; ++mm)
#pragma unroll
                    for (int bj = 0; bj < 2; ++bj)
#pragma unroll
                        for (int n = 0; n < 2; ++n) h[mm][bj][n] = *(const f32x4*)(H + (size_t)(row0 + ai * 128 + (2 * mp + mm) * 16) * DM + col0 + bj * 128 + n * 16);
                asm volatile("" ::: "memory");
#pragma unroll
                for (int mm = 0; mm < 2; ++mm)
#pragma unroll
                    for (int bj = 0; bj < 2; ++bj)
#pragma unroll
                        for (int n = 0; n < 2; ++n) *(f32x4*)(H + (size_t)(row0 + ai * 128 + (2 * mp + mm) * 16) * DM + col0 + bj * 128 + n * 16) = h[mm][bj][n] + acc[ai][bj][2 * mp + mm][n] * scale;
            }
    } };
struct EpiProj { static constexpr bool PERM = true; bf16_t* O; bf16_t* XK; bf16_t* XV;
    DI void operator()(const AccT& acc, const pg8::Unit& u, int wr, int wc, int fr, int fq) const {
        const bool is_mg = u.pn * 256 >= C_MG, is_cmp = (u.pn == 10);
        EPI_LOOP_PERM({ f32x4 a = v0, b = v1;
            if (is_mg) { for (int j = 0; j < 4; ++j) { a[j] = sigmoidf_(a[j]); b[j] = sigmoidf_(b[j]); } }
            u32x4 w; w.x = pack2(a[0], a[1]); w.y = pack2(a[2], a[3]); w.z = pack2(b[0], b[1]); w.w = pack2(b[2], b[3]);
            *(u32x4*)(O + (size_t)row * PLD + col) = w;
            if (is_cmp) { const int c = col - C_KC, kv = c >> 7, gg = (c >> 6) & 1, d = c & 63, bb = row >> 11, s = row & 2047, jj = s >> 4, l = s & 15;
                bf16_t* X = kv ? XV : XK; *(u32x4*)(X + ((size_t)((bb * 128 + jj) * 2 + gg)) * 1024 + l * 64 + d) = w; } })
    } };
struct EpiMerge { static constexpr bool PERM = true; bf16_t* MRG; const bf16_t* PROJ; int J;
    DI void operator()(const AccT& acc, const pg8::Unit& u, int wr, int wc, int fr, int fq) const {
        EPI_LANE
        const int row0 = u.pm * 256 + wr_ * 64 + fr_, col0 = u.pn * 256 + wc_ * 32 + 8 * fq_;
#pragma unroll
        for (int ai = 0; ai < 2; ++ai)
#pragma unroll
            for (int bj = 0; bj < 2; ++bj) { const int col = col0 + bj * 128;
                u32x4 gt[4], old[4];
#pragma unroll
                for (int m = 0; m < 4; ++m) { const int row = row0 + ai * 128 + m * 16;
                    gt[m] = *(const u32x4*)(PROJ + (size_t)row * PLD + C_MG + J * 1024 + col);
                    old[m] = (u32x4){0u, 0u, 0u, 0u}; if (J > 0) old[m] = *(const u32x4*)(MRG + (size_t)row * DM + col); }
                asm volatile("" ::: "memory");
#pragma unroll
                for (int m = 0; m < 4; ++m) { const int row = row0 + ai * 128 + m * 16; const f32x4 v0 = acc[ai][bj][m][0], v1 = acc[ai][bj][m][1];
                    float r[8]; const float x[8] = {v0[0], v0[1], v0[2], v0[3], v1[0], v1[1], v1[2], v1[3]};
#pragma unroll
                    for (int j = 0; j < 8; ++j) { const unsigned gw = gt[m][j >> 1], ow = old[m][j >> 1];
                        const float gf = (j & 1) ? __uint_as_float(gw & 0xFFFF0000u) : __uint_as_float(gw << 16);
                        const float of = (j & 1) ? __uint_as_float(ow & 0xFFFF0000u) : __uint_as_float(ow << 16);
                        r[j] = of + gf * x[j]; }
                    u32x4 w; w.x = pack2(r[0], r[1]); w.y = pack2(r[2], r[3]); w.z = pack2(r[4], r[5]); w.w = pack2(r[6], r[7]);
                    *(u32x4*)(MRG + (size_t)row * DM + col) = w; }
            }
    } };
struct EpiF32 { static constexpr bool PERM = false; float* C; static constexpr int ldc = 256;
    DI void operator()(const AccT& acc, const pg8::Unit& u, int wr, int wc, int fr, int fq) const {
        EPI_LOOP_NAT({ *(f32x4*)(C + (size_t)row * ldc + col) = v; })
    } };
template <int LDC> struct EpiBf16 { static constexpr bool PERM = true; bf16_t* O; static constexpr int ldc = LDC;
    DI void operator()(const AccT& acc, const pg8::Unit& u, int wr, int wc, int fr, int fq) const {
        EPI_LOOP_PERM({ u32x4 w; w.x = pack2(v0[0], v0[1]); w.y = pack2(v0[2], v0[3]); w.z = pack2(v1[0], v1[1]); w.w = pack2(v1[2], v1[3]);
            *(u32x4*)(O + (size_t)row * ldc + col) = w; })
    } };
struct EpiPleGate { static constexpr bool PERM = false; float* H; const bf16_t* TMP;
    DI void operator()(const AccT& acc, const pg8::Unit& u, int wr, int wc, int fr, int fq) const {
        EPI_LANE
        const int row0 = u.pm * 256 + wr_ * 64 + fr_, col0 = u.pn * 256 + wc_ * 32 + 4 * fq_;
#pragma unroll
        for (int ai = 0; ai < 2; ++ai)
#pragma unroll
            for (int m = 0; m < 4; ++m) { const int row = row0 + ai * 128 + m * 16;
                f32x4 h[2][2]; u32x2 tw[2][2];
#pragma unroll
                for (int bj = 0; bj < 2; ++bj)
#pragma unroll
                    for (int n = 0; n < 2; ++n) { const int col = col0 + bj * 128 + n * 16; h[bj][n] = *(const f32x4*)(H + (size_t)row * DM + col); tw[bj][n] = *(const u32x2*)(TMP + (size_t)row * DM + col); }
                asm volatile("" ::: "memory");
#pragma unroll
                for (int bj = 0; bj < 2; ++bj)
#pragma unroll
                    for (int n = 0; n < 2; ++n) { const int col = col0 + bj * 128 + n * 16; const f32x4 v = acc[ai][bj][m][n]; f32x4 o = h[bj][n]; const u32x2 t = tw[bj][n];
                        o[0] += sigmoidf_(v[0]) * __uint_as_float(t.x << 16); o[1] += sigmoidf_(v[1]) * __uint_as_float(t.x & 0xFFFF0000u);
                        o[2] += sigmoidf_(v[2]) * __uint_as_float(t.y << 16); o[3] += sigmoidf_(v[3]) * __uint_as_float(t.y & 0xFFFF0000u);
                        *(f32x4*)(H + (size_t)row * DM + col) = o; }
            }
    } };
struct EpiLora { static constexpr bool PERM = true; bf16_t* EWA; bf16_t* G;
    DI void operator()(const AccT& acc, const pg8::Unit& u, int wr, int wc, int fr, int fq) const {
        const bool isg = u.pn >= 4; bf16_t* O = isg ? G - 1024 : EWA; const int ld = isg ? 512 : 1024;
        EPI_LOOP_PERM({ u32x4 w; w.x = pack2(v0[0], v0[1]); w.y = pack2(v0[2], v0[3]); w.z = pack2(v1[0], v1[1]); w.w = pack2(v1[2], v1[3]);
            *(u32x4*)(O + (size_t)row * ld + col) = w; })
    } };

template <class Epi> DI void run_gemm(unsigned char* smem, const bf16_t* A, int lda, const bf16_t* Bt, int M, int N, int K, const Epi& E, int coff = 0) {
    __syncthreads();
    pg8::Gemm g; g.A = A; g.Bt = Bt; g.M = M; g.N = N; g.K = K; g.lda = lda;
    pg8::StaticOrder S; S.init(M, N, (int)gridDim.x, (bid_() + coff) % (int)gridDim.x);
    pg8::gemm_phase<Epi>((LAS unsigned char*)smem, g, S, E);
    __syncthreads();
}

struct MapId { DI int operator()(int n) const { return n; } };
struct MapGU { DI int operator()(int n) const { const int q = n >> 3, e = n & 7; return e < 4 ? 4 * q + e : DFF + 4 * q + (e - 4); } };
struct MapIn { DI int operator()(int n) const { return n < 3328 ? n : n + 24; } };
struct MapNg { DI int operator()(int n) const { return n < 24 ? 3328 + n : -1; } };
template <int TN, class Map> __device__ __forceinline__ void transpose_cvt_t(unsigned char* smem, const float* src, int ldsrc, bf16_t* dst, int K, int Nd, Map map, int& toff) {
    float* tile = (float*)smem;
    constexpr int RPP = 512 / TN;
    const int tid = tid_(), ntk = K / 64, nt = ntk * (Nd / TN);
    const int G = (int)gridDim.x, first = (bid_() + G - (toff % G)) % G;
    toff += nt;
    for (int t = first; t < nt; t += G) {
        const int n0 = (t / ntk) * TN, k0 = (t % ntk) * 64;
        const int nn = tid % TN, sc = map(n0 + nn);
#pragma unroll
        for (int p = 0; p < 64 / RPP; ++p) { const int kk = (tid / TN) + p * RPP; tile[kk * (TN + 1) + nn] = sc >= 0 ? src[(size_t)(k0 + kk) * ldsrc + sc] : 0.f; }
        __syncthreads();
#pragma unroll
        for (int p = 0; p < TN / 16; ++p) { const int nn2 = (tid >> 5) + p * 16, kk2 = (tid & 31) * 2;
            *(unsigned*)(dst + (size_t)(n0 + nn2) * K + k0 + kk2) = pack2(tile[kk2 * (TN + 1) + nn2], tile[(kk2 + 1) * (TN + 1) + nn2]); }
        __syncthreads();
    }
}
template <class Map> __device__ __forceinline__ void transpose_cvt(unsigned char* smem, const float* src, int ldsrc, bf16_t* dst, int K, int Nd, Map map, int& toff) {
    if ((Nd & 255) == 0) transpose_cvt_t<256>(smem, src, ldsrc, dst, K, Nd, map, toff); else transpose_cvt_t<64>(smem, src, ldsrc, dst, K, Nd, map, toff);
}
__device__ __forceinline__ void convert_layer_weights(unsigned char* smem, CP p, int L) {
    bf16_t* W = (bf16_t*)(p->ws + WS_WBF); int toff = 0;
    transpose_cvt(smem, p->in[I_F1GU] + (size_t)L * DM * 2 * DFF, 2 * DFF, W + E_GU1, DM, 2 * DFF, MapGU(), toff);
    transpose_cvt(smem, p->in[I_F1D] + (size_t)L * DFF * DM, DM, W + E_D1, DFF, DM, MapId(), toff);
    transpose_cvt(smem, p->in[I_WIN] + (size_t)L * DM * IN_COLS, IN_COLS, W + E_IN, DM, N_WIN, MapIn(), toff);
    transpose_cvt(smem, p->in[I_WIN] + (size_t)L * DM * IN_COLS, IN_COLS, W + E_NG, DM, 256, MapNg(), toff);
    for (int j = 0; j < 3; ++j) transpose_cvt(smem, p->in[I_WBR] + ((size_t)L * 3 + j) * 512 * DM, DM, W + E_BR + (size_t)j * 1024 * 512, 512, DM, MapId(), toff);
    transpose_cvt(smem, p->in[I_WOUT] + (size_t)L * DM * DM, DM, W + E_OUT, DM, DM, MapId(), toff);
    for (int i = bid_() * 512 + tid_(); i < 1536 * 256; i += gridDim.x * 512) { const int n = i >> 8, k = i & 255; float w = 0.f;
        if (n < 512) { if (k < 64) w = p->in[I_WB][((size_t)L * 64 + k) * 512 + n]; }
        else if (n < 1024) { if (k >= 64 && k < 128) w = p->in[I_AB][((size_t)L * 64 + (k - 64)) * 512 + (n - 512)]; }
        else { if (k >= 128) w = p->in[I_GB][((size_t)L * 128 + (k - 128)) * 512 + (n - 1024)]; }
        W[E_LORA + i] = f2bf(w); }
    transpose_cvt(smem, p->in[I_PLEG] + (size_t)L * DM * DM, DM, W + E_PG, DM, DM, MapId(), toff);
    transpose_cvt(smem, p->in[I_PLEW] + (size_t)L * 256 * DM, DM, W + E_PW, 256, DM, MapId(), toff);
    for (int kv = 0; kv < 2; ++kv) for (int hf = 0; hf < 2; ++hf)
        transpose_cvt(smem, p->in[I_CW1] + ((size_t)(L * 2 + kv) * 2048 + hf * 1024) * 128, 128, W + E_C1 + ((size_t)kv * 256 + hf * 128) * 1024, 1024, 128, MapId(), toff);
    { const int q = (int)gridDim.x - 1 - bid_(); const int tid = tid_();
      if (q >= 0 && q < 16 && tid < 256) {
        const int kv = tid >> 7, hc = tid & 127;
        const float* pe = p->in[I_PE] + (size_t)(L * 2 + kv) * 2048 + q * 128; const float* w1 = p->in[I_CW1] + ((size_t)(L * 2 + kv) * 2048 + q * 128) * 128 + hc;
        float s0 = 0.f, s1 = 0.f, s2 = 0.f, s3 = 0.f;
#pragma unroll 4
        for (int i = 0; i < 128; i += 4) { s0 += pe[i] * w1[(size_t)i * 128]; s1 += pe[i + 1] * w1[(size_t)(i + 1) * 128]; s2 += pe[i + 2] * w1[(size_t)(i + 2) * 128]; s3 += pe[i + 3] * w1[(size_t)(i + 3) * 128]; }
        ((float*)(p->ws + WS_PEB))[(q * 2 + kv) * 128 + hc] = (s0 + s1) + (s2 + s3);
      } }
}

__device__ __forceinline__ void convert_ffn2_weights(unsigned char* smem, CP p, int L) {
    bf16_t* W = (bf16_t*)(p->ws + WS_WBF); int toff = 0;
    transpose_cvt(smem, p->in[I_F2GU] + (size_t)L * DM * 2 * DFF, 2 * DFF, W + E_GU2, DM, 2 * DFF, MapGU(), toff);
    transpose_cvt(smem, p->in[I_F2D] + (size_t)L * DFF * DM, DM, W + E_D2, DFF, DM, MapId(), toff);
}
__device__ __forceinline__ void lora_act(CP p, int L) {
    const bf16_t* PROJ = (const bf16_t*)(p->ws + WS_PROJ); bf16_t* LACT = (bf16_t*)(p->ws + WS_LACT);
    const float* mu = p->in[I_MU] + (size_t)L * 1792 + 1536;
    const int stride = (int)gridDim.x * 512;
    for (int i = bid_() * 512 + tid_(); i < T_TOK * 32; i += 4 * stride) {
        u32x4 cur[4], prv[4];
#pragma unroll
        for (int k = 0; k < 4; ++k) { const int ii = i + k * stride; cur[k] = (u32x4){0u, 0u, 0u, 0u}; prv[k] = cur[k];
            if (ii < T_TOK * 32) { const int t = ii >> 5, j0 = (ii & 31) * 8; const bf16_t* row = PROJ + (size_t)t * PLD + C_RW + 1536 + j0;
                cur[k] = *(const u32x4*)row; if ((t & (SEQ - 1)) != 0) prv[k] = *(const u32x4*)(row - PLD); } }
        asm volatile("" ::: "memory");
#pragma unroll
        for (int k = 0; k < 4; ++k) { const int ii = i + k * stride;
            if (ii < T_TOK * 32) { const int t = ii >> 5, j0 = (ii & 31) * 8;
                const f32x4 m0 = *(const f32x4*)(mu + j0), m1 = *(const f32x4*)(mu + j0 + 4);
                float r[8];
#pragma unroll
                for (int e = 0; e < 8; ++e) { const float x1 = (e & 1) ? __uint_as_float(cur[k][e >> 1] & 0xFFFF0000u) : __uint_as_float(cur[k][e >> 1] << 16);
                    const float xp = (e & 1) ? __uint_as_float(prv[k][e >> 1] & 0xFFFF0000u) : __uint_as_float(prv[k][e >> 1] << 16);
                    float xm = x1 + (xp - x1) * (e < 4 ? m0[e & 3] : m1[e & 3]);
                    if (j0 < 64) xm = 2.0f * sigmoidf_(2.0f * xm) - 1.0f;
                    else if (j0 >= 128) xm = sigmoidf_(xm);
                    r[e] = xm; }
                u32x4 w; w.x = pack2(r[0], r[1]); w.y = pack2(r[2], r[3]); w.z = pack2(r[4], r[5]); w.w = pack2(r[6], r[7]);
                *(u32x4*)(LACT + (size_t)t * 256 + j0) = w; } }
    }
}

__device__ __forceinline__ void rmsnorm_rows(const float* hin, float* hcopy, const float* g, bf16_t* un, float* outf) {
    const int lane = tid_() & 63, gw = bid_() * 8 + (tid_() >> 6), nw = gridDim.x * 8;
    f32x4 gv[4];
#pragma unroll
    for (int i = 0; i < 4; ++i) gv[i] = *(const f32x4*)(g + lane * 4 + i * 256);
    f32x4 nx[2][4];
    int row0 = gw * 2;
    if (row0 < T_TOK) {
#pragma unroll
        for (int r = 0; r < 2; ++r)
#pragma unroll
            for (int i = 0; i < 4; ++i) nx[r][i] = *(const f32x4*)(hin + (size_t)(row0 + r) * DM + lane * 4 + i * 256); }
    for (; row0 < T_TOK; row0 += nw * 2) {
        f32x4 x[2][4]; float ss[2] = {0.f, 0.f};
#pragma unroll
        for (int r = 0; r < 2; ++r)
#pragma unroll
            for (int i = 0; i < 4; ++i) x[r][i] = nx[r][i];
        const int rown = row0 + nw * 2;
        if (rown < T_TOK) {
#pragma unroll
            for (int r = 0; r < 2; ++r)
#pragma unroll
                for (int i = 0; i < 4; ++i) nx[r][i] = *(const f32x4*)(hin + (size_t)(rown + r) * DM + lane * 4 + i * 256); }
        asm volatile("" ::: "memory");
#pragma unroll
        for (int r = 0; r < 2; ++r) {
#pragma unroll
            for (int i = 0; i < 4; ++i) ss[r] += x[r][i][0] * x[r][i][0] + x[r][i][1] * x[r][i][1] + x[r][i][2] * x[r][i][2] + x[r][i][3] * x[r][i][3];
            ss[r] = wave_sum(ss[r]); }
#pragma unroll
        for (int r = 0; r < 2; ++r) { const int row = row0 + r; const float rs = rsqrtf(ss[r] * (1.0f / DM) + 1e-6f);
#pragma unroll
            for (int i = 0; i < 4; ++i) {
                const f32x4 y = x[r][i] * rs * gv[i];
                if (hcopy) *(f32x4*)(hcopy + (size_t)row * DM + lane * 4 + i * 256) = x[r][i];
                if (un) { u32x2 w; w.x = pack2(y[0], y[1]); w.y = pack2(y[2], y[3]); *(u32x2*)(un + (size_t)row * DM + lane * 4 + i * 256) = w; }
                if (outf) *(f32x4*)(outf + (size_t)row * DM + lane * 4 + i * 256) = y;
            } }
    }
}
__device__ __forceinline__ void cvt_f32_bf16(const float* src, bf16_t* dst, size_t n4) {
    const size_t stride = (size_t)gridDim.x * 512;
    for (size_t i = (size_t)bid_() * 512 + tid_(); i < n4; i += 4 * stride) {
        f32x4 v[4];
#pragma unroll
        for (int k = 0; k < 4; ++k) { const size_t j = i + k * stride; if (j < n4) v[k] = *(const f32x4*)(src + j * 4); }
        asm volatile("" ::: "memory");
#pragma unroll
        for (int k = 0; k < 4; ++k) { const size_t j = i + k * stride; if (j < n4) { u32x2 w; w.x = pack2(v[k][0], v[k][1]); w.y = pack2(v[k][2], v[k][3]); *(u32x2*)(dst + j * 4) = w; } }
    }
}

__device__ __forceinline__ void finalize_cmp(unsigned char* smem, CP p, int L) {
    float* hid = (float*)smem + (tid_() >> 6) * 128;
    float* W2L = (float*)(smem + 4096);
    const int lane = tid_() & 63, gw = bid_() * 8 + (tid_() >> 6), nw = gridDim.x * 8;
    const float* peb = (const float*)(p->ws + WS_PEB);
    { const float* w2g = p->in[I_CW2] + (size_t)L * 2 * 128 * 64;
      for (int i = tid_(); i < 2 * 128 * 64 / 4; i += 512) *(f32x4*)(W2L + i * 4) = *(const f32x4*)(w2g + i * 4); }
    __syncthreads();
    const int total = 2 * 16 * 2 * 128, iters = (total + nw - 1) / nw;
    for (int it = 0; it < iters; ++it) {
        const int id = gw + it * nw; const bool ok = id < total;
        const int n = id & 127, gg = (id >> 7) & 1, bb = (id >> 8) & 15, kv = (id >> 12) & 1;
        if (ok && n < 127) {
            const float* Pm = (const float*)(p->ws + WS_P01) + (size_t)kv * 4096 * 256;
            const size_t r0 = (size_t)((bb * 128 + n) * 2 + gg) * 256, r1 = (size_t)((bb * 128 + n + 1) * 2 + gg) * 256;
#pragma unroll
            for (int q = 0; q < 2; ++q) { const int hc = lane + q * 64; float pb_ = 0.f; for (int s16 = 0; s16 < 16; ++s16) pb_ += peb[(s16 * 2 + kv) * 128 + hc];
                hid[hc] = siluf_(Pm[r0 + hc] + Pm[r1 + 128 + hc] + pb_); }
        }
        __syncthreads();
        if (ok) {
            float o0 = 0.f, o1 = 0.f;
            if (n < 127) { const float* w2 = W2L + kv * 8192 + lane;
#pragma unroll 8
                for (int hc = 0; hc < 128; hc += 2) { o0 += hid[hc] * w2[hc * 64]; o1 += hid[hc + 1] * w2[(hc + 1) * 64]; } }
            ((float*)(p->ws + WS_KC))[((((size_t)kv * 16 + bb) * 2 + gg) * 128 + n) * 64 + lane] = o0 + o1;
        }
        __syncthreads();
    }
}

__device__ __forceinline__ void hgrn_scan(unsigned char* smem, CP p, int L, int b, int h) {
    float* F = (float*)smem; float* Kx = F + 2048; float* Q = Kx + 2048; float* V = Q + 2048; float* PO = V + 2048;
    const int tid = tid_(), e = tid & 63, wv = tid >> 6, C = h * 64 + e;
    float lb;
    { const float* hl = p->in[I_HGLB]; const float a0 = hl[C], a1 = hl[512 + C], a2 = hl[1024 + C], a3 = hl[1536 + C];
      const float mx = fmaxf(fmaxf(a0, a1), fmaxf(a2, a3)); const float e0 = __expf(a0 - mx), e1 = __expf(a1 - mx), e2 = __expf(a2 - mx), e3 = __expf(a3 - mx);
      const float inv = 1.0f / (e0 + e1 + e2 + e3); float acc = 0.f; if (L >= 1) acc += e1; if (L >= 2) acc += e2; if (L >= 3) acc += e3; lb = fmaxf(acc * inv, 0.f); }
    const float ng = p->in[I_HGN][L * 512 + C];
    bf16_t* base = (bf16_t*)(p->ws + WS_PROJ) + (size_t)b * SEQ * PLD + C;
    f32x2 S0 = {0.f, 0.f}, S1 = {0.f, 0.f}, S2 = {0.f, 0.f}, S3 = {0.f, 0.f};
    bf16_t pz[4], pq[4], pi[4], pg[4];
#define HG_PREFETCH(T0) do { _Pragma("unroll") for (int i = 0; i < 4; ++i) { const bf16_t* row = base + (size_t)((T0) + wv * 4 + i) * PLD; \
        pz[i] = row[C_HF]; pq[i] = row[C_HQ]; pi[i] = row[C_HI]; pg[i] = row[C_HG]; } } while (0)
    HG_PREFETCH(0);
    for (int t0 = 0; t0 < SEQ; t0 += 32) {
        float gr[4];
#pragma unroll
        for (int i = 0; i < 4; ++i) { const int t = wv * 4 + i;
            const float z = bf2f(pz[i]), qr = bf2f(pq[i]), vi = bf2f(pi[i]); gr[i] = bf2f(pg[i]);
            const float sg = sigmoidf_(z); F[t * 64 + e] = sg + lb * (1.0f - sg); Kx[t * 64 + e] = (1.0f - lb) * (1.0f - sg); Q[t * 64 + e] = siluf_(qr); V[t * 64 + e] = vi; }
        __syncthreads();
        if (t0 + 32 < SEQ) HG_PREFETCH(t0 + 32);
#pragma unroll 4
        for (int t = 0; t < 32; ++t) {
            const f32x4 f0 = *(const f32x4*)(F + t * 64 + wv * 8), f1 = *(const f32x4*)(F + t * 64 + wv * 8 + 4);
            const f32x4 k0 = *(const f32x4*)(Kx + t * 64 + wv * 8), k1 = *(const f32x4*)(Kx + t * 64 + wv * 8 + 4);
            const f32x4 q0 = *(const f32x4*)(Q + t * 64 + wv * 8), q1 = *(const f32x4*)(Q + t * 64 + wv * 8 + 4);
            const float v = V[t * 64 + e]; const f32x2 vv = {v, v};
            S0 = (f32x2){f0[0], f0[1]} * S0 + (f32x2){k0[0], k0[1]} * vv; S1 = (f32x2){f0[2], f0[3]} * S1 + (f32x2){k0[2], k0[3]} * vv;
            S2 = (f32x2){f1[0], f1[1]} * S2 + (f32x2){k1[0], k1[1]} * vv; S3 = (f32x2){f1[2], f1[3]} * S3 + (f32x2){k1[2], k1[3]} * vv;
            f32x2 o2 = (f32x2){q0[0], q0[1]} * S0 + (f32x2){q0[2], q0[3]} * S1 + (f32x2){q1[0], q1[1]} * S2 + (f32x2){q1[2], q1[3]} * S3;
            PO[(t * 8 + wv) * 64 + e] = o2[0] + o2[1];
        }
        __syncthreads();
#pragma unroll
        for (int i = 0; i < 4; ++i) { const int t = wv * 4 + i;
            float o = 0.f;
#pragma unroll
            for (int q = 0; q < 8; ++q) o += PO[(t * 8 + q) * 64 + e];
            const float ss = wave_sum(o * o); const float rs = rsqrtf(ss * (1.0f / 64.0f) + 1e-6f);
            base[(size_t)(t0 + t) * PLD + C_HQ] = f2bf(o * rs * ng * siluf_(gr[i])); }
        __syncthreads();
    }
#undef HG_PREFETCH
}

DI float dpp_xor1(float v) { return __int_as_float(__builtin_amdgcn_mov_dpp(__float_as_int(v), 0xB1, 0xF, 0xF, true)); }
DI float dpp_xor2(float v) { return __int_as_float(__builtin_amdgcn_mov_dpp(__float_as_int(v), 0x4E, 0xF, 0xF, true)); }
DI float dpp_hmir(float v) { return __int_as_float(__builtin_amdgcn_mov_dpp(__float_as_int(v), 0x141, 0xF, 0xF, true)); }
DI float red8(float v) { v += dpp_xor1(v); v += dpp_xor2(v); v += dpp_hmir(v); return v; }

__device__ __forceinline__ void rwkv_scan(unsigned char* smem, CP p, int L, int b, int h) {
    constexpr int BUF_F = 6 * 2048 + 64 + 2048;
    const int tid = tid_(), c = tid & 63, wv = tid >> 6, C = h * 64 + c, lane = c;
    const float* mu = p->in[I_MU] + (size_t)L * 1792;
    const float mu_r = mu[C], mu_k = mu[512 + C], mu_v = mu[1024 + C];
    const float w0 = p->in[I_W0][L * 512 + C], a0 = p->in[I_A0][L * 512 + C];
    const float k_k = p->in[I_KK][L * 512 + C], k_a = p->in[I_KA][L * 512 + C], r_k = p->in[I_RK][L * 512 + C], ln_w = p->in[I_LNW][L * 512 + C], ln_b = p->in[I_LNB][L * 512 + C];
    const bf16_t* base = (const bf16_t*)(p->ws + WS_PROJ) + (size_t)b * SEQ * PLD + C_RW + C;
    const bf16_t* ewa = (const bf16_t*)(p->ws + WS_UN) + (size_t)b * SEQ * 1024 + C;
    bf16_t* obase = (bf16_t*)(p->ws + WS_ORW) + (size_t)b * SEQ * 512 + C;
    const int kp = lane & 7, vr = lane >> 3, vrow = wv * 8 + vr;
    f32x2 S0 = {0.f, 0.f}, S1 = {0.f, 0.f}, S2 = {0.f, 0.f}, S3 = {0.f, 0.f};
    bf16_t pr[4], pk[4], pv[4], pe[4], pa[4], pg[4], qr, qk, qv;
#define RW_PREFETCH(T0) do { const int s0_ = (T0) + wv * 4; \
        _Pragma("unroll") for (int i = 0; i < 4; ++i) { const bf16_t* row = base + (size_t)(s0_ + i) * PLD; pr[i] = row[0]; pk[i] = row[512]; pv[i] = row[1024]; \
            pe[i] = ewa[(size_t)(s0_ + i) * 1024]; pa[i] = ewa[(size_t)(s0_ + i) * 1024 + 512]; pg[i] = obase[(size_t)(s0_ + i) * 512]; } \
        if (s0_ > 0) { const bf16_t* row = base + (size_t)(s0_ - 1) * PLD; qr = row[0]; qk = row[512]; qv = row[1024]; } else { qr = 0; qk = 0; qv = 0; } } while (0)
    RW_PREFETCH(0);
    __syncthreads();
    for (int blk = 0; blk < SEQ / 32; ++blk) {
        float* Bf = (float*)smem + (blk & 1) * BUF_F;
        float* Wd = Bf; float* NKK = Bf + 2048; float* AB = Bf + 4096; float* KX = Bf + 6144; float* WR = Bf + 8192; float* VS = Bf + 10240; float* SC = Bf + 12288; float* YS = Bf + 12352;
        float bon[4], gv[4];
        { float rp = bf2f(qr), kq = bf2f(qk), vp = bf2f(qv);
#pragma unroll
          for (int i = 0; i < 4; ++i) { const int t = wv * 4 + i;
              const float r1 = bf2f(pr[i]), k1 = bf2f(pk[i]), v1 = bf2f(pv[i]);
              const float r = r1 + (rp - r1) * mu_r, k = k1 + (kq - k1) * mu_k, v = v1 + (vp - v1) * mu_v; rp = r1; kq = k1; vp = v1;
              const float decay = __expf(-0.6065306597f * sigmoidf_(w0 + bf2f(pe[i]))), a = sigmoidf_(a0 + bf2f(pa[i])); gv[i] = bf2f(pg[i]);
              const float kkv = k * k_k; const float ssq = wave_sum(kkv * kkv); const float kkn = kkv / fmaxf(sqrtf(ssq), 1e-12f);
              const float kx = k * (1.0f + (a - 1.0f) * k_a), ab = kkn * a;
              const float br = wave_sum(ab * r), kr = wave_sum(kx * r); bon[i] = wave_sum(r * kx * r_k);
              Wd[t * 64 + c] = decay; NKK[t * 64 + c] = -kkn; AB[t * 64 + c] = ab; KX[t * 64 + c] = kx; WR[t * 64 + c] = decay * r; VS[t * 64 + c] = v;
              if (c == 0) { SC[t * 2] = br; SC[t * 2 + 1] = kr; } } }
        __syncthreads();
        if (blk + 1 < SEQ / 32) RW_PREFETCH((blk + 1) * 32);
#define RW_LOAD(T, w0v, w1v, n0, n1, b0, b1, x0, x1, q0, q1, vv, sc) do { const int o_ = (T) * 64 + kp * 8; \
            w0v = *(const f32x4*)(Wd + o_); w1v = *(const f32x4*)(Wd + o_ + 4); n0 = *(const f32x4*)(NKK + o_); n1 = *(const f32x4*)(NKK + o_ + 4); \
            b0 = *(const f32x4*)(AB + o_); b1 = *(const f32x4*)(AB + o_ + 4); x0 = *(const f32x4*)(KX + o_); x1 = *(const f32x4*)(KX + o_ + 4); \
            q0 = *(const f32x4*)(WR + o_); q1 = *(const f32x4*)(WR + o_ + 4); vv = VS[(T) * 64 + vrow]; sc = *(const f32x2*)(SC + (T) * 2); } while (0)
        f32x4 cw0, cw1, cn0, cn1, cb0, cb1, cx0, cx1, cq0, cq1; float cvv; f32x2 csc;
        RW_LOAD(0, cw0, cw1, cn0, cn1, cb0, cb1, cx0, cx1, cq0, cq1, cvv, csc);
#pragma nounroll
        for (int t8 = 0; t8 < 4; ++t8) {
            float ykeep = 0.f;
#pragma unroll
            for (int j = 0; j < 8; ++j) {
                const int t = t8 * 8 + j;
                const f32x4 w0v = cw0, w1v = cw1, n0 = cn0, n1 = cn1, b0 = cb0, b1 = cb1, x0 = cx0, x1 = cx1, q0 = cq0, q1 = cq1; const float vv = cvv; const f32x2 sc = csc;
                { const int tn = (t + 1) & 31; RW_LOAD(tn, cw0, cw1, cn0, cn1, cb0, cb1, cx0, cx1, cq0, cq1, cvv, csc); }
                const f32x2 sa2 = S0 * (f32x2){n0[0], n0[1]} + S1 * (f32x2){n0[2], n0[3]} + S2 * (f32x2){n1[0], n1[1]} + S3 * (f32x2){n1[2], n1[3]};
                const f32x2 y2 = S0 * (f32x2){q0[0], q0[1]} + S1 * (f32x2){q0[2], q0[3]} + S2 * (f32x2){q1[0], q1[1]} + S3 * (f32x2){q1[2], q1[3]};
                float sa = sa2[0] + sa2[1], yy = y2[0] + y2[1];
                sa += dpp_xor1(sa); yy += dpp_xor1(yy); sa += dpp_xor2(sa); yy += dpp_xor2(yy); sa += dpp_hmir(sa); yy += dpp_hmir(yy);
                const f32x2 sav = {sa, sa}, vv2 = {vv, vv};
                S0 = S0 * (f32x2){w0v[0], w0v[1]} + sav * (f32x2){b0[0], b0[1]} + vv2 * (f32x2){x0[0], x0[1]};
                S1 = S1 * (f32x2){w0v[2], w0v[3]} + sav * (f32x2){b0[2], b0[3]} + vv2 * (f32x2){x0[2], x0[3]};
                S2 = S2 * (f32x2){w1v[0], w1v[1]} + sav * (f32x2){b1[0], b1[1]} + vv2 * (f32x2){x1[0], x1[1]};
                S3 = S3 * (f32x2){w1v[2], w1v[3]} + sav * (f32x2){b1[2], b1[3]} + vv2 * (f32x2){x1[2], x1[3]};
                const float y = yy + sa * sc[0] + vv * sc[1];
                ykeep = (kp == j) ? y : ykeep;
            }
            YS[(t8 * 8 + kp) * 64 + vrow] = ykeep;
        }
#undef RW_LOAD
        __syncthreads();
#pragma unroll
        for (int i = 0; i < 4; ++i) { const int t = wv * 4 + i;
            const float y = YS[t * 64 + c]; const float mean = wave_sum(y) * (1.0f / 64.0f); const float dlt = y - mean;
            const float var = wave_sum(dlt * dlt) * (1.0f / 64.0f);
            float yn = dlt * rsqrtf(var + 64e-5f) * ln_w + ln_b; yn += bon[i] * VS[t * 64 + c];
            obase[(size_t)(blk * 32 + t) * 512] = f2bf(yn * gv[i]); }
    }
#undef RW_PREFETCH
    __syncthreads();
}

DI int crow16(int i, int hl) { return (i & 3) + 8 * (i >> 2) + 4 * hl; }
__device__ __forceinline__ void rwkv_chunked(unsigned char* smem, CP p, int L, int b, int h) {
    bf16_t* ZB = (bf16_t*)smem;
    bf16_t* AR = (bf16_t*)(smem + 9216);
    bf16_t* BKt = (bf16_t*)(smem + 13824);
    bf16_t* UV = (bf16_t*)(smem + 18944);
    bf16_t* MT1 = (bf16_t*)(smem + 24064);
    bf16_t* MT2 = (bf16_t*)(smem + 25600);
    float* EW = (float*)(smem + 27136);
    bf16_t* BKr = (bf16_t*)(smem + 31232);
    float* Mf = (float*)(smem + 48640);
    float* Gs = (float*)(smem + 52864);
    float* YS = (float*)(smem + 57216);
    float* VS = (float*)(smem + 61312);
    float* PC = (float*)(smem + 65408);
    const int tid = tid_(), c = tid & 63, wv = tid >> 6, C = h * 64 + c, lane = c, qi = lane & 31, hl = lane >> 5;
    const float* mu = p->in[I_MU] + (size_t)L * 1792;
    const float mu_r = mu[C], mu_k = mu[512 + C], mu_v = mu[1024 + C];
    const float w0 = p->in[I_W0][L * 512 + C], a0 = p->in[I_A0][L * 512 + C];
    const float k_k = p->in[I_KK][L * 512 + C], k_a = p->in[I_KA][L * 512 + C], r_k = p->in[I_RK][L * 512 + C], ln_w = p->in[I_LNW][L * 512 + C], ln_b = p->in[I_LNB][L * 512 + C];
    const bf16_t* base = (const bf16_t*)(p->ws + WS_PROJ) + (size_t)b * SEQ * PLD + C_RW + C;
    const bf16_t* ewa = (const bf16_t*)(p->ws + WS_UN) + (size_t)b * SEQ * 1024 + C;
    bf16_t* obase = (bf16_t*)(p->ws + WS_ORW) + (size_t)b * SEQ * 512 + C;
    f32x16 zacc;
#pragma unroll
    for (int i = 0; i < 16; ++i) zacc[i] = 0.f;
    for (int i = tid; i < 64 * 72; i += 512) ZB[i] = 0;
    bf16_t pr[2], pk[2], pv[2], pe[2], pa[2], pg[2], qr, qk, qv;
#define RC_PREFETCH(T0) do { const int s0_ = (T0) + wv * 2; \
        _Pragma("unroll") for (int i = 0; i < 2; ++i) { const bf16_t* row = base + (size_t)(s0_ + i) * PLD; pr[i] = row[0]; pk[i] = row[512]; pv[i] = row[1024]; \
            pe[i] = ewa[(size_t)(s0_ + i) * 1024]; pa[i] = ewa[(size_t)(s0_ + i) * 1024 + 512]; pg[i] = obase[(size_t)(s0_ + i) * 512]; } \
        if (s0_ > 0) { const bf16_t* row = base + (size_t)(s0_ - 1) * PLD; qr = row[0]; qk = row[512]; qv = row[1024]; } else { qr = 0; qk = 0; qv = 0; } } while (0)
    RC_PREFETCH(0);
    __syncthreads();
    for (int ch = 0; ch < SEQ / 16; ++ch) {
        float bon[2], gv[2], r_[2], nk_[2], ab_[2], kx_[2], v_[2], ew_[2];
        { float rp = bf2f(qr), kq = bf2f(qk), vp = bf2f(qv);
#pragma unroll
          for (int i = 0; i < 2; ++i) { const int t = wv * 2 + i;
              const float r1 = bf2f(pr[i]), k1 = bf2f(pk[i]), v1 = bf2f(pv[i]);
              const float r = r1 + (rp - r1) * mu_r, k = k1 + (kq - k1) * mu_k, v = v1 + (vp - v1) * mu_v; rp = r1; kq = k1; vp = v1;
              const float ew = 0.6065306597f * sigmoidf_(w0 + bf2f(pe[i])), a = sigmoidf_(a0 + bf2f(pa[i])); gv[i] = bf2f(pg[i]);
              const float kkv = k * k_k; const float ssq = wave_sum(kkv * kkv); const float kkn = kkv * rsqrtf(fmaxf(ssq, 1e-24f));
              const float kx = k * (1.0f + (a - 1.0f) * k_a);
              bon[i] = wave_sum(r * kx * r_k);
              r_[i] = r; nk_[i] = kkn; ab_[i] = kkn * a; kx_[i] = kx; v_[i] = v; ew_[i] = ew; EW[t * 64 + c] = ew; } }
        __syncthreads();
        if (ch + 1 < SEQ / 16) RC_PREFETCH((ch + 1) * 16);
        { float ev[16];
#pragma unroll
          for (int j = 0; j < 16; ++j) ev[j] = EW[j * 64 + c];
#pragma unroll
          for (int i = 0; i < 2; ++i) { const int t = wv * 2 + i; float cum = 0.f;
#pragma unroll
            for (int j = 0; j < 16; ++j) cum += (j <= t) ? ev[j] : 0.f;
            const float Pt = __expf(-cum), Pm = __expf(-(cum - ew_[i])), iP = __expf(cum);
            const float al = -nk_[i] * Pm, rh = r_[i] * Pt, be = ab_[i] * iP, ka = kx_[i] * iP;
            AR[t * 72 + c] = f2bf(al); AR[(16 + t) * 72 + c] = f2bf(rh); BKr[t * 72 + c] = f2bf(be); BKr[(16 + t) * 72 + c] = f2bf(ka);
            BKt[c * 40 + t] = f2bf(be); BKt[c * 40 + 16 + t] = f2bf(ka);
            UV[c * 40 + 16 + t] = f2bf(v_[i]); VS[t * 64 + c] = v_[i];
            if (t == 15) PC[c] = Pt; } }
        __syncthreads();
        f32x16 acc;
#pragma unroll
        for (int i = 0; i < 16; ++i) acc[i] = 0.f;
        if (wv == 0) {
#pragma unroll
            for (int s = 0; s < 4; ++s) acc = MFMA32(*(const bf16x8*)(BKr + qi * 72 + 16 * s + 8 * hl), *(const bf16x8*)(AR + qi * 72 + 16 * s + 8 * hl), acc);
#pragma unroll
            for (int i = 0; i < 16; ++i) { const int j = crow16(i, hl), n = qi; const float m = acc[i];
                if (j < 16) { if (n < 16) Mf[j * 17 + n] = m; MT2[n * 24 + j] = f2bf((n >= 16 && j <= n - 16) ? m : 0.f); }
                else { const int i2 = j - 16; const bool k1 = n < 16 ? (i2 < n) : (i2 <= n - 16); MT1[n * 24 + i2] = f2bf(k1 ? m : 0.f); } }
        } else if (wv < 3) {
            const int vb = wv - 1;
#pragma unroll
            for (int s = 0; s < 4; ++s) acc = MFMA32(*(const bf16x8*)(ZB + (32 * vb + qi) * 72 + 16 * s + 8 * hl), *(const bf16x8*)(AR + qi * 72 + 16 * s + 8 * hl), acc);
        }
        __syncthreads();
        if (wv == 1 || wv == 2) { const int vb = wv - 1;
            acc = MFMA32(*(const bf16x8*)(UV + (32 * vb + qi) * 40 + 16 + 8 * hl), *(const bf16x8*)(MT1 + qi * 24 + 8 * hl), acc);
            if (qi < 16) {
#pragma unroll
                for (int i = 0; i < 16; ++i) Gs[(32 * vb + crow16(i, hl)) * 17 + qi] = acc[i]; }
        }
        __syncthreads();
        if (wv == 0) {
            float u[16];
#pragma unroll
            for (int t = 0; t < 16; ++t) { float x0 = Gs[lane * 17 + t], x1 = 0.f;
#pragma unroll
                for (int i = 0; i < t; ++i) { if (i & 1) x1 += u[i] * Mf[i * 17 + t]; else x0 += u[i] * Mf[i * 17 + t]; }
                u[t] = x0 + x1; UV[lane * 40 + t] = f2bf(u[t]); }
        }
        __syncthreads();
        if (wv == 1 || wv == 2) { const int vb = wv - 1;
            acc = MFMA32(*(const bf16x8*)(UV + (32 * vb + qi) * 40 + 8 * hl), *(const bf16x8*)(MT2 + qi * 24 + 8 * hl), acc);
            if (qi >= 16) {
#pragma unroll
                for (int i = 0; i < 16; ++i) YS[(qi - 16) * 64 + 32 * vb + crow16(i, hl)] = acc[i]; }
        }
        if (wv >= 4) { const int vb = (wv >> 1) & 1, kb = wv & 1;
#pragma unroll
            for (int s = 0; s < 2; ++s) zacc = MFMA32(*(const bf16x8*)(UV + (32 * vb + qi) * 40 + 16 * s + 8 * hl), *(const bf16x8*)(BKt + (32 * kb + qi) * 40 + 16 * s + 8 * hl), zacc);
            const float pc = PC[32 * kb + qi];
#pragma unroll
            for (int i = 0; i < 16; ++i) { zacc[i] *= pc; ZB[(32 * vb + crow16(i, hl)) * 72 + 32 * kb + qi] = f2bf(zacc[i]); }
        }
        __syncthreads();
#pragma unroll
        for (int i = 0; i < 2; ++i) { const int t = wv * 2 + i;
            const float y = YS[t * 64 + c]; const float mean = wave_sum(y) * (1.0f / 64.0f); const float dlt = y - mean;
            const float var = wave_sum(dlt * dlt) * (1.0f / 64.0f);
            float yn = dlt * rsqrtf(var + 64e-5f) * ln_w + ln_b; yn += bon[i] * VS[t * 64 + c];
            obase[(size_t)(ch * 16 + t) * 512] = f2bf(yn * gv[i]); }
    }
#undef RC_PREFETCH
    __syncthreads();
}

constexpr int KTS = 72;
DI bf16x8 pack8(float a0, float a1, float a2, float a3, float a4, float a5, float a6, float a7) {
    u32x4 w; w.x = pack2(a0, a1); w.y = pack2(a2, a3); w.z = pack2(a4, a5); w.w = pack2(a6, a7); return __builtin_bit_cast(bf16x8, w); }
DI bf16x8 ld_vfrag(const bf16_t* vt, int off) { const u32x2 lo = *(const u32x2*)(vt + off), hi = *(const u32x2*)(vt + off + 8); u32x4 w; w.x = lo.x; w.y = lo.y; w.z = hi.x; w.w = hi.y; return __builtin_bit_cast(bf16x8, w); }

struct FlashState { f32x16 o0, o1; float m, l; };

DI void flash_update(FlashState& st, f32x16& sc0, f32x16& sc1, const bf16_t* VT, int vs, int qi, int hl) {
    const bf16x8 va0 = ld_vfrag(VT, qi * vs + 4 * hl), vb0 = ld_vfrag(VT, (32 + qi) * vs + 4 * hl);
    const bf16x8 va1 = ld_vfrag(VT, qi * vs + 32 + 4 * hl), vb1 = ld_vfrag(VT, (32 + qi) * vs + 32 + 4 * hl);
    asm volatile("" ::: "memory");
    float mt = -INFINITY;
#pragma unroll
    for (int i = 0; i < 16; ++i) mt = fmaxf(mt, fmaxf(sc0[i], sc1[i]));
    mt = fmaxf(mt, shfl_xor_(mt, 32, qi + 32 * hl));
    const float mnew = fmaxf(st.m, mt), muse = (mnew == -INFINITY) ? 0.f : mnew;
    const float alpha = __builtin_amdgcn_exp2f(st.m - muse);
    float ls = 0.f;
#pragma unroll
    for (int i = 0; i < 16; ++i) { sc0[i] = __builtin_amdgcn_exp2f(sc0[i] - muse); sc1[i] = __builtin_amdgcn_exp2f(sc1[i] - muse); ls += sc0[i] + sc1[i]; }
    st.l = st.l * alpha + ls; st.m = mnew;
    st.o0 *= alpha; st.o1 *= alpha;
    {
        const bf16x8 p0 = pack8(sc0[0], sc0[1], sc0[2], sc0[3], sc0[4], sc0[5], sc0[6], sc0[7]);
        const bf16x8 p1 = pack8(sc1[0], sc1[1], sc1[2], sc1[3], sc1[4], sc1[5], sc1[6], sc1[7]);
        const bf16x8 wa0 = ld_vfrag(VT, qi * vs + 16 + 4 * hl), wb0 = ld_vfrag(VT, (32 + qi) * vs + 16 + 4 * hl);
        const bf16x8 wa1 = ld_vfrag(VT, qi * vs + 48 + 4 * hl), wb1 = ld_vfrag(VT, (32 + qi) * vs + 48 + 4 * hl);
        st.o0 = MFMA32(va0, p0, st.o0); st.o1 = MFMA32(vb0, p0, st.o1); st.o0 = MFMA32(va1, p1, st.o0); st.o1 = MFMA32(vb1, p1, st.o1);
        const bf16x8 r0 = pack8(sc0[8], sc0[9], sc0[10], sc0[11], sc0[12], sc0[13], sc0[14], sc0[15]);
        const bf16x8 r1 = pack8(sc1[8], sc1[9], sc1[10], sc1[11], sc1[12], sc1[13], sc1[14], sc1[15]);
        st.o0 = MFMA32(wa0, r0, st.o0); st.o1 = MFMA32(wb0, r0, st.o1); st.o0 = MFMA32(wa1, r1, st.o0); st.o1 = MFMA32(wb1, r1, st.o1);
    }
}
DI void qk_tile(const bf16_t* KT, const bf16x8 (&qf)[4], int qi, int hl, f32x16& sc0, f32x16& sc1) {
#pragma unroll
    for (int i = 0; i < 16; ++i) { sc0[i] = 0.f; sc1[i] = 0.f; }
#pragma unroll
    for (int s = 0; s < 4; ++s) {
        const bf16x8 k0 = *(const bf16x8*)(KT + qi * KTS + 16 * s + 8 * hl), k1 = *(const bf16x8*)(KT + (32 + qi) * KTS + 16 * s + 8 * hl);
        sc0 = MFMA32(k0, qf[s], sc0); sc1 = MFMA32(k1, qf[s], sc1);
    }
}
struct KVRegs { u32x4 k, v; };
DI void kv_fetch(KVRegs& r, const bf16_t* pb, int kcol, int vcol, int k0) {
    const int tid = tid_();
    const unsigned ok_ = (unsigned)((k0 + (tid >> 3)) * PLD + kcol + (tid & 7) * 8) * 2u, ov_ = (unsigned)((k0 + (tid & 63)) * PLD + vcol + (tid >> 6) * 8) * 2u;
    r.k = *(const u32x4*)((const char*)pb + ok_);
    r.v = *(const u32x4*)((const char*)pb + ov_);
}
DI void kv_store(const KVRegs& r, bf16_t* KT, bf16_t* VT) {
    const int tid = tid_();
    *(u32x4*)(KT + (tid >> 3) * KTS + (tid & 7) * 8) = r.k;
    const int key = tid & 63, ch = tid >> 6;
#pragma unroll
    for (int j = 0; j < 8; ++j) VT[(ch * 8 + j) * KTS + key] = (bf16_t)((j & 1) ? (r.v[j >> 1] >> 16) : (r.v[j >> 1] & 0xFFFFu));
}
template <bool LUTB, bool CAUSAL, bool WHI, bool SEL>
DI void mask_tile(f32x16& sc0, f32x16& sc1, const float* lut, int qpos, int k0, int hl, bool sel, float qs) {
    const float bfar = lut[128];
#pragma unroll
    for (int g8 = 0; g8 < 2; ++g8) {
        float ba[8], bb[8];
#pragma unroll
        for (int j = 0; j < 8; ++j) { const int i = g8 * 8 + j, kl = (i & 3) + 8 * (i >> 2) + 4 * hl; const int da = qpos - (k0 + kl), db = da - 32;
            ba[j] = LUTB ? lut[da > 128 ? 128 : (da < 0 ? 0 : da)] : bfar; bb[j] = LUTB ? lut[db > 128 ? 128 : (db < 0 ? 0 : db)] : bfar; }
        if (LUTB) asm volatile("" ::: "memory");
#pragma unroll
        for (int j = 0; j < 8; ++j) { const int i = g8 * 8 + j, kl = (i & 3) + 8 * (i >> 2) + 4 * hl; const int da = qpos - (k0 + kl), db = da - 32;
            { const float v = sc0[i] * qs + ba[j]; bool ok = true; if (CAUSAL) ok = ok && da >= 0; if (WHI) ok = ok && da < 256; if (SEL) ok = ok && sel; sc0[i] = ok ? v : -INFINITY; }
            { const float v = sc1[i] * qs + bb[j]; bool ok = true; if (CAUSAL) ok = ok && db >= 0; if (WHI) ok = ok && db < 256; if (SEL) ok = ok && sel; sc1[i] = ok ? v : -INFINITY; } }
    }
}

__device__ __forceinline__ void nsa_item(unsigned char* smem, CP p, int L, int b, int g, int qb, int ocol) {
    bf16_t* KT = (bf16_t*)smem;
    bf16_t* VT = (bf16_t*)(smem + 9216);
    float* LUT = (float*)(smem + 18432);
    unsigned* SELM = (unsigned*)(smem + 20736);
    unsigned* ORM = (unsigned*)(smem + 20992);
    float* PA = (float*)(smem + 21504);
    float* PBv = (float*)(smem + 54272);
    bf16_t* KT2 = (bf16_t*)(smem + 87040);
    bf16_t* VT2 = (bf16_t*)(smem + 105472);
    const int tid = tid_(), lane = tid & 63, wv = tid >> 6, hh = wv >> 1, qhalf = wv & 1, qi = lane & 31, hl = lane >> 5;
    const int ql = qhalf * 32 + qi, qpos = qb * 64 + ql, head = g * 4 + hh;
    bf16_t* pb = (bf16_t*)(p->ws + WS_PROJ) + (size_t)b * SEQ * PLD;
    bf16_t* qrow = pb + (size_t)qpos * PLD;
    __syncthreads();
    for (int i = tid; i < 4 * 129; i += 512) { const int h2 = i / 129, dd = i % 129; int bk;
        if (dd < 16) bk = dd; else if (dd >= 128) bk = 31; else { bk = 16 + (int)(logf((float)dd / 16.0f) / 2.0794415416798357f * 16.0f); bk = bk > 31 ? 31 : bk; }
        LUT[h2 * 132 + dd] = p->in[I_RELB][bk * 8 + g * 4 + h2] * 1.4426950408889634f; }
    if (tid == 0) *ORM = 0u;
    if (tid < 64) SELM[tid] = 0u;
    if (tid < 256) PBv[tid * 32] = 0.f;
    { const float* kc = (const float*)(p->ws + WS_KC) + ((size_t)(0 * 16 + b) * 2 + g) * 128 * 64; const float* vc = (const float*)(p->ws + WS_KC) + ((size_t)(1 * 16 + b) * 2 + g) * 128 * 64;
      for (int i = tid; i < 128 * 64; i += 512) { const int n = i >> 6, d = i & 63; KT2[n * KTS + d] = f2bf(kc[i]); }
      for (int i = tid; i < 128 * 64; i += 512) { const int n = i & 127, d = i >> 7; VT2[d * 136 + n] = f2bf(vc[n * 64 + d]); } }
    bf16x8 qf[4];
#pragma unroll
    for (int s = 0; s < 4; ++s) qf[s] = *(const bf16x8*)(qrow + C_NQ + head * 64 + 16 * s + 8 * hl);
    float g0, g1, g2;
    { const bf16_t* gp = qrow + C_NG + head * 3; g0 = sigmoidf_(bf2f(gp[0])); g1 = sigmoidf_(bf2f(gp[1])); g2 = sigmoidf_(bf2f(gp[2])); }
    __syncthreads();
    const float* lut = LUT + hh * 132;
    constexpr float QS = 0.125f * 1.4426950408889634f;
    f32x16 fin0, fin1;
    {
        FlashState st;
#pragma unroll
        for (int i = 0; i < 16; ++i) { st.o0[i] = 0.f; st.o1[i] = 0.f; }
        st.m = -INFINITY; st.l = 0.f;
#pragma nounroll
        for (int t = 0; t < 2; ++t) {
            f32x16 sc0, sc1; qk_tile(KT2 + t * 64 * KTS, qf, qi, hl, sc0, sc1);
#pragma unroll
            for (int g8 = 0; g8 < 2; ++g8) { float ba[8], bb[8];
#pragma unroll
                for (int j = 0; j < 8; ++j) { const int i = g8 * 8 + j, kl = (i & 3) + 8 * (i >> 2) + 4 * hl; const int da = qpos - (16 * (64 * t + kl) + 31), db = da - 512;
                    ba[j] = lut[da > 128 ? 128 : (da < 0 ? 0 : da)]; bb[j] = lut[db > 128 ? 128 : (db < 0 ? 0 : db)]; }
                asm volatile("" ::: "memory");
#pragma unroll
                for (int j = 0; j < 8; ++j) { const int i = g8 * 8 + j, kl = (i & 3) + 8 * (i >> 2) + 4 * hl; const int na = 64 * t + kl, nb = na + 32; const int da = qpos - (16 * na + 31), db = da - 512;
                    sc0[i] = (da >= 0 && na < 127) ? sc0[i] * QS + ba[j] : -INFINITY; sc1[i] = (db >= 0 && nb < 127) ? sc1[i] * QS + bb[j] : -INFINITY; } }
            flash_update(st, sc0, sc1, VT2 + 64 * t, 136, qi, hl);
        }
        const float lt = st.l + shfl_xor_(st.l, 32, lane); const float inv = 1.0f / fmaxf(lt, 1e-30f);
        const float muse = (st.m == -INFINITY) ? 0.f : st.m;
        fin0 = st.o0 * (g0 * inv); fin1 = st.o1 * (g0 * inv);
#pragma nounroll
        for (int t = 0; t < 2; ++t) {
            f32x16 sc0, sc1; qk_tile(KT2 + t * 64 * KTS, qf, qi, hl, sc0, sc1);
#pragma unroll
            for (int g8 = 0; g8 < 2; ++g8) { float ba[8], bb[8];
#pragma unroll
                for (int j = 0; j < 8; ++j) { const int i = g8 * 8 + j, kl = (i & 3) + 8 * (i >> 2) + 4 * hl; const int da = qpos - (16 * (64 * t + kl) + 31), db = da - 512;
                    ba[j] = lut[da > 128 ? 128 : (da < 0 ? 0 : da)]; bb[j] = lut[db > 128 ? 128 : (db < 0 ? 0 : db)]; }
                asm volatile("" ::: "memory");
#pragma unroll
                for (int j = 0; j < 8; ++j) { const int i = g8 * 8 + j, kl = (i & 3) + 8 * (i >> 2) + 4 * hl; const int na = 64 * t + kl, nb = na + 32; const int da = qpos - (16 * na + 31), db = da - 512;
                    const float va = __builtin_amdgcn_exp2f(sc0[i] * QS + ba[j] - muse) * inv, vb = __builtin_amdgcn_exp2f(sc1[i] * QS + bb[j] - muse) * inv;
                    sc0[i] = (da >= 0 && na < 127) ? va : 0.f; sc1[i] = (db >= 0 && nb < 127) ? vb : 0.f; } }
#pragma unroll
            for (int i4 = 0; i4 < 4; ++i4) {
                { const int m = 16 * t + 2 * i4 + hl; PA[(hh * 64 + ql) * 32 + m] = sc0[4 * i4] + sc0[4 * i4 + 1] + sc0[4 * i4 + 2] + sc0[4 * i4 + 3]; PBv[(hh * 64 + ql) * 32 + m + 1] = sc0[4 * i4 + 3]; }
                { const int m = 16 * t + 8 + 2 * i4 + hl; PA[(hh * 64 + ql) * 32 + m] = sc1[4 * i4] + sc1[4 * i4 + 1] + sc1[4 * i4 + 2] + sc1[4 * i4 + 3]; if (m + 1 < 32) PBv[(hh * 64 + ql) * 32 + m + 1] = sc1[4 * i4 + 3]; }
            }
        }
    }
    __syncthreads();
    {
        float* IMP = (float*)smem;
        const int q = tid & 63, part = tid >> 6, cur = qb;
#pragma unroll
        for (int mm = 0; mm < 4; ++mm) { const int m = part * 4 + mm; float v;
            if (m == 0 || m == cur || m == cur - 1) v = INFINITY;
            else if (m <= cur) { v = 0.f; for (int h2 = 0; h2 < 4; ++h2) v += PA[(h2 * 64 + q) * 32 + m] + PBv[(h2 * 64 + q) * 32 + m]; }
            else v = -INFINITY;
            IMP[q * 33 + m] = v; }
        __syncthreads();
        unsigned bits = 0u;
#pragma unroll
        for (int mm = 0; mm < 4; ++mm) { const int m = part * 4 + mm; const float v = IMP[q * 33 + m]; int rank = 0;
            for (int m2 = 0; m2 < 32; ++m2) { const float v2 = IMP[q * 33 + m2]; rank += (v2 > v || (v2 == v && m2 < m)) ? 1 : 0; }
            if (rank < 8 && v > -INFINITY) bits |= 1u << m; }
        atomicOr(&SELM[q], bits); atomicOr(ORM, bits);
    }
    __syncthreads();
    const unsigned mysel = SELM[ql], orm = *ORM;
    __syncthreads();
    float* PARK = PA + (wv * 32) * 64 + lane;
#pragma unroll
    for (int i = 0; i < 16; ++i) { PARK[i * 64] = fin0[i]; PARK[(16 + i) * 64] = fin1[i]; }
    {
        FlashState st;
#pragma unroll
        for (int i = 0; i < 16; ++i) { st.o0[i] = 0.f; st.o1[i] = 0.f; }
        st.m = -INFINITY; st.l = 0.f;
        const unsigned todo = orm & (qb >= 31 ? 0xFFFFFFFFu : ((2u << qb) - 1u));
        KVRegs kr;
        int m = todo ? __builtin_ctz(todo) : -1;
        if (m >= 0) { kv_fetch(kr, pb, C_KS + g * 64, C_VS + g * 64, m * 64); __syncthreads(); kv_store(kr, KT, VT); __syncthreads(); }
        while (m >= 0) {
            const unsigned rest = todo & ~((2u << m) - 1u); const int nm = (m < 31 && rest) ? __builtin_ctz(rest) : -1;
            if (nm >= 0) kv_fetch(kr, pb, C_KS + g * 64, C_VS + g * 64, nm * 64);
            const bool sel = (mysel >> m) & 1u;
            if (__builtin_amdgcn_ballot_w64(sel) != 0ull) {
                f32x16 sc0, sc1; qk_tile(KT, qf, qi, hl, sc0, sc1);
                if (m + 3 <= qb) mask_tile<false, false, false, true>(sc0, sc1, lut, qpos, m * 64, hl, sel, QS);
                else mask_tile<true, true, false, true>(sc0, sc1, lut, qpos, m * 64, hl, sel, QS);
                flash_update(st, sc0, sc1, VT, KTS, qi, hl);
            }
            __syncthreads();
            if (nm >= 0) kv_store(kr, KT, VT);
            __syncthreads();
            m = nm;
        }
        const float lt = st.l + shfl_xor_(st.l, 32, lane); const float sc = g1 / fmaxf(lt, 1e-30f);
#pragma unroll
        for (int i = 0; i < 16; ++i) { PARK[i * 64] += st.o0[i] * sc; PARK[(16 + i) * 64] += st.o1[i] * sc; }
    }
    {
        FlashState st;
#pragma unroll
        for (int i = 0; i < 16; ++i) { st.o0[i] = 0.f; st.o1[i] = 0.f; }
        st.m = -INFINITY; st.l = 0.f;
        KVRegs kr;
        int w = qb >= 4 ? 0 : 4 - qb;
        kv_fetch(kr, pb, C_KW + g * 64, C_VW + g * 64, qb * 64 - 256 + 64 * w); __syncthreads(); kv_store(kr, KT, VT); __syncthreads();
        for (; w < 5; ++w) {
            const int k0 = qb * 64 - 256 + 64 * w;
            if (w < 4) kv_fetch(kr, pb, C_KW + g * 64, C_VW + g * 64, k0 + 64);
            f32x16 sc0, sc1; qk_tile(KT, qf, qi, hl, sc0, sc1);
            if (w == 0) mask_tile<false, false, true, false>(sc0, sc1, lut, qpos, k0, hl, true, QS);
            else if (w == 1) mask_tile<false, false, false, false>(sc0, sc1, lut, qpos, k0, hl, true, QS);
            else if (w < 4) mask_tile<true, false, false, false>(sc0, sc1, lut, qpos, k0, hl, true, QS);
            else mask_tile<true, true, false, false>(sc0, sc1, lut, qpos, k0, hl, true, QS);
            flash_update(st, sc0, sc1, VT, KTS, qi, hl);
            __syncthreads();
            if (w < 4) kv_store(kr, KT, VT);
            __syncthreads();
        }
        const float lt = st.l + shfl_xor_(st.l, 32, lane); const float sc = g2 / fmaxf(lt, 1e-30f);
#pragma unroll
        for (int i = 0; i < 16; ++i) { fin0[i] = PARK[i * 64] + st.o0[i] * sc; fin1[i] = PARK[(16 + i) * 64] + st.o1[i] * sc; }
    }
#pragma unroll
    for (int i4 = 0; i4 < 4; ++i4) {
        u32x2 w0; w0.x = pack2(fin0[4 * i4], fin0[4 * i4 + 1]); w0.y = pack2(fin0[4 * i4 + 2], fin0[4 * i4 + 3]);
        u32x2 w1; w1.x = pack2(fin1[4 * i4], fin1[4 * i4 + 1]); w1.y = pack2(fin1[4 * i4 + 2], fin1[4 * i4 + 3]);
        *(u32x2*)(qrow + ocol + head * 64 + 8 * i4 + 4 * hl) = w0;
        *(u32x2*)(qrow + ocol + head * 64 + 32 + 8 * i4 + 4 * hl) = w1;
    }
}

constexpr int PH_PER_LAYER = 15, PH_TOTAL = DEPTH * PH_PER_LAYER + 1;
enum { S_PREP = 0, S_GU1, S_D1, S_NORM_MIX, S_WIN, S_CMP, S_LORA, S_SCAN, S_MERGE, S_OUT, S_NORM2, S_GU2, S_D2, S_NORM_PLE, S_PLEG, S_FINAL };

__device__ __forceinline__ void run_phase(unsigned char* smem, CP p, int ph) {
    const bool fin = (ph == DEPTH * PH_PER_LAYER);
    const int L = fin ? 0 : ph / PH_PER_LAYER; const int sub = fin ? S_FINAL : ph % PH_PER_LAYER;
    unsigned char* ws = p->ws; float* H = p->out;
    bf16_t* W = (bf16_t*)(ws + WS_WBF); bf16_t* UN = (bf16_t*)(ws + WS_UN); bf16_t* PROJ = (bf16_t*)(ws + WS_PROJ); bf16_t* ACT = (bf16_t*)(ws + WS_ACT);
    bf16_t* TMP = (bf16_t*)(ws + WS_TMP); bf16_t* PBF = (bf16_t*)(ws + WS_PB); bf16_t* ORW = (bf16_t*)(ws + WS_ORW);
    bf16_t* XK = (bf16_t*)(ws + WS_XK); bf16_t* XV = (bf16_t*)(ws + WS_XV); float* P01 = (float*)(ws + WS_P01);
    if (sub == S_PREP) convert_layer_weights(smem, p, L);
    if (sub == S_NORM_MIX) convert_ffn2_weights(smem, p, L);
    if (sub == S_NORM2) cvt_f32_bf16(p->in[I_P] + (size_t)L * T_TOK * 256, PBF, (size_t)T_TOK * 256 / 4);
    if (sub == S_CMP) lora_act(p, L);
    if (sub == S_LORA) finalize_cmp(smem, p, L);
    if (sub == S_NORM_PLE) { EpiBf16<DM> e; e.O = TMP; run_gemm(smem, PBF, 256, W + E_PW, T_TOK, DM, 256, e); }
    if (sub == S_PREP || sub == S_NORM_MIX || sub == S_NORM2 || sub == S_NORM_PLE || sub == S_FINAL) {
        const float* hin = (sub == S_PREP && L == 0) ? p->in[I_X] : H; float* hcopy = (sub == S_PREP && L == 0) ? H : nullptr;
        const float* g = sub == S_PREP ? p->in[I_F1N] + L * DM : sub == S_NORM_MIX ? p->in[I_MIXN] + L * DM : sub == S_NORM2 ? p->in[I_F2N] + L * DM : sub == S_NORM_PLE ? p->in[I_PLEN] + L * DM : p->in[I_FINN];
        rmsnorm_rows(hin, hcopy, g, sub == S_FINAL ? nullptr : UN, sub == S_FINAL ? H : nullptr);
    } else if (sub == S_GU1 || sub == S_GU2) {
        EpiSwiglu e; e.O = ACT; run_gemm(smem, UN, DM, W + (sub == S_GU1 ? E_GU1 : E_GU2), T_TOK, 2 * DFF, DM, e);
    } else if (sub == S_D1 || sub == S_D2 || sub == S_OUT) {
        EpiResid e; e.H = H; e.scale = sub == S_OUT ? 1.0f : 0.5f;
        run_gemm(smem, sub == S_OUT ? UN : ACT, sub == S_OUT ? DM : DFF, W + (sub == S_D1 ? E_D1 : sub == S_D2 ? E_D2 : E_OUT), T_TOK, DM, sub == S_OUT ? DM : DFF, e);
    } else if (sub == S_WIN) {
        EpiProj e; e.O = PROJ; e.XK = XK; e.XV = XV; run_gemm(smem, UN, DM, W + E_IN, T_TOK, N_WIN, DM, e);
    } else if (sub == S_CMP) {
#pragma nounroll
        for (int kv = 0; kv < 2; ++kv) { EpiF32 e; e.C = P01 + (size_t)kv * 4096 * 256;
            run_gemm(smem, kv ? XV : XK, 1024, W + E_C1 + (size_t)kv * 256 * 1024, 4096, 256, 1024, e, kv ? 240 : 0); }
        { EpiBf16<PLD> e; e.O = PROJ + C_NG; run_gemm(smem, UN, DM, W + E_NG, T_TOK, 256, DM, e, 128); }
    } else if (sub == S_LORA) {
        EpiLora e; e.EWA = UN; e.G = ORW;
        run_gemm(smem, (const bf16_t*)(ws + WS_LACT), 256, W + E_LORA, T_TOK, 1536, 256, e);
    } else if (sub == S_SCAN) {
        for (int item = bid_(); item < 256; item += gridDim.x) {
            __syncthreads();
            if (item < 128) rwkv_chunked(smem, p, L, item >> 3, item & 7); else hgrn_scan(smem, p, L, (item - 128) >> 3, (item - 128) & 7);
        }
        unsigned* ctr = (unsigned*)(ws + 14336) + L * 64;
        volatile unsigned* slot = (volatile unsigned*)(smem + 141 * 1024);
        for (;;) {
            __syncthreads();
            if (tid_() == 0) *slot = __hip_atomic_fetch_add(ctr, 1u, __ATOMIC_RELAXED, __HIP_MEMORY_SCOPE_AGENT);
            __syncthreads();
            const unsigned idx = *slot;
            if (idx >= 1024u) break;
            const int bg = idx & 31, qb = 31 - (int)(idx >> 5);
            nsa_item(smem, p, L, bg >> 1, bg & 1, qb, C_NQ);
        }
    } else if (sub == S_MERGE) {
#pragma nounroll
        for (int j = 0; j < 3; ++j) { EpiMerge e; e.MRG = UN; e.PROJ = PROJ; e.J = j;
            const bf16_t* A = j == 0 ? PROJ + C_HQ : (j == 1 ? PROJ + C_NQ : ORW);
            run_gemm(smem, A, j == 2 ? 512 : PLD, W + E_BR + (size_t)j * 1024 * 512, T_TOK, DM, 512, e); }
    } else if (sub == S_PLEG) {
        EpiPleGate e; e.H = H; e.TMP = TMP; run_gemm(smem, UN, DM, W + E_PG, T_TOK, DM, DM, e);
    }
}

#define XB_TMO      128
#define XB_XCNT(j)  (256  + 64 * (j))
#define XB_XSUB(j)  (1280 + 64 * (j))
#define XB_XGEN(j)  (2304 + 64 * (j))
#define XB_TOP      3328
#define XB_TOPGEN   3392
#define XCD_BAR_WORDS 3456
#define XB_SPIN_CAP (1u << 20)
DI unsigned xb_ld(unsigned* p)              { return __hip_atomic_load(p, __ATOMIC_RELAXED, __HIP_MEMORY_SCOPE_AGENT); }
DI unsigned xb_add(unsigned* p, unsigned v) { return __hip_atomic_fetch_add(p, v, __ATOMIC_RELAXED, __HIP_MEMORY_SCOPE_AGENT); }
DI unsigned xb_xcc_id() { return (unsigned)__builtin_amdgcn_s_getreg((3 << 11) | 20) & 0xFu; }
#define XB_SPIN(cond, bar) do { unsigned _sp = 0; while (cond) { __builtin_amdgcn_s_sleep(1); \
    if ((++_sp & 255u) == 0u) { if (xb_ld(&(bar)[XB_TMO])) break; if (_sp > XB_SPIN_CAP) { atomicAdd(&(bar)[XB_TMO], 1u); break; } } } } while (0)
struct XcdBarrier { unsigned* bar; unsigned x; volatile LAS unsigned* st; };
DI XcdBarrier xcd_barrier_post(unsigned* bar, volatile LAS unsigned* st) {
    XcdBarrier b; b.bar = bar; b.x = xb_xcc_id(); b.st = st;
    if (threadIdx.x == 0) (void)xb_add(&bar[XB_XCNT(b.x)], 1u);
    return b;
}
DI void xcd_barrier_complete(unsigned* bar, unsigned x, unsigned& nloc, unsigned& nx) {
    const unsigned G = gridDim.x * gridDim.y * gridDim.z;
    unsigned sum, cnt, mine, sp = 0u;
    for (;;) {
        sum = 0u; cnt = 0u; mine = 0u;
#pragma unroll
        for (unsigned j = 0; j < 16; ++j) { const unsigned c = xb_ld(&bar[XB_XCNT(j)]); sum += c; cnt += (c > 0u) ? 1u : 0u; mine = (j == x) ? c : mine; }
        if (sum == G) break;
        __builtin_amdgcn_s_sleep(1);
        if ((++sp & 255u) == 0u) { if (xb_ld(&bar[XB_TMO])) break; if (sp > XB_SPIN_CAP) { atomicAdd(&bar[XB_TMO], 1u); break; } }
    }
    nloc = mine > 0u ? mine : 1u; nx = cnt > 0u ? cnt : 1u;
}
DI void xcd_barrier(const XcdBarrier& b) {
    asm volatile("s_waitcnt vmcnt(0)" ::: "memory");
    __syncthreads();
    if (threadIdx.x == 0) {
        unsigned* bar = b.bar;
        __builtin_amdgcn_s_waitcnt(0);
        unsigned nloc = b.st[0], nx = b.st[1];
        if (nloc == 0u) { xcd_barrier_complete(bar, b.x, nloc, nx); b.st[0] = nloc; b.st[1] = nx; }
        const unsigned old = xb_add(&bar[XB_XSUB(b.x)], 1u);
        const unsigned gen = old / nloc;
        if (old + 1u == (gen + 1u) * nloc) {
            __builtin_amdgcn_fence(__ATOMIC_RELEASE, "agent");
            asm volatile("s_waitcnt vmcnt(0)" ::: "memory");
            const unsigned og = xb_add(&bar[XB_TOP], 1u);
            const unsigned tg = og / nx;
            if (og + 1u == (tg + 1u) * nx) xb_add(&bar[XB_TOPGEN], 1u);
            else XB_SPIN(xb_ld(&bar[XB_TOPGEN]) == tg, bar);
            __builtin_amdgcn_fence(__ATOMIC_ACQUIRE, "agent");
            xb_add(&bar[XB_XGEN(b.x)], 1u);
            asm volatile("s_waitcnt vmcnt(0)" ::: "memory");
        } else {
            XB_SPIN(xb_ld(&bar[XB_XGEN(b.x)]) == gen, bar);
            __builtin_amdgcn_fence(__ATOMIC_ACQUIRE, "agent");
            asm volatile("s_waitcnt vmcnt(0)" ::: "memory");
        }
    }
    __syncthreads();
}

__global__ void __launch_bounds__(512, 2) mega_fwd(Params p) {
    extern __shared__ __attribute__((aligned(16))) unsigned char smem[];
    cg::grid_group grid = cg::this_grid();
    volatile LAS unsigned* xst = (volatile LAS unsigned*)(LAS unsigned char*)(smem + 140 * 1024);
    if (threadIdx.x == 0) { xst[0] = 0u; xst[1] = 0u; }
    __syncthreads();
    const XcdBarrier xb = xcd_barrier_post((unsigned*)(p.ws + WS_BAR), xst);
#ifndef PROBE_DUP
#define PROBE_DUP -1
#endif
    constexpr int IT_PER_LAYER = PH_PER_LAYER + (PROBE_DUP >= 0 ? 1 : 0);
    const int it_lo = p.ph_lo, it_hi = PROBE_DUP >= 0 ? DEPTH * IT_PER_LAYER + 1 : p.ph_hi;
    for (int it = it_lo; it < it_hi; ++it) {
        int ph = it;
        if (PROBE_DUP >= 0) { const int l_ = it / IT_PER_LAYER, r_ = it % IT_PER_LAYER; ph = l_ * PH_PER_LAYER + (r_ <= PROBE_DUP ? r_ : r_ - 1); }
        CP pp = (CP)__builtin_amdgcn_kernarg_segment_ptr(); asm volatile("" : "+s"(pp));
        run_phase(smem, pp, ph);
        if (it + 1 < it_hi) {
            if (it == it_lo) grid.sync();
            else xcd_barrier(xb);
        }
    }
}

#ifndef MULTI_LAUNCH
#define MULTI_LAUNCH 0
#endif

extern "C" void kernel_launch(void* const* d_in, const int* in_sizes, int n_in, void* d_out, int out_size, void* d_ws, size_t ws_size, hipStream_t stream) {
    static int grid = 0;
    if (grid == 0) {
        if (n_in != N_INPUTS || out_size != T_TOK * DM || ws_size < WS_END) { fprintf(stderr, "kernel_launch: unexpected shapes: n_in %d out %d ws %zu (need %zu)\n", n_in, out_size, ws_size, (size_t)WS_END); grid = -1; return; }
        int dev = 0, cus = 0, per_cu = 0;
        (void)hipGetDevice(&dev); (void)hipDeviceGetAttribute(&cus, hipDeviceAttributeMultiprocessorCount, dev);
        if (hipFuncSetAttribute((const void*)mega_fwd, hipFuncAttributeMaxDynamicSharedMemorySize, LDS_BYTES) != hipSuccess) { fprintf(stderr, "kernel_launch: hipFuncSetAttribute failed\n"); grid = -1; return; }
        if (hipOccupancyMaxActiveBlocksPerMultiprocessor(&per_cu, (const void*)mega_fwd, 512, LDS_BYTES) != hipSuccess || per_cu < 1) { fprintf(stderr, "kernel_launch: occupancy query gives %d\n", per_cu); per_cu = 1; }
        (void)hipGetLastError();
        grid = cus * 1;
        if (grid > 256) grid = 256;
        fprintf(stderr, "kernel_launch: grid %d (cus %d, per_cu %d)\n", grid, cus, per_cu);
    }
    if (grid < 0) return;
    (void)hipMemsetAsync(d_ws, 0, 16384, stream);
    Params p{};
    for (int i = 0; i < N_INPUTS; ++i) p.in[i] = (const float*)d_in[i];
    p.out = (float*)d_out; p.ws = (unsigned char*)d_ws;
#if MULTI_LAUNCH
    for (int ph = 0; ph < PH_TOTAL; ++ph) { p.ph_lo = ph; p.ph_hi = ph + 1; hipLaunchKernelGGL(mega_fwd, dim3(grid), dim3(512), LDS_BYTES, stream, p); }
#else
    p.ph_lo = 0; p.ph_hi = PH_TOTAL;
    void* args[] = {&p};
    hipError_t e = hipLaunchCooperativeKernel((const void*)mega_fwd, dim3(grid), dim3(512), args, LDS_BYTES, stream);
    if (e != hipSuccess) fprintf(stderr, "kernel_launch: cooperative launch failed: %s\n", hipGetErrorString(e));
#endif
}
```

```cpp
#include <hip/hip_runtime.h>
#include <hip/hip_cooperative_groups.h>
#include <cstdio>
namespace cg = cooperative_groups;

#define LAS __attribute__((address_space(3)))
#define DI __device__ __forceinline__
typedef unsigned short bf16_t;
typedef short bf16x8 __attribute__((ext_vector_type(8)));
typedef float f32x4 __attribute__((ext_vector_type(4)));
typedef float f32x2 __attribute__((ext_vector_type(2)));
typedef float f32x16 __attribute__((ext_vector_type(16)));
typedef unsigned u32x4 __attribute__((ext_vector_type(4)));
typedef unsigned u32x2 __attribute__((ext_vector_type(2)));

constexpr int T_TOK = 32768, SEQ = 2048, NB = 16, DM = 1024, DFF = 2816, DEPTH = 4;
constexpr int PLD = 8448;
constexpr int C_HQ = 0, C_HF = 512, C_HI = 1024, C_HG = 1536, C_NQ = 2048, C_KC = 2560, C_VC = 2688, C_KS = 2816, C_VS = 2944,
              C_KW = 3072, C_VW = 3200, C_RW = 3328, C_MG = 5120, C_NG = 8192, N_WIN = 8192, IN_COLS = 8216;
enum { I_X = 0, I_P, I_F1N, I_F1GU, I_F1D, I_MIXN, I_WIN, I_HGLB, I_HGN, I_PE, I_CW1, I_CW2, I_RELB, I_MU, I_W0, I_WB, I_A0, I_AB, I_GB,
       I_KK, I_KA, I_RK, I_LNW, I_LNB, I_WBR, I_WOUT, I_F2N, I_F2GU, I_F2D, I_PLEN, I_PLEG, I_PLEW, I_FINN, N_INPUTS };

constexpr size_t WS_BAR = 0;
constexpr size_t WS_PEB = 16384;
constexpr size_t WS_WBF = 32768;
constexpr size_t E_GU1 = 0, E_D1 = E_GU1 + 5632ull * 1024, E_IN = E_D1 + 1024ull * 2816, E_BR = E_IN + 8448ull * 1024, E_OUT = E_BR + 3ull * 1024 * 512,
                 E_GU2 = E_GU1, E_D2 = E_D1  , E_PG = E_OUT + 1024ull * 1024, E_PW = E_PG + 1024ull * 1024,
                 E_C1 = E_PW + 1024ull * 256, E_LORA = E_C1 + 2ull * 256 * 1024, E_NG = E_LORA + 1536ull * 256, E_END = E_NG + 256ull * 1024;
constexpr size_t WS_UN = WS_WBF + E_END * 2;
constexpr size_t WS_ORW = WS_UN + (size_t)T_TOK * 1024 * 2;
constexpr size_t WS_XK = WS_ORW + (size_t)T_TOK * 512 * 2;
constexpr size_t WS_XV = WS_XK + 4096ull * 1024 * 2;
constexpr size_t WS_P01 = WS_XV + 4096ull * 1024 * 2;
constexpr size_t WS_KC = WS_P01 + 2ull * 4096 * 256 * 4;
constexpr size_t WS_LACT = WS_KC + 2ull * 16 * 2 * 128 * 64 * 4;
constexpr size_t WS_PROJ = WS_LACT + (size_t)T_TOK * 256 * 2;
constexpr size_t WS_END = WS_PROJ + (size_t)T_TOK * PLD * 2;
constexpr size_t WS_ACT = WS_PROJ;
constexpr size_t WS_PB = WS_PROJ + 200ull * 1024 * 1024;
constexpr size_t WS_TMP = WS_PROJ + 256ull * 1024 * 1024;
constexpr int LDS_BYTES = 144 * 1024;

struct Params {
    const float* in[N_INPUTS];
    float* out;
    unsigned char* ws;
    int ph_lo, ph_hi;
};
typedef const Params __attribute__((address_space(4)))* CP;

DI int tid_() { int t = threadIdx.x; asm volatile("" : "+v"(t)); return t; }
DI int bid_() { int b = blockIdx.x; asm volatile("" : "+s"(b)); return b; }
typedef __bf16 bf16v2 __attribute__((ext_vector_type(2)));
DI float bf2f(bf16_t b) { return __uint_as_float(((unsigned)b) << 16); }
DI unsigned pack2(float lo, float hi) { const f32x2 v = {lo, hi}; return __builtin_bit_cast(unsigned, __builtin_convertvector(v, bf16v2)); }
DI bf16_t f2bf(float f) { return (bf16_t)(pack2(f, 0.f) & 0xFFFFu); }
DI float sigmoidf_(float x) { return __builtin_amdgcn_rcpf(1.0f + __builtin_amdgcn_exp2f(-1.4426950408889634f * x)); }
DI float siluf_(float x) { return x * __builtin_amdgcn_rcpf(1.0f + __builtin_amdgcn_exp2f(-1.4426950408889634f * x)); }
DI float shfl_xor_(float v, int mask, int lane) { return __int_as_float(__builtin_amdgcn_ds_bpermute((lane ^ mask) << 2, __float_as_int(v))); }
DI float dppf_(float v, int) { return v; }
#define DPPF(v, ctrl) __int_as_float(__builtin_amdgcn_mov_dpp(__float_as_int(v), ctrl, 0xF, 0xF, true))
DI float wave_sum(float v) {
    v += DPPF(v, 0xB1); v += DPPF(v, 0x4E); v += DPPF(v, 0x141); v += DPPF(v, 0x140);
    const float s0 = __int_as_float(__builtin_amdgcn_readlane(__float_as_int(v), 0)), s1 = __int_as_float(__builtin_amdgcn_readlane(__float_as_int(v), 16));
    const float s2 = __int_as_float(__builtin_amdgcn_readlane(__float_as_int(v), 32)), s3 = __int_as_float(__builtin_amdgcn_readlane(__float_as_int(v), 48));
    return (s0 + s1) + (s2 + s3);
}

#define MFMA32(a, b, c) __builtin_amdgcn_mfma_f32_32x32x16_bf16((a), (b), (c), 0, 0, 0)
namespace pg8 {
constexpr int BM = 256, BK = 64, HALF = 128, HTB = HALF * BK * 2, STAGE_BYTES = 8 * HTB, NXCD = 8, WGM = 8;
DI int lds_byte(int r, int c) { const int st = (r >> 4) * 2 + (c >> 5), rr = r & 15, cc = c & 31, ob = rr * 64 + cc * 2; return st * 1024 + (ob ^ (((ob >> 9) & 1) << 5)); }
DI void stage_rc(int b, int& R, int& C) { const int st = b / 1024, sb = b % 1024, swz = sb ^ (((sb >> 9) & 1) << 5); R = (st >> 1) * 16 + swz / 64; C = (st & 1) * 32 + (swz % 64) / 2; }
DI int perm32(int rho) { const int n = rho >> 4, i = rho & 15; return 8 * (i >> 2) + 4 * n + (i & 3); }
struct Unit { int pm, pn; };
struct Gemm { const bf16_t* A; const bf16_t* Bt; int M, N, K, lda; };
struct StaticOrder {
    int nM, nN, nwg, G, c;
    DI void init(int M, int N, int G_, int c_) { nM = M / BM; nN = N / BM; nwg = nM * nN; G = G_; c = c_; }
    DI bool next(int i, Unit& u) const {
        const long L = (long)i * G + c; if (L >= nwg) return false;
        int wgid = (int)L; { const int q = nwg / NXCD, r = nwg % NXCD, xcd = wgid % NXCD, off = wgid / NXCD; wgid = (xcd < r ? xcd * (q + 1) : r * (q + 1) + (xcd - r) * q) + off; }
        const int nig = WGM * nN, gid = wgid / nig, fm = gid * WGM, gsz = (nM - fm) < WGM ? (nM - fm) : WGM;
        u.pm = fm + ((wgid % nig) % gsz); u.pn = (wgid % nig) / gsz; return true;
    }
};

template <class Epi>
DI void gemm_phase(LAS unsigned char* lds, const Gemm g, const StaticOrder& S, const Epi& E) {
    int tid = tid_();
    const int wid = __builtin_amdgcn_readfirstlane(tid >> 6), lane = tid & 63, wr = wid >> 2, wc = wid & 3, fr = lane & 15, fq = lane >> 4;
    const int K = g.K, nt = K / BK, lda = g.lda;
    unsigned voffA[2], voffB[2];
#pragma unroll
    for (int i = 0; i < 2; ++i) { int R, C; stage_rc(tid * 16 + i * 8192, R, C); const int Rb = Epi::PERM ? ((R & ~31) + perm32(R & 31)) : R;
        voffA[i] = (unsigned)(R * lda + C) * 2u; voffB[i] = (unsigned)(Rb * K + C) * 2u; }
    const size_t kstep = (size_t)(BK * 2);
    const size_t hstepA = (size_t)HALF * lda * 2, hstepB = (size_t)HALF * K * 2;
    const size_t tstepA = 2 * hstepA, tstepB = 2 * hstepB;
    const unsigned ldsw = (unsigned)wid * 1024u;
    const int aoff = lds_byte(wr * 64 + fr, fq * 8), boff = lds_byte(wc * 32 + fr, fq * 8);
#define PG8_SA(b, h) (((b) * 2 + (h)) * HTB)
#define PG8_SB(b, h) ((4 + (b) * 2 + (h)) * HTB)
#define PG8_STAGE(bufoff, gbase, voff) do { _Pragma("unroll") for (int _i = 0; _i < 2; ++_i) \
        __builtin_amdgcn_global_load_lds((const unsigned*)((const char*)(gbase) + (voff)[_i]), (LAS unsigned*)(lds + (bufoff) + ldsw + _i * 8192), 16, 0, 0); } while (0)
#define PG8_LDA(dst, b, h) do { _Pragma("unroll") for (int m = 0; m < 4; ++m) _Pragma("unroll") for (int k = 0; k < 2; ++k) dst[m][k] = *(const LAS bf16x8*)(lds + PG8_SA(b, h) + aoff + m * 2048 + k * 1024); } while (0)
#define PG8_LDB(dst, b, h) do { _Pragma("unroll") for (int n = 0; n < 2; ++n) _Pragma("unroll") for (int k = 0; k < 2; ++k) dst[n][k] = *(const LAS bf16x8*)(lds + PG8_SB(b, h) + boff + n * 2048 + k * 1024); } while (0)
#define PG8_MMA(ai, bj, At, Bt) do { __builtin_amdgcn_s_setprio(1); _Pragma("unroll") for (int m = 0; m < 4; ++m) _Pragma("unroll") for (int n = 0; n < 2; ++n) _Pragma("unroll") for (int k = 0; k < 2; ++k) \
        acc[ai][bj][m][n] = __builtin_amdgcn_mfma_f32_16x16x32_bf16(Bt[n][k], At[m][k], acc[ai][bj][m][n], 0, 0, 0); __builtin_amdgcn_s_setprio(0); } while (0)
#define PG8_WAIT_V(n) asm volatile("s_waitcnt vmcnt(" #n ")" ::: "memory")
#define PG8_WAIT_L(n) asm volatile("s_waitcnt lgkmcnt(" #n ")" ::: "memory")
#define PG8_BAR __builtin_amdgcn_s_barrier()
#define PG8_SCHED __builtin_amdgcn_sched_barrier(0)
    Unit cur, nxt; int ui = 0;
    if (!S.next(0, cur)) return;
    f32x4 acc[2][2][4][2];
#pragma unroll
    for (int a = 0; a < 2; ++a)
#pragma unroll
        for (int b = 0; b < 2; ++b)
#pragma unroll
            for (int m = 0; m < 4; ++m)
#pragma unroll
                for (int n = 0; n < 2; ++n) acc[a][b][m][n] = (f32x4){0.f, 0.f, 0.f, 0.f};
    bf16x8 At[4][2], B0[2][2], B1[2][2];
    const char* cA = (const char*)g.A + (size_t)cur.pm * tstepA; const char* cB = (const char*)g.Bt + (size_t)cur.pn * tstepB;
    PG8_STAGE(PG8_SB(0, 0), cB, voffB); PG8_STAGE(PG8_SA(0, 0), cA, voffA); PG8_STAGE(PG8_SB(0, 1), cB + hstepB, voffB); PG8_STAGE(PG8_SA(0, 1), cA + hstepA, voffA);
    if (wr == 1) PG8_BAR;
    PG8_WAIT_V(4); PG8_BAR;
    PG8_STAGE(PG8_SB(1, 0), cB + kstep, voffB); PG8_STAGE(PG8_SA(1, 0), cA + kstep, voffA); PG8_STAGE(PG8_SB(1, 1), cB + hstepB + kstep, voffB);
    PG8_WAIT_V(6); PG8_BAR;
    for (;;) {
        const bool has_next = S.next(ui + 1, nxt);
        const char* nA = has_next ? (const char*)g.A + (size_t)nxt.pm * tstepA : cA; const char* nB = has_next ? (const char*)g.Bt + (size_t)nxt.pn * tstepB : cB;
        for (int t = 0; t < nt; t += 2) {
            const bool last = (t == nt - 2);
            const char* a1 = cA + (size_t)(t + 1) * kstep;
            const char* a2 = last ? nA : cA + (size_t)(t + 2) * kstep; const char* b2 = last ? nB : cB + (size_t)(t + 2) * kstep;
            const char* a3 = a2 + kstep; const char* b3 = b2 + kstep;
            PG8_LDB(B0, 0, 0); PG8_SCHED; PG8_LDA(At, 0, 0); PG8_STAGE(PG8_SA(1, 1), a1 + hstepA, voffA);
            PG8_WAIT_L(8); PG8_BAR; PG8_WAIT_L(0); PG8_MMA(0, 0, At, B0); PG8_BAR; PG8_SCHED;
            PG8_LDB(B1, 0, 1); PG8_STAGE(PG8_SB(0, 0), b2, voffB);
            PG8_BAR; PG8_WAIT_L(0); PG8_MMA(0, 1, At, B1); PG8_BAR;
            PG8_LDA(At, 0, 1); PG8_STAGE(PG8_SA(0, 0), a2, voffA);
            PG8_BAR; PG8_WAIT_L(0); PG8_MMA(1, 0, At, B0); PG8_BAR; PG8_SCHED;
            PG8_STAGE(PG8_SB(0, 1), b2 + hstepB, voffB);
            PG8_WAIT_V(6); PG8_BAR; PG8_MMA(1, 1, At, B1); PG8_BAR;
            PG8_LDB(B0, 1, 0); PG8_SCHED; PG8_LDA(At, 1, 0); PG8_STAGE(PG8_SA(0, 1), a2 + hstepA, voffA);
            PG8_WAIT_L(8); PG8_BAR; PG8_WAIT_L(0); PG8_MMA(0, 0, At, B0); PG8_BAR; PG8_SCHED;
            PG8_LDB(B1, 1, 1); PG8_STAGE(PG8_SB(1, 0), b3, voffB);
            PG8_BAR; PG8_WAIT_L(0); PG8_MMA(0, 1, At, B1); PG8_BAR;
            PG8_LDA(At, 1, 1); PG8_STAGE(PG8_SA(1, 0), a3, voffA);
            PG8_BAR; PG8_WAIT_L(0); PG8_MMA(1, 0, At, B0); PG8_BAR; PG8_SCHED;
            PG8_STAGE(PG8_SB(1, 1), b3 + hstepB, voffB);
            PG8_WAIT_V(6); PG8_BAR; PG8_MMA(1, 1, At, B1); PG8_BAR;
        }
        E(acc, cur, wr, wc, fr, fq);
        if (!has_next) break;
#pragma unroll
        for (int a = 0; a < 2; ++a)
#pragma unroll
            for (int b = 0; b < 2; ++b)
#pragma unroll
                for (int m = 0; m < 4; ++m)
#pragma unroll
                    for (int n = 0; n < 2; ++n) acc[a][b][m][n] = (f32x4){0.f, 0.f, 0.f, 0.f};
        cur = nxt; cA = nA; cB = nB; ++ui;
    }
    PG8_WAIT_V(0);
    if (wr == 0) PG8_BAR;
    PG8_BAR;
#undef PG8_SA
#undef PG8_SB
#undef PG8_STAGE
#undef PG8_LDA
#undef PG8_LDB
#undef PG8_MMA
#undef PG8_WAIT_V
#undef PG8_WAIT_L
#undef PG8_BAR
#undef PG8_SCHED
}
}

typedef f32x4 AccT[2][2][4][2];
#define EPI_LANE const int t_ = tid_(), wid_ = t_ >> 6, ln_ = t_ & 63, wr_ = wid_ >> 2, wc_ = wid_ & 3, fr_ = ln_ & 15, fq_ = ln_ >> 4;
#define EPI_LOOP_PERM(...) EPI_LANE \
    const int row0 = u.pm * 256 + wr_ * 64 + fr_, col0 = u.pn * 256 + wc_ * 32 + 8 * fq_; \
    _Pragma("unroll") for (int ai = 0; ai < 2; ++ai) _Pragma("unroll") for (int m = 0; m < 4; ++m) { const int row = row0 + ai * 128 + m * 16; \
        _Pragma("unroll") for (int bj = 0; bj < 2; ++bj) { const int col = col0 + bj * 128; const f32x4 v0 = acc[ai][bj][m][0], v1 = acc[ai][bj][m][1]; __VA_ARGS__ } }
#define EPI_LOOP_NAT(...) EPI_LANE \
    const int row0 = u.pm * 256 + wr_ * 64 + fr_, col0 = u.pn * 256 + wc_ * 32 + 4 * fq_; \
    _Pragma("unroll") for (int ai = 0; ai < 2; ++ai) _Pragma("unroll") for (int m = 0; m < 4; ++m) { const int row = row0 + ai * 128 + m * 16; \
        _Pragma("unroll") for (int bj = 0; bj < 2; ++bj) _Pragma("unroll") for (int n = 0; n < 2; ++n) { const int col = col0 + bj * 128 + n * 16; const f32x4 v = acc[ai][bj][m][n]; __VA_ARGS__ } }

struct EpiSwiglu { static constexpr bool PERM = true; bf16_t* O;
    DI void operator()(const AccT& acc, const pg8::Unit& u, int wr, int wc, int fr, int fq) const {
        EPI_LOOP_PERM({ u32x2 w; w.x = pack2(siluf_(v0[0]) * v1[0], siluf_(v0[1]) * v1[1]); w.y = pack2(siluf_(v0[2]) * v1[2], siluf_(v0[3]) * v1[3]);
            *(u32x2*)(O + (size_t)row * DFF + (col >> 1)) = w; })
    } };
struct EpiResid { static constexpr bool PERM = false; float* H; float scale;
    DI void operator()(const AccT& acc, const pg8::Unit& u, int wr, int wc, int fr, int fq) const {
        EPI_LANE
        const int row0 = u.pm * 256 + wr_ * 64 + fr_, col0 = u.pn * 256 + wc_ * 32 + 4 * fq_;
#pragma unroll
        for (int ai = 0; ai < 2; ++ai)
#pragma unroll
            for (int mp = 0; mp < 2; ++mp) {
                f32x4 h[2][2][2];
#pragma unroll
                for (int mm = 0; mm < 2; ++mm)
#pragma unroll
                    for (int bj = 0; bj < 2; ++bj)
#pragma unroll
                        for (int n = 0; n < 2; ++n) h[mm][bj][n] = *(const f32x4*)(H + (size_t)(row0 + ai * 128 + (2 * mp + mm) * 16) * DM + col0 + bj * 128 + n * 16);
                asm volatile("" ::: "memory");
#pragma unroll
                for (int mm = 0; mm < 2; ++mm)
#pragma unroll
                    for (int bj = 0; bj < 2; ++bj)
#pragma unroll
                        for (int n = 0; n < 2; ++n) *(f32x4*)(H + (size_t)(row0 + ai * 128 + (2 * mp + mm) * 16) * DM + col0 + bj * 128 + n * 16) = h[mm][bj][n] + acc[ai][bj][2 * mp + mm][n] * scale;
            }
    } };
struct EpiProj { static constexpr bool PERM = true; bf16_t* O; bf16_t* XK; bf16_t* XV;
    DI void operator()(const AccT& acc, const pg8::Unit& u, int wr, int wc, int fr, int fq) const {
        const bool is_mg = u.pn * 256 >= C_MG, is_cmp = (u.pn == 10);
        EPI_LOOP_PERM({ f32x4 a = v0, b = v1;
            if (is_mg) { for (int j = 0; j < 4; ++j) { a[j] = sigmoidf_(a[j]); b[j] = sigmoidf_(b[j]); } }
            u32x4 w; w.x = pack2(a[0], a[1]); w.y = pack2(a[2], a[3]); w.z = pack2(b[0], b[1]); w.w = pack2(b[2], b[3]);
            *(u32x4*)(O + (size_t)row * PLD + col) = w;
            if (is_cmp) { const int c = col - C_KC, kv = c >> 7, gg = (c >> 6) & 1, d = c & 63, bb = row >> 11, s = row & 2047, jj = s >> 4, l = s & 15;
                bf16_t* X = kv ? XV : XK; *(u32x4*)(X + ((size_t)((bb * 128 + jj) * 2 + gg)) * 1024 + l * 64 + d) = w; } })
    } };
struct EpiMerge { static constexpr bool PERM = true; bf16_t* MRG; const bf16_t* PROJ; int J;
    DI void operator()(const AccT& acc, const pg8::Unit& u, int wr, int wc, int fr, int fq) const {
        EPI_LANE
        const int row0 = u.pm * 256 + wr_ * 64 + fr_, col0 = u.pn * 256 + wc_ * 32 + 8 * fq_;
#pragma unroll
        for (int ai = 0; ai < 2; ++ai)
#pragma unroll
            for (int bj = 0; bj < 2; ++bj) { const int col = col0 + bj * 128;
                u32x4 gt[4], old[4];
#pragma unroll
                for (int m = 0; m < 4; ++m) { const int row = row0 + ai * 128 + m * 16;
                    gt[m] = *(const u32x4*)(PROJ + (size_t)row * PLD + C_MG + J * 1024 + col);
                    old[m] = (u32x4){0u, 0u, 0u, 0u}; if (J > 0) old[m] = *(const u32x4*)(MRG + (size_t)row * DM + col); }
                asm volatile("" ::: "memory");
#pragma unroll
                for (int m = 0; m < 4; ++m) { const int row = row0 + ai * 128 + m * 16; const f32x4 v0 = acc[ai][bj][m][0], v1 = acc[ai][bj][m][1];
                    float r[8]; const float x[8] = {v0[0], v0[1], v0[2], v0[3], v1[0], v1[1], v1[2], v1[3]};
#pragma unroll
                    for (int j = 0; j < 8; ++j) { const unsigned gw = gt[m][j >> 1], ow = old[m][j >> 1];
                        const float gf = (j & 1) ? __uint_as_float(gw & 0xFFFF0000u) : __uint_as_float(gw << 16);
                        const float of = (j & 1) ? __uint_as_float(ow & 0xFFFF0000u) : __uint_as_float(ow << 16);
                        r[j] = of + gf * x[j]; }
                    u32x4 w; w.x = pack2(r[0], r[1]); w.y = pack2(r[2], r[3]); w.z = pack2(r[4], r[5]); w.w = pack2(r[6], r[7]);
                    *(u32x4*)(MRG + (size_t)row * DM + col) = w; }
            }
    } };
struct EpiF32 { static constexpr bool PERM = false; float* C; static constexpr int ldc = 256;
    DI void operator()(const AccT& acc, const pg8::Unit& u, int wr, int wc, int fr, int fq) const {
        EPI_LOOP_NAT({ *(f32x4*)(C + (size_t)row * ldc + col) = v; })
    } };
template <int LDC> struct EpiBf16 { static constexpr bool PERM = true; bf16_t* O; static constexpr int ldc = LDC;
    DI void operator()(const AccT& acc, const pg8::Unit& u, int wr, int wc, int fr, int fq) const {
        EPI_LOOP_PERM({ u32x4 w; w.x = pack2(v0[0], v0[1]); w.y = pack2(v0[2], v0[3]); w.z = pack2(v1[0], v1[1]); w.w = pack2(v1[2], v1[3]);
            *(u32x4*)(O + (size_t)row * ldc + col) = w; })
    } };
struct EpiPleGate { static constexpr bool PERM = false; float* H; const bf16_t* TMP;
    DI void operator()(const AccT& acc, const pg8::Unit& u, int wr, int wc, int fr, int fq) const {
        EPI_LANE
        const int row0 = u.pm * 256 + wr_ * 64 + fr_, col0 = u.pn * 256 + wc_ * 32 + 4 * fq_;
#pragma unroll
        for (int ai = 0; ai < 2; ++ai)
#pragma unroll
            for (int m = 0; m < 4; ++m) { const int row = row0 + ai * 128 + m * 16;
                f32x4 h[2][2]; u32x2 tw[2][2];
#pragma unroll
                for (int bj = 0; bj < 2; ++bj)
#pragma unroll
                    for (int n = 0; n < 2; ++n) { const int col = col0 + bj * 128 + n * 16; h[bj][n] = *(const f32x4*)(H + (size_t)row * DM + col); tw[bj][n] = *(const u32x2*)(TMP + (size_t)row * DM + col); }
                asm volatile("" ::: "memory");
#pragma unroll
                for (int bj = 0; bj < 2; ++bj)
#pragma unroll
                    for (int n = 0; n < 2; ++n) { const int col = col0 + bj * 128 + n * 16; const f32x4 v = acc[ai][bj][m][n]; f32x4 o = h[bj][n]; const u32x2 t = tw[bj][n];
                        o[0] += sigmoidf_(v[0]) * __uint_as_float(t.x << 16); o[1] += sigmoidf_(v[1]) * __uint_as_float(t.x & 0xFFFF0000u);
                        o[2] += sigmoidf_(v[2]) * __uint_as_float(t.y << 16); o[3] += sigmoidf_(v[3]) * __uint_as_float(t.y & 0xFFFF0000u);
                        *(f32x4*)(H + (size_t)row * DM + col) = o; }
            }
    } };
struct EpiLora { static constexpr bool PERM = true; bf16_t* EWA; bf16_t* G;
    DI void operator()(const AccT& acc, const pg8::Unit& u, int wr, int wc, int fr, int fq) const {
        const bool isg = u.pn >= 4; bf16_t* O = isg ? G - 1024 : EWA; const int ld = isg ? 512 : 1024;
        EPI_LOOP_PERM({ u32x4 w; w.x = pack2(v0[0], v0[1]); w.y = pack2(v0[2], v0[3]); w.z = pack2(v1[0], v1[1]); w.w = pack2(v1[2], v1[3]);
            *(u32x4*)(O + (size_t)row * ld + col) = w; })
    } };

template <class Epi> DI void run_gemm(unsigned char* smem, const bf16_t* A, int lda, const bf16_t* Bt, int M, int N, int K, const Epi& E, int coff = 0) {
    __syncthreads();
    pg8::Gemm g; g.A = A; g.Bt = Bt; g.M = M; g.N = N; g.K = K; g.lda = lda;
    pg8::StaticOrder S; S.init(M, N, (int)gridDim.x, (bid_() + coff) % (int)gridDim.x);
    pg8::gemm_phase<Epi>((LAS unsigned char*)smem, g, S, E);
    __syncthreads();
}

struct MapId { DI int operator()(int n) const { return n; } };
struct MapGU { DI int operator()(int n) const { const int q = n >> 3, e = n & 7; return e < 4 ? 4 * q + e : DFF + 4 * q + (e - 4); } };
struct MapIn { DI int operator()(int n) const { return n < 3328 ? n : n + 24; } };
struct MapNg { DI int operator()(int n) const { return n < 24 ? 3328 + n : -1; } };
template <int TN, class Map> __device__ __forceinline__ void transpose_cvt_t(unsigned char* smem, const float* src, int ldsrc, bf16_t* dst, int K, int Nd, Map map, int& toff) {
    float* tile = (float*)smem;
    constexpr int RPP = 512 / TN;
    const int tid = tid_(), ntk = K / 64, nt = ntk * (Nd / TN);
    const int G = (int)gridDim.x, first = (bid_() + G - (toff % G)) % G;
    toff += nt;
    for (int t = first; t < nt; t += G) {
        const int n0 = (t / ntk) * TN, k0 = (t % ntk) * 64;
        const int nn = tid % TN, sc = map(n0 + nn);
#pragma unroll
        for (int p = 0; p < 64 / RPP; ++p) { const int kk = (tid / TN) + p * RPP; tile[kk * (TN + 1) + nn] = sc >= 0 ? src[(size_t)(k0 + kk) * ldsrc + sc] : 0.f; }
        __syncthreads();
#pragma unroll
        for (int p = 0; p < TN / 16; ++p) { const int nn2 = (tid >> 5) + p * 16, kk2 = (tid & 31) * 2;
            *(unsigned*)(dst + (size_t)(n0 + nn2) * K + k0 + kk2) = pack2(tile[kk2 * (TN + 1) + nn2], tile[(kk2 + 1) * (TN + 1) + nn2]); }
        __syncthreads();
    }
}
template <class Map> __device__ __forceinline__ void transpose_cvt(unsigned char* smem, const float* src, int ldsrc, bf16_t* dst, int K, int Nd, Map map, int& toff) {
    if ((Nd & 255) == 0) transpose_cvt_t<256>(smem, src, ldsrc, dst, K, Nd, map, toff); else transpose_cvt_t<64>(smem, src, ldsrc, dst, K, Nd, map, toff);
}
__device__ __forceinline__ void convert_layer_weights(unsigned char* smem, CP p, int L) {
    bf16_t* W = (bf16_t*)(p->ws + WS_WBF); int toff = 0;
    transpose_cvt(smem, p->in[I_F1GU] + (size_t)L * DM * 2 * DFF, 2 * DFF, W + E_GU1, DM, 2 * DFF, MapGU(), toff);
    transpose_cvt(smem, p->in[I_F1D] + (size_t)L * DFF * DM, DM, W + E_D1, DFF, DM, MapId(), toff);
    transpose_cvt(smem, p->in[I_WIN] + (size_t)L * DM * IN_COLS, IN_COLS, W + E_IN, DM, N_WIN, MapIn(), toff);
    transpose_cvt(smem, p->in[I_WIN] + (size_t)L * DM * IN_COLS, IN_COLS, W + E_NG, DM, 256, MapNg(), toff);
    for (int j = 0; j < 3; ++j) transpose_cvt(smem, p->in[I_WBR] + ((size_t)L * 3 + j) * 512 * DM, DM, W + E_BR + (size_t)j * 1024 * 512, 512, DM, MapId(), toff);
    transpose_cvt(smem, p->in[I_WOUT] + (size_t)L * DM * DM, DM, W + E_OUT, DM, DM, MapId(), toff);
    for (int i = bid_() * 512 + tid_(); i < 1536 * 256; i += gridDim.x * 512) { const int n = i >> 8, k = i & 255; float w = 0.f;
        if (n < 512) { if (k < 64) w = p->in[I_WB][((size_t)L * 64 + k) * 512 + n]; }
        else if (n < 1024) { if (k >= 64 && k < 128) w = p->in[I_AB][((size_t)L * 64 + (k - 64)) * 512 + (n - 512)]; }
        else { if (k >= 128) w = p->in[I_GB][((size_t)L * 128 + (k - 128)) * 512 + (n - 1024)]; }
        W[E_LORA + i] = f2bf(w); }
    transpose_cvt(smem, p->in[I_PLEG] + (size_t)L * DM * DM, DM, W + E_PG, DM, DM, MapId(), toff);
    transpose_cvt(smem, p->in[I_PLEW] + (size_t)L * 256 * DM, DM, W + E_PW, 256, DM, MapId(), toff);
    for (int kv = 0; kv < 2; ++kv) for (int hf = 0; hf < 2; ++hf)
        transpose_cvt(smem, p->in[I_CW1] + ((size_t)(L * 2 + kv) * 2048 + hf * 1024) * 128, 128, W + E_C1 + ((size_t)kv * 256 + hf * 128) * 1024, 1024, 128, MapId(), toff);
    { const int q = (int)gridDim.x - 1 - bid_(); const int tid = tid_();
      if (q >= 0 && q < 16 && tid < 256) {
        const int kv = tid >> 7, hc = tid & 127;
        const float* pe = p->in[I_PE] + (size_t)(L * 2 + kv) * 2048 + q * 128; const float* w1 = p->in[I_CW1] + ((size_t)(L * 2 + kv) * 2048 + q * 128) * 128 + hc;
        float s0 = 0.f, s1 = 0.f, s2 = 0.f, s3 = 0.f;
#pragma unroll 4
        for (int i = 0; i < 128; i += 4) { s0 += pe[i] * w1[(size_t)i * 128]; s1 += pe[i + 1] * w1[(size_t)(i + 1) * 128]; s2 += pe[i + 2] * w1[(size_t)(i + 2) * 128]; s3 += pe[i + 3] * w1[(size_t)(i + 3) * 128]; }
        ((float*)(p->ws + WS_PEB))[(q * 2 + kv) * 128 + hc] = (s0 + s1) + (s2 + s3);
      } }
}

__device__ __forceinline__ void convert_ffn2_weights(unsigned char* smem, CP p, int L) {
    bf16_t* W = (bf16_t*)(p->ws + WS_WBF); int toff = 0;
    transpose_cvt(smem, p->in[I_F2GU] + (size_t)L * DM * 2 * DFF, 2 * DFF, W + E_GU2, DM, 2 * DFF, MapGU(), toff);
    transpose_cvt(smem, p->in[I_F2D] + (size_t)L * DFF * DM, DM, W + E_D2, DFF, DM, MapId(), toff);
}
__device__ __forceinline__ void lora_act(CP p, int L) {
    const bf16_t* PROJ = (const bf16_t*)(p->ws + WS_PROJ); bf16_t* LACT = (bf16_t*)(p->ws + WS_LACT);
    const float* mu = p->in[I_MU] + (size_t)L * 1792 + 1536;
    const int stride = (int)gridDim.x * 512;
    for (int i = bid_() * 512 + tid_(); i < T_TOK * 32; i += 4 * stride) {
        u32x4 cur[4], prv[4];
#pragma unroll
        for (int k = 0; k < 4; ++k) { const int ii = i + k * stride; cur[k] = (u32x4){0u, 0u, 0u, 0u}; prv[k] = cur[k];
            if (ii < T_TOK * 32) { const int t = ii >> 5, j0 = (ii & 31) * 8; const bf16_t* row = PROJ + (size_t)t * PLD + C_RW + 1536 + j0;
                cur[k] = *(const u32x4*)row; if ((t & (SEQ - 1)) != 0) prv[k] = *(const u32x4*)(row - PLD); } }
        asm volatile("" ::: "memory");
#pragma unroll
        for (int k = 0; k < 4; ++k) { const int ii = i + k * stride;
            if (ii < T_TOK * 32) { const int t = ii >> 5, j0 = (ii & 31) * 8;
                const f32x4 m0 = *(const f32x4*)(mu + j0), m1 = *(const f32x4*)(mu + j0 + 4);
                float r[8];
#pragma unroll
                for (int e = 0; e < 8; ++e) { const float x1 = (e & 1) ? __uint_as_float(cur[k][e >> 1] & 0xFFFF0000u) : __uint_as_float(cur[k][e >> 1] << 16);
                    const float xp = (e & 1) ? __uint_as_float(prv[k][e >> 1] & 0xFFFF0000u) : __uint_as_float(prv[k][e >> 1] << 16);
                    float xm = x1 + (xp - x1) * (e < 4 ? m0[e & 3] : m1[e & 3]);
                    if (j0 < 64) xm = 2.0f * sigmoidf_(2.0f * xm) - 1.0f;
                    else if (j0 >= 128) xm = sigmoidf_(xm);
                    r[e] = xm; }
                u32x4 w; w.x = pack2(r[0], r[1]); w.y = pack2(r[2], r[3]); w.z = pack2(r[4], r[5]); w.w = pack2(r[6], r[7]);
                *(u32x4*)(LACT + (size_t)t * 256 + j0) = w; } }
    }
}

__device__ __forceinline__ void rmsnorm_rows(const float* hin, float* hcopy, const float* g, bf16_t* un, float* outf) {
    const int lane = tid_() & 63, gw = bid_() * 8 + (tid_() >> 6), nw = gridDim.x * 8;
    f32x4 gv[4];
#pragma unroll
    for (int i = 0; i < 4; ++i) gv[i] = *(const f32x4*)(g + lane * 4 + i * 256);
    f32x4 nx[2][4];
    int row0 = gw * 2;
    if (row0 < T_TOK) {
#pragma unroll
        for (int r = 0; r < 2; ++r)
#pragma unroll
            for (int i = 0; i < 4; ++i) nx[r][i] = *(const f32x4*)(hin + (size_t)(row0 + r) * DM + lane * 4 + i * 256); }
    for (; row0 < T_TOK; row0 += nw * 2) {
        f32x4 x[2][4]; float ss[2] = {0.f, 0.f};
#pragma unroll
        for (int r = 0; r < 2; ++r)
#pragma unroll
            for (int i = 0; i < 4; ++i) x[r][i] = nx[r][i];
        const int rown = row0 + nw * 2;
        if (rown < T_TOK) {
#pragma unroll
            for (int r = 0; r < 2; ++r)
#pragma unroll
                for (int i = 0; i < 4; ++i) nx[r][i] = *(const f32x4*)(hin + (size_t)(rown + r) * DM + lane * 4 + i * 256); }
        asm volatile("" ::: "memory");
#pragma unroll
        for (int r = 0; r < 2; ++r) {
#pragma unroll
            for (int i = 0; i < 4; ++i) ss[r] += x[r][i][0] * x[r][i][0] + x[r][i][1] * x[r][i][1] + x[r][i][2] * x[r][i][2] + x[r][i][3] * x[r][i][3];
            ss[r] = wave_sum(ss[r]); }
#pragma unroll
        for (int r = 0; r < 2; ++r) { const int row = row0 + r; const float rs = rsqrtf(ss[r] * (1.0f / DM) + 1e-6f);
#pragma unroll
            for (int i = 0; i < 4; ++i) {
                const f32x4 y = x[r][i] * rs * gv[i];
                if (hcopy) *(f32x4*)(hcopy + (size_t)row * DM + lane * 4 + i * 256) = x[r][i];
                if (un) { u32x2 w; w.x = pack2(y[0], y[1]); w.y = pack2(y[2], y[3]); *(u32x2*)(un + (size_t)row * DM + lane * 4 + i * 256) = w; }
                if (outf) *(f32x4*)(outf + (size_t)row * DM + lane * 4 + i * 256) = y;
            } }
    }
}
__device__ __forceinline__ void cvt_f32_bf16(const float* src, bf16_t* dst, size_t n4) {
    const size_t stride = (size_t)gridDim.x * 512;
    for (size_t i = (size_t)bid_() * 512 + tid_(); i < n4; i += 4 * stride) {
        f32x4 v[4];
#pragma unroll
        for (int k = 0; k < 4; ++k) { const size_t j = i + k * stride; if (j < n4) v[k] = *(const f32x4*)(src + j * 4); }
        asm volatile("" ::: "memory");
#pragma unroll
        for (int k = 0; k < 4; ++k) { const size_t j = i + k * stride; if (j < n4) { u32x2 w; w.x = pack2(v[k][0], v[k][1]); w.y = pack2(v[k][2], v[k][3]); *(u32x2*)(dst + j * 4) = w; } }
    }
}

__device__ __forceinline__ void finalize_cmp(unsigned char* smem, CP p, int L) {
    float* hid = (float*)smem + (tid_() >> 6) * 128;
    float* W2L = (float*)(smem + 4096);
    const int lane = tid_() & 63, gw = bid_() * 8 + (tid_() >> 6), nw = gridDim.x * 8;
    const float* peb = (const float*)(p->ws + WS_PEB);
    { const float* w2g = p->in[I_CW2] + (size_t)L * 2 * 128 * 64;
      for (int i = tid_(); i < 2 * 128 * 64 / 4; i += 512) *(f32x4*)(W2L + i * 4) = *(const f32x4*)(w2g + i * 4); }
    __syncthreads();
    const int total = 2 * 16 * 2 * 128, iters = (total + nw - 1) / nw;
    for (int it = 0; it < iters; ++it) {
        const int id = gw + it * nw; const bool ok = id < total;
        const int n = id & 127, gg = (id >> 7) & 1, bb = (id >> 8) & 15, kv = (id >> 12) & 1;
        if (ok && n < 127) {
            const float* Pm = (const float*)(p->ws + WS_P01) + (size_t)kv * 4096 * 256;
            const size_t r0 = (size_t)((bb * 128 + n) * 2 + gg) * 256, r1 = (size_t)((bb * 128 + n + 1) * 2 + gg) * 256;
#pragma unroll
            for (int q = 0; q < 2; ++q) { const int hc = lane + q * 64; float pb_ = 0.f; for (int s16 = 0; s16 < 16; ++s16) pb_ += peb[(s16 * 2 + kv) * 128 + hc];
                hid[hc] = siluf_(Pm[r0 + hc] + Pm[r1 + 128 + hc] + pb_); }
        }
        __syncthreads();
        if (ok) {
            float o0 = 0.f, o1 = 0.f;
            if (n < 127) { const float* w2 = W2L + kv * 8192 + lane;
#pragma unroll 8
                for (int hc = 0; hc < 128; hc += 2) { o0 += hid[hc] * w2[hc * 64]; o1 += hid[hc + 1] * w2[(hc + 1) * 64]; } }
            ((float*)(p->ws + WS_KC))[((((size_t)kv * 16 + bb) * 2 + gg) * 128 + n) * 64 + lane] = o0 + o1;
        }
        __syncthreads();
    }
}

__device__ __forceinline__ void hgrn_scan(unsigned char* smem, CP p, int L, int b, int h) {
    float* F = (float*)smem; float* Kx = F + 2048; float* Q = Kx + 2048; float* V = Q + 2048; float* PO = V + 2048;
    const int tid = tid_(), e = tid & 63, wv = tid >> 6, C = h * 64 + e;
    float lb;
    { const float* hl = p->in[I_HGLB]; const float a0 = hl[C], a1 = hl[512 + C], a2 = hl[1024 + C], a3 = hl[1536 + C];
      const float mx = fmaxf(fmaxf(a0, a1), fmaxf(a2, a3)); const float e0 = __expf(a0 - mx), e1 = __expf(a1 - mx), e2 = __expf(a2 - mx), e3 = __expf(a3 - mx);
      const float inv = 1.0f / (e0 + e1 + e2 + e3); float acc = 0.f; if (L >= 1) acc += e1; if (L >= 2) acc += e2; if (L >= 3) acc += e3; lb = fmaxf(acc * inv, 0.f); }
    const float ng = p->in[I_HGN][L * 512 + C];
    bf16_t* base = (bf16_t*)(p->ws + WS_PROJ) + (size_t)b * SEQ * PLD + C;
    f32x2 S0 = {0.f, 0.f}, S1 = {0.f, 0.f}, S2 = {0.f, 0.f}, S3 = {0.f, 0.f};
    bf16_t pz[4], pq[4], pi[4], pg[4];
#define HG_PREFETCH(T0) do { _Pragma("unroll") for (int i = 0; i < 4; ++i) { const bf16_t* row = base + (size_t)((T0) + wv * 4 + i) * PLD; \
        pz[i] = row[C_HF]; pq[i] = row[C_HQ]; pi[i] = row[C_HI]; pg[i] = row[C_HG]; } } while (0)
    HG_PREFETCH(0);
    for (int t0 = 0; t0 < SEQ; t0 += 32) {
        float gr[4];
#pragma unroll
        for (int i = 0; i < 4; ++i) { const int t = wv * 4 + i;
            const float z = bf2f(pz[i]), qr = bf2f(pq[i]), vi = bf2f(pi[i]); gr[i] = bf2f(pg[i]);
            const float sg = sigmoidf_(z); F[t * 64 + e] = sg + lb * (1.0f - sg); Kx[t * 64 + e] = (1.0f - lb) * (1.0f - sg); Q[t * 64 + e] = siluf_(qr); V[t * 64 + e] = vi; }
        __syncthreads();
        if (t0 + 32 < SEQ) HG_PREFETCH(t0 + 32);
#pragma unroll 4
        for (int t = 0; t < 32; ++t) {
            const f32x4 f0 = *(const f32x4*)(F + t * 64 + wv * 8), f1 = *(const f32x4*)(F + t * 64 + wv * 8 + 4);
            const f32x4 k0 = *(const f32x4*)(Kx + t * 64 + wv * 8), k1 = *(const f32x4*)(Kx + t * 64 + wv * 8 + 4);
            const f32x4 q0 = *(const f32x4*)(Q + t * 64 + wv * 8), q1 = *(const f32x4*)(Q + t * 64 + wv * 8 + 4);
            const float v = V[t * 64 + e]; const f32x2 vv = {v, v};
            S0 = (f32x2){f0[0], f0[1]} * S0 + (f32x2){k0[0], k0[1]} * vv; S1 = (f32x2){f0[2], f0[3]} * S1 + (f32x2){k0[2], k0[3]} * vv;
            S2 = (f32x2){f1[0], f1[1]} * S2 + (f32x2){k1[0], k1[1]} * vv; S3 = (f32x2){f1[2], f1[3]} * S3 + (f32x2){k1[2], k1[3]} * vv;
            f32x2 o2 = (f32x2){q0[0], q0[1]} * S0 + (f32x2){q0[2], q0[3]} * S1 + (f32x2){q1[0], q1[1]} * S2 + (f32x2){q1[2], q1[3]} * S3;
            PO[(t * 8 + wv) * 64 + e] = o2[0] + o2[1];
        }
        __syncthreads();
#pragma unroll
        for (int i = 0; i < 4; ++i) { const int t = wv * 4 + i;
            float o = 0.f;
#pragma unroll
            for (int q = 0; q < 8; ++q) o += PO[(t * 8 + q) * 64 + e];
            const float ss = wave_sum(o * o); const float rs = rsqrtf(ss * (1.0f / 64.0f) + 1e-6f);
            base[(size_t)(t0 + t) * PLD + C_HQ] = f2bf(o * rs * ng * siluf_(gr[i])); }
        __syncthreads();
    }
#undef HG_PREFETCH
}

DI float dpp_xor1(float v) { return __int_as_float(__builtin_amdgcn_mov_dpp(__float_as_int(v), 0xB1, 0xF, 0xF, true)); }
DI float dpp_xor2(float v) { return __int_as_float(__builtin_amdgcn_mov_dpp(__float_as_int(v), 0x4E, 0xF, 0xF, true)); }
DI float dpp_hmir(float v) { return __int_as_float(__builtin_amdgcn_mov_dpp(__float_as_int(v), 0x141, 0xF, 0xF, true)); }
DI float red8(float v) { v += dpp_xor1(v); v += dpp_xor2(v); v += dpp_hmir(v); return v; }

__device__ __forceinline__ void rwkv_scan(unsigned char* smem, CP p, int L, int b, int h) {
    constexpr int BUF_F = 6 * 2048 + 64 + 2048;
    const int tid = tid_(), c = tid & 63, wv = tid >> 6, C = h * 64 + c, lane = c;
    const float* mu = p->in[I_MU] + (size_t)L * 1792;
    const float mu_r = mu[C], mu_k = mu[512 + C], mu_v = mu[1024 + C];
    const float w0 = p->in[I_W0][L * 512 + C], a0 = p->in[I_A0][L * 512 + C];
    const float k_k = p->in[I_KK][L * 512 + C], k_a = p->in[I_KA][L * 512 + C], r_k = p->in[I_RK][L * 512 + C], ln_w = p->in[I_LNW][L * 512 + C], ln_b = p->in[I_LNB][L * 512 + C];
    const bf16_t* base = (const bf16_t*)(p->ws + WS_PROJ) + (size_t)b * SEQ * PLD + C_RW + C;
    const bf16_t* ewa = (const bf16_t*)(p->ws + WS_UN) + (size_t)b * SEQ * 1024 + C;
    bf16_t* obase = (bf16_t*)(p->ws + WS_ORW) + (size_t)b * SEQ * 512 + C;
    const int kp = lane & 7, vr = lane >> 3, vrow = wv * 8 + vr;
    f32x2 S0 = {0.f, 0.f}, S1 = {0.f, 0.f}, S2 = {0.f, 0.f}, S3 = {0.f, 0.f};
    bf16_t pr[4], pk[4], pv[4], pe[4], pa[4], pg[4], qr, qk, qv;
#define RW_PREFETCH(T0) do { const int s0_ = (T0) + wv * 4; \
        _Pragma("unroll") for (int i = 0; i < 4; ++i) { const bf16_t* row = base + (size_t)(s0_ + i) * PLD; pr[i] = row[0]; pk[i] = row[512]; pv[i] = row[1024]; \
            pe[i] = ewa[(size_t)(s0_ + i) * 1024]; pa[i] = ewa[(size_t)(s0_ + i) * 1024 + 512]; pg[i] = obase[(size_t)(s0_ + i) * 512]; } \
        if (s0_ > 0) { const bf16_t* row = base + (size_t)(s0_ - 1) * PLD; qr = row[0]; qk = row[512]; qv = row[1024]; } else { qr = 0; qk = 0; qv = 0; } } while (0)
    RW_PREFETCH(0);
    __syncthreads();
    for (int blk = 0; blk < SEQ / 32; ++blk) {
        float* Bf = (float*)smem + (blk & 1) * BUF_F;
        float* Wd = Bf; float* NKK = Bf + 2048; float* AB = Bf + 4096; float* KX = Bf + 6144; float* WR = Bf + 8192; float* VS = Bf + 10240; float* SC = Bf + 12288; float* YS = Bf + 12352;
        float bon[4], gv[4];
        { float rp = bf2f(qr), kq = bf2f(qk), vp = bf2f(qv);
#pragma unroll
          for (int i = 0; i < 4; ++i) { const int t = wv * 4 + i;
              const float r1 = bf2f(pr[i]), k1 = bf2f(pk[i]), v1 = bf2f(pv[i]);
              const float r = r1 + (rp - r1) * mu_r, k = k1 + (kq - k1) * mu_k, v = v1 + (vp - v1) * mu_v; rp = r1; kq = k1; vp = v1;
              const float decay = __expf(-0.6065306597f * sigmoidf_(w0 + bf2f(pe[i]))), a = sigmoidf_(a0 + bf2f(pa[i])); gv[i] = bf2f(pg[i]);
              const float kkv = k * k_k; const float ssq = wave_sum(kkv * kkv); const float kkn = kkv / fmaxf(sqrtf(ssq), 1e-12f);
              const float kx = k * (1.0f + (a - 1.0f) * k_a), ab = kkn * a;
              const float br = wave_sum(ab * r), kr = wave_sum(kx * r); bon[i] = wave_sum(r * kx * r_k);
              Wd[t * 64 + c] = decay; NKK[t * 64 + c] = -kkn; AB[t * 64 + c] = ab; KX[t * 64 + c] = kx; WR[t * 64 + c] = decay * r; VS[t * 64 + c] = v;
              if (c == 0) { SC[t * 2] = br; SC[t * 2 + 1] = kr; } } }
        __syncthreads();
        if (blk + 1 < SEQ / 32) RW_PREFETCH((blk + 1) * 32);
#define RW_LOAD(T, w0v, w1v, n0, n1, b0, b1, x0, x1, q0, q1, vv, sc) do { const int o_ = (T) * 64 + kp * 8; \
            w0v = *(const f32x4*)(Wd + o_); w1v = *(const f32x4*)(Wd + o_ + 4); n0 = *(const f32x4*)(NKK + o_); n1 = *(const f32x4*)(NKK + o_ + 4); \
            b0 = *(const f32x4*)(AB + o_); b1 = *(const f32x4*)(AB + o_ + 4); x0 = *(const f32x4*)(KX + o_); x1 = *(const f32x4*)(KX + o_ + 4); \
            q0 = *(const f32x4*)(WR + o_); q1 = *(const f32x4*)(WR + o_ + 4); vv = VS[(T) * 64 + vrow]; sc = *(const f32x2*)(SC + (T) * 2); } while (0)
        f32x4 cw0, cw1, cn0, cn1, cb0, cb1, cx0, cx1, cq0, cq1; float cvv; f32x2 csc;
        RW_LOAD(0, cw0, cw1, cn0, cn1, cb0, cb1, cx0, cx1, cq0, cq1, cvv, csc);
#pragma nounroll
        for (int t8 = 0; t8 < 4; ++t8) {
            float ykeep = 0.f;
#pragma unroll
            for (int j = 0; j < 8; ++j) {
                const int t = t8 * 8 + j;
                const f32x4 w0v = cw0, w1v = cw1, n0 = cn0, n1 = cn1, b0 = cb0, b1 = cb1, x0 = cx0, x1 = cx1, q0 = cq0, q1 = cq1; const float vv = cvv; const f32x2 sc = csc;
                { const int tn = (t + 1) & 31; RW_LOAD(tn, cw0, cw1, cn0, cn1, cb0, cb1, cx0, cx1, cq0, cq1, cvv, csc); }
                const f32x2 sa2 = S0 * (f32x2){n0[0], n0[1]} + S1 * (f32x2){n0[2], n0[3]} + S2 * (f32x2){n1[0], n1[1]} + S3 * (f32x2){n1[2], n1[3]};
                const f32x2 y2 = S0 * (f32x2){q0[0], q0[1]} + S1 * (f32x2){q0[2], q0[3]} + S2 * (f32x2){q1[0], q1[1]} + S3 * (f32x2){q1[2], q1[3]};
                float sa = sa2[0] + sa2[1], yy = y2[0] + y2[1];
                sa += dpp_xor1(sa); yy += dpp_xor1(yy); sa += dpp_xor2(sa); yy += dpp_xor2(yy); sa += dpp_hmir(sa); yy += dpp_hmir(yy);
                const f32x2 sav = {sa, sa}, vv2 = {vv, vv};
                S0 = S0 * (f32x2){w0v[0], w0v[1]} + sav * (f32x2){b0[0], b0[1]} + vv2 * (f32x2){x0[0], x0[1]};
                S1 = S1 * (f32x2){w0v[2], w0v[3]} + sav * (f32x2){b0[2], b0[3]} + vv2 * (f32x2){x0[2], x0[3]};
                S2 = S2 * (f32x2){w1v[0], w1v[1]} + sav * (f32x2){b1[0], b1[1]} + vv2 * (f32x2){x1[0], x1[1]};
                S3 = S3 * (f32x2){w1v[2], w1v[3]} + sav * (f32x2){b1[2], b1[3]} + vv2 * (f32x2){x1[2], x1[3]};
                const float y = yy + sa * sc[0] + vv * sc[1];
                ykeep = (kp == j) ? y : ykeep;
            }
            YS[(t8 * 8 + kp) * 64 + vrow] = ykeep;
        }
#undef RW_LOAD
        __syncthreads();
#pragma unroll
        for (int i = 0; i < 4; ++i) { const int t = wv * 4 + i;
            const float y = YS[t * 64 + c]; const float mean = wave_sum(y) * (1.0f / 64.0f); const float dlt = y - mean;
            const float var = wave_sum(dlt * dlt) * (1.0f / 64.0f);
            float yn = dlt * rsqrtf(var + 64e-5f) * ln_w + ln_b; yn += bon[i] * VS[t * 64 + c];
            obase[(size_t)(blk * 32 + t) * 512] = f2bf(yn * gv[i]); }
    }
#undef RW_PREFETCH
    __syncthreads();
}

DI int crow16(int i, int hl) { return (i & 3) + 8 * (i >> 2) + 4 * hl; }
__device__ __forceinline__ void rwkv_chunked(unsigned char* smem, CP p, int L, int b, int h) {
    bf16_t* ZB = (bf16_t*)smem;
    bf16_t* AR = (bf16_t*)(smem + 9216);
    bf16_t* BKt = (bf16_t*)(smem + 13824);
    bf16_t* UV = (bf16_t*)(smem + 18944);
    bf16_t* MT1 = (bf16_t*)(smem + 24064);
    bf16_t* MT2 = (bf16_t*)(smem + 25600);
    float* EW = (float*)(smem + 27136);
    bf16_t* BKr = (bf16_t*)(smem + 31232);
    float* Mf = (float*)(smem + 48640);
    float* Gs = (float*)(smem + 52864);
    float* YS = (float*)(smem + 57216);
    float* VS = (float*)(smem + 61312);
    float* PC = (float*)(smem + 65408);
    const int tid = tid_(), c = tid & 63, wv = tid >> 6, C = h * 64 + c, lane = c, qi = lane & 31, hl = lane >> 5;
    const float* mu = p->in[I_MU] + (size_t)L * 1792;
    const float mu_r = mu[C], mu_k = mu[512 + C], mu_v = mu[1024 + C];
    const float w0 = p->in[I_W0][L * 512 + C], a0 = p->in[I_A0][L * 512 + C];
    const float k_k = p->in[I_KK][L * 512 + C], k_a = p->in[I_KA][L * 512 + C], r_k = p->in[I_RK][L * 512 + C], ln_w = p->in[I_LNW][L * 512 + C], ln_b = p->in[I_LNB][L * 512 + C];
    const bf16_t* base = (const bf16_t*)(p->ws + WS_PROJ) + (size_t)b * SEQ * PLD + C_RW + C;
    const bf16_t* ewa = (const bf16_t*)(p->ws + WS_UN) + (size_t)b * SEQ * 1024 + C;
    bf16_t* obase = (bf16_t*)(p->ws + WS_ORW) + (size_t)b * SEQ * 512 + C;
    f32x16 zacc;
#pragma unroll
    for (int i = 0; i < 16; ++i) zacc[i] = 0.f;
    for (int i = tid; i < 64 * 72; i += 512) ZB[i] = 0;
    bf16_t pr[2], pk[2], pv[2], pe[2], pa[2], pg[2], qr, qk, qv;
#define RC_PREFETCH(T0) do { const int s0_ = (T0) + wv * 2; \
        _Pragma("unroll") for (int i = 0; i < 2; ++i) { const bf16_t* row = base + (size_t)(s0_ + i) * PLD; pr[i] = row[0]; pk[i] = row[512]; pv[i] = row[1024]; \
            pe[i] = ewa[(size_t)(s0_ + i) * 1024]; pa[i] = ewa[(size_t)(s0_ + i) * 1024 + 512]; pg[i] = obase[(size_t)(s0_ + i) * 512]; } \
        if (s0_ > 0) { const bf16_t* row = base + (size_t)(s0_ - 1) * PLD; qr = row[0]; qk = row[512]; qv = row[1024]; } else { qr = 0; qk = 0; qv = 0; } } while (0)
    RC_PREFETCH(0);
    __syncthreads();
    for (int ch = 0; ch < SEQ / 16; ++ch) {
        float bon[2], gv[2], r_[2], nk_[2], ab_[2], kx_[2], v_[2], ew_[2];
        { float rp = bf2f(qr), kq = bf2f(qk), vp = bf2f(qv);
#pragma unroll
          for (int i = 0; i < 2; ++i) { const int t = wv * 2 + i;
              const float r1 = bf2f(pr[i]), k1 = bf2f(pk[i]), v1 = bf2f(pv[i]);
              const float r = r1 + (rp - r1) * mu_r, k = k1 + (kq - k1) * mu_k, v = v1 + (vp - v1) * mu_v; rp = r1; kq = k1; vp = v1;
              const float ew = 0.6065306597f * sigmoidf_(w0 + bf2f(pe[i])), a = sigmoidf_(a0 + bf2f(pa[i])); gv[i] = bf2f(pg[i]);
              const float kkv = k * k_k; const float ssq = wave_sum(kkv * kkv); const float kkn = kkv * rsqrtf(fmaxf(ssq, 1e-24f));
              const float kx = k * (1.0f + (a - 1.0f) * k_a);
              bon[i] = wave_sum(r * kx * r_k);
              r_[i] = r; nk_[i] = kkn; ab_[i] = kkn * a; kx_[i] = kx; v_[i] = v; ew_[i] = ew; EW[t * 64 + c] = ew; } }
        __syncthreads();
        if (ch + 1 < SEQ / 16) RC_PREFETCH((ch + 1) * 16);
        { float ev[16];
#pragma unroll
          for (int j = 0; j < 16; ++j) ev[j] = EW[j * 64 + c];
#pragma unroll
          for (int i = 0; i < 2; ++i) { const int t = wv * 2 + i; float cum = 0.f;
#pragma unroll
            for (int j = 0; j < 16; ++j) cum += (j <= t) ? ev[j] : 0.f;
            const float Pt = __expf(-cum), Pm = __expf(-(cum - ew_[i])), iP = __expf(cum);
            const float al = -nk_[i] * Pm, rh = r_[i] * Pt, be = ab_[i] * iP, ka = kx_[i] * iP;
            AR[t * 72 + c] = f2bf(al); AR[(16 + t) * 72 + c] = f2bf(rh); BKr[t * 72 + c] = f2bf(be); BKr[(16 + t) * 72 + c] = f2bf(ka);
            BKt[c * 40 + t] = f2bf(be); BKt[c * 40 + 16 + t] = f2bf(ka);
            UV[c * 40 + 16 + t] = f2bf(v_[i]); VS[t * 64 + c] = v_[i];
            if (t == 15) PC[c] = Pt; } }
        __syncthreads();
        f32x16 acc;
#pragma unroll
        for (int i = 0; i < 16; ++i) acc[i] = 0.f;
        if (wv == 0) {
#pragma unroll
            for (int s = 0; s < 4; ++s) acc = MFMA32(*(const bf16x8*)(BKr + qi * 72 + 16 * s + 8 * hl), *(const bf16x8*)(AR + qi * 72 + 16 * s + 8 * hl), acc);
#pragma unroll
            for (int i = 0; i < 16; ++i) { const int j = crow16(i, hl), n = qi; const float m = acc[i];
                if (j < 16) { if (n < 16) Mf[j * 17 + n] = m; MT2[n * 24 + j] = f2bf((n >= 16 && j <= n - 16) ? m : 0.f); }
                else { const int i2 = j - 16; const bool k1 = n < 16 ? (i2 < n) : (i2 <= n - 16); MT1[n * 24 + i2] = f2bf(k1 ? m : 0.f); } }
        } else if (wv < 3) {
            const int vb = wv - 1;
#pragma unroll
            for (int s = 0; s < 4; ++s) acc = MFMA32(*(const bf16x8*)(ZB + (32 * vb + qi) * 72 + 16 * s + 8 * hl), *(const bf16x8*)(AR + qi * 72 + 16 * s + 8 * hl), acc);
        }
        __syncthreads();
        if (wv == 1 || wv == 2) { const int vb = wv - 1;
            acc = MFMA32(*(const bf16x8*)(UV + (32 * vb + qi) * 40 + 16 + 8 * hl), *(const bf16x8*)(MT1 + qi * 24 + 8 * hl), acc);
            if (qi < 16) {
#pragma unroll
                for (int i = 0; i < 16; ++i) Gs[(32 * vb + crow16(i, hl)) * 17 + qi] = acc[i]; }
        }
        __syncthreads();
        if (wv == 0) {
            float u[16], cur[16], nxt[16], gcur, gnxt = 0.f;
#pragma unroll
            for (int i = 0; i < 16; ++i) { cur[i] = 0.f; nxt[i] = 0.f; }
            gcur = Gs[lane * 17];
#pragma unroll
            for (int t = 0; t < 16; ++t) {
                if (t + 1 < 16) { gnxt = Gs[lane * 17 + t + 1];
#pragma unroll
                    for (int i = 0; i <= t; ++i) nxt[i] = Mf[i * 17 + t + 1]; }
                float x0 = gcur, x1 = 0.f;
#pragma unroll
                for (int i = 0; i < t; ++i) { if (i & 1) x1 += u[i] * cur[i]; else x0 += u[i] * cur[i]; }
                u[t] = x0 + x1; UV[lane * 40 + t] = f2bf(u[t]);
#pragma unroll
                for (int i = 0; i < 16; ++i) cur[i] = nxt[i];
                gcur = gnxt; }
        }
        __syncthreads();
        if (wv == 1 || wv == 2) { const int vb = wv - 1;
            acc = MFMA32(*(const bf16x8*)(UV + (32 * vb + qi) * 40 + 8 * hl), *(const bf16x8*)(MT2 + qi * 24 + 8 * hl), acc);
            if (qi >= 16) {
#pragma unroll
                for (int i = 0; i < 16; ++i) YS[(qi - 16) * 64 + 32 * vb + crow16(i, hl)] = acc[i]; }
        }
        if (wv >= 4) { const int vb = (wv >> 1) & 1, kb = wv & 1;
#pragma unroll
            for (int s = 0; s < 2; ++s) zacc = MFMA32(*(const bf16x8*)(UV + (32 * vb + qi) * 40 + 16 * s + 8 * hl), *(const bf16x8*)(BKt + (32 * kb + qi) * 40 + 16 * s + 8 * hl), zacc);
            const float pc = PC[32 * kb + qi];
#pragma unroll
            for (int i = 0; i < 16; ++i) { zacc[i] *= pc; ZB[(32 * vb + crow16(i, hl)) * 72 + 32 * kb + qi] = f2bf(zacc[i]); }
        }
        __syncthreads();
#pragma unroll
        for (int i = 0; i < 2; ++i) { const int t = wv * 2 + i;
            const float y = YS[t * 64 + c]; const float mean = wave_sum(y) * (1.0f / 64.0f); const float dlt = y - mean;
            const float var = wave_sum(dlt * dlt) * (1.0f / 64.0f);
            float yn = dlt * rsqrtf(var + 64e-5f) * ln_w + ln_b; yn += bon[i] * VS[t * 64 + c];
            obase[(size_t)(ch * 16 + t) * 512] = f2bf(yn * gv[i]); }
    }
#undef RC_PREFETCH
    __syncthreads();
}

constexpr int KTS = 72;
DI bf16x8 pack8(float a0, float a1, float a2, float a3, float a4, float a5, float a6, float a7) {
    u32x4 w; w.x = pack2(a0, a1); w.y = pack2(a2, a3); w.z = pack2(a4, a5); w.w = pack2(a6, a7); return __builtin_bit_cast(bf16x8, w); }
DI bf16x8 ld_vfrag(const bf16_t* vt, int off) { const u32x2 lo = *(const u32x2*)(vt + off), hi = *(const u32x2*)(vt + off + 8); u32x4 w; w.x = lo.x; w.y = lo.y; w.z = hi.x; w.w = hi.y; return __builtin_bit_cast(bf16x8, w); }

struct FlashState { f32x16 o0, o1; float m, l; };

DI void flash_update(FlashState& st, f32x16& sc0, f32x16& sc1, const bf16_t* VT, int vs, int qi, int hl) {
    const bf16x8 va0 = ld_vfrag(VT, qi * vs + 4 * hl), vb0 = ld_vfrag(VT, (32 + qi) * vs + 4 * hl);
    const bf16x8 va1 = ld_vfrag(VT, qi * vs + 32 + 4 * hl), vb1 = ld_vfrag(VT, (32 + qi) * vs + 32 + 4 * hl);
    asm volatile("" ::: "memory");
    float mt = -INFINITY;
#pragma unroll
    for (int i = 0; i < 16; ++i) mt = fmaxf(mt, fmaxf(sc0[i], sc1[i]));
    mt = fmaxf(mt, shfl_xor_(mt, 32, qi + 32 * hl));
    const float mnew = fmaxf(st.m, mt), muse = (mnew == -INFINITY) ? 0.f : mnew;
    const float alpha = __builtin_amdgcn_exp2f(st.m - muse);
    float ls = 0.f;
#pragma unroll
    for (int i = 0; i < 16; ++i) { sc0[i] = __builtin_amdgcn_exp2f(sc0[i] - muse); sc1[i] = __builtin_amdgcn_exp2f(sc1[i] - muse); ls += sc0[i] + sc1[i]; }
    st.l = st.l * alpha + ls; st.m = mnew;
    st.o0 *= alpha; st.o1 *= alpha;
    {
        const bf16x8 p0 = pack8(sc0[0], sc0[1], sc0[2], sc0[3], sc0[4], sc0[5], sc0[6], sc0[7]);
        const bf16x8 p1 = pack8(sc1[0], sc1[1], sc1[2], sc1[3], sc1[4], sc1[5], sc1[6], sc1[7]);
        const bf16x8 wa0 = ld_vfrag(VT, qi * vs + 16 + 4 * hl), wb0 = ld_vfrag(VT, (32 + qi) * vs + 16 + 4 * hl);
        const bf16x8 wa1 = ld_vfrag(VT, qi * vs + 48 + 4 * hl), wb1 = ld_vfrag(VT, (32 + qi) * vs + 48 + 4 * hl);
        st.o0 = MFMA32(va0, p0, st.o0); st.o1 = MFMA32(vb0, p0, st.o1); st.o0 = MFMA32(va1, p1, st.o0); st.o1 = MFMA32(vb1, p1, st.o1);
        const bf16x8 r0 = pack8(sc0[8], sc0[9], sc0[10], sc0[11], sc0[12], sc0[13], sc0[14], sc0[15]);
        const bf16x8 r1 = pack8(sc1[8], sc1[9], sc1[10], sc1[11], sc1[12], sc1[13], sc1[14], sc1[15]);
        st.o0 = MFMA32(wa0, r0, st.o0); st.o1 = MFMA32(wb0, r0, st.o1); st.o0 = MFMA32(wa1, r1, st.o0); st.o1 = MFMA32(wb1, r1, st.o1);
    }
}
DI void qk_tile(const bf16_t* KT, const bf16x8 (&qf)[4], int qi, int hl, f32x16& sc0, f32x16& sc1) {
#pragma unroll
    for (int i = 0; i < 16; ++i) { sc0[i] = 0.f; sc1[i] = 0.f; }
#pragma unroll
    for (int s = 0; s < 4; ++s) {
        const bf16x8 k0 = *(const bf16x8*)(KT + qi * KTS + 16 * s + 8 * hl), k1 = *(const bf16x8*)(KT + (32 + qi) * KTS + 16 * s + 8 * hl);
        sc0 = MFMA32(k0, qf[s], sc0); sc1 = MFMA32(k1, qf[s], sc1);
    }
}
struct KVRegs { u32x4 k, v; };
DI void kv_fetch(KVRegs& r, const bf16_t* pb, int kcol, int vcol, int k0) {
    const int tid = tid_();
    const unsigned ok_ = (unsigned)((k0 + (tid >> 3)) * PLD + kcol + (tid & 7) * 8) * 2u, ov_ = (unsigned)((k0 + (tid & 63)) * PLD + vcol + (tid >> 6) * 8) * 2u;
    r.k = *(const u32x4*)((const char*)pb + ok_);
    r.v = *(const u32x4*)((const char*)pb + ov_);
}
DI void kv_store(const KVRegs& r, bf16_t* KT, bf16_t* VT) {
    const int tid = tid_();
    *(u32x4*)(KT + (tid >> 3) * KTS + (tid & 7) * 8) = r.k;
    const int key = tid & 63, ch = tid >> 6;
#pragma unroll
    for (int j = 0; j < 8; ++j) VT[(ch * 8 + j) * KTS + key] = (bf16_t)((j & 1) ? (r.v[j >> 1] >> 16) : (r.v[j >> 1] & 0xFFFFu));
}
template <bool LUTB, bool CAUSAL, bool WHI, bool SEL>
DI void mask_tile(f32x16& sc0, f32x16& sc1, const float* lut, int qpos, int k0, int hl, bool sel, float qs) {
    const float bfar = lut[128];
#pragma unroll
    for (int g8 = 0; g8 < 2; ++g8) {
        float ba[8], bb[8];
#pragma unroll
        for (int j = 0; j < 8; ++j) { const int i = g8 * 8 + j, kl = (i & 3) + 8 * (i >> 2) + 4 * hl; const int da = qpos - (k0 + kl), db = da - 32;
            ba[j] = LUTB ? lut[da > 128 ? 128 : (da < 0 ? 0 : da)] : bfar; bb[j] = LUTB ? lut[db > 128 ? 128 : (db < 0 ? 0 : db)] : bfar; }
        if (LUTB) asm volatile("" ::: "memory");
#pragma unroll
        for (int j = 0; j < 8; ++j) { const int i = g8 * 8 + j, kl = (i & 3) + 8 * (i >> 2) + 4 * hl; const int da = qpos - (k0 + kl), db = da - 32;
            { const float v = sc0[i] * qs + ba[j]; bool ok = true; if (CAUSAL) ok = ok && da >= 0; if (WHI) ok = ok && da < 256; if (SEL) ok = ok && sel; sc0[i] = ok ? v : -INFINITY; }
            { const float v = sc1[i] * qs + bb[j]; bool ok = true; if (CAUSAL) ok = ok && db >= 0; if (WHI) ok = ok && db < 256; if (SEL) ok = ok && sel; sc1[i] = ok ? v : -INFINITY; } }
    }
}

__device__ __forceinline__ void nsa_item(unsigned char* smem, CP p, int L, int b, int g, int qb, int ocol) {
    bf16_t* KT = (bf16_t*)smem;
    bf16_t* VT = (bf16_t*)(smem + 9216);
    float* LUT = (float*)(smem + 18432);
    unsigned* SELM = (unsigned*)(smem + 20736);
    unsigned* ORM = (unsigned*)(smem + 20992);
    float* PA = (float*)(smem + 21504);
    float* PBv = (float*)(smem + 54272);
    bf16_t* KT2 = (bf16_t*)(smem + 87040);
    bf16_t* VT2 = (bf16_t*)(smem + 105472);
    const int tid = tid_(), lane = tid & 63, wv = tid >> 6, hh = wv >> 1, qhalf = wv & 1, qi = lane & 31, hl = lane >> 5;
    const int ql = qhalf * 32 + qi, qpos = qb * 64 + ql, head = g * 4 + hh;
    bf16_t* pb = (bf16_t*)(p->ws + WS_PROJ) + (size_t)b * SEQ * PLD;
    bf16_t* qrow = pb + (size_t)qpos * PLD;
    __syncthreads();
    for (int i = tid; i < 4 * 129; i += 512) { const int h2 = i / 129, dd = i % 129; int bk;
        if (dd < 16) bk = dd; else if (dd >= 128) bk = 31; else { bk = 16 + (int)(logf((float)dd / 16.0f) / 2.0794415416798357f * 16.0f); bk = bk > 31 ? 31 : bk; }
        LUT[h2 * 132 + dd] = p->in[I_RELB][bk * 8 + g * 4 + h2] * 1.4426950408889634f; }
    if (tid == 0) *ORM = 0u;
    if (tid < 64) SELM[tid] = 0u;
    if (tid < 256) PBv[tid * 32] = 0.f;
    { const float* kc = (const float*)(p->ws + WS_KC) + ((size_t)(0 * 16 + b) * 2 + g) * 128 * 64; const float* vc = (const float*)(p->ws + WS_KC) + ((size_t)(1 * 16 + b) * 2 + g) * 128 * 64;
      for (int i = tid; i < 128 * 64; i += 512) { const int n = i >> 6, d = i & 63; KT2[n * KTS + d] = f2bf(kc[i]); }
      for (int i = tid; i < 128 * 64; i += 512) { const int n = i & 127, d = i >> 7; VT2[d * 136 + n] = f2bf(vc[n * 64 + d]); } }
    bf16x8 qf[4];
#pragma unroll
    for (int s = 0; s < 4; ++s) qf[s] = *(const bf16x8*)(qrow + C_NQ + head * 64 + 16 * s + 8 * hl);
    float g0, g1, g2;
    { const bf16_t* gp = qrow + C_NG + head * 3; g0 = sigmoidf_(bf2f(gp[0])); g1 = sigmoidf_(bf2f(gp[1])); g2 = sigmoidf_(bf2f(gp[2])); }
    __syncthreads();
    const float* lut = LUT + hh * 132;
    constexpr float QS = 0.125f * 1.4426950408889634f;
    f32x16 fin0, fin1;
    {
        FlashState st;
#pragma unroll
        for (int i = 0; i < 16; ++i) { st.o0[i] = 0.f; st.o1[i] = 0.f; }
        st.m = -INFINITY; st.l = 0.f;
#pragma nounroll
        for (int t = 0; t < 2; ++t) {
            f32x16 sc0, sc1; qk_tile(KT2 + t * 64 * KTS, qf, qi, hl, sc0, sc1);
#pragma unroll
            for (int g8 = 0; g8 < 2; ++g8) { float ba[8], bb[8];
#pragma unroll
                for (int j = 0; j < 8; ++j) { const int i = g8 * 8 + j, kl = (i & 3) + 8 * (i >> 2) + 4 * hl; const int da = qpos - (16 * (64 * t + kl) + 31), db = da - 512;
                    ba[j] = lut[da > 128 ? 128 : (da < 0 ? 0 : da)]; bb[j] = lut[db > 128 ? 128 : (db < 0 ? 0 : db)]; }
                asm volatile("" ::: "memory");
#pragma unroll
                for (int j = 0; j < 8; ++j) { const int i = g8 * 8 + j, kl = (i & 3) + 8 * (i >> 2) + 4 * hl; const int na = 64 * t + kl, nb = na + 32; const int da = qpos - (16 * na + 31), db = da - 512;
                    sc0[i] = (da >= 0 && na < 127) ? sc0[i] * QS + ba[j] : -INFINITY; sc1[i] = (db >= 0 && nb < 127) ? sc1[i] * QS + bb[j] : -INFINITY; } }
            flash_update(st, sc0, sc1, VT2 + 64 * t, 136, qi, hl);
        }
        const float lt = st.l + shfl_xor_(st.l, 32, lane); const float inv = 1.0f / fmaxf(lt, 1e-30f);
        const float muse = (st.m == -INFINITY) ? 0.f : st.m;
        fin0 = st.o0 * (g0 * inv); fin1 = st.o1 * (g0 * inv);
#pragma nounroll
        for (int t = 0; t < 2; ++t) {
            f32x16 sc0, sc1; qk_tile(KT2 + t * 64 * KTS, qf, qi, hl, sc0, sc1);
#pragma unroll
            for (int g8 = 0; g8 < 2; ++g8) { float ba[8], bb[8];
#pragma unroll
                for (int j = 0; j < 8; ++j) { const int i = g8 * 8 + j, kl = (i & 3) + 8 * (i >> 2) + 4 * hl; const int da = qpos - (16 * (64 * t + kl) + 31), db = da - 512;
                    ba[j] = lut[da > 128 ? 128 : (da < 0 ? 0 : da)]; bb[j] = lut[db > 128 ? 128 : (db < 0 ? 0 : db)]; }
                asm volatile("" ::: "memory");
#pragma unroll
                for (int j = 0; j < 8; ++j) { const int i = g8 * 8 + j, kl = (i & 3) + 8 * (i >> 2) + 4 * hl; const int na = 64 * t + kl, nb = na + 32; const int da = qpos - (16 * na + 31), db = da - 512;
                    const float va = __builtin_amdgcn_exp2f(sc0[i] * QS + ba[j] - muse) * inv, vb = __builtin_amdgcn_exp2f(sc1[i] * QS + bb[j] - muse) * inv;
                    sc0[i] = (da >= 0 && na < 127) ? va : 0.f; sc1[i] = (db >= 0 && nb < 127) ? vb : 0.f; } }
#pragma unroll
            for (int i4 = 0; i4 < 4; ++i4) {
                { const int m = 16 * t + 2 * i4 + hl; PA[(hh * 64 + ql) * 32 + m] = sc0[4 * i4] + sc0[4 * i4 + 1] + sc0[4 * i4 + 2] + sc0[4 * i4 + 3]; PBv[(hh * 64 + ql) * 32 + m + 1] = sc0[4 * i4 + 3]; }
                { const int m = 16 * t + 8 + 2 * i4 + hl; PA[(hh * 64 + ql) * 32 + m] = sc1[4 * i4] + sc1[4 * i4 + 1] + sc1[4 * i4 + 2] + sc1[4 * i4 + 3]; if (m + 1 < 32) PBv[(hh * 64 + ql) * 32 + m + 1] = sc1[4 * i4 + 3]; }
            }
        }
    }
    __syncthreads();
    {
        float* IMP = (float*)smem;
        const int q = tid & 63, part = tid >> 6, cur = qb;
#pragma unroll
        for (int mm = 0; mm < 4; ++mm) { const int m = part * 4 + mm; float v;
            if (m == 0 || m == cur || m == cur - 1) v = INFINITY;
            else if (m <= cur) { v = 0.f; for (int h2 = 0; h2 < 4; ++h2) v += PA[(h2 * 64 + q) * 32 + m] + PBv[(h2 * 64 + q) * 32 + m]; }
            else v = -INFINITY;
            IMP[q * 33 + m] = v; }
        __syncthreads();
        unsigned bits = 0u;
#pragma unroll
        for (int mm = 0; mm < 4; ++mm) { const int m = part * 4 + mm; const float v = IMP[q * 33 + m]; int rank = 0;
            for (int m2 = 0; m2 < 32; ++m2) { const float v2 = IMP[q * 33 + m2]; rank += (v2 > v || (v2 == v && m2 < m)) ? 1 : 0; }
            if (rank < 8 && v > -INFINITY) bits |= 1u << m; }
        atomicOr(&SELM[q], bits); atomicOr(ORM, bits);
    }
    __syncthreads();
    const unsigned mysel = SELM[ql], orm = *ORM;
    __syncthreads();
    float* PARK = PA + (wv * 32) * 64 + lane;
#pragma unroll
    for (int i = 0; i < 16; ++i) { PARK[i * 64] = fin0[i]; PARK[(16 + i) * 64] = fin1[i]; }
    {
        FlashState st;
#pragma unroll
        for (int i = 0; i < 16; ++i) { st.o0[i] = 0.f; st.o1[i] = 0.f; }
        st.m = -INFINITY; st.l = 0.f;
        const unsigned todo = orm & (qb >= 31 ? 0xFFFFFFFFu : ((2u << qb) - 1u));
        KVRegs kr;
        int m = todo ? __builtin_ctz(todo) : -1;
        if (m >= 0) { kv_fetch(kr, pb, C_KS + g * 64, C_VS + g * 64, m * 64); __syncthreads(); kv_store(kr, KT, VT); __syncthreads(); }
        while (m >= 0) {
            const unsigned rest = todo & ~((2u << m) - 1u); const int nm = (m < 31 && rest) ? __builtin_ctz(rest) : -1;
            if (nm >= 0) kv_fetch(kr, pb, C_KS + g * 64, C_VS + g * 64, nm * 64);
            const bool sel = (mysel >> m) & 1u;
            if (__builtin_amdgcn_ballot_w64(sel) != 0ull) {
                f32x16 sc0, sc1; qk_tile(KT, qf, qi, hl, sc0, sc1);
                if (m + 3 <= qb) mask_tile<false, false, false, true>(sc0, sc1, lut, qpos, m * 64, hl, sel, QS);
                else mask_tile<true, true, false, true>(sc0, sc1, lut, qpos, m * 64, hl, sel, QS);
                flash_update(st, sc0, sc1, VT, KTS, qi, hl);
            }
            __syncthreads();
            if (nm >= 0) kv_store(kr, KT, VT);
            __syncthreads();
            m = nm;
        }
        const float lt = st.l + shfl_xor_(st.l, 32, lane); const float sc = g1 / fmaxf(lt, 1e-30f);
#pragma unroll
        for (int i = 0; i < 16; ++i) { PARK[i * 64] += st.o0[i] * sc; PARK[(16 + i) * 64] += st.o1[i] * sc; }
    }
    {
        FlashState st;
#pragma unroll
        for (int i = 0; i < 16; ++i) { st.o0[i] = 0.f; st.o1[i] = 0.f; }
        st.m = -INFINITY; st.l = 0.f;
        KVRegs kr;
        int w = qb >= 4 ? 0 : 4 - qb;
        kv_fetch(kr, pb, C_KW + g * 64, C_VW + g * 64, qb * 64 - 256 + 64 * w); __syncthreads(); kv_store(kr, KT, VT); __syncthreads();
        for (; w < 5; ++w) {
            const int k0 = qb * 64 - 256 + 64 * w;
            if (w < 4) kv_fetch(kr, pb, C_KW + g * 64, C_VW + g * 64, k0 + 64);
            f32x16 sc0, sc1; qk_tile(KT, qf, qi, hl, sc0, sc1);
            if (w == 0) mask_tile<false, false, true, false>(sc0, sc1, lut, qpos, k0, hl, true, QS);
            else if (w == 1) mask_tile<false, false, false, false>(sc0, sc1, lut, qpos, k0, hl, true, QS);
            else if (w < 4) mask_tile<true, false, false, false>(sc0, sc1, lut, qpos, k0, hl, true, QS);
            else mask_tile<true, true, false, false>(sc0, sc1, lut, qpos, k0, hl, true, QS);
            flash_update(st, sc0, sc1, VT, KTS, qi, hl);
            __syncthreads();
            if (w < 4) kv_store(kr, KT, VT);
            __syncthreads();
        }
        const float lt = st.l + shfl_xor_(st.l, 32, lane); const float sc = g2 / fmaxf(lt, 1e-30f);
#pragma unroll
        for (int i = 0; i < 16; ++i) { fin0[i] = PARK[i * 64] + st.o0[i] * sc; fin1[i] = PARK[(16 + i) * 64] + st.o1[i] * sc; }
    }
#pragma unroll
    for (int i4 = 0; i4 < 4; ++i4) {
        u32x2 w0; w0.x = pack2(fin0[4 * i4], fin0[4 * i4 + 1]); w0.y = pack2(fin0[4 * i4 + 2], fin0[4 * i4 + 3]);
        u32x2 w1; w1.x = pack2(fin1[4 * i4], fin1[4 * i4 + 1]); w1.y = pack2(fin1[4 * i4 + 2], fin1[4 * i4 + 3]);
        *(u32x2*)(qrow + ocol + head * 64 + 8 * i4 + 4 * hl) = w0;
        *(u32x2*)(qrow + ocol + head * 64 + 32 + 8 * i4 + 4 * hl) = w1;
    }
}

constexpr int PH_PER_LAYER = 15, PH_TOTAL = DEPTH * PH_PER_LAYER + 1;
enum { S_PREP = 0, S_GU1, S_D1, S_NORM_MIX, S_WIN, S_CMP, S_LORA, S_SCAN, S_MERGE, S_OUT, S_NORM2, S_GU2, S_D2, S_NORM_PLE, S_PLEG, S_FINAL };

__device__ __forceinline__ void run_phase(unsigned char* smem, CP p, int ph) {
    const bool fin = (ph == DEPTH * PH_PER_LAYER);
    const int L = fin ? 0 : ph / PH_PER_LAYER; const int sub = fin ? S_FINAL : ph % PH_PER_LAYER;
    unsigned char* ws = p->ws; float* H = p->out;
    bf16_t* W = (bf16_t*)(ws + WS_WBF); bf16_t* UN = (bf16_t*)(ws + WS_UN); bf16_t* PROJ = (bf16_t*)(ws + WS_PROJ); bf16_t* ACT = (bf16_t*)(ws + WS_ACT);
    bf16_t* TMP = (bf16_t*)(ws + WS_TMP); bf16_t* PBF = (bf16_t*)(ws + WS_PB); bf16_t* ORW = (bf16_t*)(ws + WS_ORW);
    bf16_t* XK = (bf16_t*)(ws + WS_XK); bf16_t* XV = (bf16_t*)(ws + WS_XV); float* P01 = (float*)(ws + WS_P01);
    if (sub == S_PREP) convert_layer_weights(smem, p, L);
    if (sub == S_NORM_MIX) convert_ffn2_weights(smem, p, L);
    if (sub == S_NORM2) cvt_f32_bf16(p->in[I_P] + (size_t)L * T_TOK * 256, PBF, (size_t)T_TOK * 256 / 4);
    if (sub == S_CMP) lora_act(p, L);
    if (sub == S_LORA) finalize_cmp(smem, p, L);
    if (sub == S_NORM_PLE) { EpiBf16<DM> e; e.O = TMP; run_gemm(smem, PBF, 256, W + E_PW, T_TOK, DM, 256, e); }
    if (sub == S_PREP || sub == S_NORM_MIX || sub == S_NORM2 || sub == S_NORM_PLE || sub == S_FINAL) {
        const float* hin = (sub == S_PREP && L == 0) ? p->in[I_X] : H; float* hcopy = (sub == S_PREP && L == 0) ? H : nullptr;
        const float* g = sub == S_PREP ? p->in[I_F1N] + L * DM : sub == S_NORM_MIX ? p->in[I_MIXN] + L * DM : sub == S_NORM2 ? p->in[I_F2N] + L * DM : sub == S_NORM_PLE ? p->in[I_PLEN] + L * DM : p->in[I_FINN];
        rmsnorm_rows(hin, hcopy, g, sub == S_FINAL ? nullptr : UN, sub == S_FINAL ? H : nullptr);
    } else if (sub == S_GU1 || sub == S_GU2) {
        EpiSwiglu e; e.O = ACT; run_gemm(smem, UN, DM, W + (sub == S_GU1 ? E_GU1 : E_GU2), T_TOK, 2 * DFF, DM, e);
    } else if (sub == S_D1 || sub == S_D2 || sub == S_OUT) {
        EpiResid e; e.H = H; e.scale = sub == S_OUT ? 1.0f : 0.5f;
        run_gemm(smem, sub == S_OUT ? UN : ACT, sub == S_OUT ? DM : DFF, W + (sub == S_D1 ? E_D1 : sub == S_D2 ? E_D2 : E_OUT), T_TOK, DM, sub == S_OUT ? DM : DFF, e);
    } else if (sub == S_WIN) {
        EpiProj e; e.O = PROJ; e.XK = XK; e.XV = XV; run_gemm(smem, UN, DM, W + E_IN, T_TOK, N_WIN, DM, e);
    } else if (sub == S_CMP) {
#pragma nounroll
        for (int kv = 0; kv < 2; ++kv) { EpiF32 e; e.C = P01 + (size_t)kv * 4096 * 256;
            run_gemm(smem, kv ? XV : XK, 1024, W + E_C1 + (size_t)kv * 256 * 1024, 4096, 256, 1024, e, kv ? 240 : 0); }
        { EpiBf16<PLD> e; e.O = PROJ + C_NG; run_gemm(smem, UN, DM, W + E_NG, T_TOK, 256, DM, e, 128); }
    } else if (sub == S_LORA) {
        EpiLora e; e.EWA = UN; e.G = ORW;
        run_gemm(smem, (const bf16_t*)(ws + WS_LACT), 256, W + E_LORA, T_TOK, 1536, 256, e);
    } else if (sub == S_SCAN) {
        for (int item = bid_(); item < 256; item += gridDim.x) {
            __syncthreads();
            if (item < 128) rwkv_chunked(smem, p, L, item >> 3, item & 7); else hgrn_scan(smem, p, L, (item - 128) >> 3, (item - 128) & 7);
        }
        unsigned* ctr = (unsigned*)(ws + 14336) + L * 64;
        volatile unsigned* slot = (volatile unsigned*)(smem + 141 * 1024);
        for (;;) {
            __syncthreads();
            if (tid_() == 0) *slot = __hip_atomic_fetch_add(ctr, 1u, __ATOMIC_RELAXED, __HIP_MEMORY_SCOPE_AGENT);
            __syncthreads();
            const unsigned idx = *slot;
            if (idx >= 1024u) break;
            const int bg = idx & 31, qb = 31 - (int)(idx >> 5);
            nsa_item(smem, p, L, bg >> 1, bg & 1, qb, C_NQ);
        }
    } else if (sub == S_MERGE) {
#pragma nounroll
        for (int j = 0; j < 3; ++j) { EpiMerge e; e.MRG = UN; e.PROJ = PROJ; e.J = j;
            const bf16_t* A = j == 0 ? PROJ + C_HQ : (j == 1 ? PROJ + C_NQ : ORW);
            run_gemm(smem, A, j == 2 ? 512 : PLD, W + E_BR + (size_t)j * 1024 * 512, T_TOK, DM, 512, e); }
    } else if (sub == S_PLEG) {
        EpiPleGate e; e.H = H; e.TMP = TMP; run_gemm(smem, UN, DM, W + E_PG, T_TOK, DM, DM, e);
    }
}

#define XB_TMO      128
#define XB_XCNT(j)  (256  + 64 * (j))
#define XB_XSUB(j)  (1280 + 64 * (j))
#define XB_XGEN(j)  (2304 + 64 * (j))
#define XB_TOP      3328
#define XB_TOPGEN   3392
#define XCD_BAR_WORDS 3456
#define XB_SPIN_CAP (1u << 20)
DI unsigned xb_ld(unsigned* p)              { return __hip_atomic_load(p, __ATOMIC_RELAXED, __HIP_MEMORY_SCOPE_AGENT); }
DI unsigned xb_add(unsigned* p, unsigned v) { return __hip_atomic_fetch_add(p, v, __ATOMIC_RELAXED, __HIP_MEMORY_SCOPE_AGENT); }
DI unsigned xb_xcc_id() { return (unsigned)__builtin_amdgcn_s_getreg((3 << 11) | 20) & 0xFu; }
#define XB_SPIN(cond, bar) do { unsigned _sp = 0; while (cond) { __builtin_amdgcn_s_sleep(1); \
    if ((++_sp & 255u) == 0u) { if (xb_ld(&(bar)[XB_TMO])) break; if (_sp > XB_SPIN_CAP) { atomicAdd(&(bar)[XB_TMO], 1u); break; } } } } while (0)
struct XcdBarrier { unsigned* bar; unsigned x; volatile LAS unsigned* st; };
DI XcdBarrier xcd_barrier_post(unsigned* bar, volatile LAS unsigned* st) {
    XcdBarrier b; b.bar = bar; b.x = xb_xcc_id(); b.st = st;
    if (threadIdx.x == 0) (void)xb_add(&bar[XB_XCNT(b.x)], 1u);
    return b;
}
DI void xcd_barrier_complete(unsigned* bar, unsigned x, unsigned& nloc, unsigned& nx) {
    const unsigned G = gridDim.x * gridDim.y * gridDim.z;
    unsigned sum, cnt, mine, sp = 0u;
    for (;;) {
        sum = 0u; cnt = 0u; mine = 0u;
#pragma unroll
        for (unsigned j = 0; j < 16; ++j) { const unsigned c = xb_ld(&bar[XB_XCNT(j)]); sum += c; cnt += (c > 0u) ? 1u : 0u; mine = (j == x) ? c : mine; }
        if (sum == G) break;
        __builtin_amdgcn_s_sleep(1);
        if ((++sp & 255u) == 0u) { if (xb_ld(&bar[XB_TMO])) break; if (sp > XB_SPIN_CAP) { atomicAdd(&bar[XB_TMO], 1u); break; } }
    }
    nloc = mine > 0u ? mine : 1u; nx = cnt > 0u ? cnt : 1u;
}
DI void xcd_barrier(const XcdBarrier& b) {
    asm volatile("s_waitcnt vmcnt(0)" ::: "memory");
    __syncthreads();
    if (threadIdx.x == 0) {
        unsigned* bar = b.bar;
        __builtin_amdgcn_s_waitcnt(0);
        unsigned nloc = b.st[0], nx = b.st[1];
        if (nloc == 0u) { xcd_barrier_complete(bar, b.x, nloc, nx); b.st[0] = nloc; b.st[1] = nx; }
        const unsigned old = xb_add(&bar[XB_XSUB(b.x)], 1u);
        const unsigned gen = old / nloc;
        if (old + 1u == (gen + 1u) * nloc) {
            __builtin_amdgcn_fence(__ATOMIC_RELEASE, "agent");
            asm volatile("s_waitcnt vmcnt(0)" ::: "memory");
            const unsigned og = xb_add(&bar[XB_TOP], 1u);
            const unsigned tg = og / nx;
            if (og + 1u == (tg + 1u) * nx) xb_add(&bar[XB_TOPGEN], 1u);
            else XB_SPIN(xb_ld(&bar[XB_TOPGEN]) == tg, bar);
            __builtin_amdgcn_fence(__ATOMIC_ACQUIRE, "agent");
            xb_add(&bar[XB_XGEN(b.x)], 1u);
            asm volatile("s_waitcnt vmcnt(0)" ::: "memory");
        } else {
            XB_SPIN(xb_ld(&bar[XB_XGEN(b.x)]) == gen, bar);
            __builtin_amdgcn_fence(__ATOMIC_ACQUIRE, "agent");
            asm volatile("s_waitcnt vmcnt(0)" ::: "memory");
        }
    }
    __syncthreads();
}

__global__ void __launch_bounds__(512, 2) mega_fwd(Params p) {
    extern __shared__ __attribute__((aligned(16))) unsigned char smem[];
    cg::grid_group grid = cg::this_grid();
    volatile LAS unsigned* xst = (volatile LAS unsigned*)(LAS unsigned char*)(smem + 140 * 1024);
    if (threadIdx.x == 0) { xst[0] = 0u; xst[1] = 0u; }
    __syncthreads();
    const XcdBarrier xb = xcd_barrier_post((unsigned*)(p.ws + WS_BAR), xst);
#ifndef PROBE_DUP
#define PROBE_DUP -1
#endif
    constexpr int IT_PER_LAYER = PH_PER_LAYER + (PROBE_DUP >= 0 ? 1 : 0);
    const int it_lo = p.ph_lo, it_hi = PROBE_DUP >= 0 ? DEPTH * IT_PER_LAYER + 1 : p.ph_hi;
    for (int it = it_lo; it < it_hi; ++it) {
        int ph = it;
        if (PROBE_DUP >= 0) { const int l_ = it / IT_PER_LAYER, r_ = it % IT_PER_LAYER; ph = l_ * PH_PER_LAYER + (r_ <= PROBE_DUP ? r_ : r_ - 1); }
        CP pp = (CP)__builtin_amdgcn_kernarg_segment_ptr(); asm volatile("" : "+s"(pp));
        run_phase(smem, pp, ph);
        if (it + 1 < it_hi) {
            if (it == it_lo) grid.sync();
            else xcd_barrier(xb);
        }
    }
}

#ifndef MULTI_LAUNCH
#define MULTI_LAUNCH 0
#endif

extern "C" void kernel_launch(void* const* d_in, const int* in_sizes, int n_in, void* d_out, int out_size, void* d_ws, size_t ws_size, hipStream_t stream) {
    static int grid = 0;
    if (grid == 0) {
        if (n_in != N_INPUTS || out_size != T_TOK * DM || ws_size < WS_END) { fprintf(stderr, "kernel_launch: unexpected shapes: n_in %d out %d ws %zu (need %zu)\n", n_in, out_size, ws_size, (size_t)WS_END); grid = -1; return; }
        int dev = 0, cus = 0, per_cu = 0;
        (void)hipGetDevice(&dev); (void)hipDeviceGetAttribute(&cus, hipDeviceAttributeMultiprocessorCount, dev);
        if (hipFuncSetAttribute((const void*)mega_fwd, hipFuncAttributeMaxDynamicSharedMemorySize, LDS_BYTES) != hipSuccess) { fprintf(stderr, "kernel_launch: hipFuncSetAttribute failed\n"); grid = -1; return; }
        if (hipOccupancyMaxActiveBlocksPerMultiprocessor(&per_cu, (const void*)mega_fwd, 512, LDS_BYTES) != hipSuccess || per_cu < 1) { fprintf(stderr, "kernel_launch: occupancy query gives %d\n", per_cu); per_cu = 1; }
        (void)hipGetLastError();
        grid = cus * 1;
        if (grid > 256) grid = 256;
        fprintf(stderr, "kernel_launch: grid %d (cus %d, per_cu %d)\n", grid, cus, per_cu);
    }
    if (grid < 0) return;
    (void)hipMemsetAsync(d_ws, 0, 16384, stream);
    Params p{};
    for (int i = 0; i < N_INPUTS; ++i) p.in[i] = (const float*)d_in[i];
    p.out = (float*)d_out; p.ws = (unsigned char*)d_ws;
#if MULTI_LAUNCH
    for (int ph = 0; ph < PH_TOTAL; ++ph) { p.ph_lo = ph; p.ph_hi = ph + 1; hipLaunchKernelGGL(mega_fwd, dim3(grid), dim3(512), LDS_BYTES, stream, p); }
#else
    p.ph_lo = 0; p.ph_hi = PH_TOTAL;
    void* args[] = {&p};
    hipError_t e = hipLaunchCooperativeKernel((const void*)mega_fwd, dim3(grid), dim3(512), args, LDS_BYTES, stream);
    if (e != hipSuccess) fprintf(stderr, "kernel_launch: cooperative launch failed: %s\n", hipGetErrorString(e));
#endif
}
```

```cpp
#include <hip/hip_runtime.h>
#include <hip/hip_cooperative_groups.h>
#include <cstdio>
namespace cg = cooperative_groups;

#define LAS __attribute__((address_space(3)))
#define DI __device__ __forceinline__
typedef unsigned short bf16_t;
typedef short bf16x8 __attribute__((ext_vector_type(8)));
typedef float f32x4 __attribute__((ext_vector_type(4)));
typedef float f32x2 __attribute__((ext_vector_type(2)));
typedef float f32x16 __attribute__((ext_vector_type(16)));
typedef unsigned u32x4 __attribute__((ext_vector_type(4)));
typedef unsigned u32x2 __attribute__((ext_vector_type(2)));

constexpr int T_TOK = 32768, SEQ = 2048, NB = 16, DM = 1024, DFF = 2816, DEPTH = 4;
constexpr int PLD = 8448;
constexpr int C_HQ = 0, C_HF = 512, C_HI = 1024, C_HG = 1536, C_NQ = 2048, C_KC = 2560, C_VC = 2688, C_KS = 2816, C_VS = 2944,
              C_KW = 3072, C_VW = 3200, C_RW = 3328, C_MG = 5120, C_NG = 8192, N_WIN = 8192, IN_COLS = 8216;
enum { I_X = 0, I_P, I_F1N, I_F1GU, I_F1D, I_MIXN, I_WIN, I_HGLB, I_HGN, I_PE, I_CW1, I_CW2, I_RELB, I_MU, I_W0, I_WB, I_A0, I_AB, I_GB,
       I_KK, I_KA, I_RK, I_LNW, I_LNB, I_WBR, I_WOUT, I_F2N, I_F2GU, I_F2D, I_PLEN, I_PLEG, I_PLEW, I_FINN, N_INPUTS };

constexpr size_t WS_BAR = 0;
constexpr size_t WS_PEB = 16384;
constexpr size_t WS_WBF = 32768;
constexpr size_t E_GU1 = 0, E_D1 = E_GU1 + 5632ull * 1024, E_IN = E_D1 + 1024ull * 2816, E_BR = E_IN + 8448ull * 1024, E_OUT = E_BR + 3ull * 1024 * 512,
                 E_GU2 = E_GU1, E_D2 = E_D1  , E_PG = E_OUT + 1024ull * 1024, E_PW = E_PG + 1024ull * 1024,
                 E_C1 = E_PW + 1024ull * 256, E_LORA = E_C1 + 2ull * 256 * 1024, E_NG = E_LORA + 1536ull * 256, E_END = E_NG + 256ull * 1024;
constexpr size_t WS_UN = WS_WBF + E_END * 2;
constexpr size_t WS_ORW = WS_UN + (size_t)T_TOK * 1024 * 2;
constexpr size_t WS_XK = WS_ORW + (size_t)T_TOK * 512 * 2;
constexpr size_t WS_XV = WS_XK + 4096ull * 1024 * 2;
constexpr size_t WS_P01 = WS_XV + 4096ull * 1024 * 2;
constexpr size_t WS_KC = WS_P01 + 2ull * 4096 * 256 * 4;
constexpr size_t WS_LACT = WS_KC + 2ull * 16 * 2 * 128 * 64 * 4;
constexpr size_t WS_PROJ = WS_LACT + (size_t)T_TOK * 256 * 2;
constexpr size_t WS_END = WS_PROJ + (size_t)T_TOK * PLD * 2;
constexpr size_t WS_ACT = WS_PROJ;
constexpr size_t WS_PB = WS_PROJ + 200ull * 1024 * 1024;
constexpr size_t WS_TMP = WS_PROJ + 256ull * 1024 * 1024;
constexpr int LDS_BYTES = 144 * 1024;

struct Params {
    const float* in[N_INPUTS];
    float* out;
    unsigned char* ws;
    int ph_lo, ph_hi;
};
typedef const Params __attribute__((address_space(4)))* CP;

DI int tid_() { int t = threadIdx.x; asm volatile("" : "+v"(t)); return t; }
DI int bid_() { int b = blockIdx.x; asm volatile("" : "+s"(b)); return b; }
typedef __bf16 bf16v2 __attribute__((ext_vector_type(2)));
DI float bf2f(bf16_t b) { return __uint_as_float(((unsigned)b) << 16); }
DI unsigned pack2(float lo, float hi) { const f32x2 v = {lo, hi}; return __builtin_bit_cast(unsigned, __builtin_convertvector(v, bf16v2)); }
DI bf16_t f2bf(float f) { return (bf16_t)(pack2(f, 0.f) & 0xFFFFu); }
DI float sigmoidf_(float x) { return __builtin_amdgcn_rcpf(1.0f + __builtin_amdgcn_exp2f(-1.4426950408889634f * x)); }
DI float siluf_(float x) { return x * __builtin_amdgcn_rcpf(1.0f + __builtin_amdgcn_exp2f(-1.4426950408889634f * x)); }
DI float shfl_xor_(float v, int mask, int lane) { return __int_as_float(__builtin_amdgcn_ds_bpermute((lane ^ mask) << 2, __float_as_int(v))); }
DI float dppf_(float v, int) { return v; }
#define DPPF(v, ctrl) __int_as_float(__builtin_amdgcn_mov_dpp(__float_as_int(v), ctrl, 0xF, 0xF, true))
DI float wave_sum(float v) {
    v += DPPF(v, 0xB1); v += DPPF(v, 0x4E); v += DPPF(v, 0x141); v += DPPF(v, 0x140);
    const float s0 = __int_as_float(__builtin_amdgcn_readlane(__float_as_int(v), 0)), s1 = __int_as_float(__builtin_amdgcn_readlane(__float_as_int(v), 16));
    const float s2 = __int_as_float(__builtin_amdgcn_readlane(__float_as_int(v), 32)), s3 = __int_as_float(__builtin_amdgcn_readlane(__float_as_int(v), 48));
    return (s0 + s1) + (s2 + s3);
}

#define MFMA32(a, b, c) __builtin_amdgcn_mfma_f32_32x32x16_bf16((a), (b), (c), 0, 0, 0)
namespace pg8 {
constexpr int BM = 256, BK = 64, HALF = 128, HTB = HALF * BK * 2, STAGE_BYTES = 8 * HTB, NXCD = 8, WGM = 8;
DI int lds_byte(int r, int c) { const int st = (r >> 4) * 2 + (c >> 5), rr = r & 15, cc = c & 31, ob = rr * 64 + cc * 2; return st * 1024 + (ob ^ (((ob >> 9) & 1) << 5)); }
DI void stage_rc(int b, int& R, int& C) { const int st = b / 1024, sb = b % 1024, swz = sb ^ (((sb >> 9) & 1) << 5); R = (st >> 1) * 16 + swz / 64; C = (st & 1) * 32 + (swz % 64) / 2; }
DI int perm32(int rho) { const int n = rho >> 4, i = rho & 15; return 8 * (i >> 2) + 4 * n + (i & 3); }
struct Unit { int pm, pn; };
struct Gemm { const bf16_t* A; const bf16_t* Bt; int M, N, K, lda; };
struct StaticOrder {
    int nM, nN, nwg, G, c;
    DI void init(int M, int N, int G_, int c_) { nM = M / BM; nN = N / BM; nwg = nM * nN; G = G_; c = c_; }
    DI bool next(int i, Unit& u) const {
        const long L = (long)i * G + c; if (L >= nwg) return false;
        int wgid = (int)L; { const int q = nwg / NXCD, r = nwg % NXCD, xcd = wgid % NXCD, off = wgid / NXCD; wgid = (xcd < r ? xcd * (q + 1) : r * (q + 1) + (xcd - r) * q) + off; }
        const int nig = WGM * nN, gid = wgid / nig, fm = gid * WGM, gsz = (nM - fm) < WGM ? (nM - fm) : WGM;
        u.pm = fm + ((wgid % nig) % gsz); u.pn = (wgid % nig) / gsz; return true;
    }
};

template <class Epi>
DI void gemm_phase(LAS unsigned char* lds, const Gemm g, const StaticOrder& S, const Epi& E) {
    int tid = tid_();
    const int wid = __builtin_amdgcn_readfirstlane(tid >> 6), lane = tid & 63, wr = wid >> 2, wc = wid & 3, fr = lane & 15, fq = lane >> 4;
    const int K = g.K, nt = K / BK, lda = g.lda;
    unsigned voffA[2], voffB[2];
#pragma unroll
    for (int i = 0; i < 2; ++i) { int R, C; stage_rc(tid * 16 + i * 8192, R, C); const int Rb = Epi::PERM ? ((R & ~31) + perm32(R & 31)) : R;
        voffA[i] = (unsigned)(R * lda + C) * 2u; voffB[i] = (unsigned)(Rb * K + C) * 2u; }
    const size_t kstep = (size_t)(BK * 2);
    const size_t hstepA = (size_t)HALF * lda * 2, hstepB = (size_t)HALF * K * 2;
    const size_t tstepA = 2 * hstepA, tstepB = 2 * hstepB;
    const unsigned ldsw = (unsigned)wid * 1024u;
    const int aoff = lds_byte(wr * 64 + fr, fq * 8), boff = lds_byte(wc * 32 + fr, fq * 8);
#define PG8_SA(b, h) (((b) * 2 + (h)) * HTB)
#define PG8_SB(b, h) ((4 + (b) * 2 + (h)) * HTB)
#define PG8_STAGE(bufoff, gbase, voff) do { _Pragma("unroll") for (int _i = 0; _i < 2; ++_i) \
        __builtin_amdgcn_global_load_lds((const unsigned*)((const char*)(gbase) + (voff)[_i]), (LAS unsigned*)(lds + (bufoff) + ldsw + _i * 8192), 16, 0, 0); } while (0)
#define PG8_LDA(dst, b, h) do { _Pragma("unroll") for (int m = 0; m < 4; ++m) _Pragma("unroll") for (int k = 0; k < 2; ++k) dst[m][k] = *(const LAS bf16x8*)(lds + PG8_SA(b, h) + aoff + m * 2048 + k * 1024); } while (0)
#define PG8_LDB(dst, b, h) do { _Pragma("unroll") for (int n = 0; n < 2; ++n) _Pragma("unroll") for (int k = 0; k < 2; ++k) dst[n][k] = *(const LAS bf16x8*)(lds + PG8_SB(b, h) + boff + n * 2048 + k * 1024); } while (0)
#define PG8_MMA(ai, bj, At, Bt) do { __builtin_amdgcn_s_setprio(1); _Pragma("unroll") for (int m = 0; m < 4; ++m) _Pragma("unroll") for (int n = 0; n < 2; ++n) _Pragma("unroll") for (int k = 0; k < 2; ++k) \
        acc[ai][bj][m][n] = __builtin_amdgcn_mfma_f32_16x16x32_bf16(Bt[n][k], At[m][k], acc[ai][bj][m][n], 0, 0, 0); __builtin_amdgcn_s_setprio(0); } while (0)
#define PG8_WAIT_V(n) asm volatile("s_waitcnt vmcnt(" #n ")" ::: "memory")
#define PG8_WAIT_L(n) asm volatile("s_waitcnt lgkmcnt(" #n ")" ::: "memory")
#define PG8_BAR __builtin_amdgcn_s_barrier()
#define PG8_SCHED __builtin_amdgcn_sched_barrier(0)
    Unit cur, nxt; int ui = 0;
    if (!S.next(0, cur)) return;
    f32x4 acc[2][2][4][2];
#pragma unroll
    for (int a = 0; a < 2; ++a)
#pragma unroll
        for (int b = 0; b < 2; ++b)
#pragma unroll
            for (int m = 0; m < 4; ++m)
#pragma unroll
                for (int n = 0; n < 2; ++n) acc[a][b][m][n] = (f32x4){0.f, 0.f, 0.f, 0.f};
    bf16x8 At[4][2], B0[2][2], B1[2][2];
    const char* cA = (const char*)g.A + (size_t)cur.pm * tstepA; const char* cB = (const char*)g.Bt + (size_t)cur.pn * tstepB;
    PG8_STAGE(PG8_SB(0, 0), cB, voffB); PG8_STAGE(PG8_SA(0, 0), cA, voffA); PG8_STAGE(PG8_SB(0, 1), cB + hstepB, voffB); PG8_STAGE(PG8_SA(0, 1), cA + hstepA, voffA);
    if (wr == 1) PG8_BAR;
    PG8_WAIT_V(4); PG8_BAR;
    PG8_STAGE(PG8_SB(1, 0), cB + kstep, voffB); PG8_STAGE(PG8_SA(1, 0), cA + kstep, voffA); PG8_STAGE(PG8_SB(1, 1), cB + hstepB + kstep, voffB);
    PG8_WAIT_V(6); PG8_BAR;
    for (;;) {
        const bool has_next = S.next(ui + 1, nxt);
        const char* nA = has_next ? (const char*)g.A + (size_t)nxt.pm * tstepA : cA; const char* nB = has_next ? (const char*)g.Bt + (size_t)nxt.pn * tstepB : cB;
        for (int t = 0; t < nt; t += 2) {
            const bool last = (t == nt - 2);
            const char* a1 = cA + (size_t)(t + 1) * kstep;
            const char* a2 = last ? nA : cA + (size_t)(t + 2) * kstep; const char* b2 = last ? nB : cB + (size_t)(t + 2) * kstep;
            const char* a3 = a2 + kstep; const char* b3 = b2 + kstep;
            PG8_LDB(B0, 0, 0); PG8_SCHED; PG8_LDA(At, 0, 0); PG8_STAGE(PG8_SA(1, 1), a1 + hstepA, voffA);
            PG8_WAIT_L(8); PG8_BAR; PG8_WAIT_L(0); PG8_MMA(0, 0, At, B0); PG8_BAR; PG8_SCHED;
            PG8_LDB(B1, 0, 1); PG8_STAGE(PG8_SB(0, 0), b2, voffB);
            PG8_BAR; PG8_WAIT_L(0); PG8_MMA(0, 1, At, B1); PG8_BAR;
            PG8_LDA(At, 0, 1); PG8_STAGE(PG8_SA(0, 0), a2, voffA);
            PG8_BAR; PG8_WAIT_L(0); PG8_MMA(1, 0, At, B0); PG8_BAR; PG8_SCHED;
            PG8_STAGE(PG8_SB(0, 1), b2 + hstepB, voffB);
            PG8_WAIT_V(6); PG8_BAR; PG8_MMA(1, 1, At, B1); PG8_BAR;
            PG8_LDB(B0, 1, 0); PG8_SCHED; PG8_LDA(At, 1, 0); PG8_STAGE(PG8_SA(0, 1), a2 + hstepA, voffA);
            PG8_WAIT_L(8); PG8_BAR; PG8_WAIT_L(0); PG8_MMA(0, 0, At, B0); PG8_BAR; PG8_SCHED;
            PG8_LDB(B1, 1, 1); PG8_STAGE(PG8_SB(1, 0), b3, voffB);
            PG8_BAR; PG8_WAIT_L(0); PG8_MMA(0, 1, At, B1); PG8_BAR;
            PG8_LDA(At, 1, 1); PG8_STAGE(PG8_SA(1, 0), a3, voffA);
            PG8_BAR; PG8_WAIT_L(0); PG8_MMA(1, 0, At, B0); PG8_BAR; PG8_SCHED;
            PG8_STAGE(PG8_SB(1, 1), b3 + hstepB, voffB);
            PG8_WAIT_V(6); PG8_BAR; PG8_MMA(1, 1, At, B1); PG8_BAR;
        }
        E(acc, cur, wr, wc, fr, fq);
        if (!has_next) break;
#pragma unroll
        for (int a = 0; a < 2; ++a)
#pragma unroll
            for (int b = 0; b < 2; ++b)
#pragma unroll
                for (int m = 0; m < 4; ++m)
#pragma unroll
                    for (int n = 0; n < 2; ++n) acc[a][b][m][n] = (f32x4){0.f, 0.f, 0.f, 0.f};
        cur = nxt; cA = nA; cB = nB; ++ui;
    }
    PG8_WAIT_V(0);
    if (wr == 0) PG8_BAR;
    PG8_BAR;
#undef PG8_SA
#undef PG8_SB
#undef PG8_STAGE
#undef PG8_LDA
#undef PG8_LDB
#undef PG8_MMA
#undef PG8_WAIT_V
#undef PG8_WAIT_L
#undef PG8_BAR
#undef PG8_SCHED
}
}

typedef f32x4 AccT[2][2][4][2];
#define EPI_LANE const int t_ = tid_(), wid_ = t_ >> 6, ln_ = t_ & 63, wr_ = wid_ >> 2, wc_ = wid_ & 3, fr_ = ln_ & 15, fq_ = ln_ >> 4;
#define EPI_LOOP_PERM(...) EPI_LANE \
    const int row0 = u.pm * 256 + wr_ * 64 + fr_, col0 = u.pn * 256 + wc_ * 32 + 8 * fq_; \
    _Pragma("unroll") for (int ai = 0; ai < 2; ++ai) _Pragma("unroll") for (int m = 0; m < 4; ++m) { const int row = row0 + ai * 128 + m * 16; \
        _Pragma("unroll") for (int bj = 0; bj < 2; ++bj) { const int col = col0 + bj * 128; const f32x4 v0 = acc[ai][bj][m][0], v1 = acc[ai][bj][m][1]; __VA_ARGS__ } }
#define EPI_LOOP_NAT(...) EPI_LANE \
    const int row0 = u.pm * 256 + wr_ * 64 + fr_, col0 = u.pn * 256 + wc_ * 32 + 4 * fq_; \
    _Pragma("unroll") for (int ai = 0; ai < 2; ++ai) _Pragma("unroll") for (int m = 0; m < 4; ++m) { const int row = row0 + ai * 128 + m * 16; \
        _Pragma("unroll") for (int bj = 0; bj < 2; ++bj) _Pragma("unroll") for (int n = 0; n < 2; ++n) { const int col = col0 + bj * 128 + n * 16; const f32x4 v = acc[ai][bj][m][n]; __VA_ARGS__ } }

struct EpiSwiglu { static constexpr bool PERM = true; bf16_t* O;
    DI void operator()(const AccT& acc, const pg8::Unit& u, int wr, int wc, int fr, int fq) const {
        EPI_LOOP_PERM({ u32x2 w; w.x = pack2(siluf_(v0[0]) * v1[0], siluf_(v0[1]) * v1[1]); w.y = pack2(siluf_(v0[2]) * v1[2], siluf_(v0[3]) * v1[3]);
            *(u32x2*)(O + (size_t)row * DFF + (col >> 1)) = w; })
    } };
struct EpiResid { static constexpr bool PERM = false; float* H; float scale;
    DI void operator()(const AccT& acc, const pg8::Unit& u, int wr, int wc, int fr, int fq) const {
        EPI_LANE
        const int row0 = u.pm * 256 + wr_ * 64 + fr_, col0 = u.pn * 256 + wc_ * 32 + 4 * fq_;
#pragma unroll
        for (int ai = 0; ai < 2; ++ai) {
            f32x4 h[4][2][2];
#pragma unroll
            for (int m = 0; m < 4; ++m)
#pragma unroll
                for (int bj = 0; bj < 2; ++bj)
#pragma unroll
                    for (int n = 0; n < 2; ++n) h[m][bj][n] = *(const f32x4*)(H + (size_t)(row0 + ai * 128 + m * 16) * DM + col0 + bj * 128 + n * 16);
            asm volatile("" ::: "memory");
#pragma unroll
            for (int m = 0; m < 4; ++m)
#pragma unroll
                for (int bj = 0; bj < 2; ++bj)
#pragma unroll
                    for (int n = 0; n < 2; ++n) *(f32x4*)(H + (size_t)(row0 + ai * 128 + m * 16) * DM + col0 + bj * 128 + n * 16) = h[m][bj][n] + acc[ai][bj][m][n] * scale;
        }
    } };
struct EpiProj { static constexpr bool PERM = true; bf16_t* O; bf16_t* XK; bf16_t* XV;
    DI void operator()(const AccT& acc, const pg8::Unit& u, int wr, int wc, int fr, int fq) const {
        const bool is_mg = u.pn * 256 >= C_MG, is_cmp = (u.pn == 10);
        EPI_LOOP_PERM({ f32x4 a = v0, b = v1;
            if (is_mg) { for (int j = 0; j < 4; ++j) { a[j] = sigmoidf_(a[j]); b[j] = sigmoidf_(b[j]); } }
            u32x4 w; w.x = pack2(a[0], a[1]); w.y = pack2(a[2], a[3]); w.z = pack2(b[0], b[1]); w.w = pack2(b[2], b[3]);
            *(u32x4*)(O + (size_t)row * PLD + col) = w;
            if (is_cmp) { const int c = col - C_KC, kv = c >> 7, gg = (c >> 6) & 1, d = c & 63, bb = row >> 11, s = row & 2047, jj = s >> 4, l = s & 15;
                bf16_t* X = kv ? XV : XK; *(u32x4*)(X + ((size_t)((bb * 128 + jj) * 2 + gg)) * 1024 + l * 64 + d) = w; } })
    } };
struct EpiMerge { static constexpr bool PERM = true; bf16_t* MRG; const bf16_t* PROJ; int J;
    DI void operator()(const AccT& acc, const pg8::Unit& u, int wr, int wc, int fr, int fq) const {
        EPI_LANE
        const int row0 = u.pm * 256 + wr_ * 64 + fr_, col0 = u.pn * 256 + wc_ * 32 + 8 * fq_;
#pragma unroll
        for (int ai = 0; ai < 2; ++ai) {
                u32x4 gt[8], old[8];
#pragma unroll
                for (int q = 0; q < 8; ++q) { const int m = q & 3, bj = q >> 2; const int row = row0 + ai * 128 + m * 16, col = col0 + bj * 128;
                    gt[q] = *(const u32x4*)(PROJ + (size_t)row * PLD + C_MG + J * 1024 + col);
                    old[q] = (u32x4){0u, 0u, 0u, 0u}; if (J > 0) old[q] = *(const u32x4*)(MRG + (size_t)row * DM + col); }
                asm volatile("" ::: "memory");
#pragma unroll
                for (int q = 0; q < 8; ++q) { const int m = q & 3, bj = q >> 2; const int row = row0 + ai * 128 + m * 16, col = col0 + bj * 128; const f32x4 v0 = acc[ai][bj][m][0], v1 = acc[ai][bj][m][1];
                    float r[8]; const float x[8] = {v0[0], v0[1], v0[2], v0[3], v1[0], v1[1], v1[2], v1[3]};
#pragma unroll
                    for (int j = 0; j < 8; ++j) { const unsigned gw = gt[q][j >> 1], ow = old[q][j >> 1];
                        const float gf = (j & 1) ? __uint_as_float(gw & 0xFFFF0000u) : __uint_as_float(gw << 16);
                        const float of = (j & 1) ? __uint_as_float(ow & 0xFFFF0000u) : __uint_as_float(ow << 16);
                        r[j] = of + gf * x[j]; }
                    u32x4 w; w.x = pack2(r[0], r[1]); w.y = pack2(r[2], r[3]); w.z = pack2(r[4], r[5]); w.w = pack2(r[6], r[7]);
                    *(u32x4*)(MRG + (size_t)row * DM + col) = w; }
            }
    } };
struct EpiF32 { static constexpr bool PERM = false; float* C; static constexpr int ldc = 256;
    DI void operator()(const AccT& acc, const pg8::Unit& u, int wr, int wc, int fr, int fq) const {
        EPI_LOOP_NAT({ *(f32x4*)(C + (size_t)row * ldc + col) = v; })
    } };
template <int LDC> struct EpiBf16 { static constexpr bool PERM = true; bf16_t* O; static constexpr int ldc = LDC;
    DI void operator()(const AccT& acc, const pg8::Unit& u, int wr, int wc, int fr, int fq) const {
        EPI_LOOP_PERM({ u32x4 w; w.x = pack2(v0[0], v0[1]); w.y = pack2(v0[2], v0[3]); w.z = pack2(v1[0], v1[1]); w.w = pack2(v1[2], v1[3]);
            *(u32x4*)(O + (size_t)row * ldc + col) = w; })
    } };
struct EpiPleGate { static constexpr bool PERM = false; float* H; const bf16_t* TMP;
    DI void operator()(const AccT& acc, const pg8::Unit& u, int wr, int wc, int fr, int fq) const {
        EPI_LANE
        const int row0 = u.pm * 256 + wr_ * 64 + fr_, col0 = u.pn * 256 + wc_ * 32 + 4 * fq_;
#pragma unroll
        for (int ai = 0; ai < 2; ++ai)
#pragma unroll
            for (int mp = 0; mp < 2; ++mp) {
                f32x4 h[2][2][2]; u32x2 tw[2][2][2];
#pragma unroll
                for (int mm = 0; mm < 2; ++mm)
#pragma unroll
                    for (int bj = 0; bj < 2; ++bj)
#pragma unroll
                        for (int n = 0; n < 2; ++n) { const size_t o_ = (size_t)(row0 + ai * 128 + (2 * mp + mm) * 16) * DM + col0 + bj * 128 + n * 16;
                            h[mm][bj][n] = *(const f32x4*)(H + o_); tw[mm][bj][n] = *(const u32x2*)(TMP + o_); }
                asm volatile("" ::: "memory");
#pragma unroll
                for (int mm = 0; mm < 2; ++mm)
#pragma unroll
                    for (int bj = 0; bj < 2; ++bj)
#pragma unroll
                        for (int n = 0; n < 2; ++n) { const size_t o_ = (size_t)(row0 + ai * 128 + (2 * mp + mm) * 16) * DM + col0 + bj * 128 + n * 16;
                            const f32x4 v = acc[ai][bj][2 * mp + mm][n]; f32x4 o = h[mm][bj][n]; const u32x2 t = tw[mm][bj][n];
                            o[0] += sigmoidf_(v[0]) * __uint_as_float(t.x << 16); o[1] += sigmoidf_(v[1]) * __uint_as_float(t.x & 0xFFFF0000u);
                            o[2] += sigmoidf_(v[2]) * __uint_as_float(t.y << 16); o[3] += sigmoidf_(v[3]) * __uint_as_float(t.y & 0xFFFF0000u);
                            *(f32x4*)(H + o_) = o; }
            }
    } };
struct EpiLora { static constexpr bool PERM = true; bf16_t* EWA; bf16_t* G;
    DI void operator()(const AccT& acc, const pg8::Unit& u, int wr, int wc, int fr, int fq) const {
        const bool isg = u.pn >= 4; bf16_t* O = isg ? G - 1024 : EWA; const int ld = isg ? 512 : 1024;
        EPI_LOOP_PERM({ u32x4 w; w.x = pack2(v0[0], v0[1]); w.y = pack2(v0[2], v0[3]); w.z = pack2(v1[0], v1[1]); w.w = pack2(v1[2], v1[3]);
            *(u32x4*)(O + (size_t)row * ld + col) = w; })
    } };

template <class Epi> DI void run_gemm(unsigned char* smem, const bf16_t* A, int lda, const bf16_t* Bt, int M, int N, int K, const Epi& E, int coff = 0) {
    __syncthreads();
    pg8::Gemm g; g.A = A; g.Bt = Bt; g.M = M; g.N = N; g.K = K; g.lda = lda;
    pg8::StaticOrder S; S.init(M, N, (int)gridDim.x, (bid_() + coff) % (int)gridDim.x);
    pg8::gemm_phase<Epi>((LAS unsigned char*)smem, g, S, E);
    __syncthreads();
}

struct MapId { DI int operator()(int n) const { return n; } };
struct MapGU { DI int operator()(int n) const { const int q = n >> 3, e = n & 7; return e < 4 ? 4 * q + e : DFF + 4 * q + (e - 4); } };
struct MapIn { DI int operator()(int n) const { return n < 3328 ? n : n + 24; } };
struct MapNg { DI int operator()(int n) const { return n < 24 ? 3328 + n : -1; } };
template <int TN, class Map> __device__ __forceinline__ void transpose_cvt_t(unsigned char* smem, const float* src, int ldsrc, bf16_t* dst, int K, int Nd, Map map, int& toff) {
    float* tile = (float*)smem;
    constexpr int RPP = 512 / TN;
    const int tid = tid_(), ntk = K / 64, nt = ntk * (Nd / TN);
    const int G = (int)gridDim.x, first = (bid_() + G - (toff % G)) % G;
    toff += nt;
    for (int t = first; t < nt; t += G) {
        const int n0 = (t / ntk) * TN, k0 = (t % ntk) * 64;
        const int nn = tid % TN, sc = map(n0 + nn);
#pragma unroll
        for (int p = 0; p < 64 / RPP; ++p) { const int kk = (tid / TN) + p * RPP; tile[kk * (TN + 1) + nn] = sc >= 0 ? src[(size_t)(k0 + kk) * ldsrc + sc] : 0.f; }
        __syncthreads();
#pragma unroll
        for (int p = 0; p < TN / 16; ++p) { const int nn2 = (tid >> 5) + p * 16, kk2 = (tid & 31) * 2;
            *(unsigned*)(dst + (size_t)(n0 + nn2) * K + k0 + kk2) = pack2(tile[kk2 * (TN + 1) + nn2], tile[(kk2 + 1) * (TN + 1) + nn2]); }
        __syncthreads();
    }
}
template <class Map> __device__ __forceinline__ void transpose_cvt(unsigned char* smem, const float* src, int ldsrc, bf16_t* dst, int K, int Nd, Map map, int& toff) {
    if ((Nd & 255) == 0) transpose_cvt_t<256>(smem, src, ldsrc, dst, K, Nd, map, toff); else transpose_cvt_t<64>(smem, src, ldsrc, dst, K, Nd, map, toff);
}
__device__ __forceinline__ void convert_layer_weights(unsigned char* smem, CP p, int L) {
    bf16_t* W = (bf16_t*)(p->ws + WS_WBF); int toff = 0;
    transpose_cvt(smem, p->in[I_F1GU] + (size_t)L * DM * 2 * DFF, 2 * DFF, W + E_GU1, DM, 2 * DFF, MapGU(), toff);
    transpose_cvt(smem, p->in[I_F1D] + (size_t)L * DFF * DM, DM, W + E_D1, DFF, DM, MapId(), toff);
    transpose_cvt(smem, p->in[I_WIN] + (size_t)L * DM * IN_COLS, IN_COLS, W + E_IN, DM, N_WIN, MapIn(), toff);
    transpose_cvt(smem, p->in[I_WIN] + (size_t)L * DM * IN_COLS, IN_COLS, W + E_NG, DM, 256, MapNg(), toff);
    for (int j = 0; j < 3; ++j) transpose_cvt(smem, p->in[I_WBR] + ((size_t)L * 3 + j) * 512 * DM, DM, W + E_BR + (size_t)j * 1024 * 512, 512, DM, MapId(), toff);
    transpose_cvt(smem, p->in[I_WOUT] + (size_t)L * DM * DM, DM, W + E_OUT, DM, DM, MapId(), toff);
    for (int i = bid_() * 512 + tid_(); i < 1536 * 256; i += gridDim.x * 512) { const int n = i >> 8, k = i & 255; float w = 0.f;
        if (n < 512) { if (k < 64) w = p->in[I_WB][((size_t)L * 64 + k) * 512 + n]; }
        else if (n < 1024) { if (k >= 64 && k < 128) w = p->in[I_AB][((size_t)L * 64 + (k - 64)) * 512 + (n - 512)]; }
        else { if (k >= 128) w = p->in[I_GB][((size_t)L * 128 + (k - 128)) * 512 + (n - 1024)]; }
        W[E_LORA + i] = f2bf(w); }
    transpose_cvt(smem, p->in[I_PLEG] + (size_t)L * DM * DM, DM, W + E_PG, DM, DM, MapId(), toff);
    transpose_cvt(smem, p->in[I_PLEW] + (size_t)L * 256 * DM, DM, W + E_PW, 256, DM, MapId(), toff);
    for (int kv = 0; kv < 2; ++kv) for (int hf = 0; hf < 2; ++hf)
        transpose_cvt(smem, p->in[I_CW1] + ((size_t)(L * 2 + kv) * 2048 + hf * 1024) * 128, 128, W + E_C1 + ((size_t)kv * 256 + hf * 128) * 1024, 1024, 128, MapId(), toff);
    { const int q = (int)gridDim.x - 1 - bid_(); const int tid = tid_();
      if (q >= 0 && q < 16 && tid < 256) {
        const int kv = tid >> 7, hc = tid & 127;
        const float* pe = p->in[I_PE] + (size_t)(L * 2 + kv) * 2048 + q * 128; const float* w1 = p->in[I_CW1] + ((size_t)(L * 2 + kv) * 2048 + q * 128) * 128 + hc;
        float s0 = 0.f, s1 = 0.f, s2 = 0.f, s3 = 0.f;
#pragma unroll 4
        for (int i = 0; i < 128; i += 4) { s0 += pe[i] * w1[(size_t)i * 128]; s1 += pe[i + 1] * w1[(size_t)(i + 1) * 128]; s2 += pe[i + 2] * w1[(size_t)(i + 2) * 128]; s3 += pe[i + 3] * w1[(size_t)(i + 3) * 128]; }
        ((float*)(p->ws + WS_PEB))[(q * 2 + kv) * 128 + hc] = (s0 + s1) + (s2 + s3);
      } }
}

__device__ __forceinline__ void convert_ffn2_weights(unsigned char* smem, CP p, int L) {
    bf16_t* W = (bf16_t*)(p->ws + WS_WBF); int toff = 0;
    transpose_cvt(smem, p->in[I_F2GU] + (size_t)L * DM * 2 * DFF, 2 * DFF, W + E_GU2, DM, 2 * DFF, MapGU(), toff);
    transpose_cvt(smem, p->in[I_F2D] + (size_t)L * DFF * DM, DM, W + E_D2, DFF, DM, MapId(), toff);
}
__device__ __forceinline__ void lora_act(CP p, int L) {
    const bf16_t* PROJ = (const bf16_t*)(p->ws + WS_PROJ); bf16_t* LACT = (bf16_t*)(p->ws + WS_LACT);
    const float* mu = p->in[I_MU] + (size_t)L * 1792 + 1536;
    const int stride = (int)gridDim.x * 512;
    for (int i = bid_() * 512 + tid_(); i < T_TOK * 32; i += 4 * stride) {
        u32x4 cur[4], prv[4];
#pragma unroll
        for (int k = 0; k < 4; ++k) { const int ii = i + k * stride; cur[k] = (u32x4){0u, 0u, 0u, 0u}; prv[k] = cur[k];
            if (ii < T_TOK * 32) { const int t = ii >> 5, j0 = (ii & 31) * 8; const bf16_t* row = PROJ + (size_t)t * PLD + C_RW + 1536 + j0;
                cur[k] = *(const u32x4*)row; if ((t & (SEQ - 1)) != 0) prv[k] = *(const u32x4*)(row - PLD); } }
        asm volatile("" ::: "memory");
#pragma unroll
        for (int k = 0; k < 4; ++k) { const int ii = i + k * stride;
            if (ii < T_TOK * 32) { const int t = ii >> 5, j0 = (ii & 31) * 8;
                const f32x4 m0 = *(const f32x4*)(mu + j0), m1 = *(const f32x4*)(mu + j0 + 4);
                float r[8];
#pragma unroll
                for (int e = 0; e < 8; ++e) { const float x1 = (e & 1) ? __uint_as_float(cur[k][e >> 1] & 0xFFFF0000u) : __uint_as_float(cur[k][e >> 1] << 16);
                    const float xp = (e & 1) ? __uint_as_float(prv[k][e >> 1] & 0xFFFF0000u) : __uint_as_float(prv[k][e >> 1] << 16);
                    float xm = x1 + (xp - x1) * (e < 4 ? m0[e & 3] : m1[e & 3]);
                    if (j0 < 64) xm = 2.0f * sigmoidf_(2.0f * xm) - 1.0f;
                    else if (j0 >= 128) xm = sigmoidf_(xm);
                    r[e] = xm; }
                u32x4 w; w.x = pack2(r[0], r[1]); w.y = pack2(r[2], r[3]); w.z = pack2(r[4], r[5]); w.w = pack2(r[6], r[7]);
                *(u32x4*)(LACT + (size_t)t * 256 + j0) = w; } }
    }
}

__device__ __forceinline__ void rmsnorm_rows(const float* hin, float* hcopy, const float* g, bf16_t* un, float* outf) {
    const int lane = tid_() & 63, gw = bid_() * 8 + (tid_() >> 6), nw = gridDim.x * 8;
    f32x4 gv[4];
#pragma unroll
    for (int i = 0; i < 4; ++i) gv[i] = *(const f32x4*)(g + lane * 4 + i * 256);
    f32x4 nx[2][4];
    int row0 = gw * 2;
    if (row0 < T_TOK) {
#pragma unroll
        for (int r = 0; r < 2; ++r)
#pragma unroll
            for (int i = 0; i < 4; ++i) nx[r][i] = *(const f32x4*)(hin + (size_t)(row0 + r) * DM + lane * 4 + i * 256); }
    for (; row0 < T_TOK; row0 += nw * 2) {
        f32x4 x[2][4]; float ss[2] = {0.f, 0.f};
#pragma unroll
        for (int r = 0; r < 2; ++r)
#pragma unroll
            for (int i = 0; i < 4; ++i) x[r][i] = nx[r][i];
        const int rown = row0 + nw * 2;
        if (rown < T_TOK) {
#pragma unroll
            for (int r = 0; r < 2; ++r)
#pragma unroll
                for (int i = 0; i < 4; ++i) nx[r][i] = *(const f32x4*)(hin + (size_t)(rown + r) * DM + lane * 4 + i * 256); }
        asm volatile("" ::: "memory");
#pragma unroll
        for (int r = 0; r < 2; ++r) {
#pragma unroll
            for (int i = 0; i < 4; ++i) ss[r] += x[r][i][0] * x[r][i][0] + x[r][i][1] * x[r][i][1] + x[r][i][2] * x[r][i][2] + x[r][i][3] * x[r][i][3];
            ss[r] = wave_sum(ss[r]); }
#pragma unroll
        for (int r = 0; r < 2; ++r) { const int row = row0 + r; const float rs = rsqrtf(ss[r] * (1.0f / DM) + 1e-6f);
#pragma unroll
            for (int i = 0; i < 4; ++i) {
                const f32x4 y = x[r][i] * rs * gv[i];
                if (hcopy) *(f32x4*)(hcopy + (size_t)row * DM + lane * 4 + i * 256) = x[r][i];
                if (un) { u32x2 w; w.x = pack2(y[0], y[1]); w.y = pack2(y[2], y[3]); *(u32x2*)(un + (size_t)row * DM + lane * 4 + i * 256) = w; }
                if (outf) *(f32x4*)(outf + (size_t)row * DM + lane * 4 + i * 256) = y;
            } }
    }
}
__device__ __forceinline__ void cvt_f32_bf16(const float* src, bf16_t* dst, size_t n4) {
    const size_t stride = (size_t)gridDim.x * 512;
    for (size_t i = (size_t)bid_() * 512 + tid_(); i < n4; i += 4 * stride) {
        f32x4 v[4];
#pragma unroll
        for (int k = 0; k < 4; ++k) { const size_t j = i + k * stride; if (j < n4) v[k] = *(const f32x4*)(src + j * 4); }
        asm volatile("" ::: "memory");
#pragma unroll
        for (int k = 0; k < 4; ++k) { const size_t j = i + k * stride; if (j < n4) { u32x2 w; w.x = pack2(v[k][0], v[k][1]); w.y = pack2(v[k][2], v[k][3]); *(u32x2*)(dst + j * 4) = w; } }
    }
}

__device__ __forceinline__ void finalize_cmp(unsigned char* smem, CP p, int L) {
    float* hid = (float*)smem + (tid_() >> 6) * 128;
    float* W2L = (float*)(smem + 4096);
    const int lane = tid_() & 63, gw = bid_() * 8 + (tid_() >> 6), nw = gridDim.x * 8;
    const float* peb = (const float*)(p->ws + WS_PEB);
    { const float* w2g = p->in[I_CW2] + (size_t)L * 2 * 128 * 64;
      for (int i = tid_(); i < 2 * 128 * 64 / 4; i += 512) *(f32x4*)(W2L + i * 4) = *(const f32x4*)(w2g + i * 4); }
    __syncthreads();
    const int total = 2 * 16 * 2 * 128, iters = (total + nw - 1) / nw;
    for (int it = 0; it < iters; ++it) {
        const int id = gw + it * nw; const bool ok = id < total;
        const int n = id & 127, gg = (id >> 7) & 1, bb = (id >> 8) & 15, kv = (id >> 12) & 1;
        if (ok && n < 127) {
            const float* Pm = (const float*)(p->ws + WS_P01) + (size_t)kv * 4096 * 256;
            const size_t r0 = (size_t)((bb * 128 + n) * 2 + gg) * 256, r1 = (size_t)((bb * 128 + n + 1) * 2 + gg) * 256;
#pragma unroll
            for (int q = 0; q < 2; ++q) { const int hc = lane + q * 64; float pb_ = 0.f; for (int s16 = 0; s16 < 16; ++s16) pb_ += peb[(s16 * 2 + kv) * 128 + hc];
                hid[hc] = siluf_(Pm[r0 + hc] + Pm[r1 + 128 + hc] + pb_); }
        }
        __syncthreads();
        if (ok) {
            float o0 = 0.f, o1 = 0.f;
            if (n < 127) { const float* w2 = W2L + kv * 8192 + lane;
#pragma unroll 8
                for (int hc = 0; hc < 128; hc += 2) { o0 += hid[hc] * w2[hc * 64]; o1 += hid[hc + 1] * w2[(hc + 1) * 64]; } }
            ((float*)(p->ws + WS_KC))[((((size_t)kv * 16 + bb) * 2 + gg) * 128 + n) * 64 + lane] = o0 + o1;
        }
        __syncthreads();
    }
}

__device__ __forceinline__ void hgrn_scan(unsigned char* smem, CP p, int L, int b, int h) {
    float* F = (float*)smem; float* Kx = F + 2048; float* Q = Kx + 2048; float* V = Q + 2048; float* PO = V + 2048;
    const int tid = tid_(), e = tid & 63, wv = tid >> 6, C = h * 64 + e;
    float lb;
    { const float* hl = p->in[I_HGLB]; const float a0 = hl[C], a1 = hl[512 + C], a2 = hl[1024 + C], a3 = hl[1536 + C];
      const float mx = fmaxf(fmaxf(a0, a1), fmaxf(a2, a3)); const float e0 = __expf(a0 - mx), e1 = __expf(a1 - mx), e2 = __expf(a2 - mx), e3 = __expf(a3 - mx);
      const float inv = 1.0f / (e0 + e1 + e2 + e3); float acc = 0.f; if (L >= 1) acc += e1; if (L >= 2) acc += e2; if (L >= 3) acc += e3; lb = fmaxf(acc * inv, 0.f); }
    const float ng = p->in[I_HGN][L * 512 + C];
    bf16_t* base = (bf16_t*)(p->ws + WS_PROJ) + (size_t)b * SEQ * PLD + C;
    f32x2 S0 = {0.f, 0.f}, S1 = {0.f, 0.f}, S2 = {0.f, 0.f}, S3 = {0.f, 0.f};
    bf16_t pz[4], pq[4], pi[4], pg[4];
#define HG_PREFETCH(T0) do { _Pragma("unroll") for (int i = 0; i < 4; ++i) { const bf16_t* row = base + (size_t)((T0) + wv * 4 + i) * PLD; \
        pz[i] = row[C_HF]; pq[i] = row[C_HQ]; pi[i] = row[C_HI]; pg[i] = row[C_HG]; } } while (0)
    HG_PREFETCH(0);
    for (int t0 = 0; t0 < SEQ; t0 += 32) {
        float gr[4];
#pragma unroll
        for (int i = 0; i < 4; ++i) { const int t = wv * 4 + i;
            const float z = bf2f(pz[i]), qr = bf2f(pq[i]), vi = bf2f(pi[i]); gr[i] = bf2f(pg[i]);
            const float sg = sigmoidf_(z); F[t * 64 + e] = sg + lb * (1.0f - sg); Kx[t * 64 + e] = (1.0f - lb) * (1.0f - sg); Q[t * 64 + e] = siluf_(qr); V[t * 64 + e] = vi; }
        __syncthreads();
        if (t0 + 32 < SEQ) HG_PREFETCH(t0 + 32);
#pragma unroll 4
        for (int t = 0; t < 32; ++t) {
            const f32x4 f0 = *(const f32x4*)(F + t * 64 + wv * 8), f1 = *(const f32x4*)(F + t * 64 + wv * 8 + 4);
            const f32x4 k0 = *(const f32x4*)(Kx + t * 64 + wv * 8), k1 = *(const f32x4*)(Kx + t * 64 + wv * 8 + 4);
            const f32x4 q0 = *(const f32x4*)(Q + t * 64 + wv * 8), q1 = *(const f32x4*)(Q + t * 64 + wv * 8 + 4);
            const float v = V[t * 64 + e]; const f32x2 vv = {v, v};
            S0 = (f32x2){f0[0], f0[1]} * S0 + (f32x2){k0[0], k0[1]} * vv; S1 = (f32x2){f0[2], f0[3]} * S1 + (f32x2){k0[2], k0[3]} * vv;
            S2 = (f32x2){f1[0], f1[1]} * S2 + (f32x2){k1[0], k1[1]} * vv; S3 = (f32x2){f1[2], f1[3]} * S3 + (f32x2){k1[2], k1[3]} * vv;
            f32x2 o2 = (f32x2){q0[0], q0[1]} * S0 + (f32x2){q0[2], q0[3]} * S1 + (f32x2){q1[0], q1[1]} * S2 + (f32x2){q1[2], q1[3]} * S3;
            PO[(t * 8 + wv) * 64 + e] = o2[0] + o2[1];
        }
        __syncthreads();
#pragma unroll
        for (int i = 0; i < 4; ++i) { const int t = wv * 4 + i;
            float o = 0.f;
#pragma unroll
            for (int q = 0; q < 8; ++q) o += PO[(t * 8 + q) * 64 + e];
            const float ss = wave_sum(o * o); const float rs = rsqrtf(ss * (1.0f / 64.0f) + 1e-6f);
            base[(size_t)(t0 + t) * PLD + C_HQ] = f2bf(o * rs * ng * siluf_(gr[i])); }
        __syncthreads();
    }
#undef HG_PREFETCH
}

DI float dpp_xor1(float v) { return __int_as_float(__builtin_amdgcn_mov_dpp(__float_as_int(v), 0xB1, 0xF, 0xF, true)); }
DI float dpp_xor2(float v) { return __int_as_float(__builtin_amdgcn_mov_dpp(__float_as_int(v), 0x4E, 0xF, 0xF, true)); }
DI float dpp_hmir(float v) { return __int_as_float(__builtin_amdgcn_mov_dpp(__float_as_int(v), 0x141, 0xF, 0xF, true)); }
DI float red8(float v) { v += dpp_xor1(v); v += dpp_xor2(v); v += dpp_hmir(v); return v; }

__device__ __forceinline__ void rwkv_scan(unsigned char* smem, CP p, int L, int b, int h) {
    constexpr int BUF_F = 6 * 2048 + 64 + 2048;
    const int tid = tid_(), c = tid & 63, wv = tid >> 6, C = h * 64 + c, lane = c;
    const float* mu = p->in[I_MU] + (size_t)L * 1792;
    const float mu_r = mu[C], mu_k = mu[512 + C], mu_v = mu[1024 + C];
    const float w0 = p->in[I_W0][L * 512 + C], a0 = p->in[I_A0][L * 512 + C];
    const float k_k = p->in[I_KK][L * 512 + C], k_a = p->in[I_KA][L * 512 + C], r_k = p->in[I_RK][L * 512 + C], ln_w = p->in[I_LNW][L * 512 + C], ln_b = p->in[I_LNB][L * 512 + C];
    const bf16_t* base = (const bf16_t*)(p->ws + WS_PROJ) + (size_t)b * SEQ * PLD + C_RW + C;
    const bf16_t* ewa = (const bf16_t*)(p->ws + WS_UN) + (size_t)b * SEQ * 1024 + C;
    bf16_t* obase = (bf16_t*)(p->ws + WS_ORW) + (size_t)b * SEQ * 512 + C;
    const int kp = lane & 7, vr = lane >> 3, vrow = wv * 8 + vr;
    f32x2 S0 = {0.f, 0.f}, S1 = {0.f, 0.f}, S2 = {0.f, 0.f}, S3 = {0.f, 0.f};
    bf16_t pr[4], pk[4], pv[4], pe[4], pa[4], pg[4], qr, qk, qv;
#define RW_PREFETCH(T0) do { const int s0_ = (T0) + wv * 4; \
        _Pragma("unroll") for (int i = 0; i < 4; ++i) { const bf16_t* row = base + (size_t)(s0_ + i) * PLD; pr[i] = row[0]; pk[i] = row[512]; pv[i] = row[1024]; \
            pe[i] = ewa[(size_t)(s0_ + i) * 1024]; pa[i] = ewa[(size_t)(s0_ + i) * 1024 + 512]; pg[i] = obase[(size_t)(s0_ + i) * 512]; } \
        if (s0_ > 0) { const bf16_t* row = base + (size_t)(s0_ - 1) * PLD; qr = row[0]; qk = row[512]; qv = row[1024]; } else { qr = 0; qk = 0; qv = 0; } } while (0)
    RW_PREFETCH(0);
    __syncthreads();
    for (int blk = 0; blk < SEQ / 32; ++blk) {
        float* Bf = (float*)smem + (blk & 1) * BUF_F;
        float* Wd = Bf; float* NKK = Bf + 2048; float* AB = Bf + 4096; float* KX = Bf + 6144; float* WR = Bf + 8192; float* VS = Bf + 10240; float* SC = Bf + 12288; float* YS = Bf + 12352;
        float bon[4], gv[4];
        { float rp = bf2f(qr), kq = bf2f(qk), vp = bf2f(qv);
#pragma unroll
          for (int i = 0; i < 4; ++i) { const int t = wv * 4 + i;
              const float r1 = bf2f(pr[i]), k1 = bf2f(pk[i]), v1 = bf2f(pv[i]);
              const float r = r1 + (rp - r1) * mu_r, k = k1 + (kq - k1) * mu_k, v = v1 + (vp - v1) * mu_v; rp = r1; kq = k1; vp = v1;
              const float decay = __expf(-0.6065306597f * sigmoidf_(w0 + bf2f(pe[i]))), a = sigmoidf_(a0 + bf2f(pa[i])); gv[i] = bf2f(pg[i]);
              const float kkv = k * k_k; const float ssq = wave_sum(kkv * kkv); const float kkn = kkv / fmaxf(sqrtf(ssq), 1e-12f);
              const float kx = k * (1.0f + (a - 1.0f) * k_a), ab = kkn * a;
              const float br = wave_sum(ab * r), kr = wave_sum(kx * r); bon[i] = wave_sum(r * kx * r_k);
              Wd[t * 64 + c] = decay; NKK[t * 64 + c] = -kkn; AB[t * 64 + c] = ab; KX[t * 64 + c] = kx; WR[t * 64 + c] = decay * r; VS[t * 64 + c] = v;
              if (c == 0) { SC[t * 2] = br; SC[t * 2 + 1] = kr; } } }
        __syncthreads();
        if (blk + 1 < SEQ / 32) RW_PREFETCH((blk + 1) * 32);
#define RW_LOAD(T, w0v, w1v, n0, n1, b0, b1, x0, x1, q0, q1, vv, sc) do { const int o_ = (T) * 64 + kp * 8; \
            w0v = *(const f32x4*)(Wd + o_); w1v = *(const f32x4*)(Wd + o_ + 4); n0 = *(const f32x4*)(NKK + o_); n1 = *(const f32x4*)(NKK + o_ + 4); \
            b0 = *(const f32x4*)(AB + o_); b1 = *(const f32x4*)(AB + o_ + 4); x0 = *(const f32x4*)(KX + o_); x1 = *(const f32x4*)(KX + o_ + 4); \
            q0 = *(const f32x4*)(WR + o_); q1 = *(const f32x4*)(WR + o_ + 4); vv = VS[(T) * 64 + vrow]; sc = *(const f32x2*)(SC + (T) * 2); } while (0)
        f32x4 cw0, cw1, cn0, cn1, cb0, cb1, cx0, cx1, cq0, cq1; float cvv; f32x2 csc;
        RW_LOAD(0, cw0, cw1, cn0, cn1, cb0, cb1, cx0, cx1, cq0, cq1, cvv, csc);
#pragma nounroll
        for (int t8 = 0; t8 < 4; ++t8) {
            float ykeep = 0.f;
#pragma unroll
            for (int j = 0; j < 8; ++j) {
                const int t = t8 * 8 + j;
                const f32x4 w0v = cw0, w1v = cw1, n0 = cn0, n1 = cn1, b0 = cb0, b1 = cb1, x0 = cx0, x1 = cx1, q0 = cq0, q1 = cq1; const float vv = cvv; const f32x2 sc = csc;
                { const int tn = (t + 1) & 31; RW_LOAD(tn, cw0, cw1, cn0, cn1, cb0, cb1, cx0, cx1, cq0, cq1, cvv, csc); }
                const f32x2 sa2 = S0 * (f32x2){n0[0], n0[1]} + S1 * (f32x2){n0[2], n0[3]} + S2 * (f32x2){n1[0], n1[1]} + S3 * (f32x2){n1[2], n1[3]};
                const f32x2 y2 = S0 * (f32x2){q0[0], q0[1]} + S1 * (f32x2){q0[2], q0[3]} + S2 * (f32x2){q1[0], q1[1]} + S3 * (f32x2){q1[2], q1[3]};
                float sa = sa2[0] + sa2[1], yy = y2[0] + y2[1];
                sa += dpp_xor1(sa); yy += dpp_xor1(yy); sa += dpp_xor2(sa); yy += dpp_xor2(yy); sa += dpp_hmir(sa); yy += dpp_hmir(yy);
                const f32x2 sav = {sa, sa}, vv2 = {vv, vv};
                S0 = S0 * (f32x2){w0v[0], w0v[1]} + sav * (f32x2){b0[0], b0[1]} + vv2 * (f32x2){x0[0], x0[1]};
                S1 = S1 * (f32x2){w0v[2], w0v[3]} + sav * (f32x2){b0[2], b0[3]} + vv2 * (f32x2){x0[2], x0[3]};
                S2 = S2 * (f32x2){w1v[0], w1v[1]} + sav * (f32x2){b1[0], b1[1]} + vv2 * (f32x2){x1[0], x1[1]};
                S3 = S3 * (f32x2){w1v[2], w1v[3]} + sav * (f32x2){b1[2], b1[3]} + vv2 * (f32x2){x1[2], x1[3]};
                const float y = yy + sa * sc[0] + vv * sc[1];
                ykeep = (kp == j) ? y : ykeep;
            }
            YS[(t8 * 8 + kp) * 64 + vrow] = ykeep;
        }
#undef RW_LOAD
        __syncthreads();
#pragma unroll
        for (int i = 0; i < 4; ++i) { const int t = wv * 4 + i;
            const float y = YS[t * 64 + c]; const float mean = wave_sum(y) * (1.0f / 64.0f); const float dlt = y - mean;
            const float var = wave_sum(dlt * dlt) * (1.0f / 64.0f);
            float yn = dlt * rsqrtf(var + 64e-5f) * ln_w + ln_b; yn += bon[i] * VS[t * 64 + c];
            obase[(size_t)(blk * 32 + t) * 512] = f2bf(yn * gv[i]); }
    }
#undef RW_PREFETCH
    __syncthreads();
}

DI int crow16(int i, int hl) { return (i & 3) + 8 * (i >> 2) + 4 * hl; }
__device__ __forceinline__ void rwkv_chunked(unsigned char* smem, CP p, int L, int b, int h) {
    bf16_t* ZB = (bf16_t*)smem;
    bf16_t* AR = (bf16_t*)(smem + 9216);
    bf16_t* BKt = (bf16_t*)(smem + 13824);
    bf16_t* UV = (bf16_t*)(smem + 18944);
    bf16_t* MT1 = (bf16_t*)(smem + 24064);
    bf16_t* MT2 = (bf16_t*)(smem + 25600);
    float* EW = (float*)(smem + 27136);
    bf16_t* BKr = (bf16_t*)(smem + 31232);
    float* Mf = (float*)(smem + 48640);
    float* Gs = (float*)(smem + 52864);
    float* YS = (float*)(smem + 57216);
    float* VS = (float*)(smem + 61312);
    float* PC = (float*)(smem + 65408);
    const int tid = tid_(), c = tid & 63, wv = tid >> 6, C = h * 64 + c, lane = c, qi = lane & 31, hl = lane >> 5;
    const float* mu = p->in[I_MU] + (size_t)L * 1792;
    const float mu_r = mu[C], mu_k = mu[512 + C], mu_v = mu[1024 + C];
    const float w0 = p->in[I_W0][L * 512 + C], a0 = p->in[I_A0][L * 512 + C];
    const float k_k = p->in[I_KK][L * 512 + C], k_a = p->in[I_KA][L * 512 + C], r_k = p->in[I_RK][L * 512 + C], ln_w = p->in[I_LNW][L * 512 + C], ln_b = p->in[I_LNB][L * 512 + C];
    const bf16_t* base = (const bf16_t*)(p->ws + WS_PROJ) + (size_t)b * SEQ * PLD + C_RW + C;
    const bf16_t* ewa = (const bf16_t*)(p->ws + WS_UN) + (size_t)b * SEQ * 1024 + C;
    bf16_t* obase = (bf16_t*)(p->ws + WS_ORW) + (size_t)b * SEQ * 512 + C;
    f32x16 zacc;
#pragma unroll
    for (int i = 0; i < 16; ++i) zacc[i] = 0.f;
    for (int i = tid; i < 64 * 72; i += 512) ZB[i] = 0;
    bf16_t pr[2], pk[2], pv[2], pe[2], pa[2], pg[2], qr, qk, qv;
#define RC_PREFETCH(T0) do { const int s0_ = (T0) + wv * 2; \
        _Pragma("unroll") for (int i = 0; i < 2; ++i) { const bf16_t* row = base + (size_t)(s0_ + i) * PLD; pr[i] = row[0]; pk[i] = row[512]; pv[i] = row[1024]; \
            pe[i] = ewa[(size_t)(s0_ + i) * 1024]; pa[i] = ewa[(size_t)(s0_ + i) * 1024 + 512]; pg[i] = obase[(size_t)(s0_ + i) * 512]; } \
        if (s0_ > 0) { const bf16_t* row = base + (size_t)(s0_ - 1) * PLD; qr = row[0]; qk = row[512]; qv = row[1024]; } else { qr = 0; qk = 0; qv = 0; } } while (0)
    RC_PREFETCH(0);
    __syncthreads();
    for (int ch = 0; ch < SEQ / 16; ++ch) {
        float bon[2], gv[2], r_[2], nk_[2], ab_[2], kx_[2], v_[2], ew_[2];
        { float rp = bf2f(qr), kq = bf2f(qk), vp = bf2f(qv);
#pragma unroll
          for (int i = 0; i < 2; ++i) { const int t = wv * 2 + i;
              const float r1 = bf2f(pr[i]), k1 = bf2f(pk[i]), v1 = bf2f(pv[i]);
              const float r = r1 + (rp - r1) * mu_r, k = k1 + (kq - k1) * mu_k, v = v1 + (vp - v1) * mu_v; rp = r1; kq = k1; vp = v1;
              const float ew = 0.6065306597f * sigmoidf_(w0 + bf2f(pe[i])), a = sigmoidf_(a0 + bf2f(pa[i])); gv[i] = bf2f(pg[i]);
              const float kkv = k * k_k; const float ssq = wave_sum(kkv * kkv); const float kkn = kkv * rsqrtf(fmaxf(ssq, 1e-24f));
              const float kx = k * (1.0f + (a - 1.0f) * k_a);
              bon[i] = wave_sum(r * kx * r_k);
              r_[i] = r; nk_[i] = kkn; ab_[i] = kkn * a; kx_[i] = kx; v_[i] = v; ew_[i] = ew; EW[t * 64 + c] = ew; } }
        __syncthreads();
        if (ch + 1 < SEQ / 16) RC_PREFETCH((ch + 1) * 16);
        { float ev[16];
#pragma unroll
          for (int j = 0; j < 16; ++j) ev[j] = EW[j * 64 + c];
#pragma unroll
          for (int i = 0; i < 2; ++i) { const int t = wv * 2 + i; float cum = 0.f;
#pragma unroll
            for (int j = 0; j < 16; ++j) cum += (j <= t) ? ev[j] : 0.f;
            const float Pt = __expf(-cum), Pm = __expf(-(cum - ew_[i])), iP = __expf(cum);
            const float al = -nk_[i] * Pm, rh = r_[i] * Pt, be = ab_[i] * iP, ka = kx_[i] * iP;
            AR[t * 72 + c] = f2bf(al); AR[(16 + t) * 72 + c] = f2bf(rh); BKr[t * 72 + c] = f2bf(be); BKr[(16 + t) * 72 + c] = f2bf(ka);
            BKt[c * 40 + t] = f2bf(be); BKt[c * 40 + 16 + t] = f2bf(ka);
            UV[c * 40 + 16 + t] = f2bf(v_[i]); VS[t * 64 + c] = v_[i];
            if (t == 15) PC[c] = Pt; } }
        __syncthreads();
        f32x16 acc;
#pragma unroll
        for (int i = 0; i < 16; ++i) acc[i] = 0.f;
        if (wv == 0) {
#pragma unroll
            for (int s = 0; s < 4; ++s) acc = MFMA32(*(const bf16x8*)(BKr + qi * 72 + 16 * s + 8 * hl), *(const bf16x8*)(AR + qi * 72 + 16 * s + 8 * hl), acc);
#pragma unroll
            for (int i = 0; i < 16; ++i) { const int j = crow16(i, hl), n = qi; const float m = acc[i];
                if (j < 16) { if (n < 16) Mf[j * 17 + n] = m; MT2[n * 24 + j] = f2bf((n >= 16 && j <= n - 16) ? m : 0.f); }
                else { const int i2 = j - 16; const bool k1 = n < 16 ? (i2 < n) : (i2 <= n - 16); MT1[n * 24 + i2] = f2bf(k1 ? m : 0.f); } }
        } else if (wv < 3) {
            const int vb = wv - 1;
#pragma unroll
            for (int s = 0; s < 4; ++s) acc = MFMA32(*(const bf16x8*)(ZB + (32 * vb + qi) * 72 + 16 * s + 8 * hl), *(const bf16x8*)(AR + qi * 72 + 16 * s + 8 * hl), acc);
        }
        __syncthreads();
        if (wv == 1 || wv == 2) { const int vb = wv - 1;
            acc = MFMA32(*(const bf16x8*)(UV + (32 * vb + qi) * 40 + 16 + 8 * hl), *(const bf16x8*)(MT1 + qi * 24 + 8 * hl), acc);
            if (qi < 16) {
#pragma unroll
                for (int i = 0; i < 16; ++i) Gs[(32 * vb + crow16(i, hl)) * 17 + qi] = acc[i]; }
        }
        __syncthreads();
        if (wv == 0) {
            float u[16], cur[16], nxt[16], gcur, gnxt = 0.f;
#pragma unroll
            for (int i = 0; i < 16; ++i) { cur[i] = 0.f; nxt[i] = 0.f; }
            gcur = Gs[lane * 17];
#pragma unroll
            for (int t = 0; t < 16; ++t) {
                if (t + 1 < 16) { gnxt = Gs[lane * 17 + t + 1];
#pragma unroll
                    for (int i = 0; i <= t; ++i) nxt[i] = Mf[i * 17 + t + 1]; }
                float x0 = gcur, x1 = 0.f;
#pragma unroll
                for (int i = 0; i < t; ++i) { if (i & 1) x1 += u[i] * cur[i]; else x0 += u[i] * cur[i]; }
                u[t] = x0 + x1; UV[lane * 40 + t] = f2bf(u[t]);
#pragma unroll
                for (int i = 0; i < 16; ++i) cur[i] = nxt[i];
                gcur = gnxt; }
        }
        __syncthreads();
        if (wv == 1 || wv == 2) { const int vb = wv - 1;
            acc = MFMA32(*(const bf16x8*)(UV + (32 * vb + qi) * 40 + 8 * hl), *(const bf16x8*)(MT2 + qi * 24 + 8 * hl), acc);
            if (qi >= 16) {
#pragma unroll
                for (int i = 0; i < 16; ++i) YS[(qi - 16) * 64 + 32 * vb + crow16(i, hl)] = acc[i]; }
        }
        if (wv >= 4) { const int vb = (wv >> 1) & 1, kb = wv & 1;
#pragma unroll
            for (int s = 0; s < 2; ++s) zacc = MFMA32(*(const bf16x8*)(UV + (32 * vb + qi) * 40 + 16 * s + 8 * hl), *(const bf16x8*)(BKt + (32 * kb + qi) * 40 + 16 * s + 8 * hl), zacc);
            const float pc = PC[32 * kb + qi];
#pragma unroll
            for (int i = 0; i < 16; ++i) { zacc[i] *= pc; ZB[(32 * vb + crow16(i, hl)) * 72 + 32 * kb + qi] = f2bf(zacc[i]); }
        }
        __syncthreads();
#pragma unroll
        for (int i = 0; i < 2; ++i) { const int t = wv * 2 + i;
            const float y = YS[t * 64 + c]; const float mean = wave_sum(y) * (1.0f / 64.0f); const float dlt = y - mean;
            const float var = wave_sum(dlt * dlt) * (1.0f / 64.0f);
            float yn = dlt * rsqrtf(var + 64e-5f) * ln_w + ln_b; yn += bon[i] * VS[t * 64 + c];
            obase[(size_t)(ch * 16 + t) * 512] = f2bf(yn * gv[i]); }
    }
#undef RC_PREFETCH
    __syncthreads();
}

constexpr int KTS = 72;
DI bf16x8 pack8(float a0, float a1, float a2, float a3, float a4, float a5, float a6, float a7) {
    u32x4 w; w.x = pack2(a0, a1); w.y = pack2(a2, a3); w.z = pack2(a4, a5); w.w = pack2(a6, a7); return __builtin_bit_cast(bf16x8, w); }
DI bf16x8 ld_vfrag(const bf16_t* vt, int off) { const u32x2 lo = *(const u32x2*)(vt + off), hi = *(const u32x2*)(vt + off + 8); u32x4 w; w.x = lo.x; w.y = lo.y; w.z = hi.x; w.w = hi.y; return __builtin_bit_cast(bf16x8, w); }

struct FlashState { f32x16 o0, o1; float m, l; };

DI void flash_update(FlashState& st, f32x16& sc0, f32x16& sc1, const bf16_t* VT, int vs, int qi, int hl) {
    const bf16x8 va0 = ld_vfrag(VT, qi * vs + 4 * hl), vb0 = ld_vfrag(VT, (32 + qi) * vs + 4 * hl);
    const bf16x8 va1 = ld_vfrag(VT, qi * vs + 32 + 4 * hl), vb1 = ld_vfrag(VT, (32 + qi) * vs + 32 + 4 * hl);
    asm volatile("" ::: "memory");
    float mt = -INFINITY;
#pragma unroll
    for (int i = 0; i < 16; ++i) mt = fmaxf(mt, fmaxf(sc0[i], sc1[i]));
    mt = fmaxf(mt, shfl_xor_(mt, 32, qi + 32 * hl));
    const float mnew = fmaxf(st.m, mt), muse = (mnew == -INFINITY) ? 0.f : mnew;
    const float alpha = __builtin_amdgcn_exp2f(st.m - muse);
    float ls = 0.f;
#pragma unroll
    for (int i = 0; i < 16; ++i) { sc0[i] = __builtin_amdgcn_exp2f(sc0[i] - muse); sc1[i] = __builtin_amdgcn_exp2f(sc1[i] - muse); ls += sc0[i] + sc1[i]; }
    st.l = st.l * alpha + ls; st.m = mnew;
    st.o0 *= alpha; st.o1 *= alpha;
    {
        const bf16x8 p0 = pack8(sc0[0], sc0[1], sc0[2], sc0[3], sc0[4], sc0[5], sc0[6], sc0[7]);
        const bf16x8 p1 = pack8(sc1[0], sc1[1], sc1[2], sc1[3], sc1[4], sc1[5], sc1[6], sc1[7]);
        const bf16x8 wa0 = ld_vfrag(VT, qi * vs + 16 + 4 * hl), wb0 = ld_vfrag(VT, (32 + qi) * vs + 16 + 4 * hl);
        const bf16x8 wa1 = ld_vfrag(VT, qi * vs + 48 + 4 * hl), wb1 = ld_vfrag(VT, (32 + qi) * vs + 48 + 4 * hl);
        st.o0 = MFMA32(va0, p0, st.o0); st.o1 = MFMA32(vb0, p0, st.o1); st.o0 = MFMA32(va1, p1, st.o0); st.o1 = MFMA32(vb1, p1, st.o1);
        const bf16x8 r0 = pack8(sc0[8], sc0[9], sc0[10], sc0[11], sc0[12], sc0[13], sc0[14], sc0[15]);
        const bf16x8 r1 = pack8(sc1[8], sc1[9], sc1[10], sc1[11], sc1[12], sc1[13], sc1[14], sc1[15]);
        st.o0 = MFMA32(wa0, r0, st.o0); st.o1 = MFMA32(wb0, r0, st.o1); st.o0 = MFMA32(wa1, r1, st.o0); st.o1 = MFMA32(wb1, r1, st.o1);
    }
}
DI void qk_tile(const bf16_t* KT, const bf16x8 (&qf)[4], int qi, int hl, f32x16& sc0, f32x16& sc1) {
#pragma unroll
    for (int i = 0; i < 16; ++i) { sc0[i] = 0.f; sc1[i] = 0.f; }
#pragma unroll
    for (int s = 0; s < 4; ++s) {
        const bf16x8 k0 = *(const bf16x8*)(KT + qi * KTS + 16 * s + 8 * hl), k1 = *(const bf16x8*)(KT + (32 + qi) * KTS + 16 * s + 8 * hl);
        sc0 = MFMA32(k0, qf[s], sc0); sc1 = MFMA32(k1, qf[s], sc1);
    }
}
struct KVRegs { u32x4 k, v; };
DI void kv_fetch(KVRegs& r, const bf16_t* pb, int kcol, int vcol, int k0) {
    const int tid = tid_();
    const unsigned ok_ = (unsigned)((k0 + (tid >> 3)) * PLD + kcol + (tid & 7) * 8) * 2u, ov_ = (unsigned)((k0 + (tid & 63)) * PLD + vcol + (tid >> 6) * 8) * 2u;
    r.k = *(const u32x4*)((const char*)pb + ok_);
    r.v = *(const u32x4*)((const char*)pb + ov_);
}
DI void kv_store(const KVRegs& r, bf16_t* KT, bf16_t* VT) {
    const int tid = tid_();
    *(u32x4*)(KT + (tid >> 3) * KTS + (tid & 7) * 8) = r.k;
    const int key = tid & 63, ch = tid >> 6;
#pragma unroll
    for (int j = 0; j < 8; ++j) VT[(ch * 8 + j) * KTS + key] = (bf16_t)((j & 1) ? (r.v[j >> 1] >> 16) : (r.v[j >> 1] & 0xFFFFu));
}
template <bool LUTB, bool CAUSAL, bool WHI, bool SEL>
DI void mask_tile(f32x16& sc0, f32x16& sc1, const float* lut, int qpos, int k0, int hl, bool sel, float qs) {
    const float bfar = lut[128];
#pragma unroll
    for (int g8 = 0; g8 < 2; ++g8) {
        float ba[8], bb[8];
#pragma unroll
        for (int j = 0; j < 8; ++j) { const int i = g8 * 8 + j, kl = (i & 3) + 8 * (i >> 2) + 4 * hl; const int da = qpos - (k0 + kl), db = da - 32;
            ba[j] = LUTB ? lut[da > 128 ? 128 : (da < 0 ? 0 : da)] : bfar; bb[j] = LUTB ? lut[db > 128 ? 128 : (db < 0 ? 0 : db)] : bfar; }
        if (LUTB) asm volatile("" ::: "memory");
#pragma unroll
        for (int j = 0; j < 8; ++j) { const int i = g8 * 8 + j, kl = (i & 3) + 8 * (i >> 2) + 4 * hl; const int da = qpos - (k0 + kl), db = da - 32;
            { const float v = sc0[i] * qs + ba[j]; bool ok = true; if (CAUSAL) ok = ok && da >= 0; if (WHI) ok = ok && da < 256; if (SEL) ok = ok && sel; sc0[i] = ok ? v : -INFINITY; }
            { const float v = sc1[i] * qs + bb[j]; bool ok = true; if (CAUSAL) ok = ok && db >= 0; if (WHI) ok = ok && db < 256; if (SEL) ok = ok && sel; sc1[i] = ok ? v : -INFINITY; } }
    }
}

__device__ __forceinline__ void nsa_item(unsigned char* smem, CP p, int L, int b, int g, int qb, int ocol) {
    bf16_t* KT = (bf16_t*)smem;
    bf16_t* VT = (bf16_t*)(smem + 9216);
    float* LUT = (float*)(smem + 18432);
    unsigned* SELM = (unsigned*)(smem + 20736);
    unsigned* ORM = (unsigned*)(smem + 20992);
    float* PA = (float*)(smem + 21504);
    float* PBv = (float*)(smem + 54272);
    bf16_t* KT2 = (bf16_t*)(smem + 87040);
    bf16_t* VT2 = (bf16_t*)(smem + 105472);
    const int tid = tid_(), lane = tid & 63, wv = tid >> 6, hh = wv >> 1, qhalf = wv & 1, qi = lane & 31, hl = lane >> 5;
    const int ql = qhalf * 32 + qi, qpos = qb * 64 + ql, head = g * 4 + hh;
    bf16_t* pb = (bf16_t*)(p->ws + WS_PROJ) + (size_t)b * SEQ * PLD;
    bf16_t* qrow = pb + (size_t)qpos * PLD;
    __syncthreads();
    for (int i = tid; i < 4 * 129; i += 512) { const int h2 = i / 129, dd = i % 129; int bk;
        if (dd < 16) bk = dd; else if (dd >= 128) bk = 31; else { bk = 16 + (int)(logf((float)dd / 16.0f) / 2.0794415416798357f * 16.0f); bk = bk > 31 ? 31 : bk; }
        LUT[h2 * 132 + dd] = p->in[I_RELB][bk * 8 + g * 4 + h2] * 1.4426950408889634f; }
    if (tid == 0) *ORM = 0u;
    if (tid < 64) SELM[tid] = 0u;
    if (tid < 256) PBv[tid * 32] = 0.f;
    { const float* kc = (const float*)(p->ws + WS_KC) + ((size_t)(0 * 16 + b) * 2 + g) * 128 * 64; const float* vc = (const float*)(p->ws + WS_KC) + ((size_t)(1 * 16 + b) * 2 + g) * 128 * 64;
      for (int i = tid; i < 128 * 64; i += 512) { const int n = i >> 6, d = i & 63; KT2[n * KTS + d] = f2bf(kc[i]); }
      for (int i = tid; i < 128 * 64; i += 512) { const int n = i & 127, d = i >> 7; VT2[d * 136 + n] = f2bf(vc[n * 64 + d]); } }
    bf16x8 qf[4];
#pragma unroll
    for (int s = 0; s < 4; ++s) qf[s] = *(const bf16x8*)(qrow + C_NQ + head * 64 + 16 * s + 8 * hl);
    float g0, g1, g2;
    { const bf16_t* gp = qrow + C_NG + head * 3; g0 = sigmoidf_(bf2f(gp[0])); g1 = sigmoidf_(bf2f(gp[1])); g2 = sigmoidf_(bf2f(gp[2])); }
    __syncthreads();
    const float* lut = LUT + hh * 132;
    constexpr float QS = 0.125f * 1.4426950408889634f;
    f32x16 fin0, fin1;
    {
        FlashState st;
#pragma unroll
        for (int i = 0; i < 16; ++i) { st.o0[i] = 0.f; st.o1[i] = 0.f; }
        st.m = -INFINITY; st.l = 0.f;
#pragma nounroll
        for (int t = 0; t < 2; ++t) {
            f32x16 sc0, sc1; qk_tile(KT2 + t * 64 * KTS, qf, qi, hl, sc0, sc1);
#pragma unroll
            for (int g8 = 0; g8 < 2; ++g8) { float ba[8], bb[8];
#pragma unroll
                for (int j = 0; j < 8; ++j) { const int i = g8 * 8 + j, kl = (i & 3) + 8 * (i >> 2) + 4 * hl; const int da = qpos - (16 * (64 * t + kl) + 31), db = da - 512;
                    ba[j] = lut[da > 128 ? 128 : (da < 0 ? 0 : da)]; bb[j] = lut[db > 128 ? 128 : (db < 0 ? 0 : db)]; }
                asm volatile("" ::: "memory");
#pragma unroll
                for (int j = 0; j < 8; ++j) { const int i = g8 * 8 + j, kl = (i & 3) + 8 * (i >> 2) + 4 * hl; const int na = 64 * t + kl, nb = na + 32; const int da = qpos - (16 * na + 31), db = da - 512;
                    sc0[i] = (da >= 0 && na < 127) ? sc0[i] * QS + ba[j] : -INFINITY; sc1[i] = (db >= 0 && nb < 127) ? sc1[i] * QS + bb[j] : -INFINITY; } }
            flash_update(st, sc0, sc1, VT2 + 64 * t, 136, qi, hl);
        }
        const float lt = st.l + shfl_xor_(st.l, 32, lane); const float inv = 1.0f / fmaxf(lt, 1e-30f);
        const float muse = (st.m == -INFINITY) ? 0.f : st.m;
        fin0 = st.o0 * (g0 * inv); fin1 = st.o1 * (g0 * inv);
#pragma nounroll
        for (int t = 0; t < 2; ++t) {
            f32x16 sc0, sc1; qk_tile(KT2 + t * 64 * KTS, qf, qi, hl, sc0, sc1);
#pragma unroll
            for (int g8 = 0; g8 < 2; ++g8) { float ba[8], bb[8];
#pragma unroll
                for (int j = 0; j < 8; ++j) { const int i = g8 * 8 + j, kl = (i & 3) + 8 * (i >> 2) + 4 * hl; const int da = qpos - (16 * (64 * t + kl) + 31), db = da - 512;
                    ba[j] = lut[da > 128 ? 128 : (da < 0 ? 0 : da)]; bb[j] = lut[db > 128 ? 128 : (db < 0 ? 0 : db)]; }
                asm volatile("" ::: "memory");
#pragma unroll
                for (int j = 0; j < 8; ++j) { const int i = g8 * 8 + j, kl = (i & 3) + 8 * (i >> 2) + 4 * hl; const int na = 64 * t + kl, nb = na + 32; const int da = qpos - (16 * na + 31), db = da - 512;
                    const float va = __builtin_amdgcn_exp2f(sc0[i] * QS + ba[j] - muse) * inv, vb = __builtin_amdgcn_exp2f(sc1[i] * QS + bb[j] - muse) * inv;
                    sc0[i] = (da >= 0 && na < 127) ? va : 0.f; sc1[i] = (db >= 0 && nb < 127) ? vb : 0.f; } }
#pragma unroll
            for (int i4 = 0; i4 < 4; ++i4) {
                { const int m = 16 * t + 2 * i4 + hl; PA[(hh * 64 + ql) * 32 + m] = sc0[4 * i4] + sc0[4 * i4 + 1] + sc0[4 * i4 + 2] + sc0[4 * i4 + 3]; PBv[(hh * 64 + ql) * 32 + m + 1] = sc0[4 * i4 + 3]; }
                { const int m = 16 * t + 8 + 2 * i4 + hl; PA[(hh * 64 + ql) * 32 + m] = sc1[4 * i4] + sc1[4 * i4 + 1] + sc1[4 * i4 + 2] + sc1[4 * i4 + 3]; if (m + 1 < 32) PBv[(hh * 64 + ql) * 32 + m + 1] = sc1[4 * i4 + 3]; }
            }
        }
    }
    __syncthreads();
    {
        float* IMP = (float*)smem;
        const int q = tid & 63, part = tid >> 6, cur = qb;
#pragma unroll
        for (int mm = 0; mm < 4; ++mm) { const int m = part * 4 + mm; float v;
            if (m == 0 || m == cur || m == cur - 1) v = INFINITY;
            else if (m <= cur) { v = 0.f; for (int h2 = 0; h2 < 4; ++h2) v += PA[(h2 * 64 + q) * 32 + m] + PBv[(h2 * 64 + q) * 32 + m]; }
            else v = -INFINITY;
            IMP[q * 33 + m] = v; }
        __syncthreads();
        unsigned bits = 0u;
#pragma unroll
        for (int mm = 0; mm < 4; ++mm) { const int m = part * 4 + mm; const float v = IMP[q * 33 + m]; int rank = 0;
            for (int m2 = 0; m2 < 32; ++m2) { const float v2 = IMP[q * 33 + m2]; rank += (v2 > v || (v2 == v && m2 < m)) ? 1 : 0; }
            if (rank < 8 && v > -INFINITY) bits |= 1u << m; }
        atomicOr(&SELM[q], bits); atomicOr(ORM, bits);
    }
    __syncthreads();
    const unsigned mysel = SELM[ql], orm = *ORM;
    __syncthreads();
    float* PARK = PA + (wv * 32) * 64 + lane;
#pragma unroll
    for (int i = 0; i < 16; ++i) { PARK[i * 64] = fin0[i]; PARK[(16 + i) * 64] = fin1[i]; }
    {
        FlashState st;
#pragma unroll
        for (int i = 0; i < 16; ++i) { st.o0[i] = 0.f; st.o1[i] = 0.f; }
        st.m = -INFINITY; st.l = 0.f;
        const unsigned todo = orm & (qb >= 31 ? 0xFFFFFFFFu : ((2u << qb) - 1u));
        KVRegs kr;
        int m = todo ? __builtin_ctz(todo) : -1;
        if (m >= 0) { kv_fetch(kr, pb, C_KS + g * 64, C_VS + g * 64, m * 64); __syncthreads(); kv_store(kr, KT, VT); __syncthreads(); }
        while (m >= 0) {
            const unsigned rest = todo & ~((2u << m) - 1u); const int nm = (m < 31 && rest) ? __builtin_ctz(rest) : -1;
            if (nm >= 0) kv_fetch(kr, pb, C_KS + g * 64, C_VS + g * 64, nm * 64);
            const bool sel = (mysel >> m) & 1u;
            if (__builtin_amdgcn_ballot_w64(sel) != 0ull) {
                f32x16 sc0, sc1; qk_tile(KT, qf, qi, hl, sc0, sc1);
                if (m + 3 <= qb) mask_tile<false, false, false, true>(sc0, sc1, lut, qpos, m * 64, hl, sel, QS);
                else mask_tile<true, true, false, true>(sc0, sc1, lut, qpos, m * 64, hl, sel, QS);
                flash_update(st, sc0, sc1, VT, KTS, qi, hl);
            }
            __syncthreads();
            if (nm >= 0) kv_store(kr, KT, VT);
            __syncthreads();
            m = nm;
        }
        const float lt = st.l + shfl_xor_(st.l, 32, lane); const float sc = g1 / fmaxf(lt, 1e-30f);
#pragma unroll
        for (int i = 0; i < 16; ++i) { PARK[i * 64] += st.o0[i] * sc; PARK[(16 + i) * 64] += st.o1[i] * sc; }
    }
    {
        FlashState st;
#pragma unroll
        for (int i = 0; i < 16; ++i) { st.o0[i] = 0.f; st.o1[i] = 0.f; }
        st.m = -INFINITY; st.l = 0.f;
        KVRegs kr;
        int w = qb >= 4 ? 0 : 4 - qb;
        kv_fetch(kr, pb, C_KW + g * 64, C_VW + g * 64, qb * 64 - 256 + 64 * w); __syncthreads(); kv_store(kr, KT, VT); __syncthreads();
        for (; w < 5; ++w) {
            const int k0 = qb * 64 - 256 + 64 * w;
            if (w < 4) kv_fetch(kr, pb, C_KW + g * 64, C_VW + g * 64, k0 + 64);
            f32x16 sc0, sc1; qk_tile(KT, qf, qi, hl, sc0, sc1);
            if (w == 0) mask_tile<false, false, true, false>(sc0, sc1, lut, qpos, k0, hl, true, QS);
            else if (w == 1) mask_tile<false, false, false, false>(sc0, sc1, lut, qpos, k0, hl, true, QS);
            else if (w < 4) mask_tile<true, false, false, false>(sc0, sc1, lut, qpos, k0, hl, true, QS);
            else mask_tile<true, true, false, false>(sc0, sc1, lut, qpos, k0, hl, true, QS);
            flash_update(st, sc0, sc1, VT, KTS, qi, hl);
            __syncthreads();
            if (w < 4) kv_store(kr, KT, VT);
            __syncthreads();
        }
        const float lt = st.l + shfl_xor_(st.l, 32, lane); const float sc = g2 / fmaxf(lt, 1e-30f);
#pragma unroll
        for (int i = 0; i < 16; ++i) { fin0[i] = PARK[i * 64] + st.o0[i] * sc; fin1[i] = PARK[(16 + i) * 64] + st.o1[i] * sc; }
    }
#pragma unroll
    for (int i4 = 0; i4 < 4; ++i4) {
        u32x2 w0; w0.x = pack2(fin0[4 * i4], fin0[4 * i4 + 1]); w0.y = pack2(fin0[4 * i4 + 2], fin0[4 * i4 + 3]);
        u32x2 w1; w1.x = pack2(fin1[4 * i4], fin1[4 * i4 + 1]); w1.y = pack2(fin1[4 * i4 + 2], fin1[4 * i4 + 3]);
        *(u32x2*)(qrow + ocol + head * 64 + 8 * i4 + 4 * hl) = w0;
        *(u32x2*)(qrow + ocol + head * 64 + 32 + 8 * i4 + 4 * hl) = w1;
    }
}

constexpr int PH_PER_LAYER = 15, PH_TOTAL = DEPTH * PH_PER_LAYER + 1;
enum { S_PREP = 0, S_GU1, S_D1, S_NORM_MIX, S_WIN, S_CMP, S_LORA, S_SCAN, S_MERGE, S_OUT, S_NORM2, S_GU2, S_D2, S_NORM_PLE, S_PLEG, S_FINAL };

__device__ __forceinline__ void run_phase(unsigned char* smem, CP p, int ph) {
    const bool fin = (ph == DEPTH * PH_PER_LAYER);
    const int L = fin ? 0 : ph / PH_PER_LAYER; const int sub = fin ? S_FINAL : ph % PH_PER_LAYER;
    unsigned char* ws = p->ws; float* H = p->out;
    bf16_t* W = (bf16_t*)(ws + WS_WBF); bf16_t* UN = (bf16_t*)(ws + WS_UN); bf16_t* PROJ = (bf16_t*)(ws + WS_PROJ); bf16_t* ACT = (bf16_t*)(ws + WS_ACT);
    bf16_t* TMP = (bf16_t*)(ws + WS_TMP); bf16_t* PBF = (bf16_t*)(ws + WS_PB); bf16_t* ORW = (bf16_t*)(ws + WS_ORW);
    bf16_t* XK = (bf16_t*)(ws + WS_XK); bf16_t* XV = (bf16_t*)(ws + WS_XV); float* P01 = (float*)(ws + WS_P01);
    if (sub == S_PREP) convert_layer_weights(smem, p, L);
    if (sub == S_NORM_MIX) convert_ffn2_weights(smem, p, L);
    if (sub == S_NORM2) cvt_f32_bf16(p->in[I_P] + (size_t)L * T_TOK * 256, PBF, (size_t)T_TOK * 256 / 4);
    if (sub == S_CMP) lora_act(p, L);
    if (sub == S_LORA) finalize_cmp(smem, p, L);
    if (sub == S_NORM_PLE) { EpiBf16<DM> e; e.O = TMP; run_gemm(smem, PBF, 256, W + E_PW, T_TOK, DM, 256, e); }
    if (sub == S_PREP || sub == S_NORM_MIX || sub == S_NORM2 || sub == S_NORM_PLE || sub == S_FINAL) {
        const float* hin = (sub == S_PREP && L == 0) ? p->in[I_X] : H; float* hcopy = (sub == S_PREP && L == 0) ? H : nullptr;
        const float* g = sub == S_PREP ? p->in[I_F1N] + L * DM : sub == S_NORM_MIX ? p->in[I_MIXN] + L * DM : sub == S_NORM2 ? p->in[I_F2N] + L * DM : sub == S_NORM_PLE ? p->in[I_PLEN] + L * DM : p->in[I_FINN];
        rmsnorm_rows(hin, hcopy, g, sub == S_FINAL ? nullptr : UN, sub == S_FINAL ? H : nullptr);
    } else if (sub == S_GU1 || sub == S_GU2) {
        EpiSwiglu e; e.O = ACT; run_gemm(smem, UN, DM, W + (sub == S_GU1 ? E_GU1 : E_GU2), T_TOK, 2 * DFF, DM, e);
    } else if (sub == S_D1 || sub == S_D2 || sub == S_OUT) {
        EpiResid e; e.H = H; e.scale = sub == S_OUT ? 1.0f : 0.5f;
        run_gemm(smem, sub == S_OUT ? UN : ACT, sub == S_OUT ? DM : DFF, W + (sub == S_D1 ? E_D1 : sub == S_D2 ? E_D2 : E_OUT), T_TOK, DM, sub == S_OUT ? DM : DFF, e);
    } else if (sub == S_WIN) {
        EpiProj e; e.O = PROJ; e.XK = XK; e.XV = XV; run_gemm(smem, UN, DM, W + E_IN, T_TOK, N_WIN, DM, e);
    } else if (sub == S_CMP) {
#pragma nounroll
        for (int kv = 0; kv < 2; ++kv) { EpiF32 e; e.C = P01 + (size_t)kv * 4096 * 256;
            run_gemm(smem, kv ? XV : XK, 1024, W + E_C1 + (size_t)kv * 256 * 1024, 4096, 256, 1024, e, kv ? 240 : 0); }
        { EpiBf16<PLD> e; e.O = PROJ + C_NG; run_gemm(smem, UN, DM, W + E_NG, T_TOK, 256, DM, e, 128); }
    } else if (sub == S_LORA) {
        EpiLora e; e.EWA = UN; e.G = ORW;
        run_gemm(smem, (const bf16_t*)(ws + WS_LACT), 256, W + E_LORA, T_TOK, 1536, 256, e);
    } else if (sub == S_SCAN) {
        for (int item = bid_(); item < 256; item += gridDim.x) {
            __syncthreads();
            if (item < 128) rwkv_chunked(smem, p, L, item >> 3, item & 7); else hgrn_scan(smem, p, L, (item - 128) >> 3, (item - 128) & 7);
        }
        unsigned* ctr = (unsigned*)(ws + 14336) + L * 64;
        volatile unsigned* slot = (volatile unsigned*)(smem + 141 * 1024);
        for (;;) {
            __syncthreads();
            if (tid_() == 0) *slot = __hip_atomic_fetch_add(ctr, 1u, __ATOMIC_RELAXED, __HIP_MEMORY_SCOPE_AGENT);
            __syncthreads();
            const unsigned idx = *slot;
            if (idx >= 1024u) break;
            const int bg = idx & 31, qb = 31 - (int)(idx >> 5);
            nsa_item(smem, p, L, bg >> 1, bg & 1, qb, C_NQ);
        }
    } else if (sub == S_MERGE) {
#pragma nounroll
        for (int j = 0; j < 3; ++j) { EpiMerge e; e.MRG = UN; e.PROJ = PROJ; e.J = j;
            const bf16_t* A = j == 0 ? PROJ + C_HQ : (j == 1 ? PROJ + C_NQ : ORW);
            run_gemm(smem, A, j == 2 ? 512 : PLD, W + E_BR + (size_t)j * 1024 * 512, T_TOK, DM, 512, e); }
    } else if (sub == S_PLEG) {
        EpiPleGate e; e.H = H; e.TMP = TMP; run_gemm(smem, UN, DM, W + E_PG, T_TOK, DM, DM, e);
    }
}

#define XB_TMO      128
#define XB_XCNT(j)  (256  + 64 * (j))
#define XB_XSUB(j)  (1280 + 64 * (j))
#define XB_XGEN(j)  (2304 + 64 * (j))
#define XB_TOP      3328
#define XB_TOPGEN   3392
#define XCD_BAR_WORDS 3456
#define XB_SPIN_CAP (1u << 20)
DI unsigned xb_ld(unsigned* p)              { return __hip_atomic_load(p, __ATOMIC_RELAXED, __HIP_MEMORY_SCOPE_AGENT); }
DI unsigned xb_add(unsigned* p, unsigned v) { return __hip_atomic_fetch_add(p, v, __ATOMIC_RELAXED, __HIP_MEMORY_SCOPE_AGENT); }
DI unsigned xb_xcc_id() { return (unsigned)__builtin_amdgcn_s_getreg((3 << 11) | 20) & 0xFu; }
#define XB_SPIN(cond, bar) do { unsigned _sp = 0; while (cond) { __builtin_amdgcn_s_sleep(1); \
    if ((++_sp & 255u) == 0u) { if (xb_ld(&(bar)[XB_TMO])) break; if (_sp > XB_SPIN_CAP) { atomicAdd(&(bar)[XB_TMO], 1u); break; } } } } while (0)
struct XcdBarrier { unsigned* bar; unsigned x; volatile LAS unsigned* st; };
DI XcdBarrier xcd_barrier_post(unsigned* bar, volatile LAS unsigned* st) {
    XcdBarrier b; b.bar = bar; b.x = xb_xcc_id(); b.st = st;
    if (threadIdx.x == 0) (void)xb_add(&bar[XB_XCNT(b.x)], 1u);
    return b;
}
DI void xcd_barrier_complete(unsigned* bar, unsigned x, unsigned& nloc, unsigned& nx) {
    const unsigned G = gridDim.x * gridDim.y * gridDim.z;
    unsigned sum, cnt, mine, sp = 0u;
    for (;;) {
        sum = 0u; cnt = 0u; mine = 0u;
#pragma unroll
        for (unsigned j = 0; j < 16; ++j) { const unsigned c = xb_ld(&bar[XB_XCNT(j)]); sum += c; cnt += (c > 0u) ? 1u : 0u; mine = (j == x) ? c : mine; }
        if (sum == G) break;
        __builtin_amdgcn_s_sleep(1);
        if ((++sp & 255u) == 0u) { if (xb_ld(&bar[XB_TMO])) break; if (sp > XB_SPIN_CAP) { atomicAdd(&bar[XB_TMO], 1u); break; } }
    }
    nloc = mine > 0u ? mine : 1u; nx = cnt > 0u ? cnt : 1u;
}
DI void xcd_barrier(const XcdBarrier& b) {
    asm volatile("s_waitcnt vmcnt(0)" ::: "memory");
    __syncthreads();
    if (threadIdx.x == 0) {
        unsigned* bar = b.bar;
        __builtin_amdgcn_s_waitcnt(0);
        unsigned nloc = b.st[0], nx = b.st[1];
        if (nloc == 0u) { xcd_barrier_complete(bar, b.x, nloc, nx); b.st[0] = nloc; b.st[1] = nx; }
        const unsigned old = xb_add(&bar[XB_XSUB(b.x)], 1u);
        const unsigned gen = old / nloc;
        if (old + 1u == (gen + 1u) * nloc) {
            __builtin_amdgcn_fence(__ATOMIC_RELEASE, "agent");
            asm volatile("s_waitcnt vmcnt(0)" ::: "memory");
            const unsigned og = xb_add(&bar[XB_TOP], 1u);
            const unsigned tg = og / nx;
            if (og + 1u == (tg + 1u) * nx) xb_add(&bar[XB_TOPGEN], 1u);
            else XB_SPIN(xb_ld(&bar[XB_TOPGEN]) == tg, bar);
            __builtin_amdgcn_fence(__ATOMIC_ACQUIRE, "agent");
            xb_add(&bar[XB_XGEN(b.x)], 1u);
            asm volatile("s_waitcnt vmcnt(0)" ::: "memory");
        } else {
            XB_SPIN(xb_ld(&bar[XB_XGEN(b.x)]) == gen, bar);
            __builtin_amdgcn_fence(__ATOMIC_ACQUIRE, "agent");
            asm volatile("s_waitcnt vmcnt(0)" ::: "memory");
        }
    }
    __syncthreads();
}

__global__ void __launch_bounds__(512, 2) mega_fwd(Params p) {
    extern __shared__ __attribute__((aligned(16))) unsigned char smem[];
    cg::grid_group grid = cg::this_grid();
    volatile LAS unsigned* xst = (volatile LAS unsigned*)(LAS unsigned char*)(smem + 140 * 1024);
    if (threadIdx.x == 0) { xst[0] = 0u; xst[1] = 0u; }
    __syncthreads();
    const XcdBarrier xb = xcd_barrier_post((unsigned*)(p.ws + WS_BAR), xst);
#ifndef PROBE_DUP
#define PROBE_DUP -1
#endif
    constexpr int IT_PER_LAYER = PH_PER_LAYER + (PROBE_DUP >= 0 ? 1 : 0);
    const int it_lo = p.ph_lo, it_hi = PROBE_DUP >= 0 ? DEPTH * IT_PER_LAYER + 1 : p.ph_hi;
    for (int it = it_lo; it < it_hi; ++it) {
        int ph = it;
        if (PROBE_DUP >= 0) { const int l_ = it / IT_PER_LAYER, r_ = it % IT_PER_LAYER; ph = l_ * PH_PER_LAYER + (r_ <= PROBE_DUP ? r_ : r_ - 1); }
        CP pp = (CP)__builtin_amdgcn_kernarg_segment_ptr(); asm volatile("" : "+s"(pp));
        run_phase(smem, pp, ph);
        if (it + 1 < it_hi) {
            if (it == it_lo) grid.sync();
            else xcd_barrier(xb);
        }
    }
}

#ifndef MULTI_LAUNCH
#define MULTI_LAUNCH 0
#endif

extern "C" void kernel_launch(void* const* d_in, const int* in_sizes, int n_in, void* d_out, int out_size, void* d_ws, size_t ws_size, hipStream_t stream) {
    static int grid = 0;
    if (grid == 0) {
        if (n_in != N_INPUTS || out_size != T_TOK * DM || ws_size < WS_END) { fprintf(stderr, "kernel_launch: unexpected shapes: n_in %d out %d ws %zu (need %zu)\n", n_in, out_size, ws_size, (size_t)WS_END); grid = -1; return; }
        int dev = 0, cus = 0, per_cu = 0;
        (void)hipGetDevice(&dev); (void)hipDeviceGetAttribute(&cus, hipDeviceAttributeMultiprocessorCount, dev);
        if (hipFuncSetAttribute((const void*)mega_fwd, hipFuncAttributeMaxDynamicSharedMemorySize, LDS_BYTES) != hipSuccess) { fprintf(stderr, "kernel_launch: hipFuncSetAttribute failed\n"); grid = -1; return; }
        if (hipOccupancyMaxActiveBlocksPerMultiprocessor(&per_cu, (const void*)mega_fwd, 512, LDS_BYTES) != hipSuccess || per_cu < 1) { fprintf(stderr, "kernel_launch: occupancy query gives %d\n", per_cu); per_cu = 1; }
        (void)hipGetLastError();
        grid = cus * 1;
        if (grid > 256) grid = 256;
        fprintf(stderr, "kernel_launch: grid %d (cus %d, per_cu %d)\n", grid, cus, per_cu);
    }
    if (grid < 0) return;
    (void)hipMemsetAsync(d_ws, 0, 16384, stream);
    Params p{};
    for (int i = 0; i < N_INPUTS; ++i) p.in[i] = (const float*)d_in[i];
    p.out = (float*)d_out; p.ws = (unsigned char*)d_ws;
#if MULTI_LAUNCH
    for (int ph = 0; ph < PH_TOTAL; ++ph) { p.ph_lo = ph; p.ph_hi = ph + 1; hipLaunchKernelGGL(mega_fwd, dim3(grid), dim3(512), LDS_BYTES, stream, p); }
#else
    p.ph_lo = 0; p.ph_hi = PH_TOTAL;
    void* args[] = {&p};
    hipError_t e = hipLaunchCooperativeKernel((const void*)mega_fwd, dim3(grid), dim3(512), args, LDS_BYTES, stream);
    if (e != hipSuccess) fprintf(stderr, "kernel_launch: cooperative launch failed: %s\n", hipGetErrorString(e));
#endif
}
```
